# Optimizing an MI355X kernel written in HIP

```python
import jax
import jax.numpy as jnp
from jax import lax
import numpy as np

D_MODEL = 1024
BATCH = 2
SEQ = 8192
DEPTH = 2

GRID_W = 64
CTX_LEN = 256
CHUNK = 64
EPS = 1e-6
M_INIT = -1e30

GLA_HEADS = 4
GLA_DK = D_MODEL // 16
GLA_DV = D_MODEL // 8
GLA_RANK = 16
GLA_TAU = 16.0
ML_HEADS = 4
ML_DK = D_MODEL // 8
ML_DV = D_MODEL // 8
CONV_K = 3
ML_F_BIAS_LO = 3.0
ML_F_BIAS_HI = 6.0
RET_HEADS = 4
RET_DK = D_MODEL // 16
RET_DV = D_MODEL // 8
ROPE_BASE = 10000.0

BRANCH_W = GLA_HEADS * GLA_DV
N_BRANCH = 3
D_FF = 4 * D_MODEL
ADA_SCALE = 0.5

GLA_QK = GLA_HEADS * GLA_DK
ML_QK = ML_HEADS * ML_DK
RET_QK = RET_HEADS * RET_DK

IN_SIZES = (GLA_QK, GLA_QK, BRANCH_W, BRANCH_W, 2 * GLA_RANK,
            ML_QK, ML_QK, BRANCH_W, BRANCH_W, 2 * ML_HEADS, 2 * ML_HEADS,
            RET_QK, RET_QK, BRANCH_W, BRANCH_W,
            N_BRANCH * D_MODEL)
IN_WIDTH = sum(IN_SIZES)
IN_SPLITS = tuple(int(s) for s in np.cumsum(IN_SIZES)[:-1])

kernel_name = "hybrid_gla_mlstm_retention_prefix_dit"

F32 = jnp.float32


def rms_norm(x, g):
    xf = x.astype(F32)
    y = xf * lax.rsqrt(jnp.mean(xf * xf, axis=-1, keepdims=True) + EPS)
    return (y * g.astype(F32)).astype(x.dtype)


def modulate(h, shift, scale):
    return h * (1.0 + scale) + shift


def head_norm(o, g, center, dtype):
    B, H, T, dv = o.shape
    of = jnp.swapaxes(o, 1, 2).astype(F32)
    if center:
        of = of - jnp.mean(of, axis=-1, keepdims=True)
    y = of * lax.rsqrt(jnp.mean(of * of, axis=-1, keepdims=True) + EPS)
    return (y.reshape(B, T, H * dv) * g.astype(F32)).astype(dtype)


def _heads(t, n_heads):
    B, T, W = t.shape
    return jnp.transpose(t.reshape(B, T, n_heads, W // n_heads), (0, 2, 1, 3))


def _chunk(t):
    B, H, T = t.shape[:3]
    return t.reshape(B, H, T // CHUNK, CHUNK, *t.shape[3:])


def _flip(t):
    return jnp.flip(t, axis=2)


def _ident(t):
    return t


def dwconv_centred(x, w):
    C = x.shape[-1]
    return lax.conv_general_dilated(
        x, w[:, None, :].astype(x.dtype), window_strides=(1,),
        padding=[(CONV_K // 2, CONV_K // 2)],
        dimension_numbers=("NWC", "WIO", "NWC"), feature_group_count=C)


def axial_rope(x, row, col):
    half = x.shape[-1] // 2
    nf = half // 2
    inv = ROPE_BASE ** (-jnp.arange(nf, dtype=F32) / nf)
    ang = jnp.concatenate([row[:, None] * inv, col[:, None] * inv], axis=-1)
    cos, sin = jnp.cos(ang), jnp.sin(ang)
    xf = x.astype(F32)
    x1, x2 = xf[..., :half], xf[..., half:]
    return jnp.concatenate([x1 * cos - x2 * sin, x1 * sin + x2 * cos], axis=-1).astype(x.dtype)


def decay_states(k, v, log_a, s0):
    kc, vc, la = _chunk(k.astype(F32)), _chunk(v.astype(F32)), _chunk(log_a.astype(F32))
    b = jnp.cumsum(la, axis=3)
    b_last = b[:, :, :, -1]
    k_end = kc * jnp.exp(b_last[:, :, :, None] - b)
    u = jnp.einsum("bhncd,bhnce->bhnde", k_end, vc)

    def step(s, inp):
        dec, u_n = inp
        return dec[..., None] * s + u_n, s

    s_fin, s_prev = lax.scan(step, s0, (jnp.moveaxis(jnp.exp(b_last), 2, 0), jnp.moveaxis(u, 2, 0)))
    return jnp.moveaxis(s_prev, 0, 2), s_fin, b


def decay_outputs(q, k, v, b, s_prev):
    B, H, T, _ = q.shape
    qc, kc, vc = _chunk(q.astype(F32)), _chunk(k.astype(F32)), _chunk(v.astype(F32))
    q_in = qc * jnp.exp(b)
    k_in = kc * jnp.exp(-b)
    mask = jnp.tril(jnp.ones((CHUNK, CHUNK), dtype=bool))
    att = jnp.where(mask, jnp.einsum("bhncd,bhnsd->bhncs", q_in, k_in), 0.0)
    o = jnp.einsum("bhncs,bhnse->bhnce", att, vc) + jnp.einsum("bhncd,bhnde->bhnce", q_in, s_prev)
    return o.reshape(B, H, T, v.shape[-1])


def bidir_decay(ql, kl, vl, lal, qc, kc, vc, lac, need_ctx):
    B, H, _, dk = kl.shape
    s0 = jnp.zeros((B, H, dk, vl.shape[-1]), F32)
    o_l, o_c = [], []
    for d in range(2):
        f = _flip if d else _ident
        sp_c, s_fin_c, b_c = decay_states(f(kc), f(vc), f(lac[d]), s0)
        sp_l, _, b_l = decay_states(f(kl), f(vl), f(lal[d]), s_fin_c)
        o_l.append(f(decay_outputs(f(ql), f(kl), f(vl), b_l, sp_l)))
        if need_ctx:
            o_c.append(f(decay_outputs(f(qc), f(kc), f(vc), b_c, sp_c)))
    return o_l[0] + o_l[1], (o_c[0] + o_c[1] if need_ctx else None)


def mlstm_states(k, v, log_i, log_f, state0):
    kc, vc = _chunk(k.astype(F32)), _chunk(v.astype(F32))
    li, lf = _chunk(log_i), _chunk(log_f)
    b = jnp.cumsum(lf, axis=3)
    b_last = b[..., -1]
    g = b_last[..., None] - b + li
    m_loc = jnp.max(g, axis=-1)
    w = jnp.exp(g - m_loc[..., None])
    u_c = jnp.einsum("bhnc,bhncd,bhnce->bhnde", w, kc, vc)
    u_n = jnp.einsum("bhnc,bhncd->bhnd", w, kc)

    def step(carry, inp):
        c, n, m = carry
        bl, ml, uc, un = inp
        m_new = jnp.maximum(bl + m, ml)
        a = jnp.exp(bl + m - m_new)
        e = jnp.exp(ml - m_new)
        return (a[..., None, None] * c + e[..., None, None] * uc, a[..., None] * n + e[..., None] * un, m_new), (c, n, m)

    mv = lambda t: jnp.moveaxis(t, 2, 0)
    fin, prev = lax.scan(step, state0, (mv(b_last), mv(m_loc), mv(u_c), mv(u_n)))
    prev = tuple(jnp.moveaxis(p, 0, 2) for p in prev)
    return prev, fin, b


def mlstm_outputs(q, k, v, log_i, b, prev):
    B, H, T, _ = q.shape
    c_prev, n_prev, m_prev = prev
    qc, kc, vc = _chunk(q.astype(F32)), _chunk(k.astype(F32)), _chunk(v.astype(F32))
    li = _chunk(log_i)
    mask = jnp.tril(jnp.ones((CHUNK, CHUNK), dtype=bool))
    a = jnp.where(mask, b[..., :, None] - b[..., None, :] + li[..., None, :], -jnp.inf)
    inter = b + m_prev[..., None]
    m = jnp.maximum(jnp.max(a, axis=-1), inter)
    s = jnp.einsum("bhncd,bhnsd->bhncs", qc, kc) * jnp.exp(a - m[..., None])
    e_inter = jnp.exp(inter - m)
    num = jnp.einsum("bhncs,bhnse->bhnce", s, vc) + e_inter[..., None] * jnp.einsum("bhncd,bhnde->bhnce", qc, c_prev)
    den = jnp.sum(s, axis=-1) + e_inter * jnp.einsum("bhncd,bhnd->bhnc", qc, n_prev)
    h = num / jnp.maximum(jnp.abs(den), jnp.exp(-m))[..., None]
    return h.reshape(B, H, T, v.shape[-1])


def bidir_mlstm(ql, kl, vl, lil, lfl, qc, kc, vc, lic, lfc, need_ctx):
    B, H, _, dk = kl.shape
    st0 = (jnp.zeros((B, H, dk, vl.shape[-1]), F32), jnp.zeros((B, H, dk), F32), jnp.full((B, H), M_INIT, F32))
    o_l, o_c = [], []
    for d in range(2):
        f = _flip if d else _ident
        prev_c, fin_c, b_c = mlstm_states(f(kc), f(vc), f(lic[d]), f(lfc[d]), st0)
        prev_l, _, b_l = mlstm_states(f(kl), f(vl), f(lil[d]), f(lfl[d]), fin_c)
        o_l.append(f(mlstm_outputs(f(ql), f(kl), f(vl), f(lil[d]), b_l, prev_l)))
        if need_ctx:
            o_c.append(f(mlstm_outputs(f(qc), f(kc), f(vc), f(lic[d]), b_c, prev_c)))
    return o_l[0] + o_l[1], (o_c[0] + o_c[1] if need_ctx else None)


def gla_branch(pl, pc, a2, a_bias, norm_g, need_ctx, dtype):
    def prep(p):
        q, k, v, g, a = p
        B, T = q.shape[:2]
        q = _heads(q, GLA_HEADS) * GLA_DK ** -0.5
        k, v = _heads(k, GLA_HEADS), _heads(v, GLA_HEADS)
        z = jnp.einsum("btjr,jrk->jbtk", a.reshape(B, T, 2, GLA_RANK).astype(F32), a2.astype(F32)) + a_bias.astype(F32)[:, None, None, :]
        la = jax.nn.log_sigmoid(z) / GLA_TAU
        la = jnp.moveaxis(la.reshape(2, B, T, GLA_HEADS, GLA_DK), 3, 2)
        return q, k, v, la, g

    ql, kl, vl, lal, gl = prep(pl)
    qc, kc, vc, lac, gc = prep(pc)
    o_l, o_c = bidir_decay(ql, kl, vl, lal, qc, kc, vc, lac, need_ctx)
    out_l = head_norm(o_l, norm_g, False, dtype) * jax.nn.silu(gl)
    out_c = head_norm(o_c, norm_g, False, dtype) * jax.nn.silu(gc) if need_ctx else None
    return out_l, out_c


def mlstm_branch(pl, pc, conv_w, i_bias, f_bias, norm_g, need_ctx, dtype):
    def prep(p):
        q, k, v, z, ig, fg = p
        B, T = q.shape[:2]
        qk = jax.nn.silu(dwconv_centred(jnp.concatenate([q, k], axis=-1), conv_w))
        q, k = jnp.split(qk, 2, axis=-1)
        q = _heads(q, ML_HEADS)
        k = _heads(k, ML_HEADS) * ML_DK ** -0.5
        v = _heads(v, ML_HEADS)
        li = ig.reshape(B, T, 2, ML_HEADS).astype(F32) + i_bias.astype(F32)
        lf = jax.nn.log_sigmoid(fg.reshape(B, T, 2, ML_HEADS).astype(F32) + f_bias.astype(F32))
        return q, k, v, jnp.transpose(li, (2, 0, 3, 1)), jnp.transpose(lf, (2, 0, 3, 1)), z

    ql, kl, vl, lil, lfl, zl = prep(pl)
    qc, kc, vc, lic, lfc, zc = prep(pc)
    o_l, o_c = bidir_mlstm(ql, kl, vl, lil, lfl, qc, kc, vc, lic, lfc, need_ctx)
    out_l = head_norm(o_l, norm_g, True, dtype) * jax.nn.silu(zl)
    out_c = head_norm(o_c, norm_g, True, dtype) * jax.nn.silu(zc) if need_ctx else None
    return out_l, out_c


def retention_branch(pl, pc, row, col, decay_logit, norm_g, need_ctx, dtype):
    lg = jax.nn.log_sigmoid(decay_logit.astype(F32))

    def prep(p, rope):
        q, k, v, g = p
        q = _heads(q, RET_HEADS)
        k = _heads(k, RET_HEADS) * RET_DK ** -0.5
        if rope:
            q, k = axial_rope(q, row, col), axial_rope(k, row, col)
        la = [jnp.broadcast_to(lg[d][None, :, None, None], k.shape) for d in range(2)]
        return q, k, _heads(v, RET_HEADS), la, g

    ql, kl, vl, lal, gl = prep(pl, True)
    qc, kc, vc, lac, gc = prep(pc, False)
    o_l, o_c = bidir_decay(ql, kl, vl, lal, qc, kc, vc, lac, need_ctx)
    out_l = head_norm(o_l, norm_g, True, dtype) * jax.nn.silu(gl)
    out_c = head_norm(o_c, norm_g, True, dtype) * jax.nn.silu(gc) if need_ctx else None
    return out_l, out_c


def merge(branches, gate_pre, w_branch, w_o):
    B, T = gate_pre.shape[:2]
    gates = jax.nn.sigmoid(gate_pre.reshape(B, T, N_BRANCH, D_MODEL).astype(F32)).astype(gate_pre.dtype)
    br = jnp.stack(branches, axis=2)
    y = jnp.einsum("btjc,jcd->btjd", br, w_branch)
    return jnp.sum(gates * y, axis=2) @ w_o


def mixer_layer(h_l, h_c, row, col, w_in, gla_a2, gla_a_bias, gla_norm_g, ml_conv, ml_i_bias,
                ml_f_bias, ml_norm_g, ret_decay_logit, ret_norm_g, w_branch, w_o, need_ctx):
    dt = h_l.dtype
    pl = jnp.split(h_l @ w_in, IN_SPLITS, axis=-1)
    pc = jnp.split(h_c @ w_in, IN_SPLITS, axis=-1)
    g_l, g_c = gla_branch(pl[0:5], pc[0:5], gla_a2, gla_a_bias, gla_norm_g, need_ctx, dt)
    m_l, m_c = mlstm_branch(pl[5:11], pc[5:11], ml_conv, ml_i_bias, ml_f_bias, ml_norm_g, need_ctx, dt)
    r_l, r_c = retention_branch(pl[11:15], pc[11:15], row, col, ret_decay_logit, ret_norm_g, need_ctx, dt)
    out_l = merge([g_l, m_l, r_l], pl[15], w_branch, w_o)
    out_c = merge([g_c, m_c, r_c], pc[15], w_branch, w_o) if need_ctx else None
    return out_l, out_c


def squared_relu_mlp(h, w_up, w_down):
    return jnp.square(jax.nn.relu(h @ w_up)) @ w_down


def setup_inputs(seed: int = 0) -> dict:
    key = jax.random.key(seed)
    ks = jax.random.split(key, 24)
    L, D = DEPTH, D_MODEL

    def nrm(k, shape, scale):
        return jax.random.normal(k, shape, F32) * scale

    gamma = 1.0 - 2.0 ** (-5.0 - jnp.arange(RET_HEADS, dtype=F32))
    return {
        "x": nrm(ks[0], (BATCH, SEQ, D), 1.0),
        "c": nrm(ks[1], (BATCH, D), 1.0),
        "ctx": nrm(ks[2], (BATCH, CTX_LEN, D), 1.0),
        "c_ctx": nrm(ks[3], (D,), 1.0),
        "norm1_g": 1.0 + nrm(ks[4], (L, D), 0.01),
        "norm2_g": 1.0 + nrm(ks[5], (L, D), 0.01),
        "w_ada": nrm(ks[6], (L, D, 6 * D), ADA_SCALE * D ** -0.5),
        "b_ada": nrm(ks[7], (L, 6 * D), 0.01),
        "w_in": nrm(ks[8], (L, D, IN_WIDTH), D ** -0.5),
        "gla_a2": nrm(ks[9], (L, 2, GLA_RANK, GLA_QK), GLA_RANK ** -0.5),
        "gla_a_bias": nrm(ks[10], (L, 2, GLA_QK), 0.01),
        "gla_norm_g": 1.0 + nrm(ks[11], (L, BRANCH_W), 0.01),
        "ml_conv": nrm(ks[12], (L, CONV_K, 2 * ML_QK), CONV_K ** -0.5),
        "ml_i_bias": nrm(ks[13], (L, 2, ML_HEADS), 0.01),
        "ml_f_bias": jnp.linspace(ML_F_BIAS_LO, ML_F_BIAS_HI, ML_HEADS, dtype=F32)[None, None, :] + nrm(ks[14], (L, 2, ML_HEADS), 0.01),
        "ml_norm_g": 1.0 + nrm(ks[15], (L, BRANCH_W), 0.01),
        "ret_decay_logit": jnp.log(gamma / (1.0 - gamma))[None, None, :] + nrm(ks[16], (L, 2, RET_HEADS), 0.01),
        "ret_norm_g": 1.0 + nrm(ks[17], (L, BRANCH_W), 0.01),
        "w_branch": nrm(ks[18], (L, N_BRANCH, BRANCH_W, D), BRANCH_W ** -0.5),
        "w_o": nrm(ks[19], (L, D, D), D ** -0.5),
        "w_up": nrm(ks[20], (L, D, D_FF), D ** -0.5),
        "w_down": nrm(ks[21], (L, D_FF, D), D_FF ** -0.5),
        "final_g": 1.0 + nrm(ks[22], (D,), 0.01),
    }


def reference(x, c, ctx, c_ctx, norm1_g, norm2_g, w_ada, b_ada, w_in, gla_a2, gla_a_bias, gla_norm_g,
              ml_conv, ml_i_bias, ml_f_bias, ml_norm_g, ret_decay_logit, ret_norm_g, w_branch, w_o,
              w_up, w_down, final_g):
    n = x.shape[1]
    rows = n // GRID_W
    row = jnp.repeat(jnp.arange(rows, dtype=F32), GRID_W)
    col = jnp.tile(jnp.arange(GRID_W, dtype=F32), rows)
    s_l = jax.nn.silu(c)
    s_c = jax.nn.silu(c_ctx)
    for l in range(DEPTH):
        need_ctx = l < DEPTH - 1
        mod_l = (s_l @ w_ada[l] + b_ada[l]).reshape(-1, 6, D_MODEL)[:, :, None, :]
        mod_c = (s_c @ w_ada[l] + b_ada[l]).reshape(6, D_MODEL)[:, None, None, :]
        h_l = modulate(rms_norm(x, norm1_g[l]), mod_l[:, 0], mod_l[:, 1])
        h_c = modulate(rms_norm(ctx, norm1_g[l]), mod_c[0], mod_c[1])
        o_l, o_c = mixer_layer(h_l, h_c, row, col, w_in[l], gla_a2[l], gla_a_bias[l], gla_norm_g[l],
                               ml_conv[l], ml_i_bias[l], ml_f_bias[l], ml_norm_g[l], ret_decay_logit[l],
                               ret_norm_g[l], w_branch[l], w_o[l], need_ctx)
        x = x + mod_l[:, 2] * o_l
        h2 = modulate(rms_norm(x, norm2_g[l]), mod_l[:, 3], mod_l[:, 4])
        x = x + mod_l[:, 5] * squared_relu_mlp(h2, w_up[l], w_down[l])
        if need_ctx:
            ctx = ctx + mod_c[2] * o_c
            h2c = modulate(rms_norm(ctx, norm2_g[l]), mod_c[3], mod_c[4])
            ctx = ctx + mod_c[5] * squared_relu_mlp(h2c, w_up[l], w_down[l])
    return rms_norm(x, final_g)
```

```cpp
#include <hip/hip_runtime.h>
#include <hip/hip_cooperative_groups.h>
#include <stdint.h>
#include <stdio.h>
namespace cg = cooperative_groups;

#define LAS __attribute__((address_space(3)))
typedef unsigned short bf16_t;
typedef short bf16x8 __attribute__((ext_vector_type(8)));
typedef float f32x4 __attribute__((ext_vector_type(4)));
typedef unsigned u32x4 __attribute__((ext_vector_type(4)));
typedef unsigned u32x2 __attribute__((ext_vector_type(2)));

constexpr int D = 1024, NB = 2, SEQ = 8192, CTX = 256, RB = SEQ + CTX, R = NB * RB, RL = NB * SEQ, NCH = RB / 64, FF = 4096;
constexpr int INW = 8240;
constexpr int NTHR = 256;
constexpr int HALF_LDS = 73728;
constexpr int LDS_BYTES = 2 * HALF_LDS + 16;

constexpr size_t WS_WTIN = 0;
constexpr size_t WS_WTBR = WS_WTIN + (size_t)8448 * 1024 * 2;
constexpr size_t WS_WTO = WS_WTBR + (size_t)3 * 1024 * 512 * 2;
constexpr size_t WS_WTUP = WS_WTO + (size_t)1024 * 1024 * 2;
constexpr size_t WS_WTDN = WS_WTUP + (size_t)4096 * 1024 * 2;
constexpr size_t WS_HBUF = WS_WTDN + (size_t)4096 * 1024 * 2;
constexpr size_t WS_PBUF = WS_HBUF + (size_t)R * 1024 * 2;
constexpr size_t WS_SBUF = WS_PBUF + (size_t)R * 2048 * 2;
constexpr size_t WS_BR = WS_SBUF + (size_t)R * 2048 * 2;
constexpr size_t WS_CTXX = WS_BR + (size_t)R * 1536 * 2;
constexpr size_t WS_SMALL = WS_CTXX + (size_t)512 * 1024 * 4;
constexpr size_t WS_DEC = WS_SMALL + (size_t)R * 48 * 4;
constexpr size_t WS_UN = WS_DEC + (size_t)16 * NCH * 128 * 4;
constexpr size_t WS_MODS = WS_UN + (size_t)16 * NCH * 128 * 4;
constexpr size_t WS_ROPE = WS_MODS + (size_t)2 * 3 * 6144 * 4;
constexpr size_t WS_BAR = WS_ROPE + (size_t)(128 + 64) * 16 * 2 * 4;
constexpr size_t WS_END = WS_BAR + (size_t)3456 * 4;
constexpr size_t WS_GS = WS_PBUF;
constexpr size_t WS_MB = WS_PBUF + (size_t)R * 3072 * 2;
constexpr size_t WS_HID = WS_PBUF;

struct Params { const float* in[23]; float* out; unsigned char* ws; int lo, hi, coop, pad; };

__device__ __forceinline__ int tid_l() { int t = threadIdx.x & 255; asm volatile("" : "+v"(t)); return t; }
__device__ __forceinline__ int bid_l() { int t = blockIdx.x * 2 + (__builtin_amdgcn_readfirstlane(threadIdx.x >> 8)); asm volatile("" : "+s"(t)); return t; }
__device__ __forceinline__ int vgrid() { return gridDim.x * 2; }
__device__ __forceinline__ unsigned char* ws_l(const Params& P) { unsigned char* w = P.ws; asm volatile("" : "+s"(w)); return w; }
enum { I_X = 0, I_C, I_CTX, I_CCTX, I_N1G, I_N2G, I_WADA, I_BADA, I_WIN, I_A2, I_ABIAS, I_GNG, I_CONV, I_IB, I_FB, I_MNG, I_RDL, I_RNG, I_WBR, I_WO, I_WUP, I_WDN, I_FG };

typedef __bf16 bf16x2_t __attribute__((ext_vector_type(2)));
typedef float f32x2 __attribute__((ext_vector_type(2)));
__device__ __forceinline__ unsigned cvt_pk(float lo, float hi) { f32x2 v = {lo, hi}; bf16x2_t b = __builtin_convertvector(v, bf16x2_t); return __builtin_bit_cast(unsigned, b); }
__device__ __forceinline__ float bflo(unsigned u) { return __uint_as_float(u << 16); }
__device__ __forceinline__ float bfhi(unsigned u) { return __uint_as_float(u & 0xffff0000u); }
__device__ __forceinline__ float wave_sum(float v) {
#pragma unroll
    for (int o = 32; o > 0; o >>= 1) v += __shfl_xor(v, o);
    return v;
}
__device__ __forceinline__ float logsig(float x) { return fminf(x, 0.f) - log1pf(__expf(-fabsf(x))); }
__device__ __forceinline__ float siluf(float x) { return x * __builtin_amdgcn_rcpf(1.f + __expf(-x)); }
__device__ __forceinline__ float sigmf(float x) { return __builtin_amdgcn_rcpf(1.f + __expf(-x)); }

struct XPtr { float* lat; float* ctx; };
__device__ __forceinline__ float* xrow(const XPtr& X, int r) { return r < RL ? X.lat + (size_t)r * D : X.ctx + (size_t)(r - RL) * D; }
__device__ __forceinline__ int modidx(int r) { return r < SEQ ? 0 : (r < RL ? 1 : 2); }
__device__ __forceinline__ int rowbase(int b, int c) { return c < 4 ? RL + b * CTX + c * 64 : b * SEQ + (c - 4) * 64; }

#define UNPACK8(u, f) do { f[0] = bflo(u.x); f[1] = bfhi(u.x); f[2] = bflo(u.y); f[3] = bfhi(u.y); f[4] = bflo(u.z); f[5] = bfhi(u.z); f[6] = bflo(u.w); f[7] = bfhi(u.w); } while (0)

__device__ __forceinline__ void mods_task(const Params& P, int task, char* lds) {
    float* s = (float*)lds;
    float* red = (float*)(lds + 12288);
    const int tid = tid_l();
    const int l = task / 192, col0 = (task % 192) * 32;
    const float* c = P.in[I_C]; const float* cc = P.in[I_CCTX];
    for (int i = tid; i < 3072; i += NTHR) { const int v = i >> 10, k = i & 1023; const float cv = v < 2 ? c[v * 1024 + k] : cc[k]; s[i] = siluf(cv); }
    __syncthreads();
    const int col = tid & 31, kg = tid >> 5;
    const float* w = P.in[I_WADA] + (size_t)l * D * 6144 + col0 + col;
    float a0 = 0.f, a1 = 0.f, a2 = 0.f;
#pragma unroll 32
    for (int k = kg * 128; k < kg * 128 + 128; ++k) { const float wv = w[(size_t)k * 6144]; a0 += s[k] * wv; a1 += s[1024 + k] * wv; a2 += s[2048 + k] * wv; }
    red[(kg * 32 + col) * 3 + 0] = a0; red[(kg * 32 + col) * 3 + 1] = a1; red[(kg * 32 + col) * 3 + 2] = a2;
    __syncthreads();
    if (tid < 96) {
        const int v = tid >> 5, c2 = tid & 31; float sum = 0.f;
#pragma unroll
        for (int g = 0; g < 8; ++g) sum += red[(g * 32 + c2) * 3 + v];
        sum += P.in[I_BADA][l * 6144 + col0 + c2];
        ((float*)(ws_l(P) + WS_MODS))[(l * 3 + v) * 6144 + col0 + c2] = sum;
    }
    __syncthreads();
}

__device__ __forceinline__ void rope_task(const Params& P) {
    float* tab = (float*)(ws_l(P) + WS_ROPE);
    for (int i = tid_l(); i < 192 * 16; i += NTHR) {
        const int pos = i >> 4, f = i & 15;
        const float inv = exp2f(-(float)f * (13.287712379549449f / 16.f));
        const float p = pos < 128 ? (float)pos : (float)(pos - 128);
        const float ang = p * inv;
        const float cs = cosf(ang), sn = sinf(ang);
        if (pos < 128) { tab[pos * 16 + f] = cs; tab[2048 + pos * 16 + f] = sn; }
        else { tab[4096 + (pos - 128) * 16 + f] = cs; tab[4096 + 1024 + (pos - 128) * 16 + f] = sn; }
    }
}

__device__ __forceinline__ void transpose_tile(const float* src, int ldsrc, int k0, int n0src, int nvalid, bf16_t* dst, int ldd, int drow0, char* lds) {
    float* tile = (float*)lds;
    const int tid = tid_l(), nl = tid & 63, kq = tid >> 6;
    float v[32];
#pragma unroll
    for (int i = 0; i < 32; ++i) v[i] = nl < nvalid ? src[(size_t)(k0 + kq + 4 * i) * ldsrc + n0src + nl] : 0.f;
#pragma unroll
    for (int i = 0; i < 32; ++i) tile[(kq + 4 * i) * 65 + nl] = v[i];
    __syncthreads();
    const int n = tid >> 2, ks = (tid & 3) * 32;
    if (n < nvalid) {
        u32x4* dp = (u32x4*)(dst + (size_t)(drow0 + n) * ldd + k0 + ks);
#pragma unroll
        for (int q = 0; q < 4; ++q) {
            u32x4 o;
            o.x = cvt_pk(tile[(ks + 8 * q + 0) * 65 + n], tile[(ks + 8 * q + 1) * 65 + n]); o.y = cvt_pk(tile[(ks + 8 * q + 2) * 65 + n], tile[(ks + 8 * q + 3) * 65 + n]);
            o.z = cvt_pk(tile[(ks + 8 * q + 4) * 65 + n], tile[(ks + 8 * q + 5) * 65 + n]); o.w = cvt_pk(tile[(ks + 8 * q + 6) * 65 + n], tile[(ks + 8 * q + 7) * 65 + n]);
            dp[q] = o;
        }
    }
    __syncthreads();
}

constexpr int CONV_TILES = 192 + 8 + 8 + 256 + 192 + 384 + 192 + 128 + 512 + 512;
__device__ __forceinline__ void convert_tile(const Params& P, int l, int it, char* lds) {
    const float* win = P.in[I_WIN] + (size_t)l * D * INW;
    bf16_t* wtin = (bf16_t*)(ws_l(P) + WS_WTIN);
    int r = it;
    if (r < 192) { const int kt = r / 24, nt = r % 24; transpose_tile(win, INW, kt * 128, nt * 64, 64, wtin, 1024, nt * 64, lds); return; } r -= 192;
    if (r < 8) { transpose_tile(win, INW, r * 128, 1536, 32, wtin, 1024, 1536, lds); return; } r -= 8;
    if (r < 8) { transpose_tile(win, INW, r * 128, 3616, 16, wtin, 1024, 1568, lds); return; } r -= 8;
    if (r < 256) { const int kt = r / 32, nt = r % 32; transpose_tile(win, INW, kt * 128, 1568 + nt * 64, 64, wtin, 1024, 1792 + nt * 64, lds); return; } r -= 256;
    if (r < 192) { const int kt = r / 24, nt = r % 24; transpose_tile(win, INW, kt * 128, 3632 + nt * 64, 64, wtin, 1024, 3840 + nt * 64, lds); return; } r -= 192;
    if (r < 384) { const int kt = r / 48, nt = r % 48; transpose_tile(win, INW, kt * 128, 5168 + nt * 64, 64, wtin, 1024, 5376 + nt * 64, lds); return; } r -= 384;
    if (r < 192) { const int j = r / 64, q = r % 64, kt = q / 16, nt = q % 16;
        transpose_tile(P.in[I_WBR] + ((size_t)l * 3 + j) * 512 * 1024, 1024, kt * 128, nt * 64, 64, (bf16_t*)(ws_l(P) + WS_WTBR), 512, j * 1024 + nt * 64, lds); return; } r -= 192;
    if (r < 128) { const int kt = r / 16, nt = r % 16; transpose_tile(P.in[I_WO] + (size_t)l * D * D, 1024, kt * 128, nt * 64, 64, (bf16_t*)(ws_l(P) + WS_WTO), 1024, nt * 64, lds); return; } r -= 128;
    if (r < 512) { const int kt = r / 64, nt = r % 64; transpose_tile(P.in[I_WUP] + (size_t)l * D * FF, 4096, kt * 128, nt * 64, 64, (bf16_t*)(ws_l(P) + WS_WTUP), 1024, nt * 64, lds); return; } r -= 512;
    { const int kt = r / 16, nt = r % 16; transpose_tile(P.in[I_WDN] + (size_t)l * FF * D, 1024, kt * 128, nt * 64, 64, (bf16_t*)(ws_l(P) + WS_WTDN), 4096, nt * 64, lds); }
}
__device__ __forceinline__ void convert_all(const Params& P, int l, char* lds) {
    const int VG = vgrid(), slot = bid_l();
    static_assert(CONV_TILES % 2 == 0, "both halves of a workgroup must be active together");
    for (int i0 = 0; i0 < CONV_TILES; i0 += VG) { const int it = i0 + slot; if (it >= CONV_TILES) continue; convert_tile(P, l, it, lds); }
}

__device__ __forceinline__ void norm_phase(const Params& P, XPtr X, const float* g, int l, int sidx, int nrows) {
    const int lane = tid_l() & 63; const int gw = bid_l() * 4 + (tid_l() >> 6), ngw = vgrid() * 4;
    bf16_t* hb = (bf16_t*)(ws_l(P) + WS_HBUF);
    const float* mods = (const float*)(ws_l(P) + WS_MODS) + (size_t)l * 3 * 6144;
    for (int r = gw; r < nrows; r += 2 * ngw) {
        const int r1 = r + ngw; const bool has1 = r1 < nrows; const int rr1 = has1 ? r1 : r;
        const f32x4* xa = (const f32x4*)xrow(X, r); const f32x4* xb = (const f32x4*)xrow(X, rr1);
        f32x4 va[4], vb[4]; float sa_ = 0.f, sb_ = 0.f;
#pragma unroll
        for (int j = 0; j < 4; ++j) { va[j] = xa[lane + 64 * j]; vb[j] = xb[lane + 64 * j]; }
#pragma unroll
        for (int j = 0; j < 4; ++j) { sa_ += va[j].x * va[j].x + va[j].y * va[j].y + va[j].z * va[j].z + va[j].w * va[j].w; sb_ += vb[j].x * vb[j].x + vb[j].y * vb[j].y + vb[j].z * vb[j].z + vb[j].w * vb[j].w; }
        sa_ = wave_sum(sa_); sb_ = wave_sum(sb_);
        const float rsa = rsqrtf(sa_ * (1.f / 1024.f) + 1e-6f), rsb = rsqrtf(sb_ * (1.f / 1024.f) + 1e-6f);
        const float* mda = mods + modidx(r) * 6144; const float* mdb = mods + modidx(rr1) * 6144;
#pragma unroll
        for (int j = 0; j < 4; ++j) {
            const int col = (lane + 64 * j) * 4;
            const f32x4 gg = *(const f32x4*)(g + col);
            { const f32x4 sh = *(const f32x4*)(mda + sidx * 1024 + col), sc = *(const f32x4*)(mda + (sidx + 1) * 1024 + col);
              const f32x4 hh = va[j] * rsa * gg * (sc + 1.f) + sh; u32x2 o; o.x = cvt_pk(hh.x, hh.y); o.y = cvt_pk(hh.z, hh.w); *(u32x2*)(hb + (size_t)r * 1024 + col) = o; }
            if (has1) { const f32x4 sh = *(const f32x4*)(mdb + sidx * 1024 + col), sc = *(const f32x4*)(mdb + (sidx + 1) * 1024 + col);
              const f32x4 hh = vb[j] * rsb * gg * (sc + 1.f) + sh; u32x2 o; o.x = cvt_pk(hh.x, hh.y); o.y = cvt_pk(hh.z, hh.w); *(u32x2*)(hb + (size_t)r1 * 1024 + col) = o; }
        }
    }
}
__device__ __forceinline__ void final_norm_phase(const Params& P) {
    const int lane = tid_l() & 63; const int gw = bid_l() * 4 + (tid_l() >> 6), ngw = vgrid() * 4;
    const float* g = P.in[I_FG];
    for (int r = gw; r < RL; r += 2 * ngw) {
        const int r1 = r + ngw;
        f32x4* xa = (f32x4*)(P.out + (size_t)r * D); f32x4* xb = (f32x4*)(P.out + (size_t)r1 * D);
        f32x4 va[4], vb[4]; float sa_ = 0.f, sb_ = 0.f;
#pragma unroll
        for (int j = 0; j < 4; ++j) { va[j] = xa[lane + 64 * j]; vb[j] = xb[lane + 64 * j]; }
#pragma unroll
        for (int j = 0; j < 4; ++j) { sa_ += va[j].x * va[j].x + va[j].y * va[j].y + va[j].z * va[j].z + va[j].w * va[j].w; sb_ += vb[j].x * vb[j].x + vb[j].y * vb[j].y + vb[j].z * vb[j].z + vb[j].w * vb[j].w; }
        sa_ = wave_sum(sa_); sb_ = wave_sum(sb_);
        const float rsa = rsqrtf(sa_ * (1.f / 1024.f) + 1e-6f), rsb = rsqrtf(sb_ * (1.f / 1024.f) + 1e-6f);
#pragma unroll
        for (int j = 0; j < 4; ++j) { const f32x4 gg = *(const f32x4*)(g + (lane + 64 * j) * 4); xa[lane + 64 * j] = va[j] * rsa * gg; xb[lane + 64 * j] = vb[j] * rsb * gg; }
    }
}

struct EpiP {
    bf16_t* Pb; int pitch; int nmain; float* small;
    __device__ __forceinline__ void operator()(int r, int c, const f32x4& v, int) const {
        if (c < nmain) { u32x2 o; o.x = cvt_pk(v.x, v.y); o.y = cvt_pk(v.z, v.w); *(u32x2*)(Pb + (size_t)r * pitch + c) = o; }
        else { const int cc = c - nmain; if (cc < 48) *(f32x4*)(small + (size_t)r * 48 + cc) = v; }
    }
    __device__ __forceinline__ void w8(int r, int c, const f32x4& v0, const f32x4& v1, int) const {
        if (c < nmain) { u32x4 o; o.x = cvt_pk(v0.x, v0.y); o.y = cvt_pk(v0.z, v0.w); o.z = cvt_pk(v1.x, v1.y); o.w = cvt_pk(v1.z, v1.w); *(u32x4*)(Pb + (size_t)r * pitch + c) = o; }
        else { const int cc = c - nmain; if (cc < 48) { *(f32x4*)(small + (size_t)r * 48 + cc) = v0; *(f32x4*)(small + (size_t)r * 48 + cc + 4) = v1; } }
    }
};
struct EpiSig {
    bf16_t* O;
    __device__ __forceinline__ void operator()(int r, int c, const f32x4& v, int) const {
        u32x2 o; o.x = cvt_pk(sigmf(v.x), sigmf(v.y)); o.y = cvt_pk(sigmf(v.z), sigmf(v.w)); *(u32x2*)(O + (size_t)r * 3072 + c) = o;
    }
    __device__ __forceinline__ void w8(int r, int c, const f32x4& v0, const f32x4& v1, int) const {
        u32x4 o; o.x = cvt_pk(sigmf(v0.x), sigmf(v0.y)); o.y = cvt_pk(sigmf(v0.z), sigmf(v0.w)); o.z = cvt_pk(sigmf(v1.x), sigmf(v1.y)); o.w = cvt_pk(sigmf(v1.z), sigmf(v1.w));
        *(u32x4*)(O + (size_t)r * 3072 + c) = o;
    }
};
struct EpiRelu2 {
    bf16_t* O;
    __device__ __forceinline__ void operator()(int r, int c, const f32x4& v, int) const {
        const float a = fmaxf(v.x, 0.f), b = fmaxf(v.y, 0.f), cc = fmaxf(v.z, 0.f), d = fmaxf(v.w, 0.f);
        u32x2 o; o.x = cvt_pk(a * a, b * b); o.y = cvt_pk(cc * cc, d * d); *(u32x2*)(O + (size_t)r * 4096 + c) = o;
    }
    __device__ __forceinline__ void w8(int r, int c, const f32x4& v0, const f32x4& v1, int) const {
        const float a = fmaxf(v0.x, 0.f), b = fmaxf(v0.y, 0.f), cc = fmaxf(v0.z, 0.f), d = fmaxf(v0.w, 0.f), e = fmaxf(v1.x, 0.f), f = fmaxf(v1.y, 0.f), g = fmaxf(v1.z, 0.f), h = fmaxf(v1.w, 0.f);
        u32x4 o; o.x = cvt_pk(a * a, b * b); o.y = cvt_pk(cc * cc, d * d); o.z = cvt_pk(e * e, f * f); o.w = cvt_pk(g * g, h * h); *(u32x4*)(O + (size_t)r * 4096 + c) = o;
    }
};
struct EpiRes {
    XPtr Xold, Xnew; const float* mods_l; int gidx;
    __device__ __forceinline__ void operator()(int r, int c, const f32x4& v, int) const {
        const f32x4 g = *(const f32x4*)(mods_l + modidx(r) * 6144 + gidx * 1024 + c);
        const f32x4 xo = *(const f32x4*)(xrow(Xold, r) + c);
        *(f32x4*)(xrow(Xnew, r) + c) = xo + g * v;
    }
    __device__ __forceinline__ void w8(int r, int c, const f32x4& v0, const f32x4& v1, int) const {
        const float* gp = mods_l + modidx(r) * 6144 + gidx * 1024 + c; const float* xo = xrow(Xold, r) + c; float* xn = xrow(Xnew, r) + c;
        const f32x4 g0 = *(const f32x4*)gp, g1 = *(const f32x4*)(gp + 4), x0 = *(const f32x4*)xo, x1 = *(const f32x4*)(xo + 4);
        *(f32x4*)xn = x0 + g0 * v0; *(f32x4*)(xn + 4) = x1 + g1 * v1;
    }
};
struct EpiMerge {
    const bf16_t* gs; bf16_t* mb;
    __device__ __forceinline__ void operator()(int r, int c, const f32x4& v, int j) const {
        const u32x2 g = *(const u32x2*)(gs + (size_t)r * 3072 + j * 1024 + c);
        float a0 = v.x * bflo(g.x), a1 = v.y * bfhi(g.x), a2 = v.z * bflo(g.y), a3 = v.w * bfhi(g.y);
        u32x2* mp = (u32x2*)(mb + (size_t)r * 1024 + c);
        if (j > 0) { const u32x2 o = *mp; a0 += bflo(o.x); a1 += bfhi(o.x); a2 += bflo(o.y); a3 += bfhi(o.y); }
        u32x2 w; w.x = cvt_pk(a0, a1); w.y = cvt_pk(a2, a3); *mp = w;
    }
    __device__ __forceinline__ void w8(int r, int c, const f32x4& v0, const f32x4& v1, int j) const {
        const u32x4 g = *(const u32x4*)(gs + (size_t)r * 3072 + j * 1024 + c);
        float a0 = v0.x * bflo(g.x), a1 = v0.y * bfhi(g.x), a2 = v0.z * bflo(g.y), a3 = v0.w * bfhi(g.y), a4 = v1.x * bflo(g.z), a5 = v1.y * bfhi(g.z), a6 = v1.z * bflo(g.w), a7 = v1.w * bfhi(g.w);
        u32x4* mp = (u32x4*)(mb + (size_t)r * 1024 + c);
        if (j > 0) { const u32x4 o = *mp; a0 += bflo(o.x); a1 += bfhi(o.x); a2 += bflo(o.y); a3 += bfhi(o.y); a4 += bflo(o.z); a5 += bfhi(o.z); a6 += bflo(o.w); a7 += bfhi(o.w); }
        u32x4 w; w.x = cvt_pk(a0, a1); w.y = cvt_pk(a2, a3); w.z = cvt_pk(a4, a5); w.w = cvt_pk(a6, a7); *mp = w;
    }
};

namespace pg8 {
constexpr int BM = 256, BK = 64, HALF = 128, HTB = HALF * BK * 2, STAGE_BYTES = 8 * HTB, NXCD = 8, WGM = 8;
__device__ __forceinline__ int lds_byte(int r, int c) { const int st = (r >> 4) * 2 + (c >> 5), rr = r & 15, cc = c & 31, ob = rr * 64 + cc * 2; return st * 1024 + (ob ^ (((ob >> 9) & 1) << 5)); }
__device__ __forceinline__ int perm32(int rho) { const int n = rho >> 4, i = rho & 15; return 8 * (i >> 2) + 4 * n + (i & 3); }
__device__ __forceinline__ void stage_rc(int b, int& R_, int& C_) { const int st = b / 1024, sb = b % 1024, swz = sb ^ (((sb >> 9) & 1) << 5); R_ = (st >> 1) * 16 + swz / 64; C_ = (st & 1) * 32 + (swz % 64) / 2; }
struct Unit { int pm, pn, acol, brow, j; };
struct Gemm { const bf16_t* A; const bf16_t* Bt; int lda, K; };
struct StaticOrder {
    int nM, nN, nwg, G, c;
    __device__ void init(int M, int N, int G_, int c_) { nM = M / BM; nN = N / BM; nwg = nM * nN; G = G_; c = c_; }
    __device__ __forceinline__ bool tile(long L, int& pm, int& pn) const {
        if (L >= nwg) return false;
        int wgid = (int)L; { const int q = nwg / NXCD, r = nwg % NXCD, xcd = wgid % NXCD, off = wgid / NXCD; wgid = (xcd < r ? xcd * (q + 1) : r * (q + 1) + (xcd - r) * q) + off; }
        const int nig = WGM * nN, gid = wgid / nig, fm = gid * WGM, gsz = (nM - fm) < WGM ? (nM - fm) : WGM;
        pm = fm + ((wgid % nig) % gsz); pn = (wgid % nig) / gsz; return true;
    }
    __device__ __forceinline__ bool next(int i, Unit& u) const { if (!tile((long)i * G + c, u.pm, u.pn)) return false; u.acol = 0; u.brow = u.pn; u.j = 0; return true; }
};
struct MergeOrder {
    StaticOrder S;
    __device__ __forceinline__ bool next(int i, Unit& u) const { const int j = i % 3; if (!S.tile((long)(i / 3) * S.G + S.c, u.pm, u.pn)) return false; u.acol = j * 512; u.brow = j * 4 + u.pn; u.j = j; return true; }
};
template <class F> struct Epi {
    F f;
    __device__ __forceinline__ void operator()(const f32x4 (&acc)[2][2][4][2], const Unit& u, int wr, int wc, int fr, int fq) const {
#pragma unroll
        for (int ai = 0; ai < 2; ++ai)
#pragma unroll
            for (int m = 0; m < 4; ++m)
#pragma unroll
                for (int bj = 0; bj < 2; ++bj)
                    f.w8(u.pm * BM + ai * HALF + wr * 64 + m * 16 + fr, u.pn * BM + bj * HALF + wc * 32 + 8 * fq, acc[ai][bj][m][0], acc[ai][bj][m][1], u.j);
    }
};

template <class E_, class Sched>
__device__ __forceinline__ void gemm_phase(LAS unsigned char* lds, const Gemm g, const Sched& S, const E_& E) {
    int tid_ = threadIdx.x; asm volatile("" : "+v"(tid_));
    const int tid = tid_, wid = __builtin_amdgcn_readfirstlane(tid >> 6), lane = tid & 63, wr = wid >> 2, wc = wid & 3, fr = lane & 15, fq = lane >> 4;
    const int K = g.K, nt = K / BK;
    unsigned voffA[2], voffB[2];
#pragma unroll
    for (int i = 0; i < 2; ++i) { int R_, C_; stage_rc(tid * 16 + i * 8192, R_, C_); const int Rb = (R_ & ~31) + perm32(R_ & 31); voffA[i] = (unsigned)(R_ * g.lda + C_) * 2u; voffB[i] = (unsigned)(Rb * K + C_) * 2u; }
    const size_t kstep = (size_t)(BK * 2);
    const size_t hstepA = (size_t)HALF * g.lda * 2, hstepB = (size_t)HALF * K * 2;
    const unsigned ldsw = (unsigned)wid * 1024u;
    const int aoff = lds_byte(wr * 64 + fr, fq * 8), boff = lds_byte(wc * 32 + fr, fq * 8);
#define PG8_SA(b, h) (((b) * 2 + (h)) * HTB)
#define PG8_SB(b, h) ((4 + (b) * 2 + (h)) * HTB)
#define PG8_STAGE(bufoff, gbase, voff) do { _Pragma("unroll") for (int _i = 0; _i < 2; ++_i) \
        __builtin_amdgcn_global_load_lds((const unsigned*)((const char*)(gbase) + (voff)[_i]), (LAS unsigned*)(lds + (bufoff) + ldsw + _i * 8192), 16, 0, 0); } while (0)
#define PG8_LDA(dst, b, h) do { _Pragma("unroll") for (int m = 0; m < 4; ++m) _Pragma("unroll") for (int k = 0; k < 2; ++k) dst[m][k] = *(const LAS bf16x8*)(lds + PG8_SA(b, h) + aoff + m * 2048 + k * 1024); } while (0)
#define PG8_LDB(dst, b, h) do { _Pragma("unroll") for (int n = 0; n < 2; ++n) _Pragma("unroll") for (int k = 0; k < 2; ++k) dst[n][k] = *(const LAS bf16x8*)(lds + PG8_SB(b, h) + boff + n * 2048 + k * 1024); } while (0)
#define PG8_MMA(ai, bj, At, Bt) do { __builtin_amdgcn_s_setprio(1); _Pragma("unroll") for (int m = 0; m < 4; ++m) _Pragma("unroll") for (int n = 0; n < 2; ++n) _Pragma("unroll") for (int k = 0; k < 2; ++k) \
        acc[ai][bj][m][n] = __builtin_amdgcn_mfma_f32_16x16x32_bf16(Bt[n][k], At[m][k], acc[ai][bj][m][n], 0, 0, 0); __builtin_amdgcn_s_setprio(0); } while (0)
#define PG8_WAIT_V(n) asm volatile("s_waitcnt vmcnt(" #n ")" ::: "memory")
#define PG8_WAIT_L(n) asm volatile("s_waitcnt lgkmcnt(" #n ")" ::: "memory")
#define PG8_BAR __builtin_amdgcn_s_barrier()
#define PG8_SCHED __builtin_amdgcn_sched_barrier(0)
#define PG8_UA(u) ((const char*)g.A + ((size_t)(u).pm * BM * g.lda + (u).acol) * 2)
#define PG8_UB(u) ((const char*)g.Bt + (size_t)(u).brow * BM * K * 2)
    Unit cur, nxt; int ui = 0;
    if (!S.next(0, cur)) return;
    f32x4 acc[2][2][4][2];
#pragma unroll
    for (int a = 0; a < 2; ++a)
#pragma unroll
        for (int b = 0; b < 2; ++b)
#pragma unroll
            for (int m = 0; m < 4; ++m)
#pragma unroll
                for (int n = 0; n < 2; ++n) acc[a][b][m][n] = (f32x4){0.f, 0.f, 0.f, 0.f};
    bf16x8 At[4][2], B0[2][2], B1[2][2];
    const char* cA = PG8_UA(cur); const char* cB = PG8_UB(cur);
    PG8_STAGE(PG8_SB(0, 0), cB, voffB); PG8_STAGE(PG8_SB(0, 1), cB + hstepB, voffB); PG8_STAGE(PG8_SA(0, 0), cA, voffA); PG8_STAGE(PG8_SA(0, 1), cA + hstepA, voffA);
    if (wr == 1) PG8_BAR;
    PG8_WAIT_V(2); PG8_BAR;
    PG8_STAGE(PG8_SB(1, 0), cB + kstep, voffB); PG8_STAGE(PG8_SA(1, 0), cA + kstep, voffA); PG8_STAGE(PG8_SB(1, 1), cB + hstepB + kstep, voffB);
    PG8_WAIT_V(6); PG8_BAR;
    for (;;) {
        const bool has_next = S.next(ui + 1, nxt);
        const char* nA = has_next ? PG8_UA(nxt) : cA; const char* nB = has_next ? PG8_UB(nxt) : cB;
        for (int t = 0; t < nt; t += 2) {
            const bool last = (t == nt - 2);
            const char* a1 = cA + (size_t)(t + 1) * kstep;
            const char* a2 = last ? nA : cA + (size_t)(t + 2) * kstep; const char* b2 = last ? nB : cB + (size_t)(t + 2) * kstep;
            const char* a3 = a2 + kstep; const char* b3 = b2 + kstep;
            PG8_LDB(B0, 0, 0); PG8_LDB(B1, 0, 1); PG8_SCHED; PG8_LDA(At, 0, 0); PG8_STAGE(PG8_SA(1, 1), a1 + hstepA, voffA);
            PG8_WAIT_V(8); PG8_WAIT_L(0); PG8_BAR; PG8_MMA(0, 0, At, B0); PG8_MMA(0, 1, At, B1); PG8_BAR; PG8_SCHED;
            PG8_LDA(At, 0, 1); PG8_STAGE(PG8_SB(0, 0), b2, voffB); PG8_STAGE(PG8_SB(0, 1), b2 + hstepB, voffB); PG8_STAGE(PG8_SA(0, 0), a2, voffA);
            PG8_WAIT_V(8); PG8_WAIT_L(0); PG8_BAR; PG8_MMA(1, 0, At, B0); PG8_MMA(1, 1, At, B1); PG8_BAR; PG8_SCHED;
            PG8_LDB(B0, 1, 0); PG8_LDB(B1, 1, 1); PG8_SCHED; PG8_LDA(At, 1, 0); PG8_STAGE(PG8_SA(0, 1), a2 + hstepA, voffA);
            PG8_WAIT_V(8); PG8_WAIT_L(0); PG8_BAR; PG8_MMA(0, 0, At, B0); PG8_MMA(0, 1, At, B1); PG8_BAR; PG8_SCHED;
            PG8_LDA(At, 1, 1); PG8_STAGE(PG8_SB(1, 0), b3, voffB); PG8_STAGE(PG8_SB(1, 1), b3 + hstepB, voffB); PG8_STAGE(PG8_SA(1, 0), a3, voffA);
            PG8_WAIT_V(8); PG8_WAIT_L(0); PG8_BAR; PG8_MMA(1, 0, At, B0); PG8_MMA(1, 1, At, B1); PG8_BAR; PG8_SCHED;
        }
        if (wr == 0) PG8_BAR;
        E(acc, cur, wr, wc, fr, fq);
        if (!has_next) break;
#pragma unroll
        for (int a = 0; a < 2; ++a)
#pragma unroll
            for (int b = 0; b < 2; ++b)
#pragma unroll
                for (int m = 0; m < 4; ++m)
#pragma unroll
                    for (int n = 0; n < 2; ++n) acc[a][b][m][n] = (f32x4){0.f, 0.f, 0.f, 0.f};
        cur = nxt; cA = nA; cB = nB; ++ui;
        if (wr == 1) PG8_BAR;
    }
    PG8_WAIT_V(0);
    PG8_BAR;
#undef PG8_SA
#undef PG8_SB
#undef PG8_STAGE
#undef PG8_LDA
#undef PG8_LDB
#undef PG8_MMA
#undef PG8_WAIT_V
#undef PG8_WAIT_L
#undef PG8_BAR
#undef PG8_SCHED
#undef PG8_UA
#undef PG8_UB
}
}

template <class F>
__device__ __forceinline__ void big_gemm(LAS unsigned char* ldsb, const bf16_t* A, int lda, const bf16_t* Bt, int K, int N, const F& f) {
    pg8::Gemm g{A, Bt, lda, K}; pg8::StaticOrder S; S.init(RL, N, (int)gridDim.x, (int)blockIdx.x);
    pg8::Epi<F> E{f};
    pg8::gemm_phase(ldsb, g, S, E);
    __syncthreads();
}
template <int NI>
__device__ __forceinline__ void gemm_kloop(f32x4 (&acc)[4][NI], const bf16_t* Ag, int lda, const bf16_t* Bg, int ldb, int K, char* lds) {
    const int tid = tid_l(), lane = tid & 63, wid = tid >> 6, wm = wid >> 1, wn = wid & 1, lr = lane & 15, lq = lane >> 4;
    u32x4 ra[4], rb[NI];
    const int prow = tid >> 3, pkc = tid & 7;
    const bf16_t* ap = Ag + (size_t)prow * lda + pkc * 8;
    const bf16_t* bp = Bg + (size_t)prow * ldb + pkc * 8;
    const int soff = prow * 128 + ((pkc ^ (prow & 7)) << 4);
#pragma unroll
    for (int i = 0; i < 4; ++i) { ra[i] = *(const u32x4*)(ap + (size_t)(32 * i) * lda); if (i < NI) rb[i < NI ? i : 0] = *(const u32x4*)(bp + (size_t)(32 * i) * ldb); }
#pragma unroll
    for (int i = 0; i < 4; ++i) { *(u32x4*)(lds + soff + i * 4096) = ra[i]; if (i < NI) *(u32x4*)(lds + 32768 + soff + i * 4096) = rb[i < NI ? i : 0]; }
    __syncthreads();
    const int nk = K >> 6;
    for (int kt = 0; kt < nk; ++kt) {
        const int buf = kt & 1;
        if (kt + 1 < nk) {
#pragma unroll
            for (int i = 0; i < 4; ++i) { ra[i] = *(const u32x4*)(ap + (size_t)(32 * i) * lda + (kt + 1) * 64); if (i < NI) rb[i < NI ? i : 0] = *(const u32x4*)(bp + (size_t)(32 * i) * ldb + (kt + 1) * 64); }
        }
        const char* la = lds + buf * 16384; const char* lb = lds + 32768 + buf * 16384;
#pragma unroll
        for (int kk = 0; kk < 2; ++kk) {
            bf16x8 af[4], bfr[NI];
            const int chunk = kk * 4 + lq;
#pragma unroll
            for (int mi = 0; mi < 4; ++mi) { const int row = wm * 64 + mi * 16 + lr; af[mi] = *(const bf16x8*)(la + row * 128 + ((chunk ^ (row & 7)) << 4)); }
#pragma unroll
            for (int ni = 0; ni < NI; ++ni) { const int row = wn * (16 * NI) + ni * 16 + lr; bfr[ni] = *(const bf16x8*)(lb + row * 128 + ((chunk ^ (row & 7)) << 4)); }
#pragma unroll
            for (int mi = 0; mi < 4; ++mi)
#pragma unroll
                for (int ni = 0; ni < NI; ++ni) acc[mi][ni] = __builtin_amdgcn_mfma_f32_16x16x32_bf16(bfr[ni], af[mi], acc[mi][ni], 0, 0, 0);
        }
        if (kt + 1 < nk) {
            char* sa = lds + (buf ^ 1) * 16384 + soff;
#pragma unroll
            for (int i = 0; i < 4; ++i) { *(u32x4*)(sa + i * 4096) = ra[i]; if (i < NI) *(u32x4*)(sa + 32768 + i * 4096) = rb[i < NI ? i : 0]; }
        }
        __syncthreads();
    }
}

__device__ __forceinline__ void tile_of(int t, int Mt, int Nt, int& tm, int& tn) {
    const int per = 8 * Nt; const int p = t / per; const int r = t - p * per; const int pm = (Mt - 8 * p) < 8 ? (Mt - 8 * p) : 8;
    tm = 8 * p + r % pm; tn = r / pm;
}

template <int TYPE> struct MX {
    static constexpr int DK = TYPE == 1 ? 128 : 64;
    static constexpr int NOC = DK / 8;
    static constexpr int PITCH = TYPE == 1 ? 2048 : 1536;
    static constexpr int QOFF = 0;
    static constexpr int KOFF = TYPE == 1 ? 512 : 256;
    static constexpr int VOFF = TYPE == 1 ? 1024 : 512;
    static constexpr int GOFF = TYPE == 1 ? 1536 : 1024;
    static constexpr int QP = DK + 16;
};
constexpr int L_VT = 0;
constexpr int L_Q = 20480;
constexpr int L_CUM = 40960;
constexpr int L_ATT = 57344;
constexpr int L_SC = 67584;
constexpr int L_SA = 68096;

template <int TYPE>
__device__ __forceinline__ void load_qk8(const Params& P, int l, const bf16_t* pb, int b, int c, int t, int h, int oc, bool isk, float (&f)[8]) {
    typedef MX<TYPE> M;
    const int coff = (isk ? M::KOFF : M::QOFF) + h * M::DK;
    const size_t rowi = (size_t)(rowbase(b, c) + t);
    if (TYPE == 0) {
        const u32x4 u = *(const u32x4*)(pb + rowi * M::PITCH + coff + oc * 8); UNPACK8(u, f);
    } else if (TYPE == 1) {
        const bool hp = (t > 0) || (c != 0 && c != 4), hn = (t < 63) || (c != 3 && c != NCH - 1);
        const bf16_t* p0 = pb + rowi * M::PITCH + coff + oc * 8;
        u32x4 u1 = *(const u32x4*)p0, u0 = (u32x4){0u, 0u, 0u, 0u}, u2 = (u32x4){0u, 0u, 0u, 0u};
        if (hp) u0 = *(const u32x4*)(p0 - M::PITCH);
        if (hn) u2 = *(const u32x4*)(p0 + M::PITCH);
        float a[8], m[8], n[8]; UNPACK8(u0, a); UNPACK8(u1, m); UNPACK8(u2, n);
        const float* cw = P.in[I_CONV] + (size_t)l * 3 * 1024 + (isk ? 512 : 0) + h * 128 + oc * 8;
        const f32x4 w0a = *(const f32x4*)cw, w0b = *(const f32x4*)(cw + 4), w1a = *(const f32x4*)(cw + 1024), w1b = *(const f32x4*)(cw + 1028), w2a = *(const f32x4*)(cw + 2048), w2b = *(const f32x4*)(cw + 2052);
        const float w0[8] = {w0a.x, w0a.y, w0a.z, w0a.w, w0b.x, w0b.y, w0b.z, w0b.w};
        const float w1[8] = {w1a.x, w1a.y, w1a.z, w1a.w, w1b.x, w1b.y, w1b.z, w1b.w};
        const float w2[8] = {w2a.x, w2a.y, w2a.z, w2a.w, w2b.x, w2b.y, w2b.z, w2b.w};
#pragma unroll
        for (int j = 0; j < 8; ++j) f[j] = siluf(w0[j] * a[j] + w1[j] * m[j] + w2[j] * n[j]);
    } else {
        if (c < 4) { const u32x4 u = *(const u32x4*)(pb + rowi * M::PITCH + coff + oc * 8); UNPACK8(u, f); }
        else {
            const int o4 = oc & 3;
            const u32x4 ua = *(const u32x4*)(pb + rowi * M::PITCH + coff + o4 * 8), ub = *(const u32x4*)(pb + rowi * M::PITCH + coff + 32 + o4 * 8);
            float x1[8], x2[8]; UNPACK8(ua, x1); UNPACK8(ub, x2);
            const float* tab = (const float*)(ws_l(P) + WS_ROPE);
            const float* cs = o4 < 2 ? tab + (c - 4) * 16 + o4 * 8 : tab + 4096 + t * 16 + (o4 - 2) * 8;
            const float* sn = o4 < 2 ? tab + 2048 + (c - 4) * 16 + o4 * 8 : tab + 4096 + 1024 + t * 16 + (o4 - 2) * 8;
#pragma unroll
            for (int j = 0; j < 8; ++j) f[j] = oc < 4 ? x1[j] * cs[j] - x2[j] * sn[j] : x1[j] * sn[j] + x2[j] * cs[j];
        }
    }
}

template <int TYPE>
__device__ __forceinline__ void decay_setup(const Params& P, int l, int b, int c, int h, int dir, char* lds, const float* apre = nullptr) {
    const int tid = tid_l(); const int r0 = rowbase(b, c);
    float* sc = (float*)(lds + L_SC);
    const float* small = (const float*)(ws_l(P) + WS_SMALL);
    if (TYPE == 0) {
        float* cum = (float*)(lds + L_CUM); float* sa = (float*)(lds + L_SA);
        if (apre) {
#pragma unroll
            for (int k = 0; k < 4; ++k) sa[tid + k * NTHR] = apre[k];
        } else {
            for (int i = tid; i < 1024; i += NTHR) sa[i] = small[(size_t)(r0 + (i >> 4)) * 48 + dir * 16 + (i & 15)];
        }
        __syncthreads();
        const int d = tid & 63, tq = tid >> 6;
        const float* a2 = P.in[I_A2] + ((size_t)(l * 2 + dir) * 16) * 256 + h * 64 + d;
        float w[16];
#pragma unroll
        for (int rr = 0; rr < 16; ++rr) w[rr] = a2[rr * 256];
        const float bias = P.in[I_ABIAS][(l * 2 + dir) * 256 + h * 64 + d];
        float* blk = sa;
        float lv[16];
#pragma unroll
        for (int i = 0; i < 16; ++i) {
            const int t = tq * 16 + i;
            float z = bias;
#pragma unroll
            for (int rr = 0; rr < 16; ++rr) z += sa[t * 16 + rr] * w[rr];
            lv[i] = logsig(z) * (1.f / 16.f);
        }
        if (dir == 0) {
#pragma unroll
            for (int i = 1; i < 16; ++i) lv[i] += lv[i - 1];
        } else {
#pragma unroll
            for (int i = 14; i >= 0; --i) lv[i] += lv[i + 1];
        }
        __syncthreads();
        blk[tq * 64 + d] = dir == 0 ? lv[15] : lv[0];
        __syncthreads();
        float off = 0.f;
#pragma unroll
        for (int q = 0; q < 4; ++q) if (dir == 0 ? (q < tq) : (q > tq)) off += blk[q * 64 + d];
#pragma unroll
        for (int i = 0; i < 16; ++i) cum[(tq * 16 + i) * 64 + d] = lv[i] + off;
    } else if (TYPE == 1) {
        if (tid < 64) {
            const float fg = small[(size_t)(r0 + tid) * 48 + 40 + dir * 4 + h] + P.in[I_FB][l * 8 + dir * 4 + h];
            float v = logsig(fg);
            if (dir == 0) {
#pragma unroll
                for (int o = 1; o < 64; o <<= 1) { const float n = __shfl_up(v, o); if (tid >= o) v += n; }
            } else {
#pragma unroll
                for (int o = 1; o < 64; o <<= 1) { const float n = __shfl_down(v, o); if (tid + o < 64) v += n; }
            }
            const float tot = __shfl(v, dir == 0 ? 63 : 0);
            sc[tid] = v;
            sc[64 + tid] = small[(size_t)(r0 + tid) * 48 + 32 + dir * 4 + h] + P.in[I_IB][l * 8 + dir * 4 + h];
            if (tid == 0) sc[128] = tot;
        }
    } else {
        if (tid < 64) {
            const float lg = logsig(P.in[I_RDL][l * 8 + dir * 4 + h]);
            sc[tid] = (dir == 0 ? (float)(tid + 1) : (float)(64 - tid)) * lg;
            if (tid == 0) sc[128] = 64.f * lg;
        }
    }
    __syncthreads();
}

template <int TYPE>
__device__ __forceinline__ void build_vT(const bf16_t* pb, int b, int c, int h, char* lds) {
    typedef MX<TYPE> M;
    bf16_t* vT = (bf16_t*)(lds + L_VT);
#pragma unroll
    for (int i = 0; i < 2; ++i) {
        const int pid = tid_l() + i * NTHR, tp = pid & 31, oc = pid >> 5;
        const bf16_t* p0 = pb + (size_t)(rowbase(b, c) + 2 * tp) * M::PITCH + M::VOFF + h * 128 + oc * 8;
        const u32x4 u0 = *(const u32x4*)p0, u1 = *(const u32x4*)(p0 + M::PITCH);
        unsigned* dst = (unsigned*)(vT + (size_t)(oc * 8) * 80 + 2 * tp);
        dst[0 * 40] = (u0.x & 0xffffu) | (u1.x << 16); dst[1 * 40] = (u0.x >> 16) | (u1.x & 0xffff0000u);
        dst[2 * 40] = (u0.y & 0xffffu) | (u1.y << 16); dst[3 * 40] = (u0.y >> 16) | (u1.y & 0xffff0000u);
        dst[4 * 40] = (u0.z & 0xffffu) | (u1.z << 16); dst[5 * 40] = (u0.z >> 16) | (u1.z & 0xffff0000u);
        dst[6 * 40] = (u0.w & 0xffffu) | (u1.w << 16); dst[7 * 40] = (u0.w >> 16) | (u1.w & 0xffff0000u);
    }
}

__device__ __forceinline__ int scan_index(int dir, int c) { return dir == 0 ? c : (c < 4 ? 3 - c : 135 - c); }

template <int TYPE>
__device__ __forceinline__ void u_phase(const Params& P, int l, char* lds) {
    typedef MX<TYPE> M; constexpr int DK = M::DK;
    const int tid = tid_l(), lane = tid & 63, wid = tid >> 6, lr = lane & 15, lq = lane >> 4;
    const bf16_t* pb = (const bf16_t*)(ws_l(P) + WS_PBUF);
    bf16_t* U = (bf16_t*)(ws_l(P) + WS_SBUF); float* DEC = (float*)(ws_l(P) + WS_DEC); float* UN = (float*)(ws_l(P) + WS_UN);
    bf16_t* vT = (bf16_t*)(lds + L_VT); bf16_t* kT = (bf16_t*)(lds + L_Q);
    const float* cum = (const float*)(lds + L_CUM); const float* sc = (const float*)(lds + L_SC);
    const int NU = NB * 4 * 2 * NCH, VG = vgrid(), slot = bid_l();
    for (int u0 = 0; u0 < NU; u0 += VG) {
        int unit = u0 + slot; if (unit >= NU) unit = NU - 1;
        const int c = unit % NCH; const int rest = unit / NCH; const int dir = rest & 1, h = (rest >> 1) & 3, b = rest >> 3;
        const int chain = (b * 4 + h) * 2 + dir, n = scan_index(dir, c);
        static_assert(TYPE == 0, "the scalar-decay branches use u_phase_s");
        float k0[8], k1[8], apre[4];
        { const int tp = tid & 31, oc = tid >> 5;
          load_qk8<TYPE>(P, l, pb, b, c, 2 * tp, h, oc, true, k0);
          load_qk8<TYPE>(P, l, pb, b, c, 2 * tp + 1, h, oc, true, k1);
          const float* small = (const float*)(ws_l(P) + WS_SMALL); const int r0 = rowbase(b, c);
#pragma unroll
          for (int k = 0; k < 4; ++k) { const int i = tid + k * NTHR; apre[k] = small[(size_t)(r0 + (i >> 4)) * 48 + dir * 16 + (i & 15)]; } }
        build_vT<TYPE>(pb, b, c, h, lds);
        decay_setup<TYPE>(P, l, b, c, h, dir, lds, apre);
        const int tlast = dir == 0 ? 63 : 0;
        {
            const int pid = tid, tp = pid & 31, oc = pid >> 5;
            unsigned* dst = (unsigned*)(kT + (size_t)(oc * 8) * 80 + 2 * tp);
            if (TYPE == 0) {
#pragma unroll
                for (int j = 0; j < 8; ++j) { const int d = oc * 8 + j; const float tot = cum[tlast * 64 + d];
                    dst[j * 40] = cvt_pk(k0[j] * __expf(tot - cum[(2 * tp) * 64 + d]), k1[j] * __expf(tot - cum[(2 * tp + 1) * 64 + d])); }
            } else {
                const float tot = sc[128];
                const float w0 = TYPE == 1 ? __expf(tot - sc[2 * tp] + sc[64 + 2 * tp]) * 0.08838834764831845f : __expf(tot - sc[2 * tp]) * 0.125f;
                const float w1 = TYPE == 1 ? __expf(tot - sc[2 * tp + 1] + sc[64 + 2 * tp + 1]) * 0.08838834764831845f : __expf(tot - sc[2 * tp + 1]) * 0.125f;
#pragma unroll
                for (int j = 0; j < 8; ++j) dst[j * 40] = cvt_pk(k0[j] * w0, k1[j] * w1);
            }
        }
        __syncthreads();
        f32x4 acc[2][DK / 16];
#pragma unroll
        for (int i = 0; i < 2; ++i)
#pragma unroll
            for (int nt = 0; nt < DK / 16; ++nt) acc[i][nt] = (f32x4){0.f, 0.f, 0.f, 0.f};
#pragma unroll
        for (int kk = 0; kk < 2; ++kk) {
            bf16x8 fv[2];
#pragma unroll
            for (int i = 0; i < 2; ++i) fv[i] = *(const bf16x8*)(vT + (size_t)((2 * wid + i) * 16 + lr) * 80 + kk * 32 + lq * 8);
#pragma unroll
            for (int nt = 0; nt < DK / 16; ++nt) {
                const bf16x8 fk = *(const bf16x8*)(kT + (size_t)(nt * 16 + lr) * 80 + kk * 32 + lq * 8);
#pragma unroll
                for (int i = 0; i < 2; ++i) acc[i][nt] = __builtin_amdgcn_mfma_f32_16x16x32_bf16(fk, fv[i], acc[i][nt], 0, 0, 0);
            }
        }
        bf16_t* ub = U + (size_t)(chain * NCH + n) * 128 * DK;
#pragma unroll
        for (int i = 0; i < 2; ++i)
#pragma unroll
            for (int nt = 0; nt < DK / 16; ++nt) {
                const int e = (2 * wid + i) * 16 + lr, d = nt * 16 + lq * 4;
                u32x2 o; o.x = cvt_pk(acc[i][nt].x, acc[i][nt].y); o.y = cvt_pk(acc[i][nt].z, acc[i][nt].w);
                *(u32x2*)(ub + (size_t)e * DK + d) = o;
            }
        if (tid < DK) {
            const float tot = TYPE == 0 ? cum[tlast * 64 + (tid & 63)] : sc[128];
            DEC[(size_t)(chain * NCH + n) * 128 + tid] = __expf(tot);
            if (TYPE == 1) {
                float s = 0.f;
#pragma unroll
                for (int q = 0; q < 8; ++q) { const u32x4 u = *(const u32x4*)(kT + (size_t)tid * 80 + q * 8); float f[8]; UNPACK8(u, f);
#pragma unroll
                    for (int j = 0; j < 8; ++j) s += f[j]; }
                UN[(size_t)(chain * NCH + n) * 128 + tid] = s;
            }
        }
        __syncthreads();
    }
}

template <int TYPE>
__device__ __forceinline__ void u_phase_s(const Params& P, int l, char* lds) {
    typedef MX<TYPE> M; constexpr int DK = M::DK; constexpr int NIT = M::NOC * 32 / NTHR;
    const int tid = tid_l(), lane = tid & 63, wid = tid >> 6, lr = lane & 15, lq = lane >> 4;
    const bf16_t* pb = (const bf16_t*)(ws_l(P) + WS_PBUF);
    const float* small = (const float*)(ws_l(P) + WS_SMALL);
    bf16_t* U = (bf16_t*)(ws_l(P) + WS_SBUF); float* DEC = (float*)(ws_l(P) + WS_DEC); float* UN = (float*)(ws_l(P) + WS_UN);
    bf16_t* vT = (bf16_t*)(lds + L_VT); bf16_t* kT0 = (bf16_t*)(lds + 20480); bf16_t* kT1 = (bf16_t*)(lds + 40960);
    float* sc = (float*)(lds + L_SC);
    const int NU = NB * 4 * NCH, VG = vgrid(), slot = bid_l();
    for (int u0 = 0; u0 < NU; u0 += VG) {
        int unit = u0 + slot; if (unit >= NU) unit = NU - 1;
        const int c = unit % NCH; const int rest = unit / NCH; const int h = rest & 3, b = rest >> 2;
        const int r0 = rowbase(b, c);
        float kv[NIT][2][8];
#pragma unroll
        for (int i = 0; i < NIT; ++i) {
            const int pid = tid + i * NTHR, tp = pid & 31, oc = pid >> 5;
            load_qk8<TYPE>(P, l, pb, b, c, 2 * tp, h, oc, true, kv[i][0]);
            load_qk8<TYPE>(P, l, pb, b, c, 2 * tp + 1, h, oc, true, kv[i][1]);
        }
        if (TYPE == 1) {
            if (tid < 128) {
                const int dir = tid >> 6, t = tid & 63;
                const float fg = small[(size_t)(r0 + t) * 48 + 40 + dir * 4 + h] + P.in[I_FB][l * 8 + dir * 4 + h];
                float v = logsig(fg);
                if (dir == 0) {
#pragma unroll
                    for (int o = 1; o < 64; o <<= 1) { const float n = __shfl_up(v, o); if (t >= o) v += n; }
                } else {
#pragma unroll
                    for (int o = 1; o < 64; o <<= 1) { const float n = __shfl_down(v, o); if (t + o < 64) v += n; }
                }
                sc[dir * 64 + t] = v;
                sc[128 + dir * 64 + t] = small[(size_t)(r0 + t) * 48 + 32 + dir * 4 + h] + P.in[I_IB][l * 8 + dir * 4 + h];
            }
        } else {
            if (tid < 64) {
                const float lg0 = logsig(P.in[I_RDL][l * 8 + h]), lg1 = logsig(P.in[I_RDL][l * 8 + 4 + h]);
                sc[tid] = (float)(tid + 1) * lg0; sc[64 + tid] = (float)(64 - tid) * lg1;
            }
        }
        build_vT<TYPE>(pb, b, c, h, lds);
        __syncthreads();
        const float totf = sc[63], totb = sc[64];
        const float ks = TYPE == 1 ? 0.08838834764831845f : 0.125f;
#pragma unroll
        for (int i = 0; i < NIT; ++i) {
            const int pid = tid + i * NTHR, tp = pid & 31, oc = pid >> 5;
            const int t0 = 2 * tp, t1 = 2 * tp + 1;
            const float wf0 = __expf(totf - sc[t0] + (TYPE == 1 ? sc[128 + t0] : 0.f)) * ks, wf1 = __expf(totf - sc[t1] + (TYPE == 1 ? sc[128 + t1] : 0.f)) * ks;
            const float wb0 = __expf(totb - sc[64 + t0] + (TYPE == 1 ? sc[192 + t0] : 0.f)) * ks, wb1 = __expf(totb - sc[64 + t1] + (TYPE == 1 ? sc[192 + t1] : 0.f)) * ks;
            unsigned* d0 = (unsigned*)(kT0 + (size_t)(oc * 8) * 80 + 2 * tp); unsigned* d1 = (unsigned*)(kT1 + (size_t)(oc * 8) * 80 + 2 * tp);
#pragma unroll
            for (int j = 0; j < 8; ++j) { d0[j * 40] = cvt_pk(kv[i][0][j] * wf0, kv[i][1][j] * wf1); d1[j * 40] = cvt_pk(kv[i][0][j] * wb0, kv[i][1][j] * wb1); }
        }
        __syncthreads();
        const int chf = (b * 4 + h) * 2;
#pragma unroll 1
        for (int dir = 0; dir < 2; ++dir) {
            const bf16_t* kT = dir == 0 ? kT0 : kT1;
            const int n = scan_index(dir, c);
            f32x4 acc[2][DK / 16];
#pragma unroll
            for (int i = 0; i < 2; ++i)
#pragma unroll
                for (int nt = 0; nt < DK / 16; ++nt) acc[i][nt] = (f32x4){0.f, 0.f, 0.f, 0.f};
#pragma unroll
            for (int kk = 0; kk < 2; ++kk) {
                bf16x8 fv[2];
#pragma unroll
                for (int i = 0; i < 2; ++i) fv[i] = *(const bf16x8*)(vT + (size_t)((2 * wid + i) * 16 + lr) * 80 + kk * 32 + lq * 8);
#pragma unroll
                for (int nt = 0; nt < DK / 16; ++nt) {
                    const bf16x8 fk = *(const bf16x8*)(kT + (size_t)(nt * 16 + lr) * 80 + kk * 32 + lq * 8);
#pragma unroll
                    for (int i = 0; i < 2; ++i) acc[i][nt] = __builtin_amdgcn_mfma_f32_16x16x32_bf16(fk, fv[i], acc[i][nt], 0, 0, 0);
                }
            }
            bf16_t* ub = U + (size_t)((chf + dir) * NCH + n) * 128 * DK;
#pragma unroll
            for (int i = 0; i < 2; ++i)
#pragma unroll
                for (int nt = 0; nt < DK / 16; ++nt) {
                    const int e = (2 * wid + i) * 16 + lr, d = nt * 16 + lq * 4;
                    u32x2 o; o.x = cvt_pk(acc[i][nt].x, acc[i][nt].y); o.y = cvt_pk(acc[i][nt].z, acc[i][nt].w);
                    *(u32x2*)(ub + (size_t)e * DK + d) = o;
                }
        }
        if (tid < 2 * DK) {
            const int dir = tid / DK, d = tid % DK; const int n = scan_index(dir, c);
            DEC[(size_t)((chf + dir) * NCH + n) * 128 + d] = __expf(dir == 0 ? totf : totb);
            if (TYPE == 1) {
                const bf16_t* kT = dir == 0 ? kT0 : kT1;
                float sum = 0.f;
#pragma unroll
                for (int q = 0; q < 8; ++q) { const u32x4 u = *(const u32x4*)(kT + (size_t)d * 80 + q * 8); float f[8]; UNPACK8(u, f);
#pragma unroll
                    for (int j = 0; j < 8; ++j) sum += f[j]; }
                UN[(size_t)((chf + dir) * NCH + n) * 128 + d] = sum;
            }
        }
        __syncthreads();
    }
}

template <int DK, bool HASN>
__device__ __forceinline__ void scan_phase(const Params& P) {
    bf16_t* U = (bf16_t*)(ws_l(P) + WS_SBUF); const float* DEC = (const float*)(ws_l(P) + WS_DEC); float* UN = (float*)(ws_l(P) + WS_UN);
    constexpr int DQ = DK / 2; constexpr int TT = 16 * 128 * DQ;
    constexpr size_t US = (size_t)128 * DK;
    for (int g = bid_l() * NTHR + tid_l(); g < TT; g += vgrid() * NTHR) {
        const int dq = g % DQ, e = (g / DQ) % 128, chain = g / (DQ * 128);
        bf16_t* up = U + ((size_t)chain * NCH * 128 + e) * DK + dq * 2;
        const float* dp = DEC + (size_t)chain * NCH * 128 + dq * 2;
        float S0 = 0.f, S1 = 0.f;
        constexpr int SB = 12;
        unsigned ua[SB], ubv[SB]; f32x2 da[SB], db[SB];
#define SC_LOAD(uu, dd, n0) do { _Pragma("unroll") for (int j = 0; j < SB; ++j) { uu[j] = *(const unsigned*)(up + (size_t)((n0) + j) * US); dd[j] = *(const f32x2*)(dp + (size_t)((n0) + j) * 128); } } while (0)
#define SC_STEP(uu, dd, n0) do { _Pragma("unroll") for (int j = 0; j < SB; ++j) { *(unsigned*)(up + (size_t)((n0) + j) * US) = cvt_pk(S0, S1); \
            S0 = dd[j].x * S0 + bflo(uu[j]); S1 = dd[j].y * S1 + bfhi(uu[j]); } } while (0)
        SC_LOAD(ua, da, 0);
        for (int n0 = 0; n0 < 120; n0 += 24) {
            SC_LOAD(ubv, db, n0 + 12);
            SC_STEP(ua, da, n0);
            SC_LOAD(ua, da, n0 + 24);
            SC_STEP(ubv, db, n0 + 12);
        }
        SC_STEP(ua, da, 120);
#undef SC_LOAD
#undef SC_STEP
    }
    if (HASN) {
        for (int g = bid_l() * NTHR + tid_l(); g < 16 * 128; g += vgrid() * NTHR) {
            const int d = g & 127, chain = g >> 7;
            float* np = UN + (size_t)chain * NCH * 128 + d; const float* dp = DEC + (size_t)chain * NCH * 128 + d;
            float S = 0.f;
            float ua_[12], da_[12], ub_[12], db_[12];
#define NS_LOAD(uu, dd, n0) do { _Pragma("unroll") for (int j = 0; j < 12; ++j) { uu[j] = np[(size_t)((n0) + j) * 128]; dd[j] = dp[(size_t)((n0) + j) * 128]; } } while (0)
#define NS_STEP(uu, dd, n0) do { _Pragma("unroll") for (int j = 0; j < 12; ++j) { np[(size_t)((n0) + j) * 128] = S; S = dd[j] * S + uu[j]; } } while (0)
            NS_LOAD(ua_, da_, 0);
            for (int n0 = 0; n0 < 120; n0 += 24) {
                NS_LOAD(ub_, db_, n0 + 12);
                NS_STEP(ua_, da_, n0);
                NS_LOAD(ua_, da_, n0 + 24);
                NS_STEP(ub_, db_, n0 + 12);
            }
            NS_STEP(ua_, da_, 120);
#undef NS_LOAD
#undef NS_STEP
        }
    }
}

template <int TYPE>
__device__ __forceinline__ void out_phase(const Params& P, int l, int pass, bool latent_only, char* lds) {
    typedef MX<TYPE> M; constexpr int DK = M::DK; constexpr int QP = M::QP;
    const int tid = tid_l(), lane = tid & 63, wid = tid >> 6, lr = lane & 15, lq = lane >> 4;
    const bf16_t* pb = (const bf16_t*)(ws_l(P) + WS_PBUF);
    const bf16_t* U = (const bf16_t*)(ws_l(P) + WS_SBUF); const float* UN = (const float*)(ws_l(P) + WS_UN);
    bf16_t* brp = (bf16_t*)(ws_l(P) + WS_BR);
    bf16_t* vT = (bf16_t*)(lds + L_VT); bf16_t* qin = (bf16_t*)(lds + L_Q); bf16_t* kin = qin + 64 * QP; bf16_t* att = (bf16_t*)(lds + L_ATT);
    const float* cum = (const float*)(lds + L_CUM); const float* sc = (const float*)(lds + L_SC);
    const float* ng = P.in[TYPE == 0 ? I_GNG : (TYPE == 1 ? I_MNG : I_RNG)] + l * 512;
    const int NC = latent_only ? NCH - 4 : NCH; const int NU = NB * 4 * NC, VG = vgrid(), slot = bid_l();
    for (int u0 = 0; u0 < NU; u0 += VG) {
        int unit = u0 + slot; if (unit >= NU) unit = NU - 1;
        const int c = unit % NC + (latent_only ? 4 : 0); const int rest = unit / NC; const int h = rest & 3, b = rest >> 2;
        const int r0 = rowbase(b, c);
        build_vT<TYPE>(pb, b, c, h, lds);
        f32x4 tot[8];
#pragma unroll
        for (int et = 0; et < 8; ++et) tot[et] = (f32x4){0.f, 0.f, 0.f, 0.f};
        const int trow = wid * 16 + lr;
        for (int dir = 0; dir < 2; ++dir) {
            const int chain = (b * 4 + h) * 2 + dir, n = scan_index(dir, c);
            decay_setup<TYPE>(P, l, b, c, h, dir, lds);
#pragma unroll 2
            for (int i = 0; i < 64 * M::NOC / NTHR; ++i) {
                const int pid = tid + i * NTHR, t = pid / M::NOC, oc = pid % M::NOC;
                float q8[8], k8[8];
                load_qk8<TYPE>(P, l, pb, b, c, t, h, oc, false, q8);
                load_qk8<TYPE>(P, l, pb, b, c, t, h, oc, true, k8);
                if (TYPE == 0) {
#pragma unroll
                    for (int j = 0; j < 8; ++j) { const float cv = cum[t * 64 + oc * 8 + j]; q8[j] *= __expf(cv) * 0.125f; k8[j] *= __expf(-cv); }
                } else {
                    const float cv = sc[t];
                    const float wq = __expf(cv);
                    const float wk = TYPE == 1 ? __expf(sc[64 + t] - cv) * 0.08838834764831845f : __expf(-cv) * 0.125f;
#pragma unroll
                    for (int j = 0; j < 8; ++j) { q8[j] *= wq; k8[j] *= wk; }
                }
                u32x4 oq, ok;
                oq.x = cvt_pk(q8[0], q8[1]); oq.y = cvt_pk(q8[2], q8[3]); oq.z = cvt_pk(q8[4], q8[5]); oq.w = cvt_pk(q8[6], q8[7]);
                ok.x = cvt_pk(k8[0], k8[1]); ok.y = cvt_pk(k8[2], k8[3]); ok.z = cvt_pk(k8[4], k8[5]); ok.w = cvt_pk(k8[6], k8[7]);
                *(u32x4*)(qin + (size_t)t * QP + oc * 8) = oq;
                *(u32x4*)(kin + (size_t)t * QP + oc * 8) = ok;
            }
            __syncthreads();
            f32x4 sacc[4];
#pragma unroll
            for (int nt = 0; nt < 4; ++nt) sacc[nt] = (f32x4){0.f, 0.f, 0.f, 0.f};
#pragma unroll
            for (int kk = 0; kk < DK / 32; ++kk) {
                const bf16x8 fq = *(const bf16x8*)(qin + (size_t)trow * QP + kk * 32 + lq * 8);
#pragma unroll
                for (int nt = 0; nt < 4; ++nt) {
                    const bf16x8 fk = *(const bf16x8*)(kin + (size_t)(nt * 16 + lr) * QP + kk * 32 + lq * 8);
                    sacc[nt] = __builtin_amdgcn_mfma_f32_16x16x32_bf16(fk, fq, sacc[nt], 0, 0, 0);
                }
            }
            float den = 0.f;
#pragma unroll
            for (int nt = 0; nt < 4; ++nt) {
                const int s0 = nt * 16 + lq * 4;
                float a0 = sacc[nt].x, a1 = sacc[nt].y, a2 = sacc[nt].z, a3 = sacc[nt].w;
                if (dir == 0) { if (s0 + 0 > trow) a0 = 0.f; if (s0 + 1 > trow) a1 = 0.f; if (s0 + 2 > trow) a2 = 0.f; if (s0 + 3 > trow) a3 = 0.f; }
                else { if (s0 + 0 < trow) a0 = 0.f; if (s0 + 1 < trow) a1 = 0.f; if (s0 + 2 < trow) a2 = 0.f; if (s0 + 3 < trow) a3 = 0.f; }
                den += (a0 + a1) + (a2 + a3);
                u32x2 o; o.x = cvt_pk(a0, a1); o.y = cvt_pk(a2, a3);
                *(u32x2*)(att + (size_t)trow * 80 + s0) = o;
            }
            __syncthreads();
            f32x4 oacc[8];
#pragma unroll
            for (int et = 0; et < 8; ++et) oacc[et] = (f32x4){0.f, 0.f, 0.f, 0.f};
#pragma unroll
            for (int kk = 0; kk < 2; ++kk) {
                const bf16x8 fa = *(const bf16x8*)(att + (size_t)trow * 80 + kk * 32 + lq * 8);
#pragma unroll
                for (int et = 0; et < 8; ++et) {
                    const bf16x8 fv = *(const bf16x8*)(vT + (size_t)(et * 16 + lr) * 80 + kk * 32 + lq * 8);
                    oacc[et] = __builtin_amdgcn_mfma_f32_16x16x32_bf16(fv, fa, oacc[et], 0, 0, 0);
                }
            }
            const bf16_t* sp = U + (size_t)(chain * NCH + n) * 128 * DK;
#pragma unroll
            for (int kk = 0; kk < DK / 32; ++kk) {
                const bf16x8 fq = *(const bf16x8*)(qin + (size_t)trow * QP + kk * 32 + lq * 8);
#pragma unroll
                for (int et = 0; et < 8; ++et) {
                    const bf16x8 fs = *(const bf16x8*)(sp + (size_t)(et * 16 + lr) * DK + kk * 32 + lq * 8);
                    oacc[et] = __builtin_amdgcn_mfma_f32_16x16x32_bf16(fs, fq, oacc[et], 0, 0, 0);
                }
            }
            if (TYPE == 1) {
                const float* np = UN + (size_t)(chain * NCH + n) * 128 + lq * 32;
#pragma unroll
                for (int q = 0; q < 4; ++q) {
                    const u32x4 u = *(const u32x4*)(qin + (size_t)trow * QP + lq * 32 + q * 8); float f[8]; UNPACK8(u, f);
                    const f32x4 n0 = *(const f32x4*)(np + q * 8), n1 = *(const f32x4*)(np + q * 8 + 4);
                    den += f[0] * n0.x + f[1] * n0.y + f[2] * n0.z + f[3] * n0.w + f[4] * n1.x + f[5] * n1.y + f[6] * n1.z + f[7] * n1.w;
                }
                den += __shfl_xor(den, 16); den += __shfl_xor(den, 32);
                const float sc1 = 1.f / fmaxf(fabsf(den), 1.f);
#pragma unroll
                for (int et = 0; et < 8; ++et) tot[et] += oacc[et] * sc1;
            } else {
#pragma unroll
                for (int et = 0; et < 8; ++et) tot[et] += oacc[et];
            }
            __syncthreads();
        }
        float s1 = 0.f;
#pragma unroll
        for (int et = 0; et < 8; ++et) s1 += (tot[et].x + tot[et].y) + (tot[et].z + tot[et].w);
        s1 += __shfl_xor(s1, 16); s1 += __shfl_xor(s1, 32);
        const float mean = TYPE == 0 ? 0.f : s1 * (1.f / 128.f);
        float s2 = 0.f;
#pragma unroll
        for (int et = 0; et < 8; ++et) { tot[et] = tot[et] - mean; s2 += (tot[et].x * tot[et].x + tot[et].y * tot[et].y) + (tot[et].z * tot[et].z + tot[et].w * tot[et].w); }
        s2 += __shfl_xor(s2, 16); s2 += __shfl_xor(s2, 32);
        const float rstd = rsqrtf(s2 * (1.f / 128.f) + 1e-6f);
        const size_t rowi = (size_t)(r0 + trow);
#pragma unroll
        for (int et = 0; et < 8; ++et) {
            const int e = et * 16 + lq * 4;
            const f32x4 gg = *(const f32x4*)(ng + h * 128 + e);
            const u32x2 gu = *(const u32x2*)(pb + rowi * M::PITCH + M::GOFF + h * 128 + e);
            const float g0 = bflo(gu.x), g1 = bfhi(gu.x), g2 = bflo(gu.y), g3 = bfhi(gu.y);
            u32x2 o;
            float y0 = tot[et].x * rstd * gg.x * siluf(g0), y1 = tot[et].y * rstd * gg.y * siluf(g1), y2 = tot[et].z * rstd * gg.z * siluf(g2), y3 = tot[et].w * rstd * gg.w * siluf(g3);
            o.x = cvt_pk(y0, y1); o.y = cvt_pk(y2, y3);
            *(u32x2*)(brp + rowi * 1536 + pass * 512 + h * 128 + e) = o;
        }
        __syncthreads();
    }
}

template <int TYPE>
__device__ __forceinline__ void out_phase_s(const Params& P, int l, int pass, bool latent_only, char* lds) {
    typedef MX<TYPE> M; constexpr int DK = M::DK; constexpr int QP = M::QP; constexpr int NKK = DK / 32;
    const bf16_t* pb = (const bf16_t*)(ws_l(P) + WS_PBUF);
    const bf16_t* U = (const bf16_t*)(ws_l(P) + WS_SBUF); const float* UN = (const float*)(ws_l(P) + WS_UN);
    const float* small = (const float*)(ws_l(P) + WS_SMALL);
    bf16_t* brp = (bf16_t*)(ws_l(P) + WS_BR);
    bf16_t* vT = (bf16_t*)(lds + L_VT); bf16_t* qr = (bf16_t*)(lds + L_Q); bf16_t* kr = qr + 64 * QP; bf16_t* att = (bf16_t*)(lds + L_ATT);
    float* sc = (float*)(lds + L_SC);
    float* sn = sc + 256;
    float* rsv = sc + 512;
    float* part = sc + 640;
    const float* ng = P.in[TYPE == 1 ? I_MNG : I_RNG] + l * 512;
    const int NC = latent_only ? NCH - 4 : NCH; const int NU = NB * 4 * NC, VG = vgrid(), slot = bid_l();
    for (int u0 = 0; u0 < NU; u0 += VG) {
        int unit = u0 + slot; if (unit >= NU) unit = NU - 1;
        const int tid = tid_l(), lane = tid & 63, wid = tid >> 6, lr = lane & 15, lq = lane >> 4;
        const int c = unit % NC + (latent_only ? 4 : 0); const int rest = unit / NC; const int h = rest & 3, b = rest >> 2;
        const int r0 = rowbase(b, c);
        const int trow = wid * 16 + lr;
        const int chf = (b * 4 + h) * 2, nf = scan_index(0, c), nb = scan_index(1, c);
        const bf16_t* spf = U + (size_t)(chf * NCH + nf) * 128 * DK; const bf16_t* spb = U + (size_t)((chf + 1) * NCH + nb) * 128 * DK;
        bf16x8 fsf[2][NKK], fsb[2][NKK];
#pragma unroll
        for (int i = 0; i < 2; ++i)
#pragma unroll
            for (int kk = 0; kk < NKK; ++kk) {
                fsf[i][kk] = *(const bf16x8*)(spf + (size_t)((2 * wid + i) * 16 + lr) * DK + kk * 32 + lq * 8);
                fsb[i][kk] = *(const bf16x8*)(spb + (size_t)((2 * wid + i) * 16 + lr) * DK + kk * 32 + lq * 8);
            }
        u32x2 gu[4][2];
#pragma unroll
        for (int mt = 0; mt < 4; ++mt)
#pragma unroll
            for (int i = 0; i < 2; ++i) gu[mt][i] = *(const u32x2*)(pb + (size_t)(r0 + mt * 16 + lr) * M::PITCH + M::GOFF + h * 128 + (2 * wid + i) * 16 + lq * 4);
        if (TYPE == 1) {
            sn[tid] = UN[(size_t)((chf + (tid >> 7)) * NCH + ((tid >> 7) == 0 ? nf : nb)) * 128 + (tid & 127)];
            if (tid < 128) {
                const int dir = tid >> 6, t = tid & 63;
                const float fg = small[(size_t)(r0 + t) * 48 + 40 + dir * 4 + h] + P.in[I_FB][l * 8 + dir * 4 + h];
                float v = logsig(fg);
                if (dir == 0) {
#pragma unroll
                    for (int o = 1; o < 64; o <<= 1) { const float n = __shfl_up(v, o); if (t >= o) v += n; }
                } else {
#pragma unroll
                    for (int o = 1; o < 64; o <<= 1) { const float n = __shfl_down(v, o); if (t + o < 64) v += n; }
                }
                sc[dir * 64 + t] = v;
                sc[128 + dir * 64 + t] = small[(size_t)(r0 + t) * 48 + 32 + dir * 4 + h] + P.in[I_IB][l * 8 + dir * 4 + h];
            }
        } else {
            if (tid < 64) {
                const float lg0 = logsig(P.in[I_RDL][l * 8 + h]), lg1 = logsig(P.in[I_RDL][l * 8 + 4 + h]);
                sc[tid] = (float)(tid + 1) * lg0; sc[64 + tid] = (float)(64 - tid) * lg1;
            }
        }
        build_vT<TYPE>(pb, b, c, h, lds);
#pragma unroll
        for (int i = 0; i < 64 * M::NOC / NTHR; ++i) {
            const int pid = tid + i * NTHR, t = pid / M::NOC, oc = pid % M::NOC;
            float q8[8], k8[8];
            load_qk8<TYPE>(P, l, pb, b, c, t, h, oc, false, q8);
            load_qk8<TYPE>(P, l, pb, b, c, t, h, oc, true, k8);
            const float ks = TYPE == 1 ? 0.08838834764831845f : 0.125f;
            u32x4 oq, ok;
            oq.x = cvt_pk(q8[0], q8[1]); oq.y = cvt_pk(q8[2], q8[3]); oq.z = cvt_pk(q8[4], q8[5]); oq.w = cvt_pk(q8[6], q8[7]);
            ok.x = cvt_pk(k8[0] * ks, k8[1] * ks); ok.y = cvt_pk(k8[2] * ks, k8[3] * ks); ok.z = cvt_pk(k8[4] * ks, k8[5] * ks); ok.w = cvt_pk(k8[6] * ks, k8[7] * ks);
            *(u32x4*)(qr + (size_t)t * QP + oc * 8) = oq;
            *(u32x4*)(kr + (size_t)t * QP + oc * 8) = ok;
        }
        __syncthreads();
        f32x4 sacc[4];
#pragma unroll
        for (int nt = 0; nt < 4; ++nt) sacc[nt] = (f32x4){0.f, 0.f, 0.f, 0.f};
#pragma unroll
        for (int kk = 0; kk < NKK; ++kk) {
            const bf16x8 fq = *(const bf16x8*)(qr + (size_t)trow * QP + kk * 32 + lq * 8);
#pragma unroll
            for (int nt = 0; nt < 4; ++nt) {
                const bf16x8 fk = *(const bf16x8*)(kr + (size_t)(nt * 16 + lr) * QP + kk * 32 + lq * 8);
                sacc[nt] = __builtin_amdgcn_mfma_f32_16x16x32_bf16(fk, fq, sacc[nt], 0, 0, 0);
            }
        }
        {
            const float cft = sc[trow], cbt = sc[64 + trow];
            const float eft = __expf(cft), ebt = __expf(cbt);
            float af[4][4], ab[4][4]; float denf = 0.f, denb = 0.f;
#pragma unroll
            for (int nt = 0; nt < 4; ++nt) {
                const float av[4] = {sacc[nt].x, sacc[nt].y, sacc[nt].z, sacc[nt].w};
#pragma unroll
                for (int r = 0; r < 4; ++r) {
                    const int s_ = nt * 16 + lq * 4 + r;
                    const float argf = cft - sc[s_] + (TYPE == 1 ? sc[128 + s_] : 0.f), argb = cbt - sc[64 + s_] + (TYPE == 1 ? sc[192 + s_] : 0.f);
                    const float wf = s_ <= trow ? __expf(argf) : 0.f, wb = s_ >= trow ? __expf(argb) : 0.f;
                    af[nt][r] = av[r] * wf; ab[nt][r] = av[r] * wb; denf += af[nt][r]; denb += ab[nt][r];
                }
            }
            float scf = 1.f, scb = 1.f;
            if (TYPE == 1) {
                float qf = 0.f, qb = 0.f;
#pragma unroll
                for (int q = 0; q < 4; ++q) {
                    const u32x4 u = *(const u32x4*)(qr + (size_t)trow * QP + lq * 32 + q * 8); float f[8]; UNPACK8(u, f);
                    const float* a = sn + lq * 32 + q * 8; const float* bq = sn + 128 + lq * 32 + q * 8;
                    const f32x4 a0 = *(const f32x4*)a, a1 = *(const f32x4*)(a + 4), b0 = *(const f32x4*)bq, b1 = *(const f32x4*)(bq + 4);
                    qf += f[0] * a0.x + f[1] * a0.y + f[2] * a0.z + f[3] * a0.w + f[4] * a1.x + f[5] * a1.y + f[6] * a1.z + f[7] * a1.w;
                    qb += f[0] * b0.x + f[1] * b0.y + f[2] * b0.z + f[3] * b0.w + f[4] * b1.x + f[5] * b1.y + f[6] * b1.z + f[7] * b1.w;
                }
                denf += eft * qf; denb += ebt * qb;
                denf += __shfl_xor(denf, 16); denf += __shfl_xor(denf, 32);
                denb += __shfl_xor(denb, 16); denb += __shfl_xor(denb, 32);
                scf = 1.f / fmaxf(fabsf(denf), 1.f); scb = 1.f / fmaxf(fabsf(denb), 1.f);
            }
#pragma unroll
            for (int nt = 0; nt < 4; ++nt) {
                u32x2 o; o.x = cvt_pk(af[nt][0] * scf + ab[nt][0] * scb, af[nt][1] * scf + ab[nt][1] * scb); o.y = cvt_pk(af[nt][2] * scf + ab[nt][2] * scb, af[nt][3] * scf + ab[nt][3] * scb);
                *(u32x2*)(att + (size_t)trow * 80 + nt * 16 + lq * 4) = o;
            }
            if (lq == 0) { rsv[trow] = eft * scf; rsv[64 + trow] = ebt * scb; }
        }
        __syncthreads();
        f32x4 oacc[4][2];
#pragma unroll
        for (int mt = 0; mt < 4; ++mt)
#pragma unroll
            for (int i = 0; i < 2; ++i) oacc[mt][i] = (f32x4){0.f, 0.f, 0.f, 0.f};
#pragma unroll
        for (int kk = 0; kk < 2; ++kk) {
            bf16x8 fv[2];
#pragma unroll
            for (int i = 0; i < 2; ++i) fv[i] = *(const bf16x8*)(vT + (size_t)((2 * wid + i) * 16 + lr) * 80 + kk * 32 + lq * 8);
#pragma unroll
            for (int mt = 0; mt < 4; ++mt) {
                const bf16x8 fa = *(const bf16x8*)(att + (size_t)(mt * 16 + lr) * 80 + kk * 32 + lq * 8);
#pragma unroll
                for (int i = 0; i < 2; ++i) oacc[mt][i] = __builtin_amdgcn_mfma_f32_16x16x32_bf16(fv[i], fa, oacc[mt][i], 0, 0, 0);
            }
        }
#pragma unroll
        for (int dir = 0; dir < 2; ++dir) {
            f32x4 tmp[4][2];
#pragma unroll
            for (int mt = 0; mt < 4; ++mt)
#pragma unroll
                for (int i = 0; i < 2; ++i) tmp[mt][i] = (f32x4){0.f, 0.f, 0.f, 0.f};
#pragma unroll
            for (int kk = 0; kk < NKK; ++kk)
#pragma unroll
                for (int mt = 0; mt < 4; ++mt) {
                    const bf16x8 fq = *(const bf16x8*)(qr + (size_t)(mt * 16 + lr) * QP + kk * 32 + lq * 8);
#pragma unroll
                    for (int i = 0; i < 2; ++i) tmp[mt][i] = __builtin_amdgcn_mfma_f32_16x16x32_bf16(dir == 0 ? fsf[i][kk] : fsb[i][kk], fq, tmp[mt][i], 0, 0, 0);
                }
#pragma unroll
            for (int mt = 0; mt < 4; ++mt) {
                const float rs = rsv[dir * 64 + mt * 16 + lr];
#pragma unroll
                for (int i = 0; i < 2; ++i) oacc[mt][i] += tmp[mt][i] * rs;
            }
        }
#pragma unroll
        for (int mt = 0; mt < 4; ++mt) {
            float s1 = (oacc[mt][0].x + oacc[mt][0].y) + (oacc[mt][0].z + oacc[mt][0].w) + (oacc[mt][1].x + oacc[mt][1].y) + (oacc[mt][1].z + oacc[mt][1].w);
            float s2 = (oacc[mt][0].x * oacc[mt][0].x + oacc[mt][0].y * oacc[mt][0].y) + (oacc[mt][0].z * oacc[mt][0].z + oacc[mt][0].w * oacc[mt][0].w)
                     + (oacc[mt][1].x * oacc[mt][1].x + oacc[mt][1].y * oacc[mt][1].y) + (oacc[mt][1].z * oacc[mt][1].z + oacc[mt][1].w * oacc[mt][1].w);
            s1 += __shfl_xor(s1, 16); s1 += __shfl_xor(s1, 32); s2 += __shfl_xor(s2, 16); s2 += __shfl_xor(s2, 32);
            if (lq == 0) { part[(wid * 64 + mt * 16 + lr) * 2] = s1; part[(wid * 64 + mt * 16 + lr) * 2 + 1] = s2; }
        }
        __syncthreads();
#pragma unroll
        for (int mt = 0; mt < 4; ++mt) {
            const int t = mt * 16 + lr;
            float s1 = 0.f, s2 = 0.f;
#pragma unroll
            for (int w = 0; w < 4; ++w) { s1 += part[(w * 64 + t) * 2]; s2 += part[(w * 64 + t) * 2 + 1]; }
            const float mean = s1 * (1.f / 128.f);
            const float rstd = rsqrtf(fmaxf(s2 * (1.f / 128.f) - mean * mean, 0.f) + 1e-6f);
            const size_t rowi = (size_t)(r0 + t);
#pragma unroll
            for (int i = 0; i < 2; ++i) {
                const int e = (2 * wid + i) * 16 + lq * 4;
                const f32x4 gg = *(const f32x4*)(ng + h * 128 + e);
                const float g0 = bflo(gu[mt][i].x), g1 = bfhi(gu[mt][i].x), g2 = bflo(gu[mt][i].y), g3 = bfhi(gu[mt][i].y);
                u32x2 o;
                o.x = cvt_pk((oacc[mt][i].x - mean) * rstd * gg.x * siluf(g0), (oacc[mt][i].y - mean) * rstd * gg.y * siluf(g1));
                o.y = cvt_pk((oacc[mt][i].z - mean) * rstd * gg.z * siluf(g2), (oacc[mt][i].w - mean) * rstd * gg.w * siluf(g3));
                *(u32x2*)(brp + rowi * 1536 + pass * 512 + h * 128 + e) = o;
            }
        }
        __syncthreads();
    }
}

__device__ __forceinline__ void out_phase_g(const Params& P, int l, bool latent_only, char* lds) {
    typedef MX<0> M; constexpr int DK = 64, QP = 80;
    const bf16_t* pb = (const bf16_t*)(ws_l(P) + WS_PBUF);
    const bf16_t* U = (const bf16_t*)(ws_l(P) + WS_SBUF);
    const float* small = (const float*)(ws_l(P) + WS_SMALL);
    bf16_t* brp = (bf16_t*)(ws_l(P) + WS_BR);
    bf16_t* vT = (bf16_t*)(lds + L_VT); bf16_t* qin = (bf16_t*)(lds + L_Q); bf16_t* kin = qin + 64 * QP; bf16_t* att = (bf16_t*)(lds + L_ATT);
    float* cum = (float*)(lds + L_CUM); float* part = cum;
    const float* ng = P.in[I_GNG] + l * 512;
    const int NC = latent_only ? NCH - 4 : NCH; const int NU = NB * 4 * NC, VG = vgrid(), slot = bid_l();
    for (int u0 = 0; u0 < NU; u0 += VG) {
        int unit = u0 + slot; if (unit >= NU) unit = NU - 1;
        const int tid = tid_l(), lane = tid & 63, wid = tid >> 6, lr = lane & 15, lq = lane >> 4;
        const int c = unit % NC + (latent_only ? 4 : 0); const int rest = unit / NC; const int h = rest & 3, b = rest >> 2;
        const int r0 = rowbase(b, c);
        const int trow = wid * 16 + lr;
        const int chf = (b * 4 + h) * 2, nf = scan_index(0, c), nb = scan_index(1, c);
        const bf16_t* spf = U + (size_t)(chf * NCH + nf) * 128 * DK; const bf16_t* spb = U + (size_t)((chf + 1) * NCH + nb) * 128 * DK;
        bf16x8 fsf[2][2], fsb[2][2];
#pragma unroll
        for (int i = 0; i < 2; ++i)
#pragma unroll
            for (int kk = 0; kk < 2; ++kk) {
                fsf[i][kk] = *(const bf16x8*)(spf + (size_t)((2 * wid + i) * 16 + lr) * DK + kk * 32 + lq * 8);
                fsb[i][kk] = *(const bf16x8*)(spb + (size_t)((2 * wid + i) * 16 + lr) * DK + kk * 32 + lq * 8);
            }
        u32x2 gu[4][2];
#pragma unroll
        for (int mt = 0; mt < 4; ++mt)
#pragma unroll
            for (int i = 0; i < 2; ++i) gu[mt][i] = *(const u32x2*)(pb + (size_t)(r0 + mt * 16 + lr) * M::PITCH + M::GOFF + h * 128 + (2 * wid + i) * 16 + lq * 4);
        float qraw[2][8], kraw[2][8], apre[2][4];
#pragma unroll
        for (int i = 0; i < 2; ++i) {
            const int pid = tid + i * NTHR, t = pid >> 3, oc = pid & 7;
            load_qk8<0>(P, l, pb, b, c, t, h, oc, false, qraw[i]);
            load_qk8<0>(P, l, pb, b, c, t, h, oc, true, kraw[i]);
        }
#pragma unroll
        for (int dir = 0; dir < 2; ++dir)
#pragma unroll
            for (int k = 0; k < 4; ++k) { const int i = tid + k * NTHR; apre[dir][k] = small[(size_t)(r0 + (i >> 4)) * 48 + dir * 16 + (i & 15)]; }
        build_vT<0>(pb, b, c, h, lds);
        f32x4 oacc[4][2];
#pragma unroll
        for (int mt = 0; mt < 4; ++mt)
#pragma unroll
            for (int i = 0; i < 2; ++i) oacc[mt][i] = (f32x4){0.f, 0.f, 0.f, 0.f};
#pragma unroll
        for (int dir = 0; dir < 2; ++dir) {
            decay_setup<0>(P, l, b, c, h, dir, lds, apre[dir]);
#pragma unroll
            for (int i = 0; i < 2; ++i) {
                const int pid = tid + i * NTHR, t = pid >> 3, oc = pid & 7;
                float q8[8], k8[8];
#pragma unroll
                for (int j = 0; j < 8; ++j) { const float cv = cum[t * 64 + oc * 8 + j]; q8[j] = qraw[i][j] * (__expf(cv) * 0.125f); k8[j] = kraw[i][j] * __expf(-cv); }
                u32x4 oq, ok;
                oq.x = cvt_pk(q8[0], q8[1]); oq.y = cvt_pk(q8[2], q8[3]); oq.z = cvt_pk(q8[4], q8[5]); oq.w = cvt_pk(q8[6], q8[7]);
                ok.x = cvt_pk(k8[0], k8[1]); ok.y = cvt_pk(k8[2], k8[3]); ok.z = cvt_pk(k8[4], k8[5]); ok.w = cvt_pk(k8[6], k8[7]);
                *(u32x4*)(qin + (size_t)t * QP + oc * 8) = oq;
                *(u32x4*)(kin + (size_t)t * QP + oc * 8) = ok;
            }
            __syncthreads();
            f32x4 sacc[4];
#pragma unroll
            for (int nt = 0; nt < 4; ++nt) sacc[nt] = (f32x4){0.f, 0.f, 0.f, 0.f};
#pragma unroll
            for (int kk = 0; kk < 2; ++kk) {
                const bf16x8 fq = *(const bf16x8*)(qin + (size_t)trow * QP + kk * 32 + lq * 8);
#pragma unroll
                for (int nt = 0; nt < 4; ++nt) {
                    const bf16x8 fk = *(const bf16x8*)(kin + (size_t)(nt * 16 + lr) * QP + kk * 32 + lq * 8);
                    sacc[nt] = __builtin_amdgcn_mfma_f32_16x16x32_bf16(fk, fq, sacc[nt], 0, 0, 0);
                }
            }
#pragma unroll
            for (int nt = 0; nt < 4; ++nt) {
                const int s0 = nt * 16 + lq * 4;
                float a0 = sacc[nt].x, a1 = sacc[nt].y, a2 = sacc[nt].z, a3 = sacc[nt].w;
                if (dir == 0) { if (s0 + 0 > trow) a0 = 0.f; if (s0 + 1 > trow) a1 = 0.f; if (s0 + 2 > trow) a2 = 0.f; if (s0 + 3 > trow) a3 = 0.f; }
                else { if (s0 + 0 < trow) a0 = 0.f; if (s0 + 1 < trow) a1 = 0.f; if (s0 + 2 < trow) a2 = 0.f; if (s0 + 3 < trow) a3 = 0.f; }
                u32x2 o; o.x = cvt_pk(a0, a1); o.y = cvt_pk(a2, a3);
                *(u32x2*)(att + (size_t)trow * 80 + s0) = o;
            }
            __syncthreads();
#pragma unroll
            for (int kk = 0; kk < 2; ++kk) {
                bf16x8 fv[2];
#pragma unroll
                for (int i = 0; i < 2; ++i) fv[i] = *(const bf16x8*)(vT + (size_t)((2 * wid + i) * 16 + lr) * 80 + kk * 32 + lq * 8);
#pragma unroll
                for (int mt = 0; mt < 4; ++mt) {
                    const bf16x8 fa = *(const bf16x8*)(att + (size_t)(mt * 16 + lr) * 80 + kk * 32 + lq * 8);
                    const bf16x8 fq = *(const bf16x8*)(qin + (size_t)(mt * 16 + lr) * QP + kk * 32 + lq * 8);
#pragma unroll
                    for (int i = 0; i < 2; ++i) {
                        oacc[mt][i] = __builtin_amdgcn_mfma_f32_16x16x32_bf16(fv[i], fa, oacc[mt][i], 0, 0, 0);
                        oacc[mt][i] = __builtin_amdgcn_mfma_f32_16x16x32_bf16(dir == 0 ? fsf[i][kk] : fsb[i][kk], fq, oacc[mt][i], 0, 0, 0);
                    }
                }
            }
            __syncthreads();
        }
#pragma unroll
        for (int mt = 0; mt < 4; ++mt) {
            float s2 = (oacc[mt][0].x * oacc[mt][0].x + oacc[mt][0].y * oacc[mt][0].y) + (oacc[mt][0].z * oacc[mt][0].z + oacc[mt][0].w * oacc[mt][0].w)
                     + (oacc[mt][1].x * oacc[mt][1].x + oacc[mt][1].y * oacc[mt][1].y) + (oacc[mt][1].z * oacc[mt][1].z + oacc[mt][1].w * oacc[mt][1].w);
            s2 += __shfl_xor(s2, 16); s2 += __shfl_xor(s2, 32);
            if (lq == 0) part[wid * 64 + mt * 16 + lr] = s2;
        }
        __syncthreads();
#pragma unroll
        for (int mt = 0; mt < 4; ++mt) {
            const int t = mt * 16 + lr;
            const float s2 = (part[t] + part[64 + t]) + (part[128 + t] + part[192 + t]);
            const float rstd = rsqrtf(s2 * (1.f / 128.f) + 1e-6f);
            const size_t rowi = (size_t)(r0 + t);
#pragma unroll
            for (int i = 0; i < 2; ++i) {
                const int e = (2 * wid + i) * 16 + lq * 4;
                const f32x4 gg = *(const f32x4*)(ng + h * 128 + e);
                const float g0 = bflo(gu[mt][i].x), g1 = bfhi(gu[mt][i].x), g2 = bflo(gu[mt][i].y), g3 = bfhi(gu[mt][i].y);
                u32x2 o;
                o.x = cvt_pk(oacc[mt][i].x * rstd * gg.x * siluf(g0), oacc[mt][i].y * rstd * gg.y * siluf(g1));
                o.y = cvt_pk(oacc[mt][i].z * rstd * gg.z * siluf(g2), oacc[mt][i].w * rstd * gg.w * siluf(g3));
                *(u32x2*)(brp + rowi * 1536 + h * 128 + e) = o;
            }
        }
        __syncthreads();
    }
}

template <int NI, class F>
__device__ __forceinline__ void ctx_gemm(const bf16_t* A, int lda, const bf16_t* Bt, int ldb, int K, int N, const F& f, char* lds) {
    const int tid = tid_l(), lane = tid & 63, wid = tid >> 6, wm = wid >> 1, wn = wid & 1, lr = lane & 15, lq = lane >> 4;
    const int Nt = (N + 32 * NI - 1) / (32 * NI);
    const int total = 4 * Nt, VG = vgrid(), slot = bid_l();
    for (int t0 = 0; t0 < total; t0 += VG) {
        const int t = t0 + (VG - 1 - slot); if (t >= total) continue;
        const int tm = t & 3, tn = t >> 2;
        f32x4 acc[4][NI];
#pragma unroll
        for (int mi = 0; mi < 4; ++mi)
#pragma unroll
            for (int ni = 0; ni < NI; ++ni) acc[mi][ni] = (f32x4){0.f, 0.f, 0.f, 0.f};
        gemm_kloop<NI>(acc, A + (size_t)(RL + tm * 128) * lda, lda, Bt + (size_t)tn * (32 * NI) * ldb, ldb, K, lds);
#pragma unroll
        for (int mi = 0; mi < 4; ++mi)
#pragma unroll
            for (int ni = 0; ni < NI; ++ni) f(RL + tm * 128 + wm * 64 + mi * 16 + lr, tn * (32 * NI) + wn * (16 * NI) + ni * 16 + lq * 4, acc[mi][ni], 0);
    }
}
__device__ __forceinline__ void ctx_merge(const Params& P, char* lds) {
    const int tid = tid_l(), lane = tid & 63, wid = tid >> 6, wm = wid >> 1, wn = wid & 1, lr = lane & 15, lq = lane >> 4;
    const bf16_t* br = (const bf16_t*)(ws_l(P) + WS_BR); const bf16_t* wb = (const bf16_t*)(ws_l(P) + WS_WTBR);
    const bf16_t* gs = (const bf16_t*)(ws_l(P) + WS_GS); bf16_t* mb = (bf16_t*)(ws_l(P) + WS_MB);
    const int total = 64, VG = vgrid(), slot = bid_l();
    for (int t0 = 0; t0 < total; t0 += VG) {
        const int t = t0 + (VG - 1 - slot); if (t >= total) continue;
        const int tm = t & 3, tn = t >> 2;
        f32x4 m[4][2];
#pragma unroll
        for (int mi = 0; mi < 4; ++mi)
#pragma unroll
            for (int ni = 0; ni < 2; ++ni) m[mi][ni] = (f32x4){0.f, 0.f, 0.f, 0.f};
#pragma unroll 1
        for (int j = 0; j < 3; ++j) {
            f32x4 acc[4][2];
#pragma unroll
            for (int mi = 0; mi < 4; ++mi)
#pragma unroll
                for (int ni = 0; ni < 2; ++ni) acc[mi][ni] = (f32x4){0.f, 0.f, 0.f, 0.f};
            gemm_kloop<2>(acc, br + (size_t)(RL + tm * 128) * 1536 + j * 512, 1536, wb + ((size_t)j * 1024 + tn * 64) * 512, 512, 512, lds);
#pragma unroll
            for (int mi = 0; mi < 4; ++mi)
#pragma unroll
                for (int ni = 0; ni < 2; ++ni) {
                    const int r = RL + tm * 128 + wm * 64 + mi * 16 + lr, c = tn * 64 + wn * 32 + ni * 16 + lq * 4;
                    const u32x2 g = *(const u32x2*)(gs + (size_t)r * 3072 + j * 1024 + c);
                    m[mi][ni].x += acc[mi][ni].x * bflo(g.x); m[mi][ni].y += acc[mi][ni].y * bfhi(g.x);
                    m[mi][ni].z += acc[mi][ni].z * bflo(g.y); m[mi][ni].w += acc[mi][ni].w * bfhi(g.y);
                }
        }
#pragma unroll
        for (int mi = 0; mi < 4; ++mi)
#pragma unroll
            for (int ni = 0; ni < 2; ++ni) {
                const int r = RL + tm * 128 + wm * 64 + mi * 16 + lr, c = tn * 64 + wn * 32 + ni * 16 + lq * 4;
                u32x2 o; o.x = cvt_pk(m[mi][ni].x, m[mi][ni].y); o.y = cvt_pk(m[mi][ni].z, m[mi][ni].w);
                *(u32x2*)(mb + (size_t)r * 1024 + c) = o;
            }
    }
}


#define XB_TMO      128
#define XB_XCNT(j)  (256  + 64 * (j))
#define XB_XSUB(j)  (1280 + 64 * (j))
#define XB_XGEN(j)  (2304 + 64 * (j))
#define XB_TOP      3328
#define XB_TOPGEN   3392
#define XCD_BAR_WORDS 3456
#define XB_SPIN_CAP (1u << 18)
__device__ __forceinline__ unsigned xb_ld(unsigned* p)              { return __hip_atomic_load(p, __ATOMIC_RELAXED, __HIP_MEMORY_SCOPE_AGENT); }
__device__ __forceinline__ unsigned xb_add(unsigned* p, unsigned v) { return __hip_atomic_fetch_add(p, v, __ATOMIC_RELAXED, __HIP_MEMORY_SCOPE_AGENT); }
__device__ __forceinline__ unsigned xb_xcc_id() { return (unsigned)__builtin_amdgcn_s_getreg((3 << 11) | 20) & 0xFu; }
#define XB_SPIN(cond, bar) do { unsigned _sp = 0; while (cond) { __builtin_amdgcn_s_sleep(1); \
    if ((++_sp & 255u) == 0u) { if (xb_ld(&(bar)[XB_TMO])) break; if (_sp > XB_SPIN_CAP) { atomicAdd(&(bar)[XB_TMO], 1u); break; } } } } while (0)
struct XcdBarrier { unsigned* bar; unsigned x; volatile LAS unsigned* st; };
__device__ __forceinline__ XcdBarrier xcd_barrier_post(unsigned* bar, volatile LAS unsigned* st) {
    XcdBarrier b; b.bar = bar; b.x = xb_xcc_id(); b.st = st;
    if (threadIdx.x == 0) (void)xb_add(&bar[XB_XCNT(b.x)], 1u);
    return b;
}
__device__ __forceinline__ void xcd_barrier_complete(unsigned* bar, unsigned x, unsigned& nloc, unsigned& nx) {
    const unsigned G = gridDim.x * gridDim.y * gridDim.z;
    unsigned sum, cnt, mine, sp = 0u;
    for (;;) {
        sum = 0u; cnt = 0u; mine = 0u;
#pragma unroll
        for (unsigned j = 0; j < 16; ++j) { const unsigned c = xb_ld(&bar[XB_XCNT(j)]); sum += c; cnt += (c > 0u) ? 1u : 0u; mine = (j == x) ? c : mine; }
        if (sum == G) break;
        __builtin_amdgcn_s_sleep(1);
        if ((++sp & 255u) == 0u) { if (xb_ld(&bar[XB_TMO])) break; if (sp > XB_SPIN_CAP) { atomicAdd(&bar[XB_TMO], 1u); break; } }
    }
    nloc = mine > 0u ? mine : 1u; nx = cnt > 0u ? cnt : 1u;
}
__device__ __forceinline__ void xcd_barrier(const XcdBarrier& b) {
    asm volatile("s_waitcnt vmcnt(0)" ::: "memory");
    __syncthreads();
    if (threadIdx.x == 0) {
        unsigned* bar = b.bar;
        __builtin_amdgcn_s_waitcnt(0);
        unsigned nloc = b.st[0], nx = b.st[1];
        if (nloc == 0u) { xcd_barrier_complete(bar, b.x, nloc, nx); b.st[0] = nloc; b.st[1] = nx; }
        const unsigned old = xb_add(&bar[XB_XSUB(b.x)], 1u);
        const unsigned gen = old / nloc;
        if (old + 1u == (gen + 1u) * nloc) {
            __builtin_amdgcn_fence(__ATOMIC_RELEASE, "agent");
            asm volatile("s_waitcnt vmcnt(0)" ::: "memory");
            const unsigned og = xb_add(&bar[XB_TOP], 1u);
            const unsigned tg = og / nx;
            if (og + 1u == (tg + 1u) * nx) xb_add(&bar[XB_TOPGEN], 1u);
            else XB_SPIN(xb_ld(&bar[XB_TOPGEN]) == tg, bar);
            __builtin_amdgcn_fence(__ATOMIC_ACQUIRE, "agent");
            xb_add(&bar[XB_XGEN(b.x)], 1u);
            asm volatile("s_waitcnt vmcnt(0)" ::: "memory");
        } else {
            XB_SPIN(xb_ld(&bar[XB_XGEN(b.x)]) == gen, bar);
            __builtin_amdgcn_fence(__ATOMIC_ACQUIRE, "agent");
            asm volatile("s_waitcnt vmcnt(0)" ::: "memory");
        }
    }
    __syncthreads();
}

__global__ void __launch_bounds__(512, 2) fwd_kernel(Params P) {
    extern __shared__ __attribute__((aligned(16))) unsigned char lds_raw[];
    cg::grid_group grid = cg::this_grid();
    LAS unsigned char* ldsb = (LAS unsigned char*)lds_raw;
#define LDSH ((char*)lds_raw + __builtin_amdgcn_readfirstlane(threadIdx.x >> 8) * HALF_LDS)
    volatile LAS unsigned* bst = (volatile LAS unsigned*)(ldsb + 2 * HALF_LDS);
    if (threadIdx.x < 2) bst[threadIdx.x] = 0u;
    __syncthreads();
    XcdBarrier xbar = xcd_barrier_post((unsigned*)(P.ws + WS_BAR), bst);
    int ph = 0;
#define PHASE_BEGIN if (ph >= P.lo && ph < P.hi) {
#define PHASE_END } ++ph; if (P.coop && ph > P.lo && ph < P.hi) { if (ph == 1) grid.sync(); else xcd_barrier(xbar); }

    PHASE_BEGIN
        {
        { const int VG = vgrid(), slot = bid_l();
          for (int i0 = 0; i0 < 384; i0 += VG) { int it = i0 + slot; if (it >= 384) it = 383; mods_task(P, it, LDSH); } }
        if (bid_l() == vgrid() - 1) rope_task(P);
        convert_all(P, 0, LDSH);
        }
    PHASE_END

    const XPtr Xin{(float*)P.in[I_X], (float*)P.in[I_CTX]};
    const XPtr Xcur{P.out, (float*)(P.ws + WS_CTXX)};

    for (int l = 0; l < 2; ++l) {
        const XPtr Xold = l == 0 ? Xin : Xcur;
        const bool ctx_on = (l == 0);
        PHASE_BEGIN
            {
            if (l == 1) convert_all(P, 1, LDSH);
            norm_phase(P, Xold, P.in[I_N1G] + l * D, l, 0, R);
            }
        PHASE_END
        PHASE_BEGIN
            const bf16_t* hb = (const bf16_t*)(ws_l(P) + WS_HBUF); const bf16_t* wt = (const bf16_t*)(ws_l(P) + WS_WTIN);
            EpiP e{(bf16_t*)(ws_l(P) + WS_PBUF), 1536, 1536, (float*)(ws_l(P) + WS_SMALL)};
            {
            big_gemm(ldsb, hb, 1024, wt, 1024, 1792, e);
            ctx_gemm<4>(hb, 1024, wt, 1024, 1024, 1664, e, LDSH); }
        PHASE_END
        PHASE_BEGIN u_phase<0>(P, l, LDSH); PHASE_END
        PHASE_BEGIN scan_phase<64, false>(P); PHASE_END
        PHASE_BEGIN out_phase_g(P, l, !ctx_on, LDSH); PHASE_END
        PHASE_BEGIN
            const bf16_t* hb = (const bf16_t*)(ws_l(P) + WS_HBUF); const bf16_t* wt = (const bf16_t*)(ws_l(P) + WS_WTIN) + (size_t)1792 * 1024;
            EpiP e{(bf16_t*)(ws_l(P) + WS_PBUF), 2048, 2048, nullptr};
            {
            big_gemm(ldsb, hb, 1024, wt, 1024, 2048, e);
            ctx_gemm<2>(hb, 1024, wt, 1024, 1024, 2048, e, LDSH); }
        PHASE_END
        PHASE_BEGIN u_phase_s<1>(P, l, LDSH); PHASE_END
        PHASE_BEGIN scan_phase<128, true>(P); PHASE_END
        PHASE_BEGIN out_phase_s<1>(P, l, 1, !ctx_on, LDSH); PHASE_END
        PHASE_BEGIN
            const bf16_t* hb = (const bf16_t*)(ws_l(P) + WS_HBUF); const bf16_t* wt = (const bf16_t*)(ws_l(P) + WS_WTIN) + (size_t)3840 * 1024;
            EpiP e{(bf16_t*)(ws_l(P) + WS_PBUF), 1536, 1536, nullptr};
            {
            big_gemm(ldsb, hb, 1024, wt, 1024, 1536, e);
            ctx_gemm<4>(hb, 1024, wt, 1024, 1024, 1536, e, LDSH); }
        PHASE_END
        PHASE_BEGIN u_phase_s<2>(P, l, LDSH); PHASE_END
        PHASE_BEGIN scan_phase<64, false>(P); PHASE_END
        PHASE_BEGIN out_phase_s<2>(P, l, 2, !ctx_on, LDSH); PHASE_END
        PHASE_BEGIN
            const bf16_t* hb = (const bf16_t*)(ws_l(P) + WS_HBUF); const bf16_t* wt = (const bf16_t*)(ws_l(P) + WS_WTIN) + (size_t)5376 * 1024;
            EpiSig e{(bf16_t*)(ws_l(P) + WS_GS)};
            {
            big_gemm(ldsb, hb, 1024, wt, 1024, 3072, e);
            if (ctx_on) ctx_gemm<2>(hb, 1024, wt, 1024, 1024, 3072, e, LDSH); }
        PHASE_END
        PHASE_BEGIN
            {   pg8::Gemm g{(const bf16_t*)(ws_l(P) + WS_BR), (const bf16_t*)(ws_l(P) + WS_WTBR), 1536, 512};
                pg8::MergeOrder S; S.S.init(RL, 1024, (int)gridDim.x, (int)blockIdx.x);
                pg8::Epi<EpiMerge> E{EpiMerge{(const bf16_t*)(ws_l(P) + WS_GS), (bf16_t*)(ws_l(P) + WS_MB)}};
                pg8::gemm_phase(ldsb, g, S, E);
                __syncthreads(); }
            if (ctx_on) ctx_merge(P, LDSH);
        PHASE_END
        PHASE_BEGIN
            const float* mods_l = (const float*)(ws_l(P) + WS_MODS) + (size_t)l * 3 * 6144;
            EpiRes e{Xold, Xcur, mods_l, 2};
            big_gemm(ldsb, (const bf16_t*)(ws_l(P) + WS_MB), 1024, (const bf16_t*)(ws_l(P) + WS_WTO), 1024, 1024, e);
            if (ctx_on) ctx_gemm<1>((const bf16_t*)(ws_l(P) + WS_MB), 1024, (const bf16_t*)(ws_l(P) + WS_WTO), 1024, 1024, 1024, e, LDSH);
        PHASE_END
        PHASE_BEGIN norm_phase(P, Xcur, P.in[I_N2G] + l * D, l, 3, ctx_on ? R : RL); PHASE_END
        PHASE_BEGIN
            const bf16_t* hb = (const bf16_t*)(ws_l(P) + WS_HBUF);
            EpiRelu2 e{(bf16_t*)(ws_l(P) + WS_HID)};
            {
            big_gemm(ldsb, hb, 1024, (const bf16_t*)(ws_l(P) + WS_WTUP), 1024, 4096, e);
            if (ctx_on) ctx_gemm<2>(hb, 1024, (const bf16_t*)(ws_l(P) + WS_WTUP), 1024, 1024, 4096, e, LDSH); }
        PHASE_END
        PHASE_BEGIN
            const float* mods_l = (const float*)(ws_l(P) + WS_MODS) + (size_t)l * 3 * 6144;
            EpiRes e{Xcur, Xcur, mods_l, 5};
            big_gemm(ldsb, (const bf16_t*)(ws_l(P) + WS_HID), 4096, (const bf16_t*)(ws_l(P) + WS_WTDN), 4096, 1024, e);
            if (ctx_on) ctx_gemm<1>((const bf16_t*)(ws_l(P) + WS_HID), 4096, (const bf16_t*)(ws_l(P) + WS_WTDN), 4096, 4096, 1024, e, LDSH);
        PHASE_END
    }
    PHASE_BEGIN final_norm_phase(P); PHASE_END
#undef PHASE_BEGIN
#undef PHASE_END
}
constexpr int NPHASES = 1 + 2 * 19 + 1;

extern "C" void kernel_launch(void* const* d_in, const int* in_sizes, int n_in, void* d_out, int out_size, void* d_ws, size_t ws_size, hipStream_t stream) {
    static int grid = 0;
    if (grid == 0) {
        if (n_in != 23 || ws_size < WS_END || out_size != NB * SEQ * D) { fprintf(stderr, "kernel_launch: unexpected sizes n_in %d ws %zu (need %zu) out %d\n", n_in, ws_size, (size_t)WS_END, out_size); grid = -1; return; }
        int dev = 0, cus = 0, per_cu = 0;
        if (hipGetDevice(&dev) != hipSuccess || hipDeviceGetAttribute(&cus, hipDeviceAttributeMultiprocessorCount, dev) != hipSuccess) { grid = -1; return; }
        if (hipFuncSetAttribute((const void*)fwd_kernel, hipFuncAttributeMaxDynamicSharedMemorySize, LDS_BYTES) != hipSuccess) { fprintf(stderr, "kernel_launch: hipFuncSetAttribute failed\n"); grid = -1; return; }
        if (hipOccupancyMaxActiveBlocksPerMultiprocessor(&per_cu, (const void*)fwd_kernel, 512, LDS_BYTES) != hipSuccess || per_cu < 1) { fprintf(stderr, "kernel_launch: occupancy query failed (%d)\n", per_cu); grid = -1; return; }
        grid = cus;
        grid -= grid % 8;
    }
    if (grid < 0) return;
    if (hipMemsetAsync((char*)d_ws + WS_BAR, 0, (size_t)3456 * 4, stream) != hipSuccess) { fprintf(stderr, "kernel_launch: memset failed\n"); return; }
    Params p{};
    for (int i = 0; i < 23; ++i) p.in[i] = (const float*)d_in[i];
    p.out = (float*)d_out; p.ws = (unsigned char*)d_ws;
    p.lo = 0; p.hi = NPHASES; p.coop = 1;
    void* args[] = {&p};
    hipError_t e = hipLaunchCooperativeKernel((const void*)fwd_kernel, dim3(grid), dim3(512), args, LDS_BYTES, stream);
    if (e != hipSuccess) fprintf(stderr, "kernel_launch: cooperative launch failed: %s (grid %d)\n", hipGetErrorString(e), grid);
}
```

```cpp
#include <hip/hip_runtime.h>
#include <hip/hip_cooperative_groups.h>
#include <stdint.h>
#include <stdio.h>
namespace cg = cooperative_groups;

#define LAS __attribute__((address_space(3)))
typedef unsigned short bf16_t;
typedef short bf16x8 __attribute__((ext_vector_type(8)));
typedef float f32x4 __attribute__((ext_vector_type(4)));
typedef unsigned u32x4 __attribute__((ext_vector_type(4)));
typedef unsigned u32x2 __attribute__((ext_vector_type(2)));

constexpr int D = 1024, NB = 2, SEQ = 8192, CTX = 256, RB = SEQ + CTX, R = NB * RB, RL = NB * SEQ, NCH = RB / 64, FF = 4096;
constexpr int INW = 8240;
constexpr int NTHR = 256;
constexpr int HALF_LDS = 73728;
constexpr int LDS_BYTES = 2 * HALF_LDS + 16;

constexpr size_t WS_WTIN = 0;
constexpr size_t WS_WTBR = WS_WTIN + (size_t)8448 * 1024 * 2;
constexpr size_t WS_WTO = WS_WTBR + (size_t)3 * 1024 * 512 * 2;
constexpr size_t WS_WTUP = WS_WTO + (size_t)1024 * 1024 * 2;
constexpr size_t WS_WTDN = WS_WTUP + (size_t)4096 * 1024 * 2;
constexpr size_t WS_HBUF = WS_WTDN + (size_t)4096 * 1024 * 2;
constexpr size_t WS_PBUF = WS_HBUF + (size_t)R * 1024 * 2;
constexpr size_t WS_SBUF = WS_PBUF + (size_t)R * 2048 * 2;
constexpr size_t WS_BR = WS_SBUF + (size_t)R * 2048 * 2;
constexpr size_t WS_CTXX = WS_BR + (size_t)R * 1536 * 2;
constexpr size_t WS_SMALL = WS_CTXX + (size_t)512 * 1024 * 4;
constexpr size_t WS_DEC = WS_SMALL + (size_t)R * 48 * 4;
constexpr size_t WS_UN = WS_DEC + (size_t)16 * NCH * 128 * 4;
constexpr size_t WS_MODS = WS_UN + (size_t)16 * NCH * 128 * 4;
constexpr size_t WS_ROPE = WS_MODS + (size_t)2 * 3 * 6144 * 4;
constexpr size_t WS_BAR = WS_ROPE + (size_t)(128 + 64) * 16 * 2 * 4;
constexpr size_t WS_END = WS_BAR + (size_t)3456 * 4;
constexpr size_t WS_GS = WS_PBUF;
constexpr size_t WS_MB = WS_PBUF + (size_t)R * 3072 * 2;
constexpr size_t WS_HID = WS_PBUF;

struct Params { const float* in[23]; float* out; unsigned char* ws; int lo, hi, coop, pad; };

__device__ __forceinline__ int tid_l() { int t = threadIdx.x & 255; asm volatile("" : "+v"(t)); return t; }
__device__ __forceinline__ int bid_l() { int t = blockIdx.x * 2 + (__builtin_amdgcn_readfirstlane(threadIdx.x >> 8)); asm volatile("" : "+s"(t)); return t; }
__device__ __forceinline__ int vgrid() { return gridDim.x * 2; }
__device__ __forceinline__ unsigned char* ws_l(const Params& P) { unsigned char* w = P.ws; asm volatile("" : "+s"(w)); return w; }
enum { I_X = 0, I_C, I_CTX, I_CCTX, I_N1G, I_N2G, I_WADA, I_BADA, I_WIN, I_A2, I_ABIAS, I_GNG, I_CONV, I_IB, I_FB, I_MNG, I_RDL, I_RNG, I_WBR, I_WO, I_WUP, I_WDN, I_FG };

typedef __bf16 bf16x2_t __attribute__((ext_vector_type(2)));
typedef float f32x2 __attribute__((ext_vector_type(2)));
__device__ __forceinline__ unsigned cvt_pk(float lo, float hi) { f32x2 v = {lo, hi}; bf16x2_t b = __builtin_convertvector(v, bf16x2_t); return __builtin_bit_cast(unsigned, b); }
__device__ __forceinline__ float bflo(unsigned u) { return __uint_as_float(u << 16); }
__device__ __forceinline__ float bfhi(unsigned u) { return __uint_as_float(u & 0xffff0000u); }
__device__ __forceinline__ float wave_sum(float v) {
#pragma unroll
    for (int o = 32; o > 0; o >>= 1) v += __shfl_xor(v, o);
    return v;
}
__device__ __forceinline__ float logsig(float x) { return fminf(x, 0.f) - log1pf(__expf(-fabsf(x))); }
__device__ __forceinline__ float siluf(float x) { return x * __builtin_amdgcn_rcpf(1.f + __expf(-x)); }
__device__ __forceinline__ float sigmf(float x) { return __builtin_amdgcn_rcpf(1.f + __expf(-x)); }

struct XPtr { float* lat; float* ctx; };
__device__ __forceinline__ float* xrow(const XPtr& X, int r) { return r < RL ? X.lat + (size_t)r * D : X.ctx + (size_t)(r - RL) * D; }
__device__ __forceinline__ int modidx(int r) { return r < SEQ ? 0 : (r < RL ? 1 : 2); }
__device__ __forceinline__ int rowbase(int b, int c) { return c < 4 ? RL + b * CTX + c * 64 : b * SEQ + (c - 4) * 64; }

#define UNPACK8(u, f) do { f[0] = bflo(u.x); f[1] = bfhi(u.x); f[2] = bflo(u.y); f[3] = bfhi(u.y); f[4] = bflo(u.z); f[5] = bfhi(u.z); f[6] = bflo(u.w); f[7] = bfhi(u.w); } while (0)

__device__ __forceinline__ void mods_task(const Params& P, int task, char* lds) {
    float* s = (float*)lds;
    float* red = (float*)(lds + 12288);
    const int tid = tid_l();
    const int l = task / 192, col0 = (task % 192) * 32;
    const float* c = P.in[I_C]; const float* cc = P.in[I_CCTX];
    for (int i = tid; i < 3072; i += NTHR) { const int v = i >> 10, k = i & 1023; const float cv = v < 2 ? c[v * 1024 + k] : cc[k]; s[i] = siluf(cv); }
    __syncthreads();
    const int col = tid & 31, kg = tid >> 5;
    const float* w = P.in[I_WADA] + (size_t)l * D * 6144 + col0 + col;
    float a0 = 0.f, a1 = 0.f, a2 = 0.f;
#pragma unroll 32
    for (int k = kg * 128; k < kg * 128 + 128; ++k) { const float wv = w[(size_t)k * 6144]; a0 += s[k] * wv; a1 += s[1024 + k] * wv; a2 += s[2048 + k] * wv; }
    red[(kg * 32 + col) * 3 + 0] = a0; red[(kg * 32 + col) * 3 + 1] = a1; red[(kg * 32 + col) * 3 + 2] = a2;
    __syncthreads();
    if (tid < 96) {
        const int v = tid >> 5, c2 = tid & 31; float sum = 0.f;
#pragma unroll
        for (int g = 0; g < 8; ++g) sum += red[(g * 32 + c2) * 3 + v];
        sum += P.in[I_BADA][l * 6144 + col0 + c2];
        ((float*)(ws_l(P) + WS_MODS))[(l * 3 + v) * 6144 + col0 + c2] = sum;
    }
    __syncthreads();
}

__device__ __forceinline__ void rope_task(const Params& P) {
    float* tab = (float*)(ws_l(P) + WS_ROPE);
    for (int i = tid_l(); i < 192 * 16; i += NTHR) {
        const int pos = i >> 4, f = i & 15;
        const float inv = exp2f(-(float)f * (13.287712379549449f / 16.f));
        const float p = pos < 128 ? (float)pos : (float)(pos - 128);
        const float ang = p * inv;
        const float cs = cosf(ang), sn = sinf(ang);
        if (pos < 128) { tab[pos * 16 + f] = cs; tab[2048 + pos * 16 + f] = sn; }
        else { tab[4096 + (pos - 128) * 16 + f] = cs; tab[4096 + 1024 + (pos - 128) * 16 + f] = sn; }
    }
}

__device__ __forceinline__ void transpose_tile(const float* src, int ldsrc, int k0, int n0src, int nvalid, bf16_t* dst, int ldd, int drow0, char* lds) {
    float* tile = (float*)lds;
    const int tid = tid_l(), nl = tid & 63, kq = tid >> 6;
    float v[32];
#pragma unroll
    for (int i = 0; i < 32; ++i) v[i] = nl < nvalid ? src[(size_t)(k0 + kq + 4 * i) * ldsrc + n0src + nl] : 0.f;
#pragma unroll
    for (int i = 0; i < 32; ++i) tile[(kq + 4 * i) * 65 + nl] = v[i];
    __syncthreads();
    const int n = tid >> 2, ks = (tid & 3) * 32;
    if (n < nvalid) {
        u32x4* dp = (u32x4*)(dst + (size_t)(drow0 + n) * ldd + k0 + ks);
#pragma unroll
        for (int q = 0; q < 4; ++q) {
            u32x4 o;
            o.x = cvt_pk(tile[(ks + 8 * q + 0) * 65 + n], tile[(ks + 8 * q + 1) * 65 + n]); o.y = cvt_pk(tile[(ks + 8 * q + 2) * 65 + n], tile[(ks + 8 * q + 3) * 65 + n]);
            o.z = cvt_pk(tile[(ks + 8 * q + 4) * 65 + n], tile[(ks + 8 * q + 5) * 65 + n]); o.w = cvt_pk(tile[(ks + 8 * q + 6) * 65 + n], tile[(ks + 8 * q + 7) * 65 + n]);
            dp[q] = o;
        }
    }
    __syncthreads();
}

constexpr int CONV_TILES = 192 + 8 + 8 + 256 + 192 + 384 + 192 + 128 + 512 + 512;
__device__ __forceinline__ void convert_tile(const Params& P, int l, int it, char* lds) {
    const float* win = P.in[I_WIN] + (size_t)l * D * INW;
    bf16_t* wtin = (bf16_t*)(ws_l(P) + WS_WTIN);
    int r = it;
    if (r < 192) { const int kt = r / 24, nt = r % 24; transpose_tile(win, INW, kt * 128, nt * 64, 64, wtin, 1024, nt * 64, lds); return; } r -= 192;
    if (r < 8) { transpose_tile(win, INW, r * 128, 1536, 32, wtin, 1024, 1536, lds); return; } r -= 8;
    if (r < 8) { transpose_tile(win, INW, r * 128, 3616, 16, wtin, 1024, 1568, lds); return; } r -= 8;
    if (r < 256) { const int kt = r / 32, nt = r % 32; transpose_tile(win, INW, kt * 128, 1568 + nt * 64, 64, wtin, 1024, 1792 + nt * 64, lds); return; } r -= 256;
    if (r < 192) { const int kt = r / 24, nt = r % 24; transpose_tile(win, INW, kt * 128, 3632 + nt * 64, 64, wtin, 1024, 3840 + nt * 64, lds); return; } r -= 192;
    if (r < 384) { const int kt = r / 48, nt = r % 48; transpose_tile(win, INW, kt * 128, 5168 + nt * 64, 64, wtin, 1024, 5376 + nt * 64, lds); return; } r -= 384;
    if (r < 192) { const int j = r / 64, q = r % 64, kt = q / 16, nt = q % 16;
        transpose_tile(P.in[I_WBR] + ((size_t)l * 3 + j) * 512 * 1024, 1024, kt * 128, nt * 64, 64, (bf16_t*)(ws_l(P) + WS_WTBR), 512, j * 1024 + nt * 64, lds); return; } r -= 192;
    if (r < 128) { const int kt = r / 16, nt = r % 16; transpose_tile(P.in[I_WO] + (size_t)l * D * D, 1024, kt * 128, nt * 64, 64, (bf16_t*)(ws_l(P) + WS_WTO), 1024, nt * 64, lds); return; } r -= 128;
    if (r < 512) { const int kt = r / 64, nt = r % 64; transpose_tile(P.in[I_WUP] + (size_t)l * D * FF, 4096, kt * 128, nt * 64, 64, (bf16_t*)(ws_l(P) + WS_WTUP), 1024, nt * 64, lds); return; } r -= 512;
    { const int kt = r / 16, nt = r % 16; transpose_tile(P.in[I_WDN] + (size_t)l * FF * D, 1024, kt * 128, nt * 64, 64, (bf16_t*)(ws_l(P) + WS_WTDN), 4096, nt * 64, lds); }
}
__device__ __forceinline__ void convert_all(const Params& P, int l, char* lds) {
    const int VG = vgrid(), slot = bid_l();
    static_assert(CONV_TILES % 2 == 0, "both halves of a workgroup must be active together");
    for (int i0 = 0; i0 < CONV_TILES; i0 += VG) { const int it = i0 + slot; if (it >= CONV_TILES) continue; convert_tile(P, l, it, lds); }
}

__device__ __forceinline__ void norm_phase(const Params& P, XPtr X, const float* g, int l, int sidx, int nrows) {
    const int lane = tid_l() & 63; const int gw = bid_l() * 4 + (tid_l() >> 6), ngw = vgrid() * 4;
    bf16_t* hb = (bf16_t*)(ws_l(P) + WS_HBUF);
    const float* mods = (const float*)(ws_l(P) + WS_MODS) + (size_t)l * 3 * 6144;
    for (int r = gw; r < nrows; r += 2 * ngw) {
        const int r1 = r + ngw; const bool has1 = r1 < nrows; const int rr1 = has1 ? r1 : r;
        const f32x4* xa = (const f32x4*)xrow(X, r); const f32x4* xb = (const f32x4*)xrow(X, rr1);
        f32x4 va[4], vb[4]; float sa_ = 0.f, sb_ = 0.f;
#pragma unroll
        for (int j = 0; j < 4; ++j) { va[j] = xa[lane + 64 * j]; vb[j] = xb[lane + 64 * j]; }
#pragma unroll
        for (int j = 0; j < 4; ++j) { sa_ += va[j].x * va[j].x + va[j].y * va[j].y + va[j].z * va[j].z + va[j].w * va[j].w; sb_ += vb[j].x * vb[j].x + vb[j].y * vb[j].y + vb[j].z * vb[j].z + vb[j].w * vb[j].w; }
        sa_ = wave_sum(sa_); sb_ = wave_sum(sb_);
        const float rsa = rsqrtf(sa_ * (1.f / 1024.f) + 1e-6f), rsb = rsqrtf(sb_ * (1.f / 1024.f) + 1e-6f);
        const float* mda = mods + modidx(r) * 6144; const float* mdb = mods + modidx(rr1) * 6144;
#pragma unroll
        for (int j = 0; j < 4; ++j) {
            const int col = (lane + 64 * j) * 4;
            const f32x4 gg = *(const f32x4*)(g + col);
            { const f32x4 sh = *(const f32x4*)(mda + sidx * 1024 + col), sc = *(const f32x4*)(mda + (sidx + 1) * 1024 + col);
              const f32x4 hh = va[j] * rsa * gg * (sc + 1.f) + sh; u32x2 o; o.x = cvt_pk(hh.x, hh.y); o.y = cvt_pk(hh.z, hh.w); *(u32x2*)(hb + (size_t)r * 1024 + col) = o; }
            if (has1) { const f32x4 sh = *(const f32x4*)(mdb + sidx * 1024 + col), sc = *(const f32x4*)(mdb + (sidx + 1) * 1024 + col);
              const f32x4 hh = vb[j] * rsb * gg * (sc + 1.f) + sh; u32x2 o; o.x = cvt_pk(hh.x, hh.y); o.y = cvt_pk(hh.z, hh.w); *(u32x2*)(hb + (size_t)r1 * 1024 + col) = o; }
        }
    }
}
__device__ __forceinline__ void final_norm_phase(const Params& P) {
    const int lane = tid_l() & 63; const int gw = bid_l() * 4 + (tid_l() >> 6), ngw = vgrid() * 4;
    const float* g = P.in[I_FG];
    for (int r = gw; r < RL; r += 2 * ngw) {
        const int r1 = r + ngw;
        f32x4* xa = (f32x4*)(P.out + (size_t)r * D); f32x4* xb = (f32x4*)(P.out + (size_t)r1 * D);
        f32x4 va[4], vb[4]; float sa_ = 0.f, sb_ = 0.f;
#pragma unroll
        for (int j = 0; j < 4; ++j) { va[j] = xa[lane + 64 * j]; vb[j] = xb[lane + 64 * j]; }
#pragma unroll
        for (int j = 0; j < 4; ++j) { sa_ += va[j].x * va[j].x + va[j].y * va[j].y + va[j].z * va[j].z + va[j].w * va[j].w; sb_ += vb[j].x * vb[j].x + vb[j].y * vb[j].y + vb[j].z * vb[j].z + vb[j].w * vb[j].w; }
        sa_ = wave_sum(sa_); sb_ = wave_sum(sb_);
        const float rsa = rsqrtf(sa_ * (1.f / 1024.f) + 1e-6f), rsb = rsqrtf(sb_ * (1.f / 1024.f) + 1e-6f);
#pragma unroll
        for (int j = 0; j < 4; ++j) { const f32x4 gg = *(const f32x4*)(g + (lane + 64 * j) * 4); xa[lane + 64 * j] = va[j] * rsa * gg; xb[lane + 64 * j] = vb[j] * rsb * gg; }
    }
}

struct EpiP {
    bf16_t* Pb; int pitch; int nmain; float* small;
    __device__ __forceinline__ void operator()(int r, int c, const f32x4& v, int) const {
        if (c < nmain) { u32x2 o; o.x = cvt_pk(v.x, v.y); o.y = cvt_pk(v.z, v.w); *(u32x2*)(Pb + (size_t)r * pitch + c) = o; }
        else { const int cc = c - nmain; if (cc < 48) *(f32x4*)(small + (size_t)r * 48 + cc) = v; }
    }
    __device__ __forceinline__ void w8(int r, int c, const f32x4& v0, const f32x4& v1, int) const {
        if (c < nmain) { u32x4 o; o.x = cvt_pk(v0.x, v0.y); o.y = cvt_pk(v0.z, v0.w); o.z = cvt_pk(v1.x, v1.y); o.w = cvt_pk(v1.z, v1.w); *(u32x4*)(Pb + (size_t)r * pitch + c) = o; }
        else { const int cc = c - nmain; if (cc < 48) { *(f32x4*)(small + (size_t)r * 48 + cc) = v0; *(f32x4*)(small + (size_t)r * 48 + cc + 4) = v1; } }
    }
};
struct EpiSig {
    bf16_t* O;
    __device__ __forceinline__ void operator()(int r, int c, const f32x4& v, int) const {
        u32x2 o; o.x = cvt_pk(sigmf(v.x), sigmf(v.y)); o.y = cvt_pk(sigmf(v.z), sigmf(v.w)); *(u32x2*)(O + (size_t)r * 3072 + c) = o;
    }
    __device__ __forceinline__ void w8(int r, int c, const f32x4& v0, const f32x4& v1, int) const {
        u32x4 o; o.x = cvt_pk(sigmf(v0.x), sigmf(v0.y)); o.y = cvt_pk(sigmf(v0.z), sigmf(v0.w)); o.z = cvt_pk(sigmf(v1.x), sigmf(v1.y)); o.w = cvt_pk(sigmf(v1.z), sigmf(v1.w));
        *(u32x4*)(O + (size_t)r * 3072 + c) = o;
    }
};
struct EpiRelu2 {
    bf16_t* O;
    __device__ __forceinline__ void operator()(int r, int c, const f32x4& v, int) const {
        const float a = fmaxf(v.x, 0.f), b = fmaxf(v.y, 0.f), cc = fmaxf(v.z, 0.f), d = fmaxf(v.w, 0.f);
        u32x2 o; o.x = cvt_pk(a * a, b * b); o.y = cvt_pk(cc * cc, d * d); *(u32x2*)(O + (size_t)r * 4096 + c) = o;
    }
    __device__ __forceinline__ void w8(int r, int c, const f32x4& v0, const f32x4& v1, int) const {
        const float a = fmaxf(v0.x, 0.f), b = fmaxf(v0.y, 0.f), cc = fmaxf(v0.z, 0.f), d = fmaxf(v0.w, 0.f), e = fmaxf(v1.x, 0.f), f = fmaxf(v1.y, 0.f), g = fmaxf(v1.z, 0.f), h = fmaxf(v1.w, 0.f);
        u32x4 o; o.x = cvt_pk(a * a, b * b); o.y = cvt_pk(cc * cc, d * d); o.z = cvt_pk(e * e, f * f); o.w = cvt_pk(g * g, h * h); *(u32x4*)(O + (size_t)r * 4096 + c) = o;
    }
};
struct EpiRes {
    XPtr Xold, Xnew; const float* mods_l; int gidx;
    __device__ __forceinline__ void operator()(int r, int c, const f32x4& v, int) const {
        const f32x4 g = *(const f32x4*)(mods_l + modidx(r) * 6144 + gidx * 1024 + c);
        const f32x4 xo = *(const f32x4*)(xrow(Xold, r) + c);
        *(f32x4*)(xrow(Xnew, r) + c) = xo + g * v;
    }
    __device__ __forceinline__ void w8(int r, int c, const f32x4& v0, const f32x4& v1, int) const {
        const float* gp = mods_l + modidx(r) * 6144 + gidx * 1024 + c; const float* xo = xrow(Xold, r) + c; float* xn = xrow(Xnew, r) + c;
        const f32x4 g0 = *(const f32x4*)gp, g1 = *(const f32x4*)(gp + 4), x0 = *(const f32x4*)xo, x1 = *(const f32x4*)(xo + 4);
        *(f32x4*)xn = x0 + g0 * v0; *(f32x4*)(xn + 4) = x1 + g1 * v1;
    }
};
struct EpiMerge {
    const bf16_t* gs; bf16_t* mb;
    __device__ __forceinline__ void operator()(int r, int c, const f32x4& v, int j) const {
        const u32x2 g = *(const u32x2*)(gs + (size_t)r * 3072 + j * 1024 + c);
        float a0 = v.x * bflo(g.x), a1 = v.y * bfhi(g.x), a2 = v.z * bflo(g.y), a3 = v.w * bfhi(g.y);
        u32x2* mp = (u32x2*)(mb + (size_t)r * 1024 + c);
        if (j > 0) { const u32x2 o = *mp; a0 += bflo(o.x); a1 += bfhi(o.x); a2 += bflo(o.y); a3 += bfhi(o.y); }
        u32x2 w; w.x = cvt_pk(a0, a1); w.y = cvt_pk(a2, a3); *mp = w;
    }
    __device__ __forceinline__ void w8(int r, int c, const f32x4& v0, const f32x4& v1, int j) const {
        const u32x4 g = *(const u32x4*)(gs + (size_t)r * 3072 + j * 1024 + c);
        float a0 = v0.x * bflo(g.x), a1 = v0.y * bfhi(g.x), a2 = v0.z * bflo(g.y), a3 = v0.w * bfhi(g.y), a4 = v1.x * bflo(g.z), a5 = v1.y * bfhi(g.z), a6 = v1.z * bflo(g.w), a7 = v1.w * bfhi(g.w);
        u32x4* mp = (u32x4*)(mb + (size_t)r * 1024 + c);
        if (j > 0) { const u32x4 o = *mp; a0 += bflo(o.x); a1 += bfhi(o.x); a2 += bflo(o.y); a3 += bfhi(o.y); a4 += bflo(o.z); a5 += bfhi(o.z); a6 += bflo(o.w); a7 += bfhi(o.w); }
        u32x4 w; w.x = cvt_pk(a0, a1); w.y = cvt_pk(a2, a3); w.z = cvt_pk(a4, a5); w.w = cvt_pk(a6, a7); *mp = w;
    }
};

namespace pg8 {
constexpr int BM = 256, BK = 64, HALF = 128, HTB = HALF * BK * 2, STAGE_BYTES = 8 * HTB, NXCD = 8, WGM = 2;
__device__ __forceinline__ int lds_byte(int r, int c) { const int st = (r >> 4) * 2 + (c >> 5), rr = r & 15, cc = c & 31, ob = rr * 64 + cc * 2; return st * 1024 + (ob ^ (((ob >> 9) & 1) << 5)); }
__device__ __forceinline__ int perm32(int rho) { const int n = rho >> 4, i = rho & 15; return 8 * (i >> 2) + 4 * n + (i & 3); }
__device__ __forceinline__ void stage_rc(int b, int& R_, int& C_) { const int st = b / 1024, sb = b % 1024, swz = sb ^ (((sb >> 9) & 1) << 5); R_ = (st >> 1) * 16 + swz / 64; C_ = (st & 1) * 32 + (swz % 64) / 2; }
struct Unit { int pm, pn, acol, brow, j; };
struct Gemm { const bf16_t* A; const bf16_t* Bt; int lda, K; };
struct StaticOrder {
    int nM, nN, nwg, G, c;
    __device__ void init(int M, int N, int G_, int c_) { nM = M / BM; nN = N / BM; nwg = nM * nN; G = G_; c = c_; }
    __device__ __forceinline__ bool tile(long L, int& pm, int& pn) const {
        if (L >= nwg) return false;
        int wgid = (int)L; { const int q = nwg / NXCD, r = nwg % NXCD, xcd = wgid % NXCD, off = wgid / NXCD; wgid = (xcd < r ? xcd * (q + 1) : r * (q + 1) + (xcd - r) * q) + off; }
        const int nig = WGM * nN, gid = wgid / nig, fm = gid * WGM, gsz = (nM - fm) < WGM ? (nM - fm) : WGM;
        pm = fm + ((wgid % nig) % gsz); pn = (wgid % nig) / gsz; return true;
    }
    __device__ __forceinline__ bool next(int i, Unit& u) const { if (!tile((long)i * G + c, u.pm, u.pn)) return false; u.acol = 0; u.brow = u.pn; u.j = 0; return true; }
};
struct MergeOrder {
    StaticOrder S;
    __device__ __forceinline__ bool next(int i, Unit& u) const { const int j = i % 3; if (!S.tile((long)(i / 3) * S.G + S.c, u.pm, u.pn)) return false; u.acol = j * 512; u.brow = j * 4 + u.pn; u.j = j; return true; }
};
template <class F> struct Epi {
    F f;
    __device__ __forceinline__ void operator()(const f32x4 (&acc)[2][2][4][2], const Unit& u, int wr, int wc, int fr, int fq) const {
#pragma unroll
        for (int ai = 0; ai < 2; ++ai)
#pragma unroll
            for (int m = 0; m < 4; ++m)
#pragma unroll
                for (int bj = 0; bj < 2; ++bj)
                    f.w8(u.pm * BM + ai * HALF + wr * 64 + m * 16 + fr, u.pn * BM + bj * HALF + wc * 32 + 8 * fq, acc[ai][bj][m][0], acc[ai][bj][m][1], u.j);
    }
};

template <class E_, class Sched>
__device__ __forceinline__ void gemm_phase(LAS unsigned char* lds, const Gemm g, const Sched& S, const E_& E) {
    int tid_ = threadIdx.x; asm volatile("" : "+v"(tid_));
    const int tid = tid_, wid = __builtin_amdgcn_readfirstlane(tid >> 6), lane = tid & 63, wr = wid >> 2, wc = wid & 3, fr = lane & 15, fq = lane >> 4;
    const int K = g.K, nt = K / BK;
    unsigned voffA[2], voffB[2];
#pragma unroll
    for (int i = 0; i < 2; ++i) { int R_, C_; stage_rc(tid * 16 + i * 8192, R_, C_); const int Rb = (R_ & ~31) + perm32(R_ & 31); voffA[i] = (unsigned)(R_ * g.lda + C_) * 2u; voffB[i] = (unsigned)(Rb * K + C_) * 2u; }
    const size_t kstep = (size_t)(BK * 2);
    const size_t hstepA = (size_t)HALF * g.lda * 2, hstepB = (size_t)HALF * K * 2;
    const unsigned ldsw = (unsigned)wid * 1024u;
    const int aoff = lds_byte(wr * 64 + fr, fq * 8), boff = lds_byte(wc * 32 + fr, fq * 8);
#define PG8_SA(b, h) (((b) * 2 + (h)) * HTB)
#define PG8_SB(b, h) ((4 + (b) * 2 + (h)) * HTB)
#define PG8_STAGE(bufoff, gbase, voff) do { _Pragma("unroll") for (int _i = 0; _i < 2; ++_i) \
        __builtin_amdgcn_global_load_lds((const unsigned*)((const char*)(gbase) + (voff)[_i]), (LAS unsigned*)(lds + (bufoff) + ldsw + _i * 8192), 16, 0, 0); } while (0)
#define PG8_LDA(dst, b, h) do { _Pragma("unroll") for (int m = 0; m < 4; ++m) _Pragma("unroll") for (int k = 0; k < 2; ++k) dst[m][k] = *(const LAS bf16x8*)(lds + PG8_SA(b, h) + aoff + m * 2048 + k * 1024); } while (0)
#define PG8_LDB(dst, b, h) do { _Pragma("unroll") for (int n = 0; n < 2; ++n) _Pragma("unroll") for (int k = 0; k < 2; ++k) dst[n][k] = *(const LAS bf16x8*)(lds + PG8_SB(b, h) + boff + n * 2048 + k * 1024); } while (0)
#define PG8_MMA(ai, bj, At, Bt) do { __builtin_amdgcn_s_setprio(1); _Pragma("unroll") for (int m = 0; m < 4; ++m) _Pragma("unroll") for (int n = 0; n < 2; ++n) _Pragma("unroll") for (int k = 0; k < 2; ++k) \
        acc[ai][bj][m][n] = __builtin_amdgcn_mfma_f32_16x16x32_bf16(Bt[n][k], At[m][k], acc[ai][bj][m][n], 0, 0, 0); __builtin_amdgcn_s_setprio(0); } while (0)
#define PG8_WAIT_V(n) asm volatile("s_waitcnt vmcnt(" #n ")" ::: "memory")
#define PG8_WAIT_L(n) asm volatile("s_waitcnt lgkmcnt(" #n ")" ::: "memory")
#define PG8_BAR __builtin_amdgcn_s_barrier()
#define PG8_SCHED __builtin_amdgcn_sched_barrier(0)
#define PG8_UA(u) ((const char*)g.A + ((size_t)(u).pm * BM * g.lda + (u).acol) * 2)
#define PG8_UB(u) ((const char*)g.Bt + (size_t)(u).brow * BM * K * 2)
    Unit cur, nxt; int ui = 0;
    if (!S.next(0, cur)) return;
    f32x4 acc[2][2][4][2];
#pragma unroll
    for (int a = 0; a < 2; ++a)
#pragma unroll
        for (int b = 0; b < 2; ++b)
#pragma unroll
            for (int m = 0; m < 4; ++m)
#pragma unroll
                for (int n = 0; n < 2; ++n) acc[a][b][m][n] = (f32x4){0.f, 0.f, 0.f, 0.f};
    bf16x8 At[4][2], B0[2][2], B1[2][2];
    const char* cA = PG8_UA(cur); const char* cB = PG8_UB(cur);
    PG8_STAGE(PG8_SB(0, 0), cB, voffB); PG8_STAGE(PG8_SB(0, 1), cB + hstepB, voffB); PG8_STAGE(PG8_SA(0, 0), cA, voffA); PG8_STAGE(PG8_SA(0, 1), cA + hstepA, voffA);
    if (wr == 1) PG8_BAR;
    PG8_WAIT_V(2); PG8_BAR;
    PG8_STAGE(PG8_SB(1, 0), cB + kstep, voffB); PG8_STAGE(PG8_SA(1, 0), cA + kstep, voffA); PG8_STAGE(PG8_SB(1, 1), cB + hstepB + kstep, voffB);
    PG8_WAIT_V(6); PG8_BAR;
    for (;;) {
        const bool has_next = S.next(ui + 1, nxt);
        const char* nA = has_next ? PG8_UA(nxt) : cA; const char* nB = has_next ? PG8_UB(nxt) : cB;
        for (int t = 0; t < nt; t += 2) {
            const bool last = (t == nt - 2);
            const char* a1 = cA + (size_t)(t + 1) * kstep;
            const char* a2 = last ? nA : cA + (size_t)(t + 2) * kstep; const char* b2 = last ? nB : cB + (size_t)(t + 2) * kstep;
            const char* a3 = a2 + kstep; const char* b3 = b2 + kstep;
            PG8_LDB(B0, 0, 0); PG8_LDB(B1, 0, 1); PG8_SCHED; PG8_LDA(At, 0, 0); PG8_STAGE(PG8_SA(1, 1), a1 + hstepA, voffA);
            PG8_WAIT_V(8); PG8_WAIT_L(0); PG8_BAR; PG8_MMA(0, 0, At, B0); PG8_MMA(0, 1, At, B1); PG8_BAR; PG8_SCHED;
            PG8_LDA(At, 0, 1); PG8_STAGE(PG8_SB(0, 0), b2, voffB); PG8_STAGE(PG8_SB(0, 1), b2 + hstepB, voffB); PG8_STAGE(PG8_SA(0, 0), a2, voffA);
            PG8_WAIT_V(8); PG8_WAIT_L(0); PG8_BAR; PG8_MMA(1, 0, At, B0); PG8_MMA(1, 1, At, B1); PG8_BAR; PG8_SCHED;
            PG8_LDB(B0, 1, 0); PG8_LDB(B1, 1, 1); PG8_SCHED; PG8_LDA(At, 1, 0); PG8_STAGE(PG8_SA(0, 1), a2 + hstepA, voffA);
            PG8_WAIT_V(8); PG8_WAIT_L(0); PG8_BAR; PG8_MMA(0, 0, At, B0); PG8_MMA(0, 1, At, B1); PG8_BAR; PG8_SCHED;
            PG8_LDA(At, 1, 1); PG8_STAGE(PG8_SB(1, 0), b3, voffB); PG8_STAGE(PG8_SB(1, 1), b3 + hstepB, voffB); PG8_STAGE(PG8_SA(1, 0), a3, voffA);
            PG8_WAIT_V(8); PG8_WAIT_L(0); PG8_BAR; PG8_MMA(1, 0, At, B0); PG8_MMA(1, 1, At, B1); PG8_BAR; PG8_SCHED;
        }
        if (wr == 0) PG8_BAR;
        E(acc, cur, wr, wc, fr, fq);
        if (!has_next) break;
#pragma unroll
        for (int a = 0; a < 2; ++a)
#pragma unroll
            for (int b = 0; b < 2; ++b)
#pragma unroll
                for (int m = 0; m < 4; ++m)
#pragma unroll
                    for (int n = 0; n < 2; ++n) acc[a][b][m][n] = (f32x4){0.f, 0.f, 0.f, 0.f};
        cur = nxt; cA = nA; cB = nB; ++ui;
        if (wr == 1) PG8_BAR;
    }
    PG8_WAIT_V(0);
    PG8_BAR;
#undef PG8_SA
#undef PG8_SB
#undef PG8_STAGE
#undef PG8_LDA
#undef PG8_LDB
#undef PG8_MMA
#undef PG8_WAIT_V
#undef PG8_WAIT_L
#undef PG8_BAR
#undef PG8_SCHED
#undef PG8_UA
#undef PG8_UB
}
}

template <class F>
__device__ __forceinline__ void big_gemm(LAS unsigned char* ldsb, const bf16_t* A, int lda, const bf16_t* Bt, int K, int N, const F& f) {
    pg8::Gemm g{A, Bt, lda, K}; pg8::StaticOrder S; S.init(RL, N, (int)gridDim.x, (int)blockIdx.x);
    pg8::Epi<F> E{f};
    pg8::gemm_phase(ldsb, g, S, E);
    __syncthreads();
}
template <int NI>
__device__ __forceinline__ void gemm_kloop(f32x4 (&acc)[4][NI], const bf16_t* Ag, int lda, const bf16_t* Bg, int ldb, int K, char* lds) {
    const int tid = tid_l(), lane = tid & 63, wid = tid >> 6, wm = wid >> 1, wn = wid & 1, lr = lane & 15, lq = lane >> 4;
    u32x4 ra[4], rb[NI];
    const int prow = tid >> 3, pkc = tid & 7;
    const bf16_t* ap = Ag + (size_t)prow * lda + pkc * 8;
    const bf16_t* bp = Bg + (size_t)prow * ldb + pkc * 8;
    const int soff = prow * 128 + ((pkc ^ (prow & 7)) << 4);
#pragma unroll
    for (int i = 0; i < 4; ++i) { ra[i] = *(const u32x4*)(ap + (size_t)(32 * i) * lda); if (i < NI) rb[i < NI ? i : 0] = *(const u32x4*)(bp + (size_t)(32 * i) * ldb); }
#pragma unroll
    for (int i = 0; i < 4; ++i) { *(u32x4*)(lds + soff + i * 4096) = ra[i]; if (i < NI) *(u32x4*)(lds + 32768 + soff + i * 4096) = rb[i < NI ? i : 0]; }
    __syncthreads();
    const int nk = K >> 6;
    for (int kt = 0; kt < nk; ++kt) {
        const int buf = kt & 1;
        if (kt + 1 < nk) {
#pragma unroll
            for (int i = 0; i < 4; ++i) { ra[i] = *(const u32x4*)(ap + (size_t)(32 * i) * lda + (kt + 1) * 64); if (i < NI) rb[i < NI ? i : 0] = *(const u32x4*)(bp + (size_t)(32 * i) * ldb + (kt + 1) * 64); }
        }
        const char* la = lds + buf * 16384; const char* lb = lds + 32768 + buf * 16384;
#pragma unroll
        for (int kk = 0; kk < 2; ++kk) {
            bf16x8 af[4], bfr[NI];
            const int chunk = kk * 4 + lq;
#pragma unroll
            for (int mi = 0; mi < 4; ++mi) { const int row = wm * 64 + mi * 16 + lr; af[mi] = *(const bf16x8*)(la + row * 128 + ((chunk ^ (row & 7)) << 4)); }
#pragma unroll
            for (int ni = 0; ni < NI; ++ni) { const int row = wn * (16 * NI) + ni * 16 + lr; bfr[ni] = *(const bf16x8*)(lb + row * 128 + ((chunk ^ (row & 7)) << 4)); }
#pragma unroll
            for (int mi = 0; mi < 4; ++mi)
#pragma unroll
                for (int ni = 0; ni < NI; ++ni) acc[mi][ni] = __builtin_amdgcn_mfma_f32_16x16x32_bf16(bfr[ni], af[mi], acc[mi][ni], 0, 0, 0);
        }
        if (kt + 1 < nk) {
            char* sa = lds + (buf ^ 1) * 16384 + soff;
#pragma unroll
            for (int i = 0; i < 4; ++i) { *(u32x4*)(sa + i * 4096) = ra[i]; if (i < NI) *(u32x4*)(sa + 32768 + i * 4096) = rb[i < NI ? i : 0]; }
        }
        __syncthreads();
    }
}

__device__ __forceinline__ void tile_of(int t, int Mt, int Nt, int& tm, int& tn) {
    const int per = 8 * Nt; const int p = t / per; const int r = t - p * per; const int pm = (Mt - 8 * p) < 8 ? (Mt - 8 * p) : 8;
    tm = 8 * p + r % pm; tn = r / pm;
}

template <int TYPE> struct MX {
    static constexpr int DK = TYPE == 1 ? 128 : 64;
    static constexpr int NOC = DK / 8;
    static constexpr int PITCH = TYPE == 1 ? 2048 : 1536;
    static constexpr int QOFF = 0;
    static constexpr int KOFF = TYPE == 1 ? 512 : 256;
    static constexpr int VOFF = TYPE == 1 ? 1024 : 512;
    static constexpr int GOFF = TYPE == 1 ? 1536 : 1024;
    static constexpr int QP = DK + 16;
};
constexpr int L_VT = 0;
constexpr int L_Q = 20480;
constexpr int L_CUM = 40960;
constexpr int L_ATT = 57344;
constexpr int L_SC = 67584;
constexpr int L_SA = 68096;

template <int TYPE>
__device__ __forceinline__ void load_qk8(const Params& P, int l, const bf16_t* pb, int b, int c, int t, int h, int oc, bool isk, float (&f)[8]) {
    typedef MX<TYPE> M;
    const int coff = (isk ? M::KOFF : M::QOFF) + h * M::DK;
    const size_t rowi = (size_t)(rowbase(b, c) + t);
    if (TYPE == 0) {
        const u32x4 u = *(const u32x4*)(pb + rowi * M::PITCH + coff + oc * 8); UNPACK8(u, f);
    } else if (TYPE == 1) {
        const bool hp = (t > 0) || (c != 0 && c != 4), hn = (t < 63) || (c != 3 && c != NCH - 1);
        const bf16_t* p0 = pb + rowi * M::PITCH + coff + oc * 8;
        u32x4 u1 = *(const u32x4*)p0, u0 = (u32x4){0u, 0u, 0u, 0u}, u2 = (u32x4){0u, 0u, 0u, 0u};
        if (hp) u0 = *(const u32x4*)(p0 - M::PITCH);
        if (hn) u2 = *(const u32x4*)(p0 + M::PITCH);
        float a[8], m[8], n[8]; UNPACK8(u0, a); UNPACK8(u1, m); UNPACK8(u2, n);
        const float* cw = P.in[I_CONV] + (size_t)l * 3 * 1024 + (isk ? 512 : 0) + h * 128 + oc * 8;
        const f32x4 w0a = *(const f32x4*)cw, w0b = *(const f32x4*)(cw + 4), w1a = *(const f32x4*)(cw + 1024), w1b = *(const f32x4*)(cw + 1028), w2a = *(const f32x4*)(cw + 2048), w2b = *(const f32x4*)(cw + 2052);
        const float w0[8] = {w0a.x, w0a.y, w0a.z, w0a.w, w0b.x, w0b.y, w0b.z, w0b.w};
        const float w1[8] = {w1a.x, w1a.y, w1a.z, w1a.w, w1b.x, w1b.y, w1b.z, w1b.w};
        const float w2[8] = {w2a.x, w2a.y, w2a.z, w2a.w, w2b.x, w2b.y, w2b.z, w2b.w};
#pragma unroll
        for (int j = 0; j < 8; ++j) f[j] = siluf(w0[j] * a[j] + w1[j] * m[j] + w2[j] * n[j]);
    } else {
        if (c < 4) { const u32x4 u = *(const u32x4*)(pb + rowi * M::PITCH + coff + oc * 8); UNPACK8(u, f); }
        else {
            const int o4 = oc & 3;
            const u32x4 ua = *(const u32x4*)(pb + rowi * M::PITCH + coff + o4 * 8), ub = *(const u32x4*)(pb + rowi * M::PITCH + coff + 32 + o4 * 8);
            float x1[8], x2[8]; UNPACK8(ua, x1); UNPACK8(ub, x2);
            const float* tab = (const float*)(ws_l(P) + WS_ROPE);
            const float* cs = o4 < 2 ? tab + (c - 4) * 16 + o4 * 8 : tab + 4096 + t * 16 + (o4 - 2) * 8;
            const float* sn = o4 < 2 ? tab + 2048 + (c - 4) * 16 + o4 * 8 : tab + 4096 + 1024 + t * 16 + (o4 - 2) * 8;
#pragma unroll
            for (int j = 0; j < 8; ++j) f[j] = oc < 4 ? x1[j] * cs[j] - x2[j] * sn[j] : x1[j] * sn[j] + x2[j] * cs[j];
        }
    }
}

template <int TYPE>
__device__ __forceinline__ void decay_setup(const Params& P, int l, int b, int c, int h, int dir, char* lds, const float* apre = nullptr) {
    const int tid = tid_l(); const int r0 = rowbase(b, c);
    float* sc = (float*)(lds + L_SC);
    const float* small = (const float*)(ws_l(P) + WS_SMALL);
    if (TYPE == 0) {
        float* cum = (float*)(lds + L_CUM); float* sa = (float*)(lds + L_SA);
        if (apre) {
#pragma unroll
            for (int k = 0; k < 4; ++k) sa[tid + k * NTHR] = apre[k];
        } else {
            for (int i = tid; i < 1024; i += NTHR) sa[i] = small[(size_t)(r0 + (i >> 4)) * 48 + dir * 16 + (i & 15)];
        }
        __syncthreads();
        const int d = tid & 63, tq = tid >> 6;
        const float* a2 = P.in[I_A2] + ((size_t)(l * 2 + dir) * 16) * 256 + h * 64 + d;
        float w[16];
#pragma unroll
        for (int rr = 0; rr < 16; ++rr) w[rr] = a2[rr * 256];
        const float bias = P.in[I_ABIAS][(l * 2 + dir) * 256 + h * 64 + d];
        float* blk = sa;
        float lv[16];
#pragma unroll
        for (int i = 0; i < 16; ++i) {
            const int t = tq * 16 + i;
            float z = bias;
#pragma unroll
            for (int rr = 0; rr < 16; ++rr) z += sa[t * 16 + rr] * w[rr];
            lv[i] = logsig(z) * (1.f / 16.f);
        }
        if (dir == 0) {
#pragma unroll
            for (int i = 1; i < 16; ++i) lv[i] += lv[i - 1];
        } else {
#pragma unroll
            for (int i = 14; i >= 0; --i) lv[i] += lv[i + 1];
        }
        __syncthreads();
        blk[tq * 64 + d] = dir == 0 ? lv[15] : lv[0];
        __syncthreads();
        float off = 0.f;
#pragma unroll
        for (int q = 0; q < 4; ++q) if (dir == 0 ? (q < tq) : (q > tq)) off += blk[q * 64 + d];
#pragma unroll
        for (int i = 0; i < 16; ++i) cum[(tq * 16 + i) * 64 + d] = lv[i] + off;
    } else if (TYPE == 1) {
        if (tid < 64) {
            const float fg = small[(size_t)(r0 + tid) * 48 + 40 + dir * 4 + h] + P.in[I_FB][l * 8 + dir * 4 + h];
            float v = logsig(fg);
            if (dir == 0) {
#pragma unroll
                for (int o = 1; o < 64; o <<= 1) { const float n = __shfl_up(v, o); if (tid >= o) v += n; }
            } else {
#pragma unroll
                for (int o = 1; o < 64; o <<= 1) { const float n = __shfl_down(v, o); if (tid + o < 64) v += n; }
            }
            const float tot = __shfl(v, dir == 0 ? 63 : 0);
            sc[tid] = v;
            sc[64 + tid] = small[(size_t)(r0 + tid) * 48 + 32 + dir * 4 + h] + P.in[I_IB][l * 8 + dir * 4 + h];
            if (tid == 0) sc[128] = tot;
        }
    } else {
        if (tid < 64) {
            const float lg = logsig(P.in[I_RDL][l * 8 + dir * 4 + h]);
            sc[tid] = (dir == 0 ? (float)(tid + 1) : (float)(64 - tid)) * lg;
            if (tid == 0) sc[128] = 64.f * lg;
        }
    }
    __syncthreads();
}

template <int TYPE>
__device__ __forceinline__ void build_vT(const bf16_t* pb, int b, int c, int h, char* lds) {
    typedef MX<TYPE> M;
    bf16_t* vT = (bf16_t*)(lds + L_VT);
#pragma unroll
    for (int i = 0; i < 2; ++i) {
        const int pid = tid_l() + i * NTHR, tp = pid & 31, oc = pid >> 5;
        const bf16_t* p0 = pb + (size_t)(rowbase(b, c) + 2 * tp) * M::PITCH + M::VOFF + h * 128 + oc * 8;
        const u32x4 u0 = *(const u32x4*)p0, u1 = *(const u32x4*)(p0 + M::PITCH);
        unsigned* dst = (unsigned*)(vT + (size_t)(oc * 8) * 80 + 2 * tp);
        dst[0 * 40] = (u0.x & 0xffffu) | (u1.x << 16); dst[1 * 40] = (u0.x >> 16) | (u1.x & 0xffff0000u);
        dst[2 * 40] = (u0.y & 0xffffu) | (u1.y << 16); dst[3 * 40] = (u0.y >> 16) | (u1.y & 0xffff0000u);
        dst[4 * 40] = (u0.z & 0xffffu) | (u1.z << 16); dst[5 * 40] = (u0.z >> 16) | (u1.z & 0xffff0000u);
        dst[6 * 40] = (u0.w & 0xffffu) | (u1.w << 16); dst[7 * 40] = (u0.w >> 16) | (u1.w & 0xffff0000u);
    }
}

__device__ __forceinline__ int scan_index(int dir, int c) { return dir == 0 ? c : (c < 4 ? 3 - c : 135 - c); }

template <int TYPE>
__device__ __forceinline__ void u_phase(const Params& P, int l, char* lds) {
    typedef MX<TYPE> M; constexpr int DK = M::DK;
    const int tid = tid_l(), lane = tid & 63, wid = tid >> 6, lr = lane & 15, lq = lane >> 4;
    const bf16_t* pb = (const bf16_t*)(ws_l(P) + WS_PBUF);
    bf16_t* U = (bf16_t*)(ws_l(P) + WS_SBUF); float* DEC = (float*)(ws_l(P) + WS_DEC); float* UN = (float*)(ws_l(P) + WS_UN);
    bf16_t* vT = (bf16_t*)(lds + L_VT); bf16_t* kT = (bf16_t*)(lds + L_Q);
    const float* cum = (const float*)(lds + L_CUM); const float* sc = (const float*)(lds + L_SC);
    const int NU = NB * 4 * 2 * NCH, VG = vgrid(), slot = bid_l();
    for (int u0 = 0; u0 < NU; u0 += VG) {
        int unit = u0 + slot; if (unit >= NU) unit = NU - 1;
        const int c = unit % NCH; const int rest = unit / NCH; const int dir = rest & 1, h = (rest >> 1) & 3, b = rest >> 3;
        const int chain = (b * 4 + h) * 2 + dir, n = scan_index(dir, c);
        static_assert(TYPE == 0, "the scalar-decay branches use u_phase_s");
        float k0[8], k1[8], apre[4];
        { const int tp = tid & 31, oc = tid >> 5;
          load_qk8<TYPE>(P, l, pb, b, c, 2 * tp, h, oc, true, k0);
          load_qk8<TYPE>(P, l, pb, b, c, 2 * tp + 1, h, oc, true, k1);
          const float* small = (const float*)(ws_l(P) + WS_SMALL); const int r0 = rowbase(b, c);
#pragma unroll
          for (int k = 0; k < 4; ++k) { const int i = tid + k * NTHR; apre[k] = small[(size_t)(r0 + (i >> 4)) * 48 + dir * 16 + (i & 15)]; } }
        build_vT<TYPE>(pb, b, c, h, lds);
        decay_setup<TYPE>(P, l, b, c, h, dir, lds, apre);
        const int tlast = dir == 0 ? 63 : 0;
        {
            const int pid = tid, tp = pid & 31, oc = pid >> 5;
            unsigned* dst = (unsigned*)(kT + (size_t)(oc * 8) * 80 + 2 * tp);
            if (TYPE == 0) {
#pragma unroll
                for (int j = 0; j < 8; ++j) { const int d = oc * 8 + j; const float tot = cum[tlast * 64 + d];
                    dst[j * 40] = cvt_pk(k0[j] * __expf(tot - cum[(2 * tp) * 64 + d]), k1[j] * __expf(tot - cum[(2 * tp + 1) * 64 + d])); }
            } else {
                const float tot = sc[128];
                const float w0 = TYPE == 1 ? __expf(tot - sc[2 * tp] + sc[64 + 2 * tp]) * 0.08838834764831845f : __expf(tot - sc[2 * tp]) * 0.125f;
                const float w1 = TYPE == 1 ? __expf(tot - sc[2 * tp + 1] + sc[64 + 2 * tp + 1]) * 0.08838834764831845f : __expf(tot - sc[2 * tp + 1]) * 0.125f;
#pragma unroll
                for (int j = 0; j < 8; ++j) dst[j * 40] = cvt_pk(k0[j] * w0, k1[j] * w1);
            }
        }
        __syncthreads();
        f32x4 acc[2][DK / 16];
#pragma unroll
        for (int i = 0; i < 2; ++i)
#pragma unroll
            for (int nt = 0; nt < DK / 16; ++nt) acc[i][nt] = (f32x4){0.f, 0.f, 0.f, 0.f};
#pragma unroll
        for (int kk = 0; kk < 2; ++kk) {
            bf16x8 fv[2];
#pragma unroll
            for (int i = 0; i < 2; ++i) fv[i] = *(const bf16x8*)(vT + (size_t)((2 * wid + i) * 16 + lr) * 80 + kk * 32 + lq * 8);
#pragma unroll
            for (int nt = 0; nt < DK / 16; ++nt) {
                const bf16x8 fk = *(const bf16x8*)(kT + (size_t)(nt * 16 + lr) * 80 + kk * 32 + lq * 8);
#pragma unroll
                for (int i = 0; i < 2; ++i) acc[i][nt] = __builtin_amdgcn_mfma_f32_16x16x32_bf16(fk, fv[i], acc[i][nt], 0, 0, 0);
            }
        }
        bf16_t* ub = U + (size_t)(chain * NCH + n) * 128 * DK;
#pragma unroll
        for (int i = 0; i < 2; ++i)
#pragma unroll
            for (int nt = 0; nt < DK / 16; ++nt) {
                const int e = (2 * wid + i) * 16 + lr, d = nt * 16 + lq * 4;
                u32x2 o; o.x = cvt_pk(acc[i][nt].x, acc[i][nt].y); o.y = cvt_pk(acc[i][nt].z, acc[i][nt].w);
                *(u32x2*)(ub + (size_t)e * DK + d) = o;
            }
        if (tid < DK) {
            const float tot = TYPE == 0 ? cum[tlast * 64 + (tid & 63)] : sc[128];
            DEC[(size_t)(chain * NCH + n) * 128 + tid] = __expf(tot);
            if (TYPE == 1) {
                float s = 0.f;
#pragma unroll
                for (int q = 0; q < 8; ++q) { const u32x4 u = *(const u32x4*)(kT + (size_t)tid * 80 + q * 8); float f[8]; UNPACK8(u, f);
#pragma unroll
                    for (int j = 0; j < 8; ++j) s += f[j]; }
                UN[(size_t)(chain * NCH + n) * 128 + tid] = s;
            }
        }
        __syncthreads();
    }
}

template <int TYPE>
__device__ __forceinline__ void u_phase_s(const Params& P, int l, char* lds) {
    typedef MX<TYPE> M; constexpr int DK = M::DK; constexpr int NIT = M::NOC * 32 / NTHR;
    const int tid = tid_l(), lane = tid & 63, wid = tid >> 6, lr = lane & 15, lq = lane >> 4;
    const bf16_t* pb = (const bf16_t*)(ws_l(P) + WS_PBUF);
    const float* small = (const float*)(ws_l(P) + WS_SMALL);
    bf16_t* U = (bf16_t*)(ws_l(P) + WS_SBUF); float* DEC = (float*)(ws_l(P) + WS_DEC); float* UN = (float*)(ws_l(P) + WS_UN);
    bf16_t* vT = (bf16_t*)(lds + L_VT); bf16_t* kT0 = (bf16_t*)(lds + 20480); bf16_t* kT1 = (bf16_t*)(lds + 40960);
    float* sc = (float*)(lds + L_SC);
    const int NU = NB * 4 * NCH, VG = vgrid(), slot = bid_l();
    for (int u0 = 0; u0 < NU; u0 += VG) {
        int unit = u0 + slot; if (unit >= NU) unit = NU - 1;
        const int c = unit % NCH; const int rest = unit / NCH; const int h = rest & 3, b = rest >> 2;
        const int r0 = rowbase(b, c);
        float kv[NIT][2][8];
#pragma unroll
        for (int i = 0; i < NIT; ++i) {
            const int pid = tid + i * NTHR, tp = pid & 31, oc = pid >> 5;
            load_qk8<TYPE>(P, l, pb, b, c, 2 * tp, h, oc, true, kv[i][0]);
            load_qk8<TYPE>(P, l, pb, b, c, 2 * tp + 1, h, oc, true, kv[i][1]);
        }
        if (TYPE == 1) {
            if (tid < 128) {
                const int dir = tid >> 6, t = tid & 63;
                const float fg = small[(size_t)(r0 + t) * 48 + 40 + dir * 4 + h] + P.in[I_FB][l * 8 + dir * 4 + h];
                float v = logsig(fg);
                if (dir == 0) {
#pragma unroll
                    for (int o = 1; o < 64; o <<= 1) { const float n = __shfl_up(v, o); if (t >= o) v += n; }
                } else {
#pragma unroll
                    for (int o = 1; o < 64; o <<= 1) { const float n = __shfl_down(v, o); if (t + o < 64) v += n; }
                }
                sc[dir * 64 + t] = v;
                sc[128 + dir * 64 + t] = small[(size_t)(r0 + t) * 48 + 32 + dir * 4 + h] + P.in[I_IB][l * 8 + dir * 4 + h];
            }
        } else {
            if (tid < 64) {
                const float lg0 = logsig(P.in[I_RDL][l * 8 + h]), lg1 = logsig(P.in[I_RDL][l * 8 + 4 + h]);
                sc[tid] = (float)(tid + 1) * lg0; sc[64 + tid] = (float)(64 - tid) * lg1;
            }
        }
        build_vT<TYPE>(pb, b, c, h, lds);
        __syncthreads();
        const float totf = sc[63], totb = sc[64];
        const float ks = TYPE == 1 ? 0.08838834764831845f : 0.125f;
#pragma unroll
        for (int i = 0; i < NIT; ++i) {
            const int pid = tid + i * NTHR, tp = pid & 31, oc = pid >> 5;
            const int t0 = 2 * tp, t1 = 2 * tp + 1;
            const float wf0 = __expf(totf - sc[t0] + (TYPE == 1 ? sc[128 + t0] : 0.f)) * ks, wf1 = __expf(totf - sc[t1] + (TYPE == 1 ? sc[128 + t1] : 0.f)) * ks;
            const float wb0 = __expf(totb - sc[64 + t0] + (TYPE == 1 ? sc[192 + t0] : 0.f)) * ks, wb1 = __expf(totb - sc[64 + t1] + (TYPE == 1 ? sc[192 + t1] : 0.f)) * ks;
            unsigned* d0 = (unsigned*)(kT0 + (size_t)(oc * 8) * 80 + 2 * tp); unsigned* d1 = (unsigned*)(kT1 + (size_t)(oc * 8) * 80 + 2 * tp);
#pragma unroll
            for (int j = 0; j < 8; ++j) { d0[j * 40] = cvt_pk(kv[i][0][j] * wf0, kv[i][1][j] * wf1); d1[j * 40] = cvt_pk(kv[i][0][j] * wb0, kv[i][1][j] * wb1); }
        }
        __syncthreads();
        const int chf = (b * 4 + h) * 2;
#pragma unroll 1
        for (int dir = 0; dir < 2; ++dir) {
            const bf16_t* kT = dir == 0 ? kT0 : kT1;
            const int n = scan_index(dir, c);
            f32x4 acc[2][DK / 16];
#pragma unroll
            for (int i = 0; i < 2; ++i)
#pragma unroll
                for (int nt = 0; nt < DK / 16; ++nt) acc[i][nt] = (f32x4){0.f, 0.f, 0.f, 0.f};
#pragma unroll
            for (int kk = 0; kk < 2; ++kk) {
                bf16x8 fv[2];
#pragma unroll
                for (int i = 0; i < 2; ++i) fv[i] = *(const bf16x8*)(vT + (size_t)((2 * wid + i) * 16 + lr) * 80 + kk * 32 + lq * 8);
#pragma unroll
                for (int nt = 0; nt < DK / 16; ++nt) {
                    const bf16x8 fk = *(const bf16x8*)(kT + (size_t)(nt * 16 + lr) * 80 + kk * 32 + lq * 8);
#pragma unroll
                    for (int i = 0; i < 2; ++i) acc[i][nt] = __builtin_amdgcn_mfma_f32_16x16x32_bf16(fk, fv[i], acc[i][nt], 0, 0, 0);
                }
            }
            bf16_t* ub = U + (size_t)((chf + dir) * NCH + n) * 128 * DK;
#pragma unroll
            for (int i = 0; i < 2; ++i)
#pragma unroll
                for (int nt = 0; nt < DK / 16; ++nt) {
                    const int e = (2 * wid + i) * 16 + lr, d = nt * 16 + lq * 4;
                    u32x2 o; o.x = cvt_pk(acc[i][nt].x, acc[i][nt].y); o.y = cvt_pk(acc[i][nt].z, acc[i][nt].w);
                    *(u32x2*)(ub + (size_t)e * DK + d) = o;
                }
        }
        if (tid < 2 * DK) {
            const int dir = tid / DK, d = tid % DK; const int n = scan_index(dir, c);
            DEC[(size_t)((chf + dir) * NCH + n) * 128 + d] = __expf(dir == 0 ? totf : totb);
            if (TYPE == 1) {
                const bf16_t* kT = dir == 0 ? kT0 : kT1;
                float sum = 0.f;
#pragma unroll
                for (int q = 0; q < 8; ++q) { const u32x4 u = *(const u32x4*)(kT + (size_t)d * 80 + q * 8); float f[8]; UNPACK8(u, f);
#pragma unroll
                    for (int j = 0; j < 8; ++j) sum += f[j]; }
                UN[(size_t)((chf + dir) * NCH + n) * 128 + d] = sum;
            }
        }
        __syncthreads();
    }
}

template <int DK, bool HASN>
__device__ __forceinline__ void scan_phase(const Params& P) {
    bf16_t* U = (bf16_t*)(ws_l(P) + WS_SBUF); const float* DEC = (const float*)(ws_l(P) + WS_DEC); float* UN = (float*)(ws_l(P) + WS_UN);
    constexpr int DQ = DK / 2; constexpr int TT = 16 * 128 * DQ;
    constexpr size_t US = (size_t)128 * DK;
    for (int g = bid_l() * NTHR + tid_l(); g < TT; g += vgrid() * NTHR) {
        const int dq = g % DQ, e = (g / DQ) % 128, chain = g / (DQ * 128);
        bf16_t* up = U + ((size_t)chain * NCH * 128 + e) * DK + dq * 2;
        const float* dp = DEC + (size_t)chain * NCH * 128 + dq * 2;
        float S0 = 0.f, S1 = 0.f;
        constexpr int SB = 12;
        unsigned ua[SB], ubv[SB]; f32x2 da[SB], db[SB];
#define SC_LOAD(uu, dd, n0) do { _Pragma("unroll") for (int j = 0; j < SB; ++j) { uu[j] = *(const unsigned*)(up + (size_t)((n0) + j) * US); dd[j] = *(const f32x2*)(dp + (size_t)((n0) + j) * 128); } } while (0)
#define SC_STEP(uu, dd, n0) do { _Pragma("unroll") for (int j = 0; j < SB; ++j) { *(unsigned*)(up + (size_t)((n0) + j) * US) = cvt_pk(S0, S1); \
            S0 = dd[j].x * S0 + bflo(uu[j]); S1 = dd[j].y * S1 + bfhi(uu[j]); } } while (0)
        SC_LOAD(ua, da, 0);
        for (int n0 = 0; n0 < 120; n0 += 24) {
            SC_LOAD(ubv, db, n0 + 12);
            SC_STEP(ua, da, n0);
            SC_LOAD(ua, da, n0 + 24);
            SC_STEP(ubv, db, n0 + 12);
        }
        SC_STEP(ua, da, 120);
#undef SC_LOAD
#undef SC_STEP
    }
    if (HASN) {
        for (int g = bid_l() * NTHR + tid_l(); g < 16 * 128; g += vgrid() * NTHR) {
            const int d = g & 127, chain = g >> 7;
            float* np = UN + (size_t)chain * NCH * 128 + d; const float* dp = DEC + (size_t)chain * NCH * 128 + d;
            float S = 0.f;
            float ua_[12], da_[12], ub_[12], db_[12];
#define NS_LOAD(uu, dd, n0) do { _Pragma("unroll") for (int j = 0; j < 12; ++j) { uu[j] = np[(size_t)((n0) + j) * 128]; dd[j] = dp[(size_t)((n0) + j) * 128]; } } while (0)
#define NS_STEP(uu, dd, n0) do { _Pragma("unroll") for (int j = 0; j < 12; ++j) { np[(size_t)((n0) + j) * 128] = S; S = dd[j] * S + uu[j]; } } while (0)
            NS_LOAD(ua_, da_, 0);
            for (int n0 = 0; n0 < 120; n0 += 24) {
                NS_LOAD(ub_, db_, n0 + 12);
                NS_STEP(ua_, da_, n0);
                NS_LOAD(ua_, da_, n0 + 24);
                NS_STEP(ub_, db_, n0 + 12);
            }
            NS_STEP(ua_, da_, 120);
#undef NS_LOAD
#undef NS_STEP
        }
    }
}

template <int TYPE>
__device__ __forceinline__ void out_phase(const Params& P, int l, int pass, bool latent_only, char* lds) {
    typedef MX<TYPE> M; constexpr int DK = M::DK; constexpr int QP = M::QP;
    const int tid = tid_l(), lane = tid & 63, wid = tid >> 6, lr = lane & 15, lq = lane >> 4;
    const bf16_t* pb = (const bf16_t*)(ws_l(P) + WS_PBUF);
    const bf16_t* U = (const bf16_t*)(ws_l(P) + WS_SBUF); const float* UN = (const float*)(ws_l(P) + WS_UN);
    bf16_t* brp = (bf16_t*)(ws_l(P) + WS_BR);
    bf16_t* vT = (bf16_t*)(lds + L_VT); bf16_t* qin = (bf16_t*)(lds + L_Q); bf16_t* kin = qin + 64 * QP; bf16_t* att = (bf16_t*)(lds + L_ATT);
    const float* cum = (const float*)(lds + L_CUM); const float* sc = (const float*)(lds + L_SC);
    const float* ng = P.in[TYPE == 0 ? I_GNG : (TYPE == 1 ? I_MNG : I_RNG)] + l * 512;
    const int NC = latent_only ? NCH - 4 : NCH; const int NU = NB * 4 * NC, VG = vgrid(), slot = bid_l();
    for (int u0 = 0; u0 < NU; u0 += VG) {
        int unit = u0 + slot; if (unit >= NU) unit = NU - 1;
        const int c = unit % NC + (latent_only ? 4 : 0); const int rest = unit / NC; const int h = rest & 3, b = rest >> 2;
        const int r0 = rowbase(b, c);
        build_vT<TYPE>(pb, b, c, h, lds);
        f32x4 tot[8];
#pragma unroll
        for (int et = 0; et < 8; ++et) tot[et] = (f32x4){0.f, 0.f, 0.f, 0.f};
        const int trow = wid * 16 + lr;
        for (int dir = 0; dir < 2; ++dir) {
            const int chain = (b * 4 + h) * 2 + dir, n = scan_index(dir, c);
            decay_setup<TYPE>(P, l, b, c, h, dir, lds);
#pragma unroll 2
            for (int i = 0; i < 64 * M::NOC / NTHR; ++i) {
                const int pid = tid + i * NTHR, t = pid / M::NOC, oc = pid % M::NOC;
                float q8[8], k8[8];
                load_qk8<TYPE>(P, l, pb, b, c, t, h, oc, false, q8);
                load_qk8<TYPE>(P, l, pb, b, c, t, h, oc, true, k8);
                if (TYPE == 0) {
#pragma unroll
                    for (int j = 0; j < 8; ++j) { const float cv = cum[t * 64 + oc * 8 + j]; q8[j] *= __expf(cv) * 0.125f; k8[j] *= __expf(-cv); }
                } else {
                    const float cv = sc[t];
                    const float wq = __expf(cv);
                    const float wk = TYPE == 1 ? __expf(sc[64 + t] - cv) * 0.08838834764831845f : __expf(-cv) * 0.125f;
#pragma unroll
                    for (int j = 0; j < 8; ++j) { q8[j] *= wq; k8[j] *= wk; }
                }
                u32x4 oq, ok;
                oq.x = cvt_pk(q8[0], q8[1]); oq.y = cvt_pk(q8[2], q8[3]); oq.z = cvt_pk(q8[4], q8[5]); oq.w = cvt_pk(q8[6], q8[7]);
                ok.x = cvt_pk(k8[0], k8[1]); ok.y = cvt_pk(k8[2], k8[3]); ok.z = cvt_pk(k8[4], k8[5]); ok.w = cvt_pk(k8[6], k8[7]);
                *(u32x4*)(qin + (size_t)t * QP + oc * 8) = oq;
                *(u32x4*)(kin + (size_t)t * QP + oc * 8) = ok;
            }
            __syncthreads();
            f32x4 sacc[4];
#pragma unroll
            for (int nt = 0; nt < 4; ++nt) sacc[nt] = (f32x4){0.f, 0.f, 0.f, 0.f};
#pragma unroll
            for (int kk = 0; kk < DK / 32; ++kk) {
                const bf16x8 fq = *(const bf16x8*)(qin + (size_t)trow * QP + kk * 32 + lq * 8);
#pragma unroll
                for (int nt = 0; nt < 4; ++nt) {
                    const bf16x8 fk = *(const bf16x8*)(kin + (size_t)(nt * 16 + lr) * QP + kk * 32 + lq * 8);
                    sacc[nt] = __builtin_amdgcn_mfma_f32_16x16x32_bf16(fk, fq, sacc[nt], 0, 0, 0);
                }
            }
            float den = 0.f;
#pragma unroll
            for (int nt = 0; nt < 4; ++nt) {
                const int s0 = nt * 16 + lq * 4;
                float a0 = sacc[nt].x, a1 = sacc[nt].y, a2 = sacc[nt].z, a3 = sacc[nt].w;
                if (dir == 0) { if (s0 + 0 > trow) a0 = 0.f; if (s0 + 1 > trow) a1 = 0.f; if (s0 + 2 > trow) a2 = 0.f; if (s0 + 3 > trow) a3 = 0.f; }
                else { if (s0 + 0 < trow) a0 = 0.f; if (s0 + 1 < trow) a1 = 0.f; if (s0 + 2 < trow) a2 = 0.f; if (s0 + 3 < trow) a3 = 0.f; }
                den += (a0 + a1) + (a2 + a3);
                u32x2 o; o.x = cvt_pk(a0, a1); o.y = cvt_pk(a2, a3);
                *(u32x2*)(att + (size_t)trow * 80 + s0) = o;
            }
            __syncthreads();
            f32x4 oacc[8];
#pragma unroll
            for (int et = 0; et < 8; ++et) oacc[et] = (f32x4){0.f, 0.f, 0.f, 0.f};
#pragma unroll
            for (int kk = 0; kk < 2; ++kk) {
                const bf16x8 fa = *(const bf16x8*)(att + (size_t)trow * 80 + kk * 32 + lq * 8);
#pragma unroll
                for (int et = 0; et < 8; ++et) {
                    const bf16x8 fv = *(const bf16x8*)(vT + (size_t)(et * 16 + lr) * 80 + kk * 32 + lq * 8);
                    oacc[et] = __builtin_amdgcn_mfma_f32_16x16x32_bf16(fv, fa, oacc[et], 0, 0, 0);
                }
            }
            const bf16_t* sp = U + (size_t)(chain * NCH + n) * 128 * DK;
#pragma unroll
            for (int kk = 0; kk < DK / 32; ++kk) {
                const bf16x8 fq = *(const bf16x8*)(qin + (size_t)trow * QP + kk * 32 + lq * 8);
#pragma unroll
                for (int et = 0; et < 8; ++et) {
                    const bf16x8 fs = *(const bf16x8*)(sp + (size_t)(et * 16 + lr) * DK + kk * 32 + lq * 8);
                    oacc[et] = __builtin_amdgcn_mfma_f32_16x16x32_bf16(fs, fq, oacc[et], 0, 0, 0);
                }
            }
            if (TYPE == 1) {
                const float* np = UN + (size_t)(chain * NCH + n) * 128 + lq * 32;
#pragma unroll
                for (int q = 0; q < 4; ++q) {
                    const u32x4 u = *(const u32x4*)(qin + (size_t)trow * QP + lq * 32 + q * 8); float f[8]; UNPACK8(u, f);
                    const f32x4 n0 = *(const f32x4*)(np + q * 8), n1 = *(const f32x4*)(np + q * 8 + 4);
                    den += f[0] * n0.x + f[1] * n0.y + f[2] * n0.z + f[3] * n0.w + f[4] * n1.x + f[5] * n1.y + f[6] * n1.z + f[7] * n1.w;
                }
                den += __shfl_xor(den, 16); den += __shfl_xor(den, 32);
                const float sc1 = 1.f / fmaxf(fabsf(den), 1.f);
#pragma unroll
                for (int et = 0; et < 8; ++et) tot[et] += oacc[et] * sc1;
            } else {
#pragma unroll
                for (int et = 0; et < 8; ++et) tot[et] += oacc[et];
            }
            __syncthreads();
        }
        float s1 = 0.f;
#pragma unroll
        for (int et = 0; et < 8; ++et) s1 += (tot[et].x + tot[et].y) + (tot[et].z + tot[et].w);
        s1 += __shfl_xor(s1, 16); s1 += __shfl_xor(s1, 32);
        const float mean = TYPE == 0 ? 0.f : s1 * (1.f / 128.f);
        float s2 = 0.f;
#pragma unroll
        for (int et = 0; et < 8; ++et) { tot[et] = tot[et] - mean; s2 += (tot[et].x * tot[et].x + tot[et].y * tot[et].y) + (tot[et].z * tot[et].z + tot[et].w * tot[et].w); }
        s2 += __shfl_xor(s2, 16); s2 += __shfl_xor(s2, 32);
        const float rstd = rsqrtf(s2 * (1.f / 128.f) + 1e-6f);
        const size_t rowi = (size_t)(r0 + trow);
#pragma unroll
        for (int et = 0; et < 8; ++et) {
            const int e = et * 16 + lq * 4;
            const f32x4 gg = *(const f32x4*)(ng + h * 128 + e);
            const u32x2 gu = *(const u32x2*)(pb + rowi * M::PITCH + M::GOFF + h * 128 + e);
            const float g0 = bflo(gu.x), g1 = bfhi(gu.x), g2 = bflo(gu.y), g3 = bfhi(gu.y);
            u32x2 o;
            float y0 = tot[et].x * rstd * gg.x * siluf(g0), y1 = tot[et].y * rstd * gg.y * siluf(g1), y2 = tot[et].z * rstd * gg.z * siluf(g2), y3 = tot[et].w * rstd * gg.w * siluf(g3);
            o.x = cvt_pk(y0, y1); o.y = cvt_pk(y2, y3);
            *(u32x2*)(brp + rowi * 1536 + pass * 512 + h * 128 + e) = o;
        }
        __syncthreads();
    }
}

template <int TYPE>
__device__ __forceinline__ void out_phase_s(const Params& P, int l, int pass, bool latent_only, char* lds) {
    typedef MX<TYPE> M; constexpr int DK = M::DK; constexpr int QP = M::QP; constexpr int NKK = DK / 32;
    const bf16_t* pb = (const bf16_t*)(ws_l(P) + WS_PBUF);
    const bf16_t* U = (const bf16_t*)(ws_l(P) + WS_SBUF); const float* UN = (const float*)(ws_l(P) + WS_UN);
    const float* small = (const float*)(ws_l(P) + WS_SMALL);
    bf16_t* brp = (bf16_t*)(ws_l(P) + WS_BR);
    bf16_t* vT = (bf16_t*)(lds + L_VT); bf16_t* qr = (bf16_t*)(lds + L_Q); bf16_t* kr = qr + 64 * QP; bf16_t* att = (bf16_t*)(lds + L_ATT);
    float* sc = (float*)(lds + L_SC);
    float* sn = sc + 256;
    float* rsv = sc + 512;
    float* part = sc + 640;
    const float* ng = P.in[TYPE == 1 ? I_MNG : I_RNG] + l * 512;
    const int NC = latent_only ? NCH - 4 : NCH; const int NU = NB * 4 * NC, VG = vgrid(), slot = bid_l();
    for (int u0 = 0; u0 < NU; u0 += VG) {
        int unit = u0 + slot; if (unit >= NU) unit = NU - 1;
        const int tid = tid_l(), lane = tid & 63, wid = tid >> 6, lr = lane & 15, lq = lane >> 4;
        const int c = unit % NC + (latent_only ? 4 : 0); const int rest = unit / NC; const int h = rest & 3, b = rest >> 2;
        const int r0 = rowbase(b, c);
        const int trow = wid * 16 + lr;
        const int chf = (b * 4 + h) * 2, nf = scan_index(0, c), nb = scan_index(1, c);
        const bf16_t* spf = U + (size_t)(chf * NCH + nf) * 128 * DK; const bf16_t* spb = U + (size_t)((chf + 1) * NCH + nb) * 128 * DK;
        bf16x8 fsf[2][NKK], fsb[2][NKK];
#pragma unroll
        for (int i = 0; i < 2; ++i)
#pragma unroll
            for (int kk = 0; kk < NKK; ++kk) {
                fsf[i][kk] = *(const bf16x8*)(spf + (size_t)((2 * wid + i) * 16 + lr) * DK + kk * 32 + lq * 8);
                fsb[i][kk] = *(const bf16x8*)(spb + (size_t)((2 * wid + i) * 16 + lr) * DK + kk * 32 + lq * 8);
            }
        u32x2 gu[4][2];
#pragma unroll
        for (int mt = 0; mt < 4; ++mt)
#pragma unroll
            for (int i = 0; i < 2; ++i) gu[mt][i] = *(const u32x2*)(pb + (size_t)(r0 + mt * 16 + lr) * M::PITCH + M::GOFF + h * 128 + (2 * wid + i) * 16 + lq * 4);
        if (TYPE == 1) {
            sn[tid] = UN[(size_t)((chf + (tid >> 7)) * NCH + ((tid >> 7) == 0 ? nf : nb)) * 128 + (tid & 127)];
            if (tid < 128) {
                const int dir = tid >> 6, t = tid & 63;
                const float fg = small[(size_t)(r0 + t) * 48 + 40 + dir * 4 + h] + P.in[I_FB][l * 8 + dir * 4 + h];
                float v = logsig(fg);
                if (dir == 0) {
#pragma unroll
                    for (int o = 1; o < 64; o <<= 1) { const float n = __shfl_up(v, o); if (t >= o) v += n; }
                } else {
#pragma unroll
                    for (int o = 1; o < 64; o <<= 1) { const float n = __shfl_down(v, o); if (t + o < 64) v += n; }
                }
                sc[dir * 64 + t] = v;
                sc[128 + dir * 64 + t] = small[(size_t)(r0 + t) * 48 + 32 + dir * 4 + h] + P.in[I_IB][l * 8 + dir * 4 + h];
            }
        } else {
            if (tid < 64) {
                const float lg0 = logsig(P.in[I_RDL][l * 8 + h]), lg1 = logsig(P.in[I_RDL][l * 8 + 4 + h]);
                sc[tid] = (float)(tid + 1) * lg0; sc[64 + tid] = (float)(64 - tid) * lg1;
            }
        }
        build_vT<TYPE>(pb, b, c, h, lds);
#pragma unroll
        for (int i = 0; i < 64 * M::NOC / NTHR; ++i) {
            const int pid = tid + i * NTHR, t = pid / M::NOC, oc = pid % M::NOC;
            float q8[8], k8[8];
            load_qk8<TYPE>(P, l, pb, b, c, t, h, oc, false, q8);
            load_qk8<TYPE>(P, l, pb, b, c, t, h, oc, true, k8);
            const float ks = TYPE == 1 ? 0.08838834764831845f : 0.125f;
            u32x4 oq, ok;
            oq.x = cvt_pk(q8[0], q8[1]); oq.y = cvt_pk(q8[2], q8[3]); oq.z = cvt_pk(q8[4], q8[5]); oq.w = cvt_pk(q8[6], q8[7]);
            ok.x = cvt_pk(k8[0] * ks, k8[1] * ks); ok.y = cvt_pk(k8[2] * ks, k8[3] * ks); ok.z = cvt_pk(k8[4] * ks, k8[5] * ks); ok.w = cvt_pk(k8[6] * ks, k8[7] * ks);
            *(u32x4*)(qr + (size_t)t * QP + oc * 8) = oq;
            *(u32x4*)(kr + (size_t)t * QP + oc * 8) = ok;
        }
        __syncthreads();
        f32x4 sacc[4];
#pragma unroll
        for (int nt = 0; nt < 4; ++nt) sacc[nt] = (f32x4){0.f, 0.f, 0.f, 0.f};
#pragma unroll
        for (int kk = 0; kk < NKK; ++kk) {
            const bf16x8 fq = *(const bf16x8*)(qr + (size_t)trow * QP + kk * 32 + lq * 8);
#pragma unroll
            for (int nt = 0; nt < 4; ++nt) {
                const bf16x8 fk = *(const bf16x8*)(kr + (size_t)(nt * 16 + lr) * QP + kk * 32 + lq * 8);
                sacc[nt] = __builtin_amdgcn_mfma_f32_16x16x32_bf16(fk, fq, sacc[nt], 0, 0, 0);
            }
        }
        {
            const float cft = sc[trow], cbt = sc[64 + trow];
            const float eft = __expf(cft), ebt = __expf(cbt);
            float af[4][4], ab[4][4]; float denf = 0.f, denb = 0.f;
#pragma unroll
            for (int nt = 0; nt < 4; ++nt) {
                const float av[4] = {sacc[nt].x, sacc[nt].y, sacc[nt].z, sacc[nt].w};
#pragma unroll
                for (int r = 0; r < 4; ++r) {
                    const int s_ = nt * 16 + lq * 4 + r;
                    const float argf = cft - sc[s_] + (TYPE == 1 ? sc[128 + s_] : 0.f), argb = cbt - sc[64 + s_] + (TYPE == 1 ? sc[192 + s_] : 0.f);
                    const float wf = s_ <= trow ? __expf(argf) : 0.f, wb = s_ >= trow ? __expf(argb) : 0.f;
                    af[nt][r] = av[r] * wf; ab[nt][r] = av[r] * wb; denf += af[nt][r]; denb += ab[nt][r];
                }
            }
            float scf = 1.f, scb = 1.f;
            if (TYPE == 1) {
                float qf = 0.f, qb = 0.f;
#pragma unroll
                for (int q = 0; q < 4; ++q) {
                    const u32x4 u = *(const u32x4*)(qr + (size_t)trow * QP + lq * 32 + q * 8); float f[8]; UNPACK8(u, f);
                    const float* a = sn + lq * 32 + q * 8; const float* bq = sn + 128 + lq * 32 + q * 8;
                    const f32x4 a0 = *(const f32x4*)a, a1 = *(const f32x4*)(a + 4), b0 = *(const f32x4*)bq, b1 = *(const f32x4*)(bq + 4);
                    qf += f[0] * a0.x + f[1] * a0.y + f[2] * a0.z + f[3] * a0.w + f[4] * a1.x + f[5] * a1.y + f[6] * a1.z + f[7] * a1.w;
                    qb += f[0] * b0.x + f[1] * b0.y + f[2] * b0.z + f[3] * b0.w + f[4] * b1.x + f[5] * b1.y + f[6] * b1.z + f[7] * b1.w;
                }
                denf += eft * qf; denb += ebt * qb;
                denf += __shfl_xor(denf, 16); denf += __shfl_xor(denf, 32);
                denb += __shfl_xor(denb, 16); denb += __shfl_xor(denb, 32);
                scf = 1.f / fmaxf(fabsf(denf), 1.f); scb = 1.f / fmaxf(fabsf(denb), 1.f);
            }
#pragma unroll
            for (int nt = 0; nt < 4; ++nt) {
                u32x2 o; o.x = cvt_pk(af[nt][0] * scf + ab[nt][0] * scb, af[nt][1] * scf + ab[nt][1] * scb); o.y = cvt_pk(af[nt][2] * scf + ab[nt][2] * scb, af[nt][3] * scf + ab[nt][3] * scb);
                *(u32x2*)(att + (size_t)trow * 80 + nt * 16 + lq * 4) = o;
            }
            if (lq == 0) { rsv[trow] = eft * scf; rsv[64 + trow] = ebt * scb; }
        }
        __syncthreads();
        f32x4 oacc[4][2];
#pragma unroll
        for (int mt = 0; mt < 4; ++mt)
#pragma unroll
            for (int i = 0; i < 2; ++i) oacc[mt][i] = (f32x4){0.f, 0.f, 0.f, 0.f};
#pragma unroll
        for (int kk = 0; kk < 2; ++kk) {
            bf16x8 fv[2];
#pragma unroll
            for (int i = 0; i < 2; ++i) fv[i] = *(const bf16x8*)(vT + (size_t)((2 * wid + i) * 16 + lr) * 80 + kk * 32 + lq * 8);
#pragma unroll
            for (int mt = 0; mt < 4; ++mt) {
                const bf16x8 fa = *(const bf16x8*)(att + (size_t)(mt * 16 + lr) * 80 + kk * 32 + lq * 8);
#pragma unroll
                for (int i = 0; i < 2; ++i) oacc[mt][i] = __builtin_amdgcn_mfma_f32_16x16x32_bf16(fv[i], fa, oacc[mt][i], 0, 0, 0);
            }
        }
#pragma unroll
        for (int dir = 0; dir < 2; ++dir) {
            f32x4 tmp[4][2];
#pragma unroll
            for (int mt = 0; mt < 4; ++mt)
#pragma unroll
                for (int i = 0; i < 2; ++i) tmp[mt][i] = (f32x4){0.f, 0.f, 0.f, 0.f};
#pragma unroll
            for (int kk = 0; kk < NKK; ++kk)
#pragma unroll
                for (int mt = 0; mt < 4; ++mt) {
                    const bf16x8 fq = *(const bf16x8*)(qr + (size_t)(mt * 16 + lr) * QP + kk * 32 + lq * 8);
#pragma unroll
                    for (int i = 0; i < 2; ++i) tmp[mt][i] = __builtin_amdgcn_mfma_f32_16x16x32_bf16(dir == 0 ? fsf[i][kk] : fsb[i][kk], fq, tmp[mt][i], 0, 0, 0);
                }
#pragma unroll
            for (int mt = 0; mt < 4; ++mt) {
                const float rs = rsv[dir * 64 + mt * 16 + lr];
#pragma unroll
                for (int i = 0; i < 2; ++i) oacc[mt][i] += tmp[mt][i] * rs;
            }
        }
#pragma unroll
        for (int mt = 0; mt < 4; ++mt) {
            float s1 = (oacc[mt][0].x + oacc[mt][0].y) + (oacc[mt][0].z + oacc[mt][0].w) + (oacc[mt][1].x + oacc[mt][1].y) + (oacc[mt][1].z + oacc[mt][1].w);
            float s2 = (oacc[mt][0].x * oacc[mt][0].x + oacc[mt][0].y * oacc[mt][0].y) + (oacc[mt][0].z * oacc[mt][0].z + oacc[mt][0].w * oacc[mt][0].w)
                     + (oacc[mt][1].x * oacc[mt][1].x + oacc[mt][1].y * oacc[mt][1].y) + (oacc[mt][1].z * oacc[mt][1].z + oacc[mt][1].w * oacc[mt][1].w);
            s1 += __shfl_xor(s1, 16); s1 += __shfl_xor(s1, 32); s2 += __shfl_xor(s2, 16); s2 += __shfl_xor(s2, 32);
            if (lq == 0) { part[(wid * 64 + mt * 16 + lr) * 2] = s1; part[(wid * 64 + mt * 16 + lr) * 2 + 1] = s2; }
        }
        __syncthreads();
#pragma unroll
        for (int mt = 0; mt < 4; ++mt) {
            const int t = mt * 16 + lr;
            float s1 = 0.f, s2 = 0.f;
#pragma unroll
            for (int w = 0; w < 4; ++w) { s1 += part[(w * 64 + t) * 2]; s2 += part[(w * 64 + t) * 2 + 1]; }
            const float mean = s1 * (1.f / 128.f);
            const float rstd = rsqrtf(fmaxf(s2 * (1.f / 128.f) - mean * mean, 0.f) + 1e-6f);
            const size_t rowi = (size_t)(r0 + t);
#pragma unroll
            for (int i = 0; i < 2; ++i) {
                const int e = (2 * wid + i) * 16 + lq * 4;
                const f32x4 gg = *(const f32x4*)(ng + h * 128 + e);
                const float g0 = bflo(gu[mt][i].x), g1 = bfhi(gu[mt][i].x), g2 = bflo(gu[mt][i].y), g3 = bfhi(gu[mt][i].y);
                u32x2 o;
                o.x = cvt_pk((oacc[mt][i].x - mean) * rstd * gg.x * siluf(g0), (oacc[mt][i].y - mean) * rstd * gg.y * siluf(g1));
                o.y = cvt_pk((oacc[mt][i].z - mean) * rstd * gg.z * siluf(g2), (oacc[mt][i].w - mean) * rstd * gg.w * siluf(g3));
                *(u32x2*)(brp + rowi * 1536 + pass * 512 + h * 128 + e) = o;
            }
        }
        __syncthreads();
    }
}

__device__ __forceinline__ void out_phase_g(const Params& P, int l, bool latent_only, char* lds) {
    typedef MX<0> M; constexpr int DK = 64, QP = 80;
    const bf16_t* pb = (const bf16_t*)(ws_l(P) + WS_PBUF);
    const bf16_t* U = (const bf16_t*)(ws_l(P) + WS_SBUF);
    const float* small = (const float*)(ws_l(P) + WS_SMALL);
    bf16_t* brp = (bf16_t*)(ws_l(P) + WS_BR);
    bf16_t* vT = (bf16_t*)(lds + L_VT); bf16_t* qin = (bf16_t*)(lds + L_Q); bf16_t* kin = qin + 64 * QP; bf16_t* att = (bf16_t*)(lds + L_ATT);
    float* cum = (float*)(lds + L_CUM); float* part = cum;
    const float* ng = P.in[I_GNG] + l * 512;
    const int NC = latent_only ? NCH - 4 : NCH; const int NU = NB * 4 * NC, VG = vgrid(), slot = bid_l();
    for (int u0 = 0; u0 < NU; u0 += VG) {
        int unit = u0 + slot; if (unit >= NU) unit = NU - 1;
        const int tid = tid_l(), lane = tid & 63, wid = tid >> 6, lr = lane & 15, lq = lane >> 4;
        const int c = unit % NC + (latent_only ? 4 : 0); const int rest = unit / NC; const int h = rest & 3, b = rest >> 2;
        const int r0 = rowbase(b, c);
        const int trow = wid * 16 + lr;
        const int chf = (b * 4 + h) * 2, nf = scan_index(0, c), nb = scan_index(1, c);
        const bf16_t* spf = U + (size_t)(chf * NCH + nf) * 128 * DK; const bf16_t* spb = U + (size_t)((chf + 1) * NCH + nb) * 128 * DK;
        bf16x8 fsf[2][2], fsb[2][2];
#pragma unroll
        for (int i = 0; i < 2; ++i)
#pragma unroll
            for (int kk = 0; kk < 2; ++kk) {
                fsf[i][kk] = *(const bf16x8*)(spf + (size_t)((2 * wid + i) * 16 + lr) * DK + kk * 32 + lq * 8);
                fsb[i][kk] = *(const bf16x8*)(spb + (size_t)((2 * wid + i) * 16 + lr) * DK + kk * 32 + lq * 8);
            }
        u32x2 gu[4][2];
#pragma unroll
        for (int mt = 0; mt < 4; ++mt)
#pragma unroll
            for (int i = 0; i < 2; ++i) gu[mt][i] = *(const u32x2*)(pb + (size_t)(r0 + mt * 16 + lr) * M::PITCH + M::GOFF + h * 128 + (2 * wid + i) * 16 + lq * 4);
        float qraw[2][8], kraw[2][8], apre[2][4];
#pragma unroll
        for (int i = 0; i < 2; ++i) {
            const int pid = tid + i * NTHR, t = pid >> 3, oc = pid & 7;
            load_qk8<0>(P, l, pb, b, c, t, h, oc, false, qraw[i]);
            load_qk8<0>(P, l, pb, b, c, t, h, oc, true, kraw[i]);
        }
#pragma unroll
        for (int dir = 0; dir < 2; ++dir)
#pragma unroll
            for (int k = 0; k < 4; ++k) { const int i = tid + k * NTHR; apre[dir][k] = small[(size_t)(r0 + (i >> 4)) * 48 + dir * 16 + (i & 15)]; }
        build_vT<0>(pb, b, c, h, lds);
        f32x4 oacc[4][2];
#pragma unroll
        for (int mt = 0; mt < 4; ++mt)
#pragma unroll
            for (int i = 0; i < 2; ++i) oacc[mt][i] = (f32x4){0.f, 0.f, 0.f, 0.f};
#pragma unroll
        for (int dir = 0; dir < 2; ++dir) {
            decay_setup<0>(P, l, b, c, h, dir, lds, apre[dir]);
#pragma unroll
            for (int i = 0; i < 2; ++i) {
                const int pid = tid + i * NTHR, t = pid >> 3, oc = pid & 7;
                float q8[8], k8[8];
#pragma unroll
                for (int j = 0; j < 8; ++j) { const float cv = cum[t * 64 + oc * 8 + j]; q8[j] = qraw[i][j] * (__expf(cv) * 0.125f); k8[j] = kraw[i][j] * __expf(-cv); }
                u32x4 oq, ok;
                oq.x = cvt_pk(q8[0], q8[1]); oq.y = cvt_pk(q8[2], q8[3]); oq.z = cvt_pk(q8[4], q8[5]); oq.w = cvt_pk(q8[6], q8[7]);
                ok.x = cvt_pk(k8[0], k8[1]); ok.y = cvt_pk(k8[2], k8[3]); ok.z = cvt_pk(k8[4], k8[5]); ok.w = cvt_pk(k8[6], k8[7]);
                *(u32x4*)(qin + (size_t)t * QP + oc * 8) = oq;
                *(u32x4*)(kin + (size_t)t * QP + oc * 8) = ok;
            }
            __syncthreads();
            f32x4 sacc[4];
#pragma unroll
            for (int nt = 0; nt < 4; ++nt) sacc[nt] = (f32x4){0.f, 0.f, 0.f, 0.f};
#pragma unroll
            for (int kk = 0; kk < 2; ++kk) {
                const bf16x8 fq = *(const bf16x8*)(qin + (size_t)trow * QP + kk * 32 + lq * 8);
#pragma unroll
                for (int nt = 0; nt < 4; ++nt) {
                    const bf16x8 fk = *(const bf16x8*)(kin + (size_t)(nt * 16 + lr) * QP + kk * 32 + lq * 8);
                    sacc[nt] = __builtin_amdgcn_mfma_f32_16x16x32_bf16(fk, fq, sacc[nt], 0, 0, 0);
                }
            }
#pragma unroll
            for (int nt = 0; nt < 4; ++nt) {
                const int s0 = nt * 16 + lq * 4;
                float a0 = sacc[nt].x, a1 = sacc[nt].y, a2 = sacc[nt].z, a3 = sacc[nt].w;
                if (dir == 0) { if (s0 + 0 > trow) a0 = 0.f; if (s0 + 1 > trow) a1 = 0.f; if (s0 + 2 > trow) a2 = 0.f; if (s0 + 3 > trow) a3 = 0.f; }
                else { if (s0 + 0 < trow) a0 = 0.f; if (s0 + 1 < trow) a1 = 0.f; if (s0 + 2 < trow) a2 = 0.f; if (s0 + 3 < trow) a3 = 0.f; }
                u32x2 o; o.x = cvt_pk(a0, a1); o.y = cvt_pk(a2, a3);
                *(u32x2*)(att + (size_t)trow * 80 + s0) = o;
            }
            __syncthreads();
#pragma unroll
            for (int kk = 0; kk < 2; ++kk) {
                bf16x8 fv[2];
#pragma unroll
                for (int i = 0; i < 2; ++i) fv[i] = *(const bf16x8*)(vT + (size_t)((2 * wid + i) * 16 + lr) * 80 + kk * 32 + lq * 8);
#pragma unroll
                for (int mt = 0; mt < 4; ++mt) {
                    const bf16x8 fa = *(const bf16x8*)(att + (size_t)(mt * 16 + lr) * 80 + kk * 32 + lq * 8);
                    const bf16x8 fq = *(const bf16x8*)(qin + (size_t)(mt * 16 + lr) * QP + kk * 32 + lq * 8);
#pragma unroll
                    for (int i = 0; i < 2; ++i) {
                        oacc[mt][i] = __builtin_amdgcn_mfma_f32_16x16x32_bf16(fv[i], fa, oacc[mt][i], 0, 0, 0);
                        oacc[mt][i] = __builtin_amdgcn_mfma_f32_16x16x32_bf16(dir == 0 ? fsf[i][kk] : fsb[i][kk], fq, oacc[mt][i], 0, 0, 0);
                    }
                }
            }
            __syncthreads();
        }
#pragma unroll
        for (int mt = 0; mt < 4; ++mt) {
            float s2 = (oacc[mt][0].x * oacc[mt][0].x + oacc[mt][0].y * oacc[mt][0].y) + (oacc[mt][0].z * oacc[mt][0].z + oacc[mt][0].w * oacc[mt][0].w)
                     + (oacc[mt][1].x * oacc[mt][1].x + oacc[mt][1].y * oacc[mt][1].y) + (oacc[mt][1].z * oacc[mt][1].z + oacc[mt][1].w * oacc[mt][1].w);
            s2 += __shfl_xor(s2, 16); s2 += __shfl_xor(s2, 32);
            if (lq == 0) part[wid * 64 + mt * 16 + lr] = s2;
        }
        __syncthreads();
#pragma unroll
        for (int mt = 0; mt < 4; ++mt) {
            const int t = mt * 16 + lr;
            const float s2 = (part[t] + part[64 + t]) + (part[128 + t] + part[192 + t]);
            const float rstd = rsqrtf(s2 * (1.f / 128.f) + 1e-6f);
            const size_t rowi = (size_t)(r0 + t);
#pragma unroll
            for (int i = 0; i < 2; ++i) {
                const int e = (2 * wid + i) * 16 + lq * 4;
                const f32x4 gg = *(const f32x4*)(ng + h * 128 + e);
                const float g0 = bflo(gu[mt][i].x), g1 = bfhi(gu[mt][i].x), g2 = bflo(gu[mt][i].y), g3 = bfhi(gu[mt][i].y);
                u32x2 o;
                o.x = cvt_pk(oacc[mt][i].x * rstd * gg.x * siluf(g0), oacc[mt][i].y * rstd * gg.y * siluf(g1));
                o.y = cvt_pk(oacc[mt][i].z * rstd * gg.z * siluf(g2), oacc[mt][i].w * rstd * gg.w * siluf(g3));
                *(u32x2*)(brp + rowi * 1536 + h * 128 + e) = o;
            }
        }
        __syncthreads();
    }
}

template <int NI, class F>
__device__ __forceinline__ void ctx_gemm(const bf16_t* A, int lda, const bf16_t* Bt, int ldb, int K, int N, const F& f, char* lds) {
    const int tid = tid_l(), lane = tid & 63, wid = tid >> 6, wm = wid >> 1, wn = wid & 1, lr = lane & 15, lq = lane >> 4;
    const int Nt = (N + 32 * NI - 1) / (32 * NI);
    const int total = 4 * Nt, VG = vgrid(), slot = bid_l();
    for (int t0 = 0; t0 < total; t0 += VG) {
        const int t = t0 + (VG - 1 - slot); if (t >= total) continue;
        const int tm = t & 3, tn = t >> 2;
        f32x4 acc[4][NI];
#pragma unroll
        for (int mi = 0; mi < 4; ++mi)
#pragma unroll
            for (int ni = 0; ni < NI; ++ni) acc[mi][ni] = (f32x4){0.f, 0.f, 0.f, 0.f};
        gemm_kloop<NI>(acc, A + (size_t)(RL + tm * 128) * lda, lda, Bt + (size_t)tn * (32 * NI) * ldb, ldb, K, lds);
#pragma unroll
        for (int mi = 0; mi < 4; ++mi)
#pragma unroll
            for (int ni = 0; ni < NI; ++ni) f(RL + tm * 128 + wm * 64 + mi * 16 + lr, tn * (32 * NI) + wn * (16 * NI) + ni * 16 + lq * 4, acc[mi][ni], 0);
    }
}
__device__ __forceinline__ void ctx_merge(const Params& P, char* lds) {
    const int tid = tid_l(), lane = tid & 63, wid = tid >> 6, wm = wid >> 1, wn = wid & 1, lr = lane & 15, lq = lane >> 4;
    const bf16_t* br = (const bf16_t*)(ws_l(P) + WS_BR); const bf16_t* wb = (const bf16_t*)(ws_l(P) + WS_WTBR);
    const bf16_t* gs = (const bf16_t*)(ws_l(P) + WS_GS); bf16_t* mb = (bf16_t*)(ws_l(P) + WS_MB);
    const int total = 64, VG = vgrid(), slot = bid_l();
    for (int t0 = 0; t0 < total; t0 += VG) {
        const int t = t0 + (VG - 1 - slot); if (t >= total) continue;
        const int tm = t & 3, tn = t >> 2;
        f32x4 m[4][2];
#pragma unroll
        for (int mi = 0; mi < 4; ++mi)
#pragma unroll
            for (int ni = 0; ni < 2; ++ni) m[mi][ni] = (f32x4){0.f, 0.f, 0.f, 0.f};
#pragma unroll 1
        for (int j = 0; j < 3; ++j) {
            f32x4 acc[4][2];
#pragma unroll
            for (int mi = 0; mi < 4; ++mi)
#pragma unroll
                for (int ni = 0; ni < 2; ++ni) acc[mi][ni] = (f32x4){0.f, 0.f, 0.f, 0.f};
            gemm_kloop<2>(acc, br + (size_t)(RL + tm * 128) * 1536 + j * 512, 1536, wb + ((size_t)j * 1024 + tn * 64) * 512, 512, 512, lds);
#pragma unroll
            for (int mi = 0; mi < 4; ++mi)
#pragma unroll
                for (int ni = 0; ni < 2; ++ni) {
                    const int r = RL + tm * 128 + wm * 64 + mi * 16 + lr, c = tn * 64 + wn * 32 + ni * 16 + lq * 4;
                    const u32x2 g = *(const u32x2*)(gs + (size_t)r * 3072 + j * 1024 + c);
                    m[mi][ni].x += acc[mi][ni].x * bflo(g.x); m[mi][ni].y += acc[mi][ni].y * bfhi(g.x);
                    m[mi][ni].z += acc[mi][ni].z * bflo(g.y); m[mi][ni].w += acc[mi][ni].w * bfhi(g.y);
                }
        }
#pragma unroll
        for (int mi = 0; mi < 4; ++mi)
#pragma unroll
            for (int ni = 0; ni < 2; ++ni) {
                const int r = RL + tm * 128 + wm * 64 + mi * 16 + lr, c = tn * 64 + wn * 32 + ni * 16 + lq * 4;
                u32x2 o; o.x = cvt_pk(m[mi][ni].x, m[mi][ni].y); o.y = cvt_pk(m[mi][ni].z, m[mi][ni].w);
                *(u32x2*)(mb + (size_t)r * 1024 + c) = o;
            }
    }
}


#define XB_TMO      128
#define XB_XCNT(j)  (256  + 64 * (j))
#define XB_XSUB(j)  (1280 + 64 * (j))
#define XB_XGEN(j)  (2304 + 64 * (j))
#define XB_TOP      3328
#define XB_TOPGEN   3392
#define XCD_BAR_WORDS 3456
#define XB_SPIN_CAP (1u << 18)
__device__ __forceinline__ unsigned xb_ld(unsigned* p)              { return __hip_atomic_load(p, __ATOMIC_RELAXED, __HIP_MEMORY_SCOPE_AGENT); }
__device__ __forceinline__ unsigned xb_add(unsigned* p, unsigned v) { return __hip_atomic_fetch_add(p, v, __ATOMIC_RELAXED, __HIP_MEMORY_SCOPE_AGENT); }
__device__ __forceinline__ unsigned xb_xcc_id() { return (unsigned)__builtin_amdgcn_s_getreg((3 << 11) | 20) & 0xFu; }
#define XB_SPIN(cond, bar) do { unsigned _sp = 0; while (cond) { __builtin_amdgcn_s_sleep(1); \
    if ((++_sp & 255u) == 0u) { if (xb_ld(&(bar)[XB_TMO])) break; if (_sp > XB_SPIN_CAP) { atomicAdd(&(bar)[XB_TMO], 1u); break; } } } } while (0)
struct XcdBarrier { unsigned* bar; unsigned x; volatile LAS unsigned* st; };
__device__ __forceinline__ XcdBarrier xcd_barrier_post(unsigned* bar, volatile LAS unsigned* st) {
    XcdBarrier b; b.bar = bar; b.x = xb_xcc_id(); b.st = st;
    if (threadIdx.x == 0) (void)xb_add(&bar[XB_XCNT(b.x)], 1u);
    return b;
}
__device__ __forceinline__ void xcd_barrier_complete(unsigned* bar, unsigned x, unsigned& nloc, unsigned& nx) {
    const unsigned G = gridDim.x * gridDim.y * gridDim.z;
    unsigned sum, cnt, mine, sp = 0u;
    for (;;) {
        sum = 0u; cnt = 0u; mine = 0u;
#pragma unroll
        for (unsigned j = 0; j < 16; ++j) { const unsigned c = xb_ld(&bar[XB_XCNT(j)]); sum += c; cnt += (c > 0u) ? 1u : 0u; mine = (j == x) ? c : mine; }
        if (sum == G) break;
        __builtin_amdgcn_s_sleep(1);
        if ((++sp & 255u) == 0u) { if (xb_ld(&bar[XB_TMO])) break; if (sp > XB_SPIN_CAP) { atomicAdd(&bar[XB_TMO], 1u); break; } }
    }
    nloc = mine > 0u ? mine : 1u; nx = cnt > 0u ? cnt : 1u;
}
__device__ __forceinline__ void xcd_barrier(const XcdBarrier& b) {
    asm volatile("s_waitcnt vmcnt(0)" ::: "memory");
    __syncthreads();
    if (threadIdx.x == 0) {
        unsigned* bar = b.bar;
        __builtin_amdgcn_s_waitcnt(0);
        unsigned nloc = b.st[0], nx = b.st[1];
        if (nloc == 0u) { xcd_barrier_complete(bar, b.x, nloc, nx); b.st[0] = nloc; b.st[1] = nx; }
        const unsigned old = xb_add(&bar[XB_XSUB(b.x)], 1u);
        const unsigned gen = old / nloc;
        if (old + 1u == (gen + 1u) * nloc) {
            __builtin_amdgcn_fence(__ATOMIC_RELEASE, "agent");
            asm volatile("s_waitcnt vmcnt(0)" ::: "memory");
            const unsigned og = xb_add(&bar[XB_TOP], 1u);
            const unsigned tg = og / nx;
            if (og + 1u == (tg + 1u) * nx) xb_add(&bar[XB_TOPGEN], 1u);
            else XB_SPIN(xb_ld(&bar[XB_TOPGEN]) == tg, bar);
            __builtin_amdgcn_fence(__ATOMIC_ACQUIRE, "agent");
            xb_add(&bar[XB_XGEN(b.x)], 1u);
            asm volatile("s_waitcnt vmcnt(0)" ::: "memory");
        } else {
            XB_SPIN(xb_ld(&bar[XB_XGEN(b.x)]) == gen, bar);
            __builtin_amdgcn_fence(__ATOMIC_ACQUIRE, "agent");
            asm volatile("s_waitcnt vmcnt(0)" ::: "memory");
        }
    }
    __syncthreads();
}

__global__ void __launch_bounds__(512, 2) fwd_kernel(Params P) {
    extern __shared__ __attribute__((aligned(16))) unsigned char lds_raw[];
    cg::grid_group grid = cg::this_grid();
    LAS unsigned char* ldsb = (LAS unsigned char*)lds_raw;
#define LDSH ((char*)lds_raw + __builtin_amdgcn_readfirstlane(threadIdx.x >> 8) * HALF_LDS)
    volatile LAS unsigned* bst = (volatile LAS unsigned*)(ldsb + 2 * HALF_LDS);
    if (threadIdx.x < 2) bst[threadIdx.x] = 0u;
    __syncthreads();
    XcdBarrier xbar = xcd_barrier_post((unsigned*)(P.ws + WS_BAR), bst);
    int ph = 0;
#define PHASE_BEGIN if (ph >= P.lo && ph < P.hi) {
#define PHASE_END } ++ph; if (P.coop && ph > P.lo && ph < P.hi) { if (ph == 1) grid.sync(); else xcd_barrier(xbar); }

    PHASE_BEGIN
        {
        { const int VG = vgrid(), slot = bid_l();
          for (int i0 = 0; i0 < 384; i0 += VG) { int it = i0 + slot; if (it >= 384) it = 383; mods_task(P, it, LDSH); } }
        if (bid_l() == vgrid() - 1) rope_task(P);
        convert_all(P, 0, LDSH);
        }
    PHASE_END

    const XPtr Xin{(float*)P.in[I_X], (float*)P.in[I_CTX]};
    const XPtr Xcur{P.out, (float*)(P.ws + WS_CTXX)};

    for (int l = 0; l < 2; ++l) {
        const XPtr Xold = l == 0 ? Xin : Xcur;
        const bool ctx_on = (l == 0);
        PHASE_BEGIN
            {
            if (l == 1) convert_all(P, 1, LDSH);
            norm_phase(P, Xold, P.in[I_N1G] + l * D, l, 0, R);
            }
        PHASE_END
        PHASE_BEGIN
            const bf16_t* hb = (const bf16_t*)(ws_l(P) + WS_HBUF); const bf16_t* wt = (const bf16_t*)(ws_l(P) + WS_WTIN);
            EpiP e{(bf16_t*)(ws_l(P) + WS_PBUF), 1536, 1536, (float*)(ws_l(P) + WS_SMALL)};
            {
            big_gemm(ldsb, hb, 1024, wt, 1024, 1792, e);
            ctx_gemm<4>(hb, 1024, wt, 1024, 1024, 1664, e, LDSH); }
        PHASE_END
        PHASE_BEGIN u_phase<0>(P, l, LDSH); PHASE_END
        PHASE_BEGIN scan_phase<64, false>(P); PHASE_END
        PHASE_BEGIN out_phase_g(P, l, !ctx_on, LDSH); PHASE_END
        PHASE_BEGIN
            const bf16_t* hb = (const bf16_t*)(ws_l(P) + WS_HBUF); const bf16_t* wt = (const bf16_t*)(ws_l(P) + WS_WTIN) + (size_t)1792 * 1024;
            EpiP e{(bf16_t*)(ws_l(P) + WS_PBUF), 2048, 2048, nullptr};
            {
            big_gemm(ldsb, hb, 1024, wt, 1024, 2048, e);
            ctx_gemm<2>(hb, 1024, wt, 1024, 1024, 2048, e, LDSH); }
        PHASE_END
        PHASE_BEGIN u_phase_s<1>(P, l, LDSH); PHASE_END
        PHASE_BEGIN scan_phase<128, true>(P); PHASE_END
        PHASE_BEGIN out_phase_s<1>(P, l, 1, !ctx_on, LDSH); PHASE_END
        PHASE_BEGIN
            const bf16_t* hb = (const bf16_t*)(ws_l(P) + WS_HBUF); const bf16_t* wt = (const bf16_t*)(ws_l(P) + WS_WTIN) + (size_t)3840 * 1024;
            EpiP e{(bf16_t*)(ws_l(P) + WS_PBUF), 1536, 1536, nullptr};
            {
            big_gemm(ldsb, hb, 1024, wt, 1024, 1536, e);
            ctx_gemm<4>(hb, 1024, wt, 1024, 1024, 1536, e, LDSH); }
        PHASE_END
        PHASE_BEGIN u_phase_s<2>(P, l, LDSH); PHASE_END
        PHASE_BEGIN scan_phase<64, false>(P); PHASE_END
        PHASE_BEGIN out_phase_s<2>(P, l, 2, !ctx_on, LDSH); PHASE_END
        PHASE_BEGIN
            const bf16_t* hb = (const bf16_t*)(ws_l(P) + WS_HBUF); const bf16_t* wt = (const bf16_t*)(ws_l(P) + WS_WTIN) + (size_t)5376 * 1024;
            EpiSig e{(bf16_t*)(ws_l(P) + WS_GS)};
            {
            big_gemm(ldsb, hb, 1024, wt, 1024, 3072, e);
            if (ctx_on) ctx_gemm<2>(hb, 1024, wt, 1024, 1024, 3072, e, LDSH); }
        PHASE_END
        PHASE_BEGIN
            {   pg8::Gemm g{(const bf16_t*)(ws_l(P) + WS_BR), (const bf16_t*)(ws_l(P) + WS_WTBR), 1536, 512};
                pg8::MergeOrder S; S.S.init(RL, 1024, (int)gridDim.x, (int)blockIdx.x);
                pg8::Epi<EpiMerge> E{EpiMerge{(const bf16_t*)(ws_l(P) + WS_GS), (bf16_t*)(ws_l(P) + WS_MB)}};
                pg8::gemm_phase(ldsb, g, S, E);
                __syncthreads(); }
            if (ctx_on) ctx_merge(P, LDSH);
        PHASE_END
        PHASE_BEGIN
            const float* mods_l = (const float*)(ws_l(P) + WS_MODS) + (size_t)l * 3 * 6144;
            EpiRes e{Xold, Xcur, mods_l, 2};
            big_gemm(ldsb, (const bf16_t*)(ws_l(P) + WS_MB), 1024, (const bf16_t*)(ws_l(P) + WS_WTO), 1024, 1024, e);
            if (ctx_on) ctx_gemm<1>((const bf16_t*)(ws_l(P) + WS_MB), 1024, (const bf16_t*)(ws_l(P) + WS_WTO), 1024, 1024, 1024, e, LDSH);
        PHASE_END
        PHASE_BEGIN norm_phase(P, Xcur, P.in[I_N2G] + l * D, l, 3, ctx_on ? R : RL); PHASE_END
        PHASE_BEGIN
            const bf16_t* hb = (const bf16_t*)(ws_l(P) + WS_HBUF);
            EpiRelu2 e{(bf16_t*)(ws_l(P) + WS_HID)};
            {
            big_gemm(ldsb, hb, 1024, (const bf16_t*)(ws_l(P) + WS_WTUP), 1024, 4096, e);
            if (ctx_on) ctx_gemm<2>(hb, 1024, (const bf16_t*)(ws_l(P) + WS_WTUP), 1024, 1024, 4096, e, LDSH); }
        PHASE_END
        PHASE_BEGIN
            const float* mods_l = (const float*)(ws_l(P) + WS_MODS) + (size_t)l * 3 * 6144;
            EpiRes e{Xcur, Xcur, mods_l, 5};
            big_gemm(ldsb, (const bf16_t*)(ws_l(P) + WS_HID), 4096, (const bf16_t*)(ws_l(P) + WS_WTDN), 4096, 1024, e);
            if (ctx_on) ctx_gemm<1>((const bf16_t*)(ws_l(P) + WS_HID), 4096, (const bf16_t*)(ws_l(P) + WS_WTDN), 4096, 4096, 1024, e, LDSH);
        PHASE_END
    }
    PHASE_BEGIN final_norm_phase(P); PHASE_END
#undef PHASE_BEGIN
#undef PHASE_END
}
constexpr int NPHASES = 1 + 2 * 19 + 1;

extern "C" void kernel_launch(void* const* d_in, const int* in_sizes, int n_in, void* d_out, int out_size, void* d_ws, size_t ws_size, hipStream_t stream) {
    static int grid = 0;
    if (grid == 0) {
        if (n_in != 23 || ws_size < WS_END || out_size != NB * SEQ * D) { fprintf(stderr, "kernel_launch: unexpected sizes n_in %d ws %zu (need %zu) out %d\n", n_in, ws_size, (size_t)WS_END, out_size); grid = -1; return; }
        int dev = 0, cus = 0, per_cu = 0;
        if (hipGetDevice(&dev) != hipSuccess || hipDeviceGetAttribute(&cus, hipDeviceAttributeMultiprocessorCount, dev) != hipSuccess) { grid = -1; return; }
        if (hipFuncSetAttribute((const void*)fwd_kernel, hipFuncAttributeMaxDynamicSharedMemorySize, LDS_BYTES) != hipSuccess) { fprintf(stderr, "kernel_launch: hipFuncSetAttribute failed\n"); grid = -1; return; }
        if (hipOccupancyMaxActiveBlocksPerMultiprocessor(&per_cu, (const void*)fwd_kernel, 512, LDS_BYTES) != hipSuccess || per_cu < 1) { fprintf(stderr, "kernel_launch: occupancy query failed (%d)\n", per_cu); grid = -1; return; }
        grid = cus;
        grid -= grid % 8;
    }
    if (grid < 0) return;
    if (hipMemsetAsync((char*)d_ws + WS_BAR, 0, (size_t)3456 * 4, stream) != hipSuccess) { fprintf(stderr, "kernel_launch: memset failed\n"); return; }
    Params p{};
    for (int i = 0; i < 23; ++i) p.in[i] = (const float*)d_in[i];
    p.out = (float*)d_out; p.ws = (unsigned char*)d_ws;
    p.lo = 0; p.hi = NPHASES; p.coop = 1;
    void* args[] = {&p};
    hipError_t e = hipLaunchCooperativeKernel((const void*)fwd_kernel, dim3(grid), dim3(512), args, LDS_BYTES, stream);
    if (e != hipSuccess) fprintf(stderr, "kernel_launch: cooperative launch failed: %s (grid %d)\n", hipGetErrorString(e), grid);
}
```

```cpp
#include <hip/hip_runtime.h>
#include <hip/hip_cooperative_groups.h>
#include <stdint.h>
#include <stdio.h>
namespace cg = cooperative_groups;

#define LAS __attribute__((address_space(3)))
typedef unsigned short bf16_t;
typedef short bf16x8 __attribute__((ext_vector_type(8)));
typedef float f32x4 __attribute__((ext_vector_type(4)));
typedef unsigned u32x4 __attribute__((ext_vector_type(4)));
typedef unsigned u32x2 __attribute__((ext_vector_type(2)));

constexpr int D = 1024, NB = 2, SEQ = 8192, CTX = 256, RB = SEQ + CTX, R = NB * RB, RL = NB * SEQ, NCH = RB / 64, FF = 4096;
constexpr int INW = 8240;
constexpr int NTHR = 256;
constexpr int HALF_LDS = 73728;
constexpr int LDS_BYTES = 2 * HALF_LDS + 16;

constexpr size_t WS_WTIN = 0;
constexpr size_t WS_WTBR = WS_WTIN + (size_t)8448 * 1024 * 2;
constexpr size_t WS_WTO = WS_WTBR + (size_t)3 * 1024 * 512 * 2;
constexpr size_t WS_WTUP = WS_WTO + (size_t)1024 * 1024 * 2;
constexpr size_t WS_WTDN = WS_WTUP + (size_t)4096 * 1024 * 2;
constexpr size_t WS_HBUF = WS_WTDN + (size_t)4096 * 1024 * 2;
constexpr size_t WS_PBUF = WS_HBUF + (size_t)R * 1024 * 2;
constexpr size_t WS_SBUF = WS_PBUF + (size_t)R * 2048 * 2;
constexpr size_t WS_BR = WS_SBUF + (size_t)R * 2048 * 2;
constexpr size_t WS_CTXX = WS_BR + (size_t)R * 1536 * 2;
constexpr size_t WS_SMALL = WS_CTXX + (size_t)512 * 1024 * 4;
constexpr size_t WS_DEC = WS_SMALL + (size_t)R * 48 * 4;
constexpr size_t WS_UN = WS_DEC + (size_t)16 * NCH * 128 * 4;
constexpr size_t WS_MODS = WS_UN + (size_t)16 * NCH * 128 * 4;
constexpr size_t WS_ROPE = WS_MODS + (size_t)2 * 3 * 6144 * 4;
constexpr size_t WS_BAR = WS_ROPE + (size_t)(128 + 64) * 16 * 2 * 4;
constexpr size_t WS_END = WS_BAR + (size_t)3456 * 4;
constexpr size_t WS_GS = WS_PBUF;
constexpr size_t WS_MB = WS_PBUF + (size_t)R * 3072 * 2;
constexpr size_t WS_HID = WS_PBUF;

struct Params { const float* in[23]; float* out; unsigned char* ws; int lo, hi, coop, pad; };

__device__ __forceinline__ int tid_l() { int t = threadIdx.x & 255; asm volatile("" : "+v"(t)); return t; }
__device__ __forceinline__ int bid_l() { int t = blockIdx.x * 2 + (__builtin_amdgcn_readfirstlane(threadIdx.x >> 8)); asm volatile("" : "+s"(t)); return t; }
__device__ __forceinline__ int vgrid() { return gridDim.x * 2; }
__device__ __forceinline__ unsigned char* ws_l(const Params& P) { unsigned char* w = P.ws; asm volatile("" : "+s"(w)); return w; }
enum { I_X = 0, I_C, I_CTX, I_CCTX, I_N1G, I_N2G, I_WADA, I_BADA, I_WIN, I_A2, I_ABIAS, I_GNG, I_CONV, I_IB, I_FB, I_MNG, I_RDL, I_RNG, I_WBR, I_WO, I_WUP, I_WDN, I_FG };

typedef __bf16 bf16x2_t __attribute__((ext_vector_type(2)));
typedef float f32x2 __attribute__((ext_vector_type(2)));
__device__ __forceinline__ unsigned cvt_pk(float lo, float hi) { f32x2 v = {lo, hi}; bf16x2_t b = __builtin_convertvector(v, bf16x2_t); return __builtin_bit_cast(unsigned, b); }
__device__ __forceinline__ float bflo(unsigned u) { return __uint_as_float(u << 16); }
__device__ __forceinline__ float bfhi(unsigned u) { return __uint_as_float(u & 0xffff0000u); }
__device__ __forceinline__ float wave_sum(float v) {
#pragma unroll
    for (int o = 32; o > 0; o >>= 1) v += __shfl_xor(v, o);
    return v;
}
__device__ __forceinline__ float logsig(float x) { return fminf(x, 0.f) - log1pf(__expf(-fabsf(x))); }
__device__ __forceinline__ float siluf(float x) { return x * __builtin_amdgcn_rcpf(1.f + __expf(-x)); }
__device__ __forceinline__ float sigmf(float x) { return __builtin_amdgcn_rcpf(1.f + __expf(-x)); }

struct XPtr { float* lat; float* ctx; };
__device__ __forceinline__ float* xrow(const XPtr& X, int r) { return r < RL ? X.lat + (size_t)r * D : X.ctx + (size_t)(r - RL) * D; }
__device__ __forceinline__ int modidx(int r) { return r < SEQ ? 0 : (r < RL ? 1 : 2); }
__device__ __forceinline__ int rowbase(int b, int c) { return c < 4 ? RL + b * CTX + c * 64 : b * SEQ + (c - 4) * 64; }

#define UNPACK8(u, f) do { f[0] = bflo(u.x); f[1] = bfhi(u.x); f[2] = bflo(u.y); f[3] = bfhi(u.y); f[4] = bflo(u.z); f[5] = bfhi(u.z); f[6] = bflo(u.w); f[7] = bfhi(u.w); } while (0)

__device__ __forceinline__ void mods_task(const Params& P, int task, char* lds) {
    float* s = (float*)lds;
    float* red = (float*)(lds + 12288);
    const int tid = tid_l();
    const int l = task / 192, col0 = (task % 192) * 32;
    const float* c = P.in[I_C]; const float* cc = P.in[I_CCTX];
    for (int i = tid; i < 3072; i += NTHR) { const int v = i >> 10, k = i & 1023; const float cv = v < 2 ? c[v * 1024 + k] : cc[k]; s[i] = siluf(cv); }
    __syncthreads();
    const int col = tid & 31, kg = tid >> 5;
    const float* w = P.in[I_WADA] + (size_t)l * D * 6144 + col0 + col;
    float a0 = 0.f, a1 = 0.f, a2 = 0.f;
#pragma unroll 32
    for (int k = kg * 128; k < kg * 128 + 128; ++k) { const float wv = w[(size_t)k * 6144]; a0 += s[k] * wv; a1 += s[1024 + k] * wv; a2 += s[2048 + k] * wv; }
    red[(kg * 32 + col) * 3 + 0] = a0; red[(kg * 32 + col) * 3 + 1] = a1; red[(kg * 32 + col) * 3 + 2] = a2;
    __syncthreads();
    if (tid < 96) {
        const int v = tid >> 5, c2 = tid & 31; float sum = 0.f;
#pragma unroll
        for (int g = 0; g < 8; ++g) sum += red[(g * 32 + c2) * 3 + v];
        sum += P.in[I_BADA][l * 6144 + col0 + c2];
        ((float*)(ws_l(P) + WS_MODS))[(l * 3 + v) * 6144 + col0 + c2] = sum;
    }
    __syncthreads();
}

__device__ __forceinline__ void rope_task(const Params& P) {
    float* tab = (float*)(ws_l(P) + WS_ROPE);
    for (int i = tid_l(); i < 192 * 16; i += NTHR) {
        const int pos = i >> 4, f = i & 15;
        const float inv = exp2f(-(float)f * (13.287712379549449f / 16.f));
        const float p = pos < 128 ? (float)pos : (float)(pos - 128);
        const float ang = p * inv;
        const float cs = cosf(ang), sn = sinf(ang);
        if (pos < 128) { tab[pos * 16 + f] = cs; tab[2048 + pos * 16 + f] = sn; }
        else { tab[4096 + (pos - 128) * 16 + f] = cs; tab[4096 + 1024 + (pos - 128) * 16 + f] = sn; }
    }
}

__device__ __forceinline__ void transpose_tile(const float* src, int ldsrc, int k0, int n0src, int nvalid, bf16_t* dst, int ldd, int drow0, char* lds) {
    float* tile = (float*)lds;
    const int tid = tid_l(), nl = tid & 63, kq = tid >> 6;
    float v[32];
#pragma unroll
    for (int i = 0; i < 32; ++i) v[i] = nl < nvalid ? src[(size_t)(k0 + kq + 4 * i) * ldsrc + n0src + nl] : 0.f;
#pragma unroll
    for (int i = 0; i < 32; ++i) tile[(kq + 4 * i) * 65 + nl] = v[i];
    __syncthreads();
    const int n = tid >> 2, ks = (tid & 3) * 32;
    if (n < nvalid) {
        u32x4* dp = (u32x4*)(dst + (size_t)(drow0 + n) * ldd + k0 + ks);
#pragma unroll
        for (int q = 0; q < 4; ++q) {
            u32x4 o;
            o.x = cvt_pk(tile[(ks + 8 * q + 0) * 65 + n], tile[(ks + 8 * q + 1) * 65 + n]); o.y = cvt_pk(tile[(ks + 8 * q + 2) * 65 + n], tile[(ks + 8 * q + 3) * 65 + n]);
            o.z = cvt_pk(tile[(ks + 8 * q + 4) * 65 + n], tile[(ks + 8 * q + 5) * 65 + n]); o.w = cvt_pk(tile[(ks + 8 * q + 6) * 65 + n], tile[(ks + 8 * q + 7) * 65 + n]);
            dp[q] = o;
        }
    }
    __syncthreads();
}

constexpr int CONV_TILES = 192 + 8 + 8 + 256 + 192 + 384 + 192 + 128 + 512 + 512;
__device__ __forceinline__ void convert_tile(const Params& P, int l, int it, char* lds) {
    const float* win = P.in[I_WIN] + (size_t)l * D * INW;
    bf16_t* wtin = (bf16_t*)(ws_l(P) + WS_WTIN);
    int r = it;
    if (r < 192) { const int kt = r / 24, nt = r % 24; transpose_tile(win, INW, kt * 128, nt * 64, 64, wtin, 1024, nt * 64, lds); return; } r -= 192;
    if (r < 8) { transpose_tile(win, INW, r * 128, 1536, 32, wtin, 1024, 1536, lds); return; } r -= 8;
    if (r < 8) { transpose_tile(win, INW, r * 128, 3616, 16, wtin, 1024, 1568, lds); return; } r -= 8;
    if (r < 256) { const int kt = r / 32, nt = r % 32; transpose_tile(win, INW, kt * 128, 1568 + nt * 64, 64, wtin, 1024, 1792 + nt * 64, lds); return; } r -= 256;
    if (r < 192) { const int kt = r / 24, nt = r % 24; transpose_tile(win, INW, kt * 128, 3632 + nt * 64, 64, wtin, 1024, 3840 + nt * 64, lds); return; } r -= 192;
    if (r < 384) { const int kt = r / 48, nt = r % 48; transpose_tile(win, INW, kt * 128, 5168 + nt * 64, 64, wtin, 1024, 5376 + nt * 64, lds); return; } r -= 384;
    if (r < 192) { const int j = r / 64, q = r % 64, kt = q / 16, nt = q % 16;
        transpose_tile(P.in[I_WBR] + ((size_t)l * 3 + j) * 512 * 1024, 1024, kt * 128, nt * 64, 64, (bf16_t*)(ws_l(P) + WS_WTBR), 512, j * 1024 + nt * 64, lds); return; } r -= 192;
    if (r < 128) { const int kt = r / 16, nt = r % 16; transpose_tile(P.in[I_WO] + (size_t)l * D * D, 1024, kt * 128, nt * 64, 64, (bf16_t*)(ws_l(P) + WS_WTO), 1024, nt * 64, lds); return; } r -= 128;
    if (r < 512) { const int kt = r / 64, nt = r % 64; transpose_tile(P.in[I_WUP] + (size_t)l * D * FF, 4096, kt * 128, nt * 64, 64, (bf16_t*)(ws_l(P) + WS_WTUP), 1024, nt * 64, lds); return; } r -= 512;
    { const int kt = r / 16, nt = r % 16; transpose_tile(P.in[I_WDN] + (size_t)l * FF * D, 1024, kt * 128, nt * 64, 64, (bf16_t*)(ws_l(P) + WS_WTDN), 4096, nt * 64, lds); }
}
__device__ __forceinline__ void convert_all(const Params& P, int l, char* lds) {
    const int VG = vgrid(), slot = bid_l();
    static_assert(CONV_TILES % 2 == 0, "both halves of a workgroup must be active together");
    for (int i0 = 0; i0 < CONV_TILES; i0 += VG) { const int it = i0 + slot; if (it >= CONV_TILES) continue; convert_tile(P, l, it, lds); }
}

__device__ __forceinline__ void norm_phase(const Params& P, XPtr X, const float* g, int l, int sidx, int nrows) {
    const int lane = tid_l() & 63; const int gw = bid_l() * 4 + (tid_l() >> 6), ngw = vgrid() * 4;
    bf16_t* hb = (bf16_t*)(ws_l(P) + WS_HBUF);
    const float* mods = (const float*)(ws_l(P) + WS_MODS) + (size_t)l * 3 * 6144;
    for (int r = gw; r < nrows; r += 2 * ngw) {
        const int r1 = r + ngw; const bool has1 = r1 < nrows; const int rr1 = has1 ? r1 : r;
        const f32x4* xa = (const f32x4*)xrow(X, r); const f32x4* xb = (const f32x4*)xrow(X, rr1);
        f32x4 va[4], vb[4]; float sa_ = 0.f, sb_ = 0.f;
#pragma unroll
        for (int j = 0; j < 4; ++j) { va[j] = xa[lane + 64 * j]; vb[j] = xb[lane + 64 * j]; }
#pragma unroll
        for (int j = 0; j < 4; ++j) { sa_ += va[j].x * va[j].x + va[j].y * va[j].y + va[j].z * va[j].z + va[j].w * va[j].w; sb_ += vb[j].x * vb[j].x + vb[j].y * vb[j].y + vb[j].z * vb[j].z + vb[j].w * vb[j].w; }
        sa_ = wave_sum(sa_); sb_ = wave_sum(sb_);
        const float rsa = rsqrtf(sa_ * (1.f / 1024.f) + 1e-6f), rsb = rsqrtf(sb_ * (1.f / 1024.f) + 1e-6f);
        const float* mda = mods + modidx(r) * 6144; const float* mdb = mods + modidx(rr1) * 6144;
#pragma unroll
        for (int j = 0; j < 4; ++j) {
            const int col = (lane + 64 * j) * 4;
            const f32x4 gg = *(const f32x4*)(g + col);
            { const f32x4 sh = *(const f32x4*)(mda + sidx * 1024 + col), sc = *(const f32x4*)(mda + (sidx + 1) * 1024 + col);
              const f32x4 hh = va[j] * rsa * gg * (sc + 1.f) + sh; u32x2 o; o.x = cvt_pk(hh.x, hh.y); o.y = cvt_pk(hh.z, hh.w); *(u32x2*)(hb + (size_t)r * 1024 + col) = o; }
            if (has1) { const f32x4 sh = *(const f32x4*)(mdb + sidx * 1024 + col), sc = *(const f32x4*)(mdb + (sidx + 1) * 1024 + col);
              const f32x4 hh = vb[j] * rsb * gg * (sc + 1.f) + sh; u32x2 o; o.x = cvt_pk(hh.x, hh.y); o.y = cvt_pk(hh.z, hh.w); *(u32x2*)(hb + (size_t)r1 * 1024 + col) = o; }
        }
    }
}
__device__ __forceinline__ void final_norm_phase(const Params& P) {
    const int lane = tid_l() & 63; const int gw = bid_l() * 4 + (tid_l() >> 6), ngw = vgrid() * 4;
    const float* g = P.in[I_FG];
    for (int r = gw; r < RL; r += 2 * ngw) {
        const int r1 = r + ngw;
        f32x4* xa = (f32x4*)(P.out + (size_t)r * D); f32x4* xb = (f32x4*)(P.out + (size_t)r1 * D);
        f32x4 va[4], vb[4]; float sa_ = 0.f, sb_ = 0.f;
#pragma unroll
        for (int j = 0; j < 4; ++j) { va[j] = xa[lane + 64 * j]; vb[j] = xb[lane + 64 * j]; }
#pragma unroll
        for (int j = 0; j < 4; ++j) { sa_ += va[j].x * va[j].x + va[j].y * va[j].y + va[j].z * va[j].z + va[j].w * va[j].w; sb_ += vb[j].x * vb[j].x + vb[j].y * vb[j].y + vb[j].z * vb[j].z + vb[j].w * vb[j].w; }
        sa_ = wave_sum(sa_); sb_ = wave_sum(sb_);
        const float rsa = rsqrtf(sa_ * (1.f / 1024.f) + 1e-6f), rsb = rsqrtf(sb_ * (1.f / 1024.f) + 1e-6f);
#pragma unroll
        for (int j = 0; j < 4; ++j) { const f32x4 gg = *(const f32x4*)(g + (lane + 64 * j) * 4); xa[lane + 64 * j] = va[j] * rsa * gg; xb[lane + 64 * j] = vb[j] * rsb * gg; }
    }
}

struct EpiP {
    bf16_t* Pb; int pitch; int nmain; float* small;
    __device__ __forceinline__ void operator()(int r, int c, const f32x4& v, int) const {
        if (c < nmain) { u32x2 o; o.x = cvt_pk(v.x, v.y); o.y = cvt_pk(v.z, v.w); *(u32x2*)(Pb + (size_t)r * pitch + c) = o; }
        else { const int cc = c - nmain; if (cc < 48) *(f32x4*)(small + (size_t)r * 48 + cc) = v; }
    }
    __device__ __forceinline__ void w8(int r, int c, const f32x4& v0, const f32x4& v1, int) const {
        if (c < nmain) { u32x4 o; o.x = cvt_pk(v0.x, v0.y); o.y = cvt_pk(v0.z, v0.w); o.z = cvt_pk(v1.x, v1.y); o.w = cvt_pk(v1.z, v1.w); *(u32x4*)(Pb + (size_t)r * pitch + c) = o; }
        else { const int cc = c - nmain; if (cc < 48) { *(f32x4*)(small + (size_t)r * 48 + cc) = v0; *(f32x4*)(small + (size_t)r * 48 + cc + 4) = v1; } }
    }
};
struct EpiSig {
    bf16_t* O;
    __device__ __forceinline__ void operator()(int r, int c, const f32x4& v, int) const {
        u32x2 o; o.x = cvt_pk(sigmf(v.x), sigmf(v.y)); o.y = cvt_pk(sigmf(v.z), sigmf(v.w)); *(u32x2*)(O + (size_t)r * 3072 + c) = o;
    }
    __device__ __forceinline__ void w8(int r, int c, const f32x4& v0, const f32x4& v1, int) const {
        u32x4 o; o.x = cvt_pk(sigmf(v0.x), sigmf(v0.y)); o.y = cvt_pk(sigmf(v0.z), sigmf(v0.w)); o.z = cvt_pk(sigmf(v1.x), sigmf(v1.y)); o.w = cvt_pk(sigmf(v1.z), sigmf(v1.w));
        *(u32x4*)(O + (size_t)r * 3072 + c) = o;
    }
};
struct EpiRelu2 {
    bf16_t* O;
    __device__ __forceinline__ void operator()(int r, int c, const f32x4& v, int) const {
        const float a = fmaxf(v.x, 0.f), b = fmaxf(v.y, 0.f), cc = fmaxf(v.z, 0.f), d = fmaxf(v.w, 0.f);
        u32x2 o; o.x = cvt_pk(a * a, b * b); o.y = cvt_pk(cc * cc, d * d); *(u32x2*)(O + (size_t)r * 4096 + c) = o;
    }
    __device__ __forceinline__ void w8(int r, int c, const f32x4& v0, const f32x4& v1, int) const {
        const float a = fmaxf(v0.x, 0.f), b = fmaxf(v0.y, 0.f), cc = fmaxf(v0.z, 0.f), d = fmaxf(v0.w, 0.f), e = fmaxf(v1.x, 0.f), f = fmaxf(v1.y, 0.f), g = fmaxf(v1.z, 0.f), h = fmaxf(v1.w, 0.f);
        u32x4 o; o.x = cvt_pk(a * a, b * b); o.y = cvt_pk(cc * cc, d * d); o.z = cvt_pk(e * e, f * f); o.w = cvt_pk(g * g, h * h); *(u32x4*)(O + (size_t)r * 4096 + c) = o;
    }
};
struct EpiRes {
    XPtr Xold, Xnew; const float* mods_l; int gidx;
    __device__ __forceinline__ void operator()(int r, int c, const f32x4& v, int) const {
        const f32x4 g = *(const f32x4*)(mods_l + modidx(r) * 6144 + gidx * 1024 + c);
        const f32x4 xo = *(const f32x4*)(xrow(Xold, r) + c);
        *(f32x4*)(xrow(Xnew, r) + c) = xo + g * v;
    }
    __device__ __forceinline__ void w8(int r, int c, const f32x4& v0, const f32x4& v1, int) const {
        const float* gp = mods_l + modidx(r) * 6144 + gidx * 1024 + c; const float* xo = xrow(Xold, r) + c; float* xn = xrow(Xnew, r) + c;
        const f32x4 g0 = *(const f32x4*)gp, g1 = *(const f32x4*)(gp + 4), x0 = *(const f32x4*)xo, x1 = *(const f32x4*)(xo + 4);
        *(f32x4*)xn = x0 + g0 * v0; *(f32x4*)(xn + 4) = x1 + g1 * v1;
    }
};
struct EpiMerge {
    const bf16_t* gs; bf16_t* mb;
    __device__ __forceinline__ void operator()(int r, int c, const f32x4& v, int j) const {
        const u32x2 g = *(const u32x2*)(gs + (size_t)r * 3072 + j * 1024 + c);
        float a0 = v.x * bflo(g.x), a1 = v.y * bfhi(g.x), a2 = v.z * bflo(g.y), a3 = v.w * bfhi(g.y);
        u32x2* mp = (u32x2*)(mb + (size_t)r * 1024 + c);
        if (j > 0) { const u32x2 o = *mp; a0 += bflo(o.x); a1 += bfhi(o.x); a2 += bflo(o.y); a3 += bfhi(o.y); }
        u32x2 w; w.x = cvt_pk(a0, a1); w.y = cvt_pk(a2, a3); *mp = w;
    }
    __device__ __forceinline__ void w8(int r, int c, const f32x4& v0, const f32x4& v1, int j) const {
        const u32x4 g = *(const u32x4*)(gs + (size_t)r * 3072 + j * 1024 + c);
        float a0 = v0.x * bflo(g.x), a1 = v0.y * bfhi(g.x), a2 = v0.z * bflo(g.y), a3 = v0.w * bfhi(g.y), a4 = v1.x * bflo(g.z), a5 = v1.y * bfhi(g.z), a6 = v1.z * bflo(g.w), a7 = v1.w * bfhi(g.w);
        u32x4* mp = (u32x4*)(mb + (size_t)r * 1024 + c);
        if (j > 0) { const u32x4 o = *mp; a0 += bflo(o.x); a1 += bfhi(o.x); a2 += bflo(o.y); a3 += bfhi(o.y); a4 += bflo(o.z); a5 += bfhi(o.z); a6 += bflo(o.w); a7 += bfhi(o.w); }
        u32x4 w; w.x = cvt_pk(a0, a1); w.y = cvt_pk(a2, a3); w.z = cvt_pk(a4, a5); w.w = cvt_pk(a6, a7); *mp = w;
    }
};

namespace pg8 {
constexpr int BM = 256, BK = 64, HALF = 128, HTB = HALF * BK * 2, STAGE_BYTES = 8 * HTB, NXCD = 8, WGM = 2;
__device__ __forceinline__ int lds_byte(int r, int c) { const int st = (r >> 4) * 2 + (c >> 5), rr = r & 15, cc = c & 31, ob = rr * 64 + cc * 2; return st * 1024 + (ob ^ (((ob >> 9) & 1) << 5)); }
__device__ __forceinline__ int perm32(int rho) { const int n = rho >> 4, i = rho & 15; return 8 * (i >> 2) + 4 * n + (i & 3); }
__device__ __forceinline__ void stage_rc(int b, int& R_, int& C_) { const int st = b / 1024, sb = b % 1024, swz = sb ^ (((sb >> 9) & 1) << 5); R_ = (st >> 1) * 16 + swz / 64; C_ = (st & 1) * 32 + (swz % 64) / 2; }
struct Unit { int pm, pn, acol, brow, j; };
struct Gemm { const bf16_t* A; const bf16_t* Bt; int lda, K; };
struct StaticOrder {
    int nM, nN, nwg, G, c;
    __device__ void init(int M, int N, int G_, int c_) { nM = M / BM; nN = N / BM; nwg = nM * nN; G = G_; c = c_; }
    __device__ __forceinline__ bool tile(long L, int& pm, int& pn) const {
        if (L >= nwg) return false;
        int wgid = (int)L; { const int q = nwg / NXCD, r = nwg % NXCD, xcd = wgid % NXCD, off = wgid / NXCD; wgid = (xcd < r ? xcd * (q + 1) : r * (q + 1) + (xcd - r) * q) + off; }
        const int nig = WGM * nN, gid = wgid / nig, fm = gid * WGM, gsz = (nM - fm) < WGM ? (nM - fm) : WGM;
        pm = fm + ((wgid % nig) % gsz); pn = (wgid % nig) / gsz; return true;
    }
    __device__ __forceinline__ bool next(int i, Unit& u) const { if (!tile((long)i * G + c, u.pm, u.pn)) return false; u.acol = 0; u.brow = u.pn; u.j = 0; return true; }
};
struct MergeOrder {
    StaticOrder S;
    __device__ __forceinline__ bool next(int i, Unit& u) const { const int j = i % 3; if (!S.tile((long)(i / 3) * S.G + S.c, u.pm, u.pn)) return false; u.acol = j * 512; u.brow = j * 4 + u.pn; u.j = j; return true; }
};
template <class F> struct Epi {
    F f;
    __device__ __forceinline__ void operator()(const f32x4 (&acc)[2][2][4][2], const Unit& u, int wr, int wc, int fr, int fq) const {
#pragma unroll
        for (int ai = 0; ai < 2; ++ai)
#pragma unroll
            for (int m = 0; m < 4; ++m)
#pragma unroll
                for (int bj = 0; bj < 2; ++bj)
                    f.w8(u.pm * BM + ai * HALF + wr * 64 + m * 16 + fr, u.pn * BM + bj * HALF + wc * 32 + 8 * fq, acc[ai][bj][m][0], acc[ai][bj][m][1], u.j);
    }
};

template <class E_, class Sched>
__device__ __forceinline__ void gemm_phase(LAS unsigned char* lds, const Gemm g, const Sched& S, const E_& E) {
    int tid_ = threadIdx.x; asm volatile("" : "+v"(tid_));
    const int tid = tid_, wid = __builtin_amdgcn_readfirstlane(tid >> 6), lane = tid & 63, wr = wid >> 2, wc = wid & 3, fr = lane & 15, fq = lane >> 4;
    const int K = g.K, nt = K / BK;
    unsigned voffA[2], voffB[2];
#pragma unroll
    for (int i = 0; i < 2; ++i) { int R_, C_; stage_rc(tid * 16 + i * 8192, R_, C_); const int Rb = (R_ & ~31) + perm32(R_ & 31); voffA[i] = (unsigned)(R_ * g.lda + C_) * 2u; voffB[i] = (unsigned)(Rb * K + C_) * 2u; }
    const size_t kstep = (size_t)(BK * 2);
    const size_t hstepA = (size_t)HALF * g.lda * 2, hstepB = (size_t)HALF * K * 2;
    const unsigned ldsw = (unsigned)wid * 1024u;
    const int aoff = lds_byte(wr * 64 + fr, fq * 8), boff = lds_byte(wc * 32 + fr, fq * 8);
#define PG8_SA(b, h) (((b) * 2 + (h)) * HTB)
#define PG8_SB(b, h) ((4 + (b) * 2 + (h)) * HTB)
#define PG8_STAGE(bufoff, gbase, voff) do { _Pragma("unroll") for (int _i = 0; _i < 2; ++_i) \
        __builtin_amdgcn_global_load_lds((const unsigned*)((const char*)(gbase) + (voff)[_i]), (LAS unsigned*)(lds + (bufoff) + ldsw + _i * 8192), 16, 0, 0); } while (0)
#define PG8_LDA(dst, b, h) do { _Pragma("unroll") for (int m = 0; m < 4; ++m) _Pragma("unroll") for (int k = 0; k < 2; ++k) dst[m][k] = *(const LAS bf16x8*)(lds + PG8_SA(b, h) + aoff + m * 2048 + k * 1024); } while (0)
#define PG8_LDB(dst, b, h) do { _Pragma("unroll") for (int n = 0; n < 2; ++n) _Pragma("unroll") for (int k = 0; k < 2; ++k) dst[n][k] = *(const LAS bf16x8*)(lds + PG8_SB(b, h) + boff + n * 2048 + k * 1024); } while (0)
#define PG8_MMA(ai, bj, At, Bt) do { __builtin_amdgcn_s_setprio(1); _Pragma("unroll") for (int m = 0; m < 4; ++m) _Pragma("unroll") for (int n = 0; n < 2; ++n) _Pragma("unroll") for (int k = 0; k < 2; ++k) \
        acc[ai][bj][m][n] = __builtin_amdgcn_mfma_f32_16x16x32_bf16(Bt[n][k], At[m][k], acc[ai][bj][m][n], 0, 0, 0); __builtin_amdgcn_s_setprio(0); } while (0)
#define PG8_WAIT_V(n) asm volatile("s_waitcnt vmcnt(" #n ")" ::: "memory")
#define PG8_WAIT_L(n) asm volatile("s_waitcnt lgkmcnt(" #n ")" ::: "memory")
#define PG8_BAR __builtin_amdgcn_s_barrier()
#define PG8_SCHED __builtin_amdgcn_sched_barrier(0)
#define PG8_UA(u) ((const char*)g.A + ((size_t)(u).pm * BM * g.lda + (u).acol) * 2)
#define PG8_UB(u) ((const char*)g.Bt + (size_t)(u).brow * BM * K * 2)
    Unit cur, nxt; int ui = 0;
    if (!S.next(0, cur)) return;
    f32x4 acc[2][2][4][2];
#pragma unroll
    for (int a = 0; a < 2; ++a)
#pragma unroll
        for (int b = 0; b < 2; ++b)
#pragma unroll
            for (int m = 0; m < 4; ++m)
#pragma unroll
                for (int n = 0; n < 2; ++n) acc[a][b][m][n] = (f32x4){0.f, 0.f, 0.f, 0.f};
    bf16x8 At[4][2], B0[2][2], B1[2][2];
    const char* cA = PG8_UA(cur); const char* cB = PG8_UB(cur);
    PG8_STAGE(PG8_SB(0, 0), cB, voffB); PG8_STAGE(PG8_SB(0, 1), cB + hstepB, voffB); PG8_STAGE(PG8_SA(0, 0), cA, voffA); PG8_STAGE(PG8_SA(0, 1), cA + hstepA, voffA);
    if (wr == 1) PG8_BAR;
    PG8_WAIT_V(2); PG8_BAR;
    PG8_STAGE(PG8_SB(1, 0), cB + kstep, voffB); PG8_STAGE(PG8_SA(1, 0), cA + kstep, voffA); PG8_STAGE(PG8_SB(1, 1), cB + hstepB + kstep, voffB);
    PG8_WAIT_V(6); PG8_BAR;
    for (;;) {
        const bool has_next = S.next(ui + 1, nxt);
        const char* nA = has_next ? PG8_UA(nxt) : cA; const char* nB = has_next ? PG8_UB(nxt) : cB;
        for (int t = 0; t < nt; t += 2) {
            const bool last = (t == nt - 2);
            const char* a1 = cA + (size_t)(t + 1) * kstep;
            const char* a2 = last ? nA : cA + (size_t)(t + 2) * kstep; const char* b2 = last ? nB : cB + (size_t)(t + 2) * kstep;
            const char* a3 = a2 + kstep; const char* b3 = b2 + kstep;
            PG8_LDB(B0, 0, 0); PG8_LDB(B1, 0, 1); PG8_SCHED; PG8_LDA(At, 0, 0); PG8_STAGE(PG8_SA(1, 1), a1 + hstepA, voffA);
            PG8_WAIT_V(8); PG8_WAIT_L(0); PG8_BAR; PG8_MMA(0, 0, At, B0); PG8_MMA(0, 1, At, B1); PG8_BAR; PG8_SCHED;
            PG8_LDA(At, 0, 1); PG8_STAGE(PG8_SB(0, 0), b2, voffB); PG8_STAGE(PG8_SB(0, 1), b2 + hstepB, voffB); PG8_STAGE(PG8_SA(0, 0), a2, voffA);
            PG8_WAIT_V(8); PG8_WAIT_L(0); PG8_BAR; PG8_MMA(1, 0, At, B0); PG8_MMA(1, 1, At, B1); PG8_BAR; PG8_SCHED;
            PG8_LDB(B0, 1, 0); PG8_LDB(B1, 1, 1); PG8_SCHED; PG8_LDA(At, 1, 0); PG8_STAGE(PG8_SA(0, 1), a2 + hstepA, voffA);
            PG8_WAIT_V(8); PG8_WAIT_L(0); PG8_BAR; PG8_MMA(0, 0, At, B0); PG8_MMA(0, 1, At, B1); PG8_BAR; PG8_SCHED;
            PG8_LDA(At, 1, 1); PG8_STAGE(PG8_SB(1, 0), b3, voffB); PG8_STAGE(PG8_SB(1, 1), b3 + hstepB, voffB); PG8_STAGE(PG8_SA(1, 0), a3, voffA);
            PG8_WAIT_V(8); PG8_WAIT_L(0); PG8_BAR; PG8_MMA(1, 0, At, B0); PG8_MMA(1, 1, At, B1); PG8_BAR; PG8_SCHED;
        }
        if (wr == 0) PG8_BAR;
        E(acc, cur, wr, wc, fr, fq);
        if (!has_next) break;
#pragma unroll
        for (int a = 0; a < 2; ++a)
#pragma unroll
            for (int b = 0; b < 2; ++b)
#pragma unroll
                for (int m = 0; m < 4; ++m)
#pragma unroll
                    for (int n = 0; n < 2; ++n) acc[a][b][m][n] = (f32x4){0.f, 0.f, 0.f, 0.f};
        cur = nxt; cA = nA; cB = nB; ++ui;
        if (wr == 1) PG8_BAR;
    }
    PG8_WAIT_V(0);
    PG8_BAR;
#undef PG8_SA
#undef PG8_SB
#undef PG8_STAGE
#undef PG8_LDA
#undef PG8_LDB
#undef PG8_MMA
#undef PG8_WAIT_V
#undef PG8_WAIT_L
#undef PG8_BAR
#undef PG8_SCHED
#undef PG8_UA
#undef PG8_UB
}
}

template <class F>
__device__ __forceinline__ void big_gemm(LAS unsigned char* ldsb, const bf16_t* A, int lda, const bf16_t* Bt, int K, int N, const F& f) {
    pg8::Gemm g{A, Bt, lda, K}; pg8::StaticOrder S; S.init(RL, N, (int)gridDim.x, (int)blockIdx.x);
    pg8::Epi<F> E{f};
    pg8::gemm_phase(ldsb, g, S, E);
    __syncthreads();
}
template <int NI>
__device__ __forceinline__ void gemm_kloop(f32x4 (&acc)[4][NI], const bf16_t* Ag, int lda, const bf16_t* Bg, int ldb, int K, char* lds) {
    const int tid = tid_l(), lane = tid & 63, wid = tid >> 6, wm = wid >> 1, wn = wid & 1, lr = lane & 15, lq = lane >> 4;
    u32x4 ra[4], rb[NI];
    const int prow = tid >> 3, pkc = tid & 7;
    const bf16_t* ap = Ag + (size_t)prow * lda + pkc * 8;
    const bf16_t* bp = Bg + (size_t)prow * ldb + pkc * 8;
    const int soff = prow * 128 + ((pkc ^ (prow & 7)) << 4);
#pragma unroll
    for (int i = 0; i < 4; ++i) { ra[i] = *(const u32x4*)(ap + (size_t)(32 * i) * lda); if (i < NI) rb[i < NI ? i : 0] = *(const u32x4*)(bp + (size_t)(32 * i) * ldb); }
#pragma unroll
    for (int i = 0; i < 4; ++i) { *(u32x4*)(lds + soff + i * 4096) = ra[i]; if (i < NI) *(u32x4*)(lds + 32768 + soff + i * 4096) = rb[i < NI ? i : 0]; }
    __syncthreads();
    const int nk = K >> 6;
    for (int kt = 0; kt < nk; ++kt) {
        const int buf = kt & 1;
        if (kt + 1 < nk) {
#pragma unroll
            for (int i = 0; i < 4; ++i) { ra[i] = *(const u32x4*)(ap + (size_t)(32 * i) * lda + (kt + 1) * 64); if (i < NI) rb[i < NI ? i : 0] = *(const u32x4*)(bp + (size_t)(32 * i) * ldb + (kt + 1) * 64); }
        }
        const char* la = lds + buf * 16384; const char* lb = lds + 32768 + buf * 16384;
#pragma unroll
        for (int kk = 0; kk < 2; ++kk) {
            bf16x8 af[4], bfr[NI];
            const int chunk = kk * 4 + lq;
#pragma unroll
            for (int mi = 0; mi < 4; ++mi) { const int row = wm * 64 + mi * 16 + lr; af[mi] = *(const bf16x8*)(la + row * 128 + ((chunk ^ (row & 7)) << 4)); }
#pragma unroll
            for (int ni = 0; ni < NI; ++ni) { const int row = wn * (16 * NI) + ni * 16 + lr; bfr[ni] = *(const bf16x8*)(lb + row * 128 + ((chunk ^ (row & 7)) << 4)); }
#pragma unroll
            for (int mi = 0; mi < 4; ++mi)
#pragma unroll
                for (int ni = 0; ni < NI; ++ni) acc[mi][ni] = __builtin_amdgcn_mfma_f32_16x16x32_bf16(bfr[ni], af[mi], acc[mi][ni], 0, 0, 0);
        }
        if (kt + 1 < nk) {
            char* sa = lds + (buf ^ 1) * 16384 + soff;
#pragma unroll
            for (int i = 0; i < 4; ++i) { *(u32x4*)(sa + i * 4096) = ra[i]; if (i < NI) *(u32x4*)(sa + 32768 + i * 4096) = rb[i < NI ? i : 0]; }
        }
        __syncthreads();
    }
}

__device__ __forceinline__ void tile_of(int t, int Mt, int Nt, int& tm, int& tn) {
    const int per = 8 * Nt; const int p = t / per; const int r = t - p * per; const int pm = (Mt - 8 * p) < 8 ? (Mt - 8 * p) : 8;
    tm = 8 * p + r % pm; tn = r / pm;
}

template <int TYPE> struct MX {
    static constexpr int DK = TYPE == 1 ? 128 : 64;
    static constexpr int NOC = DK / 8;
    static constexpr int PITCH = TYPE == 1 ? 2048 : 1536;
    static constexpr int QOFF = 0;
    static constexpr int KOFF = TYPE == 1 ? 512 : 256;
    static constexpr int VOFF = TYPE == 1 ? 1024 : 512;
    static constexpr int GOFF = TYPE == 1 ? 1536 : 1024;
    static constexpr int QP = DK + 16;
};
constexpr int L_VT = 0;
constexpr int L_Q = 20480;
constexpr int L_CUM = 40960;
constexpr int L_ATT = 57344;
constexpr int L_SC = 67584;
constexpr int L_SA = 68096;

template <int TYPE>
__device__ __forceinline__ void load_qk8(const Params& P, int l, const bf16_t* pb, int b, int c, int t, int h, int oc, bool isk, float (&f)[8]) {
    typedef MX<TYPE> M;
    const int coff = (isk ? M::KOFF : M::QOFF) + h * M::DK;
    const size_t rowi = (size_t)(rowbase(b, c) + t);
    if (TYPE == 0) {
        const u32x4 u = *(const u32x4*)(pb + rowi * M::PITCH + coff + oc * 8); UNPACK8(u, f);
    } else if (TYPE == 1) {
        const bool hp = (t > 0) || (c != 0 && c != 4), hn = (t < 63) || (c != 3 && c != NCH - 1);
        const bf16_t* p0 = pb + rowi * M::PITCH + coff + oc * 8;
        u32x4 u1 = *(const u32x4*)p0, u0 = (u32x4){0u, 0u, 0u, 0u}, u2 = (u32x4){0u, 0u, 0u, 0u};
        if (hp) u0 = *(const u32x4*)(p0 - M::PITCH);
        if (hn) u2 = *(const u32x4*)(p0 + M::PITCH);
        float a[8], m[8], n[8]; UNPACK8(u0, a); UNPACK8(u1, m); UNPACK8(u2, n);
        const float* cw = P.in[I_CONV] + (size_t)l * 3 * 1024 + (isk ? 512 : 0) + h * 128 + oc * 8;
        const f32x4 w0a = *(const f32x4*)cw, w0b = *(const f32x4*)(cw + 4), w1a = *(const f32x4*)(cw + 1024), w1b = *(const f32x4*)(cw + 1028), w2a = *(const f32x4*)(cw + 2048), w2b = *(const f32x4*)(cw + 2052);
        const float w0[8] = {w0a.x, w0a.y, w0a.z, w0a.w, w0b.x, w0b.y, w0b.z, w0b.w};
        const float w1[8] = {w1a.x, w1a.y, w1a.z, w1a.w, w1b.x, w1b.y, w1b.z, w1b.w};
        const float w2[8] = {w2a.x, w2a.y, w2a.z, w2a.w, w2b.x, w2b.y, w2b.z, w2b.w};
#pragma unroll
        for (int j = 0; j < 8; ++j) f[j] = siluf(w0[j] * a[j] + w1[j] * m[j] + w2[j] * n[j]);
    } else {
        if (c < 4) { const u32x4 u = *(const u32x4*)(pb + rowi * M::PITCH + coff + oc * 8); UNPACK8(u, f); }
        else {
            const int o4 = oc & 3;
            const u32x4 ua = *(const u32x4*)(pb + rowi * M::PITCH + coff + o4 * 8), ub = *(const u32x4*)(pb + rowi * M::PITCH + coff + 32 + o4 * 8);
            float x1[8], x2[8]; UNPACK8(ua, x1); UNPACK8(ub, x2);
            const float* tab = (const float*)(ws_l(P) + WS_ROPE);
            const float* cs = o4 < 2 ? tab + (c - 4) * 16 + o4 * 8 : tab + 4096 + t * 16 + (o4 - 2) * 8;
            const float* sn = o4 < 2 ? tab + 2048 + (c - 4) * 16 + o4 * 8 : tab + 4096 + 1024 + t * 16 + (o4 - 2) * 8;
#pragma unroll
            for (int j = 0; j < 8; ++j) f[j] = oc < 4 ? x1[j] * cs[j] - x2[j] * sn[j] : x1[j] * sn[j] + x2[j] * cs[j];
        }
    }
}

template <int TYPE>
__device__ __forceinline__ void decay_setup(const Params& P, int l, int b, int c, int h, int dir, char* lds, const float* apre = nullptr) {
    const int tid = tid_l(); const int r0 = rowbase(b, c);
    float* sc = (float*)(lds + L_SC);
    const float* small = (const float*)(ws_l(P) + WS_SMALL);
    if (TYPE == 0) {
        float* cum = (float*)(lds + L_CUM); float* sa = (float*)(lds + L_SA);
        if (apre) {
#pragma unroll
            for (int k = 0; k < 4; ++k) sa[tid + k * NTHR] = apre[k];
        } else {
            for (int i = tid; i < 1024; i += NTHR) sa[i] = small[(size_t)(r0 + (i >> 4)) * 48 + dir * 16 + (i & 15)];
        }
        __syncthreads();
        const int d = tid & 63, tq = tid >> 6;
        const float* a2 = P.in[I_A2] + ((size_t)(l * 2 + dir) * 16) * 256 + h * 64 + d;
        float w[16];
#pragma unroll
        for (int rr = 0; rr < 16; ++rr) w[rr] = a2[rr * 256];
        const float bias = P.in[I_ABIAS][(l * 2 + dir) * 256 + h * 64 + d];
        float* blk = sa;
        float lv[16];
#pragma unroll
        for (int i = 0; i < 16; ++i) {
            const int t = tq * 16 + i;
            float z = bias;
#pragma unroll
            for (int rr = 0; rr < 16; ++rr) z += sa[t * 16 + rr] * w[rr];
            lv[i] = logsig(z) * (1.f / 16.f);
        }
        if (dir == 0) {
#pragma unroll
            for (int i = 1; i < 16; ++i) lv[i] += lv[i - 1];
        } else {
#pragma unroll
            for (int i = 14; i >= 0; --i) lv[i] += lv[i + 1];
        }
        __syncthreads();
        blk[tq * 64 + d] = dir == 0 ? lv[15] : lv[0];
        __syncthreads();
        float off = 0.f;
#pragma unroll
        for (int q = 0; q < 4; ++q) if (dir == 0 ? (q < tq) : (q > tq)) off += blk[q * 64 + d];
#pragma unroll
        for (int i = 0; i < 16; ++i) cum[(tq * 16 + i) * 64 + d] = lv[i] + off;
    } else if (TYPE == 1) {
        if (tid < 64) {
            const float fg = small[(size_t)(r0 + tid) * 48 + 40 + dir * 4 + h] + P.in[I_FB][l * 8 + dir * 4 + h];
            float v = logsig(fg);
            if (dir == 0) {
#pragma unroll
                for (int o = 1; o < 64; o <<= 1) { const float n = __shfl_up(v, o); if (tid >= o) v += n; }
            } else {
#pragma unroll
                for (int o = 1; o < 64; o <<= 1) { const float n = __shfl_down(v, o); if (tid + o < 64) v += n; }
            }
            const float tot = __shfl(v, dir == 0 ? 63 : 0);
            sc[tid] = v;
            sc[64 + tid] = small[(size_t)(r0 + tid) * 48 + 32 + dir * 4 + h] + P.in[I_IB][l * 8 + dir * 4 + h];
            if (tid == 0) sc[128] = tot;
        }
    } else {
        if (tid < 64) {
            const float lg = logsig(P.in[I_RDL][l * 8 + dir * 4 + h]);
            sc[tid] = (dir == 0 ? (float)(tid + 1) : (float)(64 - tid)) * lg;
            if (tid == 0) sc[128] = 64.f * lg;
        }
    }
    __syncthreads();
}

template <int TYPE>
__device__ __forceinline__ void build_vT(const bf16_t* pb, int b, int c, int h, char* lds) {
    typedef MX<TYPE> M;
    bf16_t* vT = (bf16_t*)(lds + L_VT);
#pragma unroll
    for (int i = 0; i < 2; ++i) {
        const int pid = tid_l() + i * NTHR, tp = pid & 31, oc = pid >> 5;
        const bf16_t* p0 = pb + (size_t)(rowbase(b, c) + 2 * tp) * M::PITCH + M::VOFF + h * 128 + oc * 8;
        const u32x4 u0 = *(const u32x4*)p0, u1 = *(const u32x4*)(p0 + M::PITCH);
        unsigned* dst = (unsigned*)(vT + (size_t)(oc * 8) * 80 + 2 * tp);
        dst[0 * 40] = (u0.x & 0xffffu) | (u1.x << 16); dst[1 * 40] = (u0.x >> 16) | (u1.x & 0xffff0000u);
        dst[2 * 40] = (u0.y & 0xffffu) | (u1.y << 16); dst[3 * 40] = (u0.y >> 16) | (u1.y & 0xffff0000u);
        dst[4 * 40] = (u0.z & 0xffffu) | (u1.z << 16); dst[5 * 40] = (u0.z >> 16) | (u1.z & 0xffff0000u);
        dst[6 * 40] = (u0.w & 0xffffu) | (u1.w << 16); dst[7 * 40] = (u0.w >> 16) | (u1.w & 0xffff0000u);
    }
}

__device__ __forceinline__ int scan_index(int dir, int c) { return dir == 0 ? c : (c < 4 ? 3 - c : 135 - c); }

template <int TYPE>
__device__ __forceinline__ void u_phase(const Params& P, int l, char* lds) {
    typedef MX<TYPE> M; constexpr int DK = M::DK;
    const int tid = tid_l(), lane = tid & 63, wid = tid >> 6, lr = lane & 15, lq = lane >> 4;
    const bf16_t* pb = (const bf16_t*)(ws_l(P) + WS_PBUF);
    bf16_t* U = (bf16_t*)(ws_l(P) + WS_SBUF); float* DEC = (float*)(ws_l(P) + WS_DEC); float* UN = (float*)(ws_l(P) + WS_UN);
    bf16_t* vT = (bf16_t*)(lds + L_VT); bf16_t* kT = (bf16_t*)(lds + L_Q);
    const float* cum = (const float*)(lds + L_CUM); const float* sc = (const float*)(lds + L_SC);
    const int NU = NB * 4 * 2 * NCH, VG = vgrid(), slot = bid_l();
    for (int u0 = 0; u0 < NU; u0 += VG) {
        int unit = u0 + slot; if (unit >= NU) unit = NU - 1;
        const int c = unit % NCH; const int rest = unit / NCH; const int dir = rest & 1, h = (rest >> 1) & 3, b = rest >> 3;
        const int chain = (b * 4 + h) * 2 + dir, n = scan_index(dir, c);
        static_assert(TYPE == 0, "the scalar-decay branches use u_phase_s");
        float k0[8], k1[8], apre[4];
        { const int tp = tid & 31, oc = tid >> 5;
          load_qk8<TYPE>(P, l, pb, b, c, 2 * tp, h, oc, true, k0);
          load_qk8<TYPE>(P, l, pb, b, c, 2 * tp + 1, h, oc, true, k1);
          const float* small = (const float*)(ws_l(P) + WS_SMALL); const int r0 = rowbase(b, c);
#pragma unroll
          for (int k = 0; k < 4; ++k) { const int i = tid + k * NTHR; apre[k] = small[(size_t)(r0 + (i >> 4)) * 48 + dir * 16 + (i & 15)]; } }
        build_vT<TYPE>(pb, b, c, h, lds);
        decay_setup<TYPE>(P, l, b, c, h, dir, lds, apre);
        const int tlast = dir == 0 ? 63 : 0;
        {
            const int pid = tid, tp = pid & 31, oc = pid >> 5;
            unsigned* dst = (unsigned*)(kT + (size_t)(oc * 8) * 80 + 2 * tp);
            if (TYPE == 0) {
#pragma unroll
                for (int j = 0; j < 8; ++j) { const int d = oc * 8 + j; const float tot = cum[tlast * 64 + d];
                    dst[j * 40] = cvt_pk(k0[j] * __expf(tot - cum[(2 * tp) * 64 + d]), k1[j] * __expf(tot - cum[(2 * tp + 1) * 64 + d])); }
            } else {
                const float tot = sc[128];
                const float w0 = TYPE == 1 ? __expf(tot - sc[2 * tp] + sc[64 + 2 * tp]) * 0.08838834764831845f : __expf(tot - sc[2 * tp]) * 0.125f;
                const float w1 = TYPE == 1 ? __expf(tot - sc[2 * tp + 1] + sc[64 + 2 * tp + 1]) * 0.08838834764831845f : __expf(tot - sc[2 * tp + 1]) * 0.125f;
#pragma unroll
                for (int j = 0; j < 8; ++j) dst[j * 40] = cvt_pk(k0[j] * w0, k1[j] * w1);
            }
        }
        __syncthreads();
        f32x4 acc[2][DK / 16];
#pragma unroll
        for (int i = 0; i < 2; ++i)
#pragma unroll
            for (int nt = 0; nt < DK / 16; ++nt) acc[i][nt] = (f32x4){0.f, 0.f, 0.f, 0.f};
#pragma unroll
        for (int kk = 0; kk < 2; ++kk) {
            bf16x8 fv[2];
#pragma unroll
            for (int i = 0; i < 2; ++i) fv[i] = *(const bf16x8*)(vT + (size_t)((2 * wid + i) * 16 + lr) * 80 + kk * 32 + lq * 8);
#pragma unroll
            for (int nt = 0; nt < DK / 16; ++nt) {
                const bf16x8 fk = *(const bf16x8*)(kT + (size_t)(nt * 16 + lr) * 80 + kk * 32 + lq * 8);
#pragma unroll
                for (int i = 0; i < 2; ++i) acc[i][nt] = __builtin_amdgcn_mfma_f32_16x16x32_bf16(fk, fv[i], acc[i][nt], 0, 0, 0);
            }
        }
        bf16_t* ub = U + (size_t)(chain * NCH + n) * 128 * DK;
#pragma unroll
        for (int i = 0; i < 2; ++i)
#pragma unroll
            for (int nt = 0; nt < DK / 16; ++nt) {
                const int e = (2 * wid + i) * 16 + lr, d = nt * 16 + lq * 4;
                u32x2 o; o.x = cvt_pk(acc[i][nt].x, acc[i][nt].y); o.y = cvt_pk(acc[i][nt].z, acc[i][nt].w);
                *(u32x2*)(ub + (size_t)e * DK + d) = o;
            }
        if (tid < DK) {
            const float tot = TYPE == 0 ? cum[tlast * 64 + (tid & 63)] : sc[128];
            DEC[(size_t)(chain * NCH + n) * 128 + tid] = __expf(tot);
            if (TYPE == 1) {
                float s = 0.f;
#pragma unroll
                for (int q = 0; q < 8; ++q) { const u32x4 u = *(const u32x4*)(kT + (size_t)tid * 80 + q * 8); float f[8]; UNPACK8(u, f);
#pragma unroll
                    for (int j = 0; j < 8; ++j) s += f[j]; }
                UN[(size_t)(chain * NCH + n) * 128 + tid] = s;
            }
        }
        __syncthreads();
    }
}

template <int TYPE>
__device__ __forceinline__ void u_phase_s(const Params& P, int l, char* lds) {
    typedef MX<TYPE> M; constexpr int DK = M::DK; constexpr int NIT = M::NOC * 32 / NTHR;
    const int tid = tid_l(), lane = tid & 63, wid = tid >> 6, lr = lane & 15, lq = lane >> 4;
    const bf16_t* pb = (const bf16_t*)(ws_l(P) + WS_PBUF);
    const float* small = (const float*)(ws_l(P) + WS_SMALL);
    bf16_t* U = (bf16_t*)(ws_l(P) + WS_SBUF); float* DEC = (float*)(ws_l(P) + WS_DEC); float* UN = (float*)(ws_l(P) + WS_UN);
    bf16_t* vT = (bf16_t*)(lds + L_VT); bf16_t* kT0 = (bf16_t*)(lds + 20480); bf16_t* kT1 = (bf16_t*)(lds + 40960);
    float* sc = (float*)(lds + L_SC);
    const int NU = NB * 4 * NCH, VG = vgrid(), slot = bid_l();
    for (int u0 = 0; u0 < NU; u0 += VG) {
        int unit = u0 + slot; if (unit >= NU) unit = NU - 1;
        const int c = unit % NCH; const int rest = unit / NCH; const int h = rest & 3, b = rest >> 2;
        const int r0 = rowbase(b, c);
        float kv[NIT][2][8];
#pragma unroll
        for (int i = 0; i < NIT; ++i) {
            const int pid = tid + i * NTHR, tp = pid & 31, oc = pid >> 5;
            load_qk8<TYPE>(P, l, pb, b, c, 2 * tp, h, oc, true, kv[i][0]);
            load_qk8<TYPE>(P, l, pb, b, c, 2 * tp + 1, h, oc, true, kv[i][1]);
        }
        if (TYPE == 1) {
            if (tid < 128) {
                const int dir = tid >> 6, t = tid & 63;
                const float fg = small[(size_t)(r0 + t) * 48 + 40 + dir * 4 + h] + P.in[I_FB][l * 8 + dir * 4 + h];
                float v = logsig(fg);
                if (dir == 0) {
#pragma unroll
                    for (int o = 1; o < 64; o <<= 1) { const float n = __shfl_up(v, o); if (t >= o) v += n; }
                } else {
#pragma unroll
                    for (int o = 1; o < 64; o <<= 1) { const float n = __shfl_down(v, o); if (t + o < 64) v += n; }
                }
                sc[dir * 64 + t] = v;
                sc[128 + dir * 64 + t] = small[(size_t)(r0 + t) * 48 + 32 + dir * 4 + h] + P.in[I_IB][l * 8 + dir * 4 + h];
            }
        } else {
            if (tid < 64) {
                const float lg0 = logsig(P.in[I_RDL][l * 8 + h]), lg1 = logsig(P.in[I_RDL][l * 8 + 4 + h]);
                sc[tid] = (float)(tid + 1) * lg0; sc[64 + tid] = (float)(64 - tid) * lg1;
            }
        }
        build_vT<TYPE>(pb, b, c, h, lds);
        __syncthreads();
        const float totf = sc[63], totb = sc[64];
        const float ks = TYPE == 1 ? 0.08838834764831845f : 0.125f;
#pragma unroll
        for (int i = 0; i < NIT; ++i) {
            const int pid = tid + i * NTHR, tp = pid & 31, oc = pid >> 5;
            const int t0 = 2 * tp, t1 = 2 * tp + 1;
            const float wf0 = __expf(totf - sc[t0] + (TYPE == 1 ? sc[128 + t0] : 0.f)) * ks, wf1 = __expf(totf - sc[t1] + (TYPE == 1 ? sc[128 + t1] : 0.f)) * ks;
            const float wb0 = __expf(totb - sc[64 + t0] + (TYPE == 1 ? sc[192 + t0] : 0.f)) * ks, wb1 = __expf(totb - sc[64 + t1] + (TYPE == 1 ? sc[192 + t1] : 0.f)) * ks;
            unsigned* d0 = (unsigned*)(kT0 + (size_t)(oc * 8) * 80 + 2 * tp); unsigned* d1 = (unsigned*)(kT1 + (size_t)(oc * 8) * 80 + 2 * tp);
#pragma unroll
            for (int j = 0; j < 8; ++j) { d0[j * 40] = cvt_pk(kv[i][0][j] * wf0, kv[i][1][j] * wf1); d1[j * 40] = cvt_pk(kv[i][0][j] * wb0, kv[i][1][j] * wb1); }
        }
        __syncthreads();
        const int chf = (b * 4 + h) * 2;
#pragma unroll 1
        for (int dir = 0; dir < 2; ++dir) {
            const bf16_t* kT = dir == 0 ? kT0 : kT1;
            const int n = scan_index(dir, c);
            f32x4 acc[2][DK / 16];
#pragma unroll
            for (int i = 0; i < 2; ++i)
#pragma unroll
                for (int nt = 0; nt < DK / 16; ++nt) acc[i][nt] = (f32x4){0.f, 0.f, 0.f, 0.f};
#pragma unroll
            for (int kk = 0; kk < 2; ++kk) {
                bf16x8 fv[2];
#pragma unroll
                for (int i = 0; i < 2; ++i) fv[i] = *(const bf16x8*)(vT + (size_t)((2 * wid + i) * 16 + lr) * 80 + kk * 32 + lq * 8);
#pragma unroll
                for (int nt = 0; nt < DK / 16; ++nt) {
                    const bf16x8 fk = *(const bf16x8*)(kT + (size_t)(nt * 16 + lr) * 80 + kk * 32 + lq * 8);
#pragma unroll
                    for (int i = 0; i < 2; ++i) acc[i][nt] = __builtin_amdgcn_mfma_f32_16x16x32_bf16(fk, fv[i], acc[i][nt], 0, 0, 0);
                }
            }
            bf16_t* ub = U + (size_t)((chf + dir) * NCH + n) * 128 * DK;
#pragma unroll
            for (int i = 0; i < 2; ++i)
#pragma unroll
                for (int nt = 0; nt < DK / 16; ++nt) {
                    const int e = (2 * wid + i) * 16 + lr, d = nt * 16 + lq * 4;
                    u32x2 o; o.x = cvt_pk(acc[i][nt].x, acc[i][nt].y); o.y = cvt_pk(acc[i][nt].z, acc[i][nt].w);
                    *(u32x2*)(ub + (size_t)e * DK + d) = o;
                }
        }
        if (tid < 2 * DK) {
            const int dir = tid / DK, d = tid % DK; const int n = scan_index(dir, c);
            DEC[(size_t)((chf + dir) * NCH + n) * 128 + d] = __expf(dir == 0 ? totf : totb);
            if (TYPE == 1) {
                const bf16_t* kT = dir == 0 ? kT0 : kT1;
                float sum = 0.f;
#pragma unroll
                for (int q = 0; q < 8; ++q) { const u32x4 u = *(const u32x4*)(kT + (size_t)d * 80 + q * 8); float f[8]; UNPACK8(u, f);
#pragma unroll
                    for (int j = 0; j < 8; ++j) sum += f[j]; }
                UN[(size_t)((chf + dir) * NCH + n) * 128 + d] = sum;
            }
        }
        __syncthreads();
    }
}

template <int DK, bool HASN>
__device__ __forceinline__ void scan_phase(const Params& P) {
    bf16_t* U = (bf16_t*)(ws_l(P) + WS_SBUF); const float* DEC = (const float*)(ws_l(P) + WS_DEC); float* UN = (float*)(ws_l(P) + WS_UN);
    constexpr int VEC = DK / 64;
    constexpr int DQ = DK / VEC; constexpr int TT = 16 * 128 * DQ;
    constexpr size_t US = (size_t)128 * DK;
    for (int g = bid_l() * NTHR + tid_l(); g < TT; g += vgrid() * NTHR) {
        const int dq = g % DQ, e = (g / DQ) % 128, chain = g / (DQ * 128);
        bf16_t* up = U + ((size_t)chain * NCH * 128 + e) * DK + dq * VEC;
        const float* dp = DEC + (size_t)chain * NCH * 128 + dq * VEC;
        float S0 = 0.f, S1 = 0.f;
        constexpr int SB = 12;
        unsigned ua[SB], ubv[SB]; f32x2 da[SB], db[SB];
#define SC_LOAD(uu, dd, n0) do { _Pragma("unroll") for (int j = 0; j < SB; ++j) { \
            if (VEC == 2) { uu[j] = *(const unsigned*)(up + (size_t)((n0) + j) * US); dd[j] = *(const f32x2*)(dp + (size_t)((n0) + j) * 128); } \
            else { uu[j] = (unsigned)up[(size_t)((n0) + j) * US]; dd[j].x = dp[(size_t)((n0) + j) * 128]; dd[j].y = 0.f; } } } while (0)
#define SC_STEP(uu, dd, n0) do { _Pragma("unroll") for (int j = 0; j < SB; ++j) { \
            if (VEC == 2) { *(unsigned*)(up + (size_t)((n0) + j) * US) = cvt_pk(S0, S1); S0 = dd[j].x * S0 + bflo(uu[j]); S1 = dd[j].y * S1 + bfhi(uu[j]); } \
            else { up[(size_t)((n0) + j) * US] = (bf16_t)(cvt_pk(S0, 0.f) & 0xffffu); S0 = dd[j].x * S0 + bflo(uu[j]); } } } while (0)
        SC_LOAD(ua, da, 0);
        for (int n0 = 0; n0 < 120; n0 += 24) {
            SC_LOAD(ubv, db, n0 + 12);
            SC_STEP(ua, da, n0);
            SC_LOAD(ua, da, n0 + 24);
            SC_STEP(ubv, db, n0 + 12);
        }
        SC_STEP(ua, da, 120);
#undef SC_LOAD
#undef SC_STEP
    }
    if (HASN) {
        for (int g = bid_l() * NTHR + tid_l(); g < 16 * 128; g += vgrid() * NTHR) {
            const int d = g & 127, chain = g >> 7;
            float* np = UN + (size_t)chain * NCH * 128 + d; const float* dp = DEC + (size_t)chain * NCH * 128 + d;
            float S = 0.f;
            float ua_[12], da_[12], ub_[12], db_[12];
#define NS_LOAD(uu, dd, n0) do { _Pragma("unroll") for (int j = 0; j < 12; ++j) { uu[j] = np[(size_t)((n0) + j) * 128]; dd[j] = dp[(size_t)((n0) + j) * 128]; } } while (0)
#define NS_STEP(uu, dd, n0) do { _Pragma("unroll") for (int j = 0; j < 12; ++j) { np[(size_t)((n0) + j) * 128] = S; S = dd[j] * S + uu[j]; } } while (0)
            NS_LOAD(ua_, da_, 0);
            for (int n0 = 0; n0 < 120; n0 += 24) {
                NS_LOAD(ub_, db_, n0 + 12);
                NS_STEP(ua_, da_, n0);
                NS_LOAD(ua_, da_, n0 + 24);
                NS_STEP(ub_, db_, n0 + 12);
            }
            NS_STEP(ua_, da_, 120);
#undef NS_LOAD
#undef NS_STEP
        }
    }
}

template <int TYPE>
__device__ __forceinline__ void out_phase(const Params& P, int l, int pass, bool latent_only, char* lds) {
    typedef MX<TYPE> M; constexpr int DK = M::DK; constexpr int QP = M::QP;
    const int tid = tid_l(), lane = tid & 63, wid = tid >> 6, lr = lane & 15, lq = lane >> 4;
    const bf16_t* pb = (const bf16_t*)(ws_l(P) + WS_PBUF);
    const bf16_t* U = (const bf16_t*)(ws_l(P) + WS_SBUF); const float* UN = (const float*)(ws_l(P) + WS_UN);
    bf16_t* brp = (bf16_t*)(ws_l(P) + WS_BR);
    bf16_t* vT = (bf16_t*)(lds + L_VT); bf16_t* qin = (bf16_t*)(lds + L_Q); bf16_t* kin = qin + 64 * QP; bf16_t* att = (bf16_t*)(lds + L_ATT);
    const float* cum = (const float*)(lds + L_CUM); const float* sc = (const float*)(lds + L_SC);
    const float* ng = P.in[TYPE == 0 ? I_GNG : (TYPE == 1 ? I_MNG : I_RNG)] + l * 512;
    const int NC = latent_only ? NCH - 4 : NCH; const int NU = NB * 4 * NC, VG = vgrid(), slot = bid_l();
    for (int u0 = 0; u0 < NU; u0 += VG) {
        int unit = u0 + slot; if (unit >= NU) unit = NU - 1;
        const int c = unit % NC + (latent_only ? 4 : 0); const int rest = unit / NC; const int h = rest & 3, b = rest >> 2;
        const int r0 = rowbase(b, c);
        build_vT<TYPE>(pb, b, c, h, lds);
        f32x4 tot[8];
#pragma unroll
        for (int et = 0; et < 8; ++et) tot[et] = (f32x4){0.f, 0.f, 0.f, 0.f};
        const int trow = wid * 16 + lr;
        for (int dir = 0; dir < 2; ++dir) {
            const int chain = (b * 4 + h) * 2 + dir, n = scan_index(dir, c);
            decay_setup<TYPE>(P, l, b, c, h, dir, lds);
#pragma unroll 2
            for (int i = 0; i < 64 * M::NOC / NTHR; ++i) {
                const int pid = tid + i * NTHR, t = pid / M::NOC, oc = pid % M::NOC;
                float q8[8], k8[8];
                load_qk8<TYPE>(P, l, pb, b, c, t, h, oc, false, q8);
                load_qk8<TYPE>(P, l, pb, b, c, t, h, oc, true, k8);
                if (TYPE == 0) {
#pragma unroll
                    for (int j = 0; j < 8; ++j) { const float cv = cum[t * 64 + oc * 8 + j]; q8[j] *= __expf(cv) * 0.125f; k8[j] *= __expf(-cv); }
                } else {
                    const float cv = sc[t];
                    const float wq = __expf(cv);
                    const float wk = TYPE == 1 ? __expf(sc[64 + t] - cv) * 0.08838834764831845f : __expf(-cv) * 0.125f;
#pragma unroll
                    for (int j = 0; j < 8; ++j) { q8[j] *= wq; k8[j] *= wk; }
                }
                u32x4 oq, ok;
                oq.x = cvt_pk(q8[0], q8[1]); oq.y = cvt_pk(q8[2], q8[3]); oq.z = cvt_pk(q8[4], q8[5]); oq.w = cvt_pk(q8[6], q8[7]);
                ok.x = cvt_pk(k8[0], k8[1]); ok.y = cvt_pk(k8[2], k8[3]); ok.z = cvt_pk(k8[4], k8[5]); ok.w = cvt_pk(k8[6], k8[7]);
                *(u32x4*)(qin + (size_t)t * QP + oc * 8) = oq;
                *(u32x4*)(kin + (size_t)t * QP + oc * 8) = ok;
            }
            __syncthreads();
            f32x4 sacc[4];
#pragma unroll
            for (int nt = 0; nt < 4; ++nt) sacc[nt] = (f32x4){0.f, 0.f, 0.f, 0.f};
#pragma unroll
            for (int kk = 0; kk < DK / 32; ++kk) {
                const bf16x8 fq = *(const bf16x8*)(qin + (size_t)trow * QP + kk * 32 + lq * 8);
#pragma unroll
                for (int nt = 0; nt < 4; ++nt) {
                    const bf16x8 fk = *(const bf16x8*)(kin + (size_t)(nt * 16 + lr) * QP + kk * 32 + lq * 8);
                    sacc[nt] = __builtin_amdgcn_mfma_f32_16x16x32_bf16(fk, fq, sacc[nt], 0, 0, 0);
                }
            }
            float den = 0.f;
#pragma unroll
            for (int nt = 0; nt < 4; ++nt) {
                const int s0 = nt * 16 + lq * 4;
                float a0 = sacc[nt].x, a1 = sacc[nt].y, a2 = sacc[nt].z, a3 = sacc[nt].w;
                if (dir == 0) { if (s0 + 0 > trow) a0 = 0.f; if (s0 + 1 > trow) a1 = 0.f; if (s0 + 2 > trow) a2 = 0.f; if (s0 + 3 > trow) a3 = 0.f; }
                else { if (s0 + 0 < trow) a0 = 0.f; if (s0 + 1 < trow) a1 = 0.f; if (s0 + 2 < trow) a2 = 0.f; if (s0 + 3 < trow) a3 = 0.f; }
                den += (a0 + a1) + (a2 + a3);
                u32x2 o; o.x = cvt_pk(a0, a1); o.y = cvt_pk(a2, a3);
                *(u32x2*)(att + (size_t)trow * 80 + s0) = o;
            }
            __syncthreads();
            f32x4 oacc[8];
#pragma unroll
            for (int et = 0; et < 8; ++et) oacc[et] = (f32x4){0.f, 0.f, 0.f, 0.f};
#pragma unroll
            for (int kk = 0; kk < 2; ++kk) {
                const bf16x8 fa = *(const bf16x8*)(att + (size_t)trow * 80 + kk * 32 + lq * 8);
#pragma unroll
                for (int et = 0; et < 8; ++et) {
                    const bf16x8 fv = *(const bf16x8*)(vT + (size_t)(et * 16 + lr) * 80 + kk * 32 + lq * 8);
                    oacc[et] = __builtin_amdgcn_mfma_f32_16x16x32_bf16(fv, fa, oacc[et], 0, 0, 0);
                }
            }
            const bf16_t* sp = U + (size_t)(chain * NCH + n) * 128 * DK;
#pragma unroll
            for (int kk = 0; kk < DK / 32; ++kk) {
                const bf16x8 fq = *(const bf16x8*)(qin + (size_t)trow * QP + kk * 32 + lq * 8);
#pragma unroll
                for (int et = 0; et < 8; ++et) {
                    const bf16x8 fs = *(const bf16x8*)(sp + (size_t)(et * 16 + lr) * DK + kk * 32 + lq * 8);
                    oacc[et] = __builtin_amdgcn_mfma_f32_16x16x32_bf16(fs, fq, oacc[et], 0, 0, 0);
                }
            }
            if (TYPE == 1) {
                const float* np = UN + (size_t)(chain * NCH + n) * 128 + lq * 32;
#pragma unroll
                for (int q = 0; q < 4; ++q) {
                    const u32x4 u = *(const u32x4*)(qin + (size_t)trow * QP + lq * 32 + q * 8); float f[8]; UNPACK8(u, f);
                    const f32x4 n0 = *(const f32x4*)(np + q * 8), n1 = *(const f32x4*)(np + q * 8 + 4);
                    den += f[0] * n0.x + f[1] * n0.y + f[2] * n0.z + f[3] * n0.w + f[4] * n1.x + f[5] * n1.y + f[6] * n1.z + f[7] * n1.w;
                }
                den += __shfl_xor(den, 16); den += __shfl_xor(den, 32);
                const float sc1 = 1.f / fmaxf(fabsf(den), 1.f);
#pragma unroll
                for (int et = 0; et < 8; ++et) tot[et] += oacc[et] * sc1;
            } else {
#pragma unroll
                for (int et = 0; et < 8; ++et) tot[et] += oacc[et];
            }
            __syncthreads();
        }
        float s1 = 0.f;
#pragma unroll
        for (int et = 0; et < 8; ++et) s1 += (tot[et].x + tot[et].y) + (tot[et].z + tot[et].w);
        s1 += __shfl_xor(s1, 16); s1 += __shfl_xor(s1, 32);
        const float mean = TYPE == 0 ? 0.f : s1 * (1.f / 128.f);
        float s2 = 0.f;
#pragma unroll
        for (int et = 0; et < 8; ++et) { tot[et] = tot[et] - mean; s2 += (tot[et].x * tot[et].x + tot[et].y * tot[et].y) + (tot[et].z * tot[et].z + tot[et].w * tot[et].w); }
        s2 += __shfl_xor(s2, 16); s2 += __shfl_xor(s2, 32);
        const float rstd = rsqrtf(s2 * (1.f / 128.f) + 1e-6f);
        const size_t rowi = (size_t)(r0 + trow);
#pragma unroll
        for (int et = 0; et < 8; ++et) {
            const int e = et * 16 + lq * 4;
            const f32x4 gg = *(const f32x4*)(ng + h * 128 + e);
            const u32x2 gu = *(const u32x2*)(pb + rowi * M::PITCH + M::GOFF + h * 128 + e);
            const float g0 = bflo(gu.x), g1 = bfhi(gu.x), g2 = bflo(gu.y), g3 = bfhi(gu.y);
            u32x2 o;
            float y0 = tot[et].x * rstd * gg.x * siluf(g0), y1 = tot[et].y * rstd * gg.y * siluf(g1), y2 = tot[et].z * rstd * gg.z * siluf(g2), y3 = tot[et].w * rstd * gg.w * siluf(g3);
            o.x = cvt_pk(y0, y1); o.y = cvt_pk(y2, y3);
            *(u32x2*)(brp + rowi * 1536 + pass * 512 + h * 128 + e) = o;
        }
        __syncthreads();
    }
}

template <int TYPE>
__device__ __forceinline__ void out_phase_s(const Params& P, int l, int pass, bool latent_only, char* lds) {
    typedef MX<TYPE> M; constexpr int DK = M::DK; constexpr int QP = M::QP; constexpr int NKK = DK / 32;
    const bf16_t* pb = (const bf16_t*)(ws_l(P) + WS_PBUF);
    const bf16_t* U = (const bf16_t*)(ws_l(P) + WS_SBUF); const float* UN = (const float*)(ws_l(P) + WS_UN);
    const float* small = (const float*)(ws_l(P) + WS_SMALL);
    bf16_t* brp = (bf16_t*)(ws_l(P) + WS_BR);
    bf16_t* vT = (bf16_t*)(lds + L_VT); bf16_t* qr = (bf16_t*)(lds + L_Q); bf16_t* kr = qr + 64 * QP; bf16_t* att = (bf16_t*)(lds + L_ATT);
    float* sc = (float*)(lds + L_SC);
    float* sn = sc + 256;
    float* rsv = sc + 512;
    float* part = sc + 640;
    const float* ng = P.in[TYPE == 1 ? I_MNG : I_RNG] + l * 512;
    const int NC = latent_only ? NCH - 4 : NCH; const int NU = NB * 4 * NC, VG = vgrid(), slot = bid_l();
    for (int u0 = 0; u0 < NU; u0 += VG) {
        int unit = u0 + slot; if (unit >= NU) unit = NU - 1;
        const int tid = tid_l(), lane = tid & 63, wid = tid >> 6, lr = lane & 15, lq = lane >> 4;
        const int c = unit % NC + (latent_only ? 4 : 0); const int rest = unit / NC; const int h = rest & 3, b = rest >> 2;
        const int r0 = rowbase(b, c);
        const int trow = wid * 16 + lr;
        const int chf = (b * 4 + h) * 2, nf = scan_index(0, c), nb = scan_index(1, c);
        const bf16_t* spf = U + (size_t)(chf * NCH + nf) * 128 * DK; const bf16_t* spb = U + (size_t)((chf + 1) * NCH + nb) * 128 * DK;
        bf16x8 fsf[2][NKK], fsb[2][NKK];
#pragma unroll
        for (int i = 0; i < 2; ++i)
#pragma unroll
            for (int kk = 0; kk < NKK; ++kk) {
                fsf[i][kk] = *(const bf16x8*)(spf + (size_t)((2 * wid + i) * 16 + lr) * DK + kk * 32 + lq * 8);
                fsb[i][kk] = *(const bf16x8*)(spb + (size_t)((2 * wid + i) * 16 + lr) * DK + kk * 32 + lq * 8);
            }
        u32x2 gu[4][2];
#pragma unroll
        for (int mt = 0; mt < 4; ++mt)
#pragma unroll
            for (int i = 0; i < 2; ++i) gu[mt][i] = *(const u32x2*)(pb + (size_t)(r0 + mt * 16 + lr) * M::PITCH + M::GOFF + h * 128 + (2 * wid + i) * 16 + lq * 4);
        if (TYPE == 1) {
            sn[tid] = UN[(size_t)((chf + (tid >> 7)) * NCH + ((tid >> 7) == 0 ? nf : nb)) * 128 + (tid & 127)];
            if (tid < 128) {
                const int dir = tid >> 6, t = tid & 63;
                const float fg = small[(size_t)(r0 + t) * 48 + 40 + dir * 4 + h] + P.in[I_FB][l * 8 + dir * 4 + h];
                float v = logsig(fg);
                if (dir == 0) {
#pragma unroll
                    for (int o = 1; o < 64; o <<= 1) { const float n = __shfl_up(v, o); if (t >= o) v += n; }
                } else {
#pragma unroll
                    for (int o = 1; o < 64; o <<= 1) { const float n = __shfl_down(v, o); if (t + o < 64) v += n; }
                }
                sc[dir * 64 + t] = v;
                sc[128 + dir * 64 + t] = small[(size_t)(r0 + t) * 48 + 32 + dir * 4 + h] + P.in[I_IB][l * 8 + dir * 4 + h];
            }
        } else {
            if (tid < 64) {
                const float lg0 = logsig(P.in[I_RDL][l * 8 + h]), lg1 = logsig(P.in[I_RDL][l * 8 + 4 + h]);
                sc[tid] = (float)(tid + 1) * lg0; sc[64 + tid] = (float)(64 - tid) * lg1;
            }
        }
        build_vT<TYPE>(pb, b, c, h, lds);
#pragma unroll
        for (int i = 0; i < 64 * M::NOC / NTHR; ++i) {
            const int pid = tid + i * NTHR, t = pid / M::NOC, oc = pid % M::NOC;
            float q8[8], k8[8];
            load_qk8<TYPE>(P, l, pb, b, c, t, h, oc, false, q8);
            load_qk8<TYPE>(P, l, pb, b, c, t, h, oc, true, k8);
            const float ks = TYPE == 1 ? 0.08838834764831845f : 0.125f;
            u32x4 oq, ok;
            oq.x = cvt_pk(q8[0], q8[1]); oq.y = cvt_pk(q8[2], q8[3]); oq.z = cvt_pk(q8[4], q8[5]); oq.w = cvt_pk(q8[6], q8[7]);
            ok.x = cvt_pk(k8[0] * ks, k8[1] * ks); ok.y = cvt_pk(k8[2] * ks, k8[3] * ks); ok.z = cvt_pk(k8[4] * ks, k8[5] * ks); ok.w = cvt_pk(k8[6] * ks, k8[7] * ks);
            *(u32x4*)(qr + (size_t)t * QP + oc * 8) = oq;
            *(u32x4*)(kr + (size_t)t * QP + oc * 8) = ok;
        }
        __syncthreads();
        f32x4 sacc[4];
#pragma unroll
        for (int nt = 0; nt < 4; ++nt) sacc[nt] = (f32x4){0.f, 0.f, 0.f, 0.f};
#pragma unroll
        for (int kk = 0; kk < NKK; ++kk) {
            const bf16x8 fq = *(const bf16x8*)(qr + (size_t)trow * QP + kk * 32 + lq * 8);
#pragma unroll
            for (int nt = 0; nt < 4; ++nt) {
                const bf16x8 fk = *(const bf16x8*)(kr + (size_t)(nt * 16 + lr) * QP + kk * 32 + lq * 8);
                sacc[nt] = __builtin_amdgcn_mfma_f32_16x16x32_bf16(fk, fq, sacc[nt], 0, 0, 0);
            }
        }
        {
            const float cft = sc[trow], cbt = sc[64 + trow];
            const float eft = __expf(cft), ebt = __expf(cbt);
            float af[4][4], ab[4][4]; float denf = 0.f, denb = 0.f;
#pragma unroll
            for (int nt = 0; nt < 4; ++nt) {
                const float av[4] = {sacc[nt].x, sacc[nt].y, sacc[nt].z, sacc[nt].w};
#pragma unroll
                for (int r = 0; r < 4; ++r) {
                    const int s_ = nt * 16 + lq * 4 + r;
                    const float argf = cft - sc[s_] + (TYPE == 1 ? sc[128 + s_] : 0.f), argb = cbt - sc[64 + s_] + (TYPE == 1 ? sc[192 + s_] : 0.f);
                    const float wf = s_ <= trow ? __expf(argf) : 0.f, wb = s_ >= trow ? __expf(argb) : 0.f;
                    af[nt][r] = av[r] * wf; ab[nt][r] = av[r] * wb; denf += af[nt][r]; denb += ab[nt][r];
                }
            }
            float scf = 1.f, scb = 1.f;
            if (TYPE == 1) {
                float qf = 0.f, qb = 0.f;
#pragma unroll
                for (int q = 0; q < 4; ++q) {
                    const u32x4 u = *(const u32x4*)(qr + (size_t)trow * QP + lq * 32 + q * 8); float f[8]; UNPACK8(u, f);
                    const float* a = sn + lq * 32 + q * 8; const float* bq = sn + 128 + lq * 32 + q * 8;
                    const f32x4 a0 = *(const f32x4*)a, a1 = *(const f32x4*)(a + 4), b0 = *(const f32x4*)bq, b1 = *(const f32x4*)(bq + 4);
                    qf += f[0] * a0.x + f[1] * a0.y + f[2] * a0.z + f[3] * a0.w + f[4] * a1.x + f[5] * a1.y + f[6] * a1.z + f[7] * a1.w;
                    qb += f[0] * b0.x + f[1] * b0.y + f[2] * b0.z + f[3] * b0.w + f[4] * b1.x + f[5] * b1.y + f[6] * b1.z + f[7] * b1.w;
                }
                denf += eft * qf; denb += ebt * qb;
                denf += __shfl_xor(denf, 16); denf += __shfl_xor(denf, 32);
                denb += __shfl_xor(denb, 16); denb += __shfl_xor(denb, 32);
                scf = 1.f / fmaxf(fabsf(denf), 1.f); scb = 1.f / fmaxf(fabsf(denb), 1.f);
            }
#pragma unroll
            for (int nt = 0; nt < 4; ++nt) {
                u32x2 o; o.x = cvt_pk(af[nt][0] * scf + ab[nt][0] * scb, af[nt][1] * scf + ab[nt][1] * scb); o.y = cvt_pk(af[nt][2] * scf + ab[nt][2] * scb, af[nt][3] * scf + ab[nt][3] * scb);
                *(u32x2*)(att + (size_t)trow * 80 + nt * 16 + lq * 4) = o;
            }
            if (lq == 0) { rsv[trow] = eft * scf; rsv[64 + trow] = ebt * scb; }
        }
        __syncthreads();
        f32x4 oacc[4][2];
#pragma unroll
        for (int mt = 0; mt < 4; ++mt)
#pragma unroll
            for (int i = 0; i < 2; ++i) oacc[mt][i] = (f32x4){0.f, 0.f, 0.f, 0.f};
#pragma unroll
        for (int kk = 0; kk < 2; ++kk) {
            bf16x8 fv[2];
#pragma unroll
            for (int i = 0; i < 2; ++i) fv[i] = *(const bf16x8*)(vT + (size_t)((2 * wid + i) * 16 + lr) * 80 + kk * 32 + lq * 8);
#pragma unroll
            for (int mt = 0; mt < 4; ++mt) {
                const bf16x8 fa = *(const bf16x8*)(att + (size_t)(mt * 16 + lr) * 80 + kk * 32 + lq * 8);
#pragma unroll
                for (int i = 0; i < 2; ++i) oacc[mt][i] = __builtin_amdgcn_mfma_f32_16x16x32_bf16(fv[i], fa, oacc[mt][i], 0, 0, 0);
            }
        }
#pragma unroll
        for (int dir = 0; dir < 2; ++dir) {
            f32x4 tmp[4][2];
#pragma unroll
            for (int mt = 0; mt < 4; ++mt)
#pragma unroll
                for (int i = 0; i < 2; ++i) tmp[mt][i] = (f32x4){0.f, 0.f, 0.f, 0.f};
#pragma unroll
            for (int kk = 0; kk < NKK; ++kk)
#pragma unroll
                for (int mt = 0; mt < 4; ++mt) {
                    const bf16x8 fq = *(const bf16x8*)(qr + (size_t)(mt * 16 + lr) * QP + kk * 32 + lq * 8);
#pragma unroll
                    for (int i = 0; i < 2; ++i) tmp[mt][i] = __builtin_amdgcn_mfma_f32_16x16x32_bf16(dir == 0 ? fsf[i][kk] : fsb[i][kk], fq, tmp[mt][i], 0, 0, 0);
                }
#pragma unroll
            for (int mt = 0; mt < 4; ++mt) {
                const float rs = rsv[dir * 64 + mt * 16 + lr];
#pragma unroll
                for (int i = 0; i < 2; ++i) oacc[mt][i] += tmp[mt][i] * rs;
            }
        }
#pragma unroll
        for (int mt = 0; mt < 4; ++mt) {
            float s1 = (oacc[mt][0].x + oacc[mt][0].y) + (oacc[mt][0].z + oacc[mt][0].w) + (oacc[mt][1].x + oacc[mt][1].y) + (oacc[mt][1].z + oacc[mt][1].w);
            float s2 = (oacc[mt][0].x * oacc[mt][0].x + oacc[mt][0].y * oacc[mt][0].y) + (oacc[mt][0].z * oacc[mt][0].z + oacc[mt][0].w * oacc[mt][0].w)
                     + (oacc[mt][1].x * oacc[mt][1].x + oacc[mt][1].y * oacc[mt][1].y) + (oacc[mt][1].z * oacc[mt][1].z + oacc[mt][1].w * oacc[mt][1].w);
            s1 += __shfl_xor(s1, 16); s1 += __shfl_xor(s1, 32); s2 += __shfl_xor(s2, 16); s2 += __shfl_xor(s2, 32);
            if (lq == 0) { part[(wid * 64 + mt * 16 + lr) * 2] = s1; part[(wid * 64 + mt * 16 + lr) * 2 + 1] = s2; }
        }
        __syncthreads();
#pragma unroll
        for (int mt = 0; mt < 4; ++mt) {
            const int t = mt * 16 + lr;
            float s1 = 0.f, s2 = 0.f;
#pragma unroll
            for (int w = 0; w < 4; ++w) { s1 += part[(w * 64 + t) * 2]; s2 += part[(w * 64 + t) * 2 + 1]; }
            const float mean = s1 * (1.f / 128.f);
            const float rstd = rsqrtf(fmaxf(s2 * (1.f / 128.f) - mean * mean, 0.f) + 1e-6f);
            const size_t rowi = (size_t)(r0 + t);
#pragma unroll
            for (int i = 0; i < 2; ++i) {
                const int e = (2 * wid + i) * 16 + lq * 4;
                const f32x4 gg = *(const f32x4*)(ng + h * 128 + e);
                const float g0 = bflo(gu[mt][i].x), g1 = bfhi(gu[mt][i].x), g2 = bflo(gu[mt][i].y), g3 = bfhi(gu[mt][i].y);
                u32x2 o;
                o.x = cvt_pk((oacc[mt][i].x - mean) * rstd * gg.x * siluf(g0), (oacc[mt][i].y - mean) * rstd * gg.y * siluf(g1));
                o.y = cvt_pk((oacc[mt][i].z - mean) * rstd * gg.z * siluf(g2), (oacc[mt][i].w - mean) * rstd * gg.w * siluf(g3));
                *(u32x2*)(brp + rowi * 1536 + pass * 512 + h * 128 + e) = o;
            }
        }
        __syncthreads();
    }
}

__device__ __forceinline__ void out_phase_g(const Params& P, int l, bool latent_only, char* lds) {
    typedef MX<0> M; constexpr int DK = 64, QP = 80;
    const bf16_t* pb = (const bf16_t*)(ws_l(P) + WS_PBUF);
    const bf16_t* U = (const bf16_t*)(ws_l(P) + WS_SBUF);
    const float* small = (const float*)(ws_l(P) + WS_SMALL);
    bf16_t* brp = (bf16_t*)(ws_l(P) + WS_BR);
    bf16_t* vT = (bf16_t*)(lds + L_VT); bf16_t* qin = (bf16_t*)(lds + L_Q); bf16_t* kin = qin + 64 * QP; bf16_t* att = (bf16_t*)(lds + L_ATT);
    float* cum = (float*)(lds + L_CUM); float* part = cum;
    const float* ng = P.in[I_GNG] + l * 512;
    const int NC = latent_only ? NCH - 4 : NCH; const int NU = NB * 4 * NC, VG = vgrid(), slot = bid_l();
    for (int u0 = 0; u0 < NU; u0 += VG) {
        int unit = u0 + slot; if (unit >= NU) unit = NU - 1;
        const int tid = tid_l(), lane = tid & 63, wid = tid >> 6, lr = lane & 15, lq = lane >> 4;
        const int c = unit % NC + (latent_only ? 4 : 0); const int rest = unit / NC; const int h = rest & 3, b = rest >> 2;
        const int r0 = rowbase(b, c);
        const int trow = wid * 16 + lr;
        const int chf = (b * 4 + h) * 2, nf = scan_index(0, c), nb = scan_index(1, c);
        const bf16_t* spf = U + (size_t)(chf * NCH + nf) * 128 * DK; const bf16_t* spb = U + (size_t)((chf + 1) * NCH + nb) * 128 * DK;
        bf16x8 fsf[2][2], fsb[2][2];
#pragma unroll
        for (int i = 0; i < 2; ++i)
#pragma unroll
            for (int kk = 0; kk < 2; ++kk) {
                fsf[i][kk] = *(const bf16x8*)(spf + (size_t)((2 * wid + i) * 16 + lr) * DK + kk * 32 + lq * 8);
                fsb[i][kk] = *(const bf16x8*)(spb + (size_t)((2 * wid + i) * 16 + lr) * DK + kk * 32 + lq * 8);
            }
        u32x2 gu[4][2];
#pragma unroll
        for (int mt = 0; mt < 4; ++mt)
#pragma unroll
            for (int i = 0; i < 2; ++i) gu[mt][i] = *(const u32x2*)(pb + (size_t)(r0 + mt * 16 + lr) * M::PITCH + M::GOFF + h * 128 + (2 * wid + i) * 16 + lq * 4);
        float qraw[2][8], kraw[2][8], apre[2][4];
#pragma unroll
        for (int i = 0; i < 2; ++i) {
            const int pid = tid + i * NTHR, t = pid >> 3, oc = pid & 7;
            load_qk8<0>(P, l, pb, b, c, t, h, oc, false, qraw[i]);
            load_qk8<0>(P, l, pb, b, c, t, h, oc, true, kraw[i]);
        }
#pragma unroll
        for (int dir = 0; dir < 2; ++dir)
#pragma unroll
            for (int k = 0; k < 4; ++k) { const int i = tid + k * NTHR; apre[dir][k] = small[(size_t)(r0 + (i >> 4)) * 48 + dir * 16 + (i & 15)]; }
        build_vT<0>(pb, b, c, h, lds);
        f32x4 oacc[4][2];
#pragma unroll
        for (int mt = 0; mt < 4; ++mt)
#pragma unroll
            for (int i = 0; i < 2; ++i) oacc[mt][i] = (f32x4){0.f, 0.f, 0.f, 0.f};
#pragma unroll
        for (int dir = 0; dir < 2; ++dir) {
            decay_setup<0>(P, l, b, c, h, dir, lds, apre[dir]);
#pragma unroll
            for (int i = 0; i < 2; ++i) {
                const int pid = tid + i * NTHR, t = pid >> 3, oc = pid & 7;
                float q8[8], k8[8];
#pragma unroll
                for (int j = 0; j < 8; ++j) { const float cv = cum[t * 64 + oc * 8 + j]; q8[j] = qraw[i][j] * (__expf(cv) * 0.125f); k8[j] = kraw[i][j] * __expf(-cv); }
                u32x4 oq, ok;
                oq.x = cvt_pk(q8[0], q8[1]); oq.y = cvt_pk(q8[2], q8[3]); oq.z = cvt_pk(q8[4], q8[5]); oq.w = cvt_pk(q8[6], q8[7]);
                ok.x = cvt_pk(k8[0], k8[1]); ok.y = cvt_pk(k8[2], k8[3]); ok.z = cvt_pk(k8[4], k8[5]); ok.w = cvt_pk(k8[6], k8[7]);
                *(u32x4*)(qin + (size_t)t * QP + oc * 8) = oq;
                *(u32x4*)(kin + (size_t)t * QP + oc * 8) = ok;
            }
            __syncthreads();
            f32x4 sacc[4];
#pragma unroll
            for (int nt = 0; nt < 4; ++nt) sacc[nt] = (f32x4){0.f, 0.f, 0.f, 0.f};
#pragma unroll
            for (int kk = 0; kk < 2; ++kk) {
                const bf16x8 fq = *(const bf16x8*)(qin + (size_t)trow * QP + kk * 32 + lq * 8);
#pragma unroll
                for (int nt = 0; nt < 4; ++nt) {
                    const bf16x8 fk = *(const bf16x8*)(kin + (size_t)(nt * 16 + lr) * QP + kk * 32 + lq * 8);
                    sacc[nt] = __builtin_amdgcn_mfma_f32_16x16x32_bf16(fk, fq, sacc[nt], 0, 0, 0);
                }
            }
#pragma unroll
            for (int nt = 0; nt < 4; ++nt) {
                const int s0 = nt * 16 + lq * 4;
                float a0 = sacc[nt].x, a1 = sacc[nt].y, a2 = sacc[nt].z, a3 = sacc[nt].w;
                if (dir == 0) { if (s0 + 0 > trow) a0 = 0.f; if (s0 + 1 > trow) a1 = 0.f; if (s0 + 2 > trow) a2 = 0.f; if (s0 + 3 > trow) a3 = 0.f; }
                else { if (s0 + 0 < trow) a0 = 0.f; if (s0 + 1 < trow) a1 = 0.f; if (s0 + 2 < trow) a2 = 0.f; if (s0 + 3 < trow) a3 = 0.f; }
                u32x2 o; o.x = cvt_pk(a0, a1); o.y = cvt_pk(a2, a3);
                *(u32x2*)(att + (size_t)trow * 80 + s0) = o;
            }
            __syncthreads();
#pragma unroll
            for (int kk = 0; kk < 2; ++kk) {
                bf16x8 fv[2];
#pragma unroll
                for (int i = 0; i < 2; ++i) fv[i] = *(const bf16x8*)(vT + (size_t)((2 * wid + i) * 16 + lr) * 80 + kk * 32 + lq * 8);
#pragma unroll
                for (int mt = 0; mt < 4; ++mt) {
                    const bf16x8 fa = *(const bf16x8*)(att + (size_t)(mt * 16 + lr) * 80 + kk * 32 + lq * 8);
                    const bf16x8 fq = *(const bf16x8*)(qin + (size_t)(mt * 16 + lr) * QP + kk * 32 + lq * 8);
#pragma unroll
                    for (int i = 0; i < 2; ++i) {
                        oacc[mt][i] = __builtin_amdgcn_mfma_f32_16x16x32_bf16(fv[i], fa, oacc[mt][i], 0, 0, 0);
                        oacc[mt][i] = __builtin_amdgcn_mfma_f32_16x16x32_bf16(dir == 0 ? fsf[i][kk] : fsb[i][kk], fq, oacc[mt][i], 0, 0, 0);
                    }
                }
            }
            __syncthreads();
        }
#pragma unroll
        for (int mt = 0; mt < 4; ++mt) {
            float s2 = (oacc[mt][0].x * oacc[mt][0].x + oacc[mt][0].y * oacc[mt][0].y) + (oacc[mt][0].z * oacc[mt][0].z + oacc[mt][0].w * oacc[mt][0].w)
                     + (oacc[mt][1].x * oacc[mt][1].x + oacc[mt][1].y * oacc[mt][1].y) + (oacc[mt][1].z * oacc[mt][1].z + oacc[mt][1].w * oacc[mt][1].w);
            s2 += __shfl_xor(s2, 16); s2 += __shfl_xor(s2, 32);
            if (lq == 0) part[wid * 64 + mt * 16 + lr] = s2;
        }
        __syncthreads();
#pragma unroll
        for (int mt = 0; mt < 4; ++mt) {
            const int t = mt * 16 + lr;
            const float s2 = (part[t] + part[64 + t]) + (part[128 + t] + part[192 + t]);
            const float rstd = rsqrtf(s2 * (1.f / 128.f) + 1e-6f);
            const size_t rowi = (size_t)(r0 + t);
#pragma unroll
            for (int i = 0; i < 2; ++i) {
                const int e = (2 * wid + i) * 16 + lq * 4;
                const f32x4 gg = *(const f32x4*)(ng + h * 128 + e);
                const float g0 = bflo(gu[mt][i].x), g1 = bfhi(gu[mt][i].x), g2 = bflo(gu[mt][i].y), g3 = bfhi(gu[mt][i].y);
                u32x2 o;
                o.x = cvt_pk(oacc[mt][i].x * rstd * gg.x * siluf(g0), oacc[mt][i].y * rstd * gg.y * siluf(g1));
                o.y = cvt_pk(oacc[mt][i].z * rstd * gg.z * siluf(g2), oacc[mt][i].w * rstd * gg.w * siluf(g3));
                *(u32x2*)(brp + rowi * 1536 + h * 128 + e) = o;
            }
        }
        __syncthreads();
    }
}

template <int NI, class F>
__device__ __forceinline__ void ctx_gemm(const bf16_t* A, int lda, const bf16_t* Bt, int ldb, int K, int N, const F& f, char* lds) {
    const int tid = tid_l(), lane = tid & 63, wid = tid >> 6, wm = wid >> 1, wn = wid & 1, lr = lane & 15, lq = lane >> 4;
    const int Nt = (N + 32 * NI - 1) / (32 * NI);
    const int total = 4 * Nt, VG = vgrid(), slot = bid_l();
    for (int t0 = 0; t0 < total; t0 += VG) {
        const int t = t0 + (VG - 1 - slot); if (t >= total) continue;
        const int tm = t & 3, tn = t >> 2;
        f32x4 acc[4][NI];
#pragma unroll
        for (int mi = 0; mi < 4; ++mi)
#pragma unroll
            for (int ni = 0; ni < NI; ++ni) acc[mi][ni] = (f32x4){0.f, 0.f, 0.f, 0.f};
        gemm_kloop<NI>(acc, A + (size_t)(RL + tm * 128) * lda, lda, Bt + (size_t)tn * (32 * NI) * ldb, ldb, K, lds);
#pragma unroll
        for (int mi = 0; mi < 4; ++mi)
#pragma unroll
            for (int ni = 0; ni < NI; ++ni) f(RL + tm * 128 + wm * 64 + mi * 16 + lr, tn * (32 * NI) + wn * (16 * NI) + ni * 16 + lq * 4, acc[mi][ni], 0);
    }
}
__device__ __forceinline__ void ctx_merge(const Params& P, char* lds) {
    const int tid = tid_l(), lane = tid & 63, wid = tid >> 6, wm = wid >> 1, wn = wid & 1, lr = lane & 15, lq = lane >> 4;
    const bf16_t* br = (const bf16_t*)(ws_l(P) + WS_BR); const bf16_t* wb = (const bf16_t*)(ws_l(P) + WS_WTBR);
    const bf16_t* gs = (const bf16_t*)(ws_l(P) + WS_GS); bf16_t* mb = (bf16_t*)(ws_l(P) + WS_MB);
    const int total = 64, VG = vgrid(), slot = bid_l();
    for (int t0 = 0; t0 < total; t0 += VG) {
        const int t = t0 + (VG - 1 - slot); if (t >= total) continue;
        const int tm = t & 3, tn = t >> 2;
        f32x4 m[4][2];
#pragma unroll
        for (int mi = 0; mi < 4; ++mi)
#pragma unroll
            for (int ni = 0; ni < 2; ++ni) m[mi][ni] = (f32x4){0.f, 0.f, 0.f, 0.f};
#pragma unroll 1
        for (int j = 0; j < 3; ++j) {
            f32x4 acc[4][2];
#pragma unroll
            for (int mi = 0; mi < 4; ++mi)
#pragma unroll
                for (int ni = 0; ni < 2; ++ni) acc[mi][ni] = (f32x4){0.f, 0.f, 0.f, 0.f};
            gemm_kloop<2>(acc, br + (size_t)(RL + tm * 128) * 1536 + j * 512, 1536, wb + ((size_t)j * 1024 + tn * 64) * 512, 512, 512, lds);
#pragma unroll
            for (int mi = 0; mi < 4; ++mi)
#pragma unroll
                for (int ni = 0; ni < 2; ++ni) {
                    const int r = RL + tm * 128 + wm * 64 + mi * 16 + lr, c = tn * 64 + wn * 32 + ni * 16 + lq * 4;
                    const u32x2 g = *(const u32x2*)(gs + (size_t)r * 3072 + j * 1024 + c);
                    m[mi][ni].x += acc[mi][ni].x * bflo(g.x); m[mi][ni].y += acc[mi][ni].y * bfhi(g.x);
                    m[mi][ni].z += acc[mi][ni].z * bflo(g.y); m[mi][ni].w += acc[mi][ni].w * bfhi(g.y);
                }
        }
#pragma unroll
        for (int mi = 0; mi < 4; ++mi)
#pragma unroll
            for (int ni = 0; ni < 2; ++ni) {
                const int r = RL + tm * 128 + wm * 64 + mi * 16 + lr, c = tn * 64 + wn * 32 + ni * 16 + lq * 4;
                u32x2 o; o.x = cvt_pk(m[mi][ni].x, m[mi][ni].y); o.y = cvt_pk(m[mi][ni].z, m[mi][ni].w);
                *(u32x2*)(mb + (size_t)r * 1024 + c) = o;
            }
    }
}


#define XB_TMO      128
#define XB_XCNT(j)  (256  + 64 * (j))
#define XB_XSUB(j)  (1280 + 64 * (j))
#define XB_XGEN(j)  (2304 + 64 * (j))
#define XB_TOP      3328
#define XB_TOPGEN   3392
#define XCD_BAR_WORDS 3456
#define XB_SPIN_CAP (1u << 18)
__device__ __forceinline__ unsigned xb_ld(unsigned* p)              { return __hip_atomic_load(p, __ATOMIC_RELAXED, __HIP_MEMORY_SCOPE_AGENT); }
__device__ __forceinline__ unsigned xb_add(unsigned* p, unsigned v) { return __hip_atomic_fetch_add(p, v, __ATOMIC_RELAXED, __HIP_MEMORY_SCOPE_AGENT); }
__device__ __forceinline__ unsigned xb_xcc_id() { return (unsigned)__builtin_amdgcn_s_getreg((3 << 11) | 20) & 0xFu; }
#define XB_SPIN(cond, bar) do { unsigned _sp = 0; while (cond) { __builtin_amdgcn_s_sleep(1); \
    if ((++_sp & 255u) == 0u) { if (xb_ld(&(bar)[XB_TMO])) break; if (_sp > XB_SPIN_CAP) { atomicAdd(&(bar)[XB_TMO], 1u); break; } } } } while (0)
struct XcdBarrier { unsigned* bar; unsigned x; volatile LAS unsigned* st; };
__device__ __forceinline__ XcdBarrier xcd_barrier_post(unsigned* bar, volatile LAS unsigned* st) {
    XcdBarrier b; b.bar = bar; b.x = xb_xcc_id(); b.st = st;
    if (threadIdx.x == 0) (void)xb_add(&bar[XB_XCNT(b.x)], 1u);
    return b;
}
__device__ __forceinline__ void xcd_barrier_complete(unsigned* bar, unsigned x, unsigned& nloc, unsigned& nx) {
    const unsigned G = gridDim.x * gridDim.y * gridDim.z;
    unsigned sum, cnt, mine, sp = 0u;
    for (;;) {
        sum = 0u; cnt = 0u; mine = 0u;
#pragma unroll
        for (unsigned j = 0; j < 16; ++j) { const unsigned c = xb_ld(&bar[XB_XCNT(j)]); sum += c; cnt += (c > 0u) ? 1u : 0u; mine = (j == x) ? c : mine; }
        if (sum == G) break;
        __builtin_amdgcn_s_sleep(1);
        if ((++sp & 255u) == 0u) { if (xb_ld(&bar[XB_TMO])) break; if (sp > XB_SPIN_CAP) { atomicAdd(&bar[XB_TMO], 1u); break; } }
    }
    nloc = mine > 0u ? mine : 1u; nx = cnt > 0u ? cnt : 1u;
}
__device__ __forceinline__ void xcd_barrier(const XcdBarrier& b) {
    asm volatile("s_waitcnt vmcnt(0)" ::: "memory");
    __syncthreads();
    if (threadIdx.x == 0) {
        unsigned* bar = b.bar;
        __builtin_amdgcn_s_waitcnt(0);
        unsigned nloc = b.st[0], nx = b.st[1];
        if (nloc == 0u) { xcd_barrier_complete(bar, b.x, nloc, nx); b.st[0] = nloc; b.st[1] = nx; }
        const unsigned old = xb_add(&bar[XB_XSUB(b.x)], 1u);
        const unsigned gen = old / nloc;
        if (old + 1u == (gen + 1u) * nloc) {
            __builtin_amdgcn_fence(__ATOMIC_RELEASE, "agent");
            asm volatile("s_waitcnt vmcnt(0)" ::: "memory");
            const unsigned og = xb_add(&bar[XB_TOP], 1u);
            const unsigned tg = og / nx;
            if (og + 1u == (tg + 1u) * nx) xb_add(&bar[XB_TOPGEN], 1u);
            else XB_SPIN(xb_ld(&bar[XB_TOPGEN]) == tg, bar);
            __builtin_amdgcn_fence(__ATOMIC_ACQUIRE, "agent");
            xb_add(&bar[XB_XGEN(b.x)], 1u);
            asm volatile("s_waitcnt vmcnt(0)" ::: "memory");
        } else {
            XB_SPIN(xb_ld(&bar[XB_XGEN(b.x)]) == gen, bar);
            __builtin_amdgcn_fence(__ATOMIC_ACQUIRE, "agent");
            asm volatile("s_waitcnt vmcnt(0)" ::: "memory");
        }
    }
    __syncthreads();
}

__global__ void __launch_bounds__(512, 2) fwd_kernel(Params P) {
    extern __shared__ __attribute__((aligned(16))) unsigned char lds_raw[];
    cg::grid_group grid = cg::this_grid();
    LAS unsigned char* ldsb = (LAS unsigned char*)lds_raw;
#define LDSH ((char*)lds_raw + __builtin_amdgcn_readfirstlane(threadIdx.x >> 8) * HALF_LDS)
    volatile LAS unsigned* bst = (volatile LAS unsigned*)(ldsb + 2 * HALF_LDS);
    if (threadIdx.x < 2) bst[threadIdx.x] = 0u;
    __syncthreads();
    XcdBarrier xbar = xcd_barrier_post((unsigned*)(P.ws + WS_BAR), bst);
    int ph = 0;
#define PHASE_BEGIN if (ph >= P.lo && ph < P.hi) {
#define PHASE_END } ++ph; if (P.coop && ph > P.lo && ph < P.hi) { if (ph == 1) grid.sync(); else xcd_barrier(xbar); }

    PHASE_BEGIN
        {
        { const int VG = vgrid(), slot = bid_l();
          for (int i0 = 0; i0 < 384; i0 += VG) { int it = i0 + slot; if (it >= 384) it = 383; mods_task(P, it, LDSH); } }
        if (bid_l() == vgrid() - 1) rope_task(P);
        convert_all(P, 0, LDSH);
        }
    PHASE_END

    const XPtr Xin{(float*)P.in[I_X], (float*)P.in[I_CTX]};
    const XPtr Xcur{P.out, (float*)(P.ws + WS_CTXX)};

    for (int l = 0; l < 2; ++l) {
        const XPtr Xold = l == 0 ? Xin : Xcur;
        const bool ctx_on = (l == 0);
        PHASE_BEGIN
            {
            if (l == 1) convert_all(P, 1, LDSH);
            norm_phase(P, Xold, P.in[I_N1G] + l * D, l, 0, R);
            }
        PHASE_END
        PHASE_BEGIN
            const bf16_t* hb = (const bf16_t*)(ws_l(P) + WS_HBUF); const bf16_t* wt = (const bf16_t*)(ws_l(P) + WS_WTIN);
            EpiP e{(bf16_t*)(ws_l(P) + WS_PBUF), 1536, 1536, (float*)(ws_l(P) + WS_SMALL)};
            {
            big_gemm(ldsb, hb, 1024, wt, 1024, 1792, e);
            ctx_gemm<4>(hb, 1024, wt, 1024, 1024, 1664, e, LDSH); }
        PHASE_END
        PHASE_BEGIN u_phase<0>(P, l, LDSH); PHASE_END
        PHASE_BEGIN scan_phase<64, false>(P); PHASE_END
        PHASE_BEGIN out_phase_g(P, l, !ctx_on, LDSH); PHASE_END
        PHASE_BEGIN
            const bf16_t* hb = (const bf16_t*)(ws_l(P) + WS_HBUF); const bf16_t* wt = (const bf16_t*)(ws_l(P) + WS_WTIN) + (size_t)1792 * 1024;
            EpiP e{(bf16_t*)(ws_l(P) + WS_PBUF), 2048, 2048, nullptr};
            {
            big_gemm(ldsb, hb, 1024, wt, 1024, 2048, e);
            ctx_gemm<2>(hb, 1024, wt, 1024, 1024, 2048, e, LDSH); }
        PHASE_END
        PHASE_BEGIN u_phase_s<1>(P, l, LDSH); PHASE_END
        PHASE_BEGIN scan_phase<128, true>(P); PHASE_END
        PHASE_BEGIN out_phase_s<1>(P, l, 1, !ctx_on, LDSH); PHASE_END
        PHASE_BEGIN
            const bf16_t* hb = (const bf16_t*)(ws_l(P) + WS_HBUF); const bf16_t* wt = (const bf16_t*)(ws_l(P) + WS_WTIN) + (size_t)3840 * 1024;
            EpiP e{(bf16_t*)(ws_l(P) + WS_PBUF), 1536, 1536, nullptr};
            {
            big_gemm(ldsb, hb, 1024, wt, 1024, 1536, e);
            ctx_gemm<4>(hb, 1024, wt, 1024, 1024, 1536, e, LDSH); }
        PHASE_END
        PHASE_BEGIN u_phase_s<2>(P, l, LDSH); PHASE_END
        PHASE_BEGIN scan_phase<64, false>(P); PHASE_END
        PHASE_BEGIN out_phase_s<2>(P, l, 2, !ctx_on, LDSH); PHASE_END
        PHASE_BEGIN
            const bf16_t* hb = (const bf16_t*)(ws_l(P) + WS_HBUF); const bf16_t* wt = (const bf16_t*)(ws_l(P) + WS_WTIN) + (size_t)5376 * 1024;
            EpiSig e{(bf16_t*)(ws_l(P) + WS_GS)};
            {
            big_gemm(ldsb, hb, 1024, wt, 1024, 3072, e);
            if (ctx_on) ctx_gemm<2>(hb, 1024, wt, 1024, 1024, 3072, e, LDSH); }
        PHASE_END
        PHASE_BEGIN
            {   pg8::Gemm g{(const bf16_t*)(ws_l(P) + WS_BR), (const bf16_t*)(ws_l(P) + WS_WTBR), 1536, 512};
                pg8::MergeOrder S; S.S.init(RL, 1024, (int)gridDim.x, (int)blockIdx.x);
                pg8::Epi<EpiMerge> E{EpiMerge{(const bf16_t*)(ws_l(P) + WS_GS), (bf16_t*)(ws_l(P) + WS_MB)}};
                pg8::gemm_phase(ldsb, g, S, E);
                __syncthreads(); }
            if (ctx_on) ctx_merge(P, LDSH);
        PHASE_END
        PHASE_BEGIN
            const float* mods_l = (const float*)(ws_l(P) + WS_MODS) + (size_t)l * 3 * 6144;
            EpiRes e{Xold, Xcur, mods_l, 2};
            big_gemm(ldsb, (const bf16_t*)(ws_l(P) + WS_MB), 1024, (const bf16_t*)(ws_l(P) + WS_WTO), 1024, 1024, e);
            if (ctx_on) ctx_gemm<1>((const bf16_t*)(ws_l(P) + WS_MB), 1024, (const bf16_t*)(ws_l(P) + WS_WTO), 1024, 1024, 1024, e, LDSH);
        PHASE_END
        PHASE_BEGIN norm_phase(P, Xcur, P.in[I_N2G] + l * D, l, 3, ctx_on ? R : RL); PHASE_END
        PHASE_BEGIN
            const bf16_t* hb = (const bf16_t*)(ws_l(P) + WS_HBUF);
            EpiRelu2 e{(bf16_t*)(ws_l(P) + WS_HID)};
            {
            big_gemm(ldsb, hb, 1024, (const bf16_t*)(ws_l(P) + WS_WTUP), 1024, 4096, e);
            if (ctx_on) ctx_gemm<2>(hb, 1024, (const bf16_t*)(ws_l(P) + WS_WTUP), 1024, 1024, 4096, e, LDSH); }
        PHASE_END
        PHASE_BEGIN
            const float* mods_l = (const float*)(ws_l(P) + WS_MODS) + (size_t)l * 3 * 6144;
            EpiRes e{Xcur, Xcur, mods_l, 5};
            big_gemm(ldsb, (const bf16_t*)(ws_l(P) + WS_HID), 4096, (const bf16_t*)(ws_l(P) + WS_WTDN), 4096, 1024, e);
            if (ctx_on) ctx_gemm<1>((const bf16_t*)(ws_l(P) + WS_HID), 4096, (const bf16_t*)(ws_l(P) + WS_WTDN), 4096, 4096, 1024, e, LDSH);
        PHASE_END
    }
    PHASE_BEGIN final_norm_phase(P); PHASE_END
#undef PHASE_BEGIN
#undef PHASE_END
}
constexpr int NPHASES = 1 + 2 * 19 + 1;

extern "C" void kernel_launch(void* const* d_in, const int* in_sizes, int n_in, void* d_out, int out_size, void* d_ws, size_t ws_size, hipStream_t stream) {
    static int grid = 0;
    if (grid == 0) {
        if (n_in != 23 || ws_size < WS_END || out_size != NB * SEQ * D) { fprintf(stderr, "kernel_launch: unexpected sizes n_in %d ws %zu (need %zu) out %d\n", n_in, ws_size, (size_t)WS_END, out_size); grid = -1; return; }
        int dev = 0, cus = 0, per_cu = 0;
        if (hipGetDevice(&dev) != hipSuccess || hipDeviceGetAttribute(&cus, hipDeviceAttributeMultiprocessorCount, dev) != hipSuccess) { grid = -1; return; }
        if (hipFuncSetAttribute((const void*)fwd_kernel, hipFuncAttributeMaxDynamicSharedMemorySize, LDS_BYTES) != hipSuccess) { fprintf(stderr, "kernel_launch: hipFuncSetAttribute failed\n"); grid = -1; return; }
        if (hipOccupancyMaxActiveBlocksPerMultiprocessor(&per_cu, (const void*)fwd_kernel, 512, LDS_BYTES) != hipSuccess || per_cu < 1) { fprintf(stderr, "kernel_launch: occupancy query failed (%d)\n", per_cu); grid = -1; return; }
        grid = cus;
        grid -= grid % 8;
    }
    if (grid < 0) return;
    if (hipMemsetAsync((char*)d_ws + WS_BAR, 0, (size_t)3456 * 4, stream) != hipSuccess) { fprintf(stderr, "kernel_launch: memset failed\n"); return; }
    Params p{};
    for (int i = 0; i < 23; ++i) p.in[i] = (const float*)d_in[i];
    p.out = (float*)d_out; p.ws = (unsigned char*)d_ws;
    p.lo = 0; p.hi = NPHASES; p.coop = 1;
    void* args[] = {&p};
    hipError_t e = hipLaunchCooperativeKernel((const void*)fwd_kernel, dim3(grid), dim3(512), args, LDS_BYTES, stream);
    if (e != hipSuccess) fprintf(stderr, "kernel_launch: cooperative launch failed: %s (grid %d)\n", hipGetErrorString(e), grid);
}
```

```cpp
#include <hip/hip_runtime.h>
#include <hip/hip_cooperative_groups.h>
#include <stdint.h>
#include <stdio.h>
namespace cg = cooperative_groups;

#define LAS __attribute__((address_space(3)))
typedef unsigned short bf16_t;
typedef short bf16x8 __attribute__((ext_vector_type(8)));
typedef float f32x4 __attribute__((ext_vector_type(4)));
typedef unsigned u32x4 __attribute__((ext_vector_type(4)));
typedef unsigned u32x2 __attribute__((ext_vector_type(2)));

constexpr int D = 1024, NB = 2, SEQ = 8192, CTX = 256, RB = SEQ + CTX, R = NB * RB, RL = NB * SEQ, NCH = RB / 64, FF = 4096;
constexpr int INW = 8240;
constexpr int NTHR = 256;
constexpr int HALF_LDS = 73728;
constexpr int LDS_BYTES = 2 * HALF_LDS + 16;

constexpr size_t WS_WTIN = 0;
constexpr size_t WS_WTBR = WS_WTIN + (size_t)8448 * 1024 * 2;
constexpr size_t WS_WTO = WS_WTBR + (size_t)3 * 1024 * 512 * 2;
constexpr size_t WS_WTUP = WS_WTO + (size_t)1024 * 1024 * 2;
constexpr size_t WS_WTDN = WS_WTUP + (size_t)4096 * 1024 * 2;
constexpr size_t WS_HBUF = WS_WTDN + (size_t)4096 * 1024 * 2;
constexpr size_t WS_PBUF = WS_HBUF + (size_t)R * 1024 * 2;
constexpr size_t WS_SBUF = WS_PBUF + (size_t)R * 2048 * 2;
constexpr size_t WS_BR = WS_SBUF + (size_t)R * 2048 * 2;
constexpr size_t WS_CTXX = WS_BR + (size_t)R * 1536 * 2;
constexpr size_t WS_SMALL = WS_CTXX + (size_t)512 * 1024 * 4;
constexpr size_t WS_DEC = WS_SMALL + (size_t)R * 48 * 4;
constexpr size_t WS_UN = WS_DEC + (size_t)16 * NCH * 128 * 4;
constexpr size_t WS_MODS = WS_UN + (size_t)16 * NCH * 128 * 4;
constexpr size_t WS_ROPE = WS_MODS + (size_t)2 * 3 * 6144 * 4;
constexpr size_t WS_BAR = WS_ROPE + (size_t)(128 + 64) * 16 * 2 * 4;
constexpr size_t WS_END = WS_BAR + (size_t)3456 * 4;
constexpr size_t WS_GS = WS_PBUF;
constexpr size_t WS_MB = WS_PBUF + (size_t)R * 3072 * 2;
constexpr size_t WS_HID = WS_PBUF;

struct Params { const float* in[23]; float* out; unsigned char* ws; int lo, hi, coop, pad; };

__device__ __forceinline__ int tid_l() { int t = threadIdx.x & 255; asm volatile("" : "+v"(t)); return t; }
__device__ __forceinline__ int bid_l() { int t = blockIdx.x * 2 + (__builtin_amdgcn_readfirstlane(threadIdx.x >> 8)); asm volatile("" : "+s"(t)); return t; }
__device__ __forceinline__ int vgrid() { return gridDim.x * 2; }
__device__ __forceinline__ unsigned char* ws_l(const Params& P) { unsigned char* w = P.ws; asm volatile("" : "+s"(w)); return w; }
enum { I_X = 0, I_C, I_CTX, I_CCTX, I_N1G, I_N2G, I_WADA, I_BADA, I_WIN, I_A2, I_ABIAS, I_GNG, I_CONV, I_IB, I_FB, I_MNG, I_RDL, I_RNG, I_WBR, I_WO, I_WUP, I_WDN, I_FG };

typedef __bf16 bf16x2_t __attribute__((ext_vector_type(2)));
typedef float f32x2 __attribute__((ext_vector_type(2)));
__device__ __forceinline__ unsigned cvt_pk(float lo, float hi) { f32x2 v = {lo, hi}; bf16x2_t b = __builtin_convertvector(v, bf16x2_t); return __builtin_bit_cast(unsigned, b); }
__device__ __forceinline__ float bflo(unsigned u) { return __uint_as_float(u << 16); }
__device__ __forceinline__ float bfhi(unsigned u) { return __uint_as_float(u & 0xffff0000u); }
__device__ __forceinline__ float wave_sum(float v) {
#pragma unroll
    for (int o = 32; o > 0; o >>= 1) v += __shfl_xor(v, o);
    return v;
}
__device__ __forceinline__ float logsig(float x) { return fminf(x, 0.f) - log1pf(__expf(-fabsf(x))); }
__device__ __forceinline__ float siluf(float x) { return x * __builtin_amdgcn_rcpf(1.f + __expf(-x)); }
__device__ __forceinline__ float sigmf(float x) { return __builtin_amdgcn_rcpf(1.f + __expf(-x)); }

struct XPtr { float* lat; float* ctx; };
__device__ __forceinline__ float* xrow(const XPtr& X, int r) { return r < RL ? X.lat + (size_t)r * D : X.ctx + (size_t)(r - RL) * D; }
__device__ __forceinline__ int modidx(int r) { return r < SEQ ? 0 : (r < RL ? 1 : 2); }
__device__ __forceinline__ int rowbase(int b, int c) { return c < 4 ? RL + b * CTX + c * 64 : b * SEQ + (c - 4) * 64; }

#define UNPACK8(u, f) do { f[0] = bflo(u.x); f[1] = bfhi(u.x); f[2] = bflo(u.y); f[3] = bfhi(u.y); f[4] = bflo(u.z); f[5] = bfhi(u.z); f[6] = bflo(u.w); f[7] = bfhi(u.w); } while (0)

__device__ __forceinline__ void mods_task(const Params& P, int task, char* lds) {
    float* s = (float*)lds;
    float* red = (float*)(lds + 12288);
    const int tid = tid_l();
    const int l = task / 192, col0 = (task % 192) * 32;
    const float* c = P.in[I_C]; const float* cc = P.in[I_CCTX];
    for (int i = tid; i < 3072; i += NTHR) { const int v = i >> 10, k = i & 1023; const float cv = v < 2 ? c[v * 1024 + k] : cc[k]; s[i] = siluf(cv); }
    __syncthreads();
    const int col = tid & 31, kg = tid >> 5;
    const float* w = P.in[I_WADA] + (size_t)l * D * 6144 + col0 + col;
    float a0 = 0.f, a1 = 0.f, a2 = 0.f;
#pragma unroll 32
    for (int k = kg * 128; k < kg * 128 + 128; ++k) { const float wv = w[(size_t)k * 6144]; a0 += s[k] * wv; a1 += s[1024 + k] * wv; a2 += s[2048 + k] * wv; }
    red[(kg * 32 + col) * 3 + 0] = a0; red[(kg * 32 + col) * 3 + 1] = a1; red[(kg * 32 + col) * 3 + 2] = a2;
    __syncthreads();
    if (tid < 96) {
        const int v = tid >> 5, c2 = tid & 31; float sum = 0.f;
#pragma unroll
        for (int g = 0; g < 8; ++g) sum += red[(g * 32 + c2) * 3 + v];
        sum += P.in[I_BADA][l * 6144 + col0 + c2];
        ((float*)(ws_l(P) + WS_MODS))[(l * 3 + v) * 6144 + col0 + c2] = sum;
    }
    __syncthreads();
}

__device__ __forceinline__ void rope_task(const Params& P) {
    float* tab = (float*)(ws_l(P) + WS_ROPE);
    for (int i = tid_l(); i < 192 * 16; i += NTHR) {
        const int pos = i >> 4, f = i & 15;
        const float inv = exp2f(-(float)f * (13.287712379549449f / 16.f));
        const float p = pos < 128 ? (float)pos : (float)(pos - 128);
        const float ang = p * inv;
        const float cs = cosf(ang), sn = sinf(ang);
        if (pos < 128) { tab[pos * 16 + f] = cs; tab[2048 + pos * 16 + f] = sn; }
        else { tab[4096 + (pos - 128) * 16 + f] = cs; tab[4096 + 1024 + (pos - 128) * 16 + f] = sn; }
    }
}

__device__ __forceinline__ void transpose_tile(const float* src, int ldsrc, int k0, int n0src, int nvalid, bf16_t* dst, int ldd, int drow0, char* lds) {
    float* tile = (float*)lds;
    const int tid = tid_l(), nl = tid & 63, kq = tid >> 6;
    float v[32];
#pragma unroll
    for (int i = 0; i < 32; ++i) v[i] = nl < nvalid ? src[(size_t)(k0 + kq + 4 * i) * ldsrc + n0src + nl] : 0.f;
#pragma unroll
    for (int i = 0; i < 32; ++i) tile[(kq + 4 * i) * 65 + nl] = v[i];
    __syncthreads();
    const int n = tid >> 2, ks = (tid & 3) * 32;
    if (n < nvalid) {
        u32x4* dp = (u32x4*)(dst + (size_t)(drow0 + n) * ldd + k0 + ks);
#pragma unroll
        for (int q = 0; q < 4; ++q) {
            u32x4 o;
            o.x = cvt_pk(tile[(ks + 8 * q + 0) * 65 + n], tile[(ks + 8 * q + 1) * 65 + n]); o.y = cvt_pk(tile[(ks + 8 * q + 2) * 65 + n], tile[(ks + 8 * q + 3) * 65 + n]);
            o.z = cvt_pk(tile[(ks + 8 * q + 4) * 65 + n], tile[(ks + 8 * q + 5) * 65 + n]); o.w = cvt_pk(tile[(ks + 8 * q + 6) * 65 + n], tile[(ks + 8 * q + 7) * 65 + n]);
            dp[q] = o;
        }
    }
    __syncthreads();
}

constexpr int CONV_TILES = 192 + 8 + 8 + 256 + 192 + 384 + 192 + 128 + 512 + 512;
__device__ __forceinline__ void convert_tile(const Params& P, int l, int it, char* lds) {
    const float* win = P.in[I_WIN] + (size_t)l * D * INW;
    bf16_t* wtin = (bf16_t*)(ws_l(P) + WS_WTIN);
    int r = it;
    if (r < 192) { const int kt = r / 24, nt = r % 24; transpose_tile(win, INW, kt * 128, nt * 64, 64, wtin, 1024, nt * 64, lds); return; } r -= 192;
    if (r < 8) { transpose_tile(win, INW, r * 128, 1536, 32, wtin, 1024, 1536, lds); return; } r -= 8;
    if (r < 8) { transpose_tile(win, INW, r * 128, 3616, 16, wtin, 1024, 1568, lds); return; } r -= 8;
    if (r < 256) { const int kt = r / 32, nt = r % 32; transpose_tile(win, INW, kt * 128, 1568 + nt * 64, 64, wtin, 1024, 1792 + nt * 64, lds); return; } r -= 256;
    if (r < 192) { const int kt = r / 24, nt = r % 24; transpose_tile(win, INW, kt * 128, 3632 + nt * 64, 64, wtin, 1024, 3840 + nt * 64, lds); return; } r -= 192;
    if (r < 384) { const int kt = r / 48, nt = r % 48; transpose_tile(win, INW, kt * 128, 5168 + nt * 64, 64, wtin, 1024, 5376 + nt * 64, lds); return; } r -= 384;
    if (r < 192) { const int j = r / 64, q = r % 64, kt = q / 16, nt = q % 16;
        transpose_tile(P.in[I_WBR] + ((size_t)l * 3 + j) * 512 * 1024, 1024, kt * 128, nt * 64, 64, (bf16_t*)(ws_l(P) + WS_WTBR), 512, j * 1024 + nt * 64, lds); return; } r -= 192;
    if (r < 128) { const int kt = r / 16, nt = r % 16; transpose_tile(P.in[I_WO] + (size_t)l * D * D, 1024, kt * 128, nt * 64, 64, (bf16_t*)(ws_l(P) + WS_WTO), 1024, nt * 64, lds); return; } r -= 128;
    if (r < 512) { const int kt = r / 64, nt = r % 64; transpose_tile(P.in[I_WUP] + (size_t)l * D * FF, 4096, kt * 128, nt * 64, 64, (bf16_t*)(ws_l(P) + WS_WTUP), 1024, nt * 64, lds); return; } r -= 512;
    { const int kt = r / 16, nt = r % 16; transpose_tile(P.in[I_WDN] + (size_t)l * FF * D, 1024, kt * 128, nt * 64, 64, (bf16_t*)(ws_l(P) + WS_WTDN), 4096, nt * 64, lds); }
}
__device__ __forceinline__ void convert_all(const Params& P, int l, char* lds) {
    const int VG = vgrid(), slot = bid_l();
    static_assert(CONV_TILES % 2 == 0, "both halves of a workgroup must be active together");
    for (int i0 = 0; i0 < CONV_TILES; i0 += VG) { const int it = i0 + slot; if (it >= CONV_TILES) continue; convert_tile(P, l, it, lds); }
}

__device__ __forceinline__ void norm_phase(const Params& P, XPtr X, const float* g, int l, int sidx, int nrows) {
    const int lane = tid_l() & 63; const int gw = bid_l() * 4 + (tid_l() >> 6), ngw = vgrid() * 4;
    bf16_t* hb = (bf16_t*)(ws_l(P) + WS_HBUF);
    const float* mods = (const float*)(ws_l(P) + WS_MODS) + (size_t)l * 3 * 6144;
    for (int r = gw; r < nrows; r += 2 * ngw) {
        const int r1 = r + ngw; const bool has1 = r1 < nrows; const int rr1 = has1 ? r1 : r;
        const f32x4* xa = (const f32x4*)xrow(X, r); const f32x4* xb = (const f32x4*)xrow(X, rr1);
        f32x4 va[4], vb[4]; float sa_ = 0.f, sb_ = 0.f;
#pragma unroll
        for (int j = 0; j < 4; ++j) { va[j] = xa[lane + 64 * j]; vb[j] = xb[lane + 64 * j]; }
#pragma unroll
        for (int j = 0; j < 4; ++j) { sa_ += va[j].x * va[j].x + va[j].y * va[j].y + va[j].z * va[j].z + va[j].w * va[j].w; sb_ += vb[j].x * vb[j].x + vb[j].y * vb[j].y + vb[j].z * vb[j].z + vb[j].w * vb[j].w; }
        sa_ = wave_sum(sa_); sb_ = wave_sum(sb_);
        const float rsa = rsqrtf(sa_ * (1.f / 1024.f) + 1e-6f), rsb = rsqrtf(sb_ * (1.f / 1024.f) + 1e-6f);
        const float* mda = mods + modidx(r) * 6144; const float* mdb = mods + modidx(rr1) * 6144;
#pragma unroll
        for (int j = 0; j < 4; ++j) {
            const int col = (lane + 64 * j) * 4;
            const f32x4 gg = *(const f32x4*)(g + col);
            { const f32x4 sh = *(const f32x4*)(mda + sidx * 1024 + col), sc = *(const f32x4*)(mda + (sidx + 1) * 1024 + col);
              const f32x4 hh = va[j] * rsa * gg * (sc + 1.f) + sh; u32x2 o; o.x = cvt_pk(hh.x, hh.y); o.y = cvt_pk(hh.z, hh.w); *(u32x2*)(hb + (size_t)r * 1024 + col) = o; }
            if (has1) { const f32x4 sh = *(const f32x4*)(mdb + sidx * 1024 + col), sc = *(const f32x4*)(mdb + (sidx + 1) * 1024 + col);
              const f32x4 hh = vb[j] * rsb * gg * (sc + 1.f) + sh; u32x2 o; o.x = cvt_pk(hh.x, hh.y); o.y = cvt_pk(hh.z, hh.w); *(u32x2*)(hb + (size_t)r1 * 1024 + col) = o; }
        }
    }
}
__device__ __forceinline__ void final_norm_phase(const Params& P) {
    const int lane = tid_l() & 63; const int gw = bid_l() * 4 + (tid_l() >> 6), ngw = vgrid() * 4;
    const float* g = P.in[I_FG];
    for (int r = gw; r < RL; r += 2 * ngw) {
        const int r1 = r + ngw;
        f32x4* xa = (f32x4*)(P.out + (size_t)r * D); f32x4* xb = (f32x4*)(P.out + (size_t)r1 * D);
        f32x4 va[4], vb[4]; float sa_ = 0.f, sb_ = 0.f;
#pragma unroll
        for (int j = 0; j < 4; ++j) { va[j] = xa[lane + 64 * j]; vb[j] = xb[lane + 64 * j]; }
#pragma unroll
        for (int j = 0; j < 4; ++j) { sa_ += va[j].x * va[j].x + va[j].y * va[j].y + va[j].z * va[j].z + va[j].w * va[j].w; sb_ += vb[j].x * vb[j].x + vb[j].y * vb[j].y + vb[j].z * vb[j].z + vb[j].w * vb[j].w; }
        sa_ = wave_sum(sa_); sb_ = wave_sum(sb_);
        const float rsa = rsqrtf(sa_ * (1.f / 1024.f) + 1e-6f), rsb = rsqrtf(sb_ * (1.f / 1024.f) + 1e-6f);
#pragma unroll
        for (int j = 0; j < 4; ++j) { const f32x4 gg = *(const f32x4*)(g + (lane + 64 * j) * 4); xa[lane + 64 * j] = va[j] * rsa * gg; xb[lane + 64 * j] = vb[j] * rsb * gg; }
    }
}

struct EpiP {
    bf16_t* Pb; int pitch; int nmain; float* small;
    __device__ __forceinline__ void operator()(int r, int c, const f32x4& v, int) const {
        if (c < nmain) { u32x2 o; o.x = cvt_pk(v.x, v.y); o.y = cvt_pk(v.z, v.w); *(u32x2*)(Pb + (size_t)r * pitch + c) = o; }
        else { const int cc = c - nmain; if (cc < 48) *(f32x4*)(small + (size_t)r * 48 + cc) = v; }
    }
    __device__ __forceinline__ void w8(int r, int c, const f32x4& v0, const f32x4& v1, int) const {
        if (c < nmain) { u32x4 o; o.x = cvt_pk(v0.x, v0.y); o.y = cvt_pk(v0.z, v0.w); o.z = cvt_pk(v1.x, v1.y); o.w = cvt_pk(v1.z, v1.w); *(u32x4*)(Pb + (size_t)r * pitch + c) = o; }
        else { const int cc = c - nmain; if (cc < 48) { *(f32x4*)(small + (size_t)r * 48 + cc) = v0; *(f32x4*)(small + (size_t)r * 48 + cc + 4) = v1; } }
    }
};
struct EpiSig {
    bf16_t* O;
    __device__ __forceinline__ void operator()(int r, int c, const f32x4& v, int) const {
        u32x2 o; o.x = cvt_pk(sigmf(v.x), sigmf(v.y)); o.y = cvt_pk(sigmf(v.z), sigmf(v.w)); *(u32x2*)(O + (size_t)r * 3072 + c) = o;
    }
    __device__ __forceinline__ void w8(int r, int c, const f32x4& v0, const f32x4& v1, int) const {
        u32x4 o; o.x = cvt_pk(sigmf(v0.x), sigmf(v0.y)); o.y = cvt_pk(sigmf(v0.z), sigmf(v0.w)); o.z = cvt_pk(sigmf(v1.x), sigmf(v1.y)); o.w = cvt_pk(sigmf(v1.z), sigmf(v1.w));
        *(u32x4*)(O + (size_t)r * 3072 + c) = o;
    }
};
struct EpiRelu2 {
    bf16_t* O;
    __device__ __forceinline__ void operator()(int r, int c, const f32x4& v, int) const {
        const float a = fmaxf(v.x, 0.f), b = fmaxf(v.y, 0.f), cc = fmaxf(v.z, 0.f), d = fmaxf(v.w, 0.f);
        u32x2 o; o.x = cvt_pk(a * a, b * b); o.y = cvt_pk(cc * cc, d * d); *(u32x2*)(O + (size_t)r * 4096 + c) = o;
    }
    __device__ __forceinline__ void w8(int r, int c, const f32x4& v0, const f32x4& v1, int) const {
        const float a = fmaxf(v0.x, 0.f), b = fmaxf(v0.y, 0.f), cc = fmaxf(v0.z, 0.f), d = fmaxf(v0.w, 0.f), e = fmaxf(v1.x, 0.f), f = fmaxf(v1.y, 0.f), g = fmaxf(v1.z, 0.f), h = fmaxf(v1.w, 0.f);
        u32x4 o; o.x = cvt_pk(a * a, b * b); o.y = cvt_pk(cc * cc, d * d); o.z = cvt_pk(e * e, f * f); o.w = cvt_pk(g * g, h * h); *(u32x4*)(O + (size_t)r * 4096 + c) = o;
    }
};
struct EpiRes {
    XPtr Xold, Xnew; const float* mods_l; int gidx;
    __device__ __forceinline__ void operator()(int r, int c, const f32x4& v, int) const {
        const f32x4 g = *(const f32x4*)(mods_l + modidx(r) * 6144 + gidx * 1024 + c);
        const f32x4 xo = *(const f32x4*)(xrow(Xold, r) + c);
        *(f32x4*)(xrow(Xnew, r) + c) = xo + g * v;
    }
    __device__ __forceinline__ void w8(int r, int c, const f32x4& v0, const f32x4& v1, int) const {
        const float* gp = mods_l + modidx(r) * 6144 + gidx * 1024 + c; const float* xo = xrow(Xold, r) + c; float* xn = xrow(Xnew, r) + c;
        const f32x4 g0 = *(const f32x4*)gp, g1 = *(const f32x4*)(gp + 4), x0 = *(const f32x4*)xo, x1 = *(const f32x4*)(xo + 4);
        *(f32x4*)xn = x0 + g0 * v0; *(f32x4*)(xn + 4) = x1 + g1 * v1;
    }
};
struct EpiMerge {
    const bf16_t* gs; bf16_t* mb;
    __device__ __forceinline__ void operator()(int r, int c, const f32x4& v, int j) const {
        const u32x2 g = *(const u32x2*)(gs + (size_t)r * 3072 + j * 1024 + c);
        float a0 = v.x * bflo(g.x), a1 = v.y * bfhi(g.x), a2 = v.z * bflo(g.y), a3 = v.w * bfhi(g.y);
        u32x2* mp = (u32x2*)(mb + (size_t)r * 1024 + c);
        if (j > 0) { const u32x2 o = *mp; a0 += bflo(o.x); a1 += bfhi(o.x); a2 += bflo(o.y); a3 += bfhi(o.y); }
        u32x2 w; w.x = cvt_pk(a0, a1); w.y = cvt_pk(a2, a3); *mp = w;
    }
    __device__ __forceinline__ void w8(int r, int c, const f32x4& v0, const f32x4& v1, int j) const {
        const u32x4 g = *(const u32x4*)(gs + (size_t)r * 3072 + j * 1024 + c);
        float a0 = v0.x * bflo(g.x), a1 = v0.y * bfhi(g.x), a2 = v0.z * bflo(g.y), a3 = v0.w * bfhi(g.y), a4 = v1.x * bflo(g.z), a5 = v1.y * bfhi(g.z), a6 = v1.z * bflo(g.w), a7 = v1.w * bfhi(g.w);
        u32x4* mp = (u32x4*)(mb + (size_t)r * 1024 + c);
        if (j > 0) { const u32x4 o = *mp; a0 += bflo(o.x); a1 += bfhi(o.x); a2 += bflo(o.y); a3 += bfhi(o.y); a4 += bflo(o.z); a5 += bfhi(o.z); a6 += bflo(o.w); a7 += bfhi(o.w); }
        u32x4 w; w.x = cvt_pk(a0, a1); w.y = cvt_pk(a2, a3); w.z = cvt_pk(a4, a5); w.w = cvt_pk(a6, a7); *mp = w;
    }
};

namespace pg8 {
constexpr int BM = 256, BK = 64, HALF = 128, HTB = HALF * BK * 2, STAGE_BYTES = 8 * HTB, NXCD = 8, WGM = 2;
__device__ __forceinline__ int lds_byte(int r, int c) { const int st = (r >> 4) * 2 + (c >> 5), rr = r & 15, cc = c & 31, ob = rr * 64 + cc * 2; return st * 1024 + (ob ^ (((ob >> 9) & 1) << 5)); }
__device__ __forceinline__ int perm32(int rho) { const int n = rho >> 4, i = rho & 15; return 8 * (i >> 2) + 4 * n + (i & 3); }
__device__ __forceinline__ void stage_rc(int b, int& R_, int& C_) { const int st = b / 1024, sb = b % 1024, swz = sb ^ (((sb >> 9) & 1) << 5); R_ = (st >> 1) * 16 + swz / 64; C_ = (st & 1) * 32 + (swz % 64) / 2; }
struct Unit { int pm, pn, acol, brow, j; };
struct Gemm { const bf16_t* A; const bf16_t* Bt; int lda, K; };
struct StaticOrder {
    int nM, nN, nwg, G, c;
    __device__ void init(int M, int N, int G_, int c_) { nM = M / BM; nN = N / BM; nwg = nM * nN; G = G_; c = c_; }
    __device__ __forceinline__ bool tile(long L, int& pm, int& pn) const {
        if (L >= nwg) return false;
        int wgid = (int)L; { const int q = nwg / NXCD, r = nwg % NXCD, xcd = wgid % NXCD, off = wgid / NXCD; wgid = (xcd < r ? xcd * (q + 1) : r * (q + 1) + (xcd - r) * q) + off; }
        const int nig = WGM * nN, gid = wgid / nig, fm = gid * WGM, gsz = (nM - fm) < WGM ? (nM - fm) : WGM;
        pm = fm + ((wgid % nig) % gsz); pn = (wgid % nig) / gsz; return true;
    }
    __device__ __forceinline__ bool next(int i, Unit& u) const { if (!tile((long)i * G + c, u.pm, u.pn)) return false; u.acol = 0; u.brow = u.pn; u.j = 0; return true; }
};
struct MergeOrder {
    StaticOrder S;
    __device__ __forceinline__ bool next(int i, Unit& u) const { const int j = i % 3; if (!S.tile((long)(i / 3) * S.G + S.c, u.pm, u.pn)) return false; u.acol = j * 512; u.brow = j * 4 + u.pn; u.j = j; return true; }
};
template <class F> struct Epi {
    F f;
    __device__ __forceinline__ void operator()(const f32x4 (&acc)[2][2][4][2], const Unit& u, int wr, int wc, int fr, int fq) const {
#pragma unroll
        for (int ai = 0; ai < 2; ++ai)
#pragma unroll
            for (int m = 0; m < 4; ++m)
#pragma unroll
                for (int bj = 0; bj < 2; ++bj)
                    f.w8(u.pm * BM + ai * HALF + wr * 64 + m * 16 + fr, u.pn * BM + bj * HALF + wc * 32 + 8 * fq, acc[ai][bj][m][0], acc[ai][bj][m][1], u.j);
    }
};

template <class E_, class Sched>
__device__ __forceinline__ void gemm_phase(LAS unsigned char* lds, const Gemm g, const Sched& S, const E_& E) {
    int tid_ = threadIdx.x; asm volatile("" : "+v"(tid_));
    const int tid = tid_, wid = __builtin_amdgcn_readfirstlane(tid >> 6), lane = tid & 63, wr = wid >> 2, wc = wid & 3, fr = lane & 15, fq = lane >> 4;
    const int K = g.K, nt = K / BK;
    unsigned voffA[2], voffB[2];
#pragma unroll
    for (int i = 0; i < 2; ++i) { int R_, C_; stage_rc(tid * 16 + i * 8192, R_, C_); const int Rb = (R_ & ~31) + perm32(R_ & 31); voffA[i] = (unsigned)(R_ * g.lda + C_) * 2u; voffB[i] = (unsigned)(Rb * K + C_) * 2u; }
    const size_t kstep = (size_t)(BK * 2);
    const size_t hstepA = (size_t)HALF * g.lda * 2, hstepB = (size_t)HALF * K * 2;
    const unsigned ldsw = (unsigned)wid * 1024u;
    const int aoff = lds_byte(wr * 64 + fr, fq * 8), boff = lds_byte(wc * 32 + fr, fq * 8);
#define PG8_SA(b, h) (((b) * 2 + (h)) * HTB)
#define PG8_SB(b, h) ((4 + (b) * 2 + (h)) * HTB)
#define PG8_STAGE(bufoff, gbase, voff) do { _Pragma("unroll") for (int _i = 0; _i < 2; ++_i) \
        __builtin_amdgcn_global_load_lds((const unsigned*)((const char*)(gbase) + (voff)[_i]), (LAS unsigned*)(lds + (bufoff) + ldsw + _i * 8192), 16, 0, 0); } while (0)
#define PG8_LDA(dst, b, h) do { _Pragma("unroll") for (int m = 0; m < 4; ++m) _Pragma("unroll") for (int k = 0; k < 2; ++k) dst[m][k] = *(const LAS bf16x8*)(lds + PG8_SA(b, h) + aoff + m * 2048 + k * 1024); } while (0)
#define PG8_LDB(dst, b, h) do { _Pragma("unroll") for (int n = 0; n < 2; ++n) _Pragma("unroll") for (int k = 0; k < 2; ++k) dst[n][k] = *(const LAS bf16x8*)(lds + PG8_SB(b, h) + boff + n * 2048 + k * 1024); } while (0)
#define PG8_MMA(ai, bj, At, Bt) do { __builtin_amdgcn_s_setprio(1); _Pragma("unroll") for (int m = 0; m < 4; ++m) _Pragma("unroll") for (int n = 0; n < 2; ++n) _Pragma("unroll") for (int k = 0; k < 2; ++k) \
        acc[ai][bj][m][n] = __builtin_amdgcn_mfma_f32_16x16x32_bf16(Bt[n][k], At[m][k], acc[ai][bj][m][n], 0, 0, 0); __builtin_amdgcn_s_setprio(0); } while (0)
#define PG8_WAIT_V(n) asm volatile("s_waitcnt vmcnt(" #n ")" ::: "memory")
#define PG8_WAIT_L(n) asm volatile("s_waitcnt lgkmcnt(" #n ")" ::: "memory")
#define PG8_BAR __builtin_amdgcn_s_barrier()
#define PG8_SCHED __builtin_amdgcn_sched_barrier(0)
#define PG8_UA(u) ((const char*)g.A + ((size_t)(u).pm * BM * g.lda + (u).acol) * 2)
#define PG8_UB(u) ((const char*)g.Bt + (size_t)(u).brow * BM * K * 2)
    Unit cur, nxt; int ui = 0;
    if (!S.next(0, cur)) return;
    f32x4 acc[2][2][4][2];
#pragma unroll
    for (int a = 0; a < 2; ++a)
#pragma unroll
        for (int b = 0; b < 2; ++b)
#pragma unroll
            for (int m = 0; m < 4; ++m)
#pragma unroll
                for (int n = 0; n < 2; ++n) acc[a][b][m][n] = (f32x4){0.f, 0.f, 0.f, 0.f};
    bf16x8 At[4][2], B0[2][2], B1[2][2];
    const char* cA = PG8_UA(cur); const char* cB = PG8_UB(cur);
    PG8_STAGE(PG8_SB(0, 0), cB, voffB); PG8_STAGE(PG8_SB(0, 1), cB + hstepB, voffB); PG8_STAGE(PG8_SA(0, 0), cA, voffA); PG8_STAGE(PG8_SA(0, 1), cA + hstepA, voffA);
    if (wr == 1) PG8_BAR;
    PG8_WAIT_V(2); PG8_BAR;
    PG8_STAGE(PG8_SB(1, 0), cB + kstep, voffB); PG8_STAGE(PG8_SA(1, 0), cA + kstep, voffA); PG8_STAGE(PG8_SB(1, 1), cB + hstepB + kstep, voffB);
    PG8_WAIT_V(6); PG8_BAR;
    for (;;) {
        const bool has_next = S.next(ui + 1, nxt);
        const char* nA = has_next ? PG8_UA(nxt) : cA; const char* nB = has_next ? PG8_UB(nxt) : cB;
        for (int t = 0; t < nt; t += 2) {
            const bool last = (t == nt - 2);
            const char* a1 = cA + (size_t)(t + 1) * kstep;
            const char* a2 = last ? nA : cA + (size_t)(t + 2) * kstep; const char* b2 = last ? nB : cB + (size_t)(t + 2) * kstep;
            const char* a3 = a2 + kstep; const char* b3 = b2 + kstep;
            PG8_LDB(B0, 0, 0); PG8_LDB(B1, 0, 1); PG8_SCHED; PG8_LDA(At, 0, 0); PG8_STAGE(PG8_SA(1, 1), a1 + hstepA, voffA);
            PG8_WAIT_V(8); PG8_WAIT_L(0); PG8_BAR; PG8_MMA(0, 0, At, B0); PG8_MMA(0, 1, At, B1); PG8_BAR; PG8_SCHED;
            PG8_LDA(At, 0, 1); PG8_STAGE(PG8_SB(0, 0), b2, voffB); PG8_STAGE(PG8_SB(0, 1), b2 + hstepB, voffB); PG8_STAGE(PG8_SA(0, 0), a2, voffA);
            PG8_WAIT_V(8); PG8_WAIT_L(0); PG8_BAR; PG8_MMA(1, 0, At, B0); PG8_MMA(1, 1, At, B1); PG8_BAR; PG8_SCHED;
            PG8_LDB(B0, 1, 0); PG8_LDB(B1, 1, 1); PG8_SCHED; PG8_LDA(At, 1, 0); PG8_STAGE(PG8_SA(0, 1), a2 + hstepA, voffA);
            PG8_WAIT_V(8); PG8_WAIT_L(0); PG8_BAR; PG8_MMA(0, 0, At, B0); PG8_MMA(0, 1, At, B1); PG8_BAR; PG8_SCHED;
            PG8_LDA(At, 1, 1); PG8_STAGE(PG8_SB(1, 0), b3, voffB); PG8_STAGE(PG8_SB(1, 1), b3 + hstepB, voffB); PG8_STAGE(PG8_SA(1, 0), a3, voffA);
            PG8_WAIT_V(8); PG8_WAIT_L(0); PG8_BAR; PG8_MMA(1, 0, At, B0); PG8_MMA(1, 1, At, B1); PG8_BAR; PG8_SCHED;
        }
        if (wr == 0) PG8_BAR;
        E(acc, cur, wr, wc, fr, fq);
        if (!has_next) break;
#pragma unroll
        for (int a = 0; a < 2; ++a)
#pragma unroll
            for (int b = 0; b < 2; ++b)
#pragma unroll
                for (int m = 0; m < 4; ++m)
#pragma unroll
                    for (int n = 0; n < 2; ++n) acc[a][b][m][n] = (f32x4){0.f, 0.f, 0.f, 0.f};
        cur = nxt; cA = nA; cB = nB; ++ui;
        if (wr == 1) PG8_BAR;
    }
    PG8_WAIT_V(0);
    PG8_BAR;
#undef PG8_SA
#undef PG8_SB
#undef PG8_STAGE
#undef PG8_LDA
#undef PG8_LDB
#undef PG8_MMA
#undef PG8_WAIT_V
#undef PG8_WAIT_L
#undef PG8_BAR
#undef PG8_SCHED
#undef PG8_UA
#undef PG8_UB
}
}

template <class F>
__device__ __forceinline__ void big_gemm(LAS unsigned char* ldsb, const bf16_t* A, int lda, const bf16_t* Bt, int K, int N, const F& f) {
    pg8::Gemm g{A, Bt, lda, K}; pg8::StaticOrder S; S.init(RL, N, (int)gridDim.x, (int)blockIdx.x);
    pg8::Epi<F> E{f};
    pg8::gemm_phase(ldsb, g, S, E);
    __syncthreads();
}
template <int NI>
__device__ __forceinline__ void gemm_kloop(f32x4 (&acc)[4][NI], const bf16_t* Ag, int lda, const bf16_t* Bg, int ldb, int K, char* lds) {
    const int tid = tid_l(), lane = tid & 63, wid = tid >> 6, wm = wid >> 1, wn = wid & 1, lr = lane & 15, lq = lane >> 4;
    u32x4 ra[4], rb[NI];
    const int prow = tid >> 3, pkc = tid & 7;
    const bf16_t* ap = Ag + (size_t)prow * lda + pkc * 8;
    const bf16_t* bp = Bg + (size_t)prow * ldb + pkc * 8;
    const int soff = prow * 128 + ((pkc ^ (prow & 7)) << 4);
#pragma unroll
    for (int i = 0; i < 4; ++i) { ra[i] = *(const u32x4*)(ap + (size_t)(32 * i) * lda); if (i < NI) rb[i < NI ? i : 0] = *(const u32x4*)(bp + (size_t)(32 * i) * ldb); }
#pragma unroll
    for (int i = 0; i < 4; ++i) { *(u32x4*)(lds + soff + i * 4096) = ra[i]; if (i < NI) *(u32x4*)(lds + 32768 + soff + i * 4096) = rb[i < NI ? i : 0]; }
    __syncthreads();
    const int nk = K >> 6;
    for (int kt = 0; kt < nk; ++kt) {
        const int buf = kt & 1;
        if (kt + 1 < nk) {
#pragma unroll
            for (int i = 0; i < 4; ++i) { ra[i] = *(const u32x4*)(ap + (size_t)(32 * i) * lda + (kt + 1) * 64); if (i < NI) rb[i < NI ? i : 0] = *(const u32x4*)(bp + (size_t)(32 * i) * ldb + (kt + 1) * 64); }
        }
        const char* la = lds + buf * 16384; const char* lb = lds + 32768 + buf * 16384;
#pragma unroll
        for (int kk = 0; kk < 2; ++kk) {
            bf16x8 af[4], bfr[NI];
            const int chunk = kk * 4 + lq;
#pragma unroll
            for (int mi = 0; mi < 4; ++mi) { const int row = wm * 64 + mi * 16 + lr; af[mi] = *(const bf16x8*)(la + row * 128 + ((chunk ^ (row & 7)) << 4)); }
#pragma unroll
            for (int ni = 0; ni < NI; ++ni) { const int row = wn * (16 * NI) + ni * 16 + lr; bfr[ni] = *(const bf16x8*)(lb + row * 128 + ((chunk ^ (row & 7)) << 4)); }
#pragma unroll
            for (int mi = 0; mi < 4; ++mi)
#pragma unroll
                for (int ni = 0; ni < NI; ++ni) acc[mi][ni] = __builtin_amdgcn_mfma_f32_16x16x32_bf16(bfr[ni], af[mi], acc[mi][ni], 0, 0, 0);
        }
        if (kt + 1 < nk) {
            char* sa = lds + (buf ^ 1) * 16384 + soff;
#pragma unroll
            for (int i = 0; i < 4; ++i) { *(u32x4*)(sa + i * 4096) = ra[i]; if (i < NI) *(u32x4*)(sa + 32768 + i * 4096) = rb[i < NI ? i : 0]; }
        }
        __syncthreads();
    }
}

__device__ __forceinline__ void tile_of(int t, int Mt, int Nt, int& tm, int& tn) {
    const int per = 8 * Nt; const int p = t / per; const int r = t - p * per; const int pm = (Mt - 8 * p) < 8 ? (Mt - 8 * p) : 8;
    tm = 8 * p + r % pm; tn = r / pm;
}

template <int TYPE> struct MX {
    static constexpr int DK = TYPE == 1 ? 128 : 64;
    static constexpr int NOC = DK / 8;
    static constexpr int PITCH = TYPE == 1 ? 2048 : 1536;
    static constexpr int QOFF = 0;
    static constexpr int KOFF = TYPE == 1 ? 512 : 256;
    static constexpr int VOFF = TYPE == 1 ? 1024 : 512;
    static constexpr int GOFF = TYPE == 1 ? 1536 : 1024;
    static constexpr int QP = DK + 16;
};
constexpr int L_VT = 0;
constexpr int L_Q = 20480;
constexpr int L_CUM = 40960;
constexpr int L_ATT = 57344;
constexpr int L_SC = 67584;
constexpr int L_SA = 68096;

template <int TYPE>
__device__ __forceinline__ void load_qk8(const Params& P, int l, const bf16_t* pb, int b, int c, int t, int h, int oc, bool isk, float (&f)[8]) {
    typedef MX<TYPE> M;
    const int coff = (isk ? M::KOFF : M::QOFF) + h * M::DK;
    const size_t rowi = (size_t)(rowbase(b, c) + t);
    if (TYPE == 0) {
        const u32x4 u = *(const u32x4*)(pb + rowi * M::PITCH + coff + oc * 8); UNPACK8(u, f);
    } else if (TYPE == 1) {
        const bool hp = (t > 0) || (c != 0 && c != 4), hn = (t < 63) || (c != 3 && c != NCH - 1);
        const bf16_t* p0 = pb + rowi * M::PITCH + coff + oc * 8;
        u32x4 u1 = *(const u32x4*)p0, u0 = (u32x4){0u, 0u, 0u, 0u}, u2 = (u32x4){0u, 0u, 0u, 0u};
        if (hp) u0 = *(const u32x4*)(p0 - M::PITCH);
        if (hn) u2 = *(const u32x4*)(p0 + M::PITCH);
        float a[8], m[8], n[8]; UNPACK8(u0, a); UNPACK8(u1, m); UNPACK8(u2, n);
        const float* cw = P.in[I_CONV] + (size_t)l * 3 * 1024 + (isk ? 512 : 0) + h * 128 + oc * 8;
        const f32x4 w0a = *(const f32x4*)cw, w0b = *(const f32x4*)(cw + 4), w1a = *(const f32x4*)(cw + 1024), w1b = *(const f32x4*)(cw + 1028), w2a = *(const f32x4*)(cw + 2048), w2b = *(const f32x4*)(cw + 2052);
        const float w0[8] = {w0a.x, w0a.y, w0a.z, w0a.w, w0b.x, w0b.y, w0b.z, w0b.w};
        const float w1[8] = {w1a.x, w1a.y, w1a.z, w1a.w, w1b.x, w1b.y, w1b.z, w1b.w};
        const float w2[8] = {w2a.x, w2a.y, w2a.z, w2a.w, w2b.x, w2b.y, w2b.z, w2b.w};
#pragma unroll
        for (int j = 0; j < 8; ++j) f[j] = siluf(w0[j] * a[j] + w1[j] * m[j] + w2[j] * n[j]);
    } else {
        if (c < 4) { const u32x4 u = *(const u32x4*)(pb + rowi * M::PITCH + coff + oc * 8); UNPACK8(u, f); }
        else {
            const int o4 = oc & 3;
            const u32x4 ua = *(const u32x4*)(pb + rowi * M::PITCH + coff + o4 * 8), ub = *(const u32x4*)(pb + rowi * M::PITCH + coff + 32 + o4 * 8);
            float x1[8], x2[8]; UNPACK8(ua, x1); UNPACK8(ub, x2);
            const float* tab = (const float*)(ws_l(P) + WS_ROPE);
            const float* cs = o4 < 2 ? tab + (c - 4) * 16 + o4 * 8 : tab + 4096 + t * 16 + (o4 - 2) * 8;
            const float* sn = o4 < 2 ? tab + 2048 + (c - 4) * 16 + o4 * 8 : tab + 4096 + 1024 + t * 16 + (o4 - 2) * 8;
#pragma unroll
            for (int j = 0; j < 8; ++j) f[j] = oc < 4 ? x1[j] * cs[j] - x2[j] * sn[j] : x1[j] * sn[j] + x2[j] * cs[j];
        }
    }
}

template <int TYPE>
__device__ __forceinline__ void decay_setup(const Params& P, int l, int b, int c, int h, int dir, char* lds, const float* apre = nullptr) {
    const int tid = tid_l(); const int r0 = rowbase(b, c);
    float* sc = (float*)(lds + L_SC);
    const float* small = (const float*)(ws_l(P) + WS_SMALL);
    if (TYPE == 0) {
        float* cum = (float*)(lds + L_CUM); float* sa = (float*)(lds + L_SA);
        if (apre) {
#pragma unroll
            for (int k = 0; k < 4; ++k) sa[tid + k * NTHR] = apre[k];
        } else {
            for (int i = tid; i < 1024; i += NTHR) sa[i] = small[(size_t)(r0 + (i >> 4)) * 48 + dir * 16 + (i & 15)];
        }
        __syncthreads();
        const int d = tid & 63, tq = tid >> 6;
        const float* a2 = P.in[I_A2] + ((size_t)(l * 2 + dir) * 16) * 256 + h * 64 + d;
        float w[16];
#pragma unroll
        for (int rr = 0; rr < 16; ++rr) w[rr] = a2[rr * 256];
        const float bias = P.in[I_ABIAS][(l * 2 + dir) * 256 + h * 64 + d];
        float* blk = sa;
        float lv[16];
#pragma unroll
        for (int i = 0; i < 16; ++i) {
            const int t = tq * 16 + i;
            float z = bias;
#pragma unroll
            for (int rr = 0; rr < 16; ++rr) z += sa[t * 16 + rr] * w[rr];
            lv[i] = logsig(z) * (1.f / 16.f);
        }
        if (dir == 0) {
#pragma unroll
            for (int i = 1; i < 16; ++i) lv[i] += lv[i - 1];
        } else {
#pragma unroll
            for (int i = 14; i >= 0; --i) lv[i] += lv[i + 1];
        }
        __syncthreads();
        blk[tq * 64 + d] = dir == 0 ? lv[15] : lv[0];
        __syncthreads();
        float off = 0.f;
#pragma unroll
        for (int q = 0; q < 4; ++q) if (dir == 0 ? (q < tq) : (q > tq)) off += blk[q * 64 + d];
#pragma unroll
        for (int i = 0; i < 16; ++i) cum[(tq * 16 + i) * 64 + d] = lv[i] + off;
    } else if (TYPE == 1) {
        if (tid < 64) {
            const float fg = small[(size_t)(r0 + tid) * 48 + 40 + dir * 4 + h] + P.in[I_FB][l * 8 + dir * 4 + h];
            float v = logsig(fg);
            if (dir == 0) {
#pragma unroll
                for (int o = 1; o < 64; o <<= 1) { const float n = __shfl_up(v, o); if (tid >= o) v += n; }
            } else {
#pragma unroll
                for (int o = 1; o < 64; o <<= 1) { const float n = __shfl_down(v, o); if (tid + o < 64) v += n; }
            }
            const float tot = __shfl(v, dir == 0 ? 63 : 0);
            sc[tid] = v;
            sc[64 + tid] = small[(size_t)(r0 + tid) * 48 + 32 + dir * 4 + h] + P.in[I_IB][l * 8 + dir * 4 + h];
            if (tid == 0) sc[128] = tot;
        }
    } else {
        if (tid < 64) {
            const float lg = logsig(P.in[I_RDL][l * 8 + dir * 4 + h]);
            sc[tid] = (dir == 0 ? (float)(tid + 1) : (float)(64 - tid)) * lg;
            if (tid == 0) sc[128] = 64.f * lg;
        }
    }
    __syncthreads();
}

template <int TYPE>
__device__ __forceinline__ void build_vT(const bf16_t* pb, int b, int c, int h, char* lds) {
    typedef MX<TYPE> M;
    bf16_t* vT = (bf16_t*)(lds + L_VT);
#pragma unroll
    for (int i = 0; i < 2; ++i) {
        const int pid = tid_l() + i * NTHR, tp = pid & 31, oc = pid >> 5;
        const bf16_t* p0 = pb + (size_t)(rowbase(b, c) + 2 * tp) * M::PITCH + M::VOFF + h * 128 + oc * 8;
        const u32x4 u0 = *(const u32x4*)p0, u1 = *(const u32x4*)(p0 + M::PITCH);
        unsigned* dst = (unsigned*)(vT + (size_t)(oc * 8) * 80 + 2 * tp);
        dst[0 * 40] = (u0.x & 0xffffu) | (u1.x << 16); dst[1 * 40] = (u0.x >> 16) | (u1.x & 0xffff0000u);
        dst[2 * 40] = (u0.y & 0xffffu) | (u1.y << 16); dst[3 * 40] = (u0.y >> 16) | (u1.y & 0xffff0000u);
        dst[4 * 40] = (u0.z & 0xffffu) | (u1.z << 16); dst[5 * 40] = (u0.z >> 16) | (u1.z & 0xffff0000u);
        dst[6 * 40] = (u0.w & 0xffffu) | (u1.w << 16); dst[7 * 40] = (u0.w >> 16) | (u1.w & 0xffff0000u);
    }
}

__device__ __forceinline__ int scan_index(int dir, int c) { return dir == 0 ? c : (c < 4 ? 3 - c : 135 - c); }

template <int TYPE>
__device__ __forceinline__ void u_phase(const Params& P, int l, char* lds) {
    typedef MX<TYPE> M; constexpr int DK = M::DK;
    const int tid = tid_l(), lane = tid & 63, wid = tid >> 6, lr = lane & 15, lq = lane >> 4;
    const bf16_t* pb = (const bf16_t*)(ws_l(P) + WS_PBUF);
    bf16_t* U = (bf16_t*)(ws_l(P) + WS_SBUF); float* DEC = (float*)(ws_l(P) + WS_DEC); float* UN = (float*)(ws_l(P) + WS_UN);
    bf16_t* vT = (bf16_t*)(lds + L_VT); bf16_t* kT = (bf16_t*)(lds + L_Q);
    const float* cum = (const float*)(lds + L_CUM); const float* sc = (const float*)(lds + L_SC);
    const int NU = NB * 4 * 2 * NCH, VG = vgrid(), slot = bid_l();
    for (int u0 = 0; u0 < NU; u0 += VG) {
        int unit = u0 + slot; if (unit >= NU) unit = NU - 1;
        const int c = unit % NCH; const int rest = unit / NCH; const int dir = rest & 1, h = (rest >> 1) & 3, b = rest >> 3;
        const int chain = (b * 4 + h) * 2 + dir, n = scan_index(dir, c);
        static_assert(TYPE == 0, "the scalar-decay branches use u_phase_s");
        float k0[8], k1[8], apre[4];
        { const int tp = tid & 31, oc = tid >> 5;
          load_qk8<TYPE>(P, l, pb, b, c, 2 * tp, h, oc, true, k0);
          load_qk8<TYPE>(P, l, pb, b, c, 2 * tp + 1, h, oc, true, k1);
          const float* small = (const float*)(ws_l(P) + WS_SMALL); const int r0 = rowbase(b, c);
#pragma unroll
          for (int k = 0; k < 4; ++k) { const int i = tid + k * NTHR; apre[k] = small[(size_t)(r0 + (i >> 4)) * 48 + dir * 16 + (i & 15)]; } }
        build_vT<TYPE>(pb, b, c, h, lds);
        decay_setup<TYPE>(P, l, b, c, h, dir, lds, apre);
        const int tlast = dir == 0 ? 63 : 0;
        {
            const int pid = tid, tp = pid & 31, oc = pid >> 5;
            unsigned* dst = (unsigned*)(kT + (size_t)(oc * 8) * 80 + 2 * tp);
            if (TYPE == 0) {
#pragma unroll
                for (int j = 0; j < 8; ++j) { const int d = oc * 8 + j; const float tot = cum[tlast * 64 + d];
                    dst[j * 40] = cvt_pk(k0[j] * __expf(tot - cum[(2 * tp) * 64 + d]), k1[j] * __expf(tot - cum[(2 * tp + 1) * 64 + d])); }
            } else {
                const float tot = sc[128];
                const float w0 = TYPE == 1 ? __expf(tot - sc[2 * tp] + sc[64 + 2 * tp]) * 0.08838834764831845f : __expf(tot - sc[2 * tp]) * 0.125f;
                const float w1 = TYPE == 1 ? __expf(tot - sc[2 * tp + 1] + sc[64 + 2 * tp + 1]) * 0.08838834764831845f : __expf(tot - sc[2 * tp + 1]) * 0.125f;
#pragma unroll
                for (int j = 0; j < 8; ++j) dst[j * 40] = cvt_pk(k0[j] * w0, k1[j] * w1);
            }
        }
        __syncthreads();
        f32x4 acc[2][DK / 16];
#pragma unroll
        for (int i = 0; i < 2; ++i)
#pragma unroll
            for (int nt = 0; nt < DK / 16; ++nt) acc[i][nt] = (f32x4){0.f, 0.f, 0.f, 0.f};
#pragma unroll
        for (int kk = 0; kk < 2; ++kk) {
            bf16x8 fv[2];
#pragma unroll
            for (int i = 0; i < 2; ++i) fv[i] = *(const bf16x8*)(vT + (size_t)((2 * wid + i) * 16 + lr) * 80 + kk * 32 + lq * 8);
#pragma unroll
            for (int nt = 0; nt < DK / 16; ++nt) {
                const bf16x8 fk = *(const bf16x8*)(kT + (size_t)(nt * 16 + lr) * 80 + kk * 32 + lq * 8);
#pragma unroll
                for (int i = 0; i < 2; ++i) acc[i][nt] = __builtin_amdgcn_mfma_f32_16x16x32_bf16(fk, fv[i], acc[i][nt], 0, 0, 0);
            }
        }
        bf16_t* ub = U + (size_t)(chain * NCH + n) * 128 * DK;
#pragma unroll
        for (int i = 0; i < 2; ++i)
#pragma unroll
            for (int nt = 0; nt < DK / 16; ++nt) {
                const int e = (2 * wid + i) * 16 + lr, d = nt * 16 + lq * 4;
                u32x2 o; o.x = cvt_pk(acc[i][nt].x, acc[i][nt].y); o.y = cvt_pk(acc[i][nt].z, acc[i][nt].w);
                *(u32x2*)(ub + (size_t)e * DK + d) = o;
            }
        if (tid < DK) {
            const float tot = TYPE == 0 ? cum[tlast * 64 + (tid & 63)] : sc[128];
            DEC[(size_t)(chain * NCH + n) * 128 + tid] = __expf(tot);
            if (TYPE == 1) {
                float s = 0.f;
#pragma unroll
                for (int q = 0; q < 8; ++q) { const u32x4 u = *(const u32x4*)(kT + (size_t)tid * 80 + q * 8); float f[8]; UNPACK8(u, f);
#pragma unroll
                    for (int j = 0; j < 8; ++j) s += f[j]; }
                UN[(size_t)(chain * NCH + n) * 128 + tid] = s;
            }
        }
        __syncthreads();
    }
}

template <int TYPE>
__device__ __forceinline__ void u_phase_s(const Params& P, int l, char* lds) {
    typedef MX<TYPE> M; constexpr int DK = M::DK; constexpr int NIT = M::NOC * 32 / NTHR;
    const int tid = tid_l(), lane = tid & 63, wid = tid >> 6, lr = lane & 15, lq = lane >> 4;
    const bf16_t* pb = (const bf16_t*)(ws_l(P) + WS_PBUF);
    const float* small = (const float*)(ws_l(P) + WS_SMALL);
    bf16_t* U = (bf16_t*)(ws_l(P) + WS_SBUF); float* DEC = (float*)(ws_l(P) + WS_DEC); float* UN = (float*)(ws_l(P) + WS_UN);
    bf16_t* vT = (bf16_t*)(lds + L_VT); bf16_t* kT0 = (bf16_t*)(lds + 20480); bf16_t* kT1 = (bf16_t*)(lds + 40960);
    float* sc = (float*)(lds + L_SC);
    const int NU = NB * 4 * NCH, VG = vgrid(), slot = bid_l();
    for (int u0 = 0; u0 < NU; u0 += VG) {
        int unit = u0 + slot; int dmask = 3;
        if (VG == 512 && u0 >= 1024) { if (slot >= 2 * (NU - 1024)) continue; unit = 1024 + (slot >> 1); dmask = 1 << (slot & 1); }
        else if (unit >= NU) unit = NU - 1;
        const int c = unit % NCH; const int rest = unit / NCH; const int h = rest & 3, b = rest >> 2;
        const int r0 = rowbase(b, c);
        float kv[NIT][2][8];
#pragma unroll
        for (int i = 0; i < NIT; ++i) {
            const int pid = tid + i * NTHR, tp = pid & 31, oc = pid >> 5;
            load_qk8<TYPE>(P, l, pb, b, c, 2 * tp, h, oc, true, kv[i][0]);
            load_qk8<TYPE>(P, l, pb, b, c, 2 * tp + 1, h, oc, true, kv[i][1]);
        }
        if (TYPE == 1) {
            if (tid < 128) {
                const int dir = tid >> 6, t = tid & 63;
                const float fg = small[(size_t)(r0 + t) * 48 + 40 + dir * 4 + h] + P.in[I_FB][l * 8 + dir * 4 + h];
                float v = logsig(fg);
                if (dir == 0) {
#pragma unroll
                    for (int o = 1; o < 64; o <<= 1) { const float n = __shfl_up(v, o); if (t >= o) v += n; }
                } else {
#pragma unroll
                    for (int o = 1; o < 64; o <<= 1) { const float n = __shfl_down(v, o); if (t + o < 64) v += n; }
                }
                sc[dir * 64 + t] = v;
                sc[128 + dir * 64 + t] = small[(size_t)(r0 + t) * 48 + 32 + dir * 4 + h] + P.in[I_IB][l * 8 + dir * 4 + h];
            }
        } else {
            if (tid < 64) {
                const float lg0 = logsig(P.in[I_RDL][l * 8 + h]), lg1 = logsig(P.in[I_RDL][l * 8 + 4 + h]);
                sc[tid] = (float)(tid + 1) * lg0; sc[64 + tid] = (float)(64 - tid) * lg1;
            }
        }
        build_vT<TYPE>(pb, b, c, h, lds);
        __syncthreads();
        const float totf = sc[63], totb = sc[64];
        const float ks = TYPE == 1 ? 0.08838834764831845f : 0.125f;
#pragma unroll
        for (int i = 0; i < NIT; ++i) {
            const int pid = tid + i * NTHR, tp = pid & 31, oc = pid >> 5;
            const int t0 = 2 * tp, t1 = 2 * tp + 1;
            const float wf0 = __expf(totf - sc[t0] + (TYPE == 1 ? sc[128 + t0] : 0.f)) * ks, wf1 = __expf(totf - sc[t1] + (TYPE == 1 ? sc[128 + t1] : 0.f)) * ks;
            const float wb0 = __expf(totb - sc[64 + t0] + (TYPE == 1 ? sc[192 + t0] : 0.f)) * ks, wb1 = __expf(totb - sc[64 + t1] + (TYPE == 1 ? sc[192 + t1] : 0.f)) * ks;
            unsigned* d0 = (unsigned*)(kT0 + (size_t)(oc * 8) * 80 + 2 * tp); unsigned* d1 = (unsigned*)(kT1 + (size_t)(oc * 8) * 80 + 2 * tp);
#pragma unroll
            for (int j = 0; j < 8; ++j) { d0[j * 40] = cvt_pk(kv[i][0][j] * wf0, kv[i][1][j] * wf1); d1[j * 40] = cvt_pk(kv[i][0][j] * wb0, kv[i][1][j] * wb1); }
        }
        __syncthreads();
        const int chf = (b * 4 + h) * 2;
#pragma unroll 1
        for (int dir = 0; dir < 2; ++dir) {
            if (!((dmask >> dir) & 1)) continue;
            const bf16_t* kT = dir == 0 ? kT0 : kT1;
            const int n = scan_index(dir, c);
            f32x4 acc[2][DK / 16];
#pragma unroll
            for (int i = 0; i < 2; ++i)
#pragma unroll
                for (int nt = 0; nt < DK / 16; ++nt) acc[i][nt] = (f32x4){0.f, 0.f, 0.f, 0.f};
#pragma unroll
            for (int kk = 0; kk < 2; ++kk) {
                bf16x8 fv[2];
#pragma unroll
                for (int i = 0; i < 2; ++i) fv[i] = *(const bf16x8*)(vT + (size_t)((2 * wid + i) * 16 + lr) * 80 + kk * 32 + lq * 8);
#pragma unroll
                for (int nt = 0; nt < DK / 16; ++nt) {
                    const bf16x8 fk = *(const bf16x8*)(kT + (size_t)(nt * 16 + lr) * 80 + kk * 32 + lq * 8);
#pragma unroll
                    for (int i = 0; i < 2; ++i) acc[i][nt] = __builtin_amdgcn_mfma_f32_16x16x32_bf16(fk, fv[i], acc[i][nt], 0, 0, 0);
                }
            }
            bf16_t* ub = U + (size_t)((chf + dir) * NCH + n) * 128 * DK;
#pragma unroll
            for (int i = 0; i < 2; ++i)
#pragma unroll
                for (int nt = 0; nt < DK / 16; ++nt) {
                    const int e = (2 * wid + i) * 16 + lr, d = nt * 16 + lq * 4;
                    u32x2 o; o.x = cvt_pk(acc[i][nt].x, acc[i][nt].y); o.y = cvt_pk(acc[i][nt].z, acc[i][nt].w);
                    *(u32x2*)(ub + (size_t)e * DK + d) = o;
                }
        }
        if (tid < 2 * DK) {
            const int dir = tid / DK, d = tid % DK; const int n = scan_index(dir, c);
            if ((dmask >> dir) & 1) {
            DEC[(size_t)((chf + dir) * NCH + n) * 128 + d] = __expf(dir == 0 ? totf : totb);
            if (TYPE == 1) {
                const bf16_t* kT = dir == 0 ? kT0 : kT1;
                float sum = 0.f;
#pragma unroll
                for (int q = 0; q < 8; ++q) { const u32x4 u = *(const u32x4*)(kT + (size_t)d * 80 + q * 8); float f[8]; UNPACK8(u, f);
#pragma unroll
                    for (int j = 0; j < 8; ++j) sum += f[j]; }
                UN[(size_t)((chf + dir) * NCH + n) * 128 + d] = sum;
            }
            }
        }
        __syncthreads();
    }
}

template <int DK, bool HASN>
__device__ __forceinline__ void scan_phase(const Params& P) {
    bf16_t* U = (bf16_t*)(ws_l(P) + WS_SBUF); const float* DEC = (const float*)(ws_l(P) + WS_DEC); float* UN = (float*)(ws_l(P) + WS_UN);
    constexpr int VEC = DK / 64;
    constexpr int DQ = DK / VEC; constexpr int TT = 16 * 128 * DQ;
    constexpr size_t US = (size_t)128 * DK;
    for (int g = bid_l() * NTHR + tid_l(); g < TT; g += vgrid() * NTHR) {
        const int dq = g % DQ, e = (g / DQ) % 128, chain = g / (DQ * 128);
        bf16_t* up = U + ((size_t)chain * NCH * 128 + e) * DK + dq * VEC;
        const float* dp = DEC + (size_t)chain * NCH * 128 + dq * VEC;
        float S0 = 0.f, S1 = 0.f;
        constexpr int SB = 12;
        unsigned ua[SB], ubv[SB]; f32x2 da[SB], db[SB];
#define SC_LOAD(uu, dd, n0) do { _Pragma("unroll") for (int j = 0; j < SB; ++j) { \
            if (VEC == 2) { uu[j] = *(const unsigned*)(up + (size_t)((n0) + j) * US); dd[j] = *(const f32x2*)(dp + (size_t)((n0) + j) * 128); } \
            else { uu[j] = (unsigned)up[(size_t)((n0) + j) * US]; dd[j].x = dp[(size_t)((n0) + j) * 128]; dd[j].y = 0.f; } } } while (0)
#define SC_STEP(uu, dd, n0) do { _Pragma("unroll") for (int j = 0; j < SB; ++j) { \
            if (VEC == 2) { *(unsigned*)(up + (size_t)((n0) + j) * US) = cvt_pk(S0, S1); S0 = dd[j].x * S0 + bflo(uu[j]); S1 = dd[j].y * S1 + bfhi(uu[j]); } \
            else { up[(size_t)((n0) + j) * US] = (bf16_t)(cvt_pk(S0, 0.f) & 0xffffu); S0 = dd[j].x * S0 + bflo(uu[j]); } } } while (0)
        SC_LOAD(ua, da, 0);
        for (int n0 = 0; n0 < 120; n0 += 24) {
            SC_LOAD(ubv, db, n0 + 12);
            SC_STEP(ua, da, n0);
            SC_LOAD(ua, da, n0 + 24);
            SC_STEP(ubv, db, n0 + 12);
        }
        SC_STEP(ua, da, 120);
#undef SC_LOAD
#undef SC_STEP
    }
    if (HASN) {
        for (int g = bid_l() * NTHR + tid_l(); g < 16 * 128; g += vgrid() * NTHR) {
            const int d = g & 127, chain = g >> 7;
            float* np = UN + (size_t)chain * NCH * 128 + d; const float* dp = DEC + (size_t)chain * NCH * 128 + d;
            float S = 0.f;
            float ua_[12], da_[12], ub_[12], db_[12];
#define NS_LOAD(uu, dd, n0) do { _Pragma("unroll") for (int j = 0; j < 12; ++j) { uu[j] = np[(size_t)((n0) + j) * 128]; dd[j] = dp[(size_t)((n0) + j) * 128]; } } while (0)
#define NS_STEP(uu, dd, n0) do { _Pragma("unroll") for (int j = 0; j < 12; ++j) { np[(size_t)((n0) + j) * 128] = S; S = dd[j] * S + uu[j]; } } while (0)
            NS_LOAD(ua_, da_, 0);
            for (int n0 = 0; n0 < 120; n0 += 24) {
                NS_LOAD(ub_, db_, n0 + 12);
                NS_STEP(ua_, da_, n0);
                NS_LOAD(ua_, da_, n0 + 24);
                NS_STEP(ub_, db_, n0 + 12);
            }
            NS_STEP(ua_, da_, 120);
#undef NS_LOAD
#undef NS_STEP
        }
    }
}

template <int TYPE>
__device__ __forceinline__ void out_phase(const Params& P, int l, int pass, bool latent_only, char* lds) {
    typedef MX<TYPE> M; constexpr int DK = M::DK; constexpr int QP = M::QP;
    const int tid = tid_l(), lane = tid & 63, wid = tid >> 6, lr = lane & 15, lq = lane >> 4;
    const bf16_t* pb = (const bf16_t*)(ws_l(P) + WS_PBUF);
    const bf16_t* U = (const bf16_t*)(ws_l(P) + WS_SBUF); const float* UN = (const float*)(ws_l(P) + WS_UN);
    bf16_t* brp = (bf16_t*)(ws_l(P) + WS_BR);
    bf16_t* vT = (bf16_t*)(lds + L_VT); bf16_t* qin = (bf16_t*)(lds + L_Q); bf16_t* kin = qin + 64 * QP; bf16_t* att = (bf16_t*)(lds + L_ATT);
    const float* cum = (const float*)(lds + L_CUM); const float* sc = (const float*)(lds + L_SC);
    const float* ng = P.in[TYPE == 0 ? I_GNG : (TYPE == 1 ? I_MNG : I_RNG)] + l * 512;
    const int NC = latent_only ? NCH - 4 : NCH; const int NU = NB * 4 * NC, VG = vgrid(), slot = bid_l();
    for (int u0 = 0; u0 < NU; u0 += VG) {
        int unit = u0 + slot; if (unit >= NU) unit = NU - 1;
        const int c = unit % NC + (latent_only ? 4 : 0); const int rest = unit / NC; const int h = rest & 3, b = rest >> 2;
        const int r0 = rowbase(b, c);
        build_vT<TYPE>(pb, b, c, h, lds);
        f32x4 tot[8];
#pragma unroll
        for (int et = 0; et < 8; ++et) tot[et] = (f32x4){0.f, 0.f, 0.f, 0.f};
        const int trow = wid * 16 + lr;
        for (int dir = 0; dir < 2; ++dir) {
            const int chain = (b * 4 + h) * 2 + dir, n = scan_index(dir, c);
            decay_setup<TYPE>(P, l, b, c, h, dir, lds);
#pragma unroll 2
            for (int i = 0; i < 64 * M::NOC / NTHR; ++i) {
                const int pid = tid + i * NTHR, t = pid / M::NOC, oc = pid % M::NOC;
                float q8[8], k8[8];
                load_qk8<TYPE>(P, l, pb, b, c, t, h, oc, false, q8);
                load_qk8<TYPE>(P, l, pb, b, c, t, h, oc, true, k8);
                if (TYPE == 0) {
#pragma unroll
                    for (int j = 0; j < 8; ++j) { const float cv = cum[t * 64 + oc * 8 + j]; q8[j] *= __expf(cv) * 0.125f; k8[j] *= __expf(-cv); }
                } else {
                    const float cv = sc[t];
                    const float wq = __expf(cv);
                    const float wk = TYPE == 1 ? __expf(sc[64 + t] - cv) * 0.08838834764831845f : __expf(-cv) * 0.125f;
#pragma unroll
                    for (int j = 0; j < 8; ++j) { q8[j] *= wq; k8[j] *= wk; }
                }
                u32x4 oq, ok;
                oq.x = cvt_pk(q8[0], q8[1]); oq.y = cvt_pk(q8[2], q8[3]); oq.z = cvt_pk(q8[4], q8[5]); oq.w = cvt_pk(q8[6], q8[7]);
                ok.x = cvt_pk(k8[0], k8[1]); ok.y = cvt_pk(k8[2], k8[3]); ok.z = cvt_pk(k8[4], k8[5]); ok.w = cvt_pk(k8[6], k8[7]);
                *(u32x4*)(qin + (size_t)t * QP + oc * 8) = oq;
                *(u32x4*)(kin + (size_t)t * QP + oc * 8) = ok;
            }
            __syncthreads();
            f32x4 sacc[4];
#pragma unroll
            for (int nt = 0; nt < 4; ++nt) sacc[nt] = (f32x4){0.f, 0.f, 0.f, 0.f};
#pragma unroll
            for (int kk = 0; kk < DK / 32; ++kk) {
                const bf16x8 fq = *(const bf16x8*)(qin + (size_t)trow * QP + kk * 32 + lq * 8);
#pragma unroll
                for (int nt = 0; nt < 4; ++nt) {
                    const bf16x8 fk = *(const bf16x8*)(kin + (size_t)(nt * 16 + lr) * QP + kk * 32 + lq * 8);
                    sacc[nt] = __builtin_amdgcn_mfma_f32_16x16x32_bf16(fk, fq, sacc[nt], 0, 0, 0);
                }
            }
            float den = 0.f;
#pragma unroll
            for (int nt = 0; nt < 4; ++nt) {
                const int s0 = nt * 16 + lq * 4;
                float a0 = sacc[nt].x, a1 = sacc[nt].y, a2 = sacc[nt].z, a3 = sacc[nt].w;
                if (dir == 0) { if (s0 + 0 > trow) a0 = 0.f; if (s0 + 1 > trow) a1 = 0.f; if (s0 + 2 > trow) a2 = 0.f; if (s0 + 3 > trow) a3 = 0.f; }
                else { if (s0 + 0 < trow) a0 = 0.f; if (s0 + 1 < trow) a1 = 0.f; if (s0 + 2 < trow) a2 = 0.f; if (s0 + 3 < trow) a3 = 0.f; }
                den += (a0 + a1) + (a2 + a3);
                u32x2 o; o.x = cvt_pk(a0, a1); o.y = cvt_pk(a2, a3);
                *(u32x2*)(att + (size_t)trow * 80 + s0) = o;
            }
            __syncthreads();
            f32x4 oacc[8];
#pragma unroll
            for (int et = 0; et < 8; ++et) oacc[et] = (f32x4){0.f, 0.f, 0.f, 0.f};
#pragma unroll
            for (int kk = 0; kk < 2; ++kk) {
                const bf16x8 fa = *(const bf16x8*)(att + (size_t)trow * 80 + kk * 32 + lq * 8);
#pragma unroll
                for (int et = 0; et < 8; ++et) {
                    const bf16x8 fv = *(const bf16x8*)(vT + (size_t)(et * 16 + lr) * 80 + kk * 32 + lq * 8);
                    oacc[et] = __builtin_amdgcn_mfma_f32_16x16x32_bf16(fv, fa, oacc[et], 0, 0, 0);
                }
            }
            const bf16_t* sp = U + (size_t)(chain * NCH + n) * 128 * DK;
#pragma unroll
            for (int kk = 0; kk < DK / 32; ++kk) {
                const bf16x8 fq = *(const bf16x8*)(qin + (size_t)trow * QP + kk * 32 + lq * 8);
#pragma unroll
                for (int et = 0; et < 8; ++et) {
                    const bf16x8 fs = *(const bf16x8*)(sp + (size_t)(et * 16 + lr) * DK + kk * 32 + lq * 8);
                    oacc[et] = __builtin_amdgcn_mfma_f32_16x16x32_bf16(fs, fq, oacc[et], 0, 0, 0);
                }
            }
            if (TYPE == 1) {
                const float* np = UN + (size_t)(chain * NCH + n) * 128 + lq * 32;
#pragma unroll
                for (int q = 0; q < 4; ++q) {
                    const u32x4 u = *(const u32x4*)(qin + (size_t)trow * QP + lq * 32 + q * 8); float f[8]; UNPACK8(u, f);
                    const f32x4 n0 = *(const f32x4*)(np + q * 8), n1 = *(const f32x4*)(np + q * 8 + 4);
                    den += f[0] * n0.x + f[1] * n0.y + f[2] * n0.z + f[3] * n0.w + f[4] * n1.x + f[5] * n1.y + f[6] * n1.z + f[7] * n1.w;
                }
                den += __shfl_xor(den, 16); den += __shfl_xor(den, 32);
                const float sc1 = 1.f / fmaxf(fabsf(den), 1.f);
#pragma unroll
                for (int et = 0; et < 8; ++et) tot[et] += oacc[et] * sc1;
            } else {
#pragma unroll
                for (int et = 0; et < 8; ++et) tot[et] += oacc[et];
            }
            __syncthreads();
        }
        float s1 = 0.f;
#pragma unroll
        for (int et = 0; et < 8; ++et) s1 += (tot[et].x + tot[et].y) + (tot[et].z + tot[et].w);
        s1 += __shfl_xor(s1, 16); s1 += __shfl_xor(s1, 32);
        const float mean = TYPE == 0 ? 0.f : s1 * (1.f / 128.f);
        float s2 = 0.f;
#pragma unroll
        for (int et = 0; et < 8; ++et) { tot[et] = tot[et] - mean; s2 += (tot[et].x * tot[et].x + tot[et].y * tot[et].y) + (tot[et].z * tot[et].z + tot[et].w * tot[et].w); }
        s2 += __shfl_xor(s2, 16); s2 += __shfl_xor(s2, 32);
        const float rstd = rsqrtf(s2 * (1.f / 128.f) + 1e-6f);
        const size_t rowi = (size_t)(r0 + trow);
#pragma unroll
        for (int et = 0; et < 8; ++et) {
            const int e = et * 16 + lq * 4;
            const f32x4 gg = *(const f32x4*)(ng + h * 128 + e);
            const u32x2 gu = *(const u32x2*)(pb + rowi * M::PITCH + M::GOFF + h * 128 + e);
            const float g0 = bflo(gu.x), g1 = bfhi(gu.x), g2 = bflo(gu.y), g3 = bfhi(gu.y);
            u32x2 o;
            float y0 = tot[et].x * rstd * gg.x * siluf(g0), y1 = tot[et].y * rstd * gg.y * siluf(g1), y2 = tot[et].z * rstd * gg.z * siluf(g2), y3 = tot[et].w * rstd * gg.w * siluf(g3);
            o.x = cvt_pk(y0, y1); o.y = cvt_pk(y2, y3);
            *(u32x2*)(brp + rowi * 1536 + pass * 512 + h * 128 + e) = o;
        }
        __syncthreads();
    }
}

template <int TYPE>
__device__ __forceinline__ void out_phase_s(const Params& P, int l, int pass, bool latent_only, char* lds) {
    typedef MX<TYPE> M; constexpr int DK = M::DK; constexpr int QP = M::QP; constexpr int NKK = DK / 32;
    const bf16_t* pb = (const bf16_t*)(ws_l(P) + WS_PBUF);
    const bf16_t* U = (const bf16_t*)(ws_l(P) + WS_SBUF); const float* UN = (const float*)(ws_l(P) + WS_UN);
    const float* small = (const float*)(ws_l(P) + WS_SMALL);
    bf16_t* brp = (bf16_t*)(ws_l(P) + WS_BR);
    bf16_t* vT = (bf16_t*)(lds + L_VT); bf16_t* qr = (bf16_t*)(lds + L_Q); bf16_t* kr = qr + 64 * QP; bf16_t* att = (bf16_t*)(lds + L_ATT);
    float* sc = (float*)(lds + L_SC);
    float* sn = sc + 256;
    float* rsv = sc + 512;
    float* part = sc + 640;
    const float* ng = P.in[TYPE == 1 ? I_MNG : I_RNG] + l * 512;
    const int NC = latent_only ? NCH - 4 : NCH; const int NU = NB * 4 * NC, VG = vgrid(), slot = bid_l();
    for (int u0 = 0; u0 < NU; u0 += VG) {
        int unit = u0 + slot; if (unit >= NU) unit = NU - 1;
        const int tid = tid_l(), lane = tid & 63, wid = tid >> 6, lr = lane & 15, lq = lane >> 4;
        const int c = unit % NC + (latent_only ? 4 : 0); const int rest = unit / NC; const int h = rest & 3, b = rest >> 2;
        const int r0 = rowbase(b, c);
        const int trow = wid * 16 + lr;
        const int chf = (b * 4 + h) * 2, nf = scan_index(0, c), nb = scan_index(1, c);
        const bf16_t* spf = U + (size_t)(chf * NCH + nf) * 128 * DK; const bf16_t* spb = U + (size_t)((chf + 1) * NCH + nb) * 128 * DK;
        bf16x8 fsf[2][NKK], fsb[2][NKK];
#pragma unroll
        for (int i = 0; i < 2; ++i)
#pragma unroll
            for (int kk = 0; kk < NKK; ++kk) {
                fsf[i][kk] = *(const bf16x8*)(spf + (size_t)((2 * wid + i) * 16 + lr) * DK + kk * 32 + lq * 8);
                fsb[i][kk] = *(const bf16x8*)(spb + (size_t)((2 * wid + i) * 16 + lr) * DK + kk * 32 + lq * 8);
            }
        u32x2 gu[4][2];
#pragma unroll
        for (int mt = 0; mt < 4; ++mt)
#pragma unroll
            for (int i = 0; i < 2; ++i) gu[mt][i] = *(const u32x2*)(pb + (size_t)(r0 + mt * 16 + lr) * M::PITCH + M::GOFF + h * 128 + (2 * wid + i) * 16 + lq * 4);
        if (TYPE == 1) {
            sn[tid] = UN[(size_t)((chf + (tid >> 7)) * NCH + ((tid >> 7) == 0 ? nf : nb)) * 128 + (tid & 127)];
            if (tid < 128) {
                const int dir = tid >> 6, t = tid & 63;
                const float fg = small[(size_t)(r0 + t) * 48 + 40 + dir * 4 + h] + P.in[I_FB][l * 8 + dir * 4 + h];
                float v = logsig(fg);
                if (dir == 0) {
#pragma unroll
                    for (int o = 1; o < 64; o <<= 1) { const float n = __shfl_up(v, o); if (t >= o) v += n; }
                } else {
#pragma unroll
                    for (int o = 1; o < 64; o <<= 1) { const float n = __shfl_down(v, o); if (t + o < 64) v += n; }
                }
                sc[dir * 64 + t] = v;
                sc[128 + dir * 64 + t] = small[(size_t)(r0 + t) * 48 + 32 + dir * 4 + h] + P.in[I_IB][l * 8 + dir * 4 + h];
            }
        } else {
            if (tid < 64) {
                const float lg0 = logsig(P.in[I_RDL][l * 8 + h]), lg1 = logsig(P.in[I_RDL][l * 8 + 4 + h]);
                sc[tid] = (float)(tid + 1) * lg0; sc[64 + tid] = (float)(64 - tid) * lg1;
            }
        }
        build_vT<TYPE>(pb, b, c, h, lds);
#pragma unroll
        for (int i = 0; i < 64 * M::NOC / NTHR; ++i) {
            const int pid = tid + i * NTHR, t = pid / M::NOC, oc = pid % M::NOC;
            float q8[8], k8[8];
            load_qk8<TYPE>(P, l, pb, b, c, t, h, oc, false, q8);
            load_qk8<TYPE>(P, l, pb, b, c, t, h, oc, true, k8);
            const float ks = TYPE == 1 ? 0.08838834764831845f : 0.125f;
            u32x4 oq, ok;
            oq.x = cvt_pk(q8[0], q8[1]); oq.y = cvt_pk(q8[2], q8[3]); oq.z = cvt_pk(q8[4], q8[5]); oq.w = cvt_pk(q8[6], q8[7]);
            ok.x = cvt_pk(k8[0] * ks, k8[1] * ks); ok.y = cvt_pk(k8[2] * ks, k8[3] * ks); ok.z = cvt_pk(k8[4] * ks, k8[5] * ks); ok.w = cvt_pk(k8[6] * ks, k8[7] * ks);
            *(u32x4*)(qr + (size_t)t * QP + oc * 8) = oq;
            *(u32x4*)(kr + (size_t)t * QP + oc * 8) = ok;
        }
        __syncthreads();
        f32x4 sacc[4];
#pragma unroll
        for (int nt = 0; nt < 4; ++nt) sacc[nt] = (f32x4){0.f, 0.f, 0.f, 0.f};
#pragma unroll
        for (int kk = 0; kk < NKK; ++kk) {
            const bf16x8 fq = *(const bf16x8*)(qr + (size_t)trow * QP + kk * 32 + lq * 8);
#pragma unroll
            for (int nt = 0; nt < 4; ++nt) {
                const bf16x8 fk = *(const bf16x8*)(kr + (size_t)(nt * 16 + lr) * QP + kk * 32 + lq * 8);
                sacc[nt] = __builtin_amdgcn_mfma_f32_16x16x32_bf16(fk, fq, sacc[nt], 0, 0, 0);
            }
        }
        {
            const float cft = sc[trow], cbt = sc[64 + trow];
            const float eft = __expf(cft), ebt = __expf(cbt);
            float af[4][4], ab[4][4]; float denf = 0.f, denb = 0.f;
#pragma unroll
            for (int nt = 0; nt < 4; ++nt) {
                const float av[4] = {sacc[nt].x, sacc[nt].y, sacc[nt].z, sacc[nt].w};
#pragma unroll
                for (int r = 0; r < 4; ++r) {
                    const int s_ = nt * 16 + lq * 4 + r;
                    const float argf = cft - sc[s_] + (TYPE == 1 ? sc[128 + s_] : 0.f), argb = cbt - sc[64 + s_] + (TYPE == 1 ? sc[192 + s_] : 0.f);
                    const float wf = s_ <= trow ? __expf(argf) : 0.f, wb = s_ >= trow ? __expf(argb) : 0.f;
                    af[nt][r] = av[r] * wf; ab[nt][r] = av[r] * wb; denf += af[nt][r]; denb += ab[nt][r];
                }
            }
            float scf = 1.f, scb = 1.f;
            if (TYPE == 1) {
                float qf = 0.f, qb = 0.f;
#pragma unroll
                for (int q = 0; q < 4; ++q) {
                    const u32x4 u = *(const u32x4*)(qr + (size_t)trow * QP + lq * 32 + q * 8); float f[8]; UNPACK8(u, f);
                    const float* a = sn + lq * 32 + q * 8; const float* bq = sn + 128 + lq * 32 + q * 8;
                    const f32x4 a0 = *(const f32x4*)a, a1 = *(const f32x4*)(a + 4), b0 = *(const f32x4*)bq, b1 = *(const f32x4*)(bq + 4);
                    qf += f[0] * a0.x + f[1] * a0.y + f[2] * a0.z + f[3] * a0.w + f[4] * a1.x + f[5] * a1.y + f[6] * a1.z + f[7] * a1.w;
                    qb += f[0] * b0.x + f[1] * b0.y + f[2] * b0.z + f[3] * b0.w + f[4] * b1.x + f[5] * b1.y + f[6] * b1.z + f[7] * b1.w;
                }
                denf += eft * qf; denb += ebt * qb;
                denf += __shfl_xor(denf, 16); denf += __shfl_xor(denf, 32);
                denb += __shfl_xor(denb, 16); denb += __shfl_xor(denb, 32);
                scf = 1.f / fmaxf(fabsf(denf), 1.f); scb = 1.f / fmaxf(fabsf(denb), 1.f);
            }
#pragma unroll
            for (int nt = 0; nt < 4; ++nt) {
                u32x2 o; o.x = cvt_pk(af[nt][0] * scf + ab[nt][0] * scb, af[nt][1] * scf + ab[nt][1] * scb); o.y = cvt_pk(af[nt][2] * scf + ab[nt][2] * scb, af[nt][3] * scf + ab[nt][3] * scb);
                *(u32x2*)(att + (size_t)trow * 80 + nt * 16 + lq * 4) = o;
            }
            if (lq == 0) { rsv[trow] = eft * scf; rsv[64 + trow] = ebt * scb; }
        }
        __syncthreads();
        f32x4 oacc[4][2];
#pragma unroll
        for (int mt = 0; mt < 4; ++mt)
#pragma unroll
            for (int i = 0; i < 2; ++i) oacc[mt][i] = (f32x4){0.f, 0.f, 0.f, 0.f};
#pragma unroll
        for (int kk = 0; kk < 2; ++kk) {
            bf16x8 fv[2];
#pragma unroll
            for (int i = 0; i < 2; ++i) fv[i] = *(const bf16x8*)(vT + (size_t)((2 * wid + i) * 16 + lr) * 80 + kk * 32 + lq * 8);
#pragma unroll
            for (int mt = 0; mt < 4; ++mt) {
                const bf16x8 fa = *(const bf16x8*)(att + (size_t)(mt * 16 + lr) * 80 + kk * 32 + lq * 8);
#pragma unroll
                for (int i = 0; i < 2; ++i) oacc[mt][i] = __builtin_amdgcn_mfma_f32_16x16x32_bf16(fv[i], fa, oacc[mt][i], 0, 0, 0);
            }
        }
#pragma unroll
        for (int dir = 0; dir < 2; ++dir) {
            f32x4 tmp[4][2];
#pragma unroll
            for (int mt = 0; mt < 4; ++mt)
#pragma unroll
                for (int i = 0; i < 2; ++i) tmp[mt][i] = (f32x4){0.f, 0.f, 0.f, 0.f};
#pragma unroll
            for (int kk = 0; kk < NKK; ++kk)
#pragma unroll
                for (int mt = 0; mt < 4; ++mt) {
                    const bf16x8 fq = *(const bf16x8*)(qr + (size_t)(mt * 16 + lr) * QP + kk * 32 + lq * 8);
#pragma unroll
                    for (int i = 0; i < 2; ++i) tmp[mt][i] = __builtin_amdgcn_mfma_f32_16x16x32_bf16(dir == 0 ? fsf[i][kk] : fsb[i][kk], fq, tmp[mt][i], 0, 0, 0);
                }
#pragma unroll
            for (int mt = 0; mt < 4; ++mt) {
                const float rs = rsv[dir * 64 + mt * 16 + lr];
#pragma unroll
                for (int i = 0; i < 2; ++i) oacc[mt][i] += tmp[mt][i] * rs;
            }
        }
#pragma unroll
        for (int mt = 0; mt < 4; ++mt) {
            float s1 = (oacc[mt][0].x + oacc[mt][0].y) + (oacc[mt][0].z + oacc[mt][0].w) + (oacc[mt][1].x + oacc[mt][1].y) + (oacc[mt][1].z + oacc[mt][1].w);
            float s2 = (oacc[mt][0].x * oacc[mt][0].x + oacc[mt][0].y * oacc[mt][0].y) + (oacc[mt][0].z * oacc[mt][0].z + oacc[mt][0].w * oacc[mt][0].w)
                     + (oacc[mt][1].x * oacc[mt][1].x + oacc[mt][1].y * oacc[mt][1].y) + (oacc[mt][1].z * oacc[mt][1].z + oacc[mt][1].w * oacc[mt][1].w);
            s1 += __shfl_xor(s1, 16); s1 += __shfl_xor(s1, 32); s2 += __shfl_xor(s2, 16); s2 += __shfl_xor(s2, 32);
            if (lq == 0) { part[(wid * 64 + mt * 16 + lr) * 2] = s1; part[(wid * 64 + mt * 16 + lr) * 2 + 1] = s2; }
        }
        __syncthreads();
#pragma unroll
        for (int mt = 0; mt < 4; ++mt) {
            const int t = mt * 16 + lr;
            float s1 = 0.f, s2 = 0.f;
#pragma unroll
            for (int w = 0; w < 4; ++w) { s1 += part[(w * 64 + t) * 2]; s2 += part[(w * 64 + t) * 2 + 1]; }
            const float mean = s1 * (1.f / 128.f);
            const float rstd = rsqrtf(fmaxf(s2 * (1.f / 128.f) - mean * mean, 0.f) + 1e-6f);
            const size_t rowi = (size_t)(r0 + t);
#pragma unroll
            for (int i = 0; i < 2; ++i) {
                const int e = (2 * wid + i) * 16 + lq * 4;
                const f32x4 gg = *(const f32x4*)(ng + h * 128 + e);
                const float g0 = bflo(gu[mt][i].x), g1 = bfhi(gu[mt][i].x), g2 = bflo(gu[mt][i].y), g3 = bfhi(gu[mt][i].y);
                u32x2 o;
                o.x = cvt_pk((oacc[mt][i].x - mean) * rstd * gg.x * siluf(g0), (oacc[mt][i].y - mean) * rstd * gg.y * siluf(g1));
                o.y = cvt_pk((oacc[mt][i].z - mean) * rstd * gg.z * siluf(g2), (oacc[mt][i].w - mean) * rstd * gg.w * siluf(g3));
                *(u32x2*)(brp + rowi * 1536 + pass * 512 + h * 128 + e) = o;
            }
        }
        __syncthreads();
    }
}

__device__ __forceinline__ void out_phase_g(const Params& P, int l, bool latent_only, char* lds) {
    typedef MX<0> M; constexpr int DK = 64, QP = 80;
    const bf16_t* pb = (const bf16_t*)(ws_l(P) + WS_PBUF);
    const bf16_t* U = (const bf16_t*)(ws_l(P) + WS_SBUF);
    const float* small = (const float*)(ws_l(P) + WS_SMALL);
    bf16_t* brp = (bf16_t*)(ws_l(P) + WS_BR);
    bf16_t* vT = (bf16_t*)(lds + L_VT); bf16_t* qin = (bf16_t*)(lds + L_Q); bf16_t* kin = qin + 64 * QP; bf16_t* att = (bf16_t*)(lds + L_ATT);
    float* cum = (float*)(lds + L_CUM); float* part = cum;
    const float* ng = P.in[I_GNG] + l * 512;
    const int NC = latent_only ? NCH - 4 : NCH; const int NU = NB * 4 * NC, VG = vgrid(), slot = bid_l();
    for (int u0 = 0; u0 < NU; u0 += VG) {
        int unit = u0 + slot; if (unit >= NU) unit = NU - 1;
        const int tid = tid_l(), lane = tid & 63, wid = tid >> 6, lr = lane & 15, lq = lane >> 4;
        const int c = unit % NC + (latent_only ? 4 : 0); const int rest = unit / NC; const int h = rest & 3, b = rest >> 2;
        const int r0 = rowbase(b, c);
        const int trow = wid * 16 + lr;
        const int chf = (b * 4 + h) * 2, nf = scan_index(0, c), nb = scan_index(1, c);
        const bf16_t* spf = U + (size_t)(chf * NCH + nf) * 128 * DK; const bf16_t* spb = U + (size_t)((chf + 1) * NCH + nb) * 128 * DK;
        bf16x8 fsf[2][2], fsb[2][2];
#pragma unroll
        for (int i = 0; i < 2; ++i)
#pragma unroll
            for (int kk = 0; kk < 2; ++kk) {
                fsf[i][kk] = *(const bf16x8*)(spf + (size_t)((2 * wid + i) * 16 + lr) * DK + kk * 32 + lq * 8);
                fsb[i][kk] = *(const bf16x8*)(spb + (size_t)((2 * wid + i) * 16 + lr) * DK + kk * 32 + lq * 8);
            }
        u32x2 gu[4][2];
#pragma unroll
        for (int mt = 0; mt < 4; ++mt)
#pragma unroll
            for (int i = 0; i < 2; ++i) gu[mt][i] = *(const u32x2*)(pb + (size_t)(r0 + mt * 16 + lr) * M::PITCH + M::GOFF + h * 128 + (2 * wid + i) * 16 + lq * 4);
        float qraw[2][8], kraw[2][8], apre[2][4];
#pragma unroll
        for (int i = 0; i < 2; ++i) {
            const int pid = tid + i * NTHR, t = pid >> 3, oc = pid & 7;
            load_qk8<0>(P, l, pb, b, c, t, h, oc, false, qraw[i]);
            load_qk8<0>(P, l, pb, b, c, t, h, oc, true, kraw[i]);
        }
#pragma unroll
        for (int dir = 0; dir < 2; ++dir)
#pragma unroll
            for (int k = 0; k < 4; ++k) { const int i = tid + k * NTHR; apre[dir][k] = small[(size_t)(r0 + (i >> 4)) * 48 + dir * 16 + (i & 15)]; }
        build_vT<0>(pb, b, c, h, lds);
        f32x4 oacc[4][2];
#pragma unroll
        for (int mt = 0; mt < 4; ++mt)
#pragma unroll
            for (int i = 0; i < 2; ++i) oacc[mt][i] = (f32x4){0.f, 0.f, 0.f, 0.f};
#pragma unroll
        for (int dir = 0; dir < 2; ++dir) {
            decay_setup<0>(P, l, b, c, h, dir, lds, apre[dir]);
#pragma unroll
            for (int i = 0; i < 2; ++i) {
                const int pid = tid + i * NTHR, t = pid >> 3, oc = pid & 7;
                float q8[8], k8[8];
#pragma unroll
                for (int j = 0; j < 8; ++j) { const float cv = cum[t * 64 + oc * 8 + j]; q8[j] = qraw[i][j] * (__expf(cv) * 0.125f); k8[j] = kraw[i][j] * __expf(-cv); }
                u32x4 oq, ok;
                oq.x = cvt_pk(q8[0], q8[1]); oq.y = cvt_pk(q8[2], q8[3]); oq.z = cvt_pk(q8[4], q8[5]); oq.w = cvt_pk(q8[6], q8[7]);
                ok.x = cvt_pk(k8[0], k8[1]); ok.y = cvt_pk(k8[2], k8[3]); ok.z = cvt_pk(k8[4], k8[5]); ok.w = cvt_pk(k8[6], k8[7]);
                *(u32x4*)(qin + (size_t)t * QP + oc * 8) = oq;
                *(u32x4*)(kin + (size_t)t * QP + oc * 8) = ok;
            }
            __syncthreads();
            f32x4 sacc[4];
#pragma unroll
            for (int nt = 0; nt < 4; ++nt) sacc[nt] = (f32x4){0.f, 0.f, 0.f, 0.f};
#pragma unroll
            for (int kk = 0; kk < 2; ++kk) {
                const bf16x8 fq = *(const bf16x8*)(qin + (size_t)trow * QP + kk * 32 + lq * 8);
#pragma unroll
                for (int nt = 0; nt < 4; ++nt) {
                    const bf16x8 fk = *(const bf16x8*)(kin + (size_t)(nt * 16 + lr) * QP + kk * 32 + lq * 8);
                    sacc[nt] = __builtin_amdgcn_mfma_f32_16x16x32_bf16(fk, fq, sacc[nt], 0, 0, 0);
                }
            }
#pragma unroll
            for (int nt = 0; nt < 4; ++nt) {
                const int s0 = nt * 16 + lq * 4;
                float a0 = sacc[nt].x, a1 = sacc[nt].y, a2 = sacc[nt].z, a3 = sacc[nt].w;
                if (dir == 0) { if (s0 + 0 > trow) a0 = 0.f; if (s0 + 1 > trow) a1 = 0.f; if (s0 + 2 > trow) a2 = 0.f; if (s0 + 3 > trow) a3 = 0.f; }
                else { if (s0 + 0 < trow) a0 = 0.f; if (s0 + 1 < trow) a1 = 0.f; if (s0 + 2 < trow) a2 = 0.f; if (s0 + 3 < trow) a3 = 0.f; }
                u32x2 o; o.x = cvt_pk(a0, a1); o.y = cvt_pk(a2, a3);
                *(u32x2*)(att + (size_t)trow * 80 + s0) = o;
            }
            __syncthreads();
#pragma unroll
            for (int kk = 0; kk < 2; ++kk) {
                bf16x8 fv[2];
#pragma unroll
                for (int i = 0; i < 2; ++i) fv[i] = *(const bf16x8*)(vT + (size_t)((2 * wid + i) * 16 + lr) * 80 + kk * 32 + lq * 8);
#pragma unroll
                for (int mt = 0; mt < 4; ++mt) {
                    const bf16x8 fa = *(const bf16x8*)(att + (size_t)(mt * 16 + lr) * 80 + kk * 32 + lq * 8);
                    const bf16x8 fq = *(const bf16x8*)(qin + (size_t)(mt * 16 + lr) * QP + kk * 32 + lq * 8);
#pragma unroll
                    for (int i = 0; i < 2; ++i) {
                        oacc[mt][i] = __builtin_amdgcn_mfma_f32_16x16x32_bf16(fv[i], fa, oacc[mt][i], 0, 0, 0);
                        oacc[mt][i] = __builtin_amdgcn_mfma_f32_16x16x32_bf16(dir == 0 ? fsf[i][kk] : fsb[i][kk], fq, oacc[mt][i], 0, 0, 0);
                    }
                }
            }
            __syncthreads();
        }
#pragma unroll
        for (int mt = 0; mt < 4; ++mt) {
            float s2 = (oacc[mt][0].x * oacc[mt][0].x + oacc[mt][0].y * oacc[mt][0].y) + (oacc[mt][0].z * oacc[mt][0].z + oacc[mt][0].w * oacc[mt][0].w)
                     + (oacc[mt][1].x * oacc[mt][1].x + oacc[mt][1].y * oacc[mt][1].y) + (oacc[mt][1].z * oacc[mt][1].z + oacc[mt][1].w * oacc[mt][1].w);
            s2 += __shfl_xor(s2, 16); s2 += __shfl_xor(s2, 32);
            if (lq == 0) part[wid * 64 + mt * 16 + lr] = s2;
        }
        __syncthreads();
#pragma unroll
        for (int mt = 0; mt < 4; ++mt) {
            const int t = mt * 16 + lr;
            const float s2 = (part[t] + part[64 + t]) + (part[128 + t] + part[192 + t]);
            const float rstd = rsqrtf(s2 * (1.f / 128.f) + 1e-6f);
            const size_t rowi = (size_t)(r0 + t);
#pragma unroll
            for (int i = 0; i < 2; ++i) {
                const int e = (2 * wid + i) * 16 + lq * 4;
                const f32x4 gg = *(const f32x4*)(ng + h * 128 + e);
                const float g0 = bflo(gu[mt][i].x), g1 = bfhi(gu[mt][i].x), g2 = bflo(gu[mt][i].y), g3 = bfhi(gu[mt][i].y);
                u32x2 o;
                o.x = cvt_pk(oacc[mt][i].x * rstd * gg.x * siluf(g0), oacc[mt][i].y * rstd * gg.y * siluf(g1));
                o.y = cvt_pk(oacc[mt][i].z * rstd * gg.z * siluf(g2), oacc[mt][i].w * rstd * gg.w * siluf(g3));
                *(u32x2*)(brp + rowi * 1536 + h * 128 + e) = o;
            }
        }
        __syncthreads();
    }
}

template <int NI, class F>
__device__ __forceinline__ void ctx_gemm(const bf16_t* A, int lda, const bf16_t* Bt, int ldb, int K, int N, const F& f, char* lds) {
    const int tid = tid_l(), lane = tid & 63, wid = tid >> 6, wm = wid >> 1, wn = wid & 1, lr = lane & 15, lq = lane >> 4;
    const int Nt = (N + 32 * NI - 1) / (32 * NI);
    const int total = 4 * Nt, VG = vgrid(), slot = bid_l();
    for (int t0 = 0; t0 < total; t0 += VG) {
        const int t = t0 + (VG - 1 - slot); if (t >= total) continue;
        const int tm = t & 3, tn = t >> 2;
        f32x4 acc[4][NI];
#pragma unroll
        for (int mi = 0; mi < 4; ++mi)
#pragma unroll
            for (int ni = 0; ni < NI; ++ni) acc[mi][ni] = (f32x4){0.f, 0.f, 0.f, 0.f};
        gemm_kloop<NI>(acc, A + (size_t)(RL + tm * 128) * lda, lda, Bt + (size_t)tn * (32 * NI) * ldb, ldb, K, lds);
#pragma unroll
        for (int mi = 0; mi < 4; ++mi)
#pragma unroll
            for (int ni = 0; ni < NI; ++ni) f(RL + tm * 128 + wm * 64 + mi * 16 + lr, tn * (32 * NI) + wn * (16 * NI) + ni * 16 + lq * 4, acc[mi][ni], 0);
    }
}
__device__ __forceinline__ void ctx_merge(const Params& P, char* lds) {
    const int tid = tid_l(), lane = tid & 63, wid = tid >> 6, wm = wid >> 1, wn = wid & 1, lr = lane & 15, lq = lane >> 4;
    const bf16_t* br = (const bf16_t*)(ws_l(P) + WS_BR); const bf16_t* wb = (const bf16_t*)(ws_l(P) + WS_WTBR);
    const bf16_t* gs = (const bf16_t*)(ws_l(P) + WS_GS); bf16_t* mb = (bf16_t*)(ws_l(P) + WS_MB);
    const int total = 64, VG = vgrid(), slot = bid_l();
    for (int t0 = 0; t0 < total; t0 += VG) {
        const int t = t0 + (VG - 1 - slot); if (t >= total) continue;
        const int tm = t & 3, tn = t >> 2;
        f32x4 m[4][2];
#pragma unroll
        for (int mi = 0; mi < 4; ++mi)
#pragma unroll
            for (int ni = 0; ni < 2; ++ni) m[mi][ni] = (f32x4){0.f, 0.f, 0.f, 0.f};
#pragma unroll 1
        for (int j = 0; j < 3; ++j) {
            f32x4 acc[4][2];
#pragma unroll
            for (int mi = 0; mi < 4; ++mi)
#pragma unroll
                for (int ni = 0; ni < 2; ++ni) acc[mi][ni] = (f32x4){0.f, 0.f, 0.f, 0.f};
            gemm_kloop<2>(acc, br + (size_t)(RL + tm * 128) * 1536 + j * 512, 1536, wb + ((size_t)j * 1024 + tn * 64) * 512, 512, 512, lds);
#pragma unroll
            for (int mi = 0; mi < 4; ++mi)
#pragma unroll
                for (int ni = 0; ni < 2; ++ni) {
                    const int r = RL + tm * 128 + wm * 64 + mi * 16 + lr, c = tn * 64 + wn * 32 + ni * 16 + lq * 4;
                    const u32x2 g = *(const u32x2*)(gs + (size_t)r * 3072 + j * 1024 + c);
                    m[mi][ni].x += acc[mi][ni].x * bflo(g.x); m[mi][ni].y += acc[mi][ni].y * bfhi(g.x);
                    m[mi][ni].z += acc[mi][ni].z * bflo(g.y); m[mi][ni].w += acc[mi][ni].w * bfhi(g.y);
                }
        }
#pragma unroll
        for (int mi = 0; mi < 4; ++mi)
#pragma unroll
            for (int ni = 0; ni < 2; ++ni) {
                const int r = RL + tm * 128 + wm * 64 + mi * 16 + lr, c = tn * 64 + wn * 32 + ni * 16 + lq * 4;
                u32x2 o; o.x = cvt_pk(m[mi][ni].x, m[mi][ni].y); o.y = cvt_pk(m[mi][ni].z, m[mi][ni].w);
                *(u32x2*)(mb + (size_t)r * 1024 + c) = o;
            }
    }
}


#define XB_TMO      128
#define XB_XCNT(j)  (256  + 64 * (j))
#define XB_XSUB(j)  (1280 + 64 * (j))
#define XB_XGEN(j)  (2304 + 64 * (j))
#define XB_TOP      3328
#define XB_TOPGEN   3392
#define XCD_BAR_WORDS 3456
#define XB_SPIN_CAP (1u << 18)
__device__ __forceinline__ unsigned xb_ld(unsigned* p)              { return __hip_atomic_load(p, __ATOMIC_RELAXED, __HIP_MEMORY_SCOPE_AGENT); }
__device__ __forceinline__ unsigned xb_add(unsigned* p, unsigned v) { return __hip_atomic_fetch_add(p, v, __ATOMIC_RELAXED, __HIP_MEMORY_SCOPE_AGENT); }
__device__ __forceinline__ unsigned xb_xcc_id() { return (unsigned)__builtin_amdgcn_s_getreg((3 << 11) | 20) & 0xFu; }
#define XB_SPIN(cond, bar) do { unsigned _sp = 0; while (cond) { __builtin_amdgcn_s_sleep(1); \
    if ((++_sp & 255u) == 0u) { if (xb_ld(&(bar)[XB_TMO])) break; if (_sp > XB_SPIN_CAP) { atomicAdd(&(bar)[XB_TMO], 1u); break; } } } } while (0)
struct XcdBarrier { unsigned* bar; unsigned x; volatile LAS unsigned* st; };
__device__ __forceinline__ XcdBarrier xcd_barrier_post(unsigned* bar, volatile LAS unsigned* st) {
    XcdBarrier b; b.bar = bar; b.x = xb_xcc_id(); b.st = st;
    if (threadIdx.x == 0) (void)xb_add(&bar[XB_XCNT(b.x)], 1u);
    return b;
}
__device__ __forceinline__ void xcd_barrier_complete(unsigned* bar, unsigned x, unsigned& nloc, unsigned& nx) {
    const unsigned G = gridDim.x * gridDim.y * gridDim.z;
    unsigned sum, cnt, mine, sp = 0u;
    for (;;) {
        sum = 0u; cnt = 0u; mine = 0u;
#pragma unroll
        for (unsigned j = 0; j < 16; ++j) { const unsigned c = xb_ld(&bar[XB_XCNT(j)]); sum += c; cnt += (c > 0u) ? 1u : 0u; mine = (j == x) ? c : mine; }
        if (sum == G) break;
        __builtin_amdgcn_s_sleep(1);
        if ((++sp & 255u) == 0u) { if (xb_ld(&bar[XB_TMO])) break; if (sp > XB_SPIN_CAP) { atomicAdd(&bar[XB_TMO], 1u); break; } }
    }
    nloc = mine > 0u ? mine : 1u; nx = cnt > 0u ? cnt : 1u;
}
__device__ __forceinline__ void xcd_barrier(const XcdBarrier& b) {
    asm volatile("s_waitcnt vmcnt(0)" ::: "memory");
    __syncthreads();
    if (threadIdx.x == 0) {
        unsigned* bar = b.bar;
        __builtin_amdgcn_s_waitcnt(0);
        unsigned nloc = b.st[0], nx = b.st[1];
        if (nloc == 0u) { xcd_barrier_complete(bar, b.x, nloc, nx); b.st[0] = nloc; b.st[1] = nx; }
        const unsigned old = xb_add(&bar[XB_XSUB(b.x)], 1u);
        const unsigned gen = old / nloc;
        if (old + 1u == (gen + 1u) * nloc) {
            __builtin_amdgcn_fence(__ATOMIC_RELEASE, "agent");
            asm volatile("s_waitcnt vmcnt(0)" ::: "memory");
            const unsigned og = xb_add(&bar[XB_TOP], 1u);
            const unsigned tg = og / nx;
            if (og + 1u == (tg + 1u) * nx) xb_add(&bar[XB_TOPGEN], 1u);
            else XB_SPIN(xb_ld(&bar[XB_TOPGEN]) == tg, bar);
            __builtin_amdgcn_fence(__ATOMIC_ACQUIRE, "agent");
            xb_add(&bar[XB_XGEN(b.x)], 1u);
            asm volatile("s_waitcnt vmcnt(0)" ::: "memory");
        } else {
            XB_SPIN(xb_ld(&bar[XB_XGEN(b.x)]) == gen, bar);
            __builtin_amdgcn_fence(__ATOMIC_ACQUIRE, "agent");
            asm volatile("s_waitcnt vmcnt(0)" ::: "memory");
        }
    }
    __syncthreads();
}

__global__ void __launch_bounds__(512, 2) fwd_kernel(Params P) {
    extern __shared__ __attribute__((aligned(16))) unsigned char lds_raw[];
    cg::grid_group grid = cg::this_grid();
    LAS unsigned char* ldsb = (LAS unsigned char*)lds_raw;
#define LDSH ((char*)lds_raw + __builtin_amdgcn_readfirstlane(threadIdx.x >> 8) * HALF_LDS)
    volatile LAS unsigned* bst = (volatile LAS unsigned*)(ldsb + 2 * HALF_LDS);
    if (threadIdx.x < 2) bst[threadIdx.x] = 0u;
    __syncthreads();
    XcdBarrier xbar = xcd_barrier_post((unsigned*)(P.ws + WS_BAR), bst);
    int ph = 0;
#define PHASE_BEGIN if (ph >= P.lo && ph < P.hi) {
#define PHASE_END } ++ph; if (P.coop && ph > P.lo && ph < P.hi) { if (ph == 1) grid.sync(); else xcd_barrier(xbar); }

    PHASE_BEGIN
        {
        { const int VG = vgrid(), slot = bid_l();
          for (int i0 = 0; i0 < 384; i0 += VG) { int it = i0 + slot; if (it >= 384) it = 383; mods_task(P, it, LDSH); } }
        if (bid_l() == vgrid() - 1) rope_task(P);
        convert_all(P, 0, LDSH);
        }
    PHASE_END

    const XPtr Xin{(float*)P.in[I_X], (float*)P.in[I_CTX]};
    const XPtr Xcur{P.out, (float*)(P.ws + WS_CTXX)};

    for (int l = 0; l < 2; ++l) {
        const XPtr Xold = l == 0 ? Xin : Xcur;
        const bool ctx_on = (l == 0);
        PHASE_BEGIN
            {
            if (l == 1) convert_all(P, 1, LDSH);
            norm_phase(P, Xold, P.in[I_N1G] + l * D, l, 0, R);
            }
        PHASE_END
        PHASE_BEGIN
            const bf16_t* hb = (const bf16_t*)(ws_l(P) + WS_HBUF); const bf16_t* wt = (const bf16_t*)(ws_l(P) + WS_WTIN);
            EpiP e{(bf16_t*)(ws_l(P) + WS_PBUF), 1536, 1536, (float*)(ws_l(P) + WS_SMALL)};
            {
            big_gemm(ldsb, hb, 1024, wt, 1024, 1792, e);
            ctx_gemm<4>(hb, 1024, wt, 1024, 1024, 1664, e, LDSH); }
        PHASE_END
        PHASE_BEGIN u_phase<0>(P, l, LDSH); PHASE_END
        PHASE_BEGIN scan_phase<64, false>(P); PHASE_END
        PHASE_BEGIN out_phase_g(P, l, !ctx_on, LDSH); PHASE_END
        PHASE_BEGIN
            const bf16_t* hb = (const bf16_t*)(ws_l(P) + WS_HBUF); const bf16_t* wt = (const bf16_t*)(ws_l(P) + WS_WTIN) + (size_t)1792 * 1024;
            EpiP e{(bf16_t*)(ws_l(P) + WS_PBUF), 2048, 2048, nullptr};
            {
            big_gemm(ldsb, hb, 1024, wt, 1024, 2048, e);
            ctx_gemm<2>(hb, 1024, wt, 1024, 1024, 2048, e, LDSH); }
        PHASE_END
        PHASE_BEGIN u_phase_s<1>(P, l, LDSH); PHASE_END
        PHASE_BEGIN scan_phase<128, true>(P); PHASE_END
        PHASE_BEGIN out_phase_s<1>(P, l, 1, !ctx_on, LDSH); PHASE_END
        PHASE_BEGIN
            const bf16_t* hb = (const bf16_t*)(ws_l(P) + WS_HBUF); const bf16_t* wt = (const bf16_t*)(ws_l(P) + WS_WTIN) + (size_t)3840 * 1024;
            EpiP e{(bf16_t*)(ws_l(P) + WS_PBUF), 1536, 1536, nullptr};
            {
            big_gemm(ldsb, hb, 1024, wt, 1024, 1536, e);
            ctx_gemm<4>(hb, 1024, wt, 1024, 1024, 1536, e, LDSH); }
        PHASE_END
        PHASE_BEGIN u_phase_s<2>(P, l, LDSH); PHASE_END
        PHASE_BEGIN scan_phase<64, false>(P); PHASE_END
        PHASE_BEGIN out_phase_s<2>(P, l, 2, !ctx_on, LDSH); PHASE_END
        PHASE_BEGIN
            const bf16_t* hb = (const bf16_t*)(ws_l(P) + WS_HBUF); const bf16_t* wt = (const bf16_t*)(ws_l(P) + WS_WTIN) + (size_t)5376 * 1024;
            EpiSig e{(bf16_t*)(ws_l(P) + WS_GS)};
            {
            big_gemm(ldsb, hb, 1024, wt, 1024, 3072, e);
            if (ctx_on) ctx_gemm<2>(hb, 1024, wt, 1024, 1024, 3072, e, LDSH); }
        PHASE_END
        PHASE_BEGIN
            {   pg8::Gemm g{(const bf16_t*)(ws_l(P) + WS_BR), (const bf16_t*)(ws_l(P) + WS_WTBR), 1536, 512};
                pg8::MergeOrder S; S.S.init(RL, 1024, (int)gridDim.x, (int)blockIdx.x);
                pg8::Epi<EpiMerge> E{EpiMerge{(const bf16_t*)(ws_l(P) + WS_GS), (bf16_t*)(ws_l(P) + WS_MB)}};
                pg8::gemm_phase(ldsb, g, S, E);
                __syncthreads(); }
            if (ctx_on) ctx_merge(P, LDSH);
        PHASE_END
        PHASE_BEGIN
            const float* mods_l = (const float*)(ws_l(P) + WS_MODS) + (size_t)l * 3 * 6144;
            EpiRes e{Xold, Xcur, mods_l, 2};
            big_gemm(ldsb, (const bf16_t*)(ws_l(P) + WS_MB), 1024, (const bf16_t*)(ws_l(P) + WS_WTO), 1024, 1024, e);
            if (ctx_on) ctx_gemm<1>((const bf16_t*)(ws_l(P) + WS_MB), 1024, (const bf16_t*)(ws_l(P) + WS_WTO), 1024, 1024, 1024, e, LDSH);
        PHASE_END
        PHASE_BEGIN norm_phase(P, Xcur, P.in[I_N2G] + l * D, l, 3, ctx_on ? R : RL); PHASE_END
        PHASE_BEGIN
            const bf16_t* hb = (const bf16_t*)(ws_l(P) + WS_HBUF);
            EpiRelu2 e{(bf16_t*)(ws_l(P) + WS_HID)};
            {
            big_gemm(ldsb, hb, 1024, (const bf16_t*)(ws_l(P) + WS_WTUP), 1024, 4096, e);
            if (ctx_on) ctx_gemm<2>(hb, 1024, (const bf16_t*)(ws_l(P) + WS_WTUP), 1024, 1024, 4096, e, LDSH); }
        PHASE_END
        PHASE_BEGIN
            const float* mods_l = (const float*)(ws_l(P) + WS_MODS) + (size_t)l * 3 * 6144;
            EpiRes e{Xcur, Xcur, mods_l, 5};
            big_gemm(ldsb, (const bf16_t*)(ws_l(P) + WS_HID), 4096, (const bf16_t*)(ws_l(P) + WS_WTDN), 4096, 1024, e);
            if (ctx_on) ctx_gemm<1>((const bf16_t*)(ws_l(P) + WS_HID), 4096, (const bf16_t*)(ws_l(P) + WS_WTDN), 4096, 4096, 1024, e, LDSH);
        PHASE_END
    }
    PHASE_BEGIN final_norm_phase(P); PHASE_END
#undef PHASE_BEGIN
#undef PHASE_END
}
constexpr int NPHASES = 1 + 2 * 19 + 1;

extern "C" void kernel_launch(void* const* d_in, const int* in_sizes, int n_in, void* d_out, int out_size, void* d_ws, size_t ws_size, hipStream_t stream) {
    static int grid = 0;
    if (grid == 0) {
        if (n_in != 23 || ws_size < WS_END || out_size != NB * SEQ * D) { fprintf(stderr, "kernel_launch: unexpected sizes n_in %d ws %zu (need %zu) out %d\n", n_in, ws_size, (size_t)WS_END, out_size); grid = -1; return; }
        int dev = 0, cus = 0, per_cu = 0;
        if (hipGetDevice(&dev) != hipSuccess || hipDeviceGetAttribute(&cus, hipDeviceAttributeMultiprocessorCount, dev) != hipSuccess) { grid = -1; return; }
        if (hipFuncSetAttribute((const void*)fwd_kernel, hipFuncAttributeMaxDynamicSharedMemorySize, LDS_BYTES) != hipSuccess) { fprintf(stderr, "kernel_launch: hipFuncSetAttribute failed\n"); grid = -1; return; }
        if (hipOccupancyMaxActiveBlocksPerMultiprocessor(&per_cu, (const void*)fwd_kernel, 512, LDS_BYTES) != hipSuccess || per_cu < 1) { fprintf(stderr, "kernel_launch: occupancy query failed (%d)\n", per_cu); grid = -1; return; }
        grid = cus;
        grid -= grid % 8;
    }
    if (grid < 0) return;
    if (hipMemsetAsync((char*)d_ws + WS_BAR, 0, (size_t)3456 * 4, stream) != hipSuccess) { fprintf(stderr, "kernel_launch: memset failed\n"); return; }
    Params p{};
    for (int i = 0; i < 23; ++i) p.in[i] = (const float*)d_in[i];
    p.out = (float*)d_out; p.ws = (unsigned char*)d_ws;
    p.lo = 0; p.hi = NPHASES; p.coop = 1;
    void* args[] = {&p};
    hipError_t e = hipLaunchCooperativeKernel((const void*)fwd_kernel, dim3(grid), dim3(512), args, LDS_BYTES, stream);
    if (e != hipSuccess) fprintf(stderr, "kernel_launch: cooperative launch failed: %s (grid %d)\n", hipGetErrorString(e), grid);
}
```

```cpp
#include <hip/hip_runtime.h>
#include <hip/hip_cooperative_groups.h>
#include <stdint.h>
#include <stdio.h>
namespace cg = cooperative_groups;

#define LAS __attribute__((address_space(3)))
typedef unsigned short bf16_t;
typedef short bf16x8 __attribute__((ext_vector_type(8)));
typedef float f32x4 __attribute__((ext_vector_type(4)));
typedef unsigned u32x4 __attribute__((ext_vector_type(4)));
typedef unsigned u32x2 __attribute__((ext_vector_type(2)));

constexpr int D = 1024, NB = 2, SEQ = 8192, CTX = 256, RB = SEQ + CTX, R = NB * RB, RL = NB * SEQ, NCH = RB / 64, FF = 4096;
constexpr int INW = 8240;
constexpr int NTHR = 256;
constexpr int HALF_LDS = 73728;
constexpr int LDS_BYTES = 2 * HALF_LDS + 16;

constexpr size_t WS_WTIN = 0;
constexpr size_t WS_WTBR = WS_WTIN + (size_t)8448 * 1024 * 2;
constexpr size_t WS_WTO = WS_WTBR + (size_t)3 * 1024 * 512 * 2;
constexpr size_t WS_WTUP = WS_WTO + (size_t)1024 * 1024 * 2;
constexpr size_t WS_WTDN = WS_WTUP + (size_t)4096 * 1024 * 2;
constexpr size_t WS_HBUF = WS_WTDN + (size_t)4096 * 1024 * 2;
constexpr size_t WS_PBUF = WS_HBUF + (size_t)R * 1024 * 2;
constexpr size_t WS_SBUF = WS_PBUF + (size_t)R * 2048 * 2;
constexpr size_t WS_BR = WS_SBUF + (size_t)R * 2048 * 2;
constexpr size_t WS_CTXX = WS_BR + (size_t)R * 1536 * 2;
constexpr size_t WS_SMALL = WS_CTXX + (size_t)512 * 1024 * 4;
constexpr size_t WS_DEC = WS_SMALL + (size_t)R * 48 * 4;
constexpr size_t WS_UN = WS_DEC + (size_t)16 * NCH * 128 * 4;
constexpr size_t WS_MODS = WS_UN + (size_t)16 * NCH * 128 * 4;
constexpr size_t WS_ROPE = WS_MODS + (size_t)2 * 3 * 6144 * 4;
constexpr size_t WS_BAR = WS_ROPE + (size_t)(128 + 64) * 16 * 2 * 4;
constexpr size_t WS_END = WS_BAR + (size_t)3456 * 4;
constexpr size_t WS_GS = WS_PBUF;
constexpr size_t WS_MB = WS_PBUF + (size_t)R * 3072 * 2;
constexpr size_t WS_HID = WS_PBUF;

struct Params { const float* in[23]; float* out; unsigned char* ws; int lo, hi, coop, pad; };

__device__ __forceinline__ int tid_l() { int t = threadIdx.x & 255; asm volatile("" : "+v"(t)); return t; }
__device__ __forceinline__ int bid_l() { int t = blockIdx.x * 2 + (__builtin_amdgcn_readfirstlane(threadIdx.x >> 8)); asm volatile("" : "+s"(t)); return t; }
__device__ __forceinline__ int vgrid() { return gridDim.x * 2; }
__device__ __forceinline__ unsigned char* ws_l(const Params& P) { unsigned char* w = P.ws; asm volatile("" : "+s"(w)); return w; }
enum { I_X = 0, I_C, I_CTX, I_CCTX, I_N1G, I_N2G, I_WADA, I_BADA, I_WIN, I_A2, I_ABIAS, I_GNG, I_CONV, I_IB, I_FB, I_MNG, I_RDL, I_RNG, I_WBR, I_WO, I_WUP, I_WDN, I_FG };

typedef __bf16 bf16x2_t __attribute__((ext_vector_type(2)));
typedef float f32x2 __attribute__((ext_vector_type(2)));
__device__ __forceinline__ unsigned cvt_pk(float lo, float hi) { f32x2 v = {lo, hi}; bf16x2_t b = __builtin_convertvector(v, bf16x2_t); return __builtin_bit_cast(unsigned, b); }
__device__ __forceinline__ float bflo(unsigned u) { return __uint_as_float(u << 16); }
__device__ __forceinline__ float bfhi(unsigned u) { return __uint_as_float(u & 0xffff0000u); }
__device__ __forceinline__ float wave_sum(float v) {
#pragma unroll
    for (int o = 32; o > 0; o >>= 1) v += __shfl_xor(v, o);
    return v;
}
__device__ __forceinline__ float logsig(float x) { return fminf(x, 0.f) - log1pf(__expf(-fabsf(x))); }
__device__ __forceinline__ float siluf(float x) { return x * __builtin_amdgcn_rcpf(1.f + __expf(-x)); }
__device__ __forceinline__ float sigmf(float x) { return __builtin_amdgcn_rcpf(1.f + __expf(-x)); }

struct XPtr { float* lat; float* ctx; };
__device__ __forceinline__ float* xrow(const XPtr& X, int r) { return r < RL ? X.lat + (size_t)r * D : X.ctx + (size_t)(r - RL) * D; }
__device__ __forceinline__ int modidx(int r) { return r < SEQ ? 0 : (r < RL ? 1 : 2); }
__device__ __forceinline__ int rowbase(int b, int c) { return c < 4 ? RL + b * CTX + c * 64 : b * SEQ + (c - 4) * 64; }

#define UNPACK8(u, f) do { f[0] = bflo(u.x); f[1] = bfhi(u.x); f[2] = bflo(u.y); f[3] = bfhi(u.y); f[4] = bflo(u.z); f[5] = bfhi(u.z); f[6] = bflo(u.w); f[7] = bfhi(u.w); } while (0)

__device__ __forceinline__ void mods_task(const Params& P, int task, char* lds) {
    float* s = (float*)lds;
    float* red = (float*)(lds + 12288);
    const int tid = tid_l();
    const int l = task / 192, col0 = (task % 192) * 32;
    const float* c = P.in[I_C]; const float* cc = P.in[I_CCTX];
    for (int i = tid; i < 3072; i += NTHR) { const int v = i >> 10, k = i & 1023; const float cv = v < 2 ? c[v * 1024 + k] : cc[k]; s[i] = siluf(cv); }
    __syncthreads();
    const int col = tid & 31, kg = tid >> 5;
    const float* w = P.in[I_WADA] + (size_t)l * D * 6144 + col0 + col;
    float a0 = 0.f, a1 = 0.f, a2 = 0.f;
#pragma unroll 32
    for (int k = kg * 128; k < kg * 128 + 128; ++k) { const float wv = w[(size_t)k * 6144]; a0 += s[k] * wv; a1 += s[1024 + k] * wv; a2 += s[2048 + k] * wv; }
    red[(kg * 32 + col) * 3 + 0] = a0; red[(kg * 32 + col) * 3 + 1] = a1; red[(kg * 32 + col) * 3 + 2] = a2;
    __syncthreads();
    if (tid < 96) {
        const int v = tid >> 5, c2 = tid & 31; float sum = 0.f;
#pragma unroll
        for (int g = 0; g < 8; ++g) sum += red[(g * 32 + c2) * 3 + v];
        sum += P.in[I_BADA][l * 6144 + col0 + c2];
        ((float*)(ws_l(P) + WS_MODS))[(l * 3 + v) * 6144 + col0 + c2] = sum;
    }
    __syncthreads();
}

__device__ __forceinline__ void rope_task(const Params& P) {
    float* tab = (float*)(ws_l(P) + WS_ROPE);
    for (int i = tid_l(); i < 192 * 16; i += NTHR) {
        const int pos = i >> 4, f = i & 15;
        const float inv = exp2f(-(float)f * (13.287712379549449f / 16.f));
        const float p = pos < 128 ? (float)pos : (float)(pos - 128);
        const float ang = p * inv;
        const float cs = cosf(ang), sn = sinf(ang);
        if (pos < 128) { tab[pos * 16 + f] = cs; tab[2048 + pos * 16 + f] = sn; }
        else { tab[4096 + (pos - 128) * 16 + f] = cs; tab[4096 + 1024 + (pos - 128) * 16 + f] = sn; }
    }
}

__device__ __forceinline__ void transpose_tile(const float* src, int ldsrc, int k0, int n0src, int nvalid, bf16_t* dst, int ldd, int drow0, char* lds) {
    float* tile = (float*)lds;
    const int tid = tid_l(), nl = tid & 63, kq = tid >> 6;
    float v[32];
#pragma unroll
    for (int i = 0; i < 32; ++i) v[i] = nl < nvalid ? src[(size_t)(k0 + kq + 4 * i) * ldsrc + n0src + nl] : 0.f;
#pragma unroll
    for (int i = 0; i < 32; ++i) tile[(kq + 4 * i) * 65 + nl] = v[i];
    __syncthreads();
    const int n = tid >> 2, ks = (tid & 3) * 32;
    if (n < nvalid) {
        u32x4* dp = (u32x4*)(dst + (size_t)(drow0 + n) * ldd + k0 + ks);
#pragma unroll
        for (int q = 0; q < 4; ++q) {
            u32x4 o;
            o.x = cvt_pk(tile[(ks + 8 * q + 0) * 65 + n], tile[(ks + 8 * q + 1) * 65 + n]); o.y = cvt_pk(tile[(ks + 8 * q + 2) * 65 + n], tile[(ks + 8 * q + 3) * 65 + n]);
            o.z = cvt_pk(tile[(ks + 8 * q + 4) * 65 + n], tile[(ks + 8 * q + 5) * 65 + n]); o.w = cvt_pk(tile[(ks + 8 * q + 6) * 65 + n], tile[(ks + 8 * q + 7) * 65 + n]);
            dp[q] = o;
        }
    }
    __syncthreads();
}

constexpr int CONV_TILES = 192 + 8 + 8 + 256 + 192 + 384 + 192 + 128 + 512 + 512;
__device__ __forceinline__ void convert_tile(const Params& P, int l, int it, char* lds) {
    const float* win = P.in[I_WIN] + (size_t)l * D * INW;
    bf16_t* wtin = (bf16_t*)(ws_l(P) + WS_WTIN);
    int r = it;
    if (r < 192) { const int kt = r / 24, nt = r % 24; transpose_tile(win, INW, kt * 128, nt * 64, 64, wtin, 1024, nt * 64, lds); return; } r -= 192;
    if (r < 8) { transpose_tile(win, INW, r * 128, 1536, 32, wtin, 1024, 1536, lds); return; } r -= 8;
    if (r < 8) { transpose_tile(win, INW, r * 128, 3616, 16, wtin, 1024, 1568, lds); return; } r -= 8;
    if (r < 256) { const int kt = r / 32, nt = r % 32; transpose_tile(win, INW, kt * 128, 1568 + nt * 64, 64, wtin, 1024, 1792 + nt * 64, lds); return; } r -= 256;
    if (r < 192) { const int kt = r / 24, nt = r % 24; transpose_tile(win, INW, kt * 128, 3632 + nt * 64, 64, wtin, 1024, 3840 + nt * 64, lds); return; } r -= 192;
    if (r < 384) { const int kt = r / 48, nt = r % 48; transpose_tile(win, INW, kt * 128, 5168 + nt * 64, 64, wtin, 1024, 5376 + nt * 64, lds); return; } r -= 384;
    if (r < 192) { const int j = r / 64, q = r % 64, kt = q / 16, nt = q % 16;
        transpose_tile(P.in[I_WBR] + ((size_t)l * 3 + j) * 512 * 1024, 1024, kt * 128, nt * 64, 64, (bf16_t*)(ws_l(P) + WS_WTBR), 512, j * 1024 + nt * 64, lds); return; } r -= 192;
    if (r < 128) { const int kt = r / 16, nt = r % 16; transpose_tile(P.in[I_WO] + (size_t)l * D * D, 1024, kt * 128, nt * 64, 64, (bf16_t*)(ws_l(P) + WS_WTO), 1024, nt * 64, lds); return; } r -= 128;
    if (r < 512) { const int kt = r / 64, nt = r % 64; transpose_tile(P.in[I_WUP] + (size_t)l * D * FF, 4096, kt * 128, nt * 64, 64, (bf16_t*)(ws_l(P) + WS_WTUP), 1024, nt * 64, lds); return; } r -= 512;
    { const int kt = r / 16, nt = r % 16; transpose_tile(P.in[I_WDN] + (size_t)l * FF * D, 1024, kt * 128, nt * 64, 64, (bf16_t*)(ws_l(P) + WS_WTDN), 4096, nt * 64, lds); }
}
__device__ __forceinline__ void convert_all(const Params& P, int l, char* lds) {
    const int VG = vgrid(), slot = bid_l();
    static_assert(CONV_TILES % 2 == 0, "both halves of a workgroup must be active together");
    for (int i0 = 0; i0 < CONV_TILES; i0 += VG) { const int it = i0 + slot; if (it >= CONV_TILES) continue; convert_tile(P, l, it, lds); }
}

__device__ __forceinline__ void norm_phase(const Params& P, XPtr X, const float* g, int l, int sidx, int nrows) {
    const int lane = tid_l() & 63; const int gw = bid_l() * 4 + (tid_l() >> 6), ngw = vgrid() * 4;
    bf16_t* hb = (bf16_t*)(ws_l(P) + WS_HBUF);
    const float* mods = (const float*)(ws_l(P) + WS_MODS) + (size_t)l * 3 * 6144;
    for (int r = gw; r < nrows; r += 2 * ngw) {
        const int r1 = r + ngw; const bool has1 = r1 < nrows; const int rr1 = has1 ? r1 : r;
        const f32x4* xa = (const f32x4*)xrow(X, r); const f32x4* xb = (const f32x4*)xrow(X, rr1);
        f32x4 va[4], vb[4]; float sa_ = 0.f, sb_ = 0.f;
#pragma unroll
        for (int j = 0; j < 4; ++j) { va[j] = xa[lane + 64 * j]; vb[j] = xb[lane + 64 * j]; }
#pragma unroll
        for (int j = 0; j < 4; ++j) { sa_ += va[j].x * va[j].x + va[j].y * va[j].y + va[j].z * va[j].z + va[j].w * va[j].w; sb_ += vb[j].x * vb[j].x + vb[j].y * vb[j].y + vb[j].z * vb[j].z + vb[j].w * vb[j].w; }
        sa_ = wave_sum(sa_); sb_ = wave_sum(sb_);
        const float rsa = rsqrtf(sa_ * (1.f / 1024.f) + 1e-6f), rsb = rsqrtf(sb_ * (1.f / 1024.f) + 1e-6f);
        const float* mda = mods + modidx(r) * 6144; const float* mdb = mods + modidx(rr1) * 6144;
#pragma unroll
        for (int j = 0; j < 4; ++j) {
            const int col = (lane + 64 * j) * 4;
            const f32x4 gg = *(const f32x4*)(g + col);
            { const f32x4 sh = *(const f32x4*)(mda + sidx * 1024 + col), sc = *(const f32x4*)(mda + (sidx + 1) * 1024 + col);
              const f32x4 hh = va[j] * rsa * gg * (sc + 1.f) + sh; u32x2 o; o.x = cvt_pk(hh.x, hh.y); o.y = cvt_pk(hh.z, hh.w); *(u32x2*)(hb + (size_t)r * 1024 + col) = o; }
            if (has1) { const f32x4 sh = *(const f32x4*)(mdb + sidx * 1024 + col), sc = *(const f32x4*)(mdb + (sidx + 1) * 1024 + col);
              const f32x4 hh = vb[j] * rsb * gg * (sc + 1.f) + sh; u32x2 o; o.x = cvt_pk(hh.x, hh.y); o.y = cvt_pk(hh.z, hh.w); *(u32x2*)(hb + (size_t)r1 * 1024 + col) = o; }
        }
    }
}
__device__ __forceinline__ void final_norm_phase(const Params& P) {
    const int lane = tid_l() & 63; const int gw = bid_l() * 4 + (tid_l() >> 6), ngw = vgrid() * 4;
    const float* g = P.in[I_FG];
    for (int r = gw; r < RL; r += 2 * ngw) {
        const int r1 = r + ngw;
        f32x4* xa = (f32x4*)(P.out + (size_t)r * D); f32x4* xb = (f32x4*)(P.out + (size_t)r1 * D);
        f32x4 va[4], vb[4]; float sa_ = 0.f, sb_ = 0.f;
#pragma unroll
        for (int j = 0; j < 4; ++j) { va[j] = xa[lane + 64 * j]; vb[j] = xb[lane + 64 * j]; }
#pragma unroll
        for (int j = 0; j < 4; ++j) { sa_ += va[j].x * va[j].x + va[j].y * va[j].y + va[j].z * va[j].z + va[j].w * va[j].w; sb_ += vb[j].x * vb[j].x + vb[j].y * vb[j].y + vb[j].z * vb[j].z + vb[j].w * vb[j].w; }
        sa_ = wave_sum(sa_); sb_ = wave_sum(sb_);
        const float rsa = rsqrtf(sa_ * (1.f / 1024.f) + 1e-6f), rsb = rsqrtf(sb_ * (1.f / 1024.f) + 1e-6f);
#pragma unroll
        for (int j = 0; j < 4; ++j) { const f32x4 gg = *(const f32x4*)(g + (lane + 64 * j) * 4); xa[lane + 64 * j] = va[j] * rsa * gg; xb[lane + 64 * j] = vb[j] * rsb * gg; }
    }
}

struct EpiP {
    bf16_t* Pb; int pitch; int nmain; float* small;
    __device__ __forceinline__ void operator()(int r, int c, const f32x4& v, int) const {
        if (c < nmain) { u32x2 o; o.x = cvt_pk(v.x, v.y); o.y = cvt_pk(v.z, v.w); *(u32x2*)(Pb + (size_t)r * pitch + c) = o; }
        else { const int cc = c - nmain; if (cc < 48) *(f32x4*)(small + (size_t)r * 48 + cc) = v; }
    }
    __device__ __forceinline__ void w8(int r, int c, const f32x4& v0, const f32x4& v1, int) const {
        if (c < nmain) { u32x4 o; o.x = cvt_pk(v0.x, v0.y); o.y = cvt_pk(v0.z, v0.w); o.z = cvt_pk(v1.x, v1.y); o.w = cvt_pk(v1.z, v1.w); *(u32x4*)(Pb + (size_t)r * pitch + c) = o; }
        else { const int cc = c - nmain; if (cc < 48) { *(f32x4*)(small + (size_t)r * 48 + cc) = v0; *(f32x4*)(small + (size_t)r * 48 + cc + 4) = v1; } }
    }
};
struct EpiSig {
    bf16_t* O;
    __device__ __forceinline__ void operator()(int r, int c, const f32x4& v, int) const {
        u32x2 o; o.x = cvt_pk(sigmf(v.x), sigmf(v.y)); o.y = cvt_pk(sigmf(v.z), sigmf(v.w)); *(u32x2*)(O + (size_t)r * 3072 + c) = o;
    }
    __device__ __forceinline__ void w8(int r, int c, const f32x4& v0, const f32x4& v1, int) const {
        u32x4 o; o.x = cvt_pk(sigmf(v0.x), sigmf(v0.y)); o.y = cvt_pk(sigmf(v0.z), sigmf(v0.w)); o.z = cvt_pk(sigmf(v1.x), sigmf(v1.y)); o.w = cvt_pk(sigmf(v1.z), sigmf(v1.w));
        *(u32x4*)(O + (size_t)r * 3072 + c) = o;
    }
};
struct EpiRelu2 {
    bf16_t* O;
    __device__ __forceinline__ void operator()(int r, int c, const f32x4& v, int) const {
        const float a = fmaxf(v.x, 0.f), b = fmaxf(v.y, 0.f), cc = fmaxf(v.z, 0.f), d = fmaxf(v.w, 0.f);
        u32x2 o; o.x = cvt_pk(a * a, b * b); o.y = cvt_pk(cc * cc, d * d); *(u32x2*)(O + (size_t)r * 4096 + c) = o;
    }
    __device__ __forceinline__ void w8(int r, int c, const f32x4& v0, const f32x4& v1, int) const {
        const float a = fmaxf(v0.x, 0.f), b = fmaxf(v0.y, 0.f), cc = fmaxf(v0.z, 0.f), d = fmaxf(v0.w, 0.f), e = fmaxf(v1.x, 0.f), f = fmaxf(v1.y, 0.f), g = fmaxf(v1.z, 0.f), h = fmaxf(v1.w, 0.f);
        u32x4 o; o.x = cvt_pk(a * a, b * b); o.y = cvt_pk(cc * cc, d * d); o.z = cvt_pk(e * e, f * f); o.w = cvt_pk(g * g, h * h); *(u32x4*)(O + (size_t)r * 4096 + c) = o;
    }
};
struct EpiRes {
    XPtr Xold, Xnew; const float* mods_l; int gidx;
    __device__ __forceinline__ void operator()(int r, int c, const f32x4& v, int) const {
        const f32x4 g = *(const f32x4*)(mods_l + modidx(r) * 6144 + gidx * 1024 + c);
        const f32x4 xo = *(const f32x4*)(xrow(Xold, r) + c);
        *(f32x4*)(xrow(Xnew, r) + c) = xo + g * v;
    }
    __device__ __forceinline__ void w8(int r, int c, const f32x4& v0, const f32x4& v1, int) const {
        const float* gp = mods_l + modidx(r) * 6144 + gidx * 1024 + c; const float* xo = xrow(Xold, r) + c; float* xn = xrow(Xnew, r) + c;
        const f32x4 g0 = *(const f32x4*)gp, g1 = *(const f32x4*)(gp + 4), x0 = *(const f32x4*)xo, x1 = *(const f32x4*)(xo + 4);
        *(f32x4*)xn = x0 + g0 * v0; *(f32x4*)(xn + 4) = x1 + g1 * v1;
    }
};
struct EpiMerge {
    const bf16_t* gs; bf16_t* mb;
    __device__ __forceinline__ void operator()(int r, int c, const f32x4& v, int j) const {
        const u32x2 g = *(const u32x2*)(gs + (size_t)r * 3072 + j * 1024 + c);
        float a0 = v.x * bflo(g.x), a1 = v.y * bfhi(g.x), a2 = v.z * bflo(g.y), a3 = v.w * bfhi(g.y);
        u32x2* mp = (u32x2*)(mb + (size_t)r * 1024 + c);
        if (j > 0) { const u32x2 o = *mp; a0 += bflo(o.x); a1 += bfhi(o.x); a2 += bflo(o.y); a3 += bfhi(o.y); }
        u32x2 w; w.x = cvt_pk(a0, a1); w.y = cvt_pk(a2, a3); *mp = w;
    }
    __device__ __forceinline__ void w8(int r, int c, const f32x4& v0, const f32x4& v1, int j) const {
        const u32x4 g = *(const u32x4*)(gs + (size_t)r * 3072 + j * 1024 + c);
        float a0 = v0.x * bflo(g.x), a1 = v0.y * bfhi(g.x), a2 = v0.z * bflo(g.y), a3 = v0.w * bfhi(g.y), a4 = v1.x * bflo(g.z), a5 = v1.y * bfhi(g.z), a6 = v1.z * bflo(g.w), a7 = v1.w * bfhi(g.w);
        u32x4* mp = (u32x4*)(mb + (size_t)r * 1024 + c);
        if (j > 0) { const u32x4 o = *mp; a0 += bflo(o.x); a1 += bfhi(o.x); a2 += bflo(o.y); a3 += bfhi(o.y); a4 += bflo(o.z); a5 += bfhi(o.z); a6 += bflo(o.w); a7 += bfhi(o.w); }
        u32x4 w; w.x = cvt_pk(a0, a1); w.y = cvt_pk(a2, a3); w.z = cvt_pk(a4, a5); w.w = cvt_pk(a6, a7); *mp = w;
    }
};

namespace pg8 {
constexpr int BM = 256, BK = 64, HALF = 128, HTB = HALF * BK * 2, STAGE_BYTES = 8 * HTB, NXCD = 8, WGM = 2;
__device__ __forceinline__ int lds_byte(int r, int c) { const int st = (r >> 4) * 2 + (c >> 5), rr = r & 15, cc = c & 31, ob = rr * 64 + cc * 2; return st * 1024 + (ob ^ (((ob >> 9) & 1) << 5)); }
__device__ __forceinline__ int perm32(int rho) { const int n = rho >> 4, i = rho & 15; return 8 * (i >> 2) + 4 * n + (i & 3); }
__device__ __forceinline__ void stage_rc(int b, int& R_, int& C_) { const int st = b / 1024, sb = b % 1024, swz = sb ^ (((sb >> 9) & 1) << 5); R_ = (st >> 1) * 16 + swz / 64; C_ = (st & 1) * 32 + (swz % 64) / 2; }
struct Unit { int pm, pn, acol, brow, j; };
struct Gemm { const bf16_t* A; const bf16_t* Bt; int lda, K; };
struct StaticOrder {
    int nM, nN, nwg, G, c;
    __device__ void init(int M, int N, int G_, int c_) { nM = M / BM; nN = N / BM; nwg = nM * nN; G = G_; c = c_; }
    __device__ __forceinline__ bool tile(long L, int& pm, int& pn) const {
        if (L >= nwg) return false;
        int wgid = (int)L; { const int q = nwg / NXCD, r = nwg % NXCD, xcd = wgid % NXCD, off = wgid / NXCD; wgid = (xcd < r ? xcd * (q + 1) : r * (q + 1) + (xcd - r) * q) + off; }
        const int nig = WGM * nN, gid = wgid / nig, fm = gid * WGM, gsz = (nM - fm) < WGM ? (nM - fm) : WGM;
        pm = fm + ((wgid % nig) % gsz); pn = (wgid % nig) / gsz; return true;
    }
    __device__ __forceinline__ bool next(int i, Unit& u) const { if (!tile((long)i * G + c, u.pm, u.pn)) return false; u.acol = 0; u.brow = u.pn; u.j = 0; return true; }
};
struct MergeOrder {
    StaticOrder S;
    __device__ __forceinline__ bool next(int i, Unit& u) const { const int j = i % 3; if (!S.tile((long)(i / 3) * S.G + S.c, u.pm, u.pn)) return false; u.acol = j * 512; u.brow = j * 4 + u.pn; u.j = j; return true; }
};
template <class F> struct Epi {
    F f;
    __device__ __forceinline__ void operator()(const f32x4 (&acc)[2][2][4][2], const Unit& u, int wr, int wc, int fr, int fq) const {
#pragma unroll
        for (int ai = 0; ai < 2; ++ai)
#pragma unroll
            for (int m = 0; m < 4; ++m)
#pragma unroll
                for (int bj = 0; bj < 2; ++bj)
                    f.w8(u.pm * BM + ai * HALF + wr * 64 + m * 16 + fr, u.pn * BM + bj * HALF + wc * 32 + 8 * fq, acc[ai][bj][m][0], acc[ai][bj][m][1], u.j);
    }
};

template <class E_, class Sched>
__device__ __forceinline__ void gemm_phase(LAS unsigned char* lds, const Gemm g, const Sched& S, const E_& E) {
    int tid_ = threadIdx.x; asm volatile("" : "+v"(tid_));
    const int tid = tid_, wid = __builtin_amdgcn_readfirstlane(tid >> 6), lane = tid & 63, wr = wid >> 2, wc = wid & 3, fr = lane & 15, fq = lane >> 4;
    const int K = g.K, nt = K / BK;
    unsigned voffA[2], voffB[2];
#pragma unroll
    for (int i = 0; i < 2; ++i) { int R_, C_; stage_rc(tid * 16 + i * 8192, R_, C_); const int Rb = (R_ & ~31) + perm32(R_ & 31); voffA[i] = (unsigned)(R_ * g.lda + C_) * 2u; voffB[i] = (unsigned)(Rb * K + C_) * 2u; }
    const size_t kstep = (size_t)(BK * 2);
    const size_t hstepA = (size_t)HALF * g.lda * 2, hstepB = (size_t)HALF * K * 2;
    const unsigned ldsw = (unsigned)wid * 1024u;
    const int aoff = lds_byte(wr * 64 + fr, fq * 8), boff = lds_byte(wc * 32 + fr, fq * 8);
#define PG8_SA(b, h) (((b) * 2 + (h)) * HTB)
#define PG8_SB(b, h) ((4 + (b) * 2 + (h)) * HTB)
#define PG8_STAGE(bufoff, gbase, voff) do { _Pragma("unroll") for (int _i = 0; _i < 2; ++_i) \
        __builtin_amdgcn_global_load_lds((const unsigned*)((const char*)(gbase) + (voff)[_i]), (LAS unsigned*)(lds + (bufoff) + ldsw + _i * 8192), 16, 0, 0); } while (0)
#define PG8_LDA(dst, b, h) do { _Pragma("unroll") for (int m = 0; m < 4; ++m) _Pragma("unroll") for (int k = 0; k < 2; ++k) dst[m][k] = *(const LAS bf16x8*)(lds + PG8_SA(b, h) + aoff + m * 2048 + k * 1024); } while (0)
#define PG8_LDB(dst, b, h) do { _Pragma("unroll") for (int n = 0; n < 2; ++n) _Pragma("unroll") for (int k = 0; k < 2; ++k) dst[n][k] = *(const LAS bf16x8*)(lds + PG8_SB(b, h) + boff + n * 2048 + k * 1024); } while (0)
#define PG8_MMA(ai, bj, At, Bt) do { __builtin_amdgcn_s_setprio(1); _Pragma("unroll") for (int m = 0; m < 4; ++m) _Pragma("unroll") for (int n = 0; n < 2; ++n) _Pragma("unroll") for (int k = 0; k < 2; ++k) \
        acc[ai][bj][m][n] = __builtin_amdgcn_mfma_f32_16x16x32_bf16(Bt[n][k], At[m][k], acc[ai][bj][m][n], 0, 0, 0); __builtin_amdgcn_s_setprio(0); } while (0)
#define PG8_WAIT_V(n) asm volatile("s_waitcnt vmcnt(" #n ")" ::: "memory")
#define PG8_WAIT_L(n) asm volatile("s_waitcnt lgkmcnt(" #n ")" ::: "memory")
#define PG8_BAR __builtin_amdgcn_s_barrier()
#define PG8_SCHED __builtin_amdgcn_sched_barrier(0)
#define PG8_UA(u) ((const char*)g.A + ((size_t)(u).pm * BM * g.lda + (u).acol) * 2)
#define PG8_UB(u) ((const char*)g.Bt + (size_t)(u).brow * BM * K * 2)
    Unit cur, nxt; int ui = 0;
    if (!S.next(0, cur)) return;
    f32x4 acc[2][2][4][2];
#pragma unroll
    for (int a = 0; a < 2; ++a)
#pragma unroll
        for (int b = 0; b < 2; ++b)
#pragma unroll
            for (int m = 0; m < 4; ++m)
#pragma unroll
                for (int n = 0; n < 2; ++n) acc[a][b][m][n] = (f32x4){0.f, 0.f, 0.f, 0.f};
    bf16x8 At[4][2], B0[2][2], B1[2][2];
    const char* cA = PG8_UA(cur); const char* cB = PG8_UB(cur);
    PG8_STAGE(PG8_SB(0, 0), cB, voffB); PG8_STAGE(PG8_SB(0, 1), cB + hstepB, voffB); PG8_STAGE(PG8_SA(0, 0), cA, voffA); PG8_STAGE(PG8_SA(0, 1), cA + hstepA, voffA);
    if (wr == 1) PG8_BAR;
    PG8_WAIT_V(2); PG8_BAR;
    PG8_STAGE(PG8_SB(1, 0), cB + kstep, voffB); PG8_STAGE(PG8_SA(1, 0), cA + kstep, voffA); PG8_STAGE(PG8_SB(1, 1), cB + hstepB + kstep, voffB);
    PG8_WAIT_V(6); PG8_BAR;
    for (;;) {
        const bool has_next = S.next(ui + 1, nxt);
        const char* nA = has_next ? PG8_UA(nxt) : cA; const char* nB = has_next ? PG8_UB(nxt) : cB;
        for (int t = 0; t < nt; t += 2) {
            const bool last = (t == nt - 2);
            const char* a1 = cA + (size_t)(t + 1) * kstep;
            const char* a2 = last ? nA : cA + (size_t)(t + 2) * kstep; const char* b2 = last ? nB : cB + (size_t)(t + 2) * kstep;
            const char* a3 = a2 + kstep; const char* b3 = b2 + kstep;
            PG8_LDB(B0, 0, 0); PG8_LDB(B1, 0, 1); PG8_SCHED; PG8_LDA(At, 0, 0); PG8_STAGE(PG8_SA(1, 1), a1 + hstepA, voffA);
            PG8_WAIT_V(8); PG8_WAIT_L(0); PG8_BAR; PG8_MMA(0, 0, At, B0); PG8_MMA(0, 1, At, B1); PG8_BAR; PG8_SCHED;
            PG8_LDA(At, 0, 1); PG8_STAGE(PG8_SB(0, 0), b2, voffB); PG8_STAGE(PG8_SB(0, 1), b2 + hstepB, voffB); PG8_STAGE(PG8_SA(0, 0), a2, voffA);
            PG8_WAIT_V(8); PG8_WAIT_L(0); PG8_BAR; PG8_MMA(1, 0, At, B0); PG8_MMA(1, 1, At, B1); PG8_BAR; PG8_SCHED;
            PG8_LDB(B0, 1, 0); PG8_LDB(B1, 1, 1); PG8_SCHED; PG8_LDA(At, 1, 0); PG8_STAGE(PG8_SA(0, 1), a2 + hstepA, voffA);
            PG8_WAIT_V(8); PG8_WAIT_L(0); PG8_BAR; PG8_MMA(0, 0, At, B0); PG8_MMA(0, 1, At, B1); PG8_BAR; PG8_SCHED;
            PG8_LDA(At, 1, 1); PG8_STAGE(PG8_SB(1, 0), b3, voffB); PG8_STAGE(PG8_SB(1, 1), b3 + hstepB, voffB); PG8_STAGE(PG8_SA(1, 0), a3, voffA);
            PG8_WAIT_V(8); PG8_WAIT_L(0); PG8_BAR; PG8_MMA(1, 0, At, B0); PG8_MMA(1, 1, At, B1); PG8_BAR; PG8_SCHED;
        }
        if (wr == 0) PG8_BAR;
        E(acc, cur, wr, wc, fr, fq);
        if (!has_next) break;
#pragma unroll
        for (int a = 0; a < 2; ++a)
#pragma unroll
            for (int b = 0; b < 2; ++b)
#pragma unroll
                for (int m = 0; m < 4; ++m)
#pragma unroll
                    for (int n = 0; n < 2; ++n) acc[a][b][m][n] = (f32x4){0.f, 0.f, 0.f, 0.f};
        cur = nxt; cA = nA; cB = nB; ++ui;
        if (wr == 1) PG8_BAR;
    }
    PG8_WAIT_V(0);
    PG8_BAR;
#undef PG8_SA
#undef PG8_SB
#undef PG8_STAGE
#undef PG8_LDA
#undef PG8_LDB
#undef PG8_MMA
#undef PG8_WAIT_V
#undef PG8_WAIT_L
#undef PG8_BAR
#undef PG8_SCHED
#undef PG8_UA
#undef PG8_UB
}
}

template <class F>
__device__ __forceinline__ void big_gemm(LAS unsigned char* ldsb, const bf16_t* A, int lda, const bf16_t* Bt, int K, int N, const F& f) {
    pg8::Gemm g{A, Bt, lda, K}; pg8::StaticOrder S; S.init(RL, N, (int)gridDim.x, (int)blockIdx.x);
    pg8::Epi<F> E{f};
    pg8::gemm_phase(ldsb, g, S, E);
    __syncthreads();
}
template <int NI>
__device__ __forceinline__ void gemm_kloop(f32x4 (&acc)[4][NI], const bf16_t* Ag, int lda, const bf16_t* Bg, int ldb, int K, char* lds) {
    const int tid = tid_l(), lane = tid & 63, wid = tid >> 6, wm = wid >> 1, wn = wid & 1, lr = lane & 15, lq = lane >> 4;
    u32x4 ra[4], rb[NI];
    const int prow = tid >> 3, pkc = tid & 7;
    const bf16_t* ap = Ag + (size_t)prow * lda + pkc * 8;
    const bf16_t* bp = Bg + (size_t)prow * ldb + pkc * 8;
    const int soff = prow * 128 + ((pkc ^ (prow & 7)) << 4);
#pragma unroll
    for (int i = 0; i < 4; ++i) { ra[i] = *(const u32x4*)(ap + (size_t)(32 * i) * lda); if (i < NI) rb[i < NI ? i : 0] = *(const u32x4*)(bp + (size_t)(32 * i) * ldb); }
#pragma unroll
    for (int i = 0; i < 4; ++i) { *(u32x4*)(lds + soff + i * 4096) = ra[i]; if (i < NI) *(u32x4*)(lds + 32768 + soff + i * 4096) = rb[i < NI ? i : 0]; }
    __syncthreads();
    const int nk = K >> 6;
    for (int kt = 0; kt < nk; ++kt) {
        const int buf = kt & 1;
        if (kt + 1 < nk) {
#pragma unroll
            for (int i = 0; i < 4; ++i) { ra[i] = *(const u32x4*)(ap + (size_t)(32 * i) * lda + (kt + 1) * 64); if (i < NI) rb[i < NI ? i : 0] = *(const u32x4*)(bp + (size_t)(32 * i) * ldb + (kt + 1) * 64); }
        }
        const char* la = lds + buf * 16384; const char* lb = lds + 32768 + buf * 16384;
#pragma unroll
        for (int kk = 0; kk < 2; ++kk) {
            bf16x8 af[4], bfr[NI];
            const int chunk = kk * 4 + lq;
#pragma unroll
            for (int mi = 0; mi < 4; ++mi) { const int row = wm * 64 + mi * 16 + lr; af[mi] = *(const bf16x8*)(la + row * 128 + ((chunk ^ (row & 7)) << 4)); }
#pragma unroll
            for (int ni = 0; ni < NI; ++ni) { const int row = wn * (16 * NI) + ni * 16 + lr; bfr[ni] = *(const bf16x8*)(lb + row * 128 + ((chunk ^ (row & 7)) << 4)); }
#pragma unroll
            for (int mi = 0; mi < 4; ++mi)
#pragma unroll
                for (int ni = 0; ni < NI; ++ni) acc[mi][ni] = __builtin_amdgcn_mfma_f32_16x16x32_bf16(bfr[ni], af[mi], acc[mi][ni], 0, 0, 0);
        }
        if (kt + 1 < nk) {
            char* sa = lds + (buf ^ 1) * 16384 + soff;
#pragma unroll
            for (int i = 0; i < 4; ++i) { *(u32x4*)(sa + i * 4096) = ra[i]; if (i < NI) *(u32x4*)(sa + 32768 + i * 4096) = rb[i < NI ? i : 0]; }
        }
        __syncthreads();
    }
}

__device__ __forceinline__ void tile_of(int t, int Mt, int Nt, int& tm, int& tn) {
    const int per = 8 * Nt; const int p = t / per; const int r = t - p * per; const int pm = (Mt - 8 * p) < 8 ? (Mt - 8 * p) : 8;
    tm = 8 * p + r % pm; tn = r / pm;
}

template <int TYPE> struct MX {
    static constexpr int DK = TYPE == 1 ? 128 : 64;
    static constexpr int NOC = DK / 8;
    static constexpr int PITCH = TYPE == 1 ? 2048 : 1536;
    static constexpr int QOFF = 0;
    static constexpr int KOFF = TYPE == 1 ? 512 : 256;
    static constexpr int VOFF = TYPE == 1 ? 1024 : 512;
    static constexpr int GOFF = TYPE == 1 ? 1536 : 1024;
    static constexpr int QP = DK + 16;
};
constexpr int L_VT = 0;
constexpr int L_Q = 20480;
constexpr int L_CUM = 40960;
constexpr int L_ATT = 57344;
constexpr int L_SC = 67584;
constexpr int L_SA = 68096;

template <int TYPE>
__device__ __forceinline__ void load_qk8(const Params& P, int l, const bf16_t* pb, int b, int c, int t, int h, int oc, bool isk, float (&f)[8]) {
    typedef MX<TYPE> M;
    const int coff = (isk ? M::KOFF : M::QOFF) + h * M::DK;
    const size_t rowi = (size_t)(rowbase(b, c) + t);
    if (TYPE == 0) {
        const u32x4 u = *(const u32x4*)(pb + rowi * M::PITCH + coff + oc * 8); UNPACK8(u, f);
    } else if (TYPE == 1) {
        const bool hp = (t > 0) || (c != 0 && c != 4), hn = (t < 63) || (c != 3 && c != NCH - 1);
        const bf16_t* p0 = pb + rowi * M::PITCH + coff + oc * 8;
        u32x4 u1 = *(const u32x4*)p0, u0 = (u32x4){0u, 0u, 0u, 0u}, u2 = (u32x4){0u, 0u, 0u, 0u};
        if (hp) u0 = *(const u32x4*)(p0 - M::PITCH);
        if (hn) u2 = *(const u32x4*)(p0 + M::PITCH);
        float a[8], m[8], n[8]; UNPACK8(u0, a); UNPACK8(u1, m); UNPACK8(u2, n);
        const float* cw = P.in[I_CONV] + (size_t)l * 3 * 1024 + (isk ? 512 : 0) + h * 128 + oc * 8;
        const f32x4 w0a = *(const f32x4*)cw, w0b = *(const f32x4*)(cw + 4), w1a = *(const f32x4*)(cw + 1024), w1b = *(const f32x4*)(cw + 1028), w2a = *(const f32x4*)(cw + 2048), w2b = *(const f32x4*)(cw + 2052);
        const float w0[8] = {w0a.x, w0a.y, w0a.z, w0a.w, w0b.x, w0b.y, w0b.z, w0b.w};
        const float w1[8] = {w1a.x, w1a.y, w1a.z, w1a.w, w1b.x, w1b.y, w1b.z, w1b.w};
        const float w2[8] = {w2a.x, w2a.y, w2a.z, w2a.w, w2b.x, w2b.y, w2b.z, w2b.w};
#pragma unroll
        for (int j = 0; j < 8; ++j) f[j] = siluf(w0[j] * a[j] + w1[j] * m[j] + w2[j] * n[j]);
    } else {
        if (c < 4) { const u32x4 u = *(const u32x4*)(pb + rowi * M::PITCH + coff + oc * 8); UNPACK8(u, f); }
        else {
            const int o4 = oc & 3;
            const u32x4 ua = *(const u32x4*)(pb + rowi * M::PITCH + coff + o4 * 8), ub = *(const u32x4*)(pb + rowi * M::PITCH + coff + 32 + o4 * 8);
            float x1[8], x2[8]; UNPACK8(ua, x1); UNPACK8(ub, x2);
            const float* tab = (const float*)(ws_l(P) + WS_ROPE);
            const float* cs = o4 < 2 ? tab + (c - 4) * 16 + o4 * 8 : tab + 4096 + t * 16 + (o4 - 2) * 8;
            const float* sn = o4 < 2 ? tab + 2048 + (c - 4) * 16 + o4 * 8 : tab + 4096 + 1024 + t * 16 + (o4 - 2) * 8;
            const f32x4 ca = *(const f32x4*)cs, cb = *(const f32x4*)(cs + 4), sa = *(const f32x4*)sn, sb = *(const f32x4*)(sn + 4);
            const float cv[8] = {ca.x, ca.y, ca.z, ca.w, cb.x, cb.y, cb.z, cb.w}, sv[8] = {sa.x, sa.y, sa.z, sa.w, sb.x, sb.y, sb.z, sb.w};
#pragma unroll
            for (int j = 0; j < 8; ++j) f[j] = oc < 4 ? x1[j] * cv[j] - x2[j] * sv[j] : x1[j] * sv[j] + x2[j] * cv[j];
        }
    }
}

template <int TYPE>
__device__ __forceinline__ void decay_setup(const Params& P, int l, int b, int c, int h, int dir, char* lds, const float* apre = nullptr) {
    const int tid = tid_l(); const int r0 = rowbase(b, c);
    float* sc = (float*)(lds + L_SC);
    const float* small = (const float*)(ws_l(P) + WS_SMALL);
    if (TYPE == 0) {
        float* cum = (float*)(lds + L_CUM); float* sa = (float*)(lds + L_SA);
        if (apre) {
#pragma unroll
            for (int k = 0; k < 4; ++k) sa[tid + k * NTHR] = apre[k];
        } else {
            for (int i = tid; i < 1024; i += NTHR) sa[i] = small[(size_t)(r0 + (i >> 4)) * 48 + dir * 16 + (i & 15)];
        }
        __syncthreads();
        const int d = tid & 63, tq = tid >> 6;
        const float* a2 = P.in[I_A2] + ((size_t)(l * 2 + dir) * 16) * 256 + h * 64 + d;
        float w[16];
#pragma unroll
        for (int rr = 0; rr < 16; ++rr) w[rr] = a2[rr * 256];
        const float bias = P.in[I_ABIAS][(l * 2 + dir) * 256 + h * 64 + d];
        float* blk = sa;
        float lv[16];
#pragma unroll
        for (int i = 0; i < 16; ++i) {
            const int t = tq * 16 + i;
            float z = bias;
#pragma unroll
            for (int rr = 0; rr < 16; ++rr) z += sa[t * 16 + rr] * w[rr];
            lv[i] = logsig(z) * (1.f / 16.f);
        }
        if (dir == 0) {
#pragma unroll
            for (int i = 1; i < 16; ++i) lv[i] += lv[i - 1];
        } else {
#pragma unroll
            for (int i = 14; i >= 0; --i) lv[i] += lv[i + 1];
        }
        __syncthreads();
        blk[tq * 64 + d] = dir == 0 ? lv[15] : lv[0];
        __syncthreads();
        float off = 0.f;
#pragma unroll
        for (int q = 0; q < 4; ++q) if (dir == 0 ? (q < tq) : (q > tq)) off += blk[q * 64 + d];
#pragma unroll
        for (int i = 0; i < 16; ++i) cum[(tq * 16 + i) * 64 + d] = lv[i] + off;
    } else if (TYPE == 1) {
        if (tid < 64) {
            const float fg = small[(size_t)(r0 + tid) * 48 + 40 + dir * 4 + h] + P.in[I_FB][l * 8 + dir * 4 + h];
            float v = logsig(fg);
            if (dir == 0) {
#pragma unroll
                for (int o = 1; o < 64; o <<= 1) { const float n = __shfl_up(v, o); if (tid >= o) v += n; }
            } else {
#pragma unroll
                for (int o = 1; o < 64; o <<= 1) { const float n = __shfl_down(v, o); if (tid + o < 64) v += n; }
            }
            const float tot = __shfl(v, dir == 0 ? 63 : 0);
            sc[tid] = v;
            sc[64 + tid] = small[(size_t)(r0 + tid) * 48 + 32 + dir * 4 + h] + P.in[I_IB][l * 8 + dir * 4 + h];
            if (tid == 0) sc[128] = tot;
        }
    } else {
        if (tid < 64) {
            const float lg = logsig(P.in[I_RDL][l * 8 + dir * 4 + h]);
            sc[tid] = (dir == 0 ? (float)(tid + 1) : (float)(64 - tid)) * lg;
            if (tid == 0) sc[128] = 64.f * lg;
        }
    }
    __syncthreads();
}

template <int TYPE>
__device__ __forceinline__ void build_vT(const bf16_t* pb, int b, int c, int h, char* lds) {
    typedef MX<TYPE> M;
    bf16_t* vT = (bf16_t*)(lds + L_VT);
#pragma unroll
    for (int i = 0; i < 2; ++i) {
        const int pid = tid_l() + i * NTHR, tp = pid & 31, oc = pid >> 5;
        const bf16_t* p0 = pb + (size_t)(rowbase(b, c) + 2 * tp) * M::PITCH + M::VOFF + h * 128 + oc * 8;
        const u32x4 u0 = *(const u32x4*)p0, u1 = *(const u32x4*)(p0 + M::PITCH);
        unsigned* dst = (unsigned*)(vT + (size_t)(oc * 8) * 80 + 2 * tp);
        dst[0 * 40] = (u0.x & 0xffffu) | (u1.x << 16); dst[1 * 40] = (u0.x >> 16) | (u1.x & 0xffff0000u);
        dst[2 * 40] = (u0.y & 0xffffu) | (u1.y << 16); dst[3 * 40] = (u0.y >> 16) | (u1.y & 0xffff0000u);
        dst[4 * 40] = (u0.z & 0xffffu) | (u1.z << 16); dst[5 * 40] = (u0.z >> 16) | (u1.z & 0xffff0000u);
        dst[6 * 40] = (u0.w & 0xffffu) | (u1.w << 16); dst[7 * 40] = (u0.w >> 16) | (u1.w & 0xffff0000u);
    }
}

__device__ __forceinline__ int scan_index(int dir, int c) { return dir == 0 ? c : (c < 4 ? 3 - c : 135 - c); }

template <int TYPE>
__device__ __forceinline__ void u_phase(const Params& P, int l, char* lds) {
    typedef MX<TYPE> M; constexpr int DK = M::DK;
    const int tid = tid_l(), lane = tid & 63, wid = tid >> 6, lr = lane & 15, lq = lane >> 4;
    const bf16_t* pb = (const bf16_t*)(ws_l(P) + WS_PBUF);
    bf16_t* U = (bf16_t*)(ws_l(P) + WS_SBUF); float* DEC = (float*)(ws_l(P) + WS_DEC); float* UN = (float*)(ws_l(P) + WS_UN);
    bf16_t* vT = (bf16_t*)(lds + L_VT); bf16_t* kT = (bf16_t*)(lds + L_Q);
    const float* cum = (const float*)(lds + L_CUM); const float* sc = (const float*)(lds + L_SC);
    const int NU = NB * 4 * 2 * NCH, VG = vgrid(), slot = bid_l();
    for (int u0 = 0; u0 < NU; u0 += VG) {
        int unit = u0 + slot; if (unit >= NU) unit = NU - 1;
        const int c = unit % NCH; const int rest = unit / NCH; const int dir = rest & 1, h = (rest >> 1) & 3, b = rest >> 3;
        const int chain = (b * 4 + h) * 2 + dir, n = scan_index(dir, c);
        static_assert(TYPE == 0, "the scalar-decay branches use u_phase_s");
        float k0[8], k1[8], apre[4];
        { const int tp = tid & 31, oc = tid >> 5;
          load_qk8<TYPE>(P, l, pb, b, c, 2 * tp, h, oc, true, k0);
          load_qk8<TYPE>(P, l, pb, b, c, 2 * tp + 1, h, oc, true, k1);
          const float* small = (const float*)(ws_l(P) + WS_SMALL); const int r0 = rowbase(b, c);
#pragma unroll
          for (int k = 0; k < 4; ++k) { const int i = tid + k * NTHR; apre[k] = small[(size_t)(r0 + (i >> 4)) * 48 + dir * 16 + (i & 15)]; } }
        build_vT<TYPE>(pb, b, c, h, lds);
        decay_setup<TYPE>(P, l, b, c, h, dir, lds, apre);
        const int tlast = dir == 0 ? 63 : 0;
        {
            const int pid = tid, tp = pid & 31, oc = pid >> 5;
            unsigned* dst = (unsigned*)(kT + (size_t)(oc * 8) * 80 + 2 * tp);
            if (TYPE == 0) {
#pragma unroll
                for (int j = 0; j < 8; ++j) { const int d = oc * 8 + j; const float tot = cum[tlast * 64 + d];
                    dst[j * 40] = cvt_pk(k0[j] * __expf(tot - cum[(2 * tp) * 64 + d]), k1[j] * __expf(tot - cum[(2 * tp + 1) * 64 + d])); }
            } else {
                const float tot = sc[128];
                const float w0 = TYPE == 1 ? __expf(tot - sc[2 * tp] + sc[64 + 2 * tp]) * 0.08838834764831845f : __expf(tot - sc[2 * tp]) * 0.125f;
                const float w1 = TYPE == 1 ? __expf(tot - sc[2 * tp + 1] + sc[64 + 2 * tp + 1]) * 0.08838834764831845f : __expf(tot - sc[2 * tp + 1]) * 0.125f;
#pragma unroll
                for (int j = 0; j < 8; ++j) dst[j * 40] = cvt_pk(k0[j] * w0, k1[j] * w1);
            }
        }
        __syncthreads();
        f32x4 acc[2][DK / 16];
#pragma unroll
        for (int i = 0; i < 2; ++i)
#pragma unroll
            for (int nt = 0; nt < DK / 16; ++nt) acc[i][nt] = (f32x4){0.f, 0.f, 0.f, 0.f};
#pragma unroll
        for (int kk = 0; kk < 2; ++kk) {
            bf16x8 fv[2];
#pragma unroll
            for (int i = 0; i < 2; ++i) fv[i] = *(const bf16x8*)(vT + (size_t)((2 * wid + i) * 16 + lr) * 80 + kk * 32 + lq * 8);
#pragma unroll
            for (int nt = 0; nt < DK / 16; ++nt) {
                const bf16x8 fk = *(const bf16x8*)(kT + (size_t)(nt * 16 + lr) * 80 + kk * 32 + lq * 8);
#pragma unroll
                for (int i = 0; i < 2; ++i) acc[i][nt] = __builtin_amdgcn_mfma_f32_16x16x32_bf16(fk, fv[i], acc[i][nt], 0, 0, 0);
            }
        }
        bf16_t* ub = U + (size_t)(chain * NCH + n) * 128 * DK;
#pragma unroll
        for (int i = 0; i < 2; ++i)
#pragma unroll
            for (int nt = 0; nt < DK / 16; ++nt) {
                const int e = (2 * wid + i) * 16 + lr, d = nt * 16 + lq * 4;
                u32x2 o; o.x = cvt_pk(acc[i][nt].x, acc[i][nt].y); o.y = cvt_pk(acc[i][nt].z, acc[i][nt].w);
                *(u32x2*)(ub + (size_t)e * DK + d) = o;
            }
        if (tid < DK) {
            const float tot = TYPE == 0 ? cum[tlast * 64 + (tid & 63)] : sc[128];
            DEC[(size_t)(chain * NCH + n) * 128 + tid] = __expf(tot);
            if (TYPE == 1) {
                float s = 0.f;
#pragma unroll
                for (int q = 0; q < 8; ++q) { const u32x4 u = *(const u32x4*)(kT + (size_t)tid * 80 + q * 8); float f[8]; UNPACK8(u, f);
#pragma unroll
                    for (int j = 0; j < 8; ++j) s += f[j]; }
                UN[(size_t)(chain * NCH + n) * 128 + tid] = s;
            }
        }
        __syncthreads();
    }
}

template <int TYPE>
__device__ __forceinline__ void u_phase_s(const Params& P, int l, char* lds) {
    typedef MX<TYPE> M; constexpr int DK = M::DK; constexpr int NIT = M::NOC * 32 / NTHR;
    const int tid = tid_l(), lane = tid & 63, wid = tid >> 6, lr = lane & 15, lq = lane >> 4;
    const bf16_t* pb = (const bf16_t*)(ws_l(P) + WS_PBUF);
    const float* small = (const float*)(ws_l(P) + WS_SMALL);
    bf16_t* U = (bf16_t*)(ws_l(P) + WS_SBUF); float* DEC = (float*)(ws_l(P) + WS_DEC); float* UN = (float*)(ws_l(P) + WS_UN);
    bf16_t* vT = (bf16_t*)(lds + L_VT); bf16_t* kT0 = (bf16_t*)(lds + 20480); bf16_t* kT1 = (bf16_t*)(lds + 40960);
    float* sc = (float*)(lds + L_SC);
    const int NU = NB * 4 * NCH, VG = vgrid(), slot = bid_l();
    for (int u0 = 0; u0 < NU; u0 += VG) {
        int unit = u0 + slot; int dmask = 3;
        if (VG == 512 && u0 >= 1024) { if (slot >= 2 * (NU - 1024)) continue; unit = 1024 + (slot >> 1); dmask = 1 << (slot & 1); }
        else if (unit >= NU) unit = NU - 1;
        const int c = unit % NCH; const int rest = unit / NCH; const int h = rest & 3, b = rest >> 2;
        const int r0 = rowbase(b, c);
        float kv[NIT][2][8];
#pragma unroll
        for (int i = 0; i < NIT; ++i) {
            const int pid = tid + i * NTHR, tp = pid & 31, oc = pid >> 5;
            load_qk8<TYPE>(P, l, pb, b, c, 2 * tp, h, oc, true, kv[i][0]);
            load_qk8<TYPE>(P, l, pb, b, c, 2 * tp + 1, h, oc, true, kv[i][1]);
        }
        if (TYPE == 1) {
            if (tid < 128) {
                const int dir = tid >> 6, t = tid & 63;
                const float fg = small[(size_t)(r0 + t) * 48 + 40 + dir * 4 + h] + P.in[I_FB][l * 8 + dir * 4 + h];
                float v = logsig(fg);
                if (dir == 0) {
#pragma unroll
                    for (int o = 1; o < 64; o <<= 1) { const float n = __shfl_up(v, o); if (t >= o) v += n; }
                } else {
#pragma unroll
                    for (int o = 1; o < 64; o <<= 1) { const float n = __shfl_down(v, o); if (t + o < 64) v += n; }
                }
                sc[dir * 64 + t] = v;
                sc[128 + dir * 64 + t] = small[(size_t)(r0 + t) * 48 + 32 + dir * 4 + h] + P.in[I_IB][l * 8 + dir * 4 + h];
            }
        } else {
            if (tid < 64) {
                const float lg0 = logsig(P.in[I_RDL][l * 8 + h]), lg1 = logsig(P.in[I_RDL][l * 8 + 4 + h]);
                sc[tid] = (float)(tid + 1) * lg0; sc[64 + tid] = (float)(64 - tid) * lg1;
            }
        }
        build_vT<TYPE>(pb, b, c, h, lds);
        __syncthreads();
        const float totf = sc[63], totb = sc[64];
        const float ks = TYPE == 1 ? 0.08838834764831845f : 0.125f;
#pragma unroll
        for (int i = 0; i < NIT; ++i) {
            const int pid = tid + i * NTHR, tp = pid & 31, oc = pid >> 5;
            const int t0 = 2 * tp, t1 = 2 * tp + 1;
            const float wf0 = __expf(totf - sc[t0] + (TYPE == 1 ? sc[128 + t0] : 0.f)) * ks, wf1 = __expf(totf - sc[t1] + (TYPE == 1 ? sc[128 + t1] : 0.f)) * ks;
            const float wb0 = __expf(totb - sc[64 + t0] + (TYPE == 1 ? sc[192 + t0] : 0.f)) * ks, wb1 = __expf(totb - sc[64 + t1] + (TYPE == 1 ? sc[192 + t1] : 0.f)) * ks;
            unsigned* d0 = (unsigned*)(kT0 + (size_t)(oc * 8) * 80 + 2 * tp); unsigned* d1 = (unsigned*)(kT1 + (size_t)(oc * 8) * 80 + 2 * tp);
#pragma unroll
            for (int j = 0; j < 8; ++j) { d0[j * 40] = cvt_pk(kv[i][0][j] * wf0, kv[i][1][j] * wf1); d1[j * 40] = cvt_pk(kv[i][0][j] * wb0, kv[i][1][j] * wb1); }
        }
        __syncthreads();
        const int chf = (b * 4 + h) * 2;
#pragma unroll 1
        for (int dir = 0; dir < 2; ++dir) {
            if (!((dmask >> dir) & 1)) continue;
            const bf16_t* kT = dir == 0 ? kT0 : kT1;
            const int n = scan_index(dir, c);
            f32x4 acc[2][DK / 16];
#pragma unroll
            for (int i = 0; i < 2; ++i)
#pragma unroll
                for (int nt = 0; nt < DK / 16; ++nt) acc[i][nt] = (f32x4){0.f, 0.f, 0.f, 0.f};
#pragma unroll
            for (int kk = 0; kk < 2; ++kk) {
                bf16x8 fv[2];
#pragma unroll
                for (int i = 0; i < 2; ++i) fv[i] = *(const bf16x8*)(vT + (size_t)((2 * wid + i) * 16 + lr) * 80 + kk * 32 + lq * 8);
#pragma unroll
                for (int nt = 0; nt < DK / 16; ++nt) {
                    const bf16x8 fk = *(const bf16x8*)(kT + (size_t)(nt * 16 + lr) * 80 + kk * 32 + lq * 8);
#pragma unroll
                    for (int i = 0; i < 2; ++i) acc[i][nt] = __builtin_amdgcn_mfma_f32_16x16x32_bf16(fk, fv[i], acc[i][nt], 0, 0, 0);
                }
            }
            bf16_t* ub = U + (size_t)((chf + dir) * NCH + n) * 128 * DK;
#pragma unroll
            for (int i = 0; i < 2; ++i)
#pragma unroll
                for (int nt = 0; nt < DK / 16; ++nt) {
                    const int e = (2 * wid + i) * 16 + lr, d = nt * 16 + lq * 4;
                    u32x2 o; o.x = cvt_pk(acc[i][nt].x, acc[i][nt].y); o.y = cvt_pk(acc[i][nt].z, acc[i][nt].w);
                    *(u32x2*)(ub + (size_t)e * DK + d) = o;
                }
        }
        if (tid < 2 * DK) {
            const int dir = tid / DK, d = tid % DK; const int n = scan_index(dir, c);
            if ((dmask >> dir) & 1) {
            DEC[(size_t)((chf + dir) * NCH + n) * 128 + d] = __expf(dir == 0 ? totf : totb);
            if (TYPE == 1) {
                const bf16_t* kT = dir == 0 ? kT0 : kT1;
                float sum = 0.f;
#pragma unroll
                for (int q = 0; q < 8; ++q) { const u32x4 u = *(const u32x4*)(kT + (size_t)d * 80 + q * 8); float f[8]; UNPACK8(u, f);
#pragma unroll
                    for (int j = 0; j < 8; ++j) sum += f[j]; }
                UN[(size_t)((chf + dir) * NCH + n) * 128 + d] = sum;
            }
            }
        }
        __syncthreads();
    }
}

template <int DK, bool HASN>
__device__ __forceinline__ void scan_phase(const Params& P) {
    bf16_t* U = (bf16_t*)(ws_l(P) + WS_SBUF); const float* DEC = (const float*)(ws_l(P) + WS_DEC); float* UN = (float*)(ws_l(P) + WS_UN);
    constexpr int VEC = DK / 64;
    constexpr int DQ = DK / VEC; constexpr int TT = 16 * 128 * DQ;
    constexpr size_t US = (size_t)128 * DK;
    for (int g = bid_l() * NTHR + tid_l(); g < TT; g += vgrid() * NTHR) {
        const int dq = g % DQ, e = (g / DQ) % 128, chain = g / (DQ * 128);
        bf16_t* up = U + ((size_t)chain * NCH * 128 + e) * DK + dq * VEC;
        const float* dp = DEC + (size_t)chain * NCH * 128 + dq * VEC;
        float S0 = 0.f, S1 = 0.f;
        constexpr int SB = 12;
        unsigned ua[SB], ubv[SB]; f32x2 da[SB], db[SB];
#define SC_LOAD(uu, dd, n0) do { _Pragma("unroll") for (int j = 0; j < SB; ++j) { \
            if (VEC == 2) { uu[j] = *(const unsigned*)(up + (size_t)((n0) + j) * US); dd[j] = *(const f32x2*)(dp + (size_t)((n0) + j) * 128); } \
            else { uu[j] = (unsigned)up[(size_t)((n0) + j) * US]; dd[j].x = dp[(size_t)((n0) + j) * 128]; dd[j].y = 0.f; } } } while (0)
#define SC_STEP(uu, dd, n0) do { _Pragma("unroll") for (int j = 0; j < SB; ++j) { \
            if (VEC == 2) { *(unsigned*)(up + (size_t)((n0) + j) * US) = cvt_pk(S0, S1); S0 = dd[j].x * S0 + bflo(uu[j]); S1 = dd[j].y * S1 + bfhi(uu[j]); } \
            else { up[(size_t)((n0) + j) * US] = (bf16_t)(cvt_pk(S0, 0.f) & 0xffffu); S0 = dd[j].x * S0 + bflo(uu[j]); } } } while (0)
        SC_LOAD(ua, da, 0);
        for (int n0 = 0; n0 < 120; n0 += 24) {
            SC_LOAD(ubv, db, n0 + 12);
            SC_STEP(ua, da, n0);
            SC_LOAD(ua, da, n0 + 24);
            SC_STEP(ubv, db, n0 + 12);
        }
        SC_STEP(ua, da, 120);
#undef SC_LOAD
#undef SC_STEP
    }
    if (HASN) {
        for (int g = bid_l() * NTHR + tid_l(); g < 16 * 128; g += vgrid() * NTHR) {
            const int d = g & 127, chain = g >> 7;
            float* np = UN + (size_t)chain * NCH * 128 + d; const float* dp = DEC + (size_t)chain * NCH * 128 + d;
            float S = 0.f;
            float ua_[12], da_[12], ub_[12], db_[12];
#define NS_LOAD(uu, dd, n0) do { _Pragma("unroll") for (int j = 0; j < 12; ++j) { uu[j] = np[(size_t)((n0) + j) * 128]; dd[j] = dp[(size_t)((n0) + j) * 128]; } } while (0)
#define NS_STEP(uu, dd, n0) do { _Pragma("unroll") for (int j = 0; j < 12; ++j) { np[(size_t)((n0) + j) * 128] = S; S = dd[j] * S + uu[j]; } } while (0)
            NS_LOAD(ua_, da_, 0);
            for (int n0 = 0; n0 < 120; n0 += 24) {
                NS_LOAD(ub_, db_, n0 + 12);
                NS_STEP(ua_, da_, n0);
                NS_LOAD(ua_, da_, n0 + 24);
                NS_STEP(ub_, db_, n0 + 12);
            }
            NS_STEP(ua_, da_, 120);
#undef NS_LOAD
#undef NS_STEP
        }
    }
}

template <int TYPE>
__device__ __forceinline__ void out_phase(const Params& P, int l, int pass, bool latent_only, char* lds) {
    typedef MX<TYPE> M; constexpr int DK = M::DK; constexpr int QP = M::QP;
    const int tid = tid_l(), lane = tid & 63, wid = tid >> 6, lr = lane & 15, lq = lane >> 4;
    const bf16_t* pb = (const bf16_t*)(ws_l(P) + WS_PBUF);
    const bf16_t* U = (const bf16_t*)(ws_l(P) + WS_SBUF); const float* UN = (const float*)(ws_l(P) + WS_UN);
    bf16_t* brp = (bf16_t*)(ws_l(P) + WS_BR);
    bf16_t* vT = (bf16_t*)(lds + L_VT); bf16_t* qin = (bf16_t*)(lds + L_Q); bf16_t* kin = qin + 64 * QP; bf16_t* att = (bf16_t*)(lds + L_ATT);
    const float* cum = (const float*)(lds + L_CUM); const float* sc = (const float*)(lds + L_SC);
    const float* ng = P.in[TYPE == 0 ? I_GNG : (TYPE == 1 ? I_MNG : I_RNG)] + l * 512;
    const int NC = latent_only ? NCH - 4 : NCH; const int NU = NB * 4 * NC, VG = vgrid(), slot = bid_l();
    for (int u0 = 0; u0 < NU; u0 += VG) {
        int unit = u0 + slot; if (unit >= NU) unit = NU - 1;
        const int c = unit % NC + (latent_only ? 4 : 0); const int rest = unit / NC; const int h = rest & 3, b = rest >> 2;
        const int r0 = rowbase(b, c);
        build_vT<TYPE>(pb, b, c, h, lds);
        f32x4 tot[8];
#pragma unroll
        for (int et = 0; et < 8; ++et) tot[et] = (f32x4){0.f, 0.f, 0.f, 0.f};
        const int trow = wid * 16 + lr;
        for (int dir = 0; dir < 2; ++dir) {
            const int chain = (b * 4 + h) * 2 + dir, n = scan_index(dir, c);
            decay_setup<TYPE>(P, l, b, c, h, dir, lds);
#pragma unroll 2
            for (int i = 0; i < 64 * M::NOC / NTHR; ++i) {
                const int pid = tid + i * NTHR, t = pid / M::NOC, oc = pid % M::NOC;
                float q8[8], k8[8];
                load_qk8<TYPE>(P, l, pb, b, c, t, h, oc, false, q8);
                load_qk8<TYPE>(P, l, pb, b, c, t, h, oc, true, k8);
                if (TYPE == 0) {
#pragma unroll
                    for (int j = 0; j < 8; ++j) { const float cv = cum[t * 64 + oc * 8 + j]; q8[j] *= __expf(cv) * 0.125f; k8[j] *= __expf(-cv); }
                } else {
                    const float cv = sc[t];
                    const float wq = __expf(cv);
                    const float wk = TYPE == 1 ? __expf(sc[64 + t] - cv) * 0.08838834764831845f : __expf(-cv) * 0.125f;
#pragma unroll
                    for (int j = 0; j < 8; ++j) { q8[j] *= wq; k8[j] *= wk; }
                }
                u32x4 oq, ok;
                oq.x = cvt_pk(q8[0], q8[1]); oq.y = cvt_pk(q8[2], q8[3]); oq.z = cvt_pk(q8[4], q8[5]); oq.w = cvt_pk(q8[6], q8[7]);
                ok.x = cvt_pk(k8[0], k8[1]); ok.y = cvt_pk(k8[2], k8[3]); ok.z = cvt_pk(k8[4], k8[5]); ok.w = cvt_pk(k8[6], k8[7]);
                *(u32x4*)(qin + (size_t)t * QP + oc * 8) = oq;
                *(u32x4*)(kin + (size_t)t * QP + oc * 8) = ok;
            }
            __syncthreads();
            f32x4 sacc[4];
#pragma unroll
            for (int nt = 0; nt < 4; ++nt) sacc[nt] = (f32x4){0.f, 0.f, 0.f, 0.f};
#pragma unroll
            for (int kk = 0; kk < DK / 32; ++kk) {
                const bf16x8 fq = *(const bf16x8*)(qin + (size_t)trow * QP + kk * 32 + lq * 8);
#pragma unroll
                for (int nt = 0; nt < 4; ++nt) {
                    const bf16x8 fk = *(const bf16x8*)(kin + (size_t)(nt * 16 + lr) * QP + kk * 32 + lq * 8);
                    sacc[nt] = __builtin_amdgcn_mfma_f32_16x16x32_bf16(fk, fq, sacc[nt], 0, 0, 0);
                }
            }
            float den = 0.f;
#pragma unroll
            for (int nt = 0; nt < 4; ++nt) {
                const int s0 = nt * 16 + lq * 4;
                float a0 = sacc[nt].x, a1 = sacc[nt].y, a2 = sacc[nt].z, a3 = sacc[nt].w;
                if (dir == 0) { if (s0 + 0 > trow) a0 = 0.f; if (s0 + 1 > trow) a1 = 0.f; if (s0 + 2 > trow) a2 = 0.f; if (s0 + 3 > trow) a3 = 0.f; }
                else { if (s0 + 0 < trow) a0 = 0.f; if (s0 + 1 < trow) a1 = 0.f; if (s0 + 2 < trow) a2 = 0.f; if (s0 + 3 < trow) a3 = 0.f; }
                den += (a0 + a1) + (a2 + a3);
                u32x2 o; o.x = cvt_pk(a0, a1); o.y = cvt_pk(a2, a3);
                *(u32x2*)(att + (size_t)trow * 80 + s0) = o;
            }
            __syncthreads();
            f32x4 oacc[8];
#pragma unroll
            for (int et = 0; et < 8; ++et) oacc[et] = (f32x4){0.f, 0.f, 0.f, 0.f};
#pragma unroll
            for (int kk = 0; kk < 2; ++kk) {
                const bf16x8 fa = *(const bf16x8*)(att + (size_t)trow * 80 + kk * 32 + lq * 8);
#pragma unroll
                for (int et = 0; et < 8; ++et) {
                    const bf16x8 fv = *(const bf16x8*)(vT + (size_t)(et * 16 + lr) * 80 + kk * 32 + lq * 8);
                    oacc[et] = __builtin_amdgcn_mfma_f32_16x16x32_bf16(fv, fa, oacc[et], 0, 0, 0);
                }
            }
            const bf16_t* sp = U + (size_t)(chain * NCH + n) * 128 * DK;
#pragma unroll
            for (int kk = 0; kk < DK / 32; ++kk) {
                const bf16x8 fq = *(const bf16x8*)(qin + (size_t)trow * QP + kk * 32 + lq * 8);
#pragma unroll
                for (int et = 0; et < 8; ++et) {
                    const bf16x8 fs = *(const bf16x8*)(sp + (size_t)(et * 16 + lr) * DK + kk * 32 + lq * 8);
                    oacc[et] = __builtin_amdgcn_mfma_f32_16x16x32_bf16(fs, fq, oacc[et], 0, 0, 0);
                }
            }
            if (TYPE == 1) {
                const float* np = UN + (size_t)(chain * NCH + n) * 128 + lq * 32;
#pragma unroll
                for (int q = 0; q < 4; ++q) {
                    const u32x4 u = *(const u32x4*)(qin + (size_t)trow * QP + lq * 32 + q * 8); float f[8]; UNPACK8(u, f);
                    const f32x4 n0 = *(const f32x4*)(np + q * 8), n1 = *(const f32x4*)(np + q * 8 + 4);
                    den += f[0] * n0.x + f[1] * n0.y + f[2] * n0.z + f[3] * n0.w + f[4] * n1.x + f[5] * n1.y + f[6] * n1.z + f[7] * n1.w;
                }
                den += __shfl_xor(den, 16); den += __shfl_xor(den, 32);
                const float sc1 = 1.f / fmaxf(fabsf(den), 1.f);
#pragma unroll
                for (int et = 0; et < 8; ++et) tot[et] += oacc[et] * sc1;
            } else {
#pragma unroll
                for (int et = 0; et < 8; ++et) tot[et] += oacc[et];
            }
            __syncthreads();
        }
        float s1 = 0.f;
#pragma unroll
        for (int et = 0; et < 8; ++et) s1 += (tot[et].x + tot[et].y) + (tot[et].z + tot[et].w);
        s1 += __shfl_xor(s1, 16); s1 += __shfl_xor(s1, 32);
        const float mean = TYPE == 0 ? 0.f : s1 * (1.f / 128.f);
        float s2 = 0.f;
#pragma unroll
        for (int et = 0; et < 8; ++et) { tot[et] = tot[et] - mean; s2 += (tot[et].x * tot[et].x + tot[et].y * tot[et].y) + (tot[et].z * tot[et].z + tot[et].w * tot[et].w); }
        s2 += __shfl_xor(s2, 16); s2 += __shfl_xor(s2, 32);
        const float rstd = rsqrtf(s2 * (1.f / 128.f) + 1e-6f);
        const size_t rowi = (size_t)(r0 + trow);
#pragma unroll
        for (int et = 0; et < 8; ++et) {
            const int e = et * 16 + lq * 4;
            const f32x4 gg = *(const f32x4*)(ng + h * 128 + e);
            const u32x2 gu = *(const u32x2*)(pb + rowi * M::PITCH + M::GOFF + h * 128 + e);
            const float g0 = bflo(gu.x), g1 = bfhi(gu.x), g2 = bflo(gu.y), g3 = bfhi(gu.y);
            u32x2 o;
            float y0 = tot[et].x * rstd * gg.x * siluf(g0), y1 = tot[et].y * rstd * gg.y * siluf(g1), y2 = tot[et].z * rstd * gg.z * siluf(g2), y3 = tot[et].w * rstd * gg.w * siluf(g3);
            o.x = cvt_pk(y0, y1); o.y = cvt_pk(y2, y3);
            *(u32x2*)(brp + rowi * 1536 + pass * 512 + h * 128 + e) = o;
        }
        __syncthreads();
    }
}

template <int TYPE>
__device__ __forceinline__ void out_phase_s(const Params& P, int l, int pass, bool latent_only, char* lds) {
    typedef MX<TYPE> M; constexpr int DK = M::DK; constexpr int QP = M::QP; constexpr int NKK = DK / 32;
    const bf16_t* pb = (const bf16_t*)(ws_l(P) + WS_PBUF);
    const bf16_t* U = (const bf16_t*)(ws_l(P) + WS_SBUF); const float* UN = (const float*)(ws_l(P) + WS_UN);
    const float* small = (const float*)(ws_l(P) + WS_SMALL);
    bf16_t* brp = (bf16_t*)(ws_l(P) + WS_BR);
    bf16_t* vT = (bf16_t*)(lds + L_VT); bf16_t* qr = (bf16_t*)(lds + L_Q); bf16_t* kr = qr + 64 * QP; bf16_t* att = (bf16_t*)(lds + L_ATT);
    float* sc = (float*)(lds + L_SC);
    float* sn = sc + 256;
    float* rsv = sc + 512;
    float* part = sc + 640;
    const float* ng = P.in[TYPE == 1 ? I_MNG : I_RNG] + l * 512;
    const int NC = latent_only ? NCH - 4 : NCH; const int NU = NB * 4 * NC, VG = vgrid(), slot = bid_l();
    for (int u0 = 0; u0 < NU; u0 += VG) {
        int unit = u0 + slot; if (unit >= NU) unit = NU - 1;
        const int tid = tid_l(), lane = tid & 63, wid = tid >> 6, lr = lane & 15, lq = lane >> 4;
        const int c = unit % NC + (latent_only ? 4 : 0); const int rest = unit / NC; const int h = rest & 3, b = rest >> 2;
        const int r0 = rowbase(b, c);
        const int trow = wid * 16 + lr;
        const int chf = (b * 4 + h) * 2, nf = scan_index(0, c), nb = scan_index(1, c);
        const bf16_t* spf = U + (size_t)(chf * NCH + nf) * 128 * DK; const bf16_t* spb = U + (size_t)((chf + 1) * NCH + nb) * 128 * DK;
        bf16x8 fsf[2][NKK], fsb[2][NKK];
#pragma unroll
        for (int i = 0; i < 2; ++i)
#pragma unroll
            for (int kk = 0; kk < NKK; ++kk) {
                fsf[i][kk] = *(const bf16x8*)(spf + (size_t)((2 * wid + i) * 16 + lr) * DK + kk * 32 + lq * 8);
                fsb[i][kk] = *(const bf16x8*)(spb + (size_t)((2 * wid + i) * 16 + lr) * DK + kk * 32 + lq * 8);
            }
        u32x2 gu[4][2];
#pragma unroll
        for (int mt = 0; mt < 4; ++mt)
#pragma unroll
            for (int i = 0; i < 2; ++i) gu[mt][i] = *(const u32x2*)(pb + (size_t)(r0 + mt * 16 + lr) * M::PITCH + M::GOFF + h * 128 + (2 * wid + i) * 16 + lq * 4);
        if (TYPE == 1) {
            sn[tid] = UN[(size_t)((chf + (tid >> 7)) * NCH + ((tid >> 7) == 0 ? nf : nb)) * 128 + (tid & 127)];
            if (tid < 128) {
                const int dir = tid >> 6, t = tid & 63;
                const float fg = small[(size_t)(r0 + t) * 48 + 40 + dir * 4 + h] + P.in[I_FB][l * 8 + dir * 4 + h];
                float v = logsig(fg);
                if (dir == 0) {
#pragma unroll
                    for (int o = 1; o < 64; o <<= 1) { const float n = __shfl_up(v, o); if (t >= o) v += n; }
                } else {
#pragma unroll
                    for (int o = 1; o < 64; o <<= 1) { const float n = __shfl_down(v, o); if (t + o < 64) v += n; }
                }
                sc[dir * 64 + t] = v;
                sc[128 + dir * 64 + t] = small[(size_t)(r0 + t) * 48 + 32 + dir * 4 + h] + P.in[I_IB][l * 8 + dir * 4 + h];
            }
        } else {
            if (tid < 64) {
                const float lg0 = logsig(P.in[I_RDL][l * 8 + h]), lg1 = logsig(P.in[I_RDL][l * 8 + 4 + h]);
                sc[tid] = (float)(tid + 1) * lg0; sc[64 + tid] = (float)(64 - tid) * lg1;
            }
        }
        build_vT<TYPE>(pb, b, c, h, lds);
#pragma unroll
        for (int i = 0; i < 64 * M::NOC / NTHR; ++i) {
            const int pid = tid + i * NTHR, t = pid / M::NOC, oc = pid % M::NOC;
            float q8[8], k8[8];
            load_qk8<TYPE>(P, l, pb, b, c, t, h, oc, false, q8);
            load_qk8<TYPE>(P, l, pb, b, c, t, h, oc, true, k8);
            const float ks = TYPE == 1 ? 0.08838834764831845f : 0.125f;
            u32x4 oq, ok;
            oq.x = cvt_pk(q8[0], q8[1]); oq.y = cvt_pk(q8[2], q8[3]); oq.z = cvt_pk(q8[4], q8[5]); oq.w = cvt_pk(q8[6], q8[7]);
            ok.x = cvt_pk(k8[0] * ks, k8[1] * ks); ok.y = cvt_pk(k8[2] * ks, k8[3] * ks); ok.z = cvt_pk(k8[4] * ks, k8[5] * ks); ok.w = cvt_pk(k8[6] * ks, k8[7] * ks);
            *(u32x4*)(qr + (size_t)t * QP + oc * 8) = oq;
            *(u32x4*)(kr + (size_t)t * QP + oc * 8) = ok;
        }
        __syncthreads();
        f32x4 sacc[4];
#pragma unroll
        for (int nt = 0; nt < 4; ++nt) sacc[nt] = (f32x4){0.f, 0.f, 0.f, 0.f};
#pragma unroll
        for (int kk = 0; kk < NKK; ++kk) {
            const bf16x8 fq = *(const bf16x8*)(qr + (size_t)trow * QP + kk * 32 + lq * 8);
#pragma unroll
            for (int nt = 0; nt < 4; ++nt) {
                const bf16x8 fk = *(const bf16x8*)(kr + (size_t)(nt * 16 + lr) * QP + kk * 32 + lq * 8);
                sacc[nt] = __builtin_amdgcn_mfma_f32_16x16x32_bf16(fk, fq, sacc[nt], 0, 0, 0);
            }
        }
        {
            const float cft = sc[trow], cbt = sc[64 + trow];
            const float eft = __expf(cft), ebt = __expf(cbt);
            float af[4][4], ab[4][4]; float denf = 0.f, denb = 0.f;
#pragma unroll
            for (int nt = 0; nt < 4; ++nt) {
                const float av[4] = {sacc[nt].x, sacc[nt].y, sacc[nt].z, sacc[nt].w};
#pragma unroll
                for (int r = 0; r < 4; ++r) {
                    const int s_ = nt * 16 + lq * 4 + r;
                    const float argf = cft - sc[s_] + (TYPE == 1 ? sc[128 + s_] : 0.f), argb = cbt - sc[64 + s_] + (TYPE == 1 ? sc[192 + s_] : 0.f);
                    const float wf = s_ <= trow ? __expf(argf) : 0.f, wb = s_ >= trow ? __expf(argb) : 0.f;
                    af[nt][r] = av[r] * wf; ab[nt][r] = av[r] * wb; denf += af[nt][r]; denb += ab[nt][r];
                }
            }
            float scf = 1.f, scb = 1.f;
            if (TYPE == 1) {
                float qf = 0.f, qb = 0.f;
#pragma unroll
                for (int q = 0; q < 4; ++q) {
                    const u32x4 u = *(const u32x4*)(qr + (size_t)trow * QP + lq * 32 + q * 8); float f[8]; UNPACK8(u, f);
                    const float* a = sn + lq * 32 + q * 8; const float* bq = sn + 128 + lq * 32 + q * 8;
                    const f32x4 a0 = *(const f32x4*)a, a1 = *(const f32x4*)(a + 4), b0 = *(const f32x4*)bq, b1 = *(const f32x4*)(bq + 4);
                    qf += f[0] * a0.x + f[1] * a0.y + f[2] * a0.z + f[3] * a0.w + f[4] * a1.x + f[5] * a1.y + f[6] * a1.z + f[7] * a1.w;
                    qb += f[0] * b0.x + f[1] * b0.y + f[2] * b0.z + f[3] * b0.w + f[4] * b1.x + f[5] * b1.y + f[6] * b1.z + f[7] * b1.w;
                }
                denf += eft * qf; denb += ebt * qb;
                denf += __shfl_xor(denf, 16); denf += __shfl_xor(denf, 32);
                denb += __shfl_xor(denb, 16); denb += __shfl_xor(denb, 32);
                scf = 1.f / fmaxf(fabsf(denf), 1.f); scb = 1.f / fmaxf(fabsf(denb), 1.f);
            }
#pragma unroll
            for (int nt = 0; nt < 4; ++nt) {
                u32x2 o; o.x = cvt_pk(af[nt][0] * scf + ab[nt][0] * scb, af[nt][1] * scf + ab[nt][1] * scb); o.y = cvt_pk(af[nt][2] * scf + ab[nt][2] * scb, af[nt][3] * scf + ab[nt][3] * scb);
                *(u32x2*)(att + (size_t)trow * 80 + nt * 16 + lq * 4) = o;
            }
            if (lq == 0) { rsv[trow] = eft * scf; rsv[64 + trow] = ebt * scb; }
        }
        __syncthreads();
        f32x4 oacc[4][2];
#pragma unroll
        for (int mt = 0; mt < 4; ++mt)
#pragma unroll
            for (int i = 0; i < 2; ++i) oacc[mt][i] = (f32x4){0.f, 0.f, 0.f, 0.f};
#pragma unroll
        for (int kk = 0; kk < 2; ++kk) {
            bf16x8 fv[2];
#pragma unroll
            for (int i = 0; i < 2; ++i) fv[i] = *(const bf16x8*)(vT + (size_t)((2 * wid + i) * 16 + lr) * 80 + kk * 32 + lq * 8);
#pragma unroll
            for (int mt = 0; mt < 4; ++mt) {
                const bf16x8 fa = *(const bf16x8*)(att + (size_t)(mt * 16 + lr) * 80 + kk * 32 + lq * 8);
#pragma unroll
                for (int i = 0; i < 2; ++i) oacc[mt][i] = __builtin_amdgcn_mfma_f32_16x16x32_bf16(fv[i], fa, oacc[mt][i], 0, 0, 0);
            }
        }
#pragma unroll
        for (int dir = 0; dir < 2; ++dir) {
            f32x4 tmp[4][2];
#pragma unroll
            for (int mt = 0; mt < 4; ++mt)
#pragma unroll
                for (int i = 0; i < 2; ++i) tmp[mt][i] = (f32x4){0.f, 0.f, 0.f, 0.f};
#pragma unroll
            for (int kk = 0; kk < NKK; ++kk)
#pragma unroll
                for (int mt = 0; mt < 4; ++mt) {
                    const bf16x8 fq = *(const bf16x8*)(qr + (size_t)(mt * 16 + lr) * QP + kk * 32 + lq * 8);
#pragma unroll
                    for (int i = 0; i < 2; ++i) tmp[mt][i] = __builtin_amdgcn_mfma_f32_16x16x32_bf16(dir == 0 ? fsf[i][kk] : fsb[i][kk], fq, tmp[mt][i], 0, 0, 0);
                }
#pragma unroll
            for (int mt = 0; mt < 4; ++mt) {
                const float rs = rsv[dir * 64 + mt * 16 + lr];
#pragma unroll
                for (int i = 0; i < 2; ++i) oacc[mt][i] += tmp[mt][i] * rs;
            }
        }
#pragma unroll
        for (int mt = 0; mt < 4; ++mt) {
            float s1 = (oacc[mt][0].x + oacc[mt][0].y) + (oacc[mt][0].z + oacc[mt][0].w) + (oacc[mt][1].x + oacc[mt][1].y) + (oacc[mt][1].z + oacc[mt][1].w);
            float s2 = (oacc[mt][0].x * oacc[mt][0].x + oacc[mt][0].y * oacc[mt][0].y) + (oacc[mt][0].z * oacc[mt][0].z + oacc[mt][0].w * oacc[mt][0].w)
                     + (oacc[mt][1].x * oacc[mt][1].x + oacc[mt][1].y * oacc[mt][1].y) + (oacc[mt][1].z * oacc[mt][1].z + oacc[mt][1].w * oacc[mt][1].w);
            s1 += __shfl_xor(s1, 16); s1 += __shfl_xor(s1, 32); s2 += __shfl_xor(s2, 16); s2 += __shfl_xor(s2, 32);
            if (lq == 0) { part[(wid * 64 + mt * 16 + lr) * 2] = s1; part[(wid * 64 + mt * 16 + lr) * 2 + 1] = s2; }
        }
        __syncthreads();
#pragma unroll
        for (int mt = 0; mt < 4; ++mt) {
            const int t = mt * 16 + lr;
            float s1 = 0.f, s2 = 0.f;
#pragma unroll
            for (int w = 0; w < 4; ++w) { s1 += part[(w * 64 + t) * 2]; s2 += part[(w * 64 + t) * 2 + 1]; }
            const float mean = s1 * (1.f / 128.f);
            const float rstd = rsqrtf(fmaxf(s2 * (1.f / 128.f) - mean * mean, 0.f) + 1e-6f);
            const size_t rowi = (size_t)(r0 + t);
#pragma unroll
            for (int i = 0; i < 2; ++i) {
                const int e = (2 * wid + i) * 16 + lq * 4;
                const f32x4 gg = *(const f32x4*)(ng + h * 128 + e);
                const float g0 = bflo(gu[mt][i].x), g1 = bfhi(gu[mt][i].x), g2 = bflo(gu[mt][i].y), g3 = bfhi(gu[mt][i].y);
                u32x2 o;
                o.x = cvt_pk((oacc[mt][i].x - mean) * rstd * gg.x * siluf(g0), (oacc[mt][i].y - mean) * rstd * gg.y * siluf(g1));
                o.y = cvt_pk((oacc[mt][i].z - mean) * rstd * gg.z * siluf(g2), (oacc[mt][i].w - mean) * rstd * gg.w * siluf(g3));
                *(u32x2*)(brp + rowi * 1536 + pass * 512 + h * 128 + e) = o;
            }
        }
        __syncthreads();
    }
}

__device__ __forceinline__ void out_phase_g(const Params& P, int l, bool latent_only, char* lds) {
    typedef MX<0> M; constexpr int DK = 64, QP = 80;
    const bf16_t* pb = (const bf16_t*)(ws_l(P) + WS_PBUF);
    const bf16_t* U = (const bf16_t*)(ws_l(P) + WS_SBUF);
    const float* small = (const float*)(ws_l(P) + WS_SMALL);
    bf16_t* brp = (bf16_t*)(ws_l(P) + WS_BR);
    bf16_t* vT = (bf16_t*)(lds + L_VT); bf16_t* qin = (bf16_t*)(lds + L_Q); bf16_t* kin = qin + 64 * QP; bf16_t* att = (bf16_t*)(lds + L_ATT);
    float* cum = (float*)(lds + L_CUM); float* part = cum;
    const float* ng = P.in[I_GNG] + l * 512;
    const int NC = latent_only ? NCH - 4 : NCH; const int NU = NB * 4 * NC, VG = vgrid(), slot = bid_l();
    for (int u0 = 0; u0 < NU; u0 += VG) {
        int unit = u0 + slot; if (unit >= NU) unit = NU - 1;
        const int tid = tid_l(), lane = tid & 63, wid = tid >> 6, lr = lane & 15, lq = lane >> 4;
        const int c = unit % NC + (latent_only ? 4 : 0); const int rest = unit / NC; const int h = rest & 3, b = rest >> 2;
        const int r0 = rowbase(b, c);
        const int trow = wid * 16 + lr;
        const int chf = (b * 4 + h) * 2, nf = scan_index(0, c), nb = scan_index(1, c);
        const bf16_t* spf = U + (size_t)(chf * NCH + nf) * 128 * DK; const bf16_t* spb = U + (size_t)((chf + 1) * NCH + nb) * 128 * DK;
        bf16x8 fsf[2][2], fsb[2][2];
#pragma unroll
        for (int i = 0; i < 2; ++i)
#pragma unroll
            for (int kk = 0; kk < 2; ++kk) {
                fsf[i][kk] = *(const bf16x8*)(spf + (size_t)((2 * wid + i) * 16 + lr) * DK + kk * 32 + lq * 8);
                fsb[i][kk] = *(const bf16x8*)(spb + (size_t)((2 * wid + i) * 16 + lr) * DK + kk * 32 + lq * 8);
            }
        u32x2 gu[4][2];
#pragma unroll
        for (int mt = 0; mt < 4; ++mt)
#pragma unroll
            for (int i = 0; i < 2; ++i) gu[mt][i] = *(const u32x2*)(pb + (size_t)(r0 + mt * 16 + lr) * M::PITCH + M::GOFF + h * 128 + (2 * wid + i) * 16 + lq * 4);
        float qraw[2][8], kraw[2][8], apre[2][4];
#pragma unroll
        for (int i = 0; i < 2; ++i) {
            const int pid = tid + i * NTHR, t = pid >> 3, oc = pid & 7;
            load_qk8<0>(P, l, pb, b, c, t, h, oc, false, qraw[i]);
            load_qk8<0>(P, l, pb, b, c, t, h, oc, true, kraw[i]);
        }
#pragma unroll
        for (int dir = 0; dir < 2; ++dir)
#pragma unroll
            for (int k = 0; k < 4; ++k) { const int i = tid + k * NTHR; apre[dir][k] = small[(size_t)(r0 + (i >> 4)) * 48 + dir * 16 + (i & 15)]; }
        build_vT<0>(pb, b, c, h, lds);
        f32x4 oacc[4][2];
#pragma unroll
        for (int mt = 0; mt < 4; ++mt)
#pragma unroll
            for (int i = 0; i < 2; ++i) oacc[mt][i] = (f32x4){0.f, 0.f, 0.f, 0.f};
#pragma unroll
        for (int dir = 0; dir < 2; ++dir) {
            decay_setup<0>(P, l, b, c, h, dir, lds, apre[dir]);
#pragma unroll
            for (int i = 0; i < 2; ++i) {
                const int pid = tid + i * NTHR, t = pid >> 3, oc = pid & 7;
                float q8[8], k8[8];
#pragma unroll
                for (int j = 0; j < 8; ++j) { const float cv = cum[t * 64 + oc * 8 + j]; q8[j] = qraw[i][j] * (__expf(cv) * 0.125f); k8[j] = kraw[i][j] * __expf(-cv); }
                u32x4 oq, ok;
                oq.x = cvt_pk(q8[0], q8[1]); oq.y = cvt_pk(q8[2], q8[3]); oq.z = cvt_pk(q8[4], q8[5]); oq.w = cvt_pk(q8[6], q8[7]);
                ok.x = cvt_pk(k8[0], k8[1]); ok.y = cvt_pk(k8[2], k8[3]); ok.z = cvt_pk(k8[4], k8[5]); ok.w = cvt_pk(k8[6], k8[7]);
                *(u32x4*)(qin + (size_t)t * QP + oc * 8) = oq;
                *(u32x4*)(kin + (size_t)t * QP + oc * 8) = ok;
            }
            __syncthreads();
            f32x4 sacc[4];
#pragma unroll
            for (int nt = 0; nt < 4; ++nt) sacc[nt] = (f32x4){0.f, 0.f, 0.f, 0.f};
#pragma unroll
            for (int kk = 0; kk < 2; ++kk) {
                const bf16x8 fq = *(const bf16x8*)(qin + (size_t)trow * QP + kk * 32 + lq * 8);
#pragma unroll
                for (int nt = 0; nt < 4; ++nt) {
                    const bf16x8 fk = *(const bf16x8*)(kin + (size_t)(nt * 16 + lr) * QP + kk * 32 + lq * 8);
                    sacc[nt] = __builtin_amdgcn_mfma_f32_16x16x32_bf16(fk, fq, sacc[nt], 0, 0, 0);
                }
            }
#pragma unroll
            for (int nt = 0; nt < 4; ++nt) {
                const int s0 = nt * 16 + lq * 4;
                float a0 = sacc[nt].x, a1 = sacc[nt].y, a2 = sacc[nt].z, a3 = sacc[nt].w;
                if (dir == 0) { if (s0 + 0 > trow) a0 = 0.f; if (s0 + 1 > trow) a1 = 0.f; if (s0 + 2 > trow) a2 = 0.f; if (s0 + 3 > trow) a3 = 0.f; }
                else { if (s0 + 0 < trow) a0 = 0.f; if (s0 + 1 < trow) a1 = 0.f; if (s0 + 2 < trow) a2 = 0.f; if (s0 + 3 < trow) a3 = 0.f; }
                u32x2 o; o.x = cvt_pk(a0, a1); o.y = cvt_pk(a2, a3);
                *(u32x2*)(att + (size_t)trow * 80 + s0) = o;
            }
            __syncthreads();
#pragma unroll
            for (int kk = 0; kk < 2; ++kk) {
                bf16x8 fv[2];
#pragma unroll
                for (int i = 0; i < 2; ++i) fv[i] = *(const bf16x8*)(vT + (size_t)((2 * wid + i) * 16 + lr) * 80 + kk * 32 + lq * 8);
#pragma unroll
                for (int mt = 0; mt < 4; ++mt) {
                    const bf16x8 fa = *(const bf16x8*)(att + (size_t)(mt * 16 + lr) * 80 + kk * 32 + lq * 8);
                    const bf16x8 fq = *(const bf16x8*)(qin + (size_t)(mt * 16 + lr) * QP + kk * 32 + lq * 8);
#pragma unroll
                    for (int i = 0; i < 2; ++i) {
                        oacc[mt][i] = __builtin_amdgcn_mfma_f32_16x16x32_bf16(fv[i], fa, oacc[mt][i], 0, 0, 0);
                        oacc[mt][i] = __builtin_amdgcn_mfma_f32_16x16x32_bf16(dir == 0 ? fsf[i][kk] : fsb[i][kk], fq, oacc[mt][i], 0, 0, 0);
                    }
                }
            }
            __syncthreads();
        }
#pragma unroll
        for (int mt = 0; mt < 4; ++mt) {
            float s2 = (oacc[mt][0].x * oacc[mt][0].x + oacc[mt][0].y * oacc[mt][0].y) + (oacc[mt][0].z * oacc[mt][0].z + oacc[mt][0].w * oacc[mt][0].w)
                     + (oacc[mt][1].x * oacc[mt][1].x + oacc[mt][1].y * oacc[mt][1].y) + (oacc[mt][1].z * oacc[mt][1].z + oacc[mt][1].w * oacc[mt][1].w);
            s2 += __shfl_xor(s2, 16); s2 += __shfl_xor(s2, 32);
            if (lq == 0) part[wid * 64 + mt * 16 + lr] = s2;
        }
        __syncthreads();
#pragma unroll
        for (int mt = 0; mt < 4; ++mt) {
            const int t = mt * 16 + lr;
            const float s2 = (part[t] + part[64 + t]) + (part[128 + t] + part[192 + t]);
            const float rstd = rsqrtf(s2 * (1.f / 128.f) + 1e-6f);
            const size_t rowi = (size_t)(r0 + t);
#pragma unroll
            for (int i = 0; i < 2; ++i) {
                const int e = (2 * wid + i) * 16 + lq * 4;
                const f32x4 gg = *(const f32x4*)(ng + h * 128 + e);
                const float g0 = bflo(gu[mt][i].x), g1 = bfhi(gu[mt][i].x), g2 = bflo(gu[mt][i].y), g3 = bfhi(gu[mt][i].y);
                u32x2 o;
                o.x = cvt_pk(oacc[mt][i].x * rstd * gg.x * siluf(g0), oacc[mt][i].y * rstd * gg.y * siluf(g1));
                o.y = cvt_pk(oacc[mt][i].z * rstd * gg.z * siluf(g2), oacc[mt][i].w * rstd * gg.w * siluf(g3));
                *(u32x2*)(brp + rowi * 1536 + h * 128 + e) = o;
            }
        }
        __syncthreads();
    }
}

template <int NI, class F>
__device__ __forceinline__ void ctx_gemm(const bf16_t* A, int lda, const bf16_t* Bt, int ldb, int K, int N, const F& f, char* lds) {
    const int tid = tid_l(), lane = tid & 63, wid = tid >> 6, wm = wid >> 1, wn = wid & 1, lr = lane & 15, lq = lane >> 4;
    const int Nt = (N + 32 * NI - 1) / (32 * NI);
    const int total = 4 * Nt, VG = vgrid(), slot = bid_l();
    for (int t0 = 0; t0 < total; t0 += VG) {
        const int t = t0 + (VG - 1 - slot); if (t >= total) continue;
        const int tm = t & 3, tn = t >> 2;
        f32x4 acc[4][NI];
#pragma unroll
        for (int mi = 0; mi < 4; ++mi)
#pragma unroll
            for (int ni = 0; ni < NI; ++ni) acc[mi][ni] = (f32x4){0.f, 0.f, 0.f, 0.f};
        gemm_kloop<NI>(acc, A + (size_t)(RL + tm * 128) * lda, lda, Bt + (size_t)tn * (32 * NI) * ldb, ldb, K, lds);
#pragma unroll
        for (int mi = 0; mi < 4; ++mi)
#pragma unroll
            for (int ni = 0; ni < NI; ++ni) f(RL + tm * 128 + wm * 64 + mi * 16 + lr, tn * (32 * NI) + wn * (16 * NI) + ni * 16 + lq * 4, acc[mi][ni], 0);
    }
}
__device__ __forceinline__ void ctx_merge(const Params& P, char* lds) {
    const int tid = tid_l(), lane = tid & 63, wid = tid >> 6, wm = wid >> 1, wn = wid & 1, lr = lane & 15, lq = lane >> 4;
    const bf16_t* br = (const bf16_t*)(ws_l(P) + WS_BR); const bf16_t* wb = (const bf16_t*)(ws_l(P) + WS_WTBR);
    const bf16_t* gs = (const bf16_t*)(ws_l(P) + WS_GS); bf16_t* mb = (bf16_t*)(ws_l(P) + WS_MB);
    const int total = 64, VG = vgrid(), slot = bid_l();
    for (int t0 = 0; t0 < total; t0 += VG) {
        const int t = t0 + (VG - 1 - slot); if (t >= total) continue;
        const int tm = t & 3, tn = t >> 2;
        f32x4 m[4][2];
#pragma unroll
        for (int mi = 0; mi < 4; ++mi)
#pragma unroll
            for (int ni = 0; ni < 2; ++ni) m[mi][ni] = (f32x4){0.f, 0.f, 0.f, 0.f};
#pragma unroll 1
        for (int j = 0; j < 3; ++j) {
            f32x4 acc[4][2];
#pragma unroll
            for (int mi = 0; mi < 4; ++mi)
#pragma unroll
                for (int ni = 0; ni < 2; ++ni) acc[mi][ni] = (f32x4){0.f, 0.f, 0.f, 0.f};
            gemm_kloop<2>(acc, br + (size_t)(RL + tm * 128) * 1536 + j * 512, 1536, wb + ((size_t)j * 1024 + tn * 64) * 512, 512, 512, lds);
#pragma unroll
            for (int mi = 0; mi < 4; ++mi)
#pragma unroll
                for (int ni = 0; ni < 2; ++ni) {
                    const int r = RL + tm * 128 + wm * 64 + mi * 16 + lr, c = tn * 64 + wn * 32 + ni * 16 + lq * 4;
                    const u32x2 g = *(const u32x2*)(gs + (size_t)r * 3072 + j * 1024 + c);
                    m[mi][ni].x += acc[mi][ni].x * bflo(g.x); m[mi][ni].y += acc[mi][ni].y * bfhi(g.x);
                    m[mi][ni].z += acc[mi][ni].z * bflo(g.y); m[mi][ni].w += acc[mi][ni].w * bfhi(g.y);
                }
        }
#pragma unroll
        for (int mi = 0; mi < 4; ++mi)
#pragma unroll
            for (int ni = 0; ni < 2; ++ni) {
                const int r = RL + tm * 128 + wm * 64 + mi * 16 + lr, c = tn * 64 + wn * 32 + ni * 16 + lq * 4;
                u32x2 o; o.x = cvt_pk(m[mi][ni].x, m[mi][ni].y); o.y = cvt_pk(m[mi][ni].z, m[mi][ni].w);
                *(u32x2*)(mb + (size_t)r * 1024 + c) = o;
            }
    }
}


#define XB_TMO      128
#define XB_XCNT(j)  (256  + 64 * (j))
#define XB_XSUB(j)  (1280 + 64 * (j))
#define XB_XGEN(j)  (2304 + 64 * (j))
#define XB_TOP      3328
#define XB_TOPGEN   3392
#define XCD_BAR_WORDS 3456
#define XB_SPIN_CAP (1u << 18)
__device__ __forceinline__ unsigned xb_ld(unsigned* p)              { return __hip_atomic_load(p, __ATOMIC_RELAXED, __HIP_MEMORY_SCOPE_AGENT); }
__device__ __forceinline__ unsigned xb_add(unsigned* p, unsigned v) { return __hip_atomic_fetch_add(p, v, __ATOMIC_RELAXED, __HIP_MEMORY_SCOPE_AGENT); }
__device__ __forceinline__ unsigned xb_xcc_id() { return (unsigned)__builtin_amdgcn_s_getreg((3 << 11) | 20) & 0xFu; }
#define XB_SPIN(cond, bar) do { unsigned _sp = 0; while (cond) { __builtin_amdgcn_s_sleep(1); \
    if ((++_sp & 255u) == 0u) { if (xb_ld(&(bar)[XB_TMO])) break; if (_sp > XB_SPIN_CAP) { atomicAdd(&(bar)[XB_TMO], 1u); break; } } } } while (0)
struct XcdBarrier { unsigned* bar; unsigned x; volatile LAS unsigned* st; };
__device__ __forceinline__ XcdBarrier xcd_barrier_post(unsigned* bar, volatile LAS unsigned* st) {
    XcdBarrier b; b.bar = bar; b.x = xb_xcc_id(); b.st = st;
    if (threadIdx.x == 0) (void)xb_add(&bar[XB_XCNT(b.x)], 1u);
    return b;
}
__device__ __forceinline__ void xcd_barrier_complete(unsigned* bar, unsigned x, unsigned& nloc, unsigned& nx) {
    const unsigned G = gridDim.x * gridDim.y * gridDim.z;
    unsigned sum, cnt, mine, sp = 0u;
    for (;;) {
        sum = 0u; cnt = 0u; mine = 0u;
#pragma unroll
        for (unsigned j = 0; j < 16; ++j) { const unsigned c = xb_ld(&bar[XB_XCNT(j)]); sum += c; cnt += (c > 0u) ? 1u : 0u; mine = (j == x) ? c : mine; }
        if (sum == G) break;
        __builtin_amdgcn_s_sleep(1);
        if ((++sp & 255u) == 0u) { if (xb_ld(&bar[XB_TMO])) break; if (sp > XB_SPIN_CAP) { atomicAdd(&bar[XB_TMO], 1u); break; } }
    }
    nloc = mine > 0u ? mine : 1u; nx = cnt > 0u ? cnt : 1u;
}
__device__ __forceinline__ void xcd_barrier(const XcdBarrier& b) {
    asm volatile("s_waitcnt vmcnt(0)" ::: "memory");
    __syncthreads();
    if (threadIdx.x == 0) {
        unsigned* bar = b.bar;
        __builtin_amdgcn_s_waitcnt(0);
        unsigned nloc = b.st[0], nx = b.st[1];
        if (nloc == 0u) { xcd_barrier_complete(bar, b.x, nloc, nx); b.st[0] = nloc; b.st[1] = nx; }
        const unsigned old = xb_add(&bar[XB_XSUB(b.x)], 1u);
        const unsigned gen = old / nloc;
        if (old + 1u == (gen + 1u) * nloc) {
            __builtin_amdgcn_fence(__ATOMIC_RELEASE, "agent");
            asm volatile("s_waitcnt vmcnt(0)" ::: "memory");
            const unsigned og = xb_add(&bar[XB_TOP], 1u);
            const unsigned tg = og / nx;
            if (og + 1u == (tg + 1u) * nx) xb_add(&bar[XB_TOPGEN], 1u);
            else XB_SPIN(xb_ld(&bar[XB_TOPGEN]) == tg, bar);
            __builtin_amdgcn_fence(__ATOMIC_ACQUIRE, "agent");
            xb_add(&bar[XB_XGEN(b.x)], 1u);
            asm volatile("s_waitcnt vmcnt(0)" ::: "memory");
        } else {
            XB_SPIN(xb_ld(&bar[XB_XGEN(b.x)]) == gen, bar);
            __builtin_amdgcn_fence(__ATOMIC_ACQUIRE, "agent");
            asm volatile("s_waitcnt vmcnt(0)" ::: "memory");
        }
    }
    __syncthreads();
}

__global__ void __launch_bounds__(512, 2) fwd_kernel(Params P) {
    extern __shared__ __attribute__((aligned(16))) unsigned char lds_raw[];
    cg::grid_group grid = cg::this_grid();
    LAS unsigned char* ldsb = (LAS unsigned char*)lds_raw;
#define LDSH ((char*)lds_raw + __builtin_amdgcn_readfirstlane(threadIdx.x >> 8) * HALF_LDS)
    volatile LAS unsigned* bst = (volatile LAS unsigned*)(ldsb + 2 * HALF_LDS);
    if (threadIdx.x < 2) bst[threadIdx.x] = 0u;
    __syncthreads();
    XcdBarrier xbar = xcd_barrier_post((unsigned*)(P.ws + WS_BAR), bst);
    int ph = 0;
#define PHASE_BEGIN if (ph >= P.lo && ph < P.hi) {
#define PHASE_END } ++ph; if (P.coop && ph > P.lo && ph < P.hi) { if (ph == 1) grid.sync(); else xcd_barrier(xbar); }

    PHASE_BEGIN
        {
        { const int VG = vgrid(), slot = bid_l();
          for (int i0 = 0; i0 < 384; i0 += VG) { int it = i0 + slot; if (it >= 384) it = 383; mods_task(P, it, LDSH); } }
        if (bid_l() == vgrid() - 1) rope_task(P);
        convert_all(P, 0, LDSH);
        }
    PHASE_END

    const XPtr Xin{(float*)P.in[I_X], (float*)P.in[I_CTX]};
    const XPtr Xcur{P.out, (float*)(P.ws + WS_CTXX)};

    for (int l = 0; l < 2; ++l) {
        const XPtr Xold = l == 0 ? Xin : Xcur;
        const bool ctx_on = (l == 0);
        PHASE_BEGIN
            {
            if (l == 1) convert_all(P, 1, LDSH);
            norm_phase(P, Xold, P.in[I_N1G] + l * D, l, 0, R);
            }
        PHASE_END
        PHASE_BEGIN
            const bf16_t* hb = (const bf16_t*)(ws_l(P) + WS_HBUF); const bf16_t* wt = (const bf16_t*)(ws_l(P) + WS_WTIN);
            EpiP e{(bf16_t*)(ws_l(P) + WS_PBUF), 1536, 1536, (float*)(ws_l(P) + WS_SMALL)};
            {
            big_gemm(ldsb, hb, 1024, wt, 1024, 1792, e);
            ctx_gemm<4>(hb, 1024, wt, 1024, 1024, 1664, e, LDSH); }
        PHASE_END
        PHASE_BEGIN u_phase<0>(P, l, LDSH); PHASE_END
        PHASE_BEGIN scan_phase<64, false>(P); PHASE_END
        PHASE_BEGIN out_phase_g(P, l, !ctx_on, LDSH); PHASE_END
        PHASE_BEGIN
            const bf16_t* hb = (const bf16_t*)(ws_l(P) + WS_HBUF); const bf16_t* wt = (const bf16_t*)(ws_l(P) + WS_WTIN) + (size_t)1792 * 1024;
            EpiP e{(bf16_t*)(ws_l(P) + WS_PBUF), 2048, 2048, nullptr};
            {
            big_gemm(ldsb, hb, 1024, wt, 1024, 2048, e);
            ctx_gemm<2>(hb, 1024, wt, 1024, 1024, 2048, e, LDSH); }
        PHASE_END
        PHASE_BEGIN u_phase_s<1>(P, l, LDSH); PHASE_END
        PHASE_BEGIN scan_phase<128, true>(P); PHASE_END
        PHASE_BEGIN out_phase_s<1>(P, l, 1, !ctx_on, LDSH); PHASE_END
        PHASE_BEGIN
            const bf16_t* hb = (const bf16_t*)(ws_l(P) + WS_HBUF); const bf16_t* wt = (const bf16_t*)(ws_l(P) + WS_WTIN) + (size_t)3840 * 1024;
            EpiP e{(bf16_t*)(ws_l(P) + WS_PBUF), 1536, 1536, nullptr};
            {
            big_gemm(ldsb, hb, 1024, wt, 1024, 1536, e);
            ctx_gemm<4>(hb, 1024, wt, 1024, 1024, 1536, e, LDSH); }
        PHASE_END
        PHASE_BEGIN u_phase_s<2>(P, l, LDSH); PHASE_END
        PHASE_BEGIN scan_phase<64, false>(P); PHASE_END
        PHASE_BEGIN out_phase_s<2>(P, l, 2, !ctx_on, LDSH); PHASE_END
        PHASE_BEGIN
            const bf16_t* hb = (const bf16_t*)(ws_l(P) + WS_HBUF); const bf16_t* wt = (const bf16_t*)(ws_l(P) + WS_WTIN) + (size_t)5376 * 1024;
            EpiSig e{(bf16_t*)(ws_l(P) + WS_GS)};
            {
            big_gemm(ldsb, hb, 1024, wt, 1024, 3072, e);
            if (ctx_on) ctx_gemm<2>(hb, 1024, wt, 1024, 1024, 3072, e, LDSH); }
        PHASE_END
        PHASE_BEGIN
            {   pg8::Gemm g{(const bf16_t*)(ws_l(P) + WS_BR), (const bf16_t*)(ws_l(P) + WS_WTBR), 1536, 512};
                pg8::MergeOrder S; S.S.init(RL, 1024, (int)gridDim.x, (int)blockIdx.x);
                pg8::Epi<EpiMerge> E{EpiMerge{(const bf16_t*)(ws_l(P) + WS_GS), (bf16_t*)(ws_l(P) + WS_MB)}};
                pg8::gemm_phase(ldsb, g, S, E);
                __syncthreads(); }
            if (ctx_on) ctx_merge(P, LDSH);
        PHASE_END
        PHASE_BEGIN
            const float* mods_l = (const float*)(ws_l(P) + WS_MODS) + (size_t)l * 3 * 6144;
            EpiRes e{Xold, Xcur, mods_l, 2};
            big_gemm(ldsb, (const bf16_t*)(ws_l(P) + WS_MB), 1024, (const bf16_t*)(ws_l(P) + WS_WTO), 1024, 1024, e);
            if (ctx_on) ctx_gemm<1>((const bf16_t*)(ws_l(P) + WS_MB), 1024, (const bf16_t*)(ws_l(P) + WS_WTO), 1024, 1024, 1024, e, LDSH);
        PHASE_END
        PHASE_BEGIN norm_phase(P, Xcur, P.in[I_N2G] + l * D, l, 3, ctx_on ? R : RL); PHASE_END
        PHASE_BEGIN
            const bf16_t* hb = (const bf16_t*)(ws_l(P) + WS_HBUF);
            EpiRelu2 e{(bf16_t*)(ws_l(P) + WS_HID)};
            {
            big_gemm(ldsb, hb, 1024, (const bf16_t*)(ws_l(P) + WS_WTUP), 1024, 4096, e);
            if (ctx_on) ctx_gemm<2>(hb, 1024, (const bf16_t*)(ws_l(P) + WS_WTUP), 1024, 1024, 4096, e, LDSH); }
        PHASE_END
        PHASE_BEGIN
            const float* mods_l = (const float*)(ws_l(P) + WS_MODS) + (size_t)l * 3 * 6144;
            EpiRes e{Xcur, Xcur, mods_l, 5};
            big_gemm(ldsb, (const bf16_t*)(ws_l(P) + WS_HID), 4096, (const bf16_t*)(ws_l(P) + WS_WTDN), 4096, 1024, e);
            if (ctx_on) ctx_gemm<1>((const bf16_t*)(ws_l(P) + WS_HID), 4096, (const bf16_t*)(ws_l(P) + WS_WTDN), 4096, 4096, 1024, e, LDSH);
        PHASE_END
    }
    PHASE_BEGIN final_norm_phase(P); PHASE_END
#undef PHASE_BEGIN
#undef PHASE_END
}
constexpr int NPHASES = 1 + 2 * 19 + 1;

extern "C" void kernel_launch(void* const* d_in, const int* in_sizes, int n_in, void* d_out, int out_size, void* d_ws, size_t ws_size, hipStream_t stream) {
    static int grid = 0;
    if (grid == 0) {
        if (n_in != 23 || ws_size < WS_END || out_size != NB * SEQ * D) { fprintf(stderr, "kernel_launch: unexpected sizes n_in %d ws %zu (need %zu) out %d\n", n_in, ws_size, (size_t)WS_END, out_size); grid = -1; return; }
        int dev = 0, cus = 0, per_cu = 0;
        if (hipGetDevice(&dev) != hipSuccess || hipDeviceGetAttribute(&cus, hipDeviceAttributeMultiprocessorCount, dev) != hipSuccess) { grid = -1; return; }
        if (hipFuncSetAttribute((const void*)fwd_kernel, hipFuncAttributeMaxDynamicSharedMemorySize, LDS_BYTES) != hipSuccess) { fprintf(stderr, "kernel_launch: hipFuncSetAttribute failed\n"); grid = -1; return; }
        if (hipOccupancyMaxActiveBlocksPerMultiprocessor(&per_cu, (const void*)fwd_kernel, 512, LDS_BYTES) != hipSuccess || per_cu < 1) { fprintf(stderr, "kernel_launch: occupancy query failed (%d)\n", per_cu); grid = -1; return; }
        grid = cus;
        grid -= grid % 8;
    }
    if (grid < 0) return;
    if (hipMemsetAsync((char*)d_ws + WS_BAR, 0, (size_t)3456 * 4, stream) != hipSuccess) { fprintf(stderr, "kernel_launch: memset failed\n"); return; }
    Params p{};
    for (int i = 0; i < 23; ++i) p.in[i] = (const float*)d_in[i];
    p.out = (float*)d_out; p.ws = (unsigned char*)d_ws;
    p.lo = 0; p.hi = NPHASES; p.coop = 1;
    void* args[] = {&p};
    hipError_t e = hipLaunchCooperativeKernel((const void*)fwd_kernel, dim3(grid), dim3(512), args, LDS_BYTES, stream);
    if (e != hipSuccess) fprintf(stderr, "kernel_launch: cooperative launch failed: %s (grid %d)\n", hipGetErrorString(e), grid);
}
```

```cpp
#include <hip/hip_runtime.h>
#include <hip/hip_cooperative_groups.h>
#include <stdint.h>
#include <stdio.h>
namespace cg = cooperative_groups;

#define LAS __attribute__((address_space(3)))
typedef unsigned short bf16_t;
typedef short bf16x8 __attribute__((ext_vector_type(8)));
typedef float f32x4 __attribute__((ext_vector_type(4)));
typedef unsigned u32x4 __attribute__((ext_vector_type(4)));
typedef unsigned u32x2 __attribute__((ext_vector_type(2)));

constexpr int D = 1024, NB = 2, SEQ = 8192, CTX = 256, RB = SEQ + CTX, R = NB * RB, RL = NB * SEQ, NCH = RB / 64, FF = 4096;
constexpr int INW = 8240;
constexpr int NTHR = 256;
constexpr int HALF_LDS = 73728;
constexpr int LDS_BYTES = 2 * HALF_LDS + 16;

constexpr size_t WS_WTIN = 0;
constexpr size_t WS_WTBR = WS_WTIN + (size_t)8448 * 1024 * 2;
constexpr size_t WS_WTO = WS_WTBR + (size_t)3 * 1024 * 512 * 2;
constexpr size_t WS_WTUP = WS_WTO + (size_t)1024 * 1024 * 2;
constexpr size_t WS_WTDN = WS_WTUP + (size_t)4096 * 1024 * 2;
constexpr size_t WS_HBUF = WS_WTDN + (size_t)4096 * 1024 * 2;
constexpr size_t WS_PBUF = WS_HBUF + (size_t)R * 1024 * 2;
constexpr size_t WS_SBUF = WS_PBUF + (size_t)R * 2048 * 2;
constexpr size_t WS_BR = WS_SBUF + (size_t)R * 2048 * 2;
constexpr size_t WS_CTXX = WS_BR + (size_t)R * 1536 * 2;
constexpr size_t WS_SMALL = WS_CTXX + (size_t)512 * 1024 * 4;
constexpr size_t WS_DEC = WS_SMALL + (size_t)R * 48 * 4;
constexpr size_t WS_UN = WS_DEC + (size_t)16 * NCH * 128 * 4;
constexpr size_t WS_MODS = WS_UN + (size_t)16 * NCH * 128 * 4;
constexpr size_t WS_ROPE = WS_MODS + (size_t)2 * 3 * 6144 * 4;
constexpr size_t WS_BAR = WS_ROPE + (size_t)(128 + 64) * 16 * 2 * 4;
constexpr size_t WS_END = WS_BAR + (size_t)3456 * 4;
constexpr size_t WS_GS = WS_PBUF;
constexpr size_t WS_MB = WS_PBUF + (size_t)R * 3072 * 2;
constexpr size_t WS_HID = WS_PBUF;

struct Params { const float* in[23]; float* out; unsigned char* ws; int lo, hi, coop, pad; };

__device__ __forceinline__ int tid_l() { int t = threadIdx.x & 255; asm volatile("" : "+v"(t)); return t; }
__device__ __forceinline__ int bid_l() { int t = blockIdx.x * 2 + (__builtin_amdgcn_readfirstlane(threadIdx.x >> 8)); asm volatile("" : "+s"(t)); return t; }
__device__ __forceinline__ int vgrid() { return gridDim.x * 2; }
typedef __attribute__((address_space(1))) unsigned char gas_u8;
__device__ __forceinline__ unsigned char* ws_l(const Params& P) { gas_u8* w = (gas_u8*)P.ws; asm volatile("" : "+s"(w)); return (unsigned char*)w; }
enum { I_X = 0, I_C, I_CTX, I_CCTX, I_N1G, I_N2G, I_WADA, I_BADA, I_WIN, I_A2, I_ABIAS, I_GNG, I_CONV, I_IB, I_FB, I_MNG, I_RDL, I_RNG, I_WBR, I_WO, I_WUP, I_WDN, I_FG };

typedef __bf16 bf16x2_t __attribute__((ext_vector_type(2)));
typedef float f32x2 __attribute__((ext_vector_type(2)));
__device__ __forceinline__ unsigned cvt_pk(float lo, float hi) { f32x2 v = {lo, hi}; bf16x2_t b = __builtin_convertvector(v, bf16x2_t); return __builtin_bit_cast(unsigned, b); }
__device__ __forceinline__ float bflo(unsigned u) { return __uint_as_float(u << 16); }
__device__ __forceinline__ float bfhi(unsigned u) { return __uint_as_float(u & 0xffff0000u); }
__device__ __forceinline__ float wave_sum(float v) {
#pragma unroll
    for (int o = 32; o > 0; o >>= 1) v += __shfl_xor(v, o);
    return v;
}
__device__ __forceinline__ float logsig(float x) { return fminf(x, 0.f) - log1pf(__expf(-fabsf(x))); }
__device__ __forceinline__ float siluf(float x) { return x * __builtin_amdgcn_rcpf(1.f + __expf(-x)); }
__device__ __forceinline__ float sigmf(float x) { return __builtin_amdgcn_rcpf(1.f + __expf(-x)); }

struct XPtr { float* lat; float* ctx; };
__device__ __forceinline__ float* xrow(const XPtr& X, int r) { return r < RL ? X.lat + (size_t)r * D : X.ctx + (size_t)(r - RL) * D; }
__device__ __forceinline__ int modidx(int r) { return r < SEQ ? 0 : (r < RL ? 1 : 2); }
__device__ __forceinline__ int rowbase(int b, int c) { return c < 4 ? RL + b * CTX + c * 64 : b * SEQ + (c - 4) * 64; }

#define UNPACK8(u, f) do { f[0] = bflo(u.x); f[1] = bfhi(u.x); f[2] = bflo(u.y); f[3] = bfhi(u.y); f[4] = bflo(u.z); f[5] = bfhi(u.z); f[6] = bflo(u.w); f[7] = bfhi(u.w); } while (0)

__device__ __forceinline__ void mods_task(const Params& P, int task, char* lds) {
    float* s = (float*)lds;
    float* red = (float*)(lds + 12288);
    const int tid = tid_l();
    const int l = task / 192, col0 = (task % 192) * 32;
    const float* c = P.in[I_C]; const float* cc = P.in[I_CCTX];
    for (int i = tid; i < 3072; i += NTHR) { const int v = i >> 10, k = i & 1023; const float cv = v < 2 ? c[v * 1024 + k] : cc[k]; s[i] = siluf(cv); }
    __syncthreads();
    const int col = tid & 31, kg = tid >> 5;
    const float* w = P.in[I_WADA] + (size_t)l * D * 6144 + col0 + col;
    float a0 = 0.f, a1 = 0.f, a2 = 0.f;
#pragma unroll 32
    for (int k = kg * 128; k < kg * 128 + 128; ++k) { const float wv = w[(size_t)k * 6144]; a0 += s[k] * wv; a1 += s[1024 + k] * wv; a2 += s[2048 + k] * wv; }
    red[(kg * 32 + col) * 3 + 0] = a0; red[(kg * 32 + col) * 3 + 1] = a1; red[(kg * 32 + col) * 3 + 2] = a2;
    __syncthreads();
    if (tid < 96) {
        const int v = tid >> 5, c2 = tid & 31; float sum = 0.f;
#pragma unroll
        for (int g = 0; g < 8; ++g) sum += red[(g * 32 + c2) * 3 + v];
        sum += P.in[I_BADA][l * 6144 + col0 + c2];
        ((float*)(ws_l(P) + WS_MODS))[(l * 3 + v) * 6144 + col0 + c2] = sum;
    }
    __syncthreads();
}

__device__ __forceinline__ void rope_task(const Params& P) {
    float* tab = (float*)(ws_l(P) + WS_ROPE);
    for (int i = tid_l(); i < 192 * 16; i += NTHR) {
        const int pos = i >> 4, f = i & 15;
        const float inv = exp2f(-(float)f * (13.287712379549449f / 16.f));
        const float p = pos < 128 ? (float)pos : (float)(pos - 128);
        const float ang = p * inv;
        const float cs = cosf(ang), sn = sinf(ang);
        if (pos < 128) { tab[pos * 16 + f] = cs; tab[2048 + pos * 16 + f] = sn; }
        else { tab[4096 + (pos - 128) * 16 + f] = cs; tab[4096 + 1024 + (pos - 128) * 16 + f] = sn; }
    }
}

__device__ __forceinline__ void transpose_tile(const float* src, int ldsrc, int k0, int n0src, int nvalid, bf16_t* dst, int ldd, int drow0, char* lds) {
    float* tile = (float*)lds;
    const int tid = tid_l(), nl = tid & 63, kq = tid >> 6;
    float v[32];
#pragma unroll
    for (int i = 0; i < 32; ++i) v[i] = nl < nvalid ? src[(size_t)(k0 + kq + 4 * i) * ldsrc + n0src + nl] : 0.f;
#pragma unroll
    for (int i = 0; i < 32; ++i) tile[(kq + 4 * i) * 65 + nl] = v[i];
    __syncthreads();
    const int n = tid >> 2, ks = (tid & 3) * 32;
    if (n < nvalid) {
        u32x4* dp = (u32x4*)(dst + (size_t)(drow0 + n) * ldd + k0 + ks);
#pragma unroll
        for (int q = 0; q < 4; ++q) {
            u32x4 o;
            o.x = cvt_pk(tile[(ks + 8 * q + 0) * 65 + n], tile[(ks + 8 * q + 1) * 65 + n]); o.y = cvt_pk(tile[(ks + 8 * q + 2) * 65 + n], tile[(ks + 8 * q + 3) * 65 + n]);
            o.z = cvt_pk(tile[(ks + 8 * q + 4) * 65 + n], tile[(ks + 8 * q + 5) * 65 + n]); o.w = cvt_pk(tile[(ks + 8 * q + 6) * 65 + n], tile[(ks + 8 * q + 7) * 65 + n]);
            dp[q] = o;
        }
    }
    __syncthreads();
}

constexpr int CONV_TILES = 192 + 8 + 8 + 256 + 192 + 384 + 192 + 128 + 512 + 512;
__device__ __forceinline__ void convert_tile(const Params& P, int l, int it, char* lds) {
    const float* win = P.in[I_WIN] + (size_t)l * D * INW;
    bf16_t* wtin = (bf16_t*)(ws_l(P) + WS_WTIN);
    int r = it;
    if (r < 192) { const int kt = r / 24, nt = r % 24; transpose_tile(win, INW, kt * 128, nt * 64, 64, wtin, 1024, nt * 64, lds); return; } r -= 192;
    if (r < 8) { transpose_tile(win, INW, r * 128, 1536, 32, wtin, 1024, 1536, lds); return; } r -= 8;
    if (r < 8) { transpose_tile(win, INW, r * 128, 3616, 16, wtin, 1024, 1568, lds); return; } r -= 8;
    if (r < 256) { const int kt = r / 32, nt = r % 32; transpose_tile(win, INW, kt * 128, 1568 + nt * 64, 64, wtin, 1024, 1792 + nt * 64, lds); return; } r -= 256;
    if (r < 192) { const int kt = r / 24, nt = r % 24; transpose_tile(win, INW, kt * 128, 3632 + nt * 64, 64, wtin, 1024, 3840 + nt * 64, lds); return; } r -= 192;
    if (r < 384) { const int kt = r / 48, nt = r % 48; transpose_tile(win, INW, kt * 128, 5168 + nt * 64, 64, wtin, 1024, 5376 + nt * 64, lds); return; } r -= 384;
    if (r < 192) { const int j = r / 64, q = r % 64, kt = q / 16, nt = q % 16;
        transpose_tile(P.in[I_WBR] + ((size_t)l * 3 + j) * 512 * 1024, 1024, kt * 128, nt * 64, 64, (bf16_t*)(ws_l(P) + WS_WTBR), 512, j * 1024 + nt * 64, lds); return; } r -= 192;
    if (r < 128) { const int kt = r / 16, nt = r % 16; transpose_tile(P.in[I_WO] + (size_t)l * D * D, 1024, kt * 128, nt * 64, 64, (bf16_t*)(ws_l(P) + WS_WTO), 1024, nt * 64, lds); return; } r -= 128;
    if (r < 512) { const int kt = r / 64, nt = r % 64; transpose_tile(P.in[I_WUP] + (size_t)l * D * FF, 4096, kt * 128, nt * 64, 64, (bf16_t*)(ws_l(P) + WS_WTUP), 1024, nt * 64, lds); return; } r -= 512;
    { const int kt = r / 16, nt = r % 16; transpose_tile(P.in[I_WDN] + (size_t)l * FF * D, 1024, kt * 128, nt * 64, 64, (bf16_t*)(ws_l(P) + WS_WTDN), 4096, nt * 64, lds); }
}
__device__ __forceinline__ void convert_all(const Params& P, int l, char* lds) {
    const int VG = vgrid(), slot = bid_l();
    static_assert(CONV_TILES % 2 == 0, "both halves of a workgroup must be active together");
    for (int i0 = 0; i0 < CONV_TILES; i0 += VG) { const int it = i0 + slot; if (it >= CONV_TILES) continue; convert_tile(P, l, it, lds); }
}

__device__ __forceinline__ void norm_phase(const Params& P, XPtr X, const float* g, int l, int sidx, int nrows) {
    const int lane = tid_l() & 63; const int gw = bid_l() * 4 + (tid_l() >> 6), ngw = vgrid() * 4;
    bf16_t* hb = (bf16_t*)(ws_l(P) + WS_HBUF);
    const float* mods = (const float*)(ws_l(P) + WS_MODS) + (size_t)l * 3 * 6144;
    for (int r = gw; r < nrows; r += 2 * ngw) {
        const int r1 = r + ngw; const bool has1 = r1 < nrows; const int rr1 = has1 ? r1 : r;
        const f32x4* xa = (const f32x4*)xrow(X, r); const f32x4* xb = (const f32x4*)xrow(X, rr1);
        f32x4 va[4], vb[4]; float sa_ = 0.f, sb_ = 0.f;
#pragma unroll
        for (int j = 0; j < 4; ++j) { va[j] = xa[lane + 64 * j]; vb[j] = xb[lane + 64 * j]; }
#pragma unroll
        for (int j = 0; j < 4; ++j) { sa_ += va[j].x * va[j].x + va[j].y * va[j].y + va[j].z * va[j].z + va[j].w * va[j].w; sb_ += vb[j].x * vb[j].x + vb[j].y * vb[j].y + vb[j].z * vb[j].z + vb[j].w * vb[j].w; }
        sa_ = wave_sum(sa_); sb_ = wave_sum(sb_);
        const float rsa = rsqrtf(sa_ * (1.f / 1024.f) + 1e-6f), rsb = rsqrtf(sb_ * (1.f / 1024.f) + 1e-6f);
        const float* mda = mods + modidx(r) * 6144; const float* mdb = mods + modidx(rr1) * 6144;
#pragma unroll
        for (int j = 0; j < 4; ++j) {
            const int col = (lane + 64 * j) * 4;
            const f32x4 gg = *(const f32x4*)(g + col);
            { const f32x4 sh = *(const f32x4*)(mda + sidx * 1024 + col), sc = *(const f32x4*)(mda + (sidx + 1) * 1024 + col);
              const f32x4 hh = va[j] * rsa * gg * (sc + 1.f) + sh; u32x2 o; o.x = cvt_pk(hh.x, hh.y); o.y = cvt_pk(hh.z, hh.w); *(u32x2*)(hb + (size_t)r * 1024 + col) = o; }
            if (has1) { const f32x4 sh = *(const f32x4*)(mdb + sidx * 1024 + col), sc = *(const f32x4*)(mdb + (sidx + 1) * 1024 + col);
              const f32x4 hh = vb[j] * rsb * gg * (sc + 1.f) + sh; u32x2 o; o.x = cvt_pk(hh.x, hh.y); o.y = cvt_pk(hh.z, hh.w); *(u32x2*)(hb + (size_t)r1 * 1024 + col) = o; }
        }
    }
}
__device__ __forceinline__ void final_norm_phase(const Params& P) {
    const int lane = tid_l() & 63; const int gw = bid_l() * 4 + (tid_l() >> 6), ngw = vgrid() * 4;
    const float* g = P.in[I_FG];
    for (int r = gw; r < RL; r += 2 * ngw) {
        const int r1 = r + ngw;
        f32x4* xa = (f32x4*)(P.out + (size_t)r * D); f32x4* xb = (f32x4*)(P.out + (size_t)r1 * D);
        f32x4 va[4], vb[4]; float sa_ = 0.f, sb_ = 0.f;
#pragma unroll
        for (int j = 0; j < 4; ++j) { va[j] = xa[lane + 64 * j]; vb[j] = xb[lane + 64 * j]; }
#pragma unroll
        for (int j = 0; j < 4; ++j) { sa_ += va[j].x * va[j].x + va[j].y * va[j].y + va[j].z * va[j].z + va[j].w * va[j].w; sb_ += vb[j].x * vb[j].x + vb[j].y * vb[j].y + vb[j].z * vb[j].z + vb[j].w * vb[j].w; }
        sa_ = wave_sum(sa_); sb_ = wave_sum(sb_);
        const float rsa = rsqrtf(sa_ * (1.f / 1024.f) + 1e-6f), rsb = rsqrtf(sb_ * (1.f / 1024.f) + 1e-6f);
#pragma unroll
        for (int j = 0; j < 4; ++j) { const f32x4 gg = *(const f32x4*)(g + (lane + 64 * j) * 4); xa[lane + 64 * j] = va[j] * rsa * gg; xb[lane + 64 * j] = vb[j] * rsb * gg; }
    }
}

struct EpiP {
    bf16_t* Pb; int pitch; int nmain; float* small;
    __device__ __forceinline__ void operator()(int r, int c, const f32x4& v, int) const {
        if (c < nmain) { u32x2 o; o.x = cvt_pk(v.x, v.y); o.y = cvt_pk(v.z, v.w); *(u32x2*)(Pb + (size_t)r * pitch + c) = o; }
        else { const int cc = c - nmain; if (cc < 48) *(f32x4*)(small + (size_t)r * 48 + cc) = v; }
    }
    __device__ __forceinline__ void w8(int r, int c, const f32x4& v0, const f32x4& v1, int) const {
        if (c < nmain) { u32x4 o; o.x = cvt_pk(v0.x, v0.y); o.y = cvt_pk(v0.z, v0.w); o.z = cvt_pk(v1.x, v1.y); o.w = cvt_pk(v1.z, v1.w); *(u32x4*)(Pb + (size_t)r * pitch + c) = o; }
        else { const int cc = c - nmain; if (cc < 48) { *(f32x4*)(small + (size_t)r * 48 + cc) = v0; *(f32x4*)(small + (size_t)r * 48 + cc + 4) = v1; } }
    }
};
struct EpiSig {
    bf16_t* O;
    __device__ __forceinline__ void operator()(int r, int c, const f32x4& v, int) const {
        u32x2 o; o.x = cvt_pk(sigmf(v.x), sigmf(v.y)); o.y = cvt_pk(sigmf(v.z), sigmf(v.w)); *(u32x2*)(O + (size_t)r * 3072 + c) = o;
    }
    __device__ __forceinline__ void w8(int r, int c, const f32x4& v0, const f32x4& v1, int) const {
        u32x4 o; o.x = cvt_pk(sigmf(v0.x), sigmf(v0.y)); o.y = cvt_pk(sigmf(v0.z), sigmf(v0.w)); o.z = cvt_pk(sigmf(v1.x), sigmf(v1.y)); o.w = cvt_pk(sigmf(v1.z), sigmf(v1.w));
        *(u32x4*)(O + (size_t)r * 3072 + c) = o;
    }
};
struct EpiRelu2 {
    bf16_t* O;
    __device__ __forceinline__ void operator()(int r, int c, const f32x4& v, int) const {
        const float a = fmaxf(v.x, 0.f), b = fmaxf(v.y, 0.f), cc = fmaxf(v.z, 0.f), d = fmaxf(v.w, 0.f);
        u32x2 o; o.x = cvt_pk(a * a, b * b); o.y = cvt_pk(cc * cc, d * d); *(u32x2*)(O + (size_t)r * 4096 + c) = o;
    }
    __device__ __forceinline__ void w8(int r, int c, const f32x4& v0, const f32x4& v1, int) const {
        const float a = fmaxf(v0.x, 0.f), b = fmaxf(v0.y, 0.f), cc = fmaxf(v0.z, 0.f), d = fmaxf(v0.w, 0.f), e = fmaxf(v1.x, 0.f), f = fmaxf(v1.y, 0.f), g = fmaxf(v1.z, 0.f), h = fmaxf(v1.w, 0.f);
        u32x4 o; o.x = cvt_pk(a * a, b * b); o.y = cvt_pk(cc * cc, d * d); o.z = cvt_pk(e * e, f * f); o.w = cvt_pk(g * g, h * h); *(u32x4*)(O + (size_t)r * 4096 + c) = o;
    }
};
struct EpiRes {
    XPtr Xold, Xnew; const float* mods_l; int gidx;
    __device__ __forceinline__ void operator()(int r, int c, const f32x4& v, int) const {
        const f32x4 g = *(const f32x4*)(mods_l + modidx(r) * 6144 + gidx * 1024 + c);
        const f32x4 xo = *(const f32x4*)(xrow(Xold, r) + c);
        *(f32x4*)(xrow(Xnew, r) + c) = xo + g * v;
    }
    __device__ __forceinline__ void w8(int r, int c, const f32x4& v0, const f32x4& v1, int) const {
        const float* gp = mods_l + modidx(r) * 6144 + gidx * 1024 + c; const float* xo = xrow(Xold, r) + c; float* xn = xrow(Xnew, r) + c;
        const f32x4 g0 = *(const f32x4*)gp, g1 = *(const f32x4*)(gp + 4), x0 = *(const f32x4*)xo, x1 = *(const f32x4*)(xo + 4);
        *(f32x4*)xn = x0 + g0 * v0; *(f32x4*)(xn + 4) = x1 + g1 * v1;
    }
};
struct EpiMerge {
    const bf16_t* gs; bf16_t* mb;
    __device__ __forceinline__ void operator()(int r, int c, const f32x4& v, int j) const {
        const u32x2 g = *(const u32x2*)(gs + (size_t)r * 3072 + j * 1024 + c);
        float a0 = v.x * bflo(g.x), a1 = v.y * bfhi(g.x), a2 = v.z * bflo(g.y), a3 = v.w * bfhi(g.y);
        u32x2* mp = (u32x2*)(mb + (size_t)r * 1024 + c);
        if (j > 0) { const u32x2 o = *mp; a0 += bflo(o.x); a1 += bfhi(o.x); a2 += bflo(o.y); a3 += bfhi(o.y); }
        u32x2 w; w.x = cvt_pk(a0, a1); w.y = cvt_pk(a2, a3); *mp = w;
    }
    __device__ __forceinline__ void w8(int r, int c, const f32x4& v0, const f32x4& v1, int j) const {
        const u32x4 g = *(const u32x4*)(gs + (size_t)r * 3072 + j * 1024 + c);
        float a0 = v0.x * bflo(g.x), a1 = v0.y * bfhi(g.x), a2 = v0.z * bflo(g.y), a3 = v0.w * bfhi(g.y), a4 = v1.x * bflo(g.z), a5 = v1.y * bfhi(g.z), a6 = v1.z * bflo(g.w), a7 = v1.w * bfhi(g.w);
        u32x4* mp = (u32x4*)(mb + (size_t)r * 1024 + c);
        if (j > 0) { const u32x4 o = *mp; a0 += bflo(o.x); a1 += bfhi(o.x); a2 += bflo(o.y); a3 += bfhi(o.y); a4 += bflo(o.z); a5 += bfhi(o.z); a6 += bflo(o.w); a7 += bfhi(o.w); }
        u32x4 w; w.x = cvt_pk(a0, a1); w.y = cvt_pk(a2, a3); w.z = cvt_pk(a4, a5); w.w = cvt_pk(a6, a7); *mp = w;
    }
};

namespace pg8 {
constexpr int BM = 256, BK = 64, HALF = 128, HTB = HALF * BK * 2, STAGE_BYTES = 8 * HTB, NXCD = 8, WGM = 2;
__device__ __forceinline__ int lds_byte(int r, int c) { const int st = (r >> 4) * 2 + (c >> 5), rr = r & 15, cc = c & 31, ob = rr * 64 + cc * 2; return st * 1024 + (ob ^ (((ob >> 9) & 1) << 5)); }
__device__ __forceinline__ int perm32(int rho) { const int n = rho >> 4, i = rho & 15; return 8 * (i >> 2) + 4 * n + (i & 3); }
__device__ __forceinline__ void stage_rc(int b, int& R_, int& C_) { const int st = b / 1024, sb = b % 1024, swz = sb ^ (((sb >> 9) & 1) << 5); R_ = (st >> 1) * 16 + swz / 64; C_ = (st & 1) * 32 + (swz % 64) / 2; }
struct Unit { int pm, pn, acol, brow, j; };
struct Gemm { const bf16_t* A; const bf16_t* Bt; int lda, K; };
struct StaticOrder {
    int nM, nN, nwg, G, c;
    __device__ void init(int M, int N, int G_, int c_) { nM = M / BM; nN = N / BM; nwg = nM * nN; G = G_; c = c_; }
    __device__ __forceinline__ bool tile(long L, int& pm, int& pn) const {
        if (L >= nwg) return false;
        int wgid = (int)L; { const int q = nwg / NXCD, r = nwg % NXCD, xcd = wgid % NXCD, off = wgid / NXCD; wgid = (xcd < r ? xcd * (q + 1) : r * (q + 1) + (xcd - r) * q) + off; }
        const int nig = WGM * nN, gid = wgid / nig, fm = gid * WGM, gsz = (nM - fm) < WGM ? (nM - fm) : WGM;
        pm = fm + ((wgid % nig) % gsz); pn = (wgid % nig) / gsz; return true;
    }
    __device__ __forceinline__ bool next(int i, Unit& u) const { if (!tile((long)i * G + c, u.pm, u.pn)) return false; u.acol = 0; u.brow = u.pn; u.j = 0; return true; }
};
struct MergeOrder {
    StaticOrder S;
    __device__ __forceinline__ bool next(int i, Unit& u) const { const int j = i % 3; if (!S.tile((long)(i / 3) * S.G + S.c, u.pm, u.pn)) return false; u.acol = j * 512; u.brow = j * 4 + u.pn; u.j = j; return true; }
};
template <class F> struct Epi {
    F f;
    __device__ __forceinline__ void operator()(const f32x4 (&acc)[2][2][4][2], const Unit& u, int wr, int wc, int fr, int fq) const {
#pragma unroll
        for (int ai = 0; ai < 2; ++ai)
#pragma unroll
            for (int m = 0; m < 4; ++m)
#pragma unroll
                for (int bj = 0; bj < 2; ++bj)
                    f.w8(u.pm * BM + ai * HALF + wr * 64 + m * 16 + fr, u.pn * BM + bj * HALF + wc * 32 + 8 * fq, acc[ai][bj][m][0], acc[ai][bj][m][1], u.j);
    }
};

template <class E_, class Sched>
__device__ __forceinline__ void gemm_phase(LAS unsigned char* lds, const Gemm g, const Sched& S, const E_& E) {
    int tid_ = threadIdx.x; asm volatile("" : "+v"(tid_));
    const int tid = tid_, wid = __builtin_amdgcn_readfirstlane(tid >> 6), lane = tid & 63, wr = wid >> 2, wc = wid & 3, fr = lane & 15, fq = lane >> 4;
    const int K = g.K, nt = K / BK;
    unsigned voffA[2], voffB[2];
#pragma unroll
    for (int i = 0; i < 2; ++i) { int R_, C_; stage_rc(tid * 16 + i * 8192, R_, C_); const int Rb = (R_ & ~31) + perm32(R_ & 31); voffA[i] = (unsigned)(R_ * g.lda + C_) * 2u; voffB[i] = (unsigned)(Rb * K + C_) * 2u; }
    const size_t kstep = (size_t)(BK * 2);
    const size_t hstepA = (size_t)HALF * g.lda * 2, hstepB = (size_t)HALF * K * 2;
    const unsigned ldsw = (unsigned)wid * 1024u;
    const int aoff = lds_byte(wr * 64 + fr, fq * 8), boff = lds_byte(wc * 32 + fr, fq * 8);
#define PG8_SA(b, h) (((b) * 2 + (h)) * HTB)
#define PG8_SB(b, h) ((4 + (b) * 2 + (h)) * HTB)
#define PG8_STAGE(bufoff, gbase, voff) do { _Pragma("unroll") for (int _i = 0; _i < 2; ++_i) \
        __builtin_amdgcn_global_load_lds((const unsigned*)((const char*)(gbase) + (voff)[_i]), (LAS unsigned*)(lds + (bufoff) + ldsw + _i * 8192), 16, 0, 0); } while (0)
#define PG8_LDA(dst, b, h) do { _Pragma("unroll") for (int m = 0; m < 4; ++m) _Pragma("unroll") for (int k = 0; k < 2; ++k) dst[m][k] = *(const LAS bf16x8*)(lds + PG8_SA(b, h) + aoff + m * 2048 + k * 1024); } while (0)
#define PG8_LDB(dst, b, h) do { _Pragma("unroll") for (int n = 0; n < 2; ++n) _Pragma("unroll") for (int k = 0; k < 2; ++k) dst[n][k] = *(const LAS bf16x8*)(lds + PG8_SB(b, h) + boff + n * 2048 + k * 1024); } while (0)
#define PG8_MMA(ai, bj, At, Bt) do { __builtin_amdgcn_s_setprio(1); _Pragma("unroll") for (int m = 0; m < 4; ++m) _Pragma("unroll") for (int n = 0; n < 2; ++n) _Pragma("unroll") for (int k = 0; k < 2; ++k) \
        acc[ai][bj][m][n] = __builtin_amdgcn_mfma_f32_16x16x32_bf16(Bt[n][k], At[m][k], acc[ai][bj][m][n], 0, 0, 0); __builtin_amdgcn_s_setprio(0); } while (0)
#define PG8_WAIT_V(n) asm volatile("s_waitcnt vmcnt(" #n ")" ::: "memory")
#define PG8_WAIT_L(n) asm volatile("s_waitcnt lgkmcnt(" #n ")" ::: "memory")
#define PG8_BAR __builtin_amdgcn_s_barrier()
#define PG8_SCHED __builtin_amdgcn_sched_barrier(0)
#define PG8_UA(u) ((const char*)g.A + ((size_t)(u).pm * BM * g.lda + (u).acol) * 2)
#define PG8_UB(u) ((const char*)g.Bt + (size_t)(u).brow * BM * K * 2)
    Unit cur, nxt; int ui = 0;
    if (!S.next(0, cur)) return;
    f32x4 acc[2][2][4][2];
#pragma unroll
    for (int a = 0; a < 2; ++a)
#pragma unroll
        for (int b = 0; b < 2; ++b)
#pragma unroll
            for (int m = 0; m < 4; ++m)
#pragma unroll
                for (int n = 0; n < 2; ++n) acc[a][b][m][n] = (f32x4){0.f, 0.f, 0.f, 0.f};
    bf16x8 At[4][2], B0[2][2], B1[2][2];
    const char* cA = PG8_UA(cur); const char* cB = PG8_UB(cur);
    PG8_STAGE(PG8_SB(0, 0), cB, voffB); PG8_STAGE(PG8_SB(0, 1), cB + hstepB, voffB); PG8_STAGE(PG8_SA(0, 0), cA, voffA); PG8_STAGE(PG8_SA(0, 1), cA + hstepA, voffA);
    if (wr == 1) PG8_BAR;
    PG8_WAIT_V(2); PG8_BAR;
    PG8_STAGE(PG8_SB(1, 0), cB + kstep, voffB); PG8_STAGE(PG8_SA(1, 0), cA + kstep, voffA); PG8_STAGE(PG8_SB(1, 1), cB + hstepB + kstep, voffB);
    PG8_WAIT_V(6); PG8_BAR;
    for (;;) {
        const bool has_next = S.next(ui + 1, nxt);
        const char* nA = has_next ? PG8_UA(nxt) : cA; const char* nB = has_next ? PG8_UB(nxt) : cB;
        for (int t = 0; t < nt; t += 2) {
            const bool last = (t == nt - 2);
            const char* a1 = cA + (size_t)(t + 1) * kstep;
            const char* a2 = last ? nA : cA + (size_t)(t + 2) * kstep; const char* b2 = last ? nB : cB + (size_t)(t + 2) * kstep;
            const char* a3 = a2 + kstep; const char* b3 = b2 + kstep;
            PG8_LDB(B0, 0, 0); PG8_LDB(B1, 0, 1); PG8_SCHED; PG8_LDA(At, 0, 0); PG8_STAGE(PG8_SA(1, 1), a1 + hstepA, voffA);
            PG8_WAIT_V(8); PG8_WAIT_L(0); PG8_BAR; PG8_MMA(0, 0, At, B0); PG8_MMA(0, 1, At, B1); PG8_BAR; PG8_SCHED;
            PG8_LDA(At, 0, 1); PG8_STAGE(PG8_SB(0, 0), b2, voffB); PG8_STAGE(PG8_SB(0, 1), b2 + hstepB, voffB); PG8_STAGE(PG8_SA(0, 0), a2, voffA);
            PG8_WAIT_V(8); PG8_WAIT_L(0); PG8_BAR; PG8_MMA(1, 0, At, B0); PG8_MMA(1, 1, At, B1); PG8_BAR; PG8_SCHED;
            PG8_LDB(B0, 1, 0); PG8_LDB(B1, 1, 1); PG8_SCHED; PG8_LDA(At, 1, 0); PG8_STAGE(PG8_SA(0, 1), a2 + hstepA, voffA);
            PG8_WAIT_V(8); PG8_WAIT_L(0); PG8_BAR; PG8_MMA(0, 0, At, B0); PG8_MMA(0, 1, At, B1); PG8_BAR; PG8_SCHED;
            PG8_LDA(At, 1, 1); PG8_STAGE(PG8_SB(1, 0), b3, voffB); PG8_STAGE(PG8_SB(1, 1), b3 + hstepB, voffB); PG8_STAGE(PG8_SA(1, 0), a3, voffA);
            PG8_WAIT_V(8); PG8_WAIT_L(0); PG8_BAR; PG8_MMA(1, 0, At, B0); PG8_MMA(1, 1, At, B1); PG8_BAR; PG8_SCHED;
        }
        if (wr == 0) PG8_BAR;
        E(acc, cur, wr, wc, fr, fq);
        if (!has_next) break;
#pragma unroll
        for (int a = 0; a < 2; ++a)
#pragma unroll
            for (int b = 0; b < 2; ++b)
#pragma unroll
                for (int m = 0; m < 4; ++m)
#pragma unroll
                    for (int n = 0; n < 2; ++n) acc[a][b][m][n] = (f32x4){0.f, 0.f, 0.f, 0.f};
        cur = nxt; cA = nA; cB = nB; ++ui;
        if (wr == 1) PG8_BAR;
    }
    PG8_WAIT_V(0);
    PG8_BAR;
#undef PG8_SA
#undef PG8_SB
#undef PG8_STAGE
#undef PG8_LDA
#undef PG8_LDB
#undef PG8_MMA
#undef PG8_WAIT_V
#undef PG8_WAIT_L
#undef PG8_BAR
#undef PG8_SCHED
#undef PG8_UA
#undef PG8_UB
}
}

template <class F>
__device__ __forceinline__ void big_gemm(LAS unsigned char* ldsb, const bf16_t* A, int lda, const bf16_t* Bt, int K, int N, const F& f) {
    pg8::Gemm g{A, Bt, lda, K}; pg8::StaticOrder S; S.init(RL, N, (int)gridDim.x, (int)blockIdx.x);
    pg8::Epi<F> E{f};
    pg8::gemm_phase(ldsb, g, S, E);
    __syncthreads();
}
template <int NI>
__device__ __forceinline__ void gemm_kloop(f32x4 (&acc)[4][NI], const bf16_t* Ag, int lda, const bf16_t* Bg, int ldb, int K, char* lds) {
    const int tid = tid_l(), lane = tid & 63, wid = tid >> 6, wm = wid >> 1, wn = wid & 1, lr = lane & 15, lq = lane >> 4;
    u32x4 ra[4], rb[NI];
    const int prow = tid >> 3, pkc = tid & 7;
    const bf16_t* ap = Ag + (size_t)prow * lda + pkc * 8;
    const bf16_t* bp = Bg + (size_t)prow * ldb + pkc * 8;
    const int soff = prow * 128 + ((pkc ^ (prow & 7)) << 4);
#pragma unroll
    for (int i = 0; i < 4; ++i) { ra[i] = *(const u32x4*)(ap + (size_t)(32 * i) * lda); if (i < NI) rb[i < NI ? i : 0] = *(const u32x4*)(bp + (size_t)(32 * i) * ldb); }
#pragma unroll
    for (int i = 0; i < 4; ++i) { *(u32x4*)(lds + soff + i * 4096) = ra[i]; if (i < NI) *(u32x4*)(lds + 32768 + soff + i * 4096) = rb[i < NI ? i : 0]; }
    __syncthreads();
    const int nk = K >> 6;
    for (int kt = 0; kt < nk; ++kt) {
        const int buf = kt & 1;
        if (kt + 1 < nk) {
#pragma unroll
            for (int i = 0; i < 4; ++i) { ra[i] = *(const u32x4*)(ap + (size_t)(32 * i) * lda + (kt + 1) * 64); if (i < NI) rb[i < NI ? i : 0] = *(const u32x4*)(bp + (size_t)(32 * i) * ldb + (kt + 1) * 64); }
        }
        const char* la = lds + buf * 16384; const char* lb = lds + 32768 + buf * 16384;
#pragma unroll
        for (int kk = 0; kk < 2; ++kk) {
            bf16x8 af[4], bfr[NI];
            const int chunk = kk * 4 + lq;
#pragma unroll
            for (int mi = 0; mi < 4; ++mi) { const int row = wm * 64 + mi * 16 + lr; af[mi] = *(const bf16x8*)(la + row * 128 + ((chunk ^ (row & 7)) << 4)); }
#pragma unroll
            for (int ni = 0; ni < NI; ++ni) { const int row = wn * (16 * NI) + ni * 16 + lr; bfr[ni] = *(const bf16x8*)(lb + row * 128 + ((chunk ^ (row & 7)) << 4)); }
#pragma unroll
            for (int mi = 0; mi < 4; ++mi)
#pragma unroll
                for (int ni = 0; ni < NI; ++ni) acc[mi][ni] = __builtin_amdgcn_mfma_f32_16x16x32_bf16(bfr[ni], af[mi], acc[mi][ni], 0, 0, 0);
        }
        if (kt + 1 < nk) {
            char* sa = lds + (buf ^ 1) * 16384 + soff;
#pragma unroll
            for (int i = 0; i < 4; ++i) { *(u32x4*)(sa + i * 4096) = ra[i]; if (i < NI) *(u32x4*)(sa + 32768 + i * 4096) = rb[i < NI ? i : 0]; }
        }
        __syncthreads();
    }
}

__device__ __forceinline__ void tile_of(int t, int Mt, int Nt, int& tm, int& tn) {
    const int per = 8 * Nt; const int p = t / per; const int r = t - p * per; const int pm = (Mt - 8 * p) < 8 ? (Mt - 8 * p) : 8;
    tm = 8 * p + r % pm; tn = r / pm;
}

template <int TYPE> struct MX {
    static constexpr int DK = TYPE == 1 ? 128 : 64;
    static constexpr int NOC = DK / 8;
    static constexpr int PITCH = TYPE == 1 ? 2048 : 1536;
    static constexpr int QOFF = 0;
    static constexpr int KOFF = TYPE == 1 ? 512 : 256;
    static constexpr int VOFF = TYPE == 1 ? 1024 : 512;
    static constexpr int GOFF = TYPE == 1 ? 1536 : 1024;
    static constexpr int QP = DK + 16;
};
constexpr int L_VT = 0;
constexpr int L_Q = 20480;
constexpr int L_CUM = 40960;
constexpr int L_ATT = 57344;
constexpr int L_SC = 67584;
constexpr int L_SA = 68096;

template <int TYPE>
__device__ __forceinline__ void load_qk8(const Params& P, int l, const bf16_t* pb, int b, int c, int t, int h, int oc, bool isk, float (&f)[8], const float* wpre = nullptr) {
    typedef MX<TYPE> M;
    const int coff = (isk ? M::KOFF : M::QOFF) + h * M::DK;
    const size_t rowi = (size_t)(rowbase(b, c) + t);
    if (TYPE == 0) {
        const u32x4 u = *(const u32x4*)(pb + rowi * M::PITCH + coff + oc * 8); UNPACK8(u, f);
    } else if (TYPE == 1) {
        const bool hp = (t > 0) || (c != 0 && c != 4), hn = (t < 63) || (c != 3 && c != NCH - 1);
        const bf16_t* p0 = pb + rowi * M::PITCH + coff + oc * 8;
        u32x4 u1 = *(const u32x4*)p0, u0 = (u32x4){0u, 0u, 0u, 0u}, u2 = (u32x4){0u, 0u, 0u, 0u};
        if (hp) u0 = *(const u32x4*)(p0 - M::PITCH);
        if (hn) u2 = *(const u32x4*)(p0 + M::PITCH);
        float a[8], m[8], n[8]; UNPACK8(u0, a); UNPACK8(u1, m); UNPACK8(u2, n);
        float w0[8], w1[8], w2[8];
        if (wpre) {
#pragma unroll
            for (int j = 0; j < 8; ++j) { w0[j] = wpre[j]; w1[j] = wpre[8 + j]; w2[j] = wpre[16 + j]; }
        } else {
            const float* cw = P.in[I_CONV] + (size_t)l * 3 * 1024 + (isk ? 512 : 0) + h * 128 + oc * 8;
            const f32x4 w0a = *(const f32x4*)cw, w0b = *(const f32x4*)(cw + 4), w1a = *(const f32x4*)(cw + 1024), w1b = *(const f32x4*)(cw + 1028), w2a = *(const f32x4*)(cw + 2048), w2b = *(const f32x4*)(cw + 2052);
            w0[0] = w0a.x; w0[1] = w0a.y; w0[2] = w0a.z; w0[3] = w0a.w; w0[4] = w0b.x; w0[5] = w0b.y; w0[6] = w0b.z; w0[7] = w0b.w;
            w1[0] = w1a.x; w1[1] = w1a.y; w1[2] = w1a.z; w1[3] = w1a.w; w1[4] = w1b.x; w1[5] = w1b.y; w1[6] = w1b.z; w1[7] = w1b.w;
            w2[0] = w2a.x; w2[1] = w2a.y; w2[2] = w2a.z; w2[3] = w2a.w; w2[4] = w2b.x; w2[5] = w2b.y; w2[6] = w2b.z; w2[7] = w2b.w;
        }
#pragma unroll
        for (int j = 0; j < 8; ++j) f[j] = siluf(w0[j] * a[j] + w1[j] * m[j] + w2[j] * n[j]);
    } else {
        if (c < 4) { const u32x4 u = *(const u32x4*)(pb + rowi * M::PITCH + coff + oc * 8); UNPACK8(u, f); }
        else {
            const int o4 = oc & 3;
            const u32x4 ua = *(const u32x4*)(pb + rowi * M::PITCH + coff + o4 * 8), ub = *(const u32x4*)(pb + rowi * M::PITCH + coff + 32 + o4 * 8);
            float x1[8], x2[8]; UNPACK8(ua, x1); UNPACK8(ub, x2);
            const float* tab = (const float*)(ws_l(P) + WS_ROPE);
            const float* cs = o4 < 2 ? tab + (c - 4) * 16 + o4 * 8 : tab + 4096 + t * 16 + (o4 - 2) * 8;
            const float* sn = o4 < 2 ? tab + 2048 + (c - 4) * 16 + o4 * 8 : tab + 4096 + 1024 + t * 16 + (o4 - 2) * 8;
            const f32x4 ca = *(const f32x4*)cs, cb = *(const f32x4*)(cs + 4), sa = *(const f32x4*)sn, sb = *(const f32x4*)(sn + 4);
            const float cv[8] = {ca.x, ca.y, ca.z, ca.w, cb.x, cb.y, cb.z, cb.w}, sv[8] = {sa.x, sa.y, sa.z, sa.w, sb.x, sb.y, sb.z, sb.w};
#pragma unroll
            for (int j = 0; j < 8; ++j) f[j] = oc < 4 ? x1[j] * cv[j] - x2[j] * sv[j] : x1[j] * sv[j] + x2[j] * cv[j];
        }
    }
}

__device__ __forceinline__ void load_convw(const Params& P, int l, int h, int oc, bool isk, float (&w)[24]) {
    const float* cw = P.in[I_CONV] + (size_t)l * 3 * 1024 + (isk ? 512 : 0) + h * 128 + oc * 8;
#pragma unroll
    for (int tp = 0; tp < 3; ++tp) { const f32x4 a = *(const f32x4*)(cw + tp * 1024), b = *(const f32x4*)(cw + tp * 1024 + 4);
        w[tp * 8 + 0] = a.x; w[tp * 8 + 1] = a.y; w[tp * 8 + 2] = a.z; w[tp * 8 + 3] = a.w; w[tp * 8 + 4] = b.x; w[tp * 8 + 5] = b.y; w[tp * 8 + 6] = b.z; w[tp * 8 + 7] = b.w; }
}
template <int TYPE>
__device__ __forceinline__ void decay_setup(const Params& P, int l, int b, int c, int h, int dir, char* lds, const float* apre = nullptr) {
    const int tid = tid_l(); const int r0 = rowbase(b, c);
    float* sc = (float*)(lds + L_SC);
    const float* small = (const float*)(ws_l(P) + WS_SMALL);
    if (TYPE == 0) {
        float* cum = (float*)(lds + L_CUM); float* sa = (float*)(lds + L_SA);
        if (apre) {
#pragma unroll
            for (int k = 0; k < 4; ++k) sa[tid + k * NTHR] = apre[k];
        } else {
            for (int i = tid; i < 1024; i += NTHR) sa[i] = small[(size_t)(r0 + (i >> 4)) * 48 + dir * 16 + (i & 15)];
        }
        __syncthreads();
        const int d = tid & 63, tq = tid >> 6;
        const float* a2 = P.in[I_A2] + ((size_t)(l * 2 + dir) * 16) * 256 + h * 64 + d;
        float w[16];
#pragma unroll
        for (int rr = 0; rr < 16; ++rr) w[rr] = a2[rr * 256];
        const float bias = P.in[I_ABIAS][(l * 2 + dir) * 256 + h * 64 + d];
        float* blk = sa;
        float lv[16];
#pragma unroll
        for (int i = 0; i < 16; ++i) {
            const int t = tq * 16 + i;
            float z = bias;
#pragma unroll
            for (int rr = 0; rr < 16; ++rr) z += sa[t * 16 + rr] * w[rr];
            lv[i] = logsig(z) * (1.f / 16.f);
        }
        if (dir == 0) {
#pragma unroll
            for (int i = 1; i < 16; ++i) lv[i] += lv[i - 1];
        } else {
#pragma unroll
            for (int i = 14; i >= 0; --i) lv[i] += lv[i + 1];
        }
        __syncthreads();
        blk[tq * 64 + d] = dir == 0 ? lv[15] : lv[0];
        __syncthreads();
        float off = 0.f;
#pragma unroll
        for (int q = 0; q < 4; ++q) if (dir == 0 ? (q < tq) : (q > tq)) off += blk[q * 64 + d];
#pragma unroll
        for (int i = 0; i < 16; ++i) cum[(tq * 16 + i) * 64 + d] = lv[i] + off;
    } else if (TYPE == 1) {
        if (tid < 64) {
            const float fg = small[(size_t)(r0 + tid) * 48 + 40 + dir * 4 + h] + P.in[I_FB][l * 8 + dir * 4 + h];
            float v = logsig(fg);
            if (dir == 0) {
#pragma unroll
                for (int o = 1; o < 64; o <<= 1) { const float n = __shfl_up(v, o); if (tid >= o) v += n; }
            } else {
#pragma unroll
                for (int o = 1; o < 64; o <<= 1) { const float n = __shfl_down(v, o); if (tid + o < 64) v += n; }
            }
            const float tot = __shfl(v, dir == 0 ? 63 : 0);
            sc[tid] = v;
            sc[64 + tid] = small[(size_t)(r0 + tid) * 48 + 32 + dir * 4 + h] + P.in[I_IB][l * 8 + dir * 4 + h];
            if (tid == 0) sc[128] = tot;
        }
    } else {
        if (tid < 64) {
            const float lg = logsig(P.in[I_RDL][l * 8 + dir * 4 + h]);
            sc[tid] = (dir == 0 ? (float)(tid + 1) : (float)(64 - tid)) * lg;
            if (tid == 0) sc[128] = 64.f * lg;
        }
    }
    __syncthreads();
}

template <int TYPE>
__device__ __forceinline__ void build_vT(const bf16_t* pb, int b, int c, int h, char* lds) {
    typedef MX<TYPE> M;
    bf16_t* vT = (bf16_t*)(lds + L_VT);
#pragma unroll
    for (int i = 0; i < 2; ++i) {
        const int pid = tid_l() + i * NTHR, tp = pid & 31, oc = pid >> 5;
        const bf16_t* p0 = pb + (size_t)(rowbase(b, c) + 2 * tp) * M::PITCH + M::VOFF + h * 128 + oc * 8;
        const u32x4 u0 = *(const u32x4*)p0, u1 = *(const u32x4*)(p0 + M::PITCH);
        unsigned* dst = (unsigned*)(vT + (size_t)(oc * 8) * 80 + 2 * tp);
        dst[0 * 40] = (u0.x & 0xffffu) | (u1.x << 16); dst[1 * 40] = (u0.x >> 16) | (u1.x & 0xffff0000u);
        dst[2 * 40] = (u0.y & 0xffffu) | (u1.y << 16); dst[3 * 40] = (u0.y >> 16) | (u1.y & 0xffff0000u);
        dst[4 * 40] = (u0.z & 0xffffu) | (u1.z << 16); dst[5 * 40] = (u0.z >> 16) | (u1.z & 0xffff0000u);
        dst[6 * 40] = (u0.w & 0xffffu) | (u1.w << 16); dst[7 * 40] = (u0.w >> 16) | (u1.w & 0xffff0000u);
    }
}

__device__ __forceinline__ int scan_index(int dir, int c) { return dir == 0 ? c : (c < 4 ? 3 - c : 135 - c); }

template <int TYPE>
__device__ __forceinline__ void u_phase(const Params& P, int l, char* lds) {
    typedef MX<TYPE> M; constexpr int DK = M::DK;
    const int tid = tid_l(), lane = tid & 63, wid = tid >> 6, lr = lane & 15, lq = lane >> 4;
    const bf16_t* pb = (const bf16_t*)(ws_l(P) + WS_PBUF);
    bf16_t* U = (bf16_t*)(ws_l(P) + WS_SBUF); float* DEC = (float*)(ws_l(P) + WS_DEC); float* UN = (float*)(ws_l(P) + WS_UN);
    bf16_t* vT = (bf16_t*)(lds + L_VT); bf16_t* kT = (bf16_t*)(lds + L_Q);
    const float* cum = (const float*)(lds + L_CUM); const float* sc = (const float*)(lds + L_SC);
    const int NU = NB * 4 * 2 * NCH, VG = vgrid(), slot = bid_l();
    for (int u0 = 0; u0 < NU; u0 += VG) {
        int unit = u0 + slot; if (unit >= NU) unit = NU - 1;
        const int c = unit % NCH; const int rest = unit / NCH; const int dir = rest & 1, h = (rest >> 1) & 3, b = rest >> 3;
        const int chain = (b * 4 + h) * 2 + dir, n = scan_index(dir, c);
        static_assert(TYPE == 0, "the scalar-decay branches use u_phase_s");
        float k0[8], k1[8], apre[4];
        { const int tp = tid & 31, oc = tid >> 5;
          load_qk8<TYPE>(P, l, pb, b, c, 2 * tp, h, oc, true, k0);
          load_qk8<TYPE>(P, l, pb, b, c, 2 * tp + 1, h, oc, true, k1);
          const float* small = (const float*)(ws_l(P) + WS_SMALL); const int r0 = rowbase(b, c);
#pragma unroll
          for (int k = 0; k < 4; ++k) { const int i = tid + k * NTHR; apre[k] = small[(size_t)(r0 + (i >> 4)) * 48 + dir * 16 + (i & 15)]; } }
        build_vT<TYPE>(pb, b, c, h, lds);
        decay_setup<TYPE>(P, l, b, c, h, dir, lds, apre);
        const int tlast = dir == 0 ? 63 : 0;
        {
            const int pid = tid, tp = pid & 31, oc = pid >> 5;
            unsigned* dst = (unsigned*)(kT + (size_t)(oc * 8) * 80 + 2 * tp);
            if (TYPE == 0) {
#pragma unroll
                for (int j = 0; j < 8; ++j) { const int d = oc * 8 + j; const float tot = cum[tlast * 64 + d];
                    dst[j * 40] = cvt_pk(k0[j] * __expf(tot - cum[(2 * tp) * 64 + d]), k1[j] * __expf(tot - cum[(2 * tp + 1) * 64 + d])); }
            } else {
                const float tot = sc[128];
                const float w0 = TYPE == 1 ? __expf(tot - sc[2 * tp] + sc[64 + 2 * tp]) * 0.08838834764831845f : __expf(tot - sc[2 * tp]) * 0.125f;
                const float w1 = TYPE == 1 ? __expf(tot - sc[2 * tp + 1] + sc[64 + 2 * tp + 1]) * 0.08838834764831845f : __expf(tot - sc[2 * tp + 1]) * 0.125f;
#pragma unroll
                for (int j = 0; j < 8; ++j) dst[j * 40] = cvt_pk(k0[j] * w0, k1[j] * w1);
            }
        }
        __syncthreads();
        f32x4 acc[2][DK / 16];
#pragma unroll
        for (int i = 0; i < 2; ++i)
#pragma unroll
            for (int nt = 0; nt < DK / 16; ++nt) acc[i][nt] = (f32x4){0.f, 0.f, 0.f, 0.f};
#pragma unroll
        for (int kk = 0; kk < 2; ++kk) {
            bf16x8 fv[2];
#pragma unroll
            for (int i = 0; i < 2; ++i) fv[i] = *(const bf16x8*)(vT + (size_t)((2 * wid + i) * 16 + lr) * 80 + kk * 32 + lq * 8);
#pragma unroll
            for (int nt = 0; nt < DK / 16; ++nt) {
                const bf16x8 fk = *(const bf16x8*)(kT + (size_t)(nt * 16 + lr) * 80 + kk * 32 + lq * 8);
#pragma unroll
                for (int i = 0; i < 2; ++i) acc[i][nt] = __builtin_amdgcn_mfma_f32_16x16x32_bf16(fk, fv[i], acc[i][nt], 0, 0, 0);
            }
        }
        bf16_t* ub = U + (size_t)(chain * NCH + n) * 128 * DK;
#pragma unroll
        for (int i = 0; i < 2; ++i)
#pragma unroll
            for (int nt = 0; nt < DK / 16; ++nt) {
                const int e = (2 * wid + i) * 16 + lr, d = nt * 16 + lq * 4;
                u32x2 o; o.x = cvt_pk(acc[i][nt].x, acc[i][nt].y); o.y = cvt_pk(acc[i][nt].z, acc[i][nt].w);
                *(u32x2*)(ub + (size_t)e * DK + d) = o;
            }
        if (tid < DK) {
            const float tot = TYPE == 0 ? cum[tlast * 64 + (tid & 63)] : sc[128];
            DEC[(size_t)(chain * NCH + n) * 128 + tid] = __expf(tot);
            if (TYPE == 1) {
                float s = 0.f;
#pragma unroll
                for (int q = 0; q < 8; ++q) { const u32x4 u = *(const u32x4*)(kT + (size_t)tid * 80 + q * 8); float f[8]; UNPACK8(u, f);
#pragma unroll
                    for (int j = 0; j < 8; ++j) s += f[j]; }
                UN[(size_t)(chain * NCH + n) * 128 + tid] = s;
            }
        }
        __syncthreads();
    }
}

template <int TYPE>
__device__ __forceinline__ void u_phase_s(const Params& P, int l, char* lds) {
    typedef MX<TYPE> M; constexpr int DK = M::DK; constexpr int NIT = M::NOC * 32 / NTHR;
    const int tid = tid_l(), lane = tid & 63, wid = tid >> 6, lr = lane & 15, lq = lane >> 4;
    const bf16_t* pb = (const bf16_t*)(ws_l(P) + WS_PBUF);
    const float* small = (const float*)(ws_l(P) + WS_SMALL);
    bf16_t* U = (bf16_t*)(ws_l(P) + WS_SBUF); float* DEC = (float*)(ws_l(P) + WS_DEC); float* UN = (float*)(ws_l(P) + WS_UN);
    bf16_t* vT = (bf16_t*)(lds + L_VT); bf16_t* kT0 = (bf16_t*)(lds + 20480); bf16_t* kT1 = (bf16_t*)(lds + 40960);
    float* sc = (float*)(lds + L_SC);
    const int NU = NB * 4 * NCH, VG = vgrid(), slot = bid_l();
    for (int u0 = 0; u0 < NU; u0 += VG) {
        int unit = u0 + slot; int dmask = 3;
        if (VG == 512 && u0 >= 1024) { if (slot >= 2 * (NU - 1024)) continue; unit = 1024 + (slot >> 1); dmask = 1 << (slot & 1); }
        else if (unit >= NU) unit = NU - 1;
        const int c = unit % NCH; const int rest = unit / NCH; const int h = rest & 3, b = rest >> 2;
        const int r0 = rowbase(b, c);
        float kv[NIT][2][8];
#pragma unroll
        for (int i = 0; i < NIT; ++i) {
            const int pid = tid + i * NTHR, tp = pid & 31, oc = pid >> 5;
            load_qk8<TYPE>(P, l, pb, b, c, 2 * tp, h, oc, true, kv[i][0]);
            load_qk8<TYPE>(P, l, pb, b, c, 2 * tp + 1, h, oc, true, kv[i][1]);
        }
        if (TYPE == 1) {
            if (tid < 128) {
                const int dir = tid >> 6, t = tid & 63;
                const float fg = small[(size_t)(r0 + t) * 48 + 40 + dir * 4 + h] + P.in[I_FB][l * 8 + dir * 4 + h];
                float v = logsig(fg);
                if (dir == 0) {
#pragma unroll
                    for (int o = 1; o < 64; o <<= 1) { const float n = __shfl_up(v, o); if (t >= o) v += n; }
                } else {
#pragma unroll
                    for (int o = 1; o < 64; o <<= 1) { const float n = __shfl_down(v, o); if (t + o < 64) v += n; }
                }
                sc[dir * 64 + t] = v;
                sc[128 + dir * 64 + t] = small[(size_t)(r0 + t) * 48 + 32 + dir * 4 + h] + P.in[I_IB][l * 8 + dir * 4 + h];
            }
        } else {
            if (tid < 64) {
                const float lg0 = logsig(P.in[I_RDL][l * 8 + h]), lg1 = logsig(P.in[I_RDL][l * 8 + 4 + h]);
                sc[tid] = (float)(tid + 1) * lg0; sc[64 + tid] = (float)(64 - tid) * lg1;
            }
        }
        build_vT<TYPE>(pb, b, c, h, lds);
        __syncthreads();
        const float totf = sc[63], totb = sc[64];
        const float ks = TYPE == 1 ? 0.08838834764831845f : 0.125f;
#pragma unroll
        for (int i = 0; i < NIT; ++i) {
            const int pid = tid + i * NTHR, tp = pid & 31, oc = pid >> 5;
            const int t0 = 2 * tp, t1 = 2 * tp + 1;
            const float wf0 = __expf(totf - sc[t0] + (TYPE == 1 ? sc[128 + t0] : 0.f)) * ks, wf1 = __expf(totf - sc[t1] + (TYPE == 1 ? sc[128 + t1] : 0.f)) * ks;
            const float wb0 = __expf(totb - sc[64 + t0] + (TYPE == 1 ? sc[192 + t0] : 0.f)) * ks, wb1 = __expf(totb - sc[64 + t1] + (TYPE == 1 ? sc[192 + t1] : 0.f)) * ks;
            unsigned* d0 = (unsigned*)(kT0 + (size_t)(oc * 8) * 80 + 2 * tp); unsigned* d1 = (unsigned*)(kT1 + (size_t)(oc * 8) * 80 + 2 * tp);
#pragma unroll
            for (int j = 0; j < 8; ++j) { d0[j * 40] = cvt_pk(kv[i][0][j] * wf0, kv[i][1][j] * wf1); d1[j * 40] = cvt_pk(kv[i][0][j] * wb0, kv[i][1][j] * wb1); }
        }
        __syncthreads();
        const int chf = (b * 4 + h) * 2;
#pragma unroll 1
        for (int dir = 0; dir < 2; ++dir) {
            if (!((dmask >> dir) & 1)) continue;
            const bf16_t* kT = dir == 0 ? kT0 : kT1;
            const int n = scan_index(dir, c);
            f32x4 acc[2][DK / 16];
#pragma unroll
            for (int i = 0; i < 2; ++i)
#pragma unroll
                for (int nt = 0; nt < DK / 16; ++nt) acc[i][nt] = (f32x4){0.f, 0.f, 0.f, 0.f};
#pragma unroll
            for (int kk = 0; kk < 2; ++kk) {
                bf16x8 fv[2];
#pragma unroll
                for (int i = 0; i < 2; ++i) fv[i] = *(const bf16x8*)(vT + (size_t)((2 * wid + i) * 16 + lr) * 80 + kk * 32 + lq * 8);
#pragma unroll
                for (int nt = 0; nt < DK / 16; ++nt) {
                    const bf16x8 fk = *(const bf16x8*)(kT + (size_t)(nt * 16 + lr) * 80 + kk * 32 + lq * 8);
#pragma unroll
                    for (int i = 0; i < 2; ++i) acc[i][nt] = __builtin_amdgcn_mfma_f32_16x16x32_bf16(fk, fv[i], acc[i][nt], 0, 0, 0);
                }
            }
            bf16_t* ub = U + (size_t)((chf + dir) * NCH + n) * 128 * DK;
#pragma unroll
            for (int i = 0; i < 2; ++i)
#pragma unroll
                for (int nt = 0; nt < DK / 16; ++nt) {
                    const int e = (2 * wid + i) * 16 + lr, d = nt * 16 + lq * 4;
                    u32x2 o; o.x = cvt_pk(acc[i][nt].x, acc[i][nt].y); o.y = cvt_pk(acc[i][nt].z, acc[i][nt].w);
                    *(u32x2*)(ub + (size_t)e * DK + d) = o;
                }
        }
        if (tid < 2 * DK) {
            const int dir = tid / DK, d = tid % DK; const int n = scan_index(dir, c);
            if ((dmask >> dir) & 1) {
            DEC[(size_t)((chf + dir) * NCH + n) * 128 + d] = __expf(dir == 0 ? totf : totb);
            if (TYPE == 1) {
                const bf16_t* kT = dir == 0 ? kT0 : kT1;
                float sum = 0.f;
#pragma unroll
                for (int q = 0; q < 8; ++q) { const u32x4 u = *(const u32x4*)(kT + (size_t)d * 80 + q * 8); float f[8]; UNPACK8(u, f);
#pragma unroll
                    for (int j = 0; j < 8; ++j) sum += f[j]; }
                UN[(size_t)((chf + dir) * NCH + n) * 128 + d] = sum;
            }
            }
        }
        __syncthreads();
    }
}

template <int DK, bool HASN>
__device__ __forceinline__ void scan_phase(const Params& P) {
    bf16_t* U = (bf16_t*)(ws_l(P) + WS_SBUF); const float* DEC = (const float*)(ws_l(P) + WS_DEC); float* UN = (float*)(ws_l(P) + WS_UN);
    constexpr int VEC = DK / 64;
    constexpr int DQ = DK / VEC; constexpr int TT = 16 * 128 * DQ;
    constexpr size_t US = (size_t)128 * DK;
    for (int g = bid_l() * NTHR + tid_l(); g < TT; g += vgrid() * NTHR) {
        const int dq = g % DQ, e = (g / DQ) % 128, chain = g / (DQ * 128);
        bf16_t* up = U + ((size_t)chain * NCH * 128 + e) * DK + dq * VEC;
        const float* dp = DEC + (size_t)chain * NCH * 128 + dq * VEC;
        float S0 = 0.f, S1 = 0.f;
        constexpr int SB = 12;
        unsigned ua[SB], ubv[SB]; f32x2 da[SB], db[SB];
#define SC_LOAD(uu, dd, n0) do { _Pragma("unroll") for (int j = 0; j < SB; ++j) { \
            if (VEC == 2) { uu[j] = *(const unsigned*)(up + (size_t)((n0) + j) * US); dd[j] = *(const f32x2*)(dp + (size_t)((n0) + j) * 128); } \
            else { uu[j] = (unsigned)up[(size_t)((n0) + j) * US]; dd[j].x = dp[(size_t)((n0) + j) * 128]; dd[j].y = 0.f; } } } while (0)
#define SC_STEP(uu, dd, n0) do { _Pragma("unroll") for (int j = 0; j < SB; ++j) { \
            if (VEC == 2) { *(unsigned*)(up + (size_t)((n0) + j) * US) = cvt_pk(S0, S1); S0 = dd[j].x * S0 + bflo(uu[j]); S1 = dd[j].y * S1 + bfhi(uu[j]); } \
            else { up[(size_t)((n0) + j) * US] = (bf16_t)(cvt_pk(S0, 0.f) & 0xffffu); S0 = dd[j].x * S0 + bflo(uu[j]); } } } while (0)
        SC_LOAD(ua, da, 0);
        for (int n0 = 0; n0 < 120; n0 += 24) {
            SC_LOAD(ubv, db, n0 + 12);
            SC_STEP(ua, da, n0);
            SC_LOAD(ua, da, n0 + 24);
            SC_STEP(ubv, db, n0 + 12);
        }
        SC_STEP(ua, da, 120);
#undef SC_LOAD
#undef SC_STEP
    }
    if (HASN) {
        for (int g = bid_l() * NTHR + tid_l(); g < 16 * 128; g += vgrid() * NTHR) {
            const int d = g & 127, chain = g >> 7;
            float* np = UN + (size_t)chain * NCH * 128 + d; const float* dp = DEC + (size_t)chain * NCH * 128 + d;
            float S = 0.f;
            float ua_[12], da_[12], ub_[12], db_[12];
#define NS_LOAD(uu, dd, n0) do { _Pragma("unroll") for (int j = 0; j < 12; ++j) { uu[j] = np[(size_t)((n0) + j) * 128]; dd[j] = dp[(size_t)((n0) + j) * 128]; } } while (0)
#define NS_STEP(uu, dd, n0) do { _Pragma("unroll") for (int j = 0; j < 12; ++j) { np[(size_t)((n0) + j) * 128] = S; S = dd[j] * S + uu[j]; } } while (0)
            NS_LOAD(ua_, da_, 0);
            for (int n0 = 0; n0 < 120; n0 += 24) {
                NS_LOAD(ub_, db_, n0 + 12);
                NS_STEP(ua_, da_, n0);
                NS_LOAD(ua_, da_, n0 + 24);
                NS_STEP(ub_, db_, n0 + 12);
            }
            NS_STEP(ua_, da_, 120);
#undef NS_LOAD
#undef NS_STEP
        }
    }
}

template <int TYPE>
__device__ __forceinline__ void out_phase(const Params& P, int l, int pass, bool latent_only, char* lds) {
    typedef MX<TYPE> M; constexpr int DK = M::DK; constexpr int QP = M::QP;
    const int tid = tid_l(), lane = tid & 63, wid = tid >> 6, lr = lane & 15, lq = lane >> 4;
    const bf16_t* pb = (const bf16_t*)(ws_l(P) + WS_PBUF);
    const bf16_t* U = (const bf16_t*)(ws_l(P) + WS_SBUF); const float* UN = (const float*)(ws_l(P) + WS_UN);
    bf16_t* brp = (bf16_t*)(ws_l(P) + WS_BR);
    bf16_t* vT = (bf16_t*)(lds + L_VT); bf16_t* qin = (bf16_t*)(lds + L_Q); bf16_t* kin = qin + 64 * QP; bf16_t* att = (bf16_t*)(lds + L_ATT);
    const float* cum = (const float*)(lds + L_CUM); const float* sc = (const float*)(lds + L_SC);
    const float* ng = P.in[TYPE == 0 ? I_GNG : (TYPE == 1 ? I_MNG : I_RNG)] + l * 512;
    const int NC = latent_only ? NCH - 4 : NCH; const int NU = NB * 4 * NC, VG = vgrid(), slot = bid_l();
    for (int u0 = 0; u0 < NU; u0 += VG) {
        int unit = u0 + slot; if (unit >= NU) unit = NU - 1;
        const int c = unit % NC + (latent_only ? 4 : 0); const int rest = unit / NC; const int h = rest & 3, b = rest >> 2;
        const int r0 = rowbase(b, c);
        build_vT<TYPE>(pb, b, c, h, lds);
        f32x4 tot[8];
#pragma unroll
        for (int et = 0; et < 8; ++et) tot[et] = (f32x4){0.f, 0.f, 0.f, 0.f};
        const int trow = wid * 16 + lr;
        for (int dir = 0; dir < 2; ++dir) {
            const int chain = (b * 4 + h) * 2 + dir, n = scan_index(dir, c);
            decay_setup<TYPE>(P, l, b, c, h, dir, lds);
#pragma unroll 2
            for (int i = 0; i < 64 * M::NOC / NTHR; ++i) {
                const int pid = tid + i * NTHR, t = pid / M::NOC, oc = pid % M::NOC;
                float q8[8], k8[8];
                load_qk8<TYPE>(P, l, pb, b, c, t, h, oc, false, q8);
                load_qk8<TYPE>(P, l, pb, b, c, t, h, oc, true, k8);
                if (TYPE == 0) {
#pragma unroll
                    for (int j = 0; j < 8; ++j) { const float cv = cum[t * 64 + oc * 8 + j]; q8[j] *= __expf(cv) * 0.125f; k8[j] *= __expf(-cv); }
                } else {
                    const float cv = sc[t];
                    const float wq = __expf(cv);
                    const float wk = TYPE == 1 ? __expf(sc[64 + t] - cv) * 0.08838834764831845f : __expf(-cv) * 0.125f;
#pragma unroll
                    for (int j = 0; j < 8; ++j) { q8[j] *= wq; k8[j] *= wk; }
                }
                u32x4 oq, ok;
                oq.x = cvt_pk(q8[0], q8[1]); oq.y = cvt_pk(q8[2], q8[3]); oq.z = cvt_pk(q8[4], q8[5]); oq.w = cvt_pk(q8[6], q8[7]);
                ok.x = cvt_pk(k8[0], k8[1]); ok.y = cvt_pk(k8[2], k8[3]); ok.z = cvt_pk(k8[4], k8[5]); ok.w = cvt_pk(k8[6], k8[7]);
                *(u32x4*)(qin + (size_t)t * QP + oc * 8) = oq;
                *(u32x4*)(kin + (size_t)t * QP + oc * 8) = ok;
            }
            __syncthreads();
            f32x4 sacc[4];
#pragma unroll
            for (int nt = 0; nt < 4; ++nt) sacc[nt] = (f32x4){0.f, 0.f, 0.f, 0.f};
#pragma unroll
            for (int kk = 0; kk < DK / 32; ++kk) {
                const bf16x8 fq = *(const bf16x8*)(qin + (size_t)trow * QP + kk * 32 + lq * 8);
#pragma unroll
                for (int nt = 0; nt < 4; ++nt) {
                    const bf16x8 fk = *(const bf16x8*)(kin + (size_t)(nt * 16 + lr) * QP + kk * 32 + lq * 8);
                    sacc[nt] = __builtin_amdgcn_mfma_f32_16x16x32_bf16(fk, fq, sacc[nt], 0, 0, 0);
                }
            }
            float den = 0.f;
#pragma unroll
            for (int nt = 0; nt < 4; ++nt) {
                const int s0 = nt * 16 + lq * 4;
                float a0 = sacc[nt].x, a1 = sacc[nt].y, a2 = sacc[nt].z, a3 = sacc[nt].w;
                if (dir == 0) { if (s0 + 0 > trow) a0 = 0.f; if (s0 + 1 > trow) a1 = 0.f; if (s0 + 2 > trow) a2 = 0.f; if (s0 + 3 > trow) a3 = 0.f; }
                else { if (s0 + 0 < trow) a0 = 0.f; if (s0 + 1 < trow) a1 = 0.f; if (s0 + 2 < trow) a2 = 0.f; if (s0 + 3 < trow) a3 = 0.f; }
                den += (a0 + a1) + (a2 + a3);
                u32x2 o; o.x = cvt_pk(a0, a1); o.y = cvt_pk(a2, a3);
                *(u32x2*)(att + (size_t)trow * 80 + s0) = o;
            }
            __syncthreads();
            f32x4 oacc[8];
#pragma unroll
            for (int et = 0; et < 8; ++et) oacc[et] = (f32x4){0.f, 0.f, 0.f, 0.f};
#pragma unroll
            for (int kk = 0; kk < 2; ++kk) {
                const bf16x8 fa = *(const bf16x8*)(att + (size_t)trow * 80 + kk * 32 + lq * 8);
#pragma unroll
                for (int et = 0; et < 8; ++et) {
                    const bf16x8 fv = *(const bf16x8*)(vT + (size_t)(et * 16 + lr) * 80 + kk * 32 + lq * 8);
                    oacc[et] = __builtin_amdgcn_mfma_f32_16x16x32_bf16(fv, fa, oacc[et], 0, 0, 0);
                }
            }
            const bf16_t* sp = U + (size_t)(chain * NCH + n) * 128 * DK;
#pragma unroll
            for (int kk = 0; kk < DK / 32; ++kk) {
                const bf16x8 fq = *(const bf16x8*)(qin + (size_t)trow * QP + kk * 32 + lq * 8);
#pragma unroll
                for (int et = 0; et < 8; ++et) {
                    const bf16x8 fs = *(const bf16x8*)(sp + (size_t)(et * 16 + lr) * DK + kk * 32 + lq * 8);
                    oacc[et] = __builtin_amdgcn_mfma_f32_16x16x32_bf16(fs, fq, oacc[et], 0, 0, 0);
                }
            }
            if (TYPE == 1) {
                const float* np = UN + (size_t)(chain * NCH + n) * 128 + lq * 32;
#pragma unroll
                for (int q = 0; q < 4; ++q) {
                    const u32x4 u = *(const u32x4*)(qin + (size_t)trow * QP + lq * 32 + q * 8); float f[8]; UNPACK8(u, f);
                    const f32x4 n0 = *(const f32x4*)(np + q * 8), n1 = *(const f32x4*)(np + q * 8 + 4);
                    den += f[0] * n0.x + f[1] * n0.y + f[2] * n0.z + f[3] * n0.w + f[4] * n1.x + f[5] * n1.y + f[6] * n1.z + f[7] * n1.w;
                }
                den += __shfl_xor(den, 16); den += __shfl_xor(den, 32);
                const float sc1 = 1.f / fmaxf(fabsf(den), 1.f);
#pragma unroll
                for (int et = 0; et < 8; ++et) tot[et] += oacc[et] * sc1;
            } else {
#pragma unroll
                for (int et = 0; et < 8; ++et) tot[et] += oacc[et];
            }
            __syncthreads();
        }
        float s1 = 0.f;
#pragma unroll
        for (int et = 0; et < 8; ++et) s1 += (tot[et].x + tot[et].y) + (tot[et].z + tot[et].w);
        s1 += __shfl_xor(s1, 16); s1 += __shfl_xor(s1, 32);
        const float mean = TYPE == 0 ? 0.f : s1 * (1.f / 128.f);
        float s2 = 0.f;
#pragma unroll
        for (int et = 0; et < 8; ++et) { tot[et] = tot[et] - mean; s2 += (tot[et].x * tot[et].x + tot[et].y * tot[et].y) + (tot[et].z * tot[et].z + tot[et].w * tot[et].w); }
        s2 += __shfl_xor(s2, 16); s2 += __shfl_xor(s2, 32);
        const float rstd = rsqrtf(s2 * (1.f / 128.f) + 1e-6f);
        const size_t rowi = (size_t)(r0 + trow);
#pragma unroll
        for (int et = 0; et < 8; ++et) {
            const int e = et * 16 + lq * 4;
            const f32x4 gg = *(const f32x4*)(ng + h * 128 + e);
            const u32x2 gu = *(const u32x2*)(pb + rowi * M::PITCH + M::GOFF + h * 128 + e);
            const float g0 = bflo(gu.x), g1 = bfhi(gu.x), g2 = bflo(gu.y), g3 = bfhi(gu.y);
            u32x2 o;
            float y0 = tot[et].x * rstd * gg.x * siluf(g0), y1 = tot[et].y * rstd * gg.y * siluf(g1), y2 = tot[et].z * rstd * gg.z * siluf(g2), y3 = tot[et].w * rstd * gg.w * siluf(g3);
            o.x = cvt_pk(y0, y1); o.y = cvt_pk(y2, y3);
            *(u32x2*)(brp + rowi * 1536 + pass * 512 + h * 128 + e) = o;
        }
        __syncthreads();
    }
}

template <int TYPE>
__device__ __forceinline__ void out_phase_s(const Params& P, int l, int pass, bool latent_only, char* lds) {
    typedef MX<TYPE> M; constexpr int DK = M::DK; constexpr int QP = M::QP; constexpr int NKK = DK / 32;
    const bf16_t* pb = (const bf16_t*)(ws_l(P) + WS_PBUF);
    const bf16_t* U = (const bf16_t*)(ws_l(P) + WS_SBUF); const float* UN = (const float*)(ws_l(P) + WS_UN);
    const float* small = (const float*)(ws_l(P) + WS_SMALL);
    bf16_t* brp = (bf16_t*)(ws_l(P) + WS_BR);
    bf16_t* vT = (bf16_t*)(lds + L_VT); bf16_t* qr = (bf16_t*)(lds + L_Q); bf16_t* kr = qr + 64 * QP; bf16_t* att = (bf16_t*)(lds + L_ATT);
    float* sc = (float*)(lds + L_SC);
    float* sn = sc + 256;
    float* rsv = sc + 512;
    float* part = sc + 640;
    const float* ng = P.in[TYPE == 1 ? I_MNG : I_RNG] + l * 512;
    const int NC = latent_only ? NCH - 4 : NCH; const int NU = NB * 4 * NC, VG = vgrid(), slot = bid_l();
    for (int u0 = 0; u0 < NU; u0 += VG) {
        int unit = u0 + slot; if (unit >= NU) unit = NU - 1;
        const int tid = tid_l(), lane = tid & 63, wid = tid >> 6, lr = lane & 15, lq = lane >> 4;
        const int c = unit % NC + (latent_only ? 4 : 0); const int rest = unit / NC; const int h = rest & 3, b = rest >> 2;
        const int r0 = rowbase(b, c);
        const int trow = wid * 16 + lr;
        const int chf = (b * 4 + h) * 2, nf = scan_index(0, c), nb = scan_index(1, c);
        const bf16_t* spf = U + (size_t)(chf * NCH + nf) * 128 * DK; const bf16_t* spb = U + (size_t)((chf + 1) * NCH + nb) * 128 * DK;
        bf16x8 fsf[2][NKK], fsb[2][NKK];
#pragma unroll
        for (int i = 0; i < 2; ++i)
#pragma unroll
            for (int kk = 0; kk < NKK; ++kk) {
                fsf[i][kk] = *(const bf16x8*)(spf + (size_t)((2 * wid + i) * 16 + lr) * DK + kk * 32 + lq * 8);
                fsb[i][kk] = *(const bf16x8*)(spb + (size_t)((2 * wid + i) * 16 + lr) * DK + kk * 32 + lq * 8);
            }
        u32x2 gu[4][2];
#pragma unroll
        for (int mt = 0; mt < 4; ++mt)
#pragma unroll
            for (int i = 0; i < 2; ++i) gu[mt][i] = *(const u32x2*)(pb + (size_t)(r0 + mt * 16 + lr) * M::PITCH + M::GOFF + h * 128 + (2 * wid + i) * 16 + lq * 4);
        if (TYPE == 1) {
            sn[tid] = UN[(size_t)((chf + (tid >> 7)) * NCH + ((tid >> 7) == 0 ? nf : nb)) * 128 + (tid & 127)];
            if (tid < 128) {
                const int dir = tid >> 6, t = tid & 63;
                const float fg = small[(size_t)(r0 + t) * 48 + 40 + dir * 4 + h] + P.in[I_FB][l * 8 + dir * 4 + h];
                float v = logsig(fg);
                if (dir == 0) {
#pragma unroll
                    for (int o = 1; o < 64; o <<= 1) { const float n = __shfl_up(v, o); if (t >= o) v += n; }
                } else {
#pragma unroll
                    for (int o = 1; o < 64; o <<= 1) { const float n = __shfl_down(v, o); if (t + o < 64) v += n; }
                }
                sc[dir * 64 + t] = v;
                sc[128 + dir * 64 + t] = small[(size_t)(r0 + t) * 48 + 32 + dir * 4 + h] + P.in[I_IB][l * 8 + dir * 4 + h];
            }
        } else {
            if (tid < 64) {
                const float lg0 = logsig(P.in[I_RDL][l * 8 + h]), lg1 = logsig(P.in[I_RDL][l * 8 + 4 + h]);
                sc[tid] = (float)(tid + 1) * lg0; sc[64 + tid] = (float)(64 - tid) * lg1;
            }
        }
        float wq[24], wk[24];
        if (TYPE == 1) { load_convw(P, l, h, tid % M::NOC, false, wq); load_convw(P, l, h, tid % M::NOC, true, wk); }
        build_vT<TYPE>(pb, b, c, h, lds);
#pragma unroll
        for (int i = 0; i < 64 * M::NOC / NTHR; ++i) {
            const int pid = tid + i * NTHR, t = pid / M::NOC, oc = pid % M::NOC;
            float q8[8], k8[8];
            load_qk8<TYPE>(P, l, pb, b, c, t, h, oc, false, q8, TYPE == 1 ? wq : nullptr);
            load_qk8<TYPE>(P, l, pb, b, c, t, h, oc, true, k8, TYPE == 1 ? wk : nullptr);
            const float ks = TYPE == 1 ? 0.08838834764831845f : 0.125f;
            u32x4 oq, ok;
            oq.x = cvt_pk(q8[0], q8[1]); oq.y = cvt_pk(q8[2], q8[3]); oq.z = cvt_pk(q8[4], q8[5]); oq.w = cvt_pk(q8[6], q8[7]);
            ok.x = cvt_pk(k8[0] * ks, k8[1] * ks); ok.y = cvt_pk(k8[2] * ks, k8[3] * ks); ok.z = cvt_pk(k8[4] * ks, k8[5] * ks); ok.w = cvt_pk(k8[6] * ks, k8[7] * ks);
            *(u32x4*)(qr + (size_t)t * QP + oc * 8) = oq;
            *(u32x4*)(kr + (size_t)t * QP + oc * 8) = ok;
        }
        __syncthreads();
        f32x4 sacc[4];
#pragma unroll
        for (int nt = 0; nt < 4; ++nt) sacc[nt] = (f32x4){0.f, 0.f, 0.f, 0.f};
#pragma unroll
        for (int kk = 0; kk < NKK; ++kk) {
            const bf16x8 fq = *(const bf16x8*)(qr + (size_t)trow * QP + kk * 32 + lq * 8);
#pragma unroll
            for (int nt = 0; nt < 4; ++nt) {
                const bf16x8 fk = *(const bf16x8*)(kr + (size_t)(nt * 16 + lr) * QP + kk * 32 + lq * 8);
                sacc[nt] = __builtin_amdgcn_mfma_f32_16x16x32_bf16(fk, fq, sacc[nt], 0, 0, 0);
            }
        }
        {
            const float cft = sc[trow], cbt = sc[64 + trow];
            const float eft = __expf(cft), ebt = __expf(cbt);
            float af[4][4], ab[4][4]; float denf = 0.f, denb = 0.f;
#pragma unroll
            for (int nt = 0; nt < 4; ++nt) {
                const float av[4] = {sacc[nt].x, sacc[nt].y, sacc[nt].z, sacc[nt].w};
#pragma unroll
                for (int r = 0; r < 4; ++r) {
                    const int s_ = nt * 16 + lq * 4 + r;
                    const float argf = cft - sc[s_] + (TYPE == 1 ? sc[128 + s_] : 0.f), argb = cbt - sc[64 + s_] + (TYPE == 1 ? sc[192 + s_] : 0.f);
                    const float wf = s_ <= trow ? __expf(argf) : 0.f, wb = s_ >= trow ? __expf(argb) : 0.f;
                    af[nt][r] = av[r] * wf; ab[nt][r] = av[r] * wb; denf += af[nt][r]; denb += ab[nt][r];
                }
            }
            float scf = 1.f, scb = 1.f;
            if (TYPE == 1) {
                float qf = 0.f, qb = 0.f;
#pragma unroll
                for (int q = 0; q < 4; ++q) {
                    const u32x4 u = *(const u32x4*)(qr + (size_t)trow * QP + lq * 32 + q * 8); float f[8]; UNPACK8(u, f);
                    const float* a = sn + lq * 32 + q * 8; const float* bq = sn + 128 + lq * 32 + q * 8;
                    const f32x4 a0 = *(const f32x4*)a, a1 = *(const f32x4*)(a + 4), b0 = *(const f32x4*)bq, b1 = *(const f32x4*)(bq + 4);
                    qf += f[0] * a0.x + f[1] * a0.y + f[2] * a0.z + f[3] * a0.w + f[4] * a1.x + f[5] * a1.y + f[6] * a1.z + f[7] * a1.w;
                    qb += f[0] * b0.x + f[1] * b0.y + f[2] * b0.z + f[3] * b0.w + f[4] * b1.x + f[5] * b1.y + f[6] * b1.z + f[7] * b1.w;
                }
                denf += eft * qf; denb += ebt * qb;
                denf += __shfl_xor(denf, 16); denf += __shfl_xor(denf, 32);
                denb += __shfl_xor(denb, 16); denb += __shfl_xor(denb, 32);
                scf = 1.f / fmaxf(fabsf(denf), 1.f); scb = 1.f / fmaxf(fabsf(denb), 1.f);
            }
#pragma unroll
            for (int nt = 0; nt < 4; ++nt) {
                u32x2 o; o.x = cvt_pk(af[nt][0] * scf + ab[nt][0] * scb, af[nt][1] * scf + ab[nt][1] * scb); o.y = cvt_pk(af[nt][2] * scf + ab[nt][2] * scb, af[nt][3] * scf + ab[nt][3] * scb);
                *(u32x2*)(att + (size_t)trow * 80 + nt * 16 + lq * 4) = o;
            }
            if (lq == 0) { rsv[trow] = eft * scf; rsv[64 + trow] = ebt * scb; }
        }
        __syncthreads();
        f32x4 oacc[4][2];
#pragma unroll
        for (int mt = 0; mt < 4; ++mt)
#pragma unroll
            for (int i = 0; i < 2; ++i) oacc[mt][i] = (f32x4){0.f, 0.f, 0.f, 0.f};
#pragma unroll
        for (int kk = 0; kk < 2; ++kk) {
            bf16x8 fv[2];
#pragma unroll
            for (int i = 0; i < 2; ++i) fv[i] = *(const bf16x8*)(vT + (size_t)((2 * wid + i) * 16 + lr) * 80 + kk * 32 + lq * 8);
#pragma unroll
            for (int mt = 0; mt < 4; ++mt) {
                const bf16x8 fa = *(const bf16x8*)(att + (size_t)(mt * 16 + lr) * 80 + kk * 32 + lq * 8);
#pragma unroll
                for (int i = 0; i < 2; ++i) oacc[mt][i] = __builtin_amdgcn_mfma_f32_16x16x32_bf16(fv[i], fa, oacc[mt][i], 0, 0, 0);
            }
        }
#pragma unroll
        for (int dir = 0; dir < 2; ++dir) {
            f32x4 tmp[4][2];
#pragma unroll
            for (int mt = 0; mt < 4; ++mt)
#pragma unroll
                for (int i = 0; i < 2; ++i) tmp[mt][i] = (f32x4){0.f, 0.f, 0.f, 0.f};
#pragma unroll
            for (int kk = 0; kk < NKK; ++kk)
#pragma unroll
                for (int mt = 0; mt < 4; ++mt) {
                    const bf16x8 fq = *(const bf16x8*)(qr + (size_t)(mt * 16 + lr) * QP + kk * 32 + lq * 8);
#pragma unroll
                    for (int i = 0; i < 2; ++i) tmp[mt][i] = __builtin_amdgcn_mfma_f32_16x16x32_bf16(dir == 0 ? fsf[i][kk] : fsb[i][kk], fq, tmp[mt][i], 0, 0, 0);
                }
#pragma unroll
            for (int mt = 0; mt < 4; ++mt) {
                const float rs = rsv[dir * 64 + mt * 16 + lr];
#pragma unroll
                for (int i = 0; i < 2; ++i) oacc[mt][i] += tmp[mt][i] * rs;
            }
        }
#pragma unroll
        for (int mt = 0; mt < 4; ++mt) {
            float s1 = (oacc[mt][0].x + oacc[mt][0].y) + (oacc[mt][0].z + oacc[mt][0].w) + (oacc[mt][1].x + oacc[mt][1].y) + (oacc[mt][1].z + oacc[mt][1].w);
            float s2 = (oacc[mt][0].x * oacc[mt][0].x + oacc[mt][0].y * oacc[mt][0].y) + (oacc[mt][0].z * oacc[mt][0].z + oacc[mt][0].w * oacc[mt][0].w)
                     + (oacc[mt][1].x * oacc[mt][1].x + oacc[mt][1].y * oacc[mt][1].y) + (oacc[mt][1].z * oacc[mt][1].z + oacc[mt][1].w * oacc[mt][1].w);
            s1 += __shfl_xor(s1, 16); s1 += __shfl_xor(s1, 32); s2 += __shfl_xor(s2, 16); s2 += __shfl_xor(s2, 32);
            if (lq == 0) { part[(wid * 64 + mt * 16 + lr) * 2] = s1; part[(wid * 64 + mt * 16 + lr) * 2 + 1] = s2; }
        }
        __syncthreads();
#pragma unroll
        for (int mt = 0; mt < 4; ++mt) {
            const int t = mt * 16 + lr;
            float s1 = 0.f, s2 = 0.f;
#pragma unroll
            for (int w = 0; w < 4; ++w) { s1 += part[(w * 64 + t) * 2]; s2 += part[(w * 64 + t) * 2 + 1]; }
            const float mean = s1 * (1.f / 128.f);
            const float rstd = rsqrtf(fmaxf(s2 * (1.f / 128.f) - mean * mean, 0.f) + 1e-6f);
            const size_t rowi = (size_t)(r0 + t);
#pragma unroll
            for (int i = 0; i < 2; ++i) {
                const int e = (2 * wid + i) * 16 + lq * 4;
                const f32x4 gg = *(const f32x4*)(ng + h * 128 + e);
                const float g0 = bflo(gu[mt][i].x), g1 = bfhi(gu[mt][i].x), g2 = bflo(gu[mt][i].y), g3 = bfhi(gu[mt][i].y);
                u32x2 o;
                o.x = cvt_pk((oacc[mt][i].x - mean) * rstd * gg.x * siluf(g0), (oacc[mt][i].y - mean) * rstd * gg.y * siluf(g1));
                o.y = cvt_pk((oacc[mt][i].z - mean) * rstd * gg.z * siluf(g2), (oacc[mt][i].w - mean) * rstd * gg.w * siluf(g3));
                *(u32x2*)(brp + rowi * 1536 + pass * 512 + h * 128 + e) = o;
            }
        }
        __syncthreads();
    }
}

__device__ __forceinline__ void out_phase_g(const Params& P, int l, bool latent_only, char* lds) {
    typedef MX<0> M; constexpr int DK = 64, QP = 80;
    const bf16_t* pb = (const bf16_t*)(ws_l(P) + WS_PBUF);
    const bf16_t* U = (const bf16_t*)(ws_l(P) + WS_SBUF);
    const float* small = (const float*)(ws_l(P) + WS_SMALL);
    bf16_t* brp = (bf16_t*)(ws_l(P) + WS_BR);
    bf16_t* vT = (bf16_t*)(lds + L_VT); bf16_t* qin = (bf16_t*)(lds + L_Q); bf16_t* kin = qin + 64 * QP; bf16_t* att = (bf16_t*)(lds + L_ATT);
    float* cum = (float*)(lds + L_CUM); float* part = cum;
    const float* ng = P.in[I_GNG] + l * 512;
    const int NC = latent_only ? NCH - 4 : NCH; const int NU = NB * 4 * NC, VG = vgrid(), slot = bid_l();
    for (int u0 = 0; u0 < NU; u0 += VG) {
        int unit = u0 + slot; if (unit >= NU) unit = NU - 1;
        const int tid = tid_l(), lane = tid & 63, wid = tid >> 6, lr = lane & 15, lq = lane >> 4;
        const int c = unit % NC + (latent_only ? 4 : 0); const int rest = unit / NC; const int h = rest & 3, b = rest >> 2;
        const int r0 = rowbase(b, c);
        const int trow = wid * 16 + lr;
        const int chf = (b * 4 + h) * 2, nf = scan_index(0, c), nb = scan_index(1, c);
        const bf16_t* spf = U + (size_t)(chf * NCH + nf) * 128 * DK; const bf16_t* spb = U + (size_t)((chf + 1) * NCH + nb) * 128 * DK;
        bf16x8 fsf[2][2], fsb[2][2];
#pragma unroll
        for (int i = 0; i < 2; ++i)
#pragma unroll
            for (int kk = 0; kk < 2; ++kk) {
                fsf[i][kk] = *(const bf16x8*)(spf + (size_t)((2 * wid + i) * 16 + lr) * DK + kk * 32 + lq * 8);
                fsb[i][kk] = *(const bf16x8*)(spb + (size_t)((2 * wid + i) * 16 + lr) * DK + kk * 32 + lq * 8);
            }
        u32x2 gu[4][2];
#pragma unroll
        for (int mt = 0; mt < 4; ++mt)
#pragma unroll
            for (int i = 0; i < 2; ++i) gu[mt][i] = *(const u32x2*)(pb + (size_t)(r0 + mt * 16 + lr) * M::PITCH + M::GOFF + h * 128 + (2 * wid + i) * 16 + lq * 4);
        float qraw[2][8], kraw[2][8], apre[2][4];
#pragma unroll
        for (int i = 0; i < 2; ++i) {
            const int pid = tid + i * NTHR, t = pid >> 3, oc = pid & 7;
            load_qk8<0>(P, l, pb, b, c, t, h, oc, false, qraw[i]);
            load_qk8<0>(P, l, pb, b, c, t, h, oc, true, kraw[i]);
        }
#pragma unroll
        for (int dir = 0; dir < 2; ++dir)
#pragma unroll
            for (int k = 0; k < 4; ++k) { const int i = tid + k * NTHR; apre[dir][k] = small[(size_t)(r0 + (i >> 4)) * 48 + dir * 16 + (i & 15)]; }
        build_vT<0>(pb, b, c, h, lds);
        f32x4 oacc[4][2];
#pragma unroll
        for (int mt = 0; mt < 4; ++mt)
#pragma unroll
            for (int i = 0; i < 2; ++i) oacc[mt][i] = (f32x4){0.f, 0.f, 0.f, 0.f};
#pragma unroll
        for (int dir = 0; dir < 2; ++dir) {
            decay_setup<0>(P, l, b, c, h, dir, lds, apre[dir]);
#pragma unroll
            for (int i = 0; i < 2; ++i) {
                const int pid = tid + i * NTHR, t = pid >> 3, oc = pid & 7;
                float q8[8], k8[8];
#pragma unroll
                for (int j = 0; j < 8; ++j) { const float cv = cum[t * 64 + oc * 8 + j]; q8[j] = qraw[i][j] * (__expf(cv) * 0.125f); k8[j] = kraw[i][j] * __expf(-cv); }
                u32x4 oq, ok;
                oq.x = cvt_pk(q8[0], q8[1]); oq.y = cvt_pk(q8[2], q8[3]); oq.z = cvt_pk(q8[4], q8[5]); oq.w = cvt_pk(q8[6], q8[7]);
                ok.x = cvt_pk(k8[0], k8[1]); ok.y = cvt_pk(k8[2], k8[3]); ok.z = cvt_pk(k8[4], k8[5]); ok.w = cvt_pk(k8[6], k8[7]);
                *(u32x4*)(qin + (size_t)t * QP + oc * 8) = oq;
                *(u32x4*)(kin + (size_t)t * QP + oc * 8) = ok;
            }
            __syncthreads();
            f32x4 sacc[4];
#pragma unroll
            for (int nt = 0; nt < 4; ++nt) sacc[nt] = (f32x4){0.f, 0.f, 0.f, 0.f};
#pragma unroll
            for (int kk = 0; kk < 2; ++kk) {
                const bf16x8 fq = *(const bf16x8*)(qin + (size_t)trow * QP + kk * 32 + lq * 8);
#pragma unroll
                for (int nt = 0; nt < 4; ++nt) {
                    const bf16x8 fk = *(const bf16x8*)(kin + (size_t)(nt * 16 + lr) * QP + kk * 32 + lq * 8);
                    sacc[nt] = __builtin_amdgcn_mfma_f32_16x16x32_bf16(fk, fq, sacc[nt], 0, 0, 0);
                }
            }
#pragma unroll
            for (int nt = 0; nt < 4; ++nt) {
                const int s0 = nt * 16 + lq * 4;
                float a0 = sacc[nt].x, a1 = sacc[nt].y, a2 = sacc[nt].z, a3 = sacc[nt].w;
                if (dir == 0) { if (s0 + 0 > trow) a0 = 0.f; if (s0 + 1 > trow) a1 = 0.f; if (s0 + 2 > trow) a2 = 0.f; if (s0 + 3 > trow) a3 = 0.f; }
                else { if (s0 + 0 < trow) a0 = 0.f; if (s0 + 1 < trow) a1 = 0.f; if (s0 + 2 < trow) a2 = 0.f; if (s0 + 3 < trow) a3 = 0.f; }
                u32x2 o; o.x = cvt_pk(a0, a1); o.y = cvt_pk(a2, a3);
                *(u32x2*)(att + (size_t)trow * 80 + s0) = o;
            }
            __syncthreads();
#pragma unroll
            for (int kk = 0; kk < 2; ++kk) {
                bf16x8 fv[2];
#pragma unroll
                for (int i = 0; i < 2; ++i) fv[i] = *(const bf16x8*)(vT + (size_t)((2 * wid + i) * 16 + lr) * 80 + kk * 32 + lq * 8);
#pragma unroll
                for (int mt = 0; mt < 4; ++mt) {
                    const bf16x8 fa = *(const bf16x8*)(att + (size_t)(mt * 16 + lr) * 80 + kk * 32 + lq * 8);
                    const bf16x8 fq = *(const bf16x8*)(qin + (size_t)(mt * 16 + lr) * QP + kk * 32 + lq * 8);
#pragma unroll
                    for (int i = 0; i < 2; ++i) {
                        oacc[mt][i] = __builtin_amdgcn_mfma_f32_16x16x32_bf16(fv[i], fa, oacc[mt][i], 0, 0, 0);
                        oacc[mt][i] = __builtin_amdgcn_mfma_f32_16x16x32_bf16(dir == 0 ? fsf[i][kk] : fsb[i][kk], fq, oacc[mt][i], 0, 0, 0);
                    }
                }
            }
            __syncthreads();
        }
#pragma unroll
        for (int mt = 0; mt < 4; ++mt) {
            float s2 = (oacc[mt][0].x * oacc[mt][0].x + oacc[mt][0].y * oacc[mt][0].y) + (oacc[mt][0].z * oacc[mt][0].z + oacc[mt][0].w * oacc[mt][0].w)
                     + (oacc[mt][1].x * oacc[mt][1].x + oacc[mt][1].y * oacc[mt][1].y) + (oacc[mt][1].z * oacc[mt][1].z + oacc[mt][1].w * oacc[mt][1].w);
            s2 += __shfl_xor(s2, 16); s2 += __shfl_xor(s2, 32);
            if (lq == 0) part[wid * 64 + mt * 16 + lr] = s2;
        }
        __syncthreads();
#pragma unroll
        for (int mt = 0; mt < 4; ++mt) {
            const int t = mt * 16 + lr;
            const float s2 = (part[t] + part[64 + t]) + (part[128 + t] + part[192 + t]);
            const float rstd = rsqrtf(s2 * (1.f / 128.f) + 1e-6f);
            const size_t rowi = (size_t)(r0 + t);
#pragma unroll
            for (int i = 0; i < 2; ++i) {
                const int e = (2 * wid + i) * 16 + lq * 4;
                const f32x4 gg = *(const f32x4*)(ng + h * 128 + e);
                const float g0 = bflo(gu[mt][i].x), g1 = bfhi(gu[mt][i].x), g2 = bflo(gu[mt][i].y), g3 = bfhi(gu[mt][i].y);
                u32x2 o;
                o.x = cvt_pk(oacc[mt][i].x * rstd * gg.x * siluf(g0), oacc[mt][i].y * rstd * gg.y * siluf(g1));
                o.y = cvt_pk(oacc[mt][i].z * rstd * gg.z * siluf(g2), oacc[mt][i].w * rstd * gg.w * siluf(g3));
                *(u32x2*)(brp + rowi * 1536 + h * 128 + e) = o;
            }
        }
        __syncthreads();
    }
}

template <int NI, class F>
__device__ __forceinline__ void ctx_gemm(const bf16_t* A, int lda, const bf16_t* Bt, int ldb, int K, int N, const F& f, char* lds) {
    const int tid = tid_l(), lane = tid & 63, wid = tid >> 6, wm = wid >> 1, wn = wid & 1, lr = lane & 15, lq = lane >> 4;
    const int Nt = (N + 32 * NI - 1) / (32 * NI);
    const int total = 4 * Nt, VG = vgrid(), slot = bid_l();
    for (int t0 = 0; t0 < total; t0 += VG) {
        const int t = t0 + (VG - 1 - slot); if (t >= total) continue;
        const int tm = t & 3, tn = t >> 2;
        f32x4 acc[4][NI];
#pragma unroll
        for (int mi = 0; mi < 4; ++mi)
#pragma unroll
            for (int ni = 0; ni < NI; ++ni) acc[mi][ni] = (f32x4){0.f, 0.f, 0.f, 0.f};
        gemm_kloop<NI>(acc, A + (size_t)(RL + tm * 128) * lda, lda, Bt + (size_t)tn * (32 * NI) * ldb, ldb, K, lds);
#pragma unroll
        for (int mi = 0; mi < 4; ++mi)
#pragma unroll
            for (int ni = 0; ni < NI; ++ni) f(RL + tm * 128 + wm * 64 + mi * 16 + lr, tn * (32 * NI) + wn * (16 * NI) + ni * 16 + lq * 4, acc[mi][ni], 0);
    }
}
__device__ __forceinline__ void ctx_merge(const Params& P, char* lds) {
    const int tid = tid_l(), lane = tid & 63, wid = tid >> 6, wm = wid >> 1, wn = wid & 1, lr = lane & 15, lq = lane >> 4;
    const bf16_t* br = (const bf16_t*)(ws_l(P) + WS_BR); const bf16_t* wb = (const bf16_t*)(ws_l(P) + WS_WTBR);
    const bf16_t* gs = (const bf16_t*)(ws_l(P) + WS_GS); bf16_t* mb = (bf16_t*)(ws_l(P) + WS_MB);
    const int total = 64, VG = vgrid(), slot = bid_l();
    for (int t0 = 0; t0 < total; t0 += VG) {
        const int t = t0 + (VG - 1 - slot); if (t >= total) continue;
        const int tm = t & 3, tn = t >> 2;
        f32x4 m[4][2];
#pragma unroll
        for (int mi = 0; mi < 4; ++mi)
#pragma unroll
            for (int ni = 0; ni < 2; ++ni) m[mi][ni] = (f32x4){0.f, 0.f, 0.f, 0.f};
#pragma unroll 1
        for (int j = 0; j < 3; ++j) {
            f32x4 acc[4][2];
#pragma unroll
            for (int mi = 0; mi < 4; ++mi)
#pragma unroll
                for (int ni = 0; ni < 2; ++ni) acc[mi][ni] = (f32x4){0.f, 0.f, 0.f, 0.f};
            gemm_kloop<2>(acc, br + (size_t)(RL + tm * 128) * 1536 + j * 512, 1536, wb + ((size_t)j * 1024 + tn * 64) * 512, 512, 512, lds);
#pragma unroll
            for (int mi = 0; mi < 4; ++mi)
#pragma unroll
                for (int ni = 0; ni < 2; ++ni) {
                    const int r = RL + tm * 128 + wm * 64 + mi * 16 + lr, c = tn * 64 + wn * 32 + ni * 16 + lq * 4;
                    const u32x2 g = *(const u32x2*)(gs + (size_t)r * 3072 + j * 1024 + c);
                    m[mi][ni].x += acc[mi][ni].x * bflo(g.x); m[mi][ni].y += acc[mi][ni].y * bfhi(g.x);
                    m[mi][ni].z += acc[mi][ni].z * bflo(g.y); m[mi][ni].w += acc[mi][ni].w * bfhi(g.y);
                }
        }
#pragma unroll
        for (int mi = 0; mi < 4; ++mi)
#pragma unroll
            for (int ni = 0; ni < 2; ++ni) {
                const int r = RL + tm * 128 + wm * 64 + mi * 16 + lr, c = tn * 64 + wn * 32 + ni * 16 + lq * 4;
                u32x2 o; o.x = cvt_pk(m[mi][ni].x, m[mi][ni].y); o.y = cvt_pk(m[mi][ni].z, m[mi][ni].w);
                *(u32x2*)(mb + (size_t)r * 1024 + c) = o;
            }
    }
}


#define XB_TMO      128
#define XB_XCNT(j)  (256  + 64 * (j))
#define XB_XSUB(j)  (1280 + 64 * (j))
#define XB_XGEN(j)  (2304 + 64 * (j))
#define XB_TOP      3328
#define XB_TOPGEN   3392
#define XCD_BAR_WORDS 3456
#define XB_SPIN_CAP (1u << 18)
__device__ __forceinline__ unsigned xb_ld(unsigned* p)              { return __hip_atomic_load(p, __ATOMIC_RELAXED, __HIP_MEMORY_SCOPE_AGENT); }
__device__ __forceinline__ unsigned xb_add(unsigned* p, unsigned v) { return __hip_atomic_fetch_add(p, v, __ATOMIC_RELAXED, __HIP_MEMORY_SCOPE_AGENT); }
__device__ __forceinline__ unsigned xb_xcc_id() { return (unsigned)__builtin_amdgcn_s_getreg((3 << 11) | 20) & 0xFu; }
#define XB_SPIN(cond, bar) do { unsigned _sp = 0; while (cond) { __builtin_amdgcn_s_sleep(1); \
    if ((++_sp & 255u) == 0u) { if (xb_ld(&(bar)[XB_TMO])) break; if (_sp > XB_SPIN_CAP) { atomicAdd(&(bar)[XB_TMO], 1u); break; } } } } while (0)
struct XcdBarrier { unsigned* bar; unsigned x; volatile LAS unsigned* st; };
__device__ __forceinline__ XcdBarrier xcd_barrier_post(unsigned* bar, volatile LAS unsigned* st) {
    XcdBarrier b; b.bar = bar; b.x = xb_xcc_id(); b.st = st;
    if (threadIdx.x == 0) (void)xb_add(&bar[XB_XCNT(b.x)], 1u);
    return b;
}
__device__ __forceinline__ void xcd_barrier_complete(unsigned* bar, unsigned x, unsigned& nloc, unsigned& nx) {
    const unsigned G = gridDim.x * gridDim.y * gridDim.z;
    unsigned sum, cnt, mine, sp = 0u;
    for (;;) {
        sum = 0u; cnt = 0u; mine = 0u;
#pragma unroll
        for (unsigned j = 0; j < 16; ++j) { const unsigned c = xb_ld(&bar[XB_XCNT(j)]); sum += c; cnt += (c > 0u) ? 1u : 0u; mine = (j == x) ? c : mine; }
        if (sum == G) break;
        __builtin_amdgcn_s_sleep(1);
        if ((++sp & 255u) == 0u) { if (xb_ld(&bar[XB_TMO])) break; if (sp > XB_SPIN_CAP) { atomicAdd(&bar[XB_TMO], 1u); break; } }
    }
    nloc = mine > 0u ? mine : 1u; nx = cnt > 0u ? cnt : 1u;
}
__device__ __forceinline__ void xcd_barrier(const XcdBarrier& b) {
    asm volatile("s_waitcnt vmcnt(0)" ::: "memory");
    __syncthreads();
    if (threadIdx.x == 0) {
        unsigned* bar = b.bar;
        __builtin_amdgcn_s_waitcnt(0);
        unsigned nloc = b.st[0], nx = b.st[1];
        if (nloc == 0u) { xcd_barrier_complete(bar, b.x, nloc, nx); b.st[0] = nloc; b.st[1] = nx; }
        const unsigned old = xb_add(&bar[XB_XSUB(b.x)], 1u);
        const unsigned gen = old / nloc;
        if (old + 1u == (gen + 1u) * nloc) {
            __builtin_amdgcn_fence(__ATOMIC_RELEASE, "agent");
            asm volatile("s_waitcnt vmcnt(0)" ::: "memory");
            const unsigned og = xb_add(&bar[XB_TOP], 1u);
            const unsigned tg = og / nx;
            if (og + 1u == (tg + 1u) * nx) xb_add(&bar[XB_TOPGEN], 1u);
            else XB_SPIN(xb_ld(&bar[XB_TOPGEN]) == tg, bar);
            __builtin_amdgcn_fence(__ATOMIC_ACQUIRE, "agent");
            xb_add(&bar[XB_XGEN(b.x)], 1u);
            asm volatile("s_waitcnt vmcnt(0)" ::: "memory");
        } else {
            XB_SPIN(xb_ld(&bar[XB_XGEN(b.x)]) == gen, bar);
            __builtin_amdgcn_fence(__ATOMIC_ACQUIRE, "agent");
            asm volatile("s_waitcnt vmcnt(0)" ::: "memory");
        }
    }
    __syncthreads();
}

__global__ void __launch_bounds__(512, 2) fwd_kernel(Params P) {
    extern __shared__ __attribute__((aligned(16))) unsigned char lds_raw[];
    cg::grid_group grid = cg::this_grid();
    LAS unsigned char* ldsb = (LAS unsigned char*)lds_raw;
#define LDSH ((char*)lds_raw + __builtin_amdgcn_readfirstlane(threadIdx.x >> 8) * HALF_LDS)
    volatile LAS unsigned* bst = (volatile LAS unsigned*)(ldsb + 2 * HALF_LDS);
    if (threadIdx.x < 2) bst[threadIdx.x] = 0u;
    __syncthreads();
    XcdBarrier xbar = xcd_barrier_post((unsigned*)(P.ws + WS_BAR), bst);
    int ph = 0;
#define PHASE_BEGIN if (ph >= P.lo && ph < P.hi) {
#define PHASE_END } ++ph; if (P.coop && ph > P.lo && ph < P.hi) { if (ph == 1) grid.sync(); else xcd_barrier(xbar); }

    PHASE_BEGIN
        {
        { const int VG = vgrid(), slot = bid_l();
          for (int i0 = 0; i0 < 384; i0 += VG) { int it = i0 + slot; if (it >= 384) it = 383; mods_task(P, it, LDSH); } }
        if (bid_l() == vgrid() - 1) rope_task(P);
        convert_all(P, 0, LDSH);
        }
    PHASE_END

    const XPtr Xin{(float*)P.in[I_X], (float*)P.in[I_CTX]};
    const XPtr Xcur{P.out, (float*)(P.ws + WS_CTXX)};

    for (int l = 0; l < 2; ++l) {
        const XPtr Xold = l == 0 ? Xin : Xcur;
        const bool ctx_on = (l == 0);
        PHASE_BEGIN
            {
            if (l == 1) convert_all(P, 1, LDSH);
            norm_phase(P, Xold, P.in[I_N1G] + l * D, l, 0, R);
            }
        PHASE_END
        PHASE_BEGIN
            const bf16_t* hb = (const bf16_t*)(ws_l(P) + WS_HBUF); const bf16_t* wt = (const bf16_t*)(ws_l(P) + WS_WTIN);
            EpiP e{(bf16_t*)(ws_l(P) + WS_PBUF), 1536, 1536, (float*)(ws_l(P) + WS_SMALL)};
            {
            big_gemm(ldsb, hb, 1024, wt, 1024, 1792, e);
            ctx_gemm<4>(hb, 1024, wt, 1024, 1024, 1664, e, LDSH); }
        PHASE_END
        PHASE_BEGIN u_phase<0>(P, l, LDSH); PHASE_END
        PHASE_BEGIN scan_phase<64, false>(P); PHASE_END
        PHASE_BEGIN out_phase_g(P, l, !ctx_on, LDSH); PHASE_END
        PHASE_BEGIN
            const bf16_t* hb = (const bf16_t*)(ws_l(P) + WS_HBUF); const bf16_t* wt = (const bf16_t*)(ws_l(P) + WS_WTIN) + (size_t)1792 * 1024;
            EpiP e{(bf16_t*)(ws_l(P) + WS_PBUF), 2048, 2048, nullptr};
            {
            big_gemm(ldsb, hb, 1024, wt, 1024, 2048, e);
            ctx_gemm<2>(hb, 1024, wt, 1024, 1024, 2048, e, LDSH); }
        PHASE_END
        PHASE_BEGIN u_phase_s<1>(P, l, LDSH); PHASE_END
        PHASE_BEGIN scan_phase<128, true>(P); PHASE_END
        PHASE_BEGIN out_phase_s<1>(P, l, 1, !ctx_on, LDSH); PHASE_END
        PHASE_BEGIN
            const bf16_t* hb = (const bf16_t*)(ws_l(P) + WS_HBUF); const bf16_t* wt = (const bf16_t*)(ws_l(P) + WS_WTIN) + (size_t)3840 * 1024;
            EpiP e{(bf16_t*)(ws_l(P) + WS_PBUF), 1536, 1536, nullptr};
            {
            big_gemm(ldsb, hb, 1024, wt, 1024, 1536, e);
            ctx_gemm<4>(hb, 1024, wt, 1024, 1024, 1536, e, LDSH); }
        PHASE_END
        PHASE_BEGIN u_phase_s<2>(P, l, LDSH); PHASE_END
        PHASE_BEGIN scan_phase<64, false>(P); PHASE_END
        PHASE_BEGIN out_phase_s<2>(P, l, 2, !ctx_on, LDSH); PHASE_END
        PHASE_BEGIN
            const bf16_t* hb = (const bf16_t*)(ws_l(P) + WS_HBUF); const bf16_t* wt = (const bf16_t*)(ws_l(P) + WS_WTIN) + (size_t)5376 * 1024;
            EpiSig e{(bf16_t*)(ws_l(P) + WS_GS)};
            {
            big_gemm(ldsb, hb, 1024, wt, 1024, 3072, e);
            if (ctx_on) ctx_gemm<2>(hb, 1024, wt, 1024, 1024, 3072, e, LDSH); }
        PHASE_END
        PHASE_BEGIN
            {   pg8::Gemm g{(const bf16_t*)(ws_l(P) + WS_BR), (const bf16_t*)(ws_l(P) + WS_WTBR), 1536, 512};
                pg8::MergeOrder S; S.S.init(RL, 1024, (int)gridDim.x, (int)blockIdx.x);
                pg8::Epi<EpiMerge> E{EpiMerge{(const bf16_t*)(ws_l(P) + WS_GS), (bf16_t*)(ws_l(P) + WS_MB)}};
                pg8::gemm_phase(ldsb, g, S, E);
                __syncthreads(); }
            if (ctx_on) ctx_merge(P, LDSH);
        PHASE_END
        PHASE_BEGIN
            const float* mods_l = (const float*)(ws_l(P) + WS_MODS) + (size_t)l * 3 * 6144;
            EpiRes e{Xold, Xcur, mods_l, 2};
            big_gemm(ldsb, (const bf16_t*)(ws_l(P) + WS_MB), 1024, (const bf16_t*)(ws_l(P) + WS_WTO), 1024, 1024, e);
            if (ctx_on) ctx_gemm<1>((const bf16_t*)(ws_l(P) + WS_MB), 1024, (const bf16_t*)(ws_l(P) + WS_WTO), 1024, 1024, 1024, e, LDSH);
        PHASE_END
        PHASE_BEGIN norm_phase(P, Xcur, P.in[I_N2G] + l * D, l, 3, ctx_on ? R : RL); PHASE_END
        PHASE_BEGIN
            const bf16_t* hb = (const bf16_t*)(ws_l(P) + WS_HBUF);
            EpiRelu2 e{(bf16_t*)(ws_l(P) + WS_HID)};
            {
            big_gemm(ldsb, hb, 1024, (const bf16_t*)(ws_l(P) + WS_WTUP), 1024, 4096, e);
            if (ctx_on) ctx_gemm<2>(hb, 1024, (const bf16_t*)(ws_l(P) + WS_WTUP), 1024, 1024, 4096, e, LDSH); }
        PHASE_END
        PHASE_BEGIN
            const float* mods_l = (const float*)(ws_l(P) + WS_MODS) + (size_t)l * 3 * 6144;
            EpiRes e{Xcur, Xcur, mods_l, 5};
            big_gemm(ldsb, (const bf16_t*)(ws_l(P) + WS_HID), 4096, (const bf16_t*)(ws_l(P) + WS_WTDN), 4096, 1024, e);
            if (ctx_on) ctx_gemm<1>((const bf16_t*)(ws_l(P) + WS_HID), 4096, (const bf16_t*)(ws_l(P) + WS_WTDN), 4096, 4096, 1024, e, LDSH);
        PHASE_END
    }
    PHASE_BEGIN final_norm_phase(P); PHASE_END
#undef PHASE_BEGIN
#undef PHASE_END
}
constexpr int NPHASES = 1 + 2 * 19 + 1;

extern "C" void kernel_launch(void* const* d_in, const int* in_sizes, int n_in, void* d_out, int out_size, void* d_ws, size_t ws_size, hipStream_t stream) {
    static int grid = 0;
    if (grid == 0) {
        if (n_in != 23 || ws_size < WS_END || out_size != NB * SEQ * D) { fprintf(stderr, "kernel_launch: unexpected sizes n_in %d ws %zu (need %zu) out %d\n", n_in, ws_size, (size_t)WS_END, out_size); grid = -1; return; }
        int dev = 0, cus = 0, per_cu = 0;
        if (hipGetDevice(&dev) != hipSuccess || hipDeviceGetAttribute(&cus, hipDeviceAttributeMultiprocessorCount, dev) != hipSuccess) { grid = -1; return; }
        if (hipFuncSetAttribute((const void*)fwd_kernel, hipFuncAttributeMaxDynamicSharedMemorySize, LDS_BYTES) != hipSuccess) { fprintf(stderr, "kernel_launch: hipFuncSetAttribute failed\n"); grid = -1; return; }
        if (hipOccupancyMaxActiveBlocksPerMultiprocessor(&per_cu, (const void*)fwd_kernel, 512, LDS_BYTES) != hipSuccess || per_cu < 1) { fprintf(stderr, "kernel_launch: occupancy query failed (%d)\n", per_cu); grid = -1; return; }
        grid = cus;
        grid -= grid % 8;
    }
    if (grid < 0) return;
    if (hipMemsetAsync((char*)d_ws + WS_BAR, 0, (size_t)3456 * 4, stream) != hipSuccess) { fprintf(stderr, "kernel_launch: memset failed\n"); return; }
    Params p{};
    for (int i = 0; i < 23; ++i) p.in[i] = (const float*)d_in[i];
    p.out = (float*)d_out; p.ws = (unsigned char*)d_ws;
    p.lo = 0; p.hi = NPHASES; p.coop = 1;
    void* args[] = {&p};
    hipError_t e = hipLaunchCooperativeKernel((const void*)fwd_kernel, dim3(grid), dim3(512), args, LDS_BYTES, stream);
    if (e != hipSuccess) fprintf(stderr, "kernel_launch: cooperative launch failed: %s (grid %d)\n", hipGetErrorString(e), grid);
}
```

```cpp
#include <hip/hip_runtime.h>
#include <hip/hip_cooperative_groups.h>
#include <stdint.h>
#include <stdio.h>
namespace cg = cooperative_groups;

#define LAS __attribute__((address_space(3)))
typedef unsigned short bf16_t;
typedef short bf16x8 __attribute__((ext_vector_type(8)));
typedef float f32x4 __attribute__((ext_vector_type(4)));
typedef unsigned u32x4 __attribute__((ext_vector_type(4)));
typedef unsigned u32x2 __attribute__((ext_vector_type(2)));

constexpr int D = 1024, NB = 2, SEQ = 8192, CTX = 256, RB = SEQ + CTX, R = NB * RB, RL = NB * SEQ, NCH = RB / 64, FF = 4096;
constexpr int INW = 8240;
constexpr int NTHR = 256;
constexpr int HALF_LDS = 73728;
constexpr int LDS_BYTES = 2 * HALF_LDS + 16;

constexpr size_t WS_WTIN = 0;
constexpr size_t WS_WTBR = WS_WTIN + (size_t)8448 * 1024 * 2;
constexpr size_t WS_WTO = WS_WTBR + (size_t)3 * 1024 * 512 * 2;
constexpr size_t WS_WTUP = WS_WTO + (size_t)1024 * 1024 * 2;
constexpr size_t WS_WTDN = WS_WTUP + (size_t)4096 * 1024 * 2;
constexpr size_t WS_HBUF = WS_WTDN + (size_t)4096 * 1024 * 2;
constexpr size_t WS_PBUF = WS_HBUF + (size_t)R * 1024 * 2;
constexpr size_t WS_SBUF = WS_PBUF + (size_t)R * 2048 * 2;
constexpr size_t WS_BR = WS_SBUF + (size_t)R * 2048 * 2;
constexpr size_t WS_CTXX = WS_BR + (size_t)R * 1536 * 2;
constexpr size_t WS_SMALL = WS_CTXX + (size_t)512 * 1024 * 4;
constexpr size_t WS_DEC = WS_SMALL + (size_t)R * 48 * 4;
constexpr size_t WS_UN = WS_DEC + (size_t)16 * NCH * 128 * 4;
constexpr size_t WS_MODS = WS_UN + (size_t)16 * NCH * 128 * 4;
constexpr size_t WS_ROPE = WS_MODS + (size_t)2 * 3 * 6144 * 4;
constexpr size_t WS_BAR = WS_ROPE + (size_t)(128 + 64) * 16 * 2 * 4;
constexpr size_t WS_END = WS_BAR + (size_t)3456 * 4;
constexpr size_t WS_GS = WS_PBUF;
constexpr size_t WS_MB = WS_PBUF + (size_t)R * 3072 * 2;
constexpr size_t WS_HID = WS_PBUF;

struct Params { const float* in[23]; float* out; unsigned char* ws; int lo, hi, coop, pad; };

__device__ __forceinline__ int tid_l() { int t = threadIdx.x & 255; asm volatile("" : "+v"(t)); return t; }
__device__ __forceinline__ int bid_l() { int t = blockIdx.x * 2 + (__builtin_amdgcn_readfirstlane(threadIdx.x >> 8)); asm volatile("" : "+s"(t)); return t; }
__device__ __forceinline__ int vgrid() { return gridDim.x * 2; }
typedef __attribute__((address_space(1))) unsigned char gas_u8;
__device__ __forceinline__ unsigned char* ws_l(const Params& P) { gas_u8* w = (gas_u8*)P.ws; asm volatile("" : "+s"(w)); return (unsigned char*)w; }
enum { I_X = 0, I_C, I_CTX, I_CCTX, I_N1G, I_N2G, I_WADA, I_BADA, I_WIN, I_A2, I_ABIAS, I_GNG, I_CONV, I_IB, I_FB, I_MNG, I_RDL, I_RNG, I_WBR, I_WO, I_WUP, I_WDN, I_FG };

typedef __bf16 bf16x2_t __attribute__((ext_vector_type(2)));
typedef float f32x2 __attribute__((ext_vector_type(2)));
__device__ __forceinline__ unsigned cvt_pk(float lo, float hi) { f32x2 v = {lo, hi}; bf16x2_t b = __builtin_convertvector(v, bf16x2_t); return __builtin_bit_cast(unsigned, b); }
__device__ __forceinline__ float bflo(unsigned u) { return __uint_as_float(u << 16); }
__device__ __forceinline__ float bfhi(unsigned u) { return __uint_as_float(u & 0xffff0000u); }
__device__ __forceinline__ float wave_sum(float v) {
#pragma unroll
    for (int o = 32; o > 0; o >>= 1) v += __shfl_xor(v, o);
    return v;
}
__device__ __forceinline__ float logsig(float x) { return fminf(x, 0.f) - log1pf(__expf(-fabsf(x))); }
__device__ __forceinline__ float logsig_fast(float x) { return fminf(x, 0.f) - __logf(1.f + __expf(-fabsf(x))); }
__device__ __forceinline__ float siluf(float x) { return x * __builtin_amdgcn_rcpf(1.f + __expf(-x)); }
__device__ __forceinline__ float sigmf(float x) { return __builtin_amdgcn_rcpf(1.f + __expf(-x)); }

struct XPtr { float* lat; float* ctx; };
__device__ __forceinline__ float* xrow(const XPtr& X, int r) { return r < RL ? X.lat + (size_t)r * D : X.ctx + (size_t)(r - RL) * D; }
__device__ __forceinline__ int modidx(int r) { return r < SEQ ? 0 : (r < RL ? 1 : 2); }
__device__ __forceinline__ int rowbase(int b, int c) { return c < 4 ? RL + b * CTX + c * 64 : b * SEQ + (c - 4) * 64; }

#define UNPACK8(u, f) do { f[0] = bflo(u.x); f[1] = bfhi(u.x); f[2] = bflo(u.y); f[3] = bfhi(u.y); f[4] = bflo(u.z); f[5] = bfhi(u.z); f[6] = bflo(u.w); f[7] = bfhi(u.w); } while (0)

__device__ __forceinline__ void mods_task(const Params& P, int task, char* lds) {
    float* s = (float*)lds;
    float* red = (float*)(lds + 12288);
    const int tid = tid_l();
    const int l = task / 192, col0 = (task % 192) * 32;
    const float* c = P.in[I_C]; const float* cc = P.in[I_CCTX];
    for (int i = tid; i < 3072; i += NTHR) { const int v = i >> 10, k = i & 1023; const float cv = v < 2 ? c[v * 1024 + k] : cc[k]; s[i] = siluf(cv); }
    __syncthreads();
    const int col = tid & 31, kg = tid >> 5;
    const float* w = P.in[I_WADA] + (size_t)l * D * 6144 + col0 + col;
    float a0 = 0.f, a1 = 0.f, a2 = 0.f;
#pragma unroll 32
    for (int k = kg * 128; k < kg * 128 + 128; ++k) { const float wv = w[(size_t)k * 6144]; a0 += s[k] * wv; a1 += s[1024 + k] * wv; a2 += s[2048 + k] * wv; }
    red[(kg * 32 + col) * 3 + 0] = a0; red[(kg * 32 + col) * 3 + 1] = a1; red[(kg * 32 + col) * 3 + 2] = a2;
    __syncthreads();
    if (tid < 96) {
        const int v = tid >> 5, c2 = tid & 31; float sum = 0.f;
#pragma unroll
        for (int g = 0; g < 8; ++g) sum += red[(g * 32 + c2) * 3 + v];
        sum += P.in[I_BADA][l * 6144 + col0 + c2];
        ((float*)(ws_l(P) + WS_MODS))[(l * 3 + v) * 6144 + col0 + c2] = sum;
    }
    __syncthreads();
}

__device__ __forceinline__ void rope_task(const Params& P) {
    float* tab = (float*)(ws_l(P) + WS_ROPE);
    for (int i = tid_l(); i < 192 * 16; i += NTHR) {
        const int pos = i >> 4, f = i & 15;
        const float inv = exp2f(-(float)f * (13.287712379549449f / 16.f));
        const float p = pos < 128 ? (float)pos : (float)(pos - 128);
        const float ang = p * inv;
        const float cs = cosf(ang), sn = sinf(ang);
        if (pos < 128) { tab[pos * 16 + f] = cs; tab[2048 + pos * 16 + f] = sn; }
        else { tab[4096 + (pos - 128) * 16 + f] = cs; tab[4096 + 1024 + (pos - 128) * 16 + f] = sn; }
    }
}

__device__ __forceinline__ void transpose_tile(const float* src, int ldsrc, int k0, int n0src, int nvalid, bf16_t* dst, int ldd, int drow0, char* lds) {
    float* tile = (float*)lds;
    const int tid = tid_l(), nl = tid & 63, kq = tid >> 6;
    float v[32];
#pragma unroll
    for (int i = 0; i < 32; ++i) v[i] = nl < nvalid ? src[(size_t)(k0 + kq + 4 * i) * ldsrc + n0src + nl] : 0.f;
#pragma unroll
    for (int i = 0; i < 32; ++i) tile[(kq + 4 * i) * 65 + nl] = v[i];
    __syncthreads();
    const int n = tid >> 2, ks = (tid & 3) * 32;
    if (n < nvalid) {
        u32x4* dp = (u32x4*)(dst + (size_t)(drow0 + n) * ldd + k0 + ks);
#pragma unroll
        for (int q = 0; q < 4; ++q) {
            u32x4 o;
            o.x = cvt_pk(tile[(ks + 8 * q + 0) * 65 + n], tile[(ks + 8 * q + 1) * 65 + n]); o.y = cvt_pk(tile[(ks + 8 * q + 2) * 65 + n], tile[(ks + 8 * q + 3) * 65 + n]);
            o.z = cvt_pk(tile[(ks + 8 * q + 4) * 65 + n], tile[(ks + 8 * q + 5) * 65 + n]); o.w = cvt_pk(tile[(ks + 8 * q + 6) * 65 + n], tile[(ks + 8 * q + 7) * 65 + n]);
            dp[q] = o;
        }
    }
    __syncthreads();
}

constexpr int CONV_TILES = 192 + 8 + 8 + 256 + 192 + 384 + 192 + 128 + 512 + 512;
__device__ __forceinline__ void convert_tile(const Params& P, int l, int it, char* lds) {
    const float* win = P.in[I_WIN] + (size_t)l * D * INW;
    bf16_t* wtin = (bf16_t*)(ws_l(P) + WS_WTIN);
    int r = it;
    if (r < 192) { const int kt = r / 24, nt = r % 24; transpose_tile(win, INW, kt * 128, nt * 64, 64, wtin, 1024, nt * 64, lds); return; } r -= 192;
    if (r < 8) { transpose_tile(win, INW, r * 128, 1536, 32, wtin, 1024, 1536, lds); return; } r -= 8;
    if (r < 8) { transpose_tile(win, INW, r * 128, 3616, 16, wtin, 1024, 1568, lds); return; } r -= 8;
    if (r < 256) { const int kt = r / 32, nt = r % 32; transpose_tile(win, INW, kt * 128, 1568 + nt * 64, 64, wtin, 1024, 1792 + nt * 64, lds); return; } r -= 256;
    if (r < 192) { const int kt = r / 24, nt = r % 24; transpose_tile(win, INW, kt * 128, 3632 + nt * 64, 64, wtin, 1024, 3840 + nt * 64, lds); return; } r -= 192;
    if (r < 384) { const int kt = r / 48, nt = r % 48; transpose_tile(win, INW, kt * 128, 5168 + nt * 64, 64, wtin, 1024, 5376 + nt * 64, lds); return; } r -= 384;
    if (r < 192) { const int j = r / 64, q = r % 64, kt = q / 16, nt = q % 16;
        transpose_tile(P.in[I_WBR] + ((size_t)l * 3 + j) * 512 * 1024, 1024, kt * 128, nt * 64, 64, (bf16_t*)(ws_l(P) + WS_WTBR), 512, j * 1024 + nt * 64, lds); return; } r -= 192;
    if (r < 128) { const int kt = r / 16, nt = r % 16; transpose_tile(P.in[I_WO] + (size_t)l * D * D, 1024, kt * 128, nt * 64, 64, (bf16_t*)(ws_l(P) + WS_WTO), 1024, nt * 64, lds); return; } r -= 128;
    if (r < 512) { const int kt = r / 64, nt = r % 64; transpose_tile(P.in[I_WUP] + (size_t)l * D * FF, 4096, kt * 128, nt * 64, 64, (bf16_t*)(ws_l(P) + WS_WTUP), 1024, nt * 64, lds); return; } r -= 512;
    { const int kt = r / 16, nt = r % 16; transpose_tile(P.in[I_WDN] + (size_t)l * FF * D, 1024, kt * 128, nt * 64, 64, (bf16_t*)(ws_l(P) + WS_WTDN), 4096, nt * 64, lds); }
}
__device__ __forceinline__ void convert_all(const Params& P, int l, char* lds) {
    const int VG = vgrid(), slot = bid_l();
    static_assert(CONV_TILES % 2 == 0, "both halves of a workgroup must be active together");
    for (int i0 = 0; i0 < CONV_TILES; i0 += VG) { const int it = i0 + slot; if (it >= CONV_TILES) continue; convert_tile(P, l, it, lds); }
}

__device__ __forceinline__ void norm_phase(const Params& P, XPtr X, const float* g, int l, int sidx, int nrows) {
    const int lane = tid_l() & 63; const int gw = bid_l() * 4 + (tid_l() >> 6), ngw = vgrid() * 4;
    bf16_t* hb = (bf16_t*)(ws_l(P) + WS_HBUF);
    const float* mods = (const float*)(ws_l(P) + WS_MODS) + (size_t)l * 3 * 6144;
    for (int r = gw; r < nrows; r += 2 * ngw) {
        const int r1 = r + ngw; const bool has1 = r1 < nrows; const int rr1 = has1 ? r1 : r;
        const f32x4* xa = (const f32x4*)xrow(X, r); const f32x4* xb = (const f32x4*)xrow(X, rr1);
        f32x4 va[4], vb[4]; float sa_ = 0.f, sb_ = 0.f;
#pragma unroll
        for (int j = 0; j < 4; ++j) { va[j] = xa[lane + 64 * j]; vb[j] = xb[lane + 64 * j]; }
#pragma unroll
        for (int j = 0; j < 4; ++j) { sa_ += va[j].x * va[j].x + va[j].y * va[j].y + va[j].z * va[j].z + va[j].w * va[j].w; sb_ += vb[j].x * vb[j].x + vb[j].y * vb[j].y + vb[j].z * vb[j].z + vb[j].w * vb[j].w; }
        sa_ = wave_sum(sa_); sb_ = wave_sum(sb_);
        const float rsa = rsqrtf(sa_ * (1.f / 1024.f) + 1e-6f), rsb = rsqrtf(sb_ * (1.f / 1024.f) + 1e-6f);
        const float* mda = mods + modidx(r) * 6144; const float* mdb = mods + modidx(rr1) * 6144;
#pragma unroll
        for (int j = 0; j < 4; ++j) {
            const int col = (lane + 64 * j) * 4;
            const f32x4 gg = *(const f32x4*)(g + col);
            { const f32x4 sh = *(const f32x4*)(mda + sidx * 1024 + col), sc = *(const f32x4*)(mda + (sidx + 1) * 1024 + col);
              const f32x4 hh = va[j] * rsa * gg * (sc + 1.f) + sh; u32x2 o; o.x = cvt_pk(hh.x, hh.y); o.y = cvt_pk(hh.z, hh.w); *(u32x2*)(hb + (size_t)r * 1024 + col) = o; }
            if (has1) { const f32x4 sh = *(const f32x4*)(mdb + sidx * 1024 + col), sc = *(const f32x4*)(mdb + (sidx + 1) * 1024 + col);
              const f32x4 hh = vb[j] * rsb * gg * (sc + 1.f) + sh; u32x2 o; o.x = cvt_pk(hh.x, hh.y); o.y = cvt_pk(hh.z, hh.w); *(u32x2*)(hb + (size_t)r1 * 1024 + col) = o; }
        }
    }
}
__device__ __forceinline__ void final_norm_phase(const Params& P) {
    const int lane = tid_l() & 63; const int gw = bid_l() * 4 + (tid_l() >> 6), ngw = vgrid() * 4;
    const float* g = P.in[I_FG];
    for (int r = gw; r < RL; r += 2 * ngw) {
        const int r1 = r + ngw;
        f32x4* xa = (f32x4*)(P.out + (size_t)r * D); f32x4* xb = (f32x4*)(P.out + (size_t)r1 * D);
        f32x4 va[4], vb[4]; float sa_ = 0.f, sb_ = 0.f;
#pragma unroll
        for (int j = 0; j < 4; ++j) { va[j] = xa[lane + 64 * j]; vb[j] = xb[lane + 64 * j]; }
#pragma unroll
        for (int j = 0; j < 4; ++j) { sa_ += va[j].x * va[j].x + va[j].y * va[j].y + va[j].z * va[j].z + va[j].w * va[j].w; sb_ += vb[j].x * vb[j].x + vb[j].y * vb[j].y + vb[j].z * vb[j].z + vb[j].w * vb[j].w; }
        sa_ = wave_sum(sa_); sb_ = wave_sum(sb_);
        const float rsa = rsqrtf(sa_ * (1.f / 1024.f) + 1e-6f), rsb = rsqrtf(sb_ * (1.f / 1024.f) + 1e-6f);
#pragma unroll
        for (int j = 0; j < 4; ++j) { const f32x4 gg = *(const f32x4*)(g + (lane + 64 * j) * 4); xa[lane + 64 * j] = va[j] * rsa * gg; xb[lane + 64 * j] = vb[j] * rsb * gg; }
    }
}

struct EpiP {
    bf16_t* Pb; int pitch; int nmain; float* small;
    __device__ __forceinline__ void operator()(int r, int c, const f32x4& v, int) const {
        if (c < nmain) { u32x2 o; o.x = cvt_pk(v.x, v.y); o.y = cvt_pk(v.z, v.w); *(u32x2*)(Pb + (size_t)r * pitch + c) = o; }
        else { const int cc = c - nmain; if (cc < 48) *(f32x4*)(small + (size_t)r * 48 + cc) = v; }
    }
    __device__ __forceinline__ void w8(int r, int c, const f32x4& v0, const f32x4& v1, int) const {
        if (c < nmain) { u32x4 o; o.x = cvt_pk(v0.x, v0.y); o.y = cvt_pk(v0.z, v0.w); o.z = cvt_pk(v1.x, v1.y); o.w = cvt_pk(v1.z, v1.w); *(u32x4*)(Pb + (size_t)r * pitch + c) = o; }
        else { const int cc = c - nmain; if (cc < 48) { *(f32x4*)(small + (size_t)r * 48 + cc) = v0; *(f32x4*)(small + (size_t)r * 48 + cc + 4) = v1; } }
    }
};
struct EpiSig {
    bf16_t* O;
    __device__ __forceinline__ void operator()(int r, int c, const f32x4& v, int) const {
        u32x2 o; o.x = cvt_pk(sigmf(v.x), sigmf(v.y)); o.y = cvt_pk(sigmf(v.z), sigmf(v.w)); *(u32x2*)(O + (size_t)r * 3072 + c) = o;
    }
    __device__ __forceinline__ void w8(int r, int c, const f32x4& v0, const f32x4& v1, int) const {
        u32x4 o; o.x = cvt_pk(sigmf(v0.x), sigmf(v0.y)); o.y = cvt_pk(sigmf(v0.z), sigmf(v0.w)); o.z = cvt_pk(sigmf(v1.x), sigmf(v1.y)); o.w = cvt_pk(sigmf(v1.z), sigmf(v1.w));
        *(u32x4*)(O + (size_t)r * 3072 + c) = o;
    }
};
struct EpiRelu2 {
    bf16_t* O;
    __device__ __forceinline__ void operator()(int r, int c, const f32x4& v, int) const {
        const float a = fmaxf(v.x, 0.f), b = fmaxf(v.y, 0.f), cc = fmaxf(v.z, 0.f), d = fmaxf(v.w, 0.f);
        u32x2 o; o.x = cvt_pk(a * a, b * b); o.y = cvt_pk(cc * cc, d * d); *(u32x2*)(O + (size_t)r * 4096 + c) = o;
    }
    __device__ __forceinline__ void w8(int r, int c, const f32x4& v0, const f32x4& v1, int) const {
        const float a = fmaxf(v0.x, 0.f), b = fmaxf(v0.y, 0.f), cc = fmaxf(v0.z, 0.f), d = fmaxf(v0.w, 0.f), e = fmaxf(v1.x, 0.f), f = fmaxf(v1.y, 0.f), g = fmaxf(v1.z, 0.f), h = fmaxf(v1.w, 0.f);
        u32x4 o; o.x = cvt_pk(a * a, b * b); o.y = cvt_pk(cc * cc, d * d); o.z = cvt_pk(e * e, f * f); o.w = cvt_pk(g * g, h * h); *(u32x4*)(O + (size_t)r * 4096 + c) = o;
    }
};
struct EpiRes {
    XPtr Xold, Xnew; const float* mods_l; int gidx;
    __device__ __forceinline__ void operator()(int r, int c, const f32x4& v, int) const {
        const f32x4 g = *(const f32x4*)(mods_l + modidx(r) * 6144 + gidx * 1024 + c);
        const f32x4 xo = *(const f32x4*)(xrow(Xold, r) + c);
        *(f32x4*)(xrow(Xnew, r) + c) = xo + g * v;
    }
    __device__ __forceinline__ void w8(int r, int c, const f32x4& v0, const f32x4& v1, int) const {
        const float* gp = mods_l + modidx(r) * 6144 + gidx * 1024 + c; const float* xo = xrow(Xold, r) + c; float* xn = xrow(Xnew, r) + c;
        const f32x4 g0 = *(const f32x4*)gp, g1 = *(const f32x4*)(gp + 4), x0 = *(const f32x4*)xo, x1 = *(const f32x4*)(xo + 4);
        *(f32x4*)xn = x0 + g0 * v0; *(f32x4*)(xn + 4) = x1 + g1 * v1;
    }
};
struct EpiMerge {
    const bf16_t* gs; bf16_t* mb;
    __device__ __forceinline__ void operator()(int r, int c, const f32x4& v, int j) const {
        const u32x2 g = *(const u32x2*)(gs + (size_t)r * 3072 + j * 1024 + c);
        float a0 = v.x * bflo(g.x), a1 = v.y * bfhi(g.x), a2 = v.z * bflo(g.y), a3 = v.w * bfhi(g.y);
        u32x2* mp = (u32x2*)(mb + (size_t)r * 1024 + c);
        if (j > 0) { const u32x2 o = *mp; a0 += bflo(o.x); a1 += bfhi(o.x); a2 += bflo(o.y); a3 += bfhi(o.y); }
        u32x2 w; w.x = cvt_pk(a0, a1); w.y = cvt_pk(a2, a3); *mp = w;
    }
    __device__ __forceinline__ void w8(int r, int c, const f32x4& v0, const f32x4& v1, int j) const {
        const u32x4 g = *(const u32x4*)(gs + (size_t)r * 3072 + j * 1024 + c);
        float a0 = v0.x * bflo(g.x), a1 = v0.y * bfhi(g.x), a2 = v0.z * bflo(g.y), a3 = v0.w * bfhi(g.y), a4 = v1.x * bflo(g.z), a5 = v1.y * bfhi(g.z), a6 = v1.z * bflo(g.w), a7 = v1.w * bfhi(g.w);
        u32x4* mp = (u32x4*)(mb + (size_t)r * 1024 + c);
        if (j > 0) { const u32x4 o = *mp; a0 += bflo(o.x); a1 += bfhi(o.x); a2 += bflo(o.y); a3 += bfhi(o.y); a4 += bflo(o.z); a5 += bfhi(o.z); a6 += bflo(o.w); a7 += bfhi(o.w); }
        u32x4 w; w.x = cvt_pk(a0, a1); w.y = cvt_pk(a2, a3); w.z = cvt_pk(a4, a5); w.w = cvt_pk(a6, a7); *mp = w;
    }
};

namespace pg8 {
constexpr int BM = 256, BK = 64, HALF = 128, HTB = HALF * BK * 2, STAGE_BYTES = 8 * HTB, NXCD = 8, WGM = 2;
__device__ __forceinline__ int lds_byte(int r, int c) { const int st = (r >> 4) * 2 + (c >> 5), rr = r & 15, cc = c & 31, ob = rr * 64 + cc * 2; return st * 1024 + (ob ^ (((ob >> 9) & 1) << 5)); }
__device__ __forceinline__ int perm32(int rho) { const int n = rho >> 4, i = rho & 15; return 8 * (i >> 2) + 4 * n + (i & 3); }
__device__ __forceinline__ void stage_rc(int b, int& R_, int& C_) { const int st = b / 1024, sb = b % 1024, swz = sb ^ (((sb >> 9) & 1) << 5); R_ = (st >> 1) * 16 + swz / 64; C_ = (st & 1) * 32 + (swz % 64) / 2; }
struct Unit { int pm, pn, acol, brow, j; };
struct Gemm { const bf16_t* A; const bf16_t* Bt; int lda, K; };
struct StaticOrder {
    int nM, nN, nwg, G, c;
    __device__ void init(int M, int N, int G_, int c_) { nM = M / BM; nN = N / BM; nwg = nM * nN; G = G_; c = c_; }
    __device__ __forceinline__ bool tile(long L, int& pm, int& pn) const {
        if (L >= nwg) return false;
        int wgid = (int)L; { const int q = nwg / NXCD, r = nwg % NXCD, xcd = wgid % NXCD, off = wgid / NXCD; wgid = (xcd < r ? xcd * (q + 1) : r * (q + 1) + (xcd - r) * q) + off; }
        const int nig = WGM * nN, gid = wgid / nig, fm = gid * WGM, gsz = (nM - fm) < WGM ? (nM - fm) : WGM;
        pm = fm + ((wgid % nig) % gsz); pn = (wgid % nig) / gsz; return true;
    }
    __device__ __forceinline__ bool next(int i, Unit& u) const { if (!tile((long)i * G + c, u.pm, u.pn)) return false; u.acol = 0; u.brow = u.pn; u.j = 0; return true; }
};
struct MergeOrder {
    StaticOrder S;
    __device__ __forceinline__ bool next(int i, Unit& u) const { const int j = i % 3; if (!S.tile((long)(i / 3) * S.G + S.c, u.pm, u.pn)) return false; u.acol = j * 512; u.brow = j * 4 + u.pn; u.j = j; return true; }
};
template <class F> struct Epi {
    F f;
    __device__ __forceinline__ void operator()(const f32x4 (&acc)[2][2][4][2], const Unit& u, int wr, int wc, int fr, int fq) const {
#pragma unroll
        for (int ai = 0; ai < 2; ++ai)
#pragma unroll
            for (int m = 0; m < 4; ++m)
#pragma unroll
                for (int bj = 0; bj < 2; ++bj)
                    f.w8(u.pm * BM + ai * HALF + wr * 64 + m * 16 + fr, u.pn * BM + bj * HALF + wc * 32 + 8 * fq, acc[ai][bj][m][0], acc[ai][bj][m][1], u.j);
    }
};

template <class E_, class Sched>
__device__ __forceinline__ void gemm_phase(LAS unsigned char* lds, const Gemm g, const Sched& S, const E_& E) {
    int tid_ = threadIdx.x; asm volatile("" : "+v"(tid_));
    const int tid = tid_, wid = __builtin_amdgcn_readfirstlane(tid >> 6), lane = tid & 63, wr = wid >> 2, wc = wid & 3, fr = lane & 15, fq = lane >> 4;
    const int K = g.K, nt = K / BK;
    unsigned voffA[2], voffB[2];
#pragma unroll
    for (int i = 0; i < 2; ++i) { int R_, C_; stage_rc(tid * 16 + i * 8192, R_, C_); const int Rb = (R_ & ~31) + perm32(R_ & 31); voffA[i] = (unsigned)(R_ * g.lda + C_) * 2u; voffB[i] = (unsigned)(Rb * K + C_) * 2u; }
    const size_t kstep = (size_t)(BK * 2);
    const size_t hstepA = (size_t)HALF * g.lda * 2, hstepB = (size_t)HALF * K * 2;
    const unsigned ldsw = (unsigned)wid * 1024u;
    const int aoff = lds_byte(wr * 64 + fr, fq * 8), boff = lds_byte(wc * 32 + fr, fq * 8);
#define PG8_SA(b, h) (((b) * 2 + (h)) * HTB)
#define PG8_SB(b, h) ((4 + (b) * 2 + (h)) * HTB)
#define PG8_STAGE(bufoff, gbase, voff) do { _Pragma("unroll") for (int _i = 0; _i < 2; ++_i) \
        __builtin_amdgcn_global_load_lds((const unsigned*)((const char*)(gbase) + (voff)[_i]), (LAS unsigned*)(lds + (bufoff) + ldsw + _i * 8192), 16, 0, 0); } while (0)
#define PG8_LDA(dst, b, h) do { _Pragma("unroll") for (int m = 0; m < 4; ++m) _Pragma("unroll") for (int k = 0; k < 2; ++k) dst[m][k] = *(const LAS bf16x8*)(lds + PG8_SA(b, h) + aoff + m * 2048 + k * 1024); } while (0)
#define PG8_LDB(dst, b, h) do { _Pragma("unroll") for (int n = 0; n < 2; ++n) _Pragma("unroll") for (int k = 0; k < 2; ++k) dst[n][k] = *(const LAS bf16x8*)(lds + PG8_SB(b, h) + boff + n * 2048 + k * 1024); } while (0)
#define PG8_MMA(ai, bj, At, Bt) do { __builtin_amdgcn_s_setprio(1); _Pragma("unroll") for (int m = 0; m < 4; ++m) _Pragma("unroll") for (int n = 0; n < 2; ++n) _Pragma("unroll") for (int k = 0; k < 2; ++k) \
        acc[ai][bj][m][n] = __builtin_amdgcn_mfma_f32_16x16x32_bf16(Bt[n][k], At[m][k], acc[ai][bj][m][n], 0, 0, 0); __builtin_amdgcn_s_setprio(0); } while (0)
#define PG8_WAIT_V(n) asm volatile("s_waitcnt vmcnt(" #n ")" ::: "memory")
#define PG8_WAIT_L(n) asm volatile("s_waitcnt lgkmcnt(" #n ")" ::: "memory")
#define PG8_BAR __builtin_amdgcn_s_barrier()
#define PG8_SCHED __builtin_amdgcn_sched_barrier(0)
#define PG8_UA(u) ((const char*)g.A + ((size_t)(u).pm * BM * g.lda + (u).acol) * 2)
#define PG8_UB(u) ((const char*)g.Bt + (size_t)(u).brow * BM * K * 2)
    Unit cur, nxt; int ui = 0;
    if (!S.next(0, cur)) return;
    f32x4 acc[2][2][4][2];
#pragma unroll
    for (int a = 0; a < 2; ++a)
#pragma unroll
        for (int b = 0; b < 2; ++b)
#pragma unroll
            for (int m = 0; m < 4; ++m)
#pragma unroll
                for (int n = 0; n < 2; ++n) acc[a][b][m][n] = (f32x4){0.f, 0.f, 0.f, 0.f};
    bf16x8 At[4][2], B0[2][2], B1[2][2];
    const char* cA = PG8_UA(cur); const char* cB = PG8_UB(cur);
    PG8_STAGE(PG8_SB(0, 0), cB, voffB); PG8_STAGE(PG8_SB(0, 1), cB + hstepB, voffB); PG8_STAGE(PG8_SA(0, 0), cA, voffA); PG8_STAGE(PG8_SA(0, 1), cA + hstepA, voffA);
    if (wr == 1) PG8_BAR;
    PG8_WAIT_V(2); PG8_BAR;
    PG8_STAGE(PG8_SB(1, 0), cB + kstep, voffB); PG8_STAGE(PG8_SA(1, 0), cA + kstep, voffA); PG8_STAGE(PG8_SB(1, 1), cB + hstepB + kstep, voffB);
    PG8_WAIT_V(6); PG8_BAR;
    for (;;) {
        const bool has_next = S.next(ui + 1, nxt);
        const char* nA = has_next ? PG8_UA(nxt) : cA; const char* nB = has_next ? PG8_UB(nxt) : cB;
        for (int t = 0; t < nt; t += 2) {
            const bool last = (t == nt - 2);
            const char* a1 = cA + (size_t)(t + 1) * kstep;
            const char* a2 = last ? nA : cA + (size_t)(t + 2) * kstep; const char* b2 = last ? nB : cB + (size_t)(t + 2) * kstep;
            const char* a3 = a2 + kstep; const char* b3 = b2 + kstep;
            PG8_LDB(B0, 0, 0); PG8_LDB(B1, 0, 1); PG8_SCHED; PG8_LDA(At, 0, 0); PG8_STAGE(PG8_SA(1, 1), a1 + hstepA, voffA);
            PG8_WAIT_V(8); PG8_WAIT_L(0); PG8_BAR; PG8_MMA(0, 0, At, B0); PG8_MMA(0, 1, At, B1); PG8_BAR; PG8_SCHED;
            PG8_LDA(At, 0, 1); PG8_STAGE(PG8_SB(0, 0), b2, voffB); PG8_STAGE(PG8_SB(0, 1), b2 + hstepB, voffB); PG8_STAGE(PG8_SA(0, 0), a2, voffA);
            PG8_WAIT_V(8); PG8_WAIT_L(0); PG8_BAR; PG8_MMA(1, 0, At, B0); PG8_MMA(1, 1, At, B1); PG8_BAR; PG8_SCHED;
            PG8_LDB(B0, 1, 0); PG8_LDB(B1, 1, 1); PG8_SCHED; PG8_LDA(At, 1, 0); PG8_STAGE(PG8_SA(0, 1), a2 + hstepA, voffA);
            PG8_WAIT_V(8); PG8_WAIT_L(0); PG8_BAR; PG8_MMA(0, 0, At, B0); PG8_MMA(0, 1, At, B1); PG8_BAR; PG8_SCHED;
            PG8_LDA(At, 1, 1); PG8_STAGE(PG8_SB(1, 0), b3, voffB); PG8_STAGE(PG8_SB(1, 1), b3 + hstepB, voffB); PG8_STAGE(PG8_SA(1, 0), a3, voffA);
            PG8_WAIT_V(8); PG8_WAIT_L(0); PG8_BAR; PG8_MMA(1, 0, At, B0); PG8_MMA(1, 1, At, B1); PG8_BAR; PG8_SCHED;
        }
        if (wr == 0) PG8_BAR;
        E(acc, cur, wr, wc, fr, fq);
        if (!has_next) break;
#pragma unroll
        for (int a = 0; a < 2; ++a)
#pragma unroll
            for (int b = 0; b < 2; ++b)
#pragma unroll
                for (int m = 0; m < 4; ++m)
#pragma unroll
                    for (int n = 0; n < 2; ++n) acc[a][b][m][n] = (f32x4){0.f, 0.f, 0.f, 0.f};
        cur = nxt; cA = nA; cB = nB; ++ui;
        if (wr == 1) PG8_BAR;
    }
    PG8_WAIT_V(0);
    PG8_BAR;
#undef PG8_SA
#undef PG8_SB
#undef PG8_STAGE
#undef PG8_LDA
#undef PG8_LDB
#undef PG8_MMA
#undef PG8_WAIT_V
#undef PG8_WAIT_L
#undef PG8_BAR
#undef PG8_SCHED
#undef PG8_UA
#undef PG8_UB
}
}

template <class F>
__device__ __forceinline__ void big_gemm(LAS unsigned char* ldsb, const bf16_t* A, int lda, const bf16_t* Bt, int K, int N, const F& f) {
    pg8::Gemm g{A, Bt, lda, K}; pg8::StaticOrder S; S.init(RL, N, (int)gridDim.x, (int)blockIdx.x);
    pg8::Epi<F> E{f};
    pg8::gemm_phase(ldsb, g, S, E);
    __syncthreads();
}
template <int NI>
__device__ __forceinline__ void gemm_kloop(f32x4 (&acc)[4][NI], const bf16_t* Ag, int lda, const bf16_t* Bg, int ldb, int K, char* lds) {
    const int tid = tid_l(), lane = tid & 63, wid = tid >> 6, wm = wid >> 1, wn = wid & 1, lr = lane & 15, lq = lane >> 4;
    u32x4 ra[4], rb[NI];
    const int prow = tid >> 3, pkc = tid & 7;
    const bf16_t* ap = Ag + (size_t)prow * lda + pkc * 8;
    const bf16_t* bp = Bg + (size_t)prow * ldb + pkc * 8;
    const int soff = prow * 128 + ((pkc ^ (prow & 7)) << 4);
#pragma unroll
    for (int i = 0; i < 4; ++i) { ra[i] = *(const u32x4*)(ap + (size_t)(32 * i) * lda); if (i < NI) rb[i < NI ? i : 0] = *(const u32x4*)(bp + (size_t)(32 * i) * ldb); }
#pragma unroll
    for (int i = 0; i < 4; ++i) { *(u32x4*)(lds + soff + i * 4096) = ra[i]; if (i < NI) *(u32x4*)(lds + 32768 + soff + i * 4096) = rb[i < NI ? i : 0]; }
    __syncthreads();
    const int nk = K >> 6;
    for (int kt = 0; kt < nk; ++kt) {
        const int buf = kt & 1;
        if (kt + 1 < nk) {
#pragma unroll
            for (int i = 0; i < 4; ++i) { ra[i] = *(const u32x4*)(ap + (size_t)(32 * i) * lda + (kt + 1) * 64); if (i < NI) rb[i < NI ? i : 0] = *(const u32x4*)(bp + (size_t)(32 * i) * ldb + (kt + 1) * 64); }
        }
        const char* la = lds + buf * 16384; const char* lb = lds + 32768 + buf * 16384;
#pragma unroll
        for (int kk = 0; kk < 2; ++kk) {
            bf16x8 af[4], bfr[NI];
            const int chunk = kk * 4 + lq;
#pragma unroll
            for (int mi = 0; mi < 4; ++mi) { const int row = wm * 64 + mi * 16 + lr; af[mi] = *(const bf16x8*)(la + row * 128 + ((chunk ^ (row & 7)) << 4)); }
#pragma unroll
            for (int ni = 0; ni < NI; ++ni) { const int row = wn * (16 * NI) + ni * 16 + lr; bfr[ni] = *(const bf16x8*)(lb + row * 128 + ((chunk ^ (row & 7)) << 4)); }
#pragma unroll
            for (int mi = 0; mi < 4; ++mi)
#pragma unroll
                for (int ni = 0; ni < NI; ++ni) acc[mi][ni] = __builtin_amdgcn_mfma_f32_16x16x32_bf16(bfr[ni], af[mi], acc[mi][ni], 0, 0, 0);
        }
        if (kt + 1 < nk) {
            char* sa = lds + (buf ^ 1) * 16384 + soff;
#pragma unroll
            for (int i = 0; i < 4; ++i) { *(u32x4*)(sa + i * 4096) = ra[i]; if (i < NI) *(u32x4*)(sa + 32768 + i * 4096) = rb[i < NI ? i : 0]; }
        }
        __syncthreads();
    }
}

__device__ __forceinline__ void tile_of(int t, int Mt, int Nt, int& tm, int& tn) {
    const int per = 8 * Nt; const int p = t / per; const int r = t - p * per; const int pm = (Mt - 8 * p) < 8 ? (Mt - 8 * p) : 8;
    tm = 8 * p + r % pm; tn = r / pm;
}

template <int TYPE> struct MX {
    static constexpr int DK = TYPE == 1 ? 128 : 64;
    static constexpr int NOC = DK / 8;
    static constexpr int PITCH = TYPE == 1 ? 2048 : 1536;
    static constexpr int QOFF = 0;
    static constexpr int KOFF = TYPE == 1 ? 512 : 256;
    static constexpr int VOFF = TYPE == 1 ? 1024 : 512;
    static constexpr int GOFF = TYPE == 1 ? 1536 : 1024;
    static constexpr int QP = DK + 16;
};
constexpr int L_VT = 0;
constexpr int L_Q = 20480;
constexpr int L_CUM = 40960;
constexpr int L_ATT = 57344;
constexpr int L_SC = 67584;
constexpr int L_SA = 68096;

template <int TYPE>
__device__ __forceinline__ void load_qk8(const Params& P, int l, const bf16_t* pb, int b, int c, int t, int h, int oc, bool isk, float (&f)[8], const float* wpre = nullptr) {
    typedef MX<TYPE> M;
    const int coff = (isk ? M::KOFF : M::QOFF) + h * M::DK;
    const size_t rowi = (size_t)(rowbase(b, c) + t);
    if (TYPE == 0) {
        const u32x4 u = *(const u32x4*)(pb + rowi * M::PITCH + coff + oc * 8); UNPACK8(u, f);
    } else if (TYPE == 1) {
        const bool hp = (t > 0) || (c != 0 && c != 4), hn = (t < 63) || (c != 3 && c != NCH - 1);
        const bf16_t* p0 = pb + rowi * M::PITCH + coff + oc * 8;
        u32x4 u1 = *(const u32x4*)p0, u0 = (u32x4){0u, 0u, 0u, 0u}, u2 = (u32x4){0u, 0u, 0u, 0u};
        if (hp) u0 = *(const u32x4*)(p0 - M::PITCH);
        if (hn) u2 = *(const u32x4*)(p0 + M::PITCH);
        float a[8], m[8], n[8]; UNPACK8(u0, a); UNPACK8(u1, m); UNPACK8(u2, n);
        float w0[8], w1[8], w2[8];
        if (wpre) {
#pragma unroll
            for (int j = 0; j < 8; ++j) { w0[j] = wpre[j]; w1[j] = wpre[8 + j]; w2[j] = wpre[16 + j]; }
        } else {
            const float* cw = P.in[I_CONV] + (size_t)l * 3 * 1024 + (isk ? 512 : 0) + h * 128 + oc * 8;
            const f32x4 w0a = *(const f32x4*)cw, w0b = *(const f32x4*)(cw + 4), w1a = *(const f32x4*)(cw + 1024), w1b = *(const f32x4*)(cw + 1028), w2a = *(const f32x4*)(cw + 2048), w2b = *(const f32x4*)(cw + 2052);
            w0[0] = w0a.x; w0[1] = w0a.y; w0[2] = w0a.z; w0[3] = w0a.w; w0[4] = w0b.x; w0[5] = w0b.y; w0[6] = w0b.z; w0[7] = w0b.w;
            w1[0] = w1a.x; w1[1] = w1a.y; w1[2] = w1a.z; w1[3] = w1a.w; w1[4] = w1b.x; w1[5] = w1b.y; w1[6] = w1b.z; w1[7] = w1b.w;
            w2[0] = w2a.x; w2[1] = w2a.y; w2[2] = w2a.z; w2[3] = w2a.w; w2[4] = w2b.x; w2[5] = w2b.y; w2[6] = w2b.z; w2[7] = w2b.w;
        }
#pragma unroll
        for (int j = 0; j < 8; ++j) f[j] = siluf(w0[j] * a[j] + w1[j] * m[j] + w2[j] * n[j]);
    } else {
        if (c < 4) { const u32x4 u = *(const u32x4*)(pb + rowi * M::PITCH + coff + oc * 8); UNPACK8(u, f); }
        else {
            const int o4 = oc & 3;
            const u32x4 ua = *(const u32x4*)(pb + rowi * M::PITCH + coff + o4 * 8), ub = *(const u32x4*)(pb + rowi * M::PITCH + coff + 32 + o4 * 8);
            float x1[8], x2[8]; UNPACK8(ua, x1); UNPACK8(ub, x2);
            const float* tab = (const float*)(ws_l(P) + WS_ROPE);
            const float* cs = o4 < 2 ? tab + (c - 4) * 16 + o4 * 8 : tab + 4096 + t * 16 + (o4 - 2) * 8;
            const float* sn = o4 < 2 ? tab + 2048 + (c - 4) * 16 + o4 * 8 : tab + 4096 + 1024 + t * 16 + (o4 - 2) * 8;
            const f32x4 ca = *(const f32x4*)cs, cb = *(const f32x4*)(cs + 4), sa = *(const f32x4*)sn, sb = *(const f32x4*)(sn + 4);
            const float cv[8] = {ca.x, ca.y, ca.z, ca.w, cb.x, cb.y, cb.z, cb.w}, sv[8] = {sa.x, sa.y, sa.z, sa.w, sb.x, sb.y, sb.z, sb.w};
#pragma unroll
            for (int j = 0; j < 8; ++j) f[j] = oc < 4 ? x1[j] * cv[j] - x2[j] * sv[j] : x1[j] * sv[j] + x2[j] * cv[j];
        }
    }
}

__device__ __forceinline__ void load_convw(const Params& P, int l, int h, int oc, bool isk, float (&w)[24]) {
    const float* cw = P.in[I_CONV] + (size_t)l * 3 * 1024 + (isk ? 512 : 0) + h * 128 + oc * 8;
#pragma unroll
    for (int tp = 0; tp < 3; ++tp) { const f32x4 a = *(const f32x4*)(cw + tp * 1024), b = *(const f32x4*)(cw + tp * 1024 + 4);
        w[tp * 8 + 0] = a.x; w[tp * 8 + 1] = a.y; w[tp * 8 + 2] = a.z; w[tp * 8 + 3] = a.w; w[tp * 8 + 4] = b.x; w[tp * 8 + 5] = b.y; w[tp * 8 + 6] = b.z; w[tp * 8 + 7] = b.w; }
}
template <int TYPE>
__device__ __forceinline__ void decay_setup(const Params& P, int l, int b, int c, int h, int dir, char* lds, const float* apre = nullptr) {
    const int tid = tid_l(); const int r0 = rowbase(b, c);
    float* sc = (float*)(lds + L_SC);
    const float* small = (const float*)(ws_l(P) + WS_SMALL);
    if (TYPE == 0) {
        float* cum = (float*)(lds + L_CUM); float* sa = (float*)(lds + L_SA);
        if (apre) {
#pragma unroll
            for (int k = 0; k < 4; ++k) sa[tid + k * NTHR] = apre[k];
        } else {
            for (int i = tid; i < 1024; i += NTHR) sa[i] = small[(size_t)(r0 + (i >> 4)) * 48 + dir * 16 + (i & 15)];
        }
        __syncthreads();
        const int d = tid & 63, tq = tid >> 6;
        const float* a2 = P.in[I_A2] + ((size_t)(l * 2 + dir) * 16) * 256 + h * 64 + d;
        float w[16];
#pragma unroll
        for (int rr = 0; rr < 16; ++rr) w[rr] = a2[rr * 256];
        const float bias = P.in[I_ABIAS][(l * 2 + dir) * 256 + h * 64 + d];
        float* blk = sa + 1024;
        float lv[16];
#pragma unroll
        for (int i = 0; i < 16; ++i) {
            const int t = tq * 16 + i;
            const f32x4 a0 = *(const f32x4*)(sa + t * 16), a1 = *(const f32x4*)(sa + t * 16 + 4), a2v = *(const f32x4*)(sa + t * 16 + 8), a3 = *(const f32x4*)(sa + t * 16 + 12);
            float z = bias;
            z += a0.x * w[0] + a0.y * w[1] + a0.z * w[2] + a0.w * w[3];
            z += a1.x * w[4] + a1.y * w[5] + a1.z * w[6] + a1.w * w[7];
            z += a2v.x * w[8] + a2v.y * w[9] + a2v.z * w[10] + a2v.w * w[11];
            z += a3.x * w[12] + a3.y * w[13] + a3.z * w[14] + a3.w * w[15];
            lv[i] = logsig_fast(z) * (1.f / 16.f);
        }
        if (dir == 0) {
#pragma unroll
            for (int i = 1; i < 16; ++i) lv[i] += lv[i - 1];
        } else {
#pragma unroll
            for (int i = 14; i >= 0; --i) lv[i] += lv[i + 1];
        }
        blk[tq * 64 + d] = dir == 0 ? lv[15] : lv[0];
        __syncthreads();
        float off = 0.f;
#pragma unroll
        for (int q = 0; q < 4; ++q) if (dir == 0 ? (q < tq) : (q > tq)) off += blk[q * 64 + d];
#pragma unroll
        for (int i = 0; i < 16; ++i) cum[(tq * 16 + i) * 64 + d] = lv[i] + off;
    } else if (TYPE == 1) {
        if (tid < 64) {
            const float fg = small[(size_t)(r0 + tid) * 48 + 40 + dir * 4 + h] + P.in[I_FB][l * 8 + dir * 4 + h];
            float v = logsig(fg);
            if (dir == 0) {
#pragma unroll
                for (int o = 1; o < 64; o <<= 1) { const float n = __shfl_up(v, o); if (tid >= o) v += n; }
            } else {
#pragma unroll
                for (int o = 1; o < 64; o <<= 1) { const float n = __shfl_down(v, o); if (tid + o < 64) v += n; }
            }
            const float tot = __shfl(v, dir == 0 ? 63 : 0);
            sc[tid] = v;
            sc[64 + tid] = small[(size_t)(r0 + tid) * 48 + 32 + dir * 4 + h] + P.in[I_IB][l * 8 + dir * 4 + h];
            if (tid == 0) sc[128] = tot;
        }
    } else {
        if (tid < 64) {
            const float lg = logsig(P.in[I_RDL][l * 8 + dir * 4 + h]);
            sc[tid] = (dir == 0 ? (float)(tid + 1) : (float)(64 - tid)) * lg;
            if (tid == 0) sc[128] = 64.f * lg;
        }
    }
    __syncthreads();
}

template <int TYPE>
__device__ __forceinline__ void build_vT(const bf16_t* pb, int b, int c, int h, char* lds) {
    typedef MX<TYPE> M;
    bf16_t* vT = (bf16_t*)(lds + L_VT);
#pragma unroll
    for (int i = 0; i < 2; ++i) {
        const int pid = tid_l() + i * NTHR, tp = pid & 31, oc = pid >> 5;
        const bf16_t* p0 = pb + (size_t)(rowbase(b, c) + 2 * tp) * M::PITCH + M::VOFF + h * 128 + oc * 8;
        const u32x4 u0 = *(const u32x4*)p0, u1 = *(const u32x4*)(p0 + M::PITCH);
        unsigned* dst = (unsigned*)(vT + (size_t)(oc * 8) * 80 + 2 * tp);
        dst[0 * 40] = (u0.x & 0xffffu) | (u1.x << 16); dst[1 * 40] = (u0.x >> 16) | (u1.x & 0xffff0000u);
        dst[2 * 40] = (u0.y & 0xffffu) | (u1.y << 16); dst[3 * 40] = (u0.y >> 16) | (u1.y & 0xffff0000u);
        dst[4 * 40] = (u0.z & 0xffffu) | (u1.z << 16); dst[5 * 40] = (u0.z >> 16) | (u1.z & 0xffff0000u);
        dst[6 * 40] = (u0.w & 0xffffu) | (u1.w << 16); dst[7 * 40] = (u0.w >> 16) | (u1.w & 0xffff0000u);
    }
}

__device__ __forceinline__ int scan_index(int dir, int c) { return dir == 0 ? c : (c < 4 ? 3 - c : 135 - c); }

template <int TYPE>
__device__ __forceinline__ void u_phase(const Params& P, int l, char* lds) {
    typedef MX<TYPE> M; constexpr int DK = M::DK;
    const int tid = tid_l(), lane = tid & 63, wid = tid >> 6, lr = lane & 15, lq = lane >> 4;
    const bf16_t* pb = (const bf16_t*)(ws_l(P) + WS_PBUF);
    bf16_t* U = (bf16_t*)(ws_l(P) + WS_SBUF); float* DEC = (float*)(ws_l(P) + WS_DEC); float* UN = (float*)(ws_l(P) + WS_UN);
    bf16_t* vT = (bf16_t*)(lds + L_VT); bf16_t* kT = (bf16_t*)(lds + L_Q);
    const float* cum = (const float*)(lds + L_CUM); const float* sc = (const float*)(lds + L_SC);
    const int NU = NB * 4 * 2 * NCH, VG = vgrid(), slot = bid_l();
    for (int u0 = 0; u0 < NU; u0 += VG) {
        int unit = u0 + slot; if (unit >= NU) unit = NU - 1;
        const int c = unit % NCH; const int rest = unit / NCH; const int dir = rest & 1, h = (rest >> 1) & 3, b = rest >> 3;
        const int chain = (b * 4 + h) * 2 + dir, n = scan_index(dir, c);
        static_assert(TYPE == 0, "the scalar-decay branches use u_phase_s");
        float k0[8], k1[8], apre[4];
        { const int tp = tid & 31, oc = tid >> 5;
          load_qk8<TYPE>(P, l, pb, b, c, 2 * tp, h, oc, true, k0);
          load_qk8<TYPE>(P, l, pb, b, c, 2 * tp + 1, h, oc, true, k1);
          const float* small = (const float*)(ws_l(P) + WS_SMALL); const int r0 = rowbase(b, c);
#pragma unroll
          for (int k = 0; k < 4; ++k) { const int i = tid + k * NTHR; apre[k] = small[(size_t)(r0 + (i >> 4)) * 48 + dir * 16 + (i & 15)]; } }
        build_vT<TYPE>(pb, b, c, h, lds);
        decay_setup<TYPE>(P, l, b, c, h, dir, lds, apre);
        const int tlast = dir == 0 ? 63 : 0;
        {
            const int pid = tid, tp = pid & 31, oc = pid >> 5;
            unsigned* dst = (unsigned*)(kT + (size_t)(oc * 8) * 80 + 2 * tp);
            if (TYPE == 0) {
#pragma unroll
                for (int j = 0; j < 8; ++j) { const int d = oc * 8 + j; const float tot = cum[tlast * 64 + d];
                    dst[j * 40] = cvt_pk(k0[j] * __expf(tot - cum[(2 * tp) * 64 + d]), k1[j] * __expf(tot - cum[(2 * tp + 1) * 64 + d])); }
            } else {
                const float tot = sc[128];
                const float w0 = TYPE == 1 ? __expf(tot - sc[2 * tp] + sc[64 + 2 * tp]) * 0.08838834764831845f : __expf(tot - sc[2 * tp]) * 0.125f;
                const float w1 = TYPE == 1 ? __expf(tot - sc[2 * tp + 1] + sc[64 + 2 * tp + 1]) * 0.08838834764831845f : __expf(tot - sc[2 * tp + 1]) * 0.125f;
#pragma unroll
                for (int j = 0; j < 8; ++j) dst[j * 40] = cvt_pk(k0[j] * w0, k1[j] * w1);
            }
        }
        __syncthreads();
        f32x4 acc[2][DK / 16];
#pragma unroll
        for (int i = 0; i < 2; ++i)
#pragma unroll
            for (int nt = 0; nt < DK / 16; ++nt) acc[i][nt] = (f32x4){0.f, 0.f, 0.f, 0.f};
#pragma unroll
        for (int kk = 0; kk < 2; ++kk) {
            bf16x8 fv[2];
#pragma unroll
            for (int i = 0; i < 2; ++i) fv[i] = *(const bf16x8*)(vT + (size_t)((2 * wid + i) * 16 + lr) * 80 + kk * 32 + lq * 8);
#pragma unroll
            for (int nt = 0; nt < DK / 16; ++nt) {
                const bf16x8 fk = *(const bf16x8*)(kT + (size_t)(nt * 16 + lr) * 80 + kk * 32 + lq * 8);
#pragma unroll
                for (int i = 0; i < 2; ++i) acc[i][nt] = __builtin_amdgcn_mfma_f32_16x16x32_bf16(fk, fv[i], acc[i][nt], 0, 0, 0);
            }
        }
        bf16_t* ub = U + (size_t)(chain * NCH + n) * 128 * DK;
#pragma unroll
        for (int i = 0; i < 2; ++i)
#pragma unroll
            for (int nt = 0; nt < DK / 16; ++nt) {
                const int e = (2 * wid + i) * 16 + lr, d = nt * 16 + lq * 4;
                u32x2 o; o.x = cvt_pk(acc[i][nt].x, acc[i][nt].y); o.y = cvt_pk(acc[i][nt].z, acc[i][nt].w);
                *(u32x2*)(ub + (size_t)e * DK + d) = o;
            }
        if (tid < DK) {
            const float tot = TYPE == 0 ? cum[tlast * 64 + (tid & 63)] : sc[128];
            DEC[(size_t)(chain * NCH + n) * 128 + tid] = __expf(tot);
            if (TYPE == 1) {
                float s = 0.f;
#pragma unroll
                for (int q = 0; q < 8; ++q) { const u32x4 u = *(const u32x4*)(kT + (size_t)tid * 80 + q * 8); float f[8]; UNPACK8(u, f);
#pragma unroll
                    for (int j = 0; j < 8; ++j) s += f[j]; }
                UN[(size_t)(chain * NCH + n) * 128 + tid] = s;
            }
        }
        __syncthreads();
    }
}

template <int TYPE>
__device__ __forceinline__ void u_phase_s(const Params& P, int l, char* lds) {
    typedef MX<TYPE> M; constexpr int DK = M::DK; constexpr int NIT = M::NOC * 32 / NTHR;
    const int tid = tid_l(), lane = tid & 63, wid = tid >> 6, lr = lane & 15, lq = lane >> 4;
    const bf16_t* pb = (const bf16_t*)(ws_l(P) + WS_PBUF);
    const float* small = (const float*)(ws_l(P) + WS_SMALL);
    bf16_t* U = (bf16_t*)(ws_l(P) + WS_SBUF); float* DEC = (float*)(ws_l(P) + WS_DEC); float* UN = (float*)(ws_l(P) + WS_UN);
    bf16_t* vT = (bf16_t*)(lds + L_VT); bf16_t* kT0 = (bf16_t*)(lds + 20480); bf16_t* kT1 = (bf16_t*)(lds + 40960);
    float* sc = (float*)(lds + L_SC);
    const int NU = NB * 4 * NCH, VG = vgrid(), slot = bid_l();
    for (int u0 = 0; u0 < NU; u0 += VG) {
        int unit = u0 + slot; int dmask = 3;
        if (VG == 512 && u0 >= 1024) { if (slot >= 2 * (NU - 1024)) continue; unit = 1024 + (slot >> 1); dmask = 1 << (slot & 1); }
        else if (unit >= NU) unit = NU - 1;
        const int c = unit % NCH; const int rest = unit / NCH; const int h = rest & 3, b = rest >> 2;
        const int r0 = rowbase(b, c);
        float kv[NIT][2][8];
#pragma unroll
        for (int i = 0; i < NIT; ++i) {
            const int pid = tid + i * NTHR, tp = pid & 31, oc = pid >> 5;
            load_qk8<TYPE>(P, l, pb, b, c, 2 * tp, h, oc, true, kv[i][0]);
            load_qk8<TYPE>(P, l, pb, b, c, 2 * tp + 1, h, oc, true, kv[i][1]);
        }
        if (TYPE == 1) {
            if (tid < 128) {
                const int dir = tid >> 6, t = tid & 63;
                const float fg = small[(size_t)(r0 + t) * 48 + 40 + dir * 4 + h] + P.in[I_FB][l * 8 + dir * 4 + h];
                float v = logsig(fg);
                if (dir == 0) {
#pragma unroll
                    for (int o = 1; o < 64; o <<= 1) { const float n = __shfl_up(v, o); if (t >= o) v += n; }
                } else {
#pragma unroll
                    for (int o = 1; o < 64; o <<= 1) { const float n = __shfl_down(v, o); if (t + o < 64) v += n; }
                }
                sc[dir * 64 + t] = v;
                sc[128 + dir * 64 + t] = small[(size_t)(r0 + t) * 48 + 32 + dir * 4 + h] + P.in[I_IB][l * 8 + dir * 4 + h];
            }
        } else {
            if (tid < 64) {
                const float lg0 = logsig(P.in[I_RDL][l * 8 + h]), lg1 = logsig(P.in[I_RDL][l * 8 + 4 + h]);
                sc[tid] = (float)(tid + 1) * lg0; sc[64 + tid] = (float)(64 - tid) * lg1;
            }
        }
        build_vT<TYPE>(pb, b, c, h, lds);
        __syncthreads();
        const float totf = sc[63], totb = sc[64];
        const float ks = TYPE == 1 ? 0.08838834764831845f : 0.125f;
#pragma unroll
        for (int i = 0; i < NIT; ++i) {
            const int pid = tid + i * NTHR, tp = pid & 31, oc = pid >> 5;
            const int t0 = 2 * tp, t1 = 2 * tp + 1;
            const float wf0 = __expf(totf - sc[t0] + (TYPE == 1 ? sc[128 + t0] : 0.f)) * ks, wf1 = __expf(totf - sc[t1] + (TYPE == 1 ? sc[128 + t1] : 0.f)) * ks;
            const float wb0 = __expf(totb - sc[64 + t0] + (TYPE == 1 ? sc[192 + t0] : 0.f)) * ks, wb1 = __expf(totb - sc[64 + t1] + (TYPE == 1 ? sc[192 + t1] : 0.f)) * ks;
            unsigned* d0 = (unsigned*)(kT0 + (size_t)(oc * 8) * 80 + 2 * tp); unsigned* d1 = (unsigned*)(kT1 + (size_t)(oc * 8) * 80 + 2 * tp);
#pragma unroll
            for (int j = 0; j < 8; ++j) { d0[j * 40] = cvt_pk(kv[i][0][j] * wf0, kv[i][1][j] * wf1); d1[j * 40] = cvt_pk(kv[i][0][j] * wb0, kv[i][1][j] * wb1); }
        }
        __syncthreads();
        const int chf = (b * 4 + h) * 2;
#pragma unroll 1
        for (int dir = 0; dir < 2; ++dir) {
            if (!((dmask >> dir) & 1)) continue;
            const bf16_t* kT = dir == 0 ? kT0 : kT1;
            const int n = scan_index(dir, c);
            f32x4 acc[2][DK / 16];
#pragma unroll
            for (int i = 0; i < 2; ++i)
#pragma unroll
                for (int nt = 0; nt < DK / 16; ++nt) acc[i][nt] = (f32x4){0.f, 0.f, 0.f, 0.f};
#pragma unroll
            for (int kk = 0; kk < 2; ++kk) {
                bf16x8 fv[2];
#pragma unroll
                for (int i = 0; i < 2; ++i) fv[i] = *(const bf16x8*)(vT + (size_t)((2 * wid + i) * 16 + lr) * 80 + kk * 32 + lq * 8);
#pragma unroll
                for (int nt = 0; nt < DK / 16; ++nt) {
                    const bf16x8 fk = *(const bf16x8*)(kT + (size_t)(nt * 16 + lr) * 80 + kk * 32 + lq * 8);
#pragma unroll
                    for (int i = 0; i < 2; ++i) acc[i][nt] = __builtin_amdgcn_mfma_f32_16x16x32_bf16(fk, fv[i], acc[i][nt], 0, 0, 0);
                }
            }
            bf16_t* ub = U + (size_t)((chf + dir) * NCH + n) * 128 * DK;
#pragma unroll
            for (int i = 0; i < 2; ++i)
#pragma unroll
                for (int nt = 0; nt < DK / 16; ++nt) {
                    const int e = (2 * wid + i) * 16 + lr, d = nt * 16 + lq * 4;
                    u32x2 o; o.x = cvt_pk(acc[i][nt].x, acc[i][nt].y); o.y = cvt_pk(acc[i][nt].z, acc[i][nt].w);
                    *(u32x2*)(ub + (size_t)e * DK + d) = o;
                }
        }
        if (tid < 2 * DK) {
            const int dir = tid / DK, d = tid % DK; const int n = scan_index(dir, c);
            if ((dmask >> dir) & 1) {
            DEC[(size_t)((chf + dir) * NCH + n) * 128 + d] = __expf(dir == 0 ? totf : totb);
            if (TYPE == 1) {
                const bf16_t* kT = dir == 0 ? kT0 : kT1;
                float sum = 0.f;
#pragma unroll
                for (int q = 0; q < 8; ++q) { const u32x4 u = *(const u32x4*)(kT + (size_t)d * 80 + q * 8); float f[8]; UNPACK8(u, f);
#pragma unroll
                    for (int j = 0; j < 8; ++j) sum += f[j]; }
                UN[(size_t)((chf + dir) * NCH + n) * 128 + d] = sum;
            }
            }
        }
        __syncthreads();
    }
}

template <int DK, bool HASN>
__device__ __forceinline__ void scan_phase(const Params& P) {
    bf16_t* U = (bf16_t*)(ws_l(P) + WS_SBUF); const float* DEC = (const float*)(ws_l(P) + WS_DEC); float* UN = (float*)(ws_l(P) + WS_UN);
    constexpr int VEC = DK / 64;
    constexpr int DQ = DK / VEC; constexpr int TT = 16 * 128 * DQ;
    constexpr size_t US = (size_t)128 * DK;
    for (int g = bid_l() * NTHR + tid_l(); g < TT; g += vgrid() * NTHR) {
        const int dq = g % DQ, e = (g / DQ) % 128, chain = g / (DQ * 128);
        bf16_t* up = U + ((size_t)chain * NCH * 128 + e) * DK + dq * VEC;
        const float* dp = DEC + (size_t)chain * NCH * 128 + dq * VEC;
        float S0 = 0.f, S1 = 0.f;
        constexpr int SB = 12;
        unsigned ua[SB], ubv[SB]; f32x2 da[SB], db[SB];
#define SC_LOAD(uu, dd, n0) do { _Pragma("unroll") for (int j = 0; j < SB; ++j) { \
            if (VEC == 2) { uu[j] = *(const unsigned*)(up + (size_t)((n0) + j) * US); dd[j] = *(const f32x2*)(dp + (size_t)((n0) + j) * 128); } \
            else { uu[j] = (unsigned)up[(size_t)((n0) + j) * US]; dd[j].x = dp[(size_t)((n0) + j) * 128]; dd[j].y = 0.f; } } } while (0)
#define SC_STEP(uu, dd, n0) do { _Pragma("unroll") for (int j = 0; j < SB; ++j) { \
            if (VEC == 2) { *(unsigned*)(up + (size_t)((n0) + j) * US) = cvt_pk(S0, S1); S0 = dd[j].x * S0 + bflo(uu[j]); S1 = dd[j].y * S1 + bfhi(uu[j]); } \
            else { up[(size_t)((n0) + j) * US] = (bf16_t)(cvt_pk(S0, 0.f) & 0xffffu); S0 = dd[j].x * S0 + bflo(uu[j]); } } } while (0)
        SC_LOAD(ua, da, 0);
        for (int n0 = 0; n0 < 120; n0 += 24) {
            SC_LOAD(ubv, db, n0 + 12);
            SC_STEP(ua, da, n0);
            SC_LOAD(ua, da, n0 + 24);
            SC_STEP(ubv, db, n0 + 12);
        }
        SC_STEP(ua, da, 120);
#undef SC_LOAD
#undef SC_STEP
    }
    if (HASN) {
        for (int g = bid_l() * NTHR + tid_l(); g < 16 * 128; g += vgrid() * NTHR) {
            const int d = g & 127, chain = g >> 7;
            float* np = UN + (size_t)chain * NCH * 128 + d; const float* dp = DEC + (size_t)chain * NCH * 128 + d;
            float S = 0.f;
            float ua_[12], da_[12], ub_[12], db_[12];
#define NS_LOAD(uu, dd, n0) do { _Pragma("unroll") for (int j = 0; j < 12; ++j) { uu[j] = np[(size_t)((n0) + j) * 128]; dd[j] = dp[(size_t)((n0) + j) * 128]; } } while (0)
#define NS_STEP(uu, dd, n0) do { _Pragma("unroll") for (int j = 0; j < 12; ++j) { np[(size_t)((n0) + j) * 128] = S; S = dd[j] * S + uu[j]; } } while (0)
            NS_LOAD(ua_, da_, 0);
            for (int n0 = 0; n0 < 120; n0 += 24) {
                NS_LOAD(ub_, db_, n0 + 12);
                NS_STEP(ua_, da_, n0);
                NS_LOAD(ua_, da_, n0 + 24);
                NS_STEP(ub_, db_, n0 + 12);
            }
            NS_STEP(ua_, da_, 120);
#undef NS_LOAD
#undef NS_STEP
        }
    }
}

template <int TYPE>
__device__ __forceinline__ void out_phase(const Params& P, int l, int pass, bool latent_only, char* lds) {
    typedef MX<TYPE> M; constexpr int DK = M::DK; constexpr int QP = M::QP;
    const int tid = tid_l(), lane = tid & 63, wid = tid >> 6, lr = lane & 15, lq = lane >> 4;
    const bf16_t* pb = (const bf16_t*)(ws_l(P) + WS_PBUF);
    const bf16_t* U = (const bf16_t*)(ws_l(P) + WS_SBUF); const float* UN = (const float*)(ws_l(P) + WS_UN);
    bf16_t* brp = (bf16_t*)(ws_l(P) + WS_BR);
    bf16_t* vT = (bf16_t*)(lds + L_VT); bf16_t* qin = (bf16_t*)(lds + L_Q); bf16_t* kin = qin + 64 * QP; bf16_t* att = (bf16_t*)(lds + L_ATT);
    const float* cum = (const float*)(lds + L_CUM); const float* sc = (const float*)(lds + L_SC);
    const float* ng = P.in[TYPE == 0 ? I_GNG : (TYPE == 1 ? I_MNG : I_RNG)] + l * 512;
    const int NC = latent_only ? NCH - 4 : NCH; const int NU = NB * 4 * NC, VG = vgrid(), slot = bid_l();
    for (int u0 = 0; u0 < NU; u0 += VG) {
        int unit = u0 + slot; if (unit >= NU) unit = NU - 1;
        const int c = unit % NC + (latent_only ? 4 : 0); const int rest = unit / NC; const int h = rest & 3, b = rest >> 2;
        const int r0 = rowbase(b, c);
        build_vT<TYPE>(pb, b, c, h, lds);
        f32x4 tot[8];
#pragma unroll
        for (int et = 0; et < 8; ++et) tot[et] = (f32x4){0.f, 0.f, 0.f, 0.f};
        const int trow = wid * 16 + lr;
        for (int dir = 0; dir < 2; ++dir) {
            const int chain = (b * 4 + h) * 2 + dir, n = scan_index(dir, c);
            decay_setup<TYPE>(P, l, b, c, h, dir, lds);
#pragma unroll 2
            for (int i = 0; i < 64 * M::NOC / NTHR; ++i) {
                const int pid = tid + i * NTHR, t = pid / M::NOC, oc = pid % M::NOC;
                float q8[8], k8[8];
                load_qk8<TYPE>(P, l, pb, b, c, t, h, oc, false, q8);
                load_qk8<TYPE>(P, l, pb, b, c, t, h, oc, true, k8);
                if (TYPE == 0) {
#pragma unroll
                    for (int j = 0; j < 8; ++j) { const float cv = cum[t * 64 + oc * 8 + j]; q8[j] *= __expf(cv) * 0.125f; k8[j] *= __expf(-cv); }
                } else {
                    const float cv = sc[t];
                    const float wq = __expf(cv);
                    const float wk = TYPE == 1 ? __expf(sc[64 + t] - cv) * 0.08838834764831845f : __expf(-cv) * 0.125f;
#pragma unroll
                    for (int j = 0; j < 8; ++j) { q8[j] *= wq; k8[j] *= wk; }
                }
                u32x4 oq, ok;
                oq.x = cvt_pk(q8[0], q8[1]); oq.y = cvt_pk(q8[2], q8[3]); oq.z = cvt_pk(q8[4], q8[5]); oq.w = cvt_pk(q8[6], q8[7]);
                ok.x = cvt_pk(k8[0], k8[1]); ok.y = cvt_pk(k8[2], k8[3]); ok.z = cvt_pk(k8[4], k8[5]); ok.w = cvt_pk(k8[6], k8[7]);
                *(u32x4*)(qin + (size_t)t * QP + oc * 8) = oq;
                *(u32x4*)(kin + (size_t)t * QP + oc * 8) = ok;
            }
            __syncthreads();
            f32x4 sacc[4];
#pragma unroll
            for (int nt = 0; nt < 4; ++nt) sacc[nt] = (f32x4){0.f, 0.f, 0.f, 0.f};
#pragma unroll
            for (int kk = 0; kk < DK / 32; ++kk) {
                const bf16x8 fq = *(const bf16x8*)(qin + (size_t)trow * QP + kk * 32 + lq * 8);
#pragma unroll
                for (int nt = 0; nt < 4; ++nt) {
                    const bf16x8 fk = *(const bf16x8*)(kin + (size_t)(nt * 16 + lr) * QP + kk * 32 + lq * 8);
                    sacc[nt] = __builtin_amdgcn_mfma_f32_16x16x32_bf16(fk, fq, sacc[nt], 0, 0, 0);
                }
            }
            float den = 0.f;
#pragma unroll
            for (int nt = 0; nt < 4; ++nt) {
                const int s0 = nt * 16 + lq * 4;
                float a0 = sacc[nt].x, a1 = sacc[nt].y, a2 = sacc[nt].z, a3 = sacc[nt].w;
                if (dir == 0) { if (s0 + 0 > trow) a0 = 0.f; if (s0 + 1 > trow) a1 = 0.f; if (s0 + 2 > trow) a2 = 0.f; if (s0 + 3 > trow) a3 = 0.f; }
                else { if (s0 + 0 < trow) a0 = 0.f; if (s0 + 1 < trow) a1 = 0.f; if (s0 + 2 < trow) a2 = 0.f; if (s0 + 3 < trow) a3 = 0.f; }
                den += (a0 + a1) + (a2 + a3);
                u32x2 o; o.x = cvt_pk(a0, a1); o.y = cvt_pk(a2, a3);
                *(u32x2*)(att + (size_t)trow * 80 + s0) = o;
            }
            __syncthreads();
            f32x4 oacc[8];
#pragma unroll
            for (int et = 0; et < 8; ++et) oacc[et] = (f32x4){0.f, 0.f, 0.f, 0.f};
#pragma unroll
            for (int kk = 0; kk < 2; ++kk) {
                const bf16x8 fa = *(const bf16x8*)(att + (size_t)trow * 80 + kk * 32 + lq * 8);
#pragma unroll
                for (int et = 0; et < 8; ++et) {
                    const bf16x8 fv = *(const bf16x8*)(vT + (size_t)(et * 16 + lr) * 80 + kk * 32 + lq * 8);
                    oacc[et] = __builtin_amdgcn_mfma_f32_16x16x32_bf16(fv, fa, oacc[et], 0, 0, 0);
                }
            }
            const bf16_t* sp = U + (size_t)(chain * NCH + n) * 128 * DK;
#pragma unroll
            for (int kk = 0; kk < DK / 32; ++kk) {
                const bf16x8 fq = *(const bf16x8*)(qin + (size_t)trow * QP + kk * 32 + lq * 8);
#pragma unroll
                for (int et = 0; et < 8; ++et) {
                    const bf16x8 fs = *(const bf16x8*)(sp + (size_t)(et * 16 + lr) * DK + kk * 32 + lq * 8);
                    oacc[et] = __builtin_amdgcn_mfma_f32_16x16x32_bf16(fs, fq, oacc[et], 0, 0, 0);
                }
            }
            if (TYPE == 1) {
                const float* np = UN + (size_t)(chain * NCH + n) * 128 + lq * 32;
#pragma unroll
                for (int q = 0; q < 4; ++q) {
                    const u32x4 u = *(const u32x4*)(qin + (size_t)trow * QP + lq * 32 + q * 8); float f[8]; UNPACK8(u, f);
                    const f32x4 n0 = *(const f32x4*)(np + q * 8), n1 = *(const f32x4*)(np + q * 8 + 4);
                    den += f[0] * n0.x + f[1] * n0.y + f[2] * n0.z + f[3] * n0.w + f[4] * n1.x + f[5] * n1.y + f[6] * n1.z + f[7] * n1.w;
                }
                den += __shfl_xor(den, 16); den += __shfl_xor(den, 32);
                const float sc1 = 1.f / fmaxf(fabsf(den), 1.f);
#pragma unroll
                for (int et = 0; et < 8; ++et) tot[et] += oacc[et] * sc1;
            } else {
#pragma unroll
                for (int et = 0; et < 8; ++et) tot[et] += oacc[et];
            }
            __syncthreads();
        }
        float s1 = 0.f;
#pragma unroll
        for (int et = 0; et < 8; ++et) s1 += (tot[et].x + tot[et].y) + (tot[et].z + tot[et].w);
        s1 += __shfl_xor(s1, 16); s1 += __shfl_xor(s1, 32);
        const float mean = TYPE == 0 ? 0.f : s1 * (1.f / 128.f);
        float s2 = 0.f;
#pragma unroll
        for (int et = 0; et < 8; ++et) { tot[et] = tot[et] - mean; s2 += (tot[et].x * tot[et].x + tot[et].y * tot[et].y) + (tot[et].z * tot[et].z + tot[et].w * tot[et].w); }
        s2 += __shfl_xor(s2, 16); s2 += __shfl_xor(s2, 32);
        const float rstd = rsqrtf(s2 * (1.f / 128.f) + 1e-6f);
        const size_t rowi = (size_t)(r0 + trow);
#pragma unroll
        for (int et = 0; et < 8; ++et) {
            const int e = et * 16 + lq * 4;
            const f32x4 gg = *(const f32x4*)(ng + h * 128 + e);
            const u32x2 gu = *(const u32x2*)(pb + rowi * M::PITCH + M::GOFF + h * 128 + e);
            const float g0 = bflo(gu.x), g1 = bfhi(gu.x), g2 = bflo(gu.y), g3 = bfhi(gu.y);
            u32x2 o;
            float y0 = tot[et].x * rstd * gg.x * siluf(g0), y1 = tot[et].y * rstd * gg.y * siluf(g1), y2 = tot[et].z * rstd * gg.z * siluf(g2), y3 = tot[et].w * rstd * gg.w * siluf(g3);
            o.x = cvt_pk(y0, y1); o.y = cvt_pk(y2, y3);
            *(u32x2*)(brp + rowi * 1536 + pass * 512 + h * 128 + e) = o;
        }
        __syncthreads();
    }
}

template <int TYPE>
__device__ __forceinline__ void out_phase_s(const Params& P, int l, int pass, bool latent_only, char* lds) {
    typedef MX<TYPE> M; constexpr int DK = M::DK; constexpr int QP = M::QP; constexpr int NKK = DK / 32;
    const bf16_t* pb = (const bf16_t*)(ws_l(P) + WS_PBUF);
    const bf16_t* U = (const bf16_t*)(ws_l(P) + WS_SBUF); const float* UN = (const float*)(ws_l(P) + WS_UN);
    const float* small = (const float*)(ws_l(P) + WS_SMALL);
    bf16_t* brp = (bf16_t*)(ws_l(P) + WS_BR);
    bf16_t* vT = (bf16_t*)(lds + L_VT); bf16_t* qr = (bf16_t*)(lds + L_Q); bf16_t* kr = qr + 64 * QP; bf16_t* att = (bf16_t*)(lds + L_ATT);
    float* sc = (float*)(lds + L_SC);
    float* sn = sc + 256;
    float* rsv = sc + 512;
    float* part = sc + 640;
    const float* ng = P.in[TYPE == 1 ? I_MNG : I_RNG] + l * 512;
    const int NC = latent_only ? NCH - 4 : NCH; const int NU = NB * 4 * NC, VG = vgrid(), slot = bid_l();
    for (int u0 = 0; u0 < NU; u0 += VG) {
        int unit = u0 + slot; if (unit >= NU) unit = NU - 1;
        const int tid = tid_l(), lane = tid & 63, wid = tid >> 6, lr = lane & 15, lq = lane >> 4;
        const int c = unit % NC + (latent_only ? 4 : 0); const int rest = unit / NC; const int h = rest & 3, b = rest >> 2;
        const int r0 = rowbase(b, c);
        const int trow = wid * 16 + lr;
        const int chf = (b * 4 + h) * 2, nf = scan_index(0, c), nb = scan_index(1, c);
        const bf16_t* spf = U + (size_t)(chf * NCH + nf) * 128 * DK; const bf16_t* spb = U + (size_t)((chf + 1) * NCH + nb) * 128 * DK;
        bf16x8 fsf[2][NKK], fsb[2][NKK];
#pragma unroll
        for (int i = 0; i < 2; ++i)
#pragma unroll
            for (int kk = 0; kk < NKK; ++kk) {
                fsf[i][kk] = *(const bf16x8*)(spf + (size_t)((2 * wid + i) * 16 + lr) * DK + kk * 32 + lq * 8);
                fsb[i][kk] = *(const bf16x8*)(spb + (size_t)((2 * wid + i) * 16 + lr) * DK + kk * 32 + lq * 8);
            }
        u32x2 gu[4][2];
#pragma unroll
        for (int mt = 0; mt < 4; ++mt)
#pragma unroll
            for (int i = 0; i < 2; ++i) gu[mt][i] = *(const u32x2*)(pb + (size_t)(r0 + mt * 16 + lr) * M::PITCH + M::GOFF + h * 128 + (2 * wid + i) * 16 + lq * 4);
        if (TYPE == 1) {
            sn[tid] = UN[(size_t)((chf + (tid >> 7)) * NCH + ((tid >> 7) == 0 ? nf : nb)) * 128 + (tid & 127)];
            if (tid < 128) {
                const int dir = tid >> 6, t = tid & 63;
                const float fg = small[(size_t)(r0 + t) * 48 + 40 + dir * 4 + h] + P.in[I_FB][l * 8 + dir * 4 + h];
                float v = logsig(fg);
                if (dir == 0) {
#pragma unroll
                    for (int o = 1; o < 64; o <<= 1) { const float n = __shfl_up(v, o); if (t >= o) v += n; }
                } else {
#pragma unroll
                    for (int o = 1; o < 64; o <<= 1) { const float n = __shfl_down(v, o); if (t + o < 64) v += n; }
                }
                sc[dir * 64 + t] = v;
                sc[128 + dir * 64 + t] = small[(size_t)(r0 + t) * 48 + 32 + dir * 4 + h] + P.in[I_IB][l * 8 + dir * 4 + h];
            }
        } else {
            if (tid < 64) {
                const float lg0 = logsig(P.in[I_RDL][l * 8 + h]), lg1 = logsig(P.in[I_RDL][l * 8 + 4 + h]);
                sc[tid] = (float)(tid + 1) * lg0; sc[64 + tid] = (float)(64 - tid) * lg1;
            }
        }
        float wq[24], wk[24];
        if (TYPE == 1) { load_convw(P, l, h, tid % M::NOC, false, wq); load_convw(P, l, h, tid % M::NOC, true, wk); }
        build_vT<TYPE>(pb, b, c, h, lds);
#pragma unroll
        for (int i = 0; i < 64 * M::NOC / NTHR; ++i) {
            const int pid = tid + i * NTHR, t = pid / M::NOC, oc = pid % M::NOC;
            float q8[8], k8[8];
            load_qk8<TYPE>(P, l, pb, b, c, t, h, oc, false, q8, TYPE == 1 ? wq : nullptr);
            load_qk8<TYPE>(P, l, pb, b, c, t, h, oc, true, k8, TYPE == 1 ? wk : nullptr);
            const float ks = TYPE == 1 ? 0.08838834764831845f : 0.125f;
            u32x4 oq, ok;
            oq.x = cvt_pk(q8[0], q8[1]); oq.y = cvt_pk(q8[2], q8[3]); oq.z = cvt_pk(q8[4], q8[5]); oq.w = cvt_pk(q8[6], q8[7]);
            ok.x = cvt_pk(k8[0] * ks, k8[1] * ks); ok.y = cvt_pk(k8[2] * ks, k8[3] * ks); ok.z = cvt_pk(k8[4] * ks, k8[5] * ks); ok.w = cvt_pk(k8[6] * ks, k8[7] * ks);
            *(u32x4*)(qr + (size_t)t * QP + oc * 8) = oq;
            *(u32x4*)(kr + (size_t)t * QP + oc * 8) = ok;
        }
        __syncthreads();
        f32x4 sacc[4];
#pragma unroll
        for (int nt = 0; nt < 4; ++nt) sacc[nt] = (f32x4){0.f, 0.f, 0.f, 0.f};
#pragma unroll
        for (int kk = 0; kk < NKK; ++kk) {
            const bf16x8 fq = *(const bf16x8*)(qr + (size_t)trow * QP + kk * 32 + lq * 8);
#pragma unroll
            for (int nt = 0; nt < 4; ++nt) {
                const bf16x8 fk = *(const bf16x8*)(kr + (size_t)(nt * 16 + lr) * QP + kk * 32 + lq * 8);
                sacc[nt] = __builtin_amdgcn_mfma_f32_16x16x32_bf16(fk, fq, sacc[nt], 0, 0, 0);
            }
        }
        {
            const float cft = sc[trow], cbt = sc[64 + trow];
            const float eft = __expf(cft), ebt = __expf(cbt);
            float af[4][4], ab[4][4]; float denf = 0.f, denb = 0.f;
#pragma unroll
            for (int nt = 0; nt < 4; ++nt) {
                const float av[4] = {sacc[nt].x, sacc[nt].y, sacc[nt].z, sacc[nt].w};
#pragma unroll
                for (int r = 0; r < 4; ++r) {
                    const int s_ = nt * 16 + lq * 4 + r;
                    const float argf = cft - sc[s_] + (TYPE == 1 ? sc[128 + s_] : 0.f), argb = cbt - sc[64 + s_] + (TYPE == 1 ? sc[192 + s_] : 0.f);
                    const float wf = s_ <= trow ? __expf(argf) : 0.f, wb = s_ >= trow ? __expf(argb) : 0.f;
                    af[nt][r] = av[r] * wf; ab[nt][r] = av[r] * wb; denf += af[nt][r]; denb += ab[nt][r];
                }
            }
            float scf = 1.f, scb = 1.f;
            if (TYPE == 1) {
                float qf = 0.f, qb = 0.f;
#pragma unroll
                for (int q = 0; q < 4; ++q) {
                    const u32x4 u = *(const u32x4*)(qr + (size_t)trow * QP + lq * 32 + q * 8); float f[8]; UNPACK8(u, f);
                    const float* a = sn + lq * 32 + q * 8; const float* bq = sn + 128 + lq * 32 + q * 8;
                    const f32x4 a0 = *(const f32x4*)a, a1 = *(const f32x4*)(a + 4), b0 = *(const f32x4*)bq, b1 = *(const f32x4*)(bq + 4);
                    qf += f[0] * a0.x + f[1] * a0.y + f[2] * a0.z + f[3] * a0.w + f[4] * a1.x + f[5] * a1.y + f[6] * a1.z + f[7] * a1.w;
                    qb += f[0] * b0.x + f[1] * b0.y + f[2] * b0.z + f[3] * b0.w + f[4] * b1.x + f[5] * b1.y + f[6] * b1.z + f[7] * b1.w;
                }
                denf += eft * qf; denb += ebt * qb;
                denf += __shfl_xor(denf, 16); denf += __shfl_xor(denf, 32);
                denb += __shfl_xor(denb, 16); denb += __shfl_xor(denb, 32);
                scf = 1.f / fmaxf(fabsf(denf), 1.f); scb = 1.f / fmaxf(fabsf(denb), 1.f);
            }
#pragma unroll
            for (int nt = 0; nt < 4; ++nt) {
                u32x2 o; o.x = cvt_pk(af[nt][0] * scf + ab[nt][0] * scb, af[nt][1] * scf + ab[nt][1] * scb); o.y = cvt_pk(af[nt][2] * scf + ab[nt][2] * scb, af[nt][3] * scf + ab[nt][3] * scb);
                *(u32x2*)(att + (size_t)trow * 80 + nt * 16 + lq * 4) = o;
            }
            if (lq == 0) { rsv[trow] = eft * scf; rsv[64 + trow] = ebt * scb; }
        }
        __syncthreads();
        f32x4 oacc[4][2];
#pragma unroll
        for (int mt = 0; mt < 4; ++mt)
#pragma unroll
            for (int i = 0; i < 2; ++i) oacc[mt][i] = (f32x4){0.f, 0.f, 0.f, 0.f};
#pragma unroll
        for (int kk = 0; kk < 2; ++kk) {
            bf16x8 fv[2];
#pragma unroll
            for (int i = 0; i < 2; ++i) fv[i] = *(const bf16x8*)(vT + (size_t)((2 * wid + i) * 16 + lr) * 80 + kk * 32 + lq * 8);
#pragma unroll
            for (int mt = 0; mt < 4; ++mt) {
                const bf16x8 fa = *(const bf16x8*)(att + (size_t)(mt * 16 + lr) * 80 + kk * 32 + lq * 8);
#pragma unroll
                for (int i = 0; i < 2; ++i) oacc[mt][i] = __builtin_amdgcn_mfma_f32_16x16x32_bf16(fv[i], fa, oacc[mt][i], 0, 0, 0);
            }
        }
#pragma unroll
        for (int dir = 0; dir < 2; ++dir) {
            f32x4 tmp[4][2];
#pragma unroll
            for (int mt = 0; mt < 4; ++mt)
#pragma unroll
                for (int i = 0; i < 2; ++i) tmp[mt][i] = (f32x4){0.f, 0.f, 0.f, 0.f};
#pragma unroll
            for (int kk = 0; kk < NKK; ++kk)
#pragma unroll
                for (int mt = 0; mt < 4; ++mt) {
                    const bf16x8 fq = *(const bf16x8*)(qr + (size_t)(mt * 16 + lr) * QP + kk * 32 + lq * 8);
#pragma unroll
                    for (int i = 0; i < 2; ++i) tmp[mt][i] = __builtin_amdgcn_mfma_f32_16x16x32_bf16(dir == 0 ? fsf[i][kk] : fsb[i][kk], fq, tmp[mt][i], 0, 0, 0);
                }
#pragma unroll
            for (int mt = 0; mt < 4; ++mt) {
                const float rs = rsv[dir * 64 + mt * 16 + lr];
#pragma unroll
                for (int i = 0; i < 2; ++i) oacc[mt][i] += tmp[mt][i] * rs;
            }
        }
#pragma unroll
        for (int mt = 0; mt < 4; ++mt) {
            float s1 = (oacc[mt][0].x + oacc[mt][0].y) + (oacc[mt][0].z + oacc[mt][0].w) + (oacc[mt][1].x + oacc[mt][1].y) + (oacc[mt][1].z + oacc[mt][1].w);
            float s2 = (oacc[mt][0].x * oacc[mt][0].x + oacc[mt][0].y * oacc[mt][0].y) + (oacc[mt][0].z * oacc[mt][0].z + oacc[mt][0].w * oacc[mt][0].w)
                     + (oacc[mt][1].x * oacc[mt][1].x + oacc[mt][1].y * oacc[mt][1].y) + (oacc[mt][1].z * oacc[mt][1].z + oacc[mt][1].w * oacc[mt][1].w);
            s1 += __shfl_xor(s1, 16); s1 += __shfl_xor(s1, 32); s2 += __shfl_xor(s2, 16); s2 += __shfl_xor(s2, 32);
            if (lq == 0) { part[(wid * 64 + mt * 16 + lr) * 2] = s1; part[(wid * 64 + mt * 16 + lr) * 2 + 1] = s2; }
        }
        __syncthreads();
#pragma unroll
        for (int mt = 0; mt < 4; ++mt) {
            const int t = mt * 16 + lr;
            float s1 = 0.f, s2 = 0.f;
#pragma unroll
            for (int w = 0; w < 4; ++w) { s1 += part[(w * 64 + t) * 2]; s2 += part[(w * 64 + t) * 2 + 1]; }
            const float mean = s1 * (1.f / 128.f);
            const float rstd = rsqrtf(fmaxf(s2 * (1.f / 128.f) - mean * mean, 0.f) + 1e-6f);
            const size_t rowi = (size_t)(r0 + t);
#pragma unroll
            for (int i = 0; i < 2; ++i) {
                const int e = (2 * wid + i) * 16 + lq * 4;
                const f32x4 gg = *(const f32x4*)(ng + h * 128 + e);
                const float g0 = bflo(gu[mt][i].x), g1 = bfhi(gu[mt][i].x), g2 = bflo(gu[mt][i].y), g3 = bfhi(gu[mt][i].y);
                u32x2 o;
                o.x = cvt_pk((oacc[mt][i].x - mean) * rstd * gg.x * siluf(g0), (oacc[mt][i].y - mean) * rstd * gg.y * siluf(g1));
                o.y = cvt_pk((oacc[mt][i].z - mean) * rstd * gg.z * siluf(g2), (oacc[mt][i].w - mean) * rstd * gg.w * siluf(g3));
                *(u32x2*)(brp + rowi * 1536 + pass * 512 + h * 128 + e) = o;
            }
        }
        __syncthreads();
    }
}

__device__ __forceinline__ void out_phase_g(const Params& P, int l, bool latent_only, char* lds) {
    typedef MX<0> M; constexpr int DK = 64, QP = 80;
    const bf16_t* pb = (const bf16_t*)(ws_l(P) + WS_PBUF);
    const bf16_t* U = (const bf16_t*)(ws_l(P) + WS_SBUF);
    const float* small = (const float*)(ws_l(P) + WS_SMALL);
    bf16_t* brp = (bf16_t*)(ws_l(P) + WS_BR);
    bf16_t* vT = (bf16_t*)(lds + L_VT); bf16_t* qin = (bf16_t*)(lds + L_Q); bf16_t* kin = qin + 64 * QP; bf16_t* att = (bf16_t*)(lds + L_ATT);
    float* cum = (float*)(lds + L_CUM); float* part = cum;
    const float* ng = P.in[I_GNG] + l * 512;
    const int NC = latent_only ? NCH - 4 : NCH; const int NU = NB * 4 * NC, VG = vgrid(), slot = bid_l();
    for (int u0 = 0; u0 < NU; u0 += VG) {
        int unit = u0 + slot; if (unit >= NU) unit = NU - 1;
        const int tid = tid_l(), lane = tid & 63, wid = tid >> 6, lr = lane & 15, lq = lane >> 4;
        const int c = unit % NC + (latent_only ? 4 : 0); const int rest = unit / NC; const int h = rest & 3, b = rest >> 2;
        const int r0 = rowbase(b, c);
        const int trow = wid * 16 + lr;
        const int chf = (b * 4 + h) * 2, nf = scan_index(0, c), nb = scan_index(1, c);
        const bf16_t* spf = U + (size_t)(chf * NCH + nf) * 128 * DK; const bf16_t* spb = U + (size_t)((chf + 1) * NCH + nb) * 128 * DK;
        bf16x8 fsf[2][2], fsb[2][2];
#pragma unroll
        for (int i = 0; i < 2; ++i)
#pragma unroll
            for (int kk = 0; kk < 2; ++kk) {
                fsf[i][kk] = *(const bf16x8*)(spf + (size_t)((2 * wid + i) * 16 + lr) * DK + kk * 32 + lq * 8);
                fsb[i][kk] = *(const bf16x8*)(spb + (size_t)((2 * wid + i) * 16 + lr) * DK + kk * 32 + lq * 8);
            }
        u32x2 gu[4][2];
#pragma unroll
        for (int mt = 0; mt < 4; ++mt)
#pragma unroll
            for (int i = 0; i < 2; ++i) gu[mt][i] = *(const u32x2*)(pb + (size_t)(r0 + mt * 16 + lr) * M::PITCH + M::GOFF + h * 128 + (2 * wid + i) * 16 + lq * 4);
        float qraw[2][8], kraw[2][8], apre[2][4];
#pragma unroll
        for (int i = 0; i < 2; ++i) {
            const int pid = tid + i * NTHR, t = pid >> 3, oc = pid & 7;
            load_qk8<0>(P, l, pb, b, c, t, h, oc, false, qraw[i]);
            load_qk8<0>(P, l, pb, b, c, t, h, oc, true, kraw[i]);
        }
#pragma unroll
        for (int dir = 0; dir < 2; ++dir)
#pragma unroll
            for (int k = 0; k < 4; ++k) { const int i = tid + k * NTHR; apre[dir][k] = small[(size_t)(r0 + (i >> 4)) * 48 + dir * 16 + (i & 15)]; }
        build_vT<0>(pb, b, c, h, lds);
        f32x4 oacc[4][2];
#pragma unroll
        for (int mt = 0; mt < 4; ++mt)
#pragma unroll
            for (int i = 0; i < 2; ++i) oacc[mt][i] = (f32x4){0.f, 0.f, 0.f, 0.f};
#pragma unroll
        for (int dir = 0; dir < 2; ++dir) {
            decay_setup<0>(P, l, b, c, h, dir, lds, apre[dir]);
#pragma unroll
            for (int i = 0; i < 2; ++i) {
                const int pid = tid + i * NTHR, t = pid >> 3, oc = pid & 7;
                float q8[8], k8[8];
#pragma unroll
                for (int j = 0; j < 8; ++j) { const float cv = cum[t * 64 + oc * 8 + j]; q8[j] = qraw[i][j] * (__expf(cv) * 0.125f); k8[j] = kraw[i][j] * __expf(-cv); }
                u32x4 oq, ok;
                oq.x = cvt_pk(q8[0], q8[1]); oq.y = cvt_pk(q8[2], q8[3]); oq.z = cvt_pk(q8[4], q8[5]); oq.w = cvt_pk(q8[6], q8[7]);
                ok.x = cvt_pk(k8[0], k8[1]); ok.y = cvt_pk(k8[2], k8[3]); ok.z = cvt_pk(k8[4], k8[5]); ok.w = cvt_pk(k8[6], k8[7]);
                *(u32x4*)(qin + (size_t)t * QP + oc * 8) = oq;
                *(u32x4*)(kin + (size_t)t * QP + oc * 8) = ok;
            }
            __syncthreads();
            f32x4 sacc[4];
#pragma unroll
            for (int nt = 0; nt < 4; ++nt) sacc[nt] = (f32x4){0.f, 0.f, 0.f, 0.f};
#pragma unroll
            for (int kk = 0; kk < 2; ++kk) {
                const bf16x8 fq = *(const bf16x8*)(qin + (size_t)trow * QP + kk * 32 + lq * 8);
#pragma unroll
                for (int nt = 0; nt < 4; ++nt) {
                    const bf16x8 fk = *(const bf16x8*)(kin + (size_t)(nt * 16 + lr) * QP + kk * 32 + lq * 8);
                    sacc[nt] = __builtin_amdgcn_mfma_f32_16x16x32_bf16(fk, fq, sacc[nt], 0, 0, 0);
                }
            }
#pragma unroll
            for (int nt = 0; nt < 4; ++nt) {
                const int s0 = nt * 16 + lq * 4;
                float a0 = sacc[nt].x, a1 = sacc[nt].y, a2 = sacc[nt].z, a3 = sacc[nt].w;
                if (dir == 0) { if (s0 + 0 > trow) a0 = 0.f; if (s0 + 1 > trow) a1 = 0.f; if (s0 + 2 > trow) a2 = 0.f; if (s0 + 3 > trow) a3 = 0.f; }
                else { if (s0 + 0 < trow) a0 = 0.f; if (s0 + 1 < trow) a1 = 0.f; if (s0 + 2 < trow) a2 = 0.f; if (s0 + 3 < trow) a3 = 0.f; }
                u32x2 o; o.x = cvt_pk(a0, a1); o.y = cvt_pk(a2, a3);
                *(u32x2*)(att + (size_t)trow * 80 + s0) = o;
            }
            __syncthreads();
#pragma unroll
            for (int kk = 0; kk < 2; ++kk) {
                bf16x8 fv[2];
#pragma unroll
                for (int i = 0; i < 2; ++i) fv[i] = *(const bf16x8*)(vT + (size_t)((2 * wid + i) * 16 + lr) * 80 + kk * 32 + lq * 8);
#pragma unroll
                for (int mt = 0; mt < 4; ++mt) {
                    const bf16x8 fa = *(const bf16x8*)(att + (size_t)(mt * 16 + lr) * 80 + kk * 32 + lq * 8);
                    const bf16x8 fq = *(const bf16x8*)(qin + (size_t)(mt * 16 + lr) * QP + kk * 32 + lq * 8);
#pragma unroll
                    for (int i = 0; i < 2; ++i) {
                        oacc[mt][i] = __builtin_amdgcn_mfma_f32_16x16x32_bf16(fv[i], fa, oacc[mt][i], 0, 0, 0);
                        oacc[mt][i] = __builtin_amdgcn_mfma_f32_16x16x32_bf16(dir == 0 ? fsf[i][kk] : fsb[i][kk], fq, oacc[mt][i], 0, 0, 0);
                    }
                }
            }
            __syncthreads();
        }
#pragma unroll
        for (int mt = 0; mt < 4; ++mt) {
            float s2 = (oacc[mt][0].x * oacc[mt][0].x + oacc[mt][0].y * oacc[mt][0].y) + (oacc[mt][0].z * oacc[mt][0].z + oacc[mt][0].w * oacc[mt][0].w)
                     + (oacc[mt][1].x * oacc[mt][1].x + oacc[mt][1].y * oacc[mt][1].y) + (oacc[mt][1].z * oacc[mt][1].z + oacc[mt][1].w * oacc[mt][1].w);
            s2 += __shfl_xor(s2, 16); s2 += __shfl_xor(s2, 32);
            if (lq == 0) part[wid * 64 + mt * 16 + lr] = s2;
        }
        __syncthreads();
#pragma unroll
        for (int mt = 0; mt < 4; ++mt) {
            const int t = mt * 16 + lr;
            const float s2 = (part[t] + part[64 + t]) + (part[128 + t] + part[192 + t]);
            const float rstd = rsqrtf(s2 * (1.f / 128.f) + 1e-6f);
            const size_t rowi = (size_t)(r0 + t);
#pragma unroll
            for (int i = 0; i < 2; ++i) {
                const int e = (2 * wid + i) * 16 + lq * 4;
                const f32x4 gg = *(const f32x4*)(ng + h * 128 + e);
                const float g0 = bflo(gu[mt][i].x), g1 = bfhi(gu[mt][i].x), g2 = bflo(gu[mt][i].y), g3 = bfhi(gu[mt][i].y);
                u32x2 o;
                o.x = cvt_pk(oacc[mt][i].x * rstd * gg.x * siluf(g0), oacc[mt][i].y * rstd * gg.y * siluf(g1));
                o.y = cvt_pk(oacc[mt][i].z * rstd * gg.z * siluf(g2), oacc[mt][i].w * rstd * gg.w * siluf(g3));
                *(u32x2*)(brp + rowi * 1536 + h * 128 + e) = o;
            }
        }
        __syncthreads();
    }
}

template <int NI, class F>
__device__ __forceinline__ void ctx_gemm(const bf16_t* A, int lda, const bf16_t* Bt, int ldb, int K, int N, const F& f, char* lds) {
    const int tid = tid_l(), lane = tid & 63, wid = tid >> 6, wm = wid >> 1, wn = wid & 1, lr = lane & 15, lq = lane >> 4;
    const int Nt = (N + 32 * NI - 1) / (32 * NI);
    const int total = 4 * Nt, VG = vgrid(), slot = bid_l();
    for (int t0 = 0; t0 < total; t0 += VG) {
        const int t = t0 + (VG - 1 - slot); if (t >= total) continue;
        const int tm = t & 3, tn = t >> 2;
        f32x4 acc[4][NI];
#pragma unroll
        for (int mi = 0; mi < 4; ++mi)
#pragma unroll
            for (int ni = 0; ni < NI; ++ni) acc[mi][ni] = (f32x4){0.f, 0.f, 0.f, 0.f};
        gemm_kloop<NI>(acc, A + (size_t)(RL + tm * 128) * lda, lda, Bt + (size_t)tn * (32 * NI) * ldb, ldb, K, lds);
#pragma unroll
        for (int mi = 0; mi < 4; ++mi)
#pragma unroll
            for (int ni = 0; ni < NI; ++ni) f(RL + tm * 128 + wm * 64 + mi * 16 + lr, tn * (32 * NI) + wn * (16 * NI) + ni * 16 + lq * 4, acc[mi][ni], 0);
    }
}
__device__ __forceinline__ void ctx_merge(const Params& P, char* lds) {
    const int tid = tid_l(), lane = tid & 63, wid = tid >> 6, wm = wid >> 1, wn = wid & 1, lr = lane & 15, lq = lane >> 4;
    const bf16_t* br = (const bf16_t*)(ws_l(P) + WS_BR); const bf16_t* wb = (const bf16_t*)(ws_l(P) + WS_WTBR);
    const bf16_t* gs = (const bf16_t*)(ws_l(P) + WS_GS); bf16_t* mb = (bf16_t*)(ws_l(P) + WS_MB);
    const int total = 64, VG = vgrid(), slot = bid_l();
    for (int t0 = 0; t0 < total; t0 += VG) {
        const int t = t0 + (VG - 1 - slot); if (t >= total) continue;
        const int tm = t & 3, tn = t >> 2;
        f32x4 m[4][2];
#pragma unroll
        for (int mi = 0; mi < 4; ++mi)
#pragma unroll
            for (int ni = 0; ni < 2; ++ni) m[mi][ni] = (f32x4){0.f, 0.f, 0.f, 0.f};
#pragma unroll 1
        for (int j = 0; j < 3; ++j) {
            f32x4 acc[4][2];
#pragma unroll
            for (int mi = 0; mi < 4; ++mi)
#pragma unroll
                for (int ni = 0; ni < 2; ++ni) acc[mi][ni] = (f32x4){0.f, 0.f, 0.f, 0.f};
            gemm_kloop<2>(acc, br + (size_t)(RL + tm * 128) * 1536 + j * 512, 1536, wb + ((size_t)j * 1024 + tn * 64) * 512, 512, 512, lds);
#pragma unroll
            for (int mi = 0; mi < 4; ++mi)
#pragma unroll
                for (int ni = 0; ni < 2; ++ni) {
                    const int r = RL + tm * 128 + wm * 64 + mi * 16 + lr, c = tn * 64 + wn * 32 + ni * 16 + lq * 4;
                    const u32x2 g = *(const u32x2*)(gs + (size_t)r * 3072 + j * 1024 + c);
                    m[mi][ni].x += acc[mi][ni].x * bflo(g.x); m[mi][ni].y += acc[mi][ni].y * bfhi(g.x);
                    m[mi][ni].z += acc[mi][ni].z * bflo(g.y); m[mi][ni].w += acc[mi][ni].w * bfhi(g.y);
                }
        }
#pragma unroll
        for (int mi = 0; mi < 4; ++mi)
#pragma unroll
            for (int ni = 0; ni < 2; ++ni) {
                const int r = RL + tm * 128 + wm * 64 + mi * 16 + lr, c = tn * 64 + wn * 32 + ni * 16 + lq * 4;
                u32x2 o; o.x = cvt_pk(m[mi][ni].x, m[mi][ni].y); o.y = cvt_pk(m[mi][ni].z, m[mi][ni].w);
                *(u32x2*)(mb + (size_t)r * 1024 + c) = o;
            }
    }
}


#define XB_TMO      128
#define XB_XCNT(j)  (256  + 64 * (j))
#define XB_XSUB(j)  (1280 + 64 * (j))
#define XB_XGEN(j)  (2304 + 64 * (j))
#define XB_TOP      3328
#define XB_TOPGEN   3392
#define XCD_BAR_WORDS 3456
#define XB_SPIN_CAP (1u << 18)
__device__ __forceinline__ unsigned xb_ld(unsigned* p)              { return __hip_atomic_load(p, __ATOMIC_RELAXED, __HIP_MEMORY_SCOPE_AGENT); }
__device__ __forceinline__ unsigned xb_add(unsigned* p, unsigned v) { return __hip_atomic_fetch_add(p, v, __ATOMIC_RELAXED, __HIP_MEMORY_SCOPE_AGENT); }
__device__ __forceinline__ unsigned xb_xcc_id() { return (unsigned)__builtin_amdgcn_s_getreg((3 << 11) | 20) & 0xFu; }
#define XB_SPIN(cond, bar) do { unsigned _sp = 0; while (cond) { __builtin_amdgcn_s_sleep(1); \
    if ((++_sp & 255u) == 0u) { if (xb_ld(&(bar)[XB_TMO])) break; if (_sp > XB_SPIN_CAP) { atomicAdd(&(bar)[XB_TMO], 1u); break; } } } } while (0)
struct XcdBarrier { unsigned* bar; unsigned x; volatile LAS unsigned* st; };
__device__ __forceinline__ XcdBarrier xcd_barrier_post(unsigned* bar, volatile LAS unsigned* st) {
    XcdBarrier b; b.bar = bar; b.x = xb_xcc_id(); b.st = st;
    if (threadIdx.x == 0) (void)xb_add(&bar[XB_XCNT(b.x)], 1u);
    return b;
}
__device__ __forceinline__ void xcd_barrier_complete(unsigned* bar, unsigned x, unsigned& nloc, unsigned& nx) {
    const unsigned G = gridDim.x * gridDim.y * gridDim.z;
    unsigned sum, cnt, mine, sp = 0u;
    for (;;) {
        sum = 0u; cnt = 0u; mine = 0u;
#pragma unroll
        for (unsigned j = 0; j < 16; ++j) { const unsigned c = xb_ld(&bar[XB_XCNT(j)]); sum += c; cnt += (c > 0u) ? 1u : 0u; mine = (j == x) ? c : mine; }
        if (sum == G) break;
        __builtin_amdgcn_s_sleep(1);
        if ((++sp & 255u) == 0u) { if (xb_ld(&bar[XB_TMO])) break; if (sp > XB_SPIN_CAP) { atomicAdd(&bar[XB_TMO], 1u); break; } }
    }
    nloc = mine > 0u ? mine : 1u; nx = cnt > 0u ? cnt : 1u;
}
__device__ __forceinline__ void xcd_barrier(const XcdBarrier& b) {
    asm volatile("s_waitcnt vmcnt(0)" ::: "memory");
    __syncthreads();
    if (threadIdx.x == 0) {
        unsigned* bar = b.bar;
        __builtin_amdgcn_s_waitcnt(0);
        unsigned nloc = b.st[0], nx = b.st[1];
        if (nloc == 0u) { xcd_barrier_complete(bar, b.x, nloc, nx); b.st[0] = nloc; b.st[1] = nx; }
        const unsigned old = xb_add(&bar[XB_XSUB(b.x)], 1u);
        const unsigned gen = old / nloc;
        if (old + 1u == (gen + 1u) * nloc) {
            __builtin_amdgcn_fence(__ATOMIC_RELEASE, "agent");
            asm volatile("s_waitcnt vmcnt(0)" ::: "memory");
            const unsigned og = xb_add(&bar[XB_TOP], 1u);
            const unsigned tg = og / nx;
            if (og + 1u == (tg + 1u) * nx) xb_add(&bar[XB_TOPGEN], 1u);
            else XB_SPIN(xb_ld(&bar[XB_TOPGEN]) == tg, bar);
            __builtin_amdgcn_fence(__ATOMIC_ACQUIRE, "agent");
            xb_add(&bar[XB_XGEN(b.x)], 1u);
            asm volatile("s_waitcnt vmcnt(0)" ::: "memory");
        } else {
            XB_SPIN(xb_ld(&bar[XB_XGEN(b.x)]) == gen, bar);
            __builtin_amdgcn_fence(__ATOMIC_ACQUIRE, "agent");
            asm volatile("s_waitcnt vmcnt(0)" ::: "memory");
        }
    }
    __syncthreads();
}

__global__ void __launch_bounds__(512, 2) fwd_kernel(Params P) {
    extern __shared__ __attribute__((aligned(16))) unsigned char lds_raw[];
    cg::grid_group grid = cg::this_grid();
    LAS unsigned char* ldsb = (LAS unsigned char*)lds_raw;
#define LDSH ((char*)lds_raw + __builtin_amdgcn_readfirstlane(threadIdx.x >> 8) * HALF_LDS)
    volatile LAS unsigned* bst = (volatile LAS unsigned*)(ldsb + 2 * HALF_LDS);
    if (threadIdx.x < 2) bst[threadIdx.x] = 0u;
    __syncthreads();
    XcdBarrier xbar = xcd_barrier_post((unsigned*)(P.ws + WS_BAR), bst);
    int ph = 0;
#define PHASE_BEGIN if (ph >= P.lo && ph < P.hi) {
#define PHASE_END } ++ph; if (P.coop && ph > P.lo && ph < P.hi) { if (ph == 1) grid.sync(); else xcd_barrier(xbar); }

    PHASE_BEGIN
        {
        { const int VG = vgrid(), slot = bid_l();
          for (int i0 = 0; i0 < 384; i0 += VG) { int it = i0 + slot; if (it >= 384) it = 383; mods_task(P, it, LDSH); } }
        if (bid_l() == vgrid() - 1) rope_task(P);
        convert_all(P, 0, LDSH);
        }
    PHASE_END

    const XPtr Xin{(float*)P.in[I_X], (float*)P.in[I_CTX]};
    const XPtr Xcur{P.out, (float*)(P.ws + WS_CTXX)};

    for (int l = 0; l < 2; ++l) {
        const XPtr Xold = l == 0 ? Xin : Xcur;
        const bool ctx_on = (l == 0);
        PHASE_BEGIN
            {
            if (l == 1) convert_all(P, 1, LDSH);
            norm_phase(P, Xold, P.in[I_N1G] + l * D, l, 0, R);
            }
        PHASE_END
        PHASE_BEGIN
            const bf16_t* hb = (const bf16_t*)(ws_l(P) + WS_HBUF); const bf16_t* wt = (const bf16_t*)(ws_l(P) + WS_WTIN);
            EpiP e{(bf16_t*)(ws_l(P) + WS_PBUF), 1536, 1536, (float*)(ws_l(P) + WS_SMALL)};
            {
            big_gemm(ldsb, hb, 1024, wt, 1024, 1792, e);
            ctx_gemm<4>(hb, 1024, wt, 1024, 1024, 1664, e, LDSH); }
        PHASE_END
        PHASE_BEGIN u_phase<0>(P, l, LDSH); PHASE_END
        PHASE_BEGIN scan_phase<64, false>(P); PHASE_END
        PHASE_BEGIN out_phase_g(P, l, !ctx_on, LDSH); PHASE_END
        PHASE_BEGIN
            const bf16_t* hb = (const bf16_t*)(ws_l(P) + WS_HBUF); const bf16_t* wt = (const bf16_t*)(ws_l(P) + WS_WTIN) + (size_t)1792 * 1024;
            EpiP e{(bf16_t*)(ws_l(P) + WS_PBUF), 2048, 2048, nullptr};
            {
            big_gemm(ldsb, hb, 1024, wt, 1024, 2048, e);
            ctx_gemm<2>(hb, 1024, wt, 1024, 1024, 2048, e, LDSH); }
        PHASE_END
        PHASE_BEGIN u_phase_s<1>(P, l, LDSH); PHASE_END
        PHASE_BEGIN scan_phase<128, true>(P); PHASE_END
        PHASE_BEGIN out_phase_s<1>(P, l, 1, !ctx_on, LDSH); PHASE_END
        PHASE_BEGIN
            const bf16_t* hb = (const bf16_t*)(ws_l(P) + WS_HBUF); const bf16_t* wt = (const bf16_t*)(ws_l(P) + WS_WTIN) + (size_t)3840 * 1024;
            EpiP e{(bf16_t*)(ws_l(P) + WS_PBUF), 1536, 1536, nullptr};
            {
            big_gemm(ldsb, hb, 1024, wt, 1024, 1536, e);
            ctx_gemm<4>(hb, 1024, wt, 1024, 1024, 1536, e, LDSH); }
        PHASE_END
        PHASE_BEGIN u_phase_s<2>(P, l, LDSH); PHASE_END
        PHASE_BEGIN scan_phase<64, false>(P); PHASE_END
        PHASE_BEGIN out_phase_s<2>(P, l, 2, !ctx_on, LDSH); PHASE_END
        PHASE_BEGIN
            const bf16_t* hb = (const bf16_t*)(ws_l(P) + WS_HBUF); const bf16_t* wt = (const bf16_t*)(ws_l(P) + WS_WTIN) + (size_t)5376 * 1024;
            EpiSig e{(bf16_t*)(ws_l(P) + WS_GS)};
            {
            big_gemm(ldsb, hb, 1024, wt, 1024, 3072, e);
            if (ctx_on) ctx_gemm<2>(hb, 1024, wt, 1024, 1024, 3072, e, LDSH); }
        PHASE_END
        PHASE_BEGIN
            {   pg8::Gemm g{(const bf16_t*)(ws_l(P) + WS_BR), (const bf16_t*)(ws_l(P) + WS_WTBR), 1536, 512};
                pg8::MergeOrder S; S.S.init(RL, 1024, (int)gridDim.x, (int)blockIdx.x);
                pg8::Epi<EpiMerge> E{EpiMerge{(const bf16_t*)(ws_l(P) + WS_GS), (bf16_t*)(ws_l(P) + WS_MB)}};
                pg8::gemm_phase(ldsb, g, S, E);
                __syncthreads(); }
            if (ctx_on) ctx_merge(P, LDSH);
        PHASE_END
        PHASE_BEGIN
            const float* mods_l = (const float*)(ws_l(P) + WS_MODS) + (size_t)l * 3 * 6144;
            EpiRes e{Xold, Xcur, mods_l, 2};
            big_gemm(ldsb, (const bf16_t*)(ws_l(P) + WS_MB), 1024, (const bf16_t*)(ws_l(P) + WS_WTO), 1024, 1024, e);
            if (ctx_on) ctx_gemm<1>((const bf16_t*)(ws_l(P) + WS_MB), 1024, (const bf16_t*)(ws_l(P) + WS_WTO), 1024, 1024, 1024, e, LDSH);
        PHASE_END
        PHASE_BEGIN norm_phase(P, Xcur, P.in[I_N2G] + l * D, l, 3, ctx_on ? R : RL); PHASE_END
        PHASE_BEGIN
            const bf16_t* hb = (const bf16_t*)(ws_l(P) + WS_HBUF);
            EpiRelu2 e{(bf16_t*)(ws_l(P) + WS_HID)};
            {
            big_gemm(ldsb, hb, 1024, (const bf16_t*)(ws_l(P) + WS_WTUP), 1024, 4096, e);
            if (ctx_on) ctx_gemm<2>(hb, 1024, (const bf16_t*)(ws_l(P) + WS_WTUP), 1024, 1024, 4096, e, LDSH); }
        PHASE_END
        PHASE_BEGIN
            const float* mods_l = (const float*)(ws_l(P) + WS_MODS) + (size_t)l * 3 * 6144;
            EpiRes e{Xcur, Xcur, mods_l, 5};
            big_gemm(ldsb, (const bf16_t*)(ws_l(P) + WS_HID), 4096, (const bf16_t*)(ws_l(P) + WS_WTDN), 4096, 1024, e);
            if (ctx_on) ctx_gemm<1>((const bf16_t*)(ws_l(P) + WS_HID), 4096, (const bf16_t*)(ws_l(P) + WS_WTDN), 4096, 4096, 1024, e, LDSH);
        PHASE_END
    }
    PHASE_BEGIN final_norm_phase(P); PHASE_END
#undef PHASE_BEGIN
#undef PHASE_END
}
constexpr int NPHASES = 1 + 2 * 19 + 1;

extern "C" void kernel_launch(void* const* d_in, const int* in_sizes, int n_in, void* d_out, int out_size, void* d_ws, size_t ws_size, hipStream_t stream) {
    static int grid = 0;
    if (grid == 0) {
        if (n_in != 23 || ws_size < WS_END || out_size != NB * SEQ * D) { fprintf(stderr, "kernel_launch: unexpected sizes n_in %d ws %zu (need %zu) out %d\n", n_in, ws_size, (size_t)WS_END, out_size); grid = -1; return; }
        int dev = 0, cus = 0, per_cu = 0;
        if (hipGetDevice(&dev) != hipSuccess || hipDeviceGetAttribute(&cus, hipDeviceAttributeMultiprocessorCount, dev) != hipSuccess) { grid = -1; return; }
        if (hipFuncSetAttribute((const void*)fwd_kernel, hipFuncAttributeMaxDynamicSharedMemorySize, LDS_BYTES) != hipSuccess) { fprintf(stderr, "kernel_launch: hipFuncSetAttribute failed\n"); grid = -1; return; }
        if (hipOccupancyMaxActiveBlocksPerMultiprocessor(&per_cu, (const void*)fwd_kernel, 512, LDS_BYTES) != hipSuccess || per_cu < 1) { fprintf(stderr, "kernel_launch: occupancy query failed (%d)\n", per_cu); grid = -1; return; }
        grid = cus;
        grid -= grid % 8;
    }
    if (grid < 0) return;
    if (hipMemsetAsync((char*)d_ws + WS_BAR, 0, (size_t)3456 * 4, stream) != hipSuccess) { fprintf(stderr, "kernel_launch: memset failed\n"); return; }
    Params p{};
    for (int i = 0; i < 23; ++i) p.in[i] = (const float*)d_in[i];
    p.out = (float*)d_out; p.ws = (unsigned char*)d_ws;
    p.lo = 0; p.hi = NPHASES; p.coop = 1;
    void* args[] = {&p};
    hipError_t e = hipLaunchCooperativeKernel((const void*)fwd_kernel, dim3(grid), dim3(512), args, LDS_BYTES, stream);
    if (e != hipSuccess) fprintf(stderr, "kernel_launch: cooperative launch failed: %s (grid %d)\n", hipGetErrorString(e), grid);
}
```

```cpp
#include <hip/hip_runtime.h>
#include <hip/hip_cooperative_groups.h>
#include <stdint.h>
#include <stdio.h>
namespace cg = cooperative_groups;

#define LAS __attribute__((address_space(3)))
typedef unsigned short bf16_t;
typedef short bf16x8 __attribute__((ext_vector_type(8)));
typedef float f32x4 __attribute__((ext_vector_type(4)));
typedef unsigned u32x4 __attribute__((ext_vector_type(4)));
typedef unsigned u32x2 __attribute__((ext_vector_type(2)));

constexpr int D = 1024, NB = 2, SEQ = 8192, CTX = 256, RB = SEQ + CTX, R = NB * RB, RL = NB * SEQ, NCH = RB / 64, FF = 4096;
constexpr int INW = 8240;
constexpr int NTHR = 256;
constexpr int HALF_LDS = 73728;
constexpr int LDS_BYTES = 2 * HALF_LDS + 16;

constexpr size_t WS_WTIN = 0;
constexpr size_t WS_WTBR = WS_WTIN + (size_t)8448 * 1024 * 2;
constexpr size_t WS_WTO = WS_WTBR + (size_t)3 * 1024 * 512 * 2;
constexpr size_t WS_WTUP = WS_WTO + (size_t)1024 * 1024 * 2;
constexpr size_t WS_WTDN = WS_WTUP + (size_t)4096 * 1024 * 2;
constexpr size_t WS_HBUF = WS_WTDN + (size_t)4096 * 1024 * 2;
constexpr size_t WS_PBUF = WS_HBUF + (size_t)R * 1024 * 2;
constexpr size_t WS_SBUF = WS_PBUF + (size_t)R * 2048 * 2;
constexpr size_t WS_BR = WS_SBUF + (size_t)R * 2048 * 2;
constexpr size_t WS_CTXX = WS_BR + (size_t)R * 1536 * 2;
constexpr size_t WS_SMALL = WS_CTXX + (size_t)512 * 1024 * 4;
constexpr size_t WS_DEC = WS_SMALL + (size_t)R * 48 * 4;
constexpr size_t WS_UN = WS_DEC + (size_t)16 * NCH * 128 * 4;
constexpr size_t WS_MODS = WS_UN + (size_t)16 * NCH * 128 * 4;
constexpr size_t WS_ROPE = WS_MODS + (size_t)2 * 3 * 6144 * 4;
constexpr size_t WS_BAR = WS_ROPE + (size_t)(128 + 64) * 16 * 2 * 4;
constexpr size_t WS_END = WS_BAR + (size_t)3456 * 4;
constexpr size_t WS_GS = WS_PBUF;
constexpr size_t WS_MB = WS_PBUF + (size_t)R * 3072 * 2;
constexpr size_t WS_HID = WS_PBUF;

struct Params { const float* in[23]; float* out; unsigned char* ws; int lo, hi, coop, pad; };

__device__ __forceinline__ int tid_l() { int t = threadIdx.x & 255; asm volatile("" : "+v"(t)); return t; }
__device__ __forceinline__ int bid_l() { int t = blockIdx.x * 2 + (__builtin_amdgcn_readfirstlane(threadIdx.x >> 8)); asm volatile("" : "+s"(t)); return t; }
__device__ __forceinline__ int vgrid() { return gridDim.x * 2; }
typedef __attribute__((address_space(1))) unsigned char gas_u8;
__device__ __forceinline__ unsigned char* ws_l(const Params& P) { gas_u8* w = (gas_u8*)P.ws; asm volatile("" : "+s"(w)); return (unsigned char*)w; }
enum { I_X = 0, I_C, I_CTX, I_CCTX, I_N1G, I_N2G, I_WADA, I_BADA, I_WIN, I_A2, I_ABIAS, I_GNG, I_CONV, I_IB, I_FB, I_MNG, I_RDL, I_RNG, I_WBR, I_WO, I_WUP, I_WDN, I_FG };

typedef __bf16 bf16x2_t __attribute__((ext_vector_type(2)));
typedef float f32x2 __attribute__((ext_vector_type(2)));
__device__ __forceinline__ unsigned cvt_pk(float lo, float hi) { f32x2 v = {lo, hi}; bf16x2_t b = __builtin_convertvector(v, bf16x2_t); return __builtin_bit_cast(unsigned, b); }
__device__ __forceinline__ float bflo(unsigned u) { return __uint_as_float(u << 16); }
__device__ __forceinline__ float bfhi(unsigned u) { return __uint_as_float(u & 0xffff0000u); }
__device__ __forceinline__ float wave_sum(float v) {
#pragma unroll
    for (int o = 32; o > 0; o >>= 1) v += __shfl_xor(v, o);
    return v;
}
__device__ __forceinline__ float logsig(float x) { return fminf(x, 0.f) - log1pf(__expf(-fabsf(x))); }
__device__ __forceinline__ float logsig_fast(float x) { return fminf(x, 0.f) - __logf(1.f + __expf(-fabsf(x))); }
__device__ __forceinline__ float siluf(float x) { return x * __builtin_amdgcn_rcpf(1.f + __expf(-x)); }
__device__ __forceinline__ float sigmf(float x) { return __builtin_amdgcn_rcpf(1.f + __expf(-x)); }

struct XPtr { float* lat; float* ctx; };
__device__ __forceinline__ float* xrow(const XPtr& X, int r) { return r < RL ? X.lat + (size_t)r * D : X.ctx + (size_t)(r - RL) * D; }
__device__ __forceinline__ int modidx(int r) { return r < SEQ ? 0 : (r < RL ? 1 : 2); }
__device__ __forceinline__ int rowbase(int b, int c) { return c < 4 ? RL + b * CTX + c * 64 : b * SEQ + (c - 4) * 64; }

#define UNPACK8(u, f) do { f[0] = bflo(u.x); f[1] = bfhi(u.x); f[2] = bflo(u.y); f[3] = bfhi(u.y); f[4] = bflo(u.z); f[5] = bfhi(u.z); f[6] = bflo(u.w); f[7] = bfhi(u.w); } while (0)

__device__ __forceinline__ void mods_task(const Params& P, int task, char* lds) {
    float* s = (float*)lds;
    float* red = (float*)(lds + 12288);
    const int tid = tid_l();
    const int l = task / 192, col0 = (task % 192) * 32;
    const float* c = P.in[I_C]; const float* cc = P.in[I_CCTX];
    for (int i = tid; i < 3072; i += NTHR) { const int v = i >> 10, k = i & 1023; const float cv = v < 2 ? c[v * 1024 + k] : cc[k]; s[i] = siluf(cv); }
    __syncthreads();
    const int col = tid & 31, kg = tid >> 5;
    const float* w = P.in[I_WADA] + (size_t)l * D * 6144 + col0 + col;
    float a0 = 0.f, a1 = 0.f, a2 = 0.f;
#pragma unroll 32
    for (int k = kg * 128; k < kg * 128 + 128; ++k) { const float wv = w[(size_t)k * 6144]; a0 += s[k] * wv; a1 += s[1024 + k] * wv; a2 += s[2048 + k] * wv; }
    red[(kg * 32 + col) * 3 + 0] = a0; red[(kg * 32 + col) * 3 + 1] = a1; red[(kg * 32 + col) * 3 + 2] = a2;
    __syncthreads();
    if (tid < 96) {
        const int v = tid >> 5, c2 = tid & 31; float sum = 0.f;
#pragma unroll
        for (int g = 0; g < 8; ++g) sum += red[(g * 32 + c2) * 3 + v];
        sum += P.in[I_BADA][l * 6144 + col0 + c2];
        ((float*)(ws_l(P) + WS_MODS))[(l * 3 + v) * 6144 + col0 + c2] = sum;
    }
    __syncthreads();
}

__device__ __forceinline__ void rope_task(const Params& P) {
    float* tab = (float*)(ws_l(P) + WS_ROPE);
    for (int i = tid_l(); i < 192 * 16; i += NTHR) {
        const int pos = i >> 4, f = i & 15;
        const float inv = exp2f(-(float)f * (13.287712379549449f / 16.f));
        const float p = pos < 128 ? (float)pos : (float)(pos - 128);
        const float ang = p * inv;
        const float cs = cosf(ang), sn = sinf(ang);
        if (pos < 128) { tab[pos * 16 + f] = cs; tab[2048 + pos * 16 + f] = sn; }
        else { tab[4096 + (pos - 128) * 16 + f] = cs; tab[4096 + 1024 + (pos - 128) * 16 + f] = sn; }
    }
}

__device__ __forceinline__ void transpose_tile(const float* src, int ldsrc, int k0, int n0src, int nvalid, bf16_t* dst, int ldd, int drow0, char* lds) {
    float* tile = (float*)lds;
    const int tid = tid_l(), nl = tid & 63, kq = tid >> 6;
    float v[32];
#pragma unroll
    for (int i = 0; i < 32; ++i) v[i] = nl < nvalid ? src[(size_t)(k0 + kq + 4 * i) * ldsrc + n0src + nl] : 0.f;
#pragma unroll
    for (int i = 0; i < 32; ++i) tile[(kq + 4 * i) * 65 + nl] = v[i];
    __syncthreads();
    const int n = tid >> 2, ks = (tid & 3) * 32;
    if (n < nvalid) {
        u32x4* dp = (u32x4*)(dst + (size_t)(drow0 + n) * ldd + k0 + ks);
#pragma unroll
        for (int q = 0; q < 4; ++q) {
            u32x4 o;
            o.x = cvt_pk(tile[(ks + 8 * q + 0) * 65 + n], tile[(ks + 8 * q + 1) * 65 + n]); o.y = cvt_pk(tile[(ks + 8 * q + 2) * 65 + n], tile[(ks + 8 * q + 3) * 65 + n]);
            o.z = cvt_pk(tile[(ks + 8 * q + 4) * 65 + n], tile[(ks + 8 * q + 5) * 65 + n]); o.w = cvt_pk(tile[(ks + 8 * q + 6) * 65 + n], tile[(ks + 8 * q + 7) * 65 + n]);
            dp[q] = o;
        }
    }
    __syncthreads();
}

constexpr int CONV_TILES = 192 + 8 + 8 + 256 + 192 + 384 + 192 + 128 + 512 + 512;
__device__ __forceinline__ void convert_tile(const Params& P, int l, int it, char* lds) {
    const float* win = P.in[I_WIN] + (size_t)l * D * INW;
    bf16_t* wtin = (bf16_t*)(ws_l(P) + WS_WTIN);
    int r = it;
    if (r < 192) { const int kt = r / 24, nt = r % 24; transpose_tile(win, INW, kt * 128, nt * 64, 64, wtin, 1024, nt * 64, lds); return; } r -= 192;
    if (r < 8) { transpose_tile(win, INW, r * 128, 1536, 32, wtin, 1024, 1536, lds); return; } r -= 8;
    if (r < 8) { transpose_tile(win, INW, r * 128, 3616, 16, wtin, 1024, 1568, lds); return; } r -= 8;
    if (r < 256) { const int kt = r / 32, nt = r % 32; transpose_tile(win, INW, kt * 128, 1568 + nt * 64, 64, wtin, 1024, 1792 + nt * 64, lds); return; } r -= 256;
    if (r < 192) { const int kt = r / 24, nt = r % 24; transpose_tile(win, INW, kt * 128, 3632 + nt * 64, 64, wtin, 1024, 3840 + nt * 64, lds); return; } r -= 192;
    if (r < 384) { const int kt = r / 48, nt = r % 48; transpose_tile(win, INW, kt * 128, 5168 + nt * 64, 64, wtin, 1024, 5376 + nt * 64, lds); return; } r -= 384;
    if (r < 192) { const int j = r / 64, q = r % 64, kt = q / 16, nt = q % 16;
        transpose_tile(P.in[I_WBR] + ((size_t)l * 3 + j) * 512 * 1024, 1024, kt * 128, nt * 64, 64, (bf16_t*)(ws_l(P) + WS_WTBR), 512, j * 1024 + nt * 64, lds); return; } r -= 192;
    if (r < 128) { const int kt = r / 16, nt = r % 16; transpose_tile(P.in[I_WO] + (size_t)l * D * D, 1024, kt * 128, nt * 64, 64, (bf16_t*)(ws_l(P) + WS_WTO), 1024, nt * 64, lds); return; } r -= 128;
    if (r < 512) { const int kt = r / 64, nt = r % 64; transpose_tile(P.in[I_WUP] + (size_t)l * D * FF, 4096, kt * 128, nt * 64, 64, (bf16_t*)(ws_l(P) + WS_WTUP), 1024, nt * 64, lds); return; } r -= 512;
    { const int kt = r / 16, nt = r % 16; transpose_tile(P.in[I_WDN] + (size_t)l * FF * D, 1024, kt * 128, nt * 64, 64, (bf16_t*)(ws_l(P) + WS_WTDN), 4096, nt * 64, lds); }
}
__device__ __forceinline__ void convert_all(const Params& P, int l, char* lds) {
    const int VG = vgrid(), slot = bid_l();
    static_assert(CONV_TILES % 2 == 0, "both halves of a workgroup must be active together");
    for (int i0 = 0; i0 < CONV_TILES; i0 += VG) { const int it = i0 + slot; if (it >= CONV_TILES) continue; convert_tile(P, l, it, lds); }
}

__device__ __forceinline__ void norm_phase(const Params& P, XPtr X, const float* g, int l, int sidx, int nrows) {
    const int lane = tid_l() & 63; const int gw = bid_l() * 4 + (tid_l() >> 6), ngw = vgrid() * 4;
    bf16_t* hb = (bf16_t*)(ws_l(P) + WS_HBUF);
    const float* mods = (const float*)(ws_l(P) + WS_MODS) + (size_t)l * 3 * 6144;
    for (int r = gw; r < nrows; r += 2 * ngw) {
        const int r1 = r + ngw; const bool has1 = r1 < nrows; const int rr1 = has1 ? r1 : r;
        const f32x4* xa = (const f32x4*)xrow(X, r); const f32x4* xb = (const f32x4*)xrow(X, rr1);
        f32x4 va[4], vb[4]; float sa_ = 0.f, sb_ = 0.f;
#pragma unroll
        for (int j = 0; j < 4; ++j) { va[j] = xa[lane + 64 * j]; vb[j] = xb[lane + 64 * j]; }
#pragma unroll
        for (int j = 0; j < 4; ++j) { sa_ += va[j].x * va[j].x + va[j].y * va[j].y + va[j].z * va[j].z + va[j].w * va[j].w; sb_ += vb[j].x * vb[j].x + vb[j].y * vb[j].y + vb[j].z * vb[j].z + vb[j].w * vb[j].w; }
        sa_ = wave_sum(sa_); sb_ = wave_sum(sb_);
        const float rsa = rsqrtf(sa_ * (1.f / 1024.f) + 1e-6f), rsb = rsqrtf(sb_ * (1.f / 1024.f) + 1e-6f);
        const float* mda = mods + modidx(r) * 6144; const float* mdb = mods + modidx(rr1) * 6144;
#pragma unroll
        for (int j = 0; j < 4; ++j) {
            const int col = (lane + 64 * j) * 4;
            const f32x4 gg = *(const f32x4*)(g + col);
            { const f32x4 sh = *(const f32x4*)(mda + sidx * 1024 + col), sc = *(const f32x4*)(mda + (sidx + 1) * 1024 + col);
              const f32x4 hh = va[j] * rsa * gg * (sc + 1.f) + sh; u32x2 o; o.x = cvt_pk(hh.x, hh.y); o.y = cvt_pk(hh.z, hh.w); *(u32x2*)(hb + (size_t)r * 1024 + col) = o; }
            if (has1) { const f32x4 sh = *(const f32x4*)(mdb + sidx * 1024 + col), sc = *(const f32x4*)(mdb + (sidx + 1) * 1024 + col);
              const f32x4 hh = vb[j] * rsb * gg * (sc + 1.f) + sh; u32x2 o; o.x = cvt_pk(hh.x, hh.y); o.y = cvt_pk(hh.z, hh.w); *(u32x2*)(hb + (size_t)r1 * 1024 + col) = o; }
        }
    }
}
__device__ __forceinline__ void final_norm_phase(const Params& P) {
    const int lane = tid_l() & 63; const int gw = bid_l() * 4 + (tid_l() >> 6), ngw = vgrid() * 4;
    const float* g = P.in[I_FG];
    for (int r = gw; r < RL; r += 2 * ngw) {
        const int r1 = r + ngw;
        f32x4* xa = (f32x4*)(P.out + (size_t)r * D); f32x4* xb = (f32x4*)(P.out + (size_t)r1 * D);
        f32x4 va[4], vb[4]; float sa_ = 0.f, sb_ = 0.f;
#pragma unroll
        for (int j = 0; j < 4; ++j) { va[j] = xa[lane + 64 * j]; vb[j] = xb[lane + 64 * j]; }
#pragma unroll
        for (int j = 0; j < 4; ++j) { sa_ += va[j].x * va[j].x + va[j].y * va[j].y + va[j].z * va[j].z + va[j].w * va[j].w; sb_ += vb[j].x * vb[j].x + vb[j].y * vb[j].y + vb[j].z * vb[j].z + vb[j].w * vb[j].w; }
        sa_ = wave_sum(sa_); sb_ = wave_sum(sb_);
        const float rsa = rsqrtf(sa_ * (1.f / 1024.f) + 1e-6f), rsb = rsqrtf(sb_ * (1.f / 1024.f) + 1e-6f);
#pragma unroll
        for (int j = 0; j < 4; ++j) { const f32x4 gg = *(const f32x4*)(g + (lane + 64 * j) * 4); xa[lane + 64 * j] = va[j] * rsa * gg; xb[lane + 64 * j] = vb[j] * rsb * gg; }
    }
}

struct EpiP {
    bf16_t* Pb; int pitch; int nmain; float* small;
    __device__ __forceinline__ void operator()(int r, int c, const f32x4& v, int) const {
        if (c < nmain) { u32x2 o; o.x = cvt_pk(v.x, v.y); o.y = cvt_pk(v.z, v.w); *(u32x2*)(Pb + (size_t)r * pitch + c) = o; }
        else { const int cc = c - nmain; if (cc < 48) *(f32x4*)(small + (size_t)r * 48 + cc) = v; }
    }
    __device__ __forceinline__ void w8(int r, int c, const f32x4& v0, const f32x4& v1, int) const {
        if (c < nmain) { u32x4 o; o.x = cvt_pk(v0.x, v0.y); o.y = cvt_pk(v0.z, v0.w); o.z = cvt_pk(v1.x, v1.y); o.w = cvt_pk(v1.z, v1.w); *(u32x4*)(Pb + (size_t)r * pitch + c) = o; }
        else { const int cc = c - nmain; if (cc < 48) { *(f32x4*)(small + (size_t)r * 48 + cc) = v0; *(f32x4*)(small + (size_t)r * 48 + cc + 4) = v1; } }
    }
};
struct EpiSig {
    bf16_t* O;
    __device__ __forceinline__ void operator()(int r, int c, const f32x4& v, int) const {
        u32x2 o; o.x = cvt_pk(sigmf(v.x), sigmf(v.y)); o.y = cvt_pk(sigmf(v.z), sigmf(v.w)); *(u32x2*)(O + (size_t)r * 3072 + c) = o;
    }
    __device__ __forceinline__ void w8(int r, int c, const f32x4& v0, const f32x4& v1, int) const {
        u32x4 o; o.x = cvt_pk(sigmf(v0.x), sigmf(v0.y)); o.y = cvt_pk(sigmf(v0.z), sigmf(v0.w)); o.z = cvt_pk(sigmf(v1.x), sigmf(v1.y)); o.w = cvt_pk(sigmf(v1.z), sigmf(v1.w));
        *(u32x4*)(O + (size_t)r * 3072 + c) = o;
    }
};
struct EpiRelu2 {
    bf16_t* O;
    __device__ __forceinline__ void operator()(int r, int c, const f32x4& v, int) const {
        const float a = fmaxf(v.x, 0.f), b = fmaxf(v.y, 0.f), cc = fmaxf(v.z, 0.f), d = fmaxf(v.w, 0.f);
        u32x2 o; o.x = cvt_pk(a * a, b * b); o.y = cvt_pk(cc * cc, d * d); *(u32x2*)(O + (size_t)r * 4096 + c) = o;
    }
    __device__ __forceinline__ void w8(int r, int c, const f32x4& v0, const f32x4& v1, int) const {
        const float a = fmaxf(v0.x, 0.f), b = fmaxf(v0.y, 0.f), cc = fmaxf(v0.z, 0.f), d = fmaxf(v0.w, 0.f), e = fmaxf(v1.x, 0.f), f = fmaxf(v1.y, 0.f), g = fmaxf(v1.z, 0.f), h = fmaxf(v1.w, 0.f);
        u32x4 o; o.x = cvt_pk(a * a, b * b); o.y = cvt_pk(cc * cc, d * d); o.z = cvt_pk(e * e, f * f); o.w = cvt_pk(g * g, h * h); *(u32x4*)(O + (size_t)r * 4096 + c) = o;
    }
};
struct EpiRes {
    XPtr Xold, Xnew; const float* mods_l; int gidx;
    __device__ __forceinline__ void operator()(int r, int c, const f32x4& v, int) const {
        const f32x4 g = *(const f32x4*)(mods_l + modidx(r) * 6144 + gidx * 1024 + c);
        const f32x4 xo = *(const f32x4*)(xrow(Xold, r) + c);
        *(f32x4*)(xrow(Xnew, r) + c) = xo + g * v;
    }
    __device__ __forceinline__ void w8(int r, int c, const f32x4& v0, const f32x4& v1, int) const {
        const float* gp = mods_l + modidx(r) * 6144 + gidx * 1024 + c; const float* xo = xrow(Xold, r) + c; float* xn = xrow(Xnew, r) + c;
        const f32x4 g0 = *(const f32x4*)gp, g1 = *(const f32x4*)(gp + 4), x0 = *(const f32x4*)xo, x1 = *(const f32x4*)(xo + 4);
        *(f32x4*)xn = x0 + g0 * v0; *(f32x4*)(xn + 4) = x1 + g1 * v1;
    }
};
struct EpiMerge {
    const bf16_t* gs; bf16_t* mb;
    __device__ __forceinline__ void operator()(int r, int c, const f32x4& v, int j) const {
        const u32x2 g = *(const u32x2*)(gs + (size_t)r * 3072 + j * 1024 + c);
        float a0 = v.x * bflo(g.x), a1 = v.y * bfhi(g.x), a2 = v.z * bflo(g.y), a3 = v.w * bfhi(g.y);
        u32x2* mp = (u32x2*)(mb + (size_t)r * 1024 + c);
        if (j > 0) { const u32x2 o = *mp; a0 += bflo(o.x); a1 += bfhi(o.x); a2 += bflo(o.y); a3 += bfhi(o.y); }
        u32x2 w; w.x = cvt_pk(a0, a1); w.y = cvt_pk(a2, a3); *mp = w;
    }
    __device__ __forceinline__ void w8(int r, int c, const f32x4& v0, const f32x4& v1, int j) const {
        const u32x4 g = *(const u32x4*)(gs + (size_t)r * 3072 + j * 1024 + c);
        float a0 = v0.x * bflo(g.x), a1 = v0.y * bfhi(g.x), a2 = v0.z * bflo(g.y), a3 = v0.w * bfhi(g.y), a4 = v1.x * bflo(g.z), a5 = v1.y * bfhi(g.z), a6 = v1.z * bflo(g.w), a7 = v1.w * bfhi(g.w);
        u32x4* mp = (u32x4*)(mb + (size_t)r * 1024 + c);
        if (j > 0) { const u32x4 o = *mp; a0 += bflo(o.x); a1 += bfhi(o.x); a2 += bflo(o.y); a3 += bfhi(o.y); a4 += bflo(o.z); a5 += bfhi(o.z); a6 += bflo(o.w); a7 += bfhi(o.w); }
        u32x4 w; w.x = cvt_pk(a0, a1); w.y = cvt_pk(a2, a3); w.z = cvt_pk(a4, a5); w.w = cvt_pk(a6, a7); *mp = w;
    }
};

namespace pg8 {
constexpr int BM = 256, BK = 64, HALF = 128, HTB = HALF * BK * 2, STAGE_BYTES = 8 * HTB, NXCD = 8, WGM = 2;
__device__ __forceinline__ int lds_byte(int r, int c) { const int st = (r >> 4) * 2 + (c >> 5), rr = r & 15, cc = c & 31, ob = rr * 64 + cc * 2; return st * 1024 + (ob ^ (((ob >> 9) & 1) << 5)); }
__device__ __forceinline__ int perm32(int rho) { const int n = rho >> 4, i = rho & 15; return 8 * (i >> 2) + 4 * n + (i & 3); }
__device__ __forceinline__ void stage_rc(int b, int& R_, int& C_) { const int st = b / 1024, sb = b % 1024, swz = sb ^ (((sb >> 9) & 1) << 5); R_ = (st >> 1) * 16 + swz / 64; C_ = (st & 1) * 32 + (swz % 64) / 2; }
struct Unit { int pm, pn, acol, brow, j; };
struct Gemm { const bf16_t* A; const bf16_t* Bt; int lda, K; };
struct StaticOrder {
    int nM, nN, nwg, G, c;
    __device__ void init(int M, int N, int G_, int c_) { nM = M / BM; nN = N / BM; nwg = nM * nN; G = G_; c = c_; }
    __device__ __forceinline__ bool tile(long L, int& pm, int& pn) const {
        if (L >= nwg) return false;
        int wgid = (int)L; { const int q = nwg / NXCD, r = nwg % NXCD, xcd = wgid % NXCD, off = wgid / NXCD; wgid = (xcd < r ? xcd * (q + 1) : r * (q + 1) + (xcd - r) * q) + off; }
        const int nig = WGM * nN, gid = wgid / nig, fm = gid * WGM, gsz = (nM - fm) < WGM ? (nM - fm) : WGM;
        pm = fm + ((wgid % nig) % gsz); pn = (wgid % nig) / gsz; return true;
    }
    __device__ __forceinline__ bool next(int i, Unit& u) const { if (!tile((long)i * G + c, u.pm, u.pn)) return false; u.acol = 0; u.brow = u.pn; u.j = 0; return true; }
};
struct MergeOrder {
    StaticOrder S;
    __device__ __forceinline__ bool next(int i, Unit& u) const { const int j = i % 3; if (!S.tile((long)(i / 3) * S.G + S.c, u.pm, u.pn)) return false; u.acol = j * 512; u.brow = j * 4 + u.pn; u.j = j; return true; }
};
template <class F> struct Epi {
    F f;
    __device__ __forceinline__ void operator()(const f32x4 (&acc)[2][2][4][2], const Unit& u, int wr, int wc, int fr, int fq) const {
#pragma unroll
        for (int ai = 0; ai < 2; ++ai)
#pragma unroll
            for (int m = 0; m < 4; ++m)
#pragma unroll
                for (int bj = 0; bj < 2; ++bj)
                    f.w8(u.pm * BM + ai * HALF + wr * 64 + m * 16 + fr, u.pn * BM + bj * HALF + wc * 32 + 8 * fq, acc[ai][bj][m][0], acc[ai][bj][m][1], u.j);
    }
};

template <class E_, class Sched>
__device__ __forceinline__ void gemm_phase(LAS unsigned char* lds, const Gemm g, const Sched& S, const E_& E) {
    int tid_ = threadIdx.x; asm volatile("" : "+v"(tid_));
    const int tid = tid_, wid = __builtin_amdgcn_readfirstlane(tid >> 6), lane = tid & 63, wr = wid >> 2, wc = wid & 3, fr = lane & 15, fq = lane >> 4;
    const int K = g.K, nt = K / BK;
    unsigned voffA[2], voffB[2];
#pragma unroll
    for (int i = 0; i < 2; ++i) { int R_, C_; stage_rc(tid * 16 + i * 8192, R_, C_); const int Rb = (R_ & ~31) + perm32(R_ & 31); voffA[i] = (unsigned)(R_ * g.lda + C_) * 2u; voffB[i] = (unsigned)(Rb * K + C_) * 2u; }
    const size_t kstep = (size_t)(BK * 2);
    const size_t hstepA = (size_t)HALF * g.lda * 2, hstepB = (size_t)HALF * K * 2;
    const unsigned ldsw = (unsigned)wid * 1024u;
    const int aoff = lds_byte(wr * 64 + fr, fq * 8), boff = lds_byte(wc * 32 + fr, fq * 8);
#define PG8_SA(b, h) (((b) * 2 + (h)) * HTB)
#define PG8_SB(b, h) ((4 + (b) * 2 + (h)) * HTB)
#define PG8_STAGE(bufoff, gbase, voff) do { _Pragma("unroll") for (int _i = 0; _i < 2; ++_i) \
        __builtin_amdgcn_global_load_lds((const unsigned*)((const char*)(gbase) + (voff)[_i]), (LAS unsigned*)(lds + (bufoff) + ldsw + _i * 8192), 16, 0, 0); } while (0)
#define PG8_LDA(dst, b, h) do { _Pragma("unroll") for (int m = 0; m < 4; ++m) _Pragma("unroll") for (int k = 0; k < 2; ++k) dst[m][k] = *(const LAS bf16x8*)(lds + PG8_SA(b, h) + aoff + m * 2048 + k * 1024); } while (0)
#define PG8_LDB(dst, b, h) do { _Pragma("unroll") for (int n = 0; n < 2; ++n) _Pragma("unroll") for (int k = 0; k < 2; ++k) dst[n][k] = *(const LAS bf16x8*)(lds + PG8_SB(b, h) + boff + n * 2048 + k * 1024); } while (0)
#define PG8_MMA(ai, bj, At, Bt) do { __builtin_amdgcn_s_setprio(1); _Pragma("unroll") for (int m = 0; m < 4; ++m) _Pragma("unroll") for (int n = 0; n < 2; ++n) _Pragma("unroll") for (int k = 0; k < 2; ++k) \
        acc[ai][bj][m][n] = __builtin_amdgcn_mfma_f32_16x16x32_bf16(Bt[n][k], At[m][k], acc[ai][bj][m][n], 0, 0, 0); __builtin_amdgcn_s_setprio(0); } while (0)
#define PG8_WAIT_V(n) asm volatile("s_waitcnt vmcnt(" #n ")" ::: "memory")
#define PG8_WAIT_L(n) asm volatile("s_waitcnt lgkmcnt(" #n ")" ::: "memory")
#define PG8_BAR __builtin_amdgcn_s_barrier()
#define PG8_SCHED __builtin_amdgcn_sched_barrier(0)
#define PG8_UA(u) ((const char*)g.A + ((size_t)(u).pm * BM * g.lda + (u).acol) * 2)
#define PG8_UB(u) ((const char*)g.Bt + (size_t)(u).brow * BM * K * 2)
    Unit cur, nxt; int ui = 0;
    if (!S.next(0, cur)) return;
    f32x4 acc[2][2][4][2];
#pragma unroll
    for (int a = 0; a < 2; ++a)
#pragma unroll
        for (int b = 0; b < 2; ++b)
#pragma unroll
            for (int m = 0; m < 4; ++m)
#pragma unroll
                for (int n = 0; n < 2; ++n) acc[a][b][m][n] = (f32x4){0.f, 0.f, 0.f, 0.f};
    bf16x8 At[4][2], B0[2][2], B1[2][2];
    const char* cA = PG8_UA(cur); const char* cB = PG8_UB(cur);
    PG8_STAGE(PG8_SB(0, 0), cB, voffB); PG8_STAGE(PG8_SB(0, 1), cB + hstepB, voffB); PG8_STAGE(PG8_SA(0, 0), cA, voffA); PG8_STAGE(PG8_SA(0, 1), cA + hstepA, voffA);
    if (wr == 1) PG8_BAR;
    PG8_WAIT_V(2); PG8_BAR;
    PG8_STAGE(PG8_SB(1, 0), cB + kstep, voffB); PG8_STAGE(PG8_SA(1, 0), cA + kstep, voffA); PG8_STAGE(PG8_SB(1, 1), cB + hstepB + kstep, voffB);
    PG8_WAIT_V(6); PG8_BAR;
    for (;;) {
        const bool has_next = S.next(ui + 1, nxt);
        const char* nA = has_next ? PG8_UA(nxt) : cA; const char* nB = has_next ? PG8_UB(nxt) : cB;
        for (int t = 0; t < nt; t += 2) {
            const bool last = (t == nt - 2);
            const char* a1 = cA + (size_t)(t + 1) * kstep;
            const char* a2 = last ? nA : cA + (size_t)(t + 2) * kstep; const char* b2 = last ? nB : cB + (size_t)(t + 2) * kstep;
            const char* a3 = a2 + kstep; const char* b3 = b2 + kstep;
            PG8_LDB(B0, 0, 0); PG8_LDB(B1, 0, 1); PG8_SCHED; PG8_LDA(At, 0, 0); PG8_STAGE(PG8_SA(1, 1), a1 + hstepA, voffA);
            PG8_WAIT_V(8); PG8_WAIT_L(0); PG8_BAR; PG8_MMA(0, 0, At, B0); PG8_MMA(0, 1, At, B1); PG8_BAR; PG8_SCHED;
            PG8_LDA(At, 0, 1); PG8_STAGE(PG8_SB(0, 0), b2, voffB); PG8_STAGE(PG8_SB(0, 1), b2 + hstepB, voffB); PG8_STAGE(PG8_SA(0, 0), a2, voffA);
            PG8_WAIT_V(8); PG8_WAIT_L(0); PG8_BAR; PG8_MMA(1, 0, At, B0); PG8_MMA(1, 1, At, B1); PG8_BAR; PG8_SCHED;
            PG8_LDB(B0, 1, 0); PG8_LDB(B1, 1, 1); PG8_SCHED; PG8_LDA(At, 1, 0); PG8_STAGE(PG8_SA(0, 1), a2 + hstepA, voffA);
            PG8_WAIT_V(8); PG8_WAIT_L(0); PG8_BAR; PG8_MMA(0, 0, At, B0); PG8_MMA(0, 1, At, B1); PG8_BAR; PG8_SCHED;
            PG8_LDA(At, 1, 1); PG8_STAGE(PG8_SB(1, 0), b3, voffB); PG8_STAGE(PG8_SB(1, 1), b3 + hstepB, voffB); PG8_STAGE(PG8_SA(1, 0), a3, voffA);
            PG8_WAIT_V(8); PG8_WAIT_L(0); PG8_BAR; PG8_MMA(1, 0, At, B0); PG8_MMA(1, 1, At, B1); PG8_BAR; PG8_SCHED;
        }
        if (wr == 0) PG8_BAR;
        E(acc, cur, wr, wc, fr, fq);
        if (!has_next) break;
#pragma unroll
        for (int a = 0; a < 2; ++a)
#pragma unroll
            for (int b = 0; b < 2; ++b)
#pragma unroll
                for (int m = 0; m < 4; ++m)
#pragma unroll
                    for (int n = 0; n < 2; ++n) acc[a][b][m][n] = (f32x4){0.f, 0.f, 0.f, 0.f};
        cur = nxt; cA = nA; cB = nB; ++ui;
        if (wr == 1) PG8_BAR;
    }
    PG8_WAIT_V(0);
    PG8_BAR;
#undef PG8_SA
#undef PG8_SB
#undef PG8_STAGE
#undef PG8_LDA
#undef PG8_LDB
#undef PG8_MMA
#undef PG8_WAIT_V
#undef PG8_WAIT_L
#undef PG8_BAR
#undef PG8_SCHED
#undef PG8_UA
#undef PG8_UB
}
}

template <class F>
__device__ __forceinline__ void big_gemm(LAS unsigned char* ldsb, const bf16_t* A, int lda, const bf16_t* Bt, int K, int N, const F& f) {
    pg8::Gemm g{A, Bt, lda, K}; pg8::StaticOrder S; S.init(RL, N, (int)gridDim.x, (int)blockIdx.x);
    pg8::Epi<F> E{f};
    pg8::gemm_phase(ldsb, g, S, E);
    __syncthreads();
}
template <int NI>
__device__ __forceinline__ void gemm_kloop(f32x4 (&acc)[4][NI], const bf16_t* Ag, int lda, const bf16_t* Bg, int ldb, int K, char* lds) {
    const int tid = tid_l(), lane = tid & 63, wid = tid >> 6, wm = wid >> 1, wn = wid & 1, lr = lane & 15, lq = lane >> 4;
    u32x4 ra[4], rb[NI];
    const int prow = tid >> 3, pkc = tid & 7;
    const bf16_t* ap = Ag + (size_t)prow * lda + pkc * 8;
    const bf16_t* bp = Bg + (size_t)prow * ldb + pkc * 8;
    const int soff = prow * 128 + ((pkc ^ (prow & 7)) << 4);
#pragma unroll
    for (int i = 0; i < 4; ++i) { ra[i] = *(const u32x4*)(ap + (size_t)(32 * i) * lda); if (i < NI) rb[i < NI ? i : 0] = *(const u32x4*)(bp + (size_t)(32 * i) * ldb); }
#pragma unroll
    for (int i = 0; i < 4; ++i) { *(u32x4*)(lds + soff + i * 4096) = ra[i]; if (i < NI) *(u32x4*)(lds + 32768 + soff + i * 4096) = rb[i < NI ? i : 0]; }
    __syncthreads();
    const int nk = K >> 6;
    for (int kt = 0; kt < nk; ++kt) {
        const int buf = kt & 1;
        if (kt + 1 < nk) {
#pragma unroll
            for (int i = 0; i < 4; ++i) { ra[i] = *(const u32x4*)(ap + (size_t)(32 * i) * lda + (kt + 1) * 64); if (i < NI) rb[i < NI ? i : 0] = *(const u32x4*)(bp + (size_t)(32 * i) * ldb + (kt + 1) * 64); }
        }
        const char* la = lds + buf * 16384; const char* lb = lds + 32768 + buf * 16384;
#pragma unroll
        for (int kk = 0; kk < 2; ++kk) {
            bf16x8 af[4], bfr[NI];
            const int chunk = kk * 4 + lq;
#pragma unroll
            for (int mi = 0; mi < 4; ++mi) { const int row = wm * 64 + mi * 16 + lr; af[mi] = *(const bf16x8*)(la + row * 128 + ((chunk ^ (row & 7)) << 4)); }
#pragma unroll
            for (int ni = 0; ni < NI; ++ni) { const int row = wn * (16 * NI) + ni * 16 + lr; bfr[ni] = *(const bf16x8*)(lb + row * 128 + ((chunk ^ (row & 7)) << 4)); }
#pragma unroll
            for (int mi = 0; mi < 4; ++mi)
#pragma unroll
                for (int ni = 0; ni < NI; ++ni) acc[mi][ni] = __builtin_amdgcn_mfma_f32_16x16x32_bf16(bfr[ni], af[mi], acc[mi][ni], 0, 0, 0);
        }
        if (kt + 1 < nk) {
            char* sa = lds + (buf ^ 1) * 16384 + soff;
#pragma unroll
            for (int i = 0; i < 4; ++i) { *(u32x4*)(sa + i * 4096) = ra[i]; if (i < NI) *(u32x4*)(sa + 32768 + i * 4096) = rb[i < NI ? i : 0]; }
        }
        __syncthreads();
    }
}

__device__ __forceinline__ void tile_of(int t, int Mt, int Nt, int& tm, int& tn) {
    const int per = 8 * Nt; const int p = t / per; const int r = t - p * per; const int pm = (Mt - 8 * p) < 8 ? (Mt - 8 * p) : 8;
    tm = 8 * p + r % pm; tn = r / pm;
}

template <int TYPE> struct MX {
    static constexpr int DK = TYPE == 1 ? 128 : 64;
    static constexpr int NOC = DK / 8;
    static constexpr int PITCH = TYPE == 1 ? 2048 : 1536;
    static constexpr int QOFF = 0;
    static constexpr int KOFF = TYPE == 1 ? 512 : 256;
    static constexpr int VOFF = TYPE == 1 ? 1024 : 512;
    static constexpr int GOFF = TYPE == 1 ? 1536 : 1024;
    static constexpr int QP = DK + 16;
};
constexpr int L_VT = 0;
constexpr int L_Q = 20480;
constexpr int L_CUM = 40960;
constexpr int L_ATT = 57344;
constexpr int L_SC = 67584;
constexpr int L_SA = 68096;

template <int TYPE>
__device__ __forceinline__ void load_qk8(const Params& P, int l, const bf16_t* pb, int b, int c, int t, int h, int oc, bool isk, float (&f)[8], const float* wpre = nullptr) {
    typedef MX<TYPE> M;
    const int coff = (isk ? M::KOFF : M::QOFF) + h * M::DK;
    const size_t rowi = (size_t)(rowbase(b, c) + t);
    if (TYPE == 0) {
        const u32x4 u = *(const u32x4*)(pb + rowi * M::PITCH + coff + oc * 8); UNPACK8(u, f);
    } else if (TYPE == 1) {
        const bool hp = (t > 0) || (c != 0 && c != 4), hn = (t < 63) || (c != 3 && c != NCH - 1);
        const bf16_t* p0 = pb + rowi * M::PITCH + coff + oc * 8;
        u32x4 u1 = *(const u32x4*)p0, u0 = (u32x4){0u, 0u, 0u, 0u}, u2 = (u32x4){0u, 0u, 0u, 0u};
        if (hp) u0 = *(const u32x4*)(p0 - M::PITCH);
        if (hn) u2 = *(const u32x4*)(p0 + M::PITCH);
        float a[8], m[8], n[8]; UNPACK8(u0, a); UNPACK8(u1, m); UNPACK8(u2, n);
        float w0[8], w1[8], w2[8];
        if (wpre) {
#pragma unroll
            for (int j = 0; j < 8; ++j) { w0[j] = wpre[j]; w1[j] = wpre[8 + j]; w2[j] = wpre[16 + j]; }
        } else {
            const float* cw = P.in[I_CONV] + (size_t)l * 3 * 1024 + (isk ? 512 : 0) + h * 128 + oc * 8;
            const f32x4 w0a = *(const f32x4*)cw, w0b = *(const f32x4*)(cw + 4), w1a = *(const f32x4*)(cw + 1024), w1b = *(const f32x4*)(cw + 1028), w2a = *(const f32x4*)(cw + 2048), w2b = *(const f32x4*)(cw + 2052);
            w0[0] = w0a.x; w0[1] = w0a.y; w0[2] = w0a.z; w0[3] = w0a.w; w0[4] = w0b.x; w0[5] = w0b.y; w0[6] = w0b.z; w0[7] = w0b.w;
            w1[0] = w1a.x; w1[1] = w1a.y; w1[2] = w1a.z; w1[3] = w1a.w; w1[4] = w1b.x; w1[5] = w1b.y; w1[6] = w1b.z; w1[7] = w1b.w;
            w2[0] = w2a.x; w2[1] = w2a.y; w2[2] = w2a.z; w2[3] = w2a.w; w2[4] = w2b.x; w2[5] = w2b.y; w2[6] = w2b.z; w2[7] = w2b.w;
        }
#pragma unroll
        for (int j = 0; j < 8; ++j) f[j] = siluf(w0[j] * a[j] + w1[j] * m[j] + w2[j] * n[j]);
    } else {
        if (c < 4) { const u32x4 u = *(const u32x4*)(pb + rowi * M::PITCH + coff + oc * 8); UNPACK8(u, f); }
        else {
            const int o4 = oc & 3;
            const u32x4 ua = *(const u32x4*)(pb + rowi * M::PITCH + coff + o4 * 8), ub = *(const u32x4*)(pb + rowi * M::PITCH + coff + 32 + o4 * 8);
            float x1[8], x2[8]; UNPACK8(ua, x1); UNPACK8(ub, x2);
            const float* tab = (const float*)(ws_l(P) + WS_ROPE);
            const float* cs = o4 < 2 ? tab + (c - 4) * 16 + o4 * 8 : tab + 4096 + t * 16 + (o4 - 2) * 8;
            const float* sn = o4 < 2 ? tab + 2048 + (c - 4) * 16 + o4 * 8 : tab + 4096 + 1024 + t * 16 + (o4 - 2) * 8;
            const f32x4 ca = *(const f32x4*)cs, cb = *(const f32x4*)(cs + 4), sa = *(const f32x4*)sn, sb = *(const f32x4*)(sn + 4);
            const float cv[8] = {ca.x, ca.y, ca.z, ca.w, cb.x, cb.y, cb.z, cb.w}, sv[8] = {sa.x, sa.y, sa.z, sa.w, sb.x, sb.y, sb.z, sb.w};
#pragma unroll
            for (int j = 0; j < 8; ++j) f[j] = oc < 4 ? x1[j] * cv[j] - x2[j] * sv[j] : x1[j] * sv[j] + x2[j] * cv[j];
        }
    }
}

__device__ __forceinline__ void load_convw(const Params& P, int l, int h, int oc, bool isk, float (&w)[24]) {
    const float* cw = P.in[I_CONV] + (size_t)l * 3 * 1024 + (isk ? 512 : 0) + h * 128 + oc * 8;
#pragma unroll
    for (int tp = 0; tp < 3; ++tp) { const f32x4 a = *(const f32x4*)(cw + tp * 1024), b = *(const f32x4*)(cw + tp * 1024 + 4);
        w[tp * 8 + 0] = a.x; w[tp * 8 + 1] = a.y; w[tp * 8 + 2] = a.z; w[tp * 8 + 3] = a.w; w[tp * 8 + 4] = b.x; w[tp * 8 + 5] = b.y; w[tp * 8 + 6] = b.z; w[tp * 8 + 7] = b.w; }
}
template <int TYPE>
__device__ __forceinline__ void decay_setup(const Params& P, int l, int b, int c, int h, int dir, char* lds, const float* apre = nullptr) {
    const int tid = tid_l(); const int r0 = rowbase(b, c);
    float* sc = (float*)(lds + L_SC);
    const float* small = (const float*)(ws_l(P) + WS_SMALL);
    if (TYPE == 0) {
        float* cum = (float*)(lds + L_CUM); float* sa = (float*)(lds + L_SA);
        if (apre) {
#pragma unroll
            for (int k = 0; k < 4; ++k) sa[tid + k * NTHR] = apre[k];
        } else {
            for (int i = tid; i < 1024; i += NTHR) sa[i] = small[(size_t)(r0 + (i >> 4)) * 48 + dir * 16 + (i & 15)];
        }
        __syncthreads();
        const int d = tid & 63, tq = tid >> 6;
        const float* a2 = P.in[I_A2] + ((size_t)(l * 2 + dir) * 16) * 256 + h * 64 + d;
        float w[16];
#pragma unroll
        for (int rr = 0; rr < 16; ++rr) w[rr] = a2[rr * 256];
        const float bias = P.in[I_ABIAS][(l * 2 + dir) * 256 + h * 64 + d];
        float* blk = sa + 1024;
        float lv[16];
#pragma unroll
        for (int i = 0; i < 16; ++i) {
            const int t = tq * 16 + i;
            const f32x4 a0 = *(const f32x4*)(sa + t * 16), a1 = *(const f32x4*)(sa + t * 16 + 4), a2v = *(const f32x4*)(sa + t * 16 + 8), a3 = *(const f32x4*)(sa + t * 16 + 12);
            float z = bias;
            z += a0.x * w[0] + a0.y * w[1] + a0.z * w[2] + a0.w * w[3];
            z += a1.x * w[4] + a1.y * w[5] + a1.z * w[6] + a1.w * w[7];
            z += a2v.x * w[8] + a2v.y * w[9] + a2v.z * w[10] + a2v.w * w[11];
            z += a3.x * w[12] + a3.y * w[13] + a3.z * w[14] + a3.w * w[15];
            lv[i] = logsig_fast(z) * (1.f / 16.f);
        }
        if (dir == 0) {
#pragma unroll
            for (int i = 1; i < 16; ++i) lv[i] += lv[i - 1];
        } else {
#pragma unroll
            for (int i = 14; i >= 0; --i) lv[i] += lv[i + 1];
        }
        blk[tq * 64 + d] = dir == 0 ? lv[15] : lv[0];
        __syncthreads();
        float off = 0.f;
#pragma unroll
        for (int q = 0; q < 4; ++q) if (dir == 0 ? (q < tq) : (q > tq)) off += blk[q * 64 + d];
#pragma unroll
        for (int i = 0; i < 16; ++i) cum[(tq * 16 + i) * 64 + d] = lv[i] + off;
    } else if (TYPE == 1) {
        if (tid < 64) {
            const float fg = small[(size_t)(r0 + tid) * 48 + 40 + dir * 4 + h] + P.in[I_FB][l * 8 + dir * 4 + h];
            float v = logsig(fg);
            if (dir == 0) {
#pragma unroll
                for (int o = 1; o < 64; o <<= 1) { const float n = __shfl_up(v, o); if (tid >= o) v += n; }
            } else {
#pragma unroll
                for (int o = 1; o < 64; o <<= 1) { const float n = __shfl_down(v, o); if (tid + o < 64) v += n; }
            }
            const float tot = __shfl(v, dir == 0 ? 63 : 0);
            sc[tid] = v;
            sc[64 + tid] = small[(size_t)(r0 + tid) * 48 + 32 + dir * 4 + h] + P.in[I_IB][l * 8 + dir * 4 + h];
            if (tid == 0) sc[128] = tot;
        }
    } else {
        if (tid < 64) {
            const float lg = logsig(P.in[I_RDL][l * 8 + dir * 4 + h]);
            sc[tid] = (dir == 0 ? (float)(tid + 1) : (float)(64 - tid)) * lg;
            if (tid == 0) sc[128] = 64.f * lg;
        }
    }
    __syncthreads();
}

template <int TYPE>
__device__ __forceinline__ void build_vT(const bf16_t* pb, int b, int c, int h, char* lds) {
    typedef MX<TYPE> M;
    bf16_t* vT = (bf16_t*)(lds + L_VT);
#pragma unroll
    for (int i = 0; i < 2; ++i) {
        const int pid = tid_l() + i * NTHR, tp = pid & 31, oc = pid >> 5;
        const bf16_t* p0 = pb + (size_t)(rowbase(b, c) + 2 * tp) * M::PITCH + M::VOFF + h * 128 + oc * 8;
        const u32x4 u0 = *(const u32x4*)p0, u1 = *(const u32x4*)(p0 + M::PITCH);
        unsigned* dst = (unsigned*)(vT + (size_t)(oc * 8) * 80 + 2 * tp);
        dst[0 * 40] = (u0.x & 0xffffu) | (u1.x << 16); dst[1 * 40] = (u0.x >> 16) | (u1.x & 0xffff0000u);
        dst[2 * 40] = (u0.y & 0xffffu) | (u1.y << 16); dst[3 * 40] = (u0.y >> 16) | (u1.y & 0xffff0000u);
        dst[4 * 40] = (u0.z & 0xffffu) | (u1.z << 16); dst[5 * 40] = (u0.z >> 16) | (u1.z & 0xffff0000u);
        dst[6 * 40] = (u0.w & 0xffffu) | (u1.w << 16); dst[7 * 40] = (u0.w >> 16) | (u1.w & 0xffff0000u);
    }
}

__device__ __forceinline__ int scan_index(int dir, int c) { return dir == 0 ? c : (c < 4 ? 3 - c : 135 - c); }

template <int TYPE>
__device__ __forceinline__ void u_phase(const Params& P, int l, char* lds) {
    typedef MX<TYPE> M; constexpr int DK = M::DK;
    const int tid = tid_l(), lane = tid & 63, wid = tid >> 6, lr = lane & 15, lq = lane >> 4;
    const bf16_t* pb = (const bf16_t*)(ws_l(P) + WS_PBUF);
    bf16_t* U = (bf16_t*)(ws_l(P) + WS_SBUF); float* DEC = (float*)(ws_l(P) + WS_DEC); float* UN = (float*)(ws_l(P) + WS_UN);
    bf16_t* vT = (bf16_t*)(lds + L_VT); bf16_t* kT = (bf16_t*)(lds + L_Q);
    const float* cum = (const float*)(lds + L_CUM); const float* sc = (const float*)(lds + L_SC);
    const int NU = NB * 4 * 2 * NCH, VG = vgrid(), slot = bid_l();
    for (int u0 = 0; u0 < NU; u0 += VG) {
        int unit = u0 + slot; if (unit >= NU) unit = NU - 1;
        const int c = unit % NCH; const int rest = unit / NCH; const int dir = rest & 1, h = (rest >> 1) & 3, b = rest >> 3;
        const int chain = (b * 4 + h) * 2 + dir, n = scan_index(dir, c);
        static_assert(TYPE == 0, "the scalar-decay branches use u_phase_s");
        float k0[8], k1[8], apre[4];
        { const int tp = tid & 31, oc = tid >> 5;
          load_qk8<TYPE>(P, l, pb, b, c, 2 * tp, h, oc, true, k0);
          load_qk8<TYPE>(P, l, pb, b, c, 2 * tp + 1, h, oc, true, k1);
          const float* small = (const float*)(ws_l(P) + WS_SMALL); const int r0 = rowbase(b, c);
#pragma unroll
          for (int k = 0; k < 4; ++k) { const int i = tid + k * NTHR; apre[k] = small[(size_t)(r0 + (i >> 4)) * 48 + dir * 16 + (i & 15)]; } }
        build_vT<TYPE>(pb, b, c, h, lds);
        decay_setup<TYPE>(P, l, b, c, h, dir, lds, apre);
        const int tlast = dir == 0 ? 63 : 0;
        {
            const int pid = tid, tp = pid & 31, oc = pid >> 5;
            unsigned* dst = (unsigned*)(kT + (size_t)(oc * 8) * 80 + 2 * tp);
            if (TYPE == 0) {
#pragma unroll
                for (int j = 0; j < 8; ++j) { const int d = oc * 8 + j; const float tot = cum[tlast * 64 + d];
                    dst[j * 40] = cvt_pk(k0[j] * __expf(tot - cum[(2 * tp) * 64 + d]), k1[j] * __expf(tot - cum[(2 * tp + 1) * 64 + d])); }
            } else {
                const float tot = sc[128];
                const float w0 = TYPE == 1 ? __expf(tot - sc[2 * tp] + sc[64 + 2 * tp]) * 0.08838834764831845f : __expf(tot - sc[2 * tp]) * 0.125f;
                const float w1 = TYPE == 1 ? __expf(tot - sc[2 * tp + 1] + sc[64 + 2 * tp + 1]) * 0.08838834764831845f : __expf(tot - sc[2 * tp + 1]) * 0.125f;
#pragma unroll
                for (int j = 0; j < 8; ++j) dst[j * 40] = cvt_pk(k0[j] * w0, k1[j] * w1);
            }
        }
        __syncthreads();
        f32x4 acc[2][DK / 16];
#pragma unroll
        for (int i = 0; i < 2; ++i)
#pragma unroll
            for (int nt = 0; nt < DK / 16; ++nt) acc[i][nt] = (f32x4){0.f, 0.f, 0.f, 0.f};
#pragma unroll
        for (int kk = 0; kk < 2; ++kk) {
            bf16x8 fv[2];
#pragma unroll
            for (int i = 0; i < 2; ++i) fv[i] = *(const bf16x8*)(vT + (size_t)((2 * wid + i) * 16 + lr) * 80 + kk * 32 + lq * 8);
#pragma unroll
            for (int nt = 0; nt < DK / 16; ++nt) {
                const bf16x8 fk = *(const bf16x8*)(kT + (size_t)(nt * 16 + lr) * 80 + kk * 32 + lq * 8);
#pragma unroll
                for (int i = 0; i < 2; ++i) acc[i][nt] = __builtin_amdgcn_mfma_f32_16x16x32_bf16(fk, fv[i], acc[i][nt], 0, 0, 0);
            }
        }
        bf16_t* ub = U + (size_t)(chain * NCH + n) * 128 * DK;
#pragma unroll
        for (int i = 0; i < 2; ++i)
#pragma unroll
            for (int nt = 0; nt < DK / 16; ++nt) {
                const int e = (2 * wid + i) * 16 + lr, d = nt * 16 + lq * 4;
                u32x2 o; o.x = cvt_pk(acc[i][nt].x, acc[i][nt].y); o.y = cvt_pk(acc[i][nt].z, acc[i][nt].w);
                *(u32x2*)(ub + (size_t)e * DK + d) = o;
            }
        if (tid < DK) {
            const float tot = TYPE == 0 ? cum[tlast * 64 + (tid & 63)] : sc[128];
            DEC[(size_t)(chain * NCH + n) * 128 + tid] = __expf(tot);
            if (TYPE == 1) {
                float s = 0.f;
#pragma unroll
                for (int q = 0; q < 8; ++q) { const u32x4 u = *(const u32x4*)(kT + (size_t)tid * 80 + q * 8); float f[8]; UNPACK8(u, f);
#pragma unroll
                    for (int j = 0; j < 8; ++j) s += f[j]; }
                UN[(size_t)(chain * NCH + n) * 128 + tid] = s;
            }
        }
        __syncthreads();
    }
}

template <int TYPE>
__device__ __forceinline__ void u_phase_s(const Params& P, int l, char* lds) {
    typedef MX<TYPE> M; constexpr int DK = M::DK; constexpr int NIT = M::NOC * 32 / NTHR;
    const int tid = tid_l(), lane = tid & 63, wid = tid >> 6, lr = lane & 15, lq = lane >> 4;
    const bf16_t* pb = (const bf16_t*)(ws_l(P) + WS_PBUF);
    const float* small = (const float*)(ws_l(P) + WS_SMALL);
    bf16_t* U = (bf16_t*)(ws_l(P) + WS_SBUF); float* DEC = (float*)(ws_l(P) + WS_DEC); float* UN = (float*)(ws_l(P) + WS_UN);
    bf16_t* vT = (bf16_t*)(lds + L_VT); bf16_t* kT0 = (bf16_t*)(lds + 20480); bf16_t* kT1 = (bf16_t*)(lds + 40960);
    float* sc = (float*)(lds + L_SC);
    const int NU = NB * 4 * NCH, VG = vgrid(), slot = bid_l();
    for (int u0 = 0; u0 < NU; u0 += VG) {
        int unit = u0 + slot; int dmask = 3;
        if (VG == 512 && u0 >= 1024) { if (slot >= 2 * (NU - 1024)) continue; unit = 1024 + (slot >> 1); dmask = 1 << (slot & 1); }
        else if (unit >= NU) unit = NU - 1;
        const int c = unit % NCH; const int rest = unit / NCH; const int h = rest & 3, b = rest >> 2;
        const int r0 = rowbase(b, c);
        float kv[NIT][2][8];
#pragma unroll
        for (int i = 0; i < NIT; ++i) {
            const int pid = tid + i * NTHR, tp = pid & 31, oc = pid >> 5;
            load_qk8<TYPE>(P, l, pb, b, c, 2 * tp, h, oc, true, kv[i][0]);
            load_qk8<TYPE>(P, l, pb, b, c, 2 * tp + 1, h, oc, true, kv[i][1]);
        }
        if (TYPE == 1) {
            if (tid < 128) {
                const int dir = tid >> 6, t = tid & 63;
                const float fg = small[(size_t)(r0 + t) * 48 + 40 + dir * 4 + h] + P.in[I_FB][l * 8 + dir * 4 + h];
                float v = logsig(fg);
                if (dir == 0) {
#pragma unroll
                    for (int o = 1; o < 64; o <<= 1) { const float n = __shfl_up(v, o); if (t >= o) v += n; }
                } else {
#pragma unroll
                    for (int o = 1; o < 64; o <<= 1) { const float n = __shfl_down(v, o); if (t + o < 64) v += n; }
                }
                sc[dir * 64 + t] = v;
                sc[128 + dir * 64 + t] = small[(size_t)(r0 + t) * 48 + 32 + dir * 4 + h] + P.in[I_IB][l * 8 + dir * 4 + h];
            }
        } else {
            if (tid < 64) {
                const float lg0 = logsig(P.in[I_RDL][l * 8 + h]), lg1 = logsig(P.in[I_RDL][l * 8 + 4 + h]);
                sc[tid] = (float)(tid + 1) * lg0; sc[64 + tid] = (float)(64 - tid) * lg1;
            }
        }
        build_vT<TYPE>(pb, b, c, h, lds);
        __syncthreads();
        const float totf = sc[63], totb = sc[64];
        const float ks = TYPE == 1 ? 0.08838834764831845f : 0.125f;
#pragma unroll
        for (int i = 0; i < NIT; ++i) {
            const int pid = tid + i * NTHR, tp = pid & 31, oc = pid >> 5;
            const int t0 = 2 * tp, t1 = 2 * tp + 1;
            const float wf0 = __expf(totf - sc[t0] + (TYPE == 1 ? sc[128 + t0] : 0.f)) * ks, wf1 = __expf(totf - sc[t1] + (TYPE == 1 ? sc[128 + t1] : 0.f)) * ks;
            const float wb0 = __expf(totb - sc[64 + t0] + (TYPE == 1 ? sc[192 + t0] : 0.f)) * ks, wb1 = __expf(totb - sc[64 + t1] + (TYPE == 1 ? sc[192 + t1] : 0.f)) * ks;
            unsigned* d0 = (unsigned*)(kT0 + (size_t)(oc * 8) * 80 + 2 * tp); unsigned* d1 = (unsigned*)(kT1 + (size_t)(oc * 8) * 80 + 2 * tp);
#pragma unroll
            for (int j = 0; j < 8; ++j) { d0[j * 40] = cvt_pk(kv[i][0][j] * wf0, kv[i][1][j] * wf1); d1[j * 40] = cvt_pk(kv[i][0][j] * wb0, kv[i][1][j] * wb1); }
        }
        __syncthreads();
        const int chf = (b * 4 + h) * 2;
#pragma unroll 1
        for (int dir = 0; dir < 2; ++dir) {
            if (!((dmask >> dir) & 1)) continue;
            const bf16_t* kT = dir == 0 ? kT0 : kT1;
            const int n = scan_index(dir, c);
            f32x4 acc[2][DK / 16];
#pragma unroll
            for (int i = 0; i < 2; ++i)
#pragma unroll
                for (int nt = 0; nt < DK / 16; ++nt) acc[i][nt] = (f32x4){0.f, 0.f, 0.f, 0.f};
#pragma unroll
            for (int kk = 0; kk < 2; ++kk) {
                bf16x8 fv[2];
#pragma unroll
                for (int i = 0; i < 2; ++i) fv[i] = *(const bf16x8*)(vT + (size_t)((2 * wid + i) * 16 + lr) * 80 + kk * 32 + lq * 8);
#pragma unroll
                for (int nt = 0; nt < DK / 16; ++nt) {
                    const bf16x8 fk = *(const bf16x8*)(kT + (size_t)(nt * 16 + lr) * 80 + kk * 32 + lq * 8);
#pragma unroll
                    for (int i = 0; i < 2; ++i) acc[i][nt] = __builtin_amdgcn_mfma_f32_16x16x32_bf16(fk, fv[i], acc[i][nt], 0, 0, 0);
                }
            }
            bf16_t* ub = U + (size_t)((chf + dir) * NCH + n) * 128 * DK;
#pragma unroll
            for (int i = 0; i < 2; ++i)
#pragma unroll
                for (int nt = 0; nt < DK / 16; ++nt) {
                    const int e = (2 * wid + i) * 16 + lr, d = nt * 16 + lq * 4;
                    u32x2 o; o.x = cvt_pk(acc[i][nt].x, acc[i][nt].y); o.y = cvt_pk(acc[i][nt].z, acc[i][nt].w);
                    *(u32x2*)(ub + (size_t)e * DK + d) = o;
                }
        }
        if (tid < 2 * DK) {
            const int dir = tid / DK, d = tid % DK; const int n = scan_index(dir, c);
            if ((dmask >> dir) & 1) {
            DEC[(size_t)((chf + dir) * NCH + n) * 128 + d] = __expf(dir == 0 ? totf : totb);
            if (TYPE == 1) {
                const bf16_t* kT = dir == 0 ? kT0 : kT1;
                float sum = 0.f;
#pragma unroll
                for (int q = 0; q < 8; ++q) { const u32x4 u = *(const u32x4*)(kT + (size_t)d * 80 + q * 8); float f[8]; UNPACK8(u, f);
#pragma unroll
                    for (int j = 0; j < 8; ++j) sum += f[j]; }
                UN[(size_t)((chf + dir) * NCH + n) * 128 + d] = sum;
            }
            }
        }
        __syncthreads();
    }
}

template <int DK, bool HASN>
__device__ __forceinline__ void scan_phase(const Params& P) {
    bf16_t* U = (bf16_t*)(ws_l(P) + WS_SBUF); const float* DEC = (const float*)(ws_l(P) + WS_DEC); float* UN = (float*)(ws_l(P) + WS_UN);
    constexpr int VEC = DK / 64;
    constexpr int DQ = DK / VEC; constexpr int TT = 16 * 128 * DQ;
    constexpr size_t US = (size_t)128 * DK;
    for (int g = bid_l() * NTHR + tid_l(); g < TT; g += vgrid() * NTHR) {
        const int dq = g % DQ, e = (g / DQ) % 128, chain = g / (DQ * 128);
        bf16_t* up = U + ((size_t)chain * NCH * 128 + e) * DK + dq * VEC;
        const float* dp = DEC + (size_t)chain * NCH * 128 + dq * VEC;
        float S0 = 0.f, S1 = 0.f;
        constexpr int SB = 12;
        unsigned ua[SB], ubv[SB]; f32x2 da[SB], db[SB];
#define SC_LOAD(uu, dd, n0) do { _Pragma("unroll") for (int j = 0; j < SB; ++j) { \
            if (VEC == 2) { uu[j] = *(const unsigned*)(up + (size_t)((n0) + j) * US); dd[j] = *(const f32x2*)(dp + (size_t)((n0) + j) * 128); } \
            else { uu[j] = (unsigned)up[(size_t)((n0) + j) * US]; dd[j].x = dp[(size_t)((n0) + j) * 128]; dd[j].y = 0.f; } } } while (0)
#define SC_STEP(uu, dd, n0) do { _Pragma("unroll") for (int j = 0; j < SB; ++j) { \
            if (VEC == 2) { *(unsigned*)(up + (size_t)((n0) + j) * US) = cvt_pk(S0, S1); S0 = dd[j].x * S0 + bflo(uu[j]); S1 = dd[j].y * S1 + bfhi(uu[j]); } \
            else { up[(size_t)((n0) + j) * US] = (bf16_t)(cvt_pk(S0, 0.f) & 0xffffu); S0 = dd[j].x * S0 + bflo(uu[j]); } } } while (0)
        SC_LOAD(ua, da, 0);
        for (int n0 = 0; n0 < 120; n0 += 24) {
            SC_LOAD(ubv, db, n0 + 12);
            SC_STEP(ua, da, n0);
            SC_LOAD(ua, da, n0 + 24);
            SC_STEP(ubv, db, n0 + 12);
        }
        SC_STEP(ua, da, 120);
#undef SC_LOAD
#undef SC_STEP
    }
    if (HASN) {
        for (int g = bid_l() * NTHR + tid_l(); g < 16 * 128; g += vgrid() * NTHR) {
            const int d = g & 127, chain = g >> 7;
            float* np = UN + (size_t)chain * NCH * 128 + d; const float* dp = DEC + (size_t)chain * NCH * 128 + d;
            float S = 0.f;
            float ua_[12], da_[12], ub_[12], db_[12];
#define NS_LOAD(uu, dd, n0) do { _Pragma("unroll") for (int j = 0; j < 12; ++j) { uu[j] = np[(size_t)((n0) + j) * 128]; dd[j] = dp[(size_t)((n0) + j) * 128]; } } while (0)
#define NS_STEP(uu, dd, n0) do { _Pragma("unroll") for (int j = 0; j < 12; ++j) { np[(size_t)((n0) + j) * 128] = S; S = dd[j] * S + uu[j]; } } while (0)
            NS_LOAD(ua_, da_, 0);
            for (int n0 = 0; n0 < 120; n0 += 24) {
                NS_LOAD(ub_, db_, n0 + 12);
                NS_STEP(ua_, da_, n0);
                NS_LOAD(ua_, da_, n0 + 24);
                NS_STEP(ub_, db_, n0 + 12);
            }
            NS_STEP(ua_, da_, 120);
#undef NS_LOAD
#undef NS_STEP
        }
    }
}

template <int TYPE>
__device__ __forceinline__ void out_phase(const Params& P, int l, int pass, bool latent_only, char* lds) {
    typedef MX<TYPE> M; constexpr int DK = M::DK; constexpr int QP = M::QP;
    const int tid = tid_l(), lane = tid & 63, wid = tid >> 6, lr = lane & 15, lq = lane >> 4;
    const bf16_t* pb = (const bf16_t*)(ws_l(P) + WS_PBUF);
    const bf16_t* U = (const bf16_t*)(ws_l(P) + WS_SBUF); const float* UN = (const float*)(ws_l(P) + WS_UN);
    bf16_t* brp = (bf16_t*)(ws_l(P) + WS_BR);
    bf16_t* vT = (bf16_t*)(lds + L_VT); bf16_t* qin = (bf16_t*)(lds + L_Q); bf16_t* kin = qin + 64 * QP; bf16_t* att = (bf16_t*)(lds + L_ATT);
    const float* cum = (const float*)(lds + L_CUM); const float* sc = (const float*)(lds + L_SC);
    const float* ng = P.in[TYPE == 0 ? I_GNG : (TYPE == 1 ? I_MNG : I_RNG)] + l * 512;
    const int NC = latent_only ? NCH - 4 : NCH; const int NU = NB * 4 * NC, VG = vgrid(), slot = bid_l();
    for (int u0 = 0; u0 < NU; u0 += VG) {
        int unit = u0 + slot; if (unit >= NU) unit = NU - 1;
        const int c = unit % NC + (latent_only ? 4 : 0); const int rest = unit / NC; const int h = rest & 3, b = rest >> 2;
        const int r0 = rowbase(b, c);
        build_vT<TYPE>(pb, b, c, h, lds);
        f32x4 tot[8];
#pragma unroll
        for (int et = 0; et < 8; ++et) tot[et] = (f32x4){0.f, 0.f, 0.f, 0.f};
        const int trow = wid * 16 + lr;
        for (int dir = 0; dir < 2; ++dir) {
            const int chain = (b * 4 + h) * 2 + dir, n = scan_index(dir, c);
            decay_setup<TYPE>(P, l, b, c, h, dir, lds);
#pragma unroll 2
            for (int i = 0; i < 64 * M::NOC / NTHR; ++i) {
                const int pid = tid + i * NTHR, t = pid / M::NOC, oc = pid % M::NOC;
                float q8[8], k8[8];
                load_qk8<TYPE>(P, l, pb, b, c, t, h, oc, false, q8);
                load_qk8<TYPE>(P, l, pb, b, c, t, h, oc, true, k8);
                if (TYPE == 0) {
#pragma unroll
                    for (int j = 0; j < 8; ++j) { const float cv = cum[t * 64 + oc * 8 + j]; q8[j] *= __expf(cv) * 0.125f; k8[j] *= __expf(-cv); }
                } else {
                    const float cv = sc[t];
                    const float wq = __expf(cv);
                    const float wk = TYPE == 1 ? __expf(sc[64 + t] - cv) * 0.08838834764831845f : __expf(-cv) * 0.125f;
#pragma unroll
                    for (int j = 0; j < 8; ++j) { q8[j] *= wq; k8[j] *= wk; }
                }
                u32x4 oq, ok;
                oq.x = cvt_pk(q8[0], q8[1]); oq.y = cvt_pk(q8[2], q8[3]); oq.z = cvt_pk(q8[4], q8[5]); oq.w = cvt_pk(q8[6], q8[7]);
                ok.x = cvt_pk(k8[0], k8[1]); ok.y = cvt_pk(k8[2], k8[3]); ok.z = cvt_pk(k8[4], k8[5]); ok.w = cvt_pk(k8[6], k8[7]);
                *(u32x4*)(qin + (size_t)t * QP + oc * 8) = oq;
                *(u32x4*)(kin + (size_t)t * QP + oc * 8) = ok;
            }
            __syncthreads();
            f32x4 sacc[4];
#pragma unroll
            for (int nt = 0; nt < 4; ++nt) sacc[nt] = (f32x4){0.f, 0.f, 0.f, 0.f};
#pragma unroll
            for (int kk = 0; kk < DK / 32; ++kk) {
                const bf16x8 fq = *(const bf16x8*)(qin + (size_t)trow * QP + kk * 32 + lq * 8);
#pragma unroll
                for (int nt = 0; nt < 4; ++nt) {
                    const bf16x8 fk = *(const bf16x8*)(kin + (size_t)(nt * 16 + lr) * QP + kk * 32 + lq * 8);
                    sacc[nt] = __builtin_amdgcn_mfma_f32_16x16x32_bf16(fk, fq, sacc[nt], 0, 0, 0);
                }
            }
            float den = 0.f;
#pragma unroll
            for (int nt = 0; nt < 4; ++nt) {
                const int s0 = nt * 16 + lq * 4;
                float a0 = sacc[nt].x, a1 = sacc[nt].y, a2 = sacc[nt].z, a3 = sacc[nt].w;
                if (dir == 0) { if (s0 + 0 > trow) a0 = 0.f; if (s0 + 1 > trow) a1 = 0.f; if (s0 + 2 > trow) a2 = 0.f; if (s0 + 3 > trow) a3 = 0.f; }
                else { if (s0 + 0 < trow) a0 = 0.f; if (s0 + 1 < trow) a1 = 0.f; if (s0 + 2 < trow) a2 = 0.f; if (s0 + 3 < trow) a3 = 0.f; }
                den += (a0 + a1) + (a2 + a3);
                u32x2 o; o.x = cvt_pk(a0, a1); o.y = cvt_pk(a2, a3);
                *(u32x2*)(att + (size_t)trow * 80 + s0) = o;
            }
            __syncthreads();
            f32x4 oacc[8];
#pragma unroll
            for (int et = 0; et < 8; ++et) oacc[et] = (f32x4){0.f, 0.f, 0.f, 0.f};
#pragma unroll
            for (int kk = 0; kk < 2; ++kk) {
                const bf16x8 fa = *(const bf16x8*)(att + (size_t)trow * 80 + kk * 32 + lq * 8);
#pragma unroll
                for (int et = 0; et < 8; ++et) {
                    const bf16x8 fv = *(const bf16x8*)(vT + (size_t)(et * 16 + lr) * 80 + kk * 32 + lq * 8);
                    oacc[et] = __builtin_amdgcn_mfma_f32_16x16x32_bf16(fv, fa, oacc[et], 0, 0, 0);
                }
            }
            const bf16_t* sp = U + (size_t)(chain * NCH + n) * 128 * DK;
#pragma unroll
            for (int kk = 0; kk < DK / 32; ++kk) {
                const bf16x8 fq = *(const bf16x8*)(qin + (size_t)trow * QP + kk * 32 + lq * 8);
#pragma unroll
                for (int et = 0; et < 8; ++et) {
                    const bf16x8 fs = *(const bf16x8*)(sp + (size_t)(et * 16 + lr) * DK + kk * 32 + lq * 8);
                    oacc[et] = __builtin_amdgcn_mfma_f32_16x16x32_bf16(fs, fq, oacc[et], 0, 0, 0);
                }
            }
            if (TYPE == 1) {
                const float* np = UN + (size_t)(chain * NCH + n) * 128 + lq * 32;
#pragma unroll
                for (int q = 0; q < 4; ++q) {
                    const u32x4 u = *(const u32x4*)(qin + (size_t)trow * QP + lq * 32 + q * 8); float f[8]; UNPACK8(u, f);
                    const f32x4 n0 = *(const f32x4*)(np + q * 8), n1 = *(const f32x4*)(np + q * 8 + 4);
                    den += f[0] * n0.x + f[1] * n0.y + f[2] * n0.z + f[3] * n0.w + f[4] * n1.x + f[5] * n1.y + f[6] * n1.z + f[7] * n1.w;
                }
                den += __shfl_xor(den, 16); den += __shfl_xor(den, 32);
                const float sc1 = 1.f / fmaxf(fabsf(den), 1.f);
#pragma unroll
                for (int et = 0; et < 8; ++et) tot[et] += oacc[et] * sc1;
            } else {
#pragma unroll
                for (int et = 0; et < 8; ++et) tot[et] += oacc[et];
            }
            __syncthreads();
        }
        float s1 = 0.f;
#pragma unroll
        for (int et = 0; et < 8; ++et) s1 += (tot[et].x + tot[et].y) + (tot[et].z + tot[et].w);
        s1 += __shfl_xor(s1, 16); s1 += __shfl_xor(s1, 32);
        const float mean = TYPE == 0 ? 0.f : s1 * (1.f / 128.f);
        float s2 = 0.f;
#pragma unroll
        for (int et = 0; et < 8; ++et) { tot[et] = tot[et] - mean; s2 += (tot[et].x * tot[et].x + tot[et].y * tot[et].y) + (tot[et].z * tot[et].z + tot[et].w * tot[et].w); }
        s2 += __shfl_xor(s2, 16); s2 += __shfl_xor(s2, 32);
        const float rstd = rsqrtf(s2 * (1.f / 128.f) + 1e-6f);
        const size_t rowi = (size_t)(r0 + trow);
#pragma unroll
        for (int et = 0; et < 8; ++et) {
            const int e = et * 16 + lq * 4;
            const f32x4 gg = *(const f32x4*)(ng + h * 128 + e);
            const u32x2 gu = *(const u32x2*)(pb + rowi * M::PITCH + M::GOFF + h * 128 + e);
            const float g0 = bflo(gu.x), g1 = bfhi(gu.x), g2 = bflo(gu.y), g3 = bfhi(gu.y);
            u32x2 o;
            float y0 = tot[et].x * rstd * gg.x * siluf(g0), y1 = tot[et].y * rstd * gg.y * siluf(g1), y2 = tot[et].z * rstd * gg.z * siluf(g2), y3 = tot[et].w * rstd * gg.w * siluf(g3);
            o.x = cvt_pk(y0, y1); o.y = cvt_pk(y2, y3);
            *(u32x2*)(brp + rowi * 1536 + pass * 512 + h * 128 + e) = o;
        }
        __syncthreads();
    }
}

template <int TYPE>
__device__ __forceinline__ void out_phase_s(const Params& P, int l, int pass, bool latent_only, char* lds) {
    typedef MX<TYPE> M; constexpr int DK = M::DK; constexpr int QP = M::QP; constexpr int NKK = DK / 32;
    const bf16_t* pb = (const bf16_t*)(ws_l(P) + WS_PBUF);
    const bf16_t* U = (const bf16_t*)(ws_l(P) + WS_SBUF); const float* UN = (const float*)(ws_l(P) + WS_UN);
    const float* small = (const float*)(ws_l(P) + WS_SMALL);
    bf16_t* brp = (bf16_t*)(ws_l(P) + WS_BR);
    bf16_t* vT = (bf16_t*)(lds + L_VT); bf16_t* qr = (bf16_t*)(lds + L_Q); bf16_t* kr = qr + 64 * QP; bf16_t* att = (bf16_t*)(lds + L_ATT);
    float* sc = (float*)(lds + L_SC);
    float* sn = sc + 256;
    float* rsv = sc + 512;
    float* part = sc + 640;
    const float* ng = P.in[TYPE == 1 ? I_MNG : I_RNG] + l * 512;
    const int NC = latent_only ? NCH - 4 : NCH; const int NU = NB * 4 * NC, VG = vgrid(), slot = bid_l();
    for (int u0 = 0; u0 < NU; u0 += VG) {
        int unit = u0 + slot; if (unit >= NU) unit = NU - 1;
        const int tid = tid_l(), lane = tid & 63, wid = tid >> 6, lr = lane & 15, lq = lane >> 4;
        const int c = unit % NC + (latent_only ? 4 : 0); const int rest = unit / NC; const int h = rest & 3, b = rest >> 2;
        const int r0 = rowbase(b, c);
        const int trow = wid * 16 + lr;
        const int chf = (b * 4 + h) * 2, nf = scan_index(0, c), nb = scan_index(1, c);
        if (TYPE == 1) {
            sn[tid] = UN[(size_t)((chf + (tid >> 7)) * NCH + ((tid >> 7) == 0 ? nf : nb)) * 128 + (tid & 127)];
            if (tid < 128) {
                const int dir = tid >> 6, t = tid & 63;
                const float fg = small[(size_t)(r0 + t) * 48 + 40 + dir * 4 + h] + P.in[I_FB][l * 8 + dir * 4 + h];
                float v = logsig(fg);
                if (dir == 0) {
#pragma unroll
                    for (int o = 1; o < 64; o <<= 1) { const float n = __shfl_up(v, o); if (t >= o) v += n; }
                } else {
#pragma unroll
                    for (int o = 1; o < 64; o <<= 1) { const float n = __shfl_down(v, o); if (t + o < 64) v += n; }
                }
                sc[dir * 64 + t] = v;
                sc[128 + dir * 64 + t] = small[(size_t)(r0 + t) * 48 + 32 + dir * 4 + h] + P.in[I_IB][l * 8 + dir * 4 + h];
            }
        } else {
            if (tid < 64) {
                const float lg0 = logsig(P.in[I_RDL][l * 8 + h]), lg1 = logsig(P.in[I_RDL][l * 8 + 4 + h]);
                sc[tid] = (float)(tid + 1) * lg0; sc[64 + tid] = (float)(64 - tid) * lg1;
            }
        }
        float wq[24], wk[24];
        if (TYPE == 1) { load_convw(P, l, h, tid % M::NOC, false, wq); load_convw(P, l, h, tid % M::NOC, true, wk); }
        build_vT<TYPE>(pb, b, c, h, lds);
#pragma unroll
        for (int i = 0; i < 64 * M::NOC / NTHR; ++i) {
            const int pid = tid + i * NTHR, t = pid / M::NOC, oc = pid % M::NOC;
            float q8[8], k8[8];
            load_qk8<TYPE>(P, l, pb, b, c, t, h, oc, false, q8, TYPE == 1 ? wq : nullptr);
            load_qk8<TYPE>(P, l, pb, b, c, t, h, oc, true, k8, TYPE == 1 ? wk : nullptr);
            const float ks = TYPE == 1 ? 0.08838834764831845f : 0.125f;
            u32x4 oq, ok;
            oq.x = cvt_pk(q8[0], q8[1]); oq.y = cvt_pk(q8[2], q8[3]); oq.z = cvt_pk(q8[4], q8[5]); oq.w = cvt_pk(q8[6], q8[7]);
            ok.x = cvt_pk(k8[0] * ks, k8[1] * ks); ok.y = cvt_pk(k8[2] * ks, k8[3] * ks); ok.z = cvt_pk(k8[4] * ks, k8[5] * ks); ok.w = cvt_pk(k8[6] * ks, k8[7] * ks);
            *(u32x4*)(qr + (size_t)t * QP + oc * 8) = oq;
            *(u32x4*)(kr + (size_t)t * QP + oc * 8) = ok;
        }
        const bf16_t* spf = U + (size_t)(chf * NCH + nf) * 128 * DK; const bf16_t* spb = U + (size_t)((chf + 1) * NCH + nb) * 128 * DK;
        bf16x8 fsf[2][NKK], fsb[2][NKK];
#pragma unroll
        for (int i = 0; i < 2; ++i)
#pragma unroll
            for (int kk = 0; kk < NKK; ++kk) {
                fsf[i][kk] = *(const bf16x8*)(spf + (size_t)((2 * wid + i) * 16 + lr) * DK + kk * 32 + lq * 8);
                fsb[i][kk] = *(const bf16x8*)(spb + (size_t)((2 * wid + i) * 16 + lr) * DK + kk * 32 + lq * 8);
            }
        u32x2 gu[4][2];
#pragma unroll
        for (int mt = 0; mt < 4; ++mt)
#pragma unroll
            for (int i = 0; i < 2; ++i) gu[mt][i] = *(const u32x2*)(pb + (size_t)(r0 + mt * 16 + lr) * M::PITCH + M::GOFF + h * 128 + (2 * wid + i) * 16 + lq * 4);
        __syncthreads();
        f32x4 sacc[4];
#pragma unroll
        for (int nt = 0; nt < 4; ++nt) sacc[nt] = (f32x4){0.f, 0.f, 0.f, 0.f};
#pragma unroll
        for (int kk = 0; kk < NKK; ++kk) {
            const bf16x8 fq = *(const bf16x8*)(qr + (size_t)trow * QP + kk * 32 + lq * 8);
#pragma unroll
            for (int nt = 0; nt < 4; ++nt) {
                const bf16x8 fk = *(const bf16x8*)(kr + (size_t)(nt * 16 + lr) * QP + kk * 32 + lq * 8);
                sacc[nt] = __builtin_amdgcn_mfma_f32_16x16x32_bf16(fk, fq, sacc[nt], 0, 0, 0);
            }
        }
        {
            const float cft = sc[trow], cbt = sc[64 + trow];
            const float eft = __expf(cft), ebt = __expf(cbt);
            float af[4][4], ab[4][4]; float denf = 0.f, denb = 0.f;
#pragma unroll
            for (int nt = 0; nt < 4; ++nt) {
                const float av[4] = {sacc[nt].x, sacc[nt].y, sacc[nt].z, sacc[nt].w};
#pragma unroll
                for (int r = 0; r < 4; ++r) {
                    const int s_ = nt * 16 + lq * 4 + r;
                    const float argf = cft - sc[s_] + (TYPE == 1 ? sc[128 + s_] : 0.f), argb = cbt - sc[64 + s_] + (TYPE == 1 ? sc[192 + s_] : 0.f);
                    const float wf = s_ <= trow ? __expf(argf) : 0.f, wb = s_ >= trow ? __expf(argb) : 0.f;
                    af[nt][r] = av[r] * wf; ab[nt][r] = av[r] * wb; denf += af[nt][r]; denb += ab[nt][r];
                }
            }
            float scf = 1.f, scb = 1.f;
            if (TYPE == 1) {
                float qf = 0.f, qb = 0.f;
#pragma unroll
                for (int q = 0; q < 4; ++q) {
                    const u32x4 u = *(const u32x4*)(qr + (size_t)trow * QP + lq * 32 + q * 8); float f[8]; UNPACK8(u, f);
                    const float* a = sn + lq * 32 + q * 8; const float* bq = sn + 128 + lq * 32 + q * 8;
                    const f32x4 a0 = *(const f32x4*)a, a1 = *(const f32x4*)(a + 4), b0 = *(const f32x4*)bq, b1 = *(const f32x4*)(bq + 4);
                    qf += f[0] * a0.x + f[1] * a0.y + f[2] * a0.z + f[3] * a0.w + f[4] * a1.x + f[5] * a1.y + f[6] * a1.z + f[7] * a1.w;
                    qb += f[0] * b0.x + f[1] * b0.y + f[2] * b0.z + f[3] * b0.w + f[4] * b1.x + f[5] * b1.y + f[6] * b1.z + f[7] * b1.w;
                }
                denf += eft * qf; denb += ebt * qb;
                denf += __shfl_xor(denf, 16); denf += __shfl_xor(denf, 32);
                denb += __shfl_xor(denb, 16); denb += __shfl_xor(denb, 32);
                scf = 1.f / fmaxf(fabsf(denf), 1.f); scb = 1.f / fmaxf(fabsf(denb), 1.f);
            }
#pragma unroll
            for (int nt = 0; nt < 4; ++nt) {
                u32x2 o; o.x = cvt_pk(af[nt][0] * scf + ab[nt][0] * scb, af[nt][1] * scf + ab[nt][1] * scb); o.y = cvt_pk(af[nt][2] * scf + ab[nt][2] * scb, af[nt][3] * scf + ab[nt][3] * scb);
                *(u32x2*)(att + (size_t)trow * 80 + nt * 16 + lq * 4) = o;
            }
            if (lq == 0) { rsv[trow] = eft * scf; rsv[64 + trow] = ebt * scb; }
        }
        __syncthreads();
        f32x4 oacc[4][2];
#pragma unroll
        for (int mt = 0; mt < 4; ++mt)
#pragma unroll
            for (int i = 0; i < 2; ++i) oacc[mt][i] = (f32x4){0.f, 0.f, 0.f, 0.f};
#pragma unroll
        for (int kk = 0; kk < 2; ++kk) {
            bf16x8 fv[2];
#pragma unroll
            for (int i = 0; i < 2; ++i) fv[i] = *(const bf16x8*)(vT + (size_t)((2 * wid + i) * 16 + lr) * 80 + kk * 32 + lq * 8);
#pragma unroll
            for (int mt = 0; mt < 4; ++mt) {
                const bf16x8 fa = *(const bf16x8*)(att + (size_t)(mt * 16 + lr) * 80 + kk * 32 + lq * 8);
#pragma unroll
                for (int i = 0; i < 2; ++i) oacc[mt][i] = __builtin_amdgcn_mfma_f32_16x16x32_bf16(fv[i], fa, oacc[mt][i], 0, 0, 0);
            }
        }
#pragma unroll
        for (int dir = 0; dir < 2; ++dir) {
            f32x4 tmp[4][2];
#pragma unroll
            for (int mt = 0; mt < 4; ++mt)
#pragma unroll
                for (int i = 0; i < 2; ++i) tmp[mt][i] = (f32x4){0.f, 0.f, 0.f, 0.f};
#pragma unroll
            for (int kk = 0; kk < NKK; ++kk)
#pragma unroll
                for (int mt = 0; mt < 4; ++mt) {
                    const bf16x8 fq = *(const bf16x8*)(qr + (size_t)(mt * 16 + lr) * QP + kk * 32 + lq * 8);
#pragma unroll
                    for (int i = 0; i < 2; ++i) tmp[mt][i] = __builtin_amdgcn_mfma_f32_16x16x32_bf16(dir == 0 ? fsf[i][kk] : fsb[i][kk], fq, tmp[mt][i], 0, 0, 0);
                }
#pragma unroll
            for (int mt = 0; mt < 4; ++mt) {
                const float rs = rsv[dir * 64 + mt * 16 + lr];
#pragma unroll
                for (int i = 0; i < 2; ++i) oacc[mt][i] += tmp[mt][i] * rs;
            }
        }
#pragma unroll
        for (int mt = 0; mt < 4; ++mt) {
            float s1 = (oacc[mt][0].x + oacc[mt][0].y) + (oacc[mt][0].z + oacc[mt][0].w) + (oacc[mt][1].x + oacc[mt][1].y) + (oacc[mt][1].z + oacc[mt][1].w);
            float s2 = (oacc[mt][0].x * oacc[mt][0].x + oacc[mt][0].y * oacc[mt][0].y) + (oacc[mt][0].z * oacc[mt][0].z + oacc[mt][0].w * oacc[mt][0].w)
                     + (oacc[mt][1].x * oacc[mt][1].x + oacc[mt][1].y * oacc[mt][1].y) + (oacc[mt][1].z * oacc[mt][1].z + oacc[mt][1].w * oacc[mt][1].w);
            s1 += __shfl_xor(s1, 16); s1 += __shfl_xor(s1, 32); s2 += __shfl_xor(s2, 16); s2 += __shfl_xor(s2, 32);
            if (lq == 0) { part[(wid * 64 + mt * 16 + lr) * 2] = s1; part[(wid * 64 + mt * 16 + lr) * 2 + 1] = s2; }
        }
        __syncthreads();
#pragma unroll
        for (int mt = 0; mt < 4; ++mt) {
            const int t = mt * 16 + lr;
            float s1 = 0.f, s2 = 0.f;
#pragma unroll
            for (int w = 0; w < 4; ++w) { s1 += part[(w * 64 + t) * 2]; s2 += part[(w * 64 + t) * 2 + 1]; }
            const float mean = s1 * (1.f / 128.f);
            const float rstd = rsqrtf(fmaxf(s2 * (1.f / 128.f) - mean * mean, 0.f) + 1e-6f);
            const size_t rowi = (size_t)(r0 + t);
#pragma unroll
            for (int i = 0; i < 2; ++i) {
                const int e = (2 * wid + i) * 16 + lq * 4;
                const f32x4 gg = *(const f32x4*)(ng + h * 128 + e);
                const float g0 = bflo(gu[mt][i].x), g1 = bfhi(gu[mt][i].x), g2 = bflo(gu[mt][i].y), g3 = bfhi(gu[mt][i].y);
                u32x2 o;
                o.x = cvt_pk((oacc[mt][i].x - mean) * rstd * gg.x * siluf(g0), (oacc[mt][i].y - mean) * rstd * gg.y * siluf(g1));
                o.y = cvt_pk((oacc[mt][i].z - mean) * rstd * gg.z * siluf(g2), (oacc[mt][i].w - mean) * rstd * gg.w * siluf(g3));
                *(u32x2*)(brp + rowi * 1536 + pass * 512 + h * 128 + e) = o;
            }
        }
        __syncthreads();
    }
}

__device__ __forceinline__ void out_phase_g(const Params& P, int l, bool latent_only, char* lds) {
    typedef MX<0> M; constexpr int DK = 64, QP = 80;
    const bf16_t* pb = (const bf16_t*)(ws_l(P) + WS_PBUF);
    const bf16_t* U = (const bf16_t*)(ws_l(P) + WS_SBUF);
    const float* small = (const float*)(ws_l(P) + WS_SMALL);
    bf16_t* brp = (bf16_t*)(ws_l(P) + WS_BR);
    bf16_t* vT = (bf16_t*)(lds + L_VT); bf16_t* qin = (bf16_t*)(lds + L_Q); bf16_t* kin = qin + 64 * QP; bf16_t* att = (bf16_t*)(lds + L_ATT);
    float* cum = (float*)(lds + L_CUM); float* part = cum;
    const float* ng = P.in[I_GNG] + l * 512;
    const int NC = latent_only ? NCH - 4 : NCH; const int NU = NB * 4 * NC, VG = vgrid(), slot = bid_l();
    for (int u0 = 0; u0 < NU; u0 += VG) {
        int unit = u0 + slot; if (unit >= NU) unit = NU - 1;
        const int tid = tid_l(), lane = tid & 63, wid = tid >> 6, lr = lane & 15, lq = lane >> 4;
        const int c = unit % NC + (latent_only ? 4 : 0); const int rest = unit / NC; const int h = rest & 3, b = rest >> 2;
        const int r0 = rowbase(b, c);
        const int trow = wid * 16 + lr;
        const int chf = (b * 4 + h) * 2, nf = scan_index(0, c), nb = scan_index(1, c);
        float qraw[2][8], kraw[2][8], apre[2][4];
#pragma unroll
        for (int i = 0; i < 2; ++i) {
            const int pid = tid + i * NTHR, t = pid >> 3, oc = pid & 7;
            load_qk8<0>(P, l, pb, b, c, t, h, oc, false, qraw[i]);
            load_qk8<0>(P, l, pb, b, c, t, h, oc, true, kraw[i]);
        }
#pragma unroll
        for (int dir = 0; dir < 2; ++dir)
#pragma unroll
            for (int k = 0; k < 4; ++k) { const int i = tid + k * NTHR; apre[dir][k] = small[(size_t)(r0 + (i >> 4)) * 48 + dir * 16 + (i & 15)]; }
        build_vT<0>(pb, b, c, h, lds);
        const bf16_t* spf = U + (size_t)(chf * NCH + nf) * 128 * DK; const bf16_t* spb = U + (size_t)((chf + 1) * NCH + nb) * 128 * DK;
        bf16x8 fsf[2][2], fsb[2][2];
#pragma unroll
        for (int i = 0; i < 2; ++i)
#pragma unroll
            for (int kk = 0; kk < 2; ++kk) {
                fsf[i][kk] = *(const bf16x8*)(spf + (size_t)((2 * wid + i) * 16 + lr) * DK + kk * 32 + lq * 8);
                fsb[i][kk] = *(const bf16x8*)(spb + (size_t)((2 * wid + i) * 16 + lr) * DK + kk * 32 + lq * 8);
            }
        u32x2 gu[4][2];
#pragma unroll
        for (int mt = 0; mt < 4; ++mt)
#pragma unroll
            for (int i = 0; i < 2; ++i) gu[mt][i] = *(const u32x2*)(pb + (size_t)(r0 + mt * 16 + lr) * M::PITCH + M::GOFF + h * 128 + (2 * wid + i) * 16 + lq * 4);
        f32x4 oacc[4][2];
#pragma unroll
        for (int mt = 0; mt < 4; ++mt)
#pragma unroll
            for (int i = 0; i < 2; ++i) oacc[mt][i] = (f32x4){0.f, 0.f, 0.f, 0.f};
#pragma unroll
        for (int dir = 0; dir < 2; ++dir) {
            decay_setup<0>(P, l, b, c, h, dir, lds, apre[dir]);
#pragma unroll
            for (int i = 0; i < 2; ++i) {
                const int pid = tid + i * NTHR, t = pid >> 3, oc = pid & 7;
                float q8[8], k8[8];
#pragma unroll
                for (int j = 0; j < 8; ++j) { const float cv = cum[t * 64 + oc * 8 + j]; q8[j] = qraw[i][j] * (__expf(cv) * 0.125f); k8[j] = kraw[i][j] * __expf(-cv); }
                u32x4 oq, ok;
                oq.x = cvt_pk(q8[0], q8[1]); oq.y = cvt_pk(q8[2], q8[3]); oq.z = cvt_pk(q8[4], q8[5]); oq.w = cvt_pk(q8[6], q8[7]);
                ok.x = cvt_pk(k8[0], k8[1]); ok.y = cvt_pk(k8[2], k8[3]); ok.z = cvt_pk(k8[4], k8[5]); ok.w = cvt_pk(k8[6], k8[7]);
                *(u32x4*)(qin + (size_t)t * QP + oc * 8) = oq;
                *(u32x4*)(kin + (size_t)t * QP + oc * 8) = ok;
            }
            __syncthreads();
            f32x4 sacc[4];
#pragma unroll
            for (int nt = 0; nt < 4; ++nt) sacc[nt] = (f32x4){0.f, 0.f, 0.f, 0.f};
#pragma unroll
            for (int kk = 0; kk < 2; ++kk) {
                const bf16x8 fq = *(const bf16x8*)(qin + (size_t)trow * QP + kk * 32 + lq * 8);
#pragma unroll
                for (int nt = 0; nt < 4; ++nt) {
                    const bf16x8 fk = *(const bf16x8*)(kin + (size_t)(nt * 16 + lr) * QP + kk * 32 + lq * 8);
                    sacc[nt] = __builtin_amdgcn_mfma_f32_16x16x32_bf16(fk, fq, sacc[nt], 0, 0, 0);
                }
            }
#pragma unroll
            for (int nt = 0; nt < 4; ++nt) {
                const int s0 = nt * 16 + lq * 4;
                float a0 = sacc[nt].x, a1 = sacc[nt].y, a2 = sacc[nt].z, a3 = sacc[nt].w;
                if (dir == 0) { if (s0 + 0 > trow) a0 = 0.f; if (s0 + 1 > trow) a1 = 0.f; if (s0 + 2 > trow) a2 = 0.f; if (s0 + 3 > trow) a3 = 0.f; }
                else { if (s0 + 0 < trow) a0 = 0.f; if (s0 + 1 < trow) a1 = 0.f; if (s0 + 2 < trow) a2 = 0.f; if (s0 + 3 < trow) a3 = 0.f; }
                u32x2 o; o.x = cvt_pk(a0, a1); o.y = cvt_pk(a2, a3);
                *(u32x2*)(att + (size_t)trow * 80 + s0) = o;
            }
            __syncthreads();
#pragma unroll
            for (int kk = 0; kk < 2; ++kk) {
                bf16x8 fv[2];
#pragma unroll
                for (int i = 0; i < 2; ++i) fv[i] = *(const bf16x8*)(vT + (size_t)((2 * wid + i) * 16 + lr) * 80 + kk * 32 + lq * 8);
#pragma unroll
                for (int mt = 0; mt < 4; ++mt) {
                    const bf16x8 fa = *(const bf16x8*)(att + (size_t)(mt * 16 + lr) * 80 + kk * 32 + lq * 8);
                    const bf16x8 fq = *(const bf16x8*)(qin + (size_t)(mt * 16 + lr) * QP + kk * 32 + lq * 8);
#pragma unroll
                    for (int i = 0; i < 2; ++i) {
                        oacc[mt][i] = __builtin_amdgcn_mfma_f32_16x16x32_bf16(fv[i], fa, oacc[mt][i], 0, 0, 0);
                        oacc[mt][i] = __builtin_amdgcn_mfma_f32_16x16x32_bf16(dir == 0 ? fsf[i][kk] : fsb[i][kk], fq, oacc[mt][i], 0, 0, 0);
                    }
                }
            }
            __syncthreads();
        }
#pragma unroll
        for (int mt = 0; mt < 4; ++mt) {
            float s2 = (oacc[mt][0].x * oacc[mt][0].x + oacc[mt][0].y * oacc[mt][0].y) + (oacc[mt][0].z * oacc[mt][0].z + oacc[mt][0].w * oacc[mt][0].w)
                     + (oacc[mt][1].x * oacc[mt][1].x + oacc[mt][1].y * oacc[mt][1].y) + (oacc[mt][1].z * oacc[mt][1].z + oacc[mt][1].w * oacc[mt][1].w);
            s2 += __shfl_xor(s2, 16); s2 += __shfl_xor(s2, 32);
            if (lq == 0) part[wid * 64 + mt * 16 + lr] = s2;
        }
        __syncthreads();
#pragma unroll
        for (int mt = 0; mt < 4; ++mt) {
            const int t = mt * 16 + lr;
            const float s2 = (part[t] + part[64 + t]) + (part[128 + t] + part[192 + t]);
            const float rstd = rsqrtf(s2 * (1.f / 128.f) + 1e-6f);
            const size_t rowi = (size_t)(r0 + t);
#pragma unroll
            for (int i = 0; i < 2; ++i) {
                const int e = (2 * wid + i) * 16 + lq * 4;
                const f32x4 gg = *(const f32x4*)(ng + h * 128 + e);
                const float g0 = bflo(gu[mt][i].x), g1 = bfhi(gu[mt][i].x), g2 = bflo(gu[mt][i].y), g3 = bfhi(gu[mt][i].y);
                u32x2 o;
                o.x = cvt_pk(oacc[mt][i].x * rstd * gg.x * siluf(g0), oacc[mt][i].y * rstd * gg.y * siluf(g1));
                o.y = cvt_pk(oacc[mt][i].z * rstd * gg.z * siluf(g2), oacc[mt][i].w * rstd * gg.w * siluf(g3));
                *(u32x2*)(brp + rowi * 1536 + h * 128 + e) = o;
            }
        }
        __syncthreads();
    }
}

template <int NI, class F>
__device__ __forceinline__ void ctx_gemm(const bf16_t* A, int lda, const bf16_t* Bt, int ldb, int K, int N, const F& f, char* lds) {
    const int tid = tid_l(), lane = tid & 63, wid = tid >> 6, wm = wid >> 1, wn = wid & 1, lr = lane & 15, lq = lane >> 4;
    const int Nt = (N + 32 * NI - 1) / (32 * NI);
    const int total = 4 * Nt, VG = vgrid(), slot = bid_l();
    for (int t0 = 0; t0 < total; t0 += VG) {
        const int t = t0 + (VG - 1 - slot); if (t >= total) continue;
        const int tm = t & 3, tn = t >> 2;
        f32x4 acc[4][NI];
#pragma unroll
        for (int mi = 0; mi < 4; ++mi)
#pragma unroll
            for (int ni = 0; ni < NI; ++ni) acc[mi][ni] = (f32x4){0.f, 0.f, 0.f, 0.f};
        gemm_kloop<NI>(acc, A + (size_t)(RL + tm * 128) * lda, lda, Bt + (size_t)tn * (32 * NI) * ldb, ldb, K, lds);
#pragma unroll
        for (int mi = 0; mi < 4; ++mi)
#pragma unroll
            for (int ni = 0; ni < NI; ++ni) f(RL + tm * 128 + wm * 64 + mi * 16 + lr, tn * (32 * NI) + wn * (16 * NI) + ni * 16 + lq * 4, acc[mi][ni], 0);
    }
}
__device__ __forceinline__ void ctx_merge(const Params& P, char* lds) {
    const int tid = tid_l(), lane = tid & 63, wid = tid >> 6, wm = wid >> 1, wn = wid & 1, lr = lane & 15, lq = lane >> 4;
    const bf16_t* br = (const bf16_t*)(ws_l(P) + WS_BR); const bf16_t* wb = (const bf16_t*)(ws_l(P) + WS_WTBR);
    const bf16_t* gs = (const bf16_t*)(ws_l(P) + WS_GS); bf16_t* mb = (bf16_t*)(ws_l(P) + WS_MB);
    const int total = 64, VG = vgrid(), slot = bid_l();
    for (int t0 = 0; t0 < total; t0 += VG) {
        const int t = t0 + (VG - 1 - slot); if (t >= total) continue;
        const int tm = t & 3, tn = t >> 2;
        f32x4 m[4][2];
#pragma unroll
        for (int mi = 0; mi < 4; ++mi)
#pragma unroll
            for (int ni = 0; ni < 2; ++ni) m[mi][ni] = (f32x4){0.f, 0.f, 0.f, 0.f};
#pragma unroll 1
        for (int j = 0; j < 3; ++j) {
            f32x4 acc[4][2];
#pragma unroll
            for (int mi = 0; mi < 4; ++mi)
#pragma unroll
                for (int ni = 0; ni < 2; ++ni) acc[mi][ni] = (f32x4){0.f, 0.f, 0.f, 0.f};
            gemm_kloop<2>(acc, br + (size_t)(RL + tm * 128) * 1536 + j * 512, 1536, wb + ((size_t)j * 1024 + tn * 64) * 512, 512, 512, lds);
#pragma unroll
            for (int mi = 0; mi < 4; ++mi)
#pragma unroll
                for (int ni = 0; ni < 2; ++ni) {
                    const int r = RL + tm * 128 + wm * 64 + mi * 16 + lr, c = tn * 64 + wn * 32 + ni * 16 + lq * 4;
                    const u32x2 g = *(const u32x2*)(gs + (size_t)r * 3072 + j * 1024 + c);
                    m[mi][ni].x += acc[mi][ni].x * bflo(g.x); m[mi][ni].y += acc[mi][ni].y * bfhi(g.x);
                    m[mi][ni].z += acc[mi][ni].z * bflo(g.y); m[mi][ni].w += acc[mi][ni].w * bfhi(g.y);
                }
        }
#pragma unroll
        for (int mi = 0; mi < 4; ++mi)
#pragma unroll
            for (int ni = 0; ni < 2; ++ni) {
                const int r = RL + tm * 128 + wm * 64 + mi * 16 + lr, c = tn * 64 + wn * 32 + ni * 16 + lq * 4;
                u32x2 o; o.x = cvt_pk(m[mi][ni].x, m[mi][ni].y); o.y = cvt_pk(m[mi][ni].z, m[mi][ni].w);
                *(u32x2*)(mb + (size_t)r * 1024 + c) = o;
            }
    }
}


#define XB_TMO      128
#define XB_XCNT(j)  (256  + 64 * (j))
#define XB_XSUB(j)  (1280 + 64 * (j))
#define XB_XGEN(j)  (2304 + 64 * (j))
#define XB_TOP      3328
#define XB_TOPGEN   3392
#define XCD_BAR_WORDS 3456
#define XB_SPIN_CAP (1u << 18)
__device__ __forceinline__ unsigned xb_ld(unsigned* p)              { return __hip_atomic_load(p, __ATOMIC_RELAXED, __HIP_MEMORY_SCOPE_AGENT); }
__device__ __forceinline__ unsigned xb_add(unsigned* p, unsigned v) { return __hip_atomic_fetch_add(p, v, __ATOMIC_RELAXED, __HIP_MEMORY_SCOPE_AGENT); }
__device__ __forceinline__ unsigned xb_xcc_id() { return (unsigned)__builtin_amdgcn_s_getreg((3 << 11) | 20) & 0xFu; }
#define XB_SPIN(cond, bar) do { unsigned _sp = 0; while (cond) { __builtin_amdgcn_s_sleep(1); \
    if ((++_sp & 255u) == 0u) { if (xb_ld(&(bar)[XB_TMO])) break; if (_sp > XB_SPIN_CAP) { atomicAdd(&(bar)[XB_TMO], 1u); break; } } } } while (0)
struct XcdBarrier { unsigned* bar; unsigned x; volatile LAS unsigned* st; };
__device__ __forceinline__ XcdBarrier xcd_barrier_post(unsigned* bar, volatile LAS unsigned* st) {
    XcdBarrier b; b.bar = bar; b.x = xb_xcc_id(); b.st = st;
    if (threadIdx.x == 0) (void)xb_add(&bar[XB_XCNT(b.x)], 1u);
    return b;
}
__device__ __forceinline__ void xcd_barrier_complete(unsigned* bar, unsigned x, unsigned& nloc, unsigned& nx) {
    const unsigned G = gridDim.x * gridDim.y * gridDim.z;
    unsigned sum, cnt, mine, sp = 0u;
    for (;;) {
        sum = 0u; cnt = 0u; mine = 0u;
#pragma unroll
        for (unsigned j = 0; j < 16; ++j) { const unsigned c = xb_ld(&bar[XB_XCNT(j)]); sum += c; cnt += (c > 0u) ? 1u : 0u; mine = (j == x) ? c : mine; }
        if (sum == G) break;
        __builtin_amdgcn_s_sleep(1);
        if ((++sp & 255u) == 0u) { if (xb_ld(&bar[XB_TMO])) break; if (sp > XB_SPIN_CAP) { atomicAdd(&bar[XB_TMO], 1u); break; } }
    }
    nloc = mine > 0u ? mine : 1u; nx = cnt > 0u ? cnt : 1u;
}
__device__ __forceinline__ void xcd_barrier(const XcdBarrier& b) {
    asm volatile("s_waitcnt vmcnt(0)" ::: "memory");
    __syncthreads();
    if (threadIdx.x == 0) {
        unsigned* bar = b.bar;
        __builtin_amdgcn_s_waitcnt(0);
        unsigned nloc = b.st[0], nx = b.st[1];
        if (nloc == 0u) { xcd_barrier_complete(bar, b.x, nloc, nx); b.st[0] = nloc; b.st[1] = nx; }
        const unsigned old = xb_add(&bar[XB_XSUB(b.x)], 1u);
        const unsigned gen = old / nloc;
        if (old + 1u == (gen + 1u) * nloc) {
            __builtin_amdgcn_fence(__ATOMIC_RELEASE, "agent");
            asm volatile("s_waitcnt vmcnt(0)" ::: "memory");
            const unsigned og = xb_add(&bar[XB_TOP], 1u);
            const unsigned tg = og / nx;
            if (og + 1u == (tg + 1u) * nx) xb_add(&bar[XB_TOPGEN], 1u);
            else XB_SPIN(xb_ld(&bar[XB_TOPGEN]) == tg, bar);
            __builtin_amdgcn_fence(__ATOMIC_ACQUIRE, "agent");
            xb_add(&bar[XB_XGEN(b.x)], 1u);
            asm volatile("s_waitcnt vmcnt(0)" ::: "memory");
        } else {
            XB_SPIN(xb_ld(&bar[XB_XGEN(b.x)]) == gen, bar);
            __builtin_amdgcn_fence(__ATOMIC_ACQUIRE, "agent");
            asm volatile("s_waitcnt vmcnt(0)" ::: "memory");
        }
    }
    __syncthreads();
}

__global__ void __launch_bounds__(512, 2) fwd_kernel(Params P) {
    extern __shared__ __attribute__((aligned(16))) unsigned char lds_raw[];
    cg::grid_group grid = cg::this_grid();
    LAS unsigned char* ldsb = (LAS unsigned char*)lds_raw;
#define LDSH ((char*)lds_raw + __builtin_amdgcn_readfirstlane(threadIdx.x >> 8) * HALF_LDS)
    volatile LAS unsigned* bst = (volatile LAS unsigned*)(ldsb + 2 * HALF_LDS);
    if (threadIdx.x < 2) bst[threadIdx.x] = 0u;
    __syncthreads();
    XcdBarrier xbar = xcd_barrier_post((unsigned*)(P.ws + WS_BAR), bst);
    int ph = 0;
#define PHASE_BEGIN if (ph >= P.lo && ph < P.hi) {
#define PHASE_END } ++ph; if (P.coop && ph > P.lo && ph < P.hi) { if (ph == 1) grid.sync(); else xcd_barrier(xbar); }

    PHASE_BEGIN
        {
        { const int VG = vgrid(), slot = bid_l();
          for (int i0 = 0; i0 < 384; i0 += VG) { int it = i0 + slot; if (it >= 384) it = 383; mods_task(P, it, LDSH); } }
        if (bid_l() == vgrid() - 1) rope_task(P);
        convert_all(P, 0, LDSH);
        }
    PHASE_END

    const XPtr Xin{(float*)P.in[I_X], (float*)P.in[I_CTX]};
    const XPtr Xcur{P.out, (float*)(P.ws + WS_CTXX)};

    for (int l = 0; l < 2; ++l) {
        const XPtr Xold = l == 0 ? Xin : Xcur;
        const bool ctx_on = (l == 0);
        PHASE_BEGIN
            {
            if (l == 1) convert_all(P, 1, LDSH);
            norm_phase(P, Xold, P.in[I_N1G] + l * D, l, 0, R);
            }
        PHASE_END
        PHASE_BEGIN
            const bf16_t* hb = (const bf16_t*)(ws_l(P) + WS_HBUF); const bf16_t* wt = (const bf16_t*)(ws_l(P) + WS_WTIN);
            EpiP e{(bf16_t*)(ws_l(P) + WS_PBUF), 1536, 1536, (float*)(ws_l(P) + WS_SMALL)};
            {
            big_gemm(ldsb, hb, 1024, wt, 1024, 1792, e);
            ctx_gemm<4>(hb, 1024, wt, 1024, 1024, 1664, e, LDSH); }
        PHASE_END
        PHASE_BEGIN u_phase<0>(P, l, LDSH); PHASE_END
        PHASE_BEGIN scan_phase<64, false>(P); PHASE_END
        PHASE_BEGIN out_phase_g(P, l, !ctx_on, LDSH); PHASE_END
        PHASE_BEGIN
            const bf16_t* hb = (const bf16_t*)(ws_l(P) + WS_HBUF); const bf16_t* wt = (const bf16_t*)(ws_l(P) + WS_WTIN) + (size_t)1792 * 1024;
            EpiP e{(bf16_t*)(ws_l(P) + WS_PBUF), 2048, 2048, nullptr};
            {
            big_gemm(ldsb, hb, 1024, wt, 1024, 2048, e);
            ctx_gemm<2>(hb, 1024, wt, 1024, 1024, 2048, e, LDSH); }
        PHASE_END
        PHASE_BEGIN u_phase_s<1>(P, l, LDSH); PHASE_END
        PHASE_BEGIN scan_phase<128, true>(P); PHASE_END
        PHASE_BEGIN out_phase_s<1>(P, l, 1, !ctx_on, LDSH); PHASE_END
        PHASE_BEGIN
            const bf16_t* hb = (const bf16_t*)(ws_l(P) + WS_HBUF); const bf16_t* wt = (const bf16_t*)(ws_l(P) + WS_WTIN) + (size_t)3840 * 1024;
            EpiP e{(bf16_t*)(ws_l(P) + WS_PBUF), 1536, 1536, nullptr};
            {
            big_gemm(ldsb, hb, 1024, wt, 1024, 1536, e);
            ctx_gemm<4>(hb, 1024, wt, 1024, 1024, 1536, e, LDSH); }
        PHASE_END
        PHASE_BEGIN u_phase_s<2>(P, l, LDSH); PHASE_END
        PHASE_BEGIN scan_phase<64, false>(P); PHASE_END
        PHASE_BEGIN out_phase_s<2>(P, l, 2, !ctx_on, LDSH); PHASE_END
        PHASE_BEGIN
            const bf16_t* hb = (const bf16_t*)(ws_l(P) + WS_HBUF); const bf16_t* wt = (const bf16_t*)(ws_l(P) + WS_WTIN) + (size_t)5376 * 1024;
            EpiSig e{(bf16_t*)(ws_l(P) + WS_GS)};
            {
            big_gemm(ldsb, hb, 1024, wt, 1024, 3072, e);
            if (ctx_on) ctx_gemm<2>(hb, 1024, wt, 1024, 1024, 3072, e, LDSH); }
        PHASE_END
        PHASE_BEGIN
            {   pg8::Gemm g{(const bf16_t*)(ws_l(P) + WS_BR), (const bf16_t*)(ws_l(P) + WS_WTBR), 1536, 512};
                pg8::MergeOrder S; S.S.init(RL, 1024, (int)gridDim.x, (int)blockIdx.x);
                pg8::Epi<EpiMerge> E{EpiMerge{(const bf16_t*)(ws_l(P) + WS_GS), (bf16_t*)(ws_l(P) + WS_MB)}};
                pg8::gemm_phase(ldsb, g, S, E);
                __syncthreads(); }
            if (ctx_on) ctx_merge(P, LDSH);
        PHASE_END
        PHASE_BEGIN
            const float* mods_l = (const float*)(ws_l(P) + WS_MODS) + (size_t)l * 3 * 6144;
            EpiRes e{Xold, Xcur, mods_l, 2};
            big_gemm(ldsb, (const bf16_t*)(ws_l(P) + WS_MB), 1024, (const bf16_t*)(ws_l(P) + WS_WTO), 1024, 1024, e);
            if (ctx_on) ctx_gemm<1>((const bf16_t*)(ws_l(P) + WS_MB), 1024, (const bf16_t*)(ws_l(P) + WS_WTO), 1024, 1024, 1024, e, LDSH);
        PHASE_END
        PHASE_BEGIN norm_phase(P, Xcur, P.in[I_N2G] + l * D, l, 3, ctx_on ? R : RL); PHASE_END
        PHASE_BEGIN
            const bf16_t* hb = (const bf16_t*)(ws_l(P) + WS_HBUF);
            EpiRelu2 e{(bf16_t*)(ws_l(P) + WS_HID)};
            {
            big_gemm(ldsb, hb, 1024, (const bf16_t*)(ws_l(P) + WS_WTUP), 1024, 4096, e);
            if (ctx_on) ctx_gemm<2>(hb, 1024, (const bf16_t*)(ws_l(P) + WS_WTUP), 1024, 1024, 4096, e, LDSH); }
        PHASE_END
        PHASE_BEGIN
            const float* mods_l = (const float*)(ws_l(P) + WS_MODS) + (size_t)l * 3 * 6144;
            EpiRes e{Xcur, Xcur, mods_l, 5};
            big_gemm(ldsb, (const bf16_t*)(ws_l(P) + WS_HID), 4096, (const bf16_t*)(ws_l(P) + WS_WTDN), 4096, 1024, e);
            if (ctx_on) ctx_gemm<1>((const bf16_t*)(ws_l(P) + WS_HID), 4096, (const bf16_t*)(ws_l(P) + WS_WTDN), 4096, 4096, 1024, e, LDSH);
        PHASE_END
    }
    PHASE_BEGIN final_norm_phase(P); PHASE_END
#undef PHASE_BEGIN
#undef PHASE_END
}
constexpr int NPHASES = 1 + 2 * 19 + 1;

extern "C" void kernel_launch(void* const* d_in, const int* in_sizes, int n_in, void* d_out, int out_size, void* d_ws, size_t ws_size, hipStream_t stream) {
    static int grid = 0;
    if (grid == 0) {
        if (n_in != 23 || ws_size < WS_END || out_size != NB * SEQ * D) { fprintf(stderr, "kernel_launch: unexpected sizes n_in %d ws %zu (need %zu) out %d\n", n_in, ws_size, (size_t)WS_END, out_size); grid = -1; return; }
        int dev = 0, cus = 0, per_cu = 0;
        if (hipGetDevice(&dev) != hipSuccess || hipDeviceGetAttribute(&cus, hipDeviceAttributeMultiprocessorCount, dev) != hipSuccess) { grid = -1; return; }
        if (hipFuncSetAttribute((const void*)fwd_kernel, hipFuncAttributeMaxDynamicSharedMemorySize, LDS_BYTES) != hipSuccess) { fprintf(stderr, "kernel_launch: hipFuncSetAttribute failed\n"); grid = -1; return; }
        if (hipOccupancyMaxActiveBlocksPerMultiprocessor(&per_cu, (const void*)fwd_kernel, 512, LDS_BYTES) != hipSuccess || per_cu < 1) { fprintf(stderr, "kernel_launch: occupancy query failed (%d)\n", per_cu); grid = -1; return; }
        grid = cus;
        grid -= grid % 8;
    }
    if (grid < 0) return;
    if (hipMemsetAsync((char*)d_ws + WS_BAR, 0, (size_t)3456 * 4, stream) != hipSuccess) { fprintf(stderr, "kernel_launch: memset failed\n"); return; }
    Params p{};
    for (int i = 0; i < 23; ++i) p.in[i] = (const float*)d_in[i];
    p.out = (float*)d_out; p.ws = (unsigned char*)d_ws;
    p.lo = 0; p.hi = NPHASES; p.coop = 1;
    void* args[] = {&p};
    hipError_t e = hipLaunchCooperativeKernel((const void*)fwd_kernel, dim3(grid), dim3(512), args, LDS_BYTES, stream);
    if (e != hipSuccess) fprintf(stderr, "kernel_launch: cooperative launch failed: %s (grid %d)\n", hipGetErrorString(e), grid);
}
```

```cpp
#include <hip/hip_runtime.h>
#include <hip/hip_cooperative_groups.h>
#include <stdint.h>
#include <stdio.h>
namespace cg = cooperative_groups;

#define LAS __attribute__((address_space(3)))
typedef unsigned short bf16_t;
typedef short bf16x8 __attribute__((ext_vector_type(8)));
typedef float f32x4 __attribute__((ext_vector_type(4)));
typedef unsigned u32x4 __attribute__((ext_vector_type(4)));
typedef unsigned u32x2 __attribute__((ext_vector_type(2)));

constexpr int D = 1024, NB = 2, SEQ = 8192, CTX = 256, RB = SEQ + CTX, R = NB * RB, RL = NB * SEQ, NCH = RB / 64, FF = 4096;
constexpr int INW = 8240;
constexpr int NTHR = 256;
constexpr int HALF_LDS = 73728;
constexpr int LDS_BYTES = 2 * HALF_LDS + 16;

constexpr size_t WS_WTIN = 0;
constexpr size_t WS_WTBR = WS_WTIN + (size_t)8448 * 1024 * 2;
constexpr size_t WS_WTO = WS_WTBR + (size_t)3 * 1024 * 512 * 2;
constexpr size_t WS_WTUP = WS_WTO + (size_t)1024 * 1024 * 2;
constexpr size_t WS_WTDN = WS_WTUP + (size_t)4096 * 1024 * 2;
constexpr size_t WS_HBUF = WS_WTDN + (size_t)4096 * 1024 * 2;
constexpr size_t WS_PBUF = WS_HBUF + (size_t)R * 1024 * 2;
constexpr size_t WS_SBUF = WS_PBUF + (size_t)R * 2048 * 2;
constexpr size_t WS_BR = WS_SBUF + (size_t)R * 2048 * 2;
constexpr size_t WS_CTXX = WS_BR + (size_t)R * 1536 * 2;
constexpr size_t WS_SMALL = WS_CTXX + (size_t)512 * 1024 * 4;
constexpr size_t WS_DEC = WS_SMALL + (size_t)R * 48 * 4;
constexpr size_t WS_UN = WS_DEC + (size_t)16 * NCH * 128 * 4;
constexpr size_t WS_MODS = WS_UN + (size_t)16 * NCH * 128 * 4;
constexpr size_t WS_ROPE = WS_MODS + (size_t)2 * 3 * 6144 * 4;
constexpr size_t WS_BAR = WS_ROPE + (size_t)(128 + 64) * 16 * 2 * 4;
constexpr size_t WS_END = WS_BAR + (size_t)3456 * 4;
constexpr size_t WS_GS = WS_PBUF;
constexpr size_t WS_MB = WS_PBUF + (size_t)R * 3072 * 2;
constexpr size_t WS_HID = WS_PBUF;

struct Params { const float* in[23]; float* out; unsigned char* ws; int lo, hi, coop, pad; };

__device__ __forceinline__ int tid_l() { int t = threadIdx.x & 255; asm volatile("" : "+v"(t)); return t; }
__device__ __forceinline__ int bid_l() { int t = blockIdx.x * 2 + (__builtin_amdgcn_readfirstlane(threadIdx.x >> 8)); asm volatile("" : "+s"(t)); return t; }
__device__ __forceinline__ int vgrid() { return gridDim.x * 2; }
typedef __attribute__((address_space(1))) unsigned char gas_u8;
__device__ __forceinline__ unsigned char* ws_l(const Params& P) { gas_u8* w = (gas_u8*)P.ws; asm volatile("" : "+s"(w)); return (unsigned char*)w; }
enum { I_X = 0, I_C, I_CTX, I_CCTX, I_N1G, I_N2G, I_WADA, I_BADA, I_WIN, I_A2, I_ABIAS, I_GNG, I_CONV, I_IB, I_FB, I_MNG, I_RDL, I_RNG, I_WBR, I_WO, I_WUP, I_WDN, I_FG };

typedef __bf16 bf16x2_t __attribute__((ext_vector_type(2)));
typedef float f32x2 __attribute__((ext_vector_type(2)));
__device__ __forceinline__ unsigned cvt_pk(float lo, float hi) { f32x2 v = {lo, hi}; bf16x2_t b = __builtin_convertvector(v, bf16x2_t); return __builtin_bit_cast(unsigned, b); }
__device__ __forceinline__ float bflo(unsigned u) { return __uint_as_float(u << 16); }
__device__ __forceinline__ float bfhi(unsigned u) { return __uint_as_float(u & 0xffff0000u); }
__device__ __forceinline__ float wave_sum(float v) {
#pragma unroll
    for (int o = 32; o > 0; o >>= 1) v += __shfl_xor(v, o);
    return v;
}
__device__ __forceinline__ float logsig(float x) { return fminf(x, 0.f) - log1pf(__expf(-fabsf(x))); }
__device__ __forceinline__ float logsig_fast(float x) { return fminf(x, 0.f) - __logf(1.f + __expf(-fabsf(x))); }
__device__ __forceinline__ float siluf(float x) { return x * __builtin_amdgcn_rcpf(1.f + __expf(-x)); }
__device__ __forceinline__ float sigmf(float x) { return __builtin_amdgcn_rcpf(1.f + __expf(-x)); }

struct XPtr { float* lat; float* ctx; };
__device__ __forceinline__ float* xrow(const XPtr& X, int r) { return r < RL ? X.lat + (size_t)r * D : X.ctx + (size_t)(r - RL) * D; }
__device__ __forceinline__ int modidx(int r) { return r < SEQ ? 0 : (r < RL ? 1 : 2); }
__device__ __forceinline__ int rowbase(int b, int c) { return c < 4 ? RL + b * CTX + c * 64 : b * SEQ + (c - 4) * 64; }

#define UNPACK8(u, f) do { f[0] = bflo(u.x); f[1] = bfhi(u.x); f[2] = bflo(u.y); f[3] = bfhi(u.y); f[4] = bflo(u.z); f[5] = bfhi(u.z); f[6] = bflo(u.w); f[7] = bfhi(u.w); } while (0)

__device__ __forceinline__ void mods_task(const Params& P, int task, char* lds) {
    float* s = (float*)lds;
    float* red = (float*)(lds + 12288);
    const int tid = tid_l();
    const int l = task / 192, col0 = (task % 192) * 32;
    const float* c = P.in[I_C]; const float* cc = P.in[I_CCTX];
    for (int i = tid; i < 3072; i += NTHR) { const int v = i >> 10, k = i & 1023; const float cv = v < 2 ? c[v * 1024 + k] : cc[k]; s[i] = siluf(cv); }
    __syncthreads();
    const int col = tid & 31, kg = tid >> 5;
    const float* w = P.in[I_WADA] + (size_t)l * D * 6144 + col0 + col;
    float a0 = 0.f, a1 = 0.f, a2 = 0.f;
#pragma unroll 32
    for (int k = kg * 128; k < kg * 128 + 128; ++k) { const float wv = w[(size_t)k * 6144]; a0 += s[k] * wv; a1 += s[1024 + k] * wv; a2 += s[2048 + k] * wv; }
    red[(kg * 32 + col) * 3 + 0] = a0; red[(kg * 32 + col) * 3 + 1] = a1; red[(kg * 32 + col) * 3 + 2] = a2;
    __syncthreads();
    if (tid < 96) {
        const int v = tid >> 5, c2 = tid & 31; float sum = 0.f;
#pragma unroll
        for (int g = 0; g < 8; ++g) sum += red[(g * 32 + c2) * 3 + v];
        sum += P.in[I_BADA][l * 6144 + col0 + c2];
        ((float*)(ws_l(P) + WS_MODS))[(l * 3 + v) * 6144 + col0 + c2] = sum;
    }
    __syncthreads();
}

__device__ __forceinline__ void rope_task(const Params& P) {
    float* tab = (float*)(ws_l(P) + WS_ROPE);
    for (int i = tid_l(); i < 192 * 16; i += NTHR) {
        const int pos = i >> 4, f = i & 15;
        const float inv = exp2f(-(float)f * (13.287712379549449f / 16.f));
        const float p = pos < 128 ? (float)pos : (float)(pos - 128);
        const float ang = p * inv;
        const float cs = cosf(ang), sn = sinf(ang);
        if (pos < 128) { tab[pos * 16 + f] = cs; tab[2048 + pos * 16 + f] = sn; }
        else { tab[4096 + (pos - 128) * 16 + f] = cs; tab[4096 + 1024 + (pos - 128) * 16 + f] = sn; }
    }
}

__device__ __forceinline__ void transpose_tile(const float* src, int ldsrc, int k0, int n0src, int nvalid, bf16_t* dst, int ldd, int drow0, char* lds) {
    float* tile = (float*)lds;
    const int tid = tid_l(), nl = tid & 63, kq = tid >> 6;
    float v[32];
#pragma unroll
    for (int i = 0; i < 32; ++i) v[i] = nl < nvalid ? src[(size_t)(k0 + kq + 4 * i) * ldsrc + n0src + nl] : 0.f;
#pragma unroll
    for (int i = 0; i < 32; ++i) tile[(kq + 4 * i) * 65 + nl] = v[i];
    __syncthreads();
    const int n = tid >> 2, ks = (tid & 3) * 32;
    if (n < nvalid) {
        u32x4* dp = (u32x4*)(dst + (size_t)(drow0 + n) * ldd + k0 + ks);
#pragma unroll
        for (int q = 0; q < 4; ++q) {
            u32x4 o;
            o.x = cvt_pk(tile[(ks + 8 * q + 0) * 65 + n], tile[(ks + 8 * q + 1) * 65 + n]); o.y = cvt_pk(tile[(ks + 8 * q + 2) * 65 + n], tile[(ks + 8 * q + 3) * 65 + n]);
            o.z = cvt_pk(tile[(ks + 8 * q + 4) * 65 + n], tile[(ks + 8 * q + 5) * 65 + n]); o.w = cvt_pk(tile[(ks + 8 * q + 6) * 65 + n], tile[(ks + 8 * q + 7) * 65 + n]);
            dp[q] = o;
        }
    }
    __syncthreads();
}

constexpr int CONV_TILES = 192 + 8 + 8 + 256 + 192 + 384 + 192 + 128 + 512 + 512;
__device__ __forceinline__ void convert_tile(const Params& P, int l, int it, char* lds) {
    const float* win = P.in[I_WIN] + (size_t)l * D * INW;
    bf16_t* wtin = (bf16_t*)(ws_l(P) + WS_WTIN);
    int r = it;
    if (r < 192) { const int kt = r / 24, nt = r % 24; transpose_tile(win, INW, kt * 128, nt * 64, 64, wtin, 1024, nt * 64, lds); return; } r -= 192;
    if (r < 8) { transpose_tile(win, INW, r * 128, 1536, 32, wtin, 1024, 1536, lds); return; } r -= 8;
    if (r < 8) { transpose_tile(win, INW, r * 128, 3616, 16, wtin, 1024, 1568, lds); return; } r -= 8;
    if (r < 256) { const int kt = r / 32, nt = r % 32; transpose_tile(win, INW, kt * 128, 1568 + nt * 64, 64, wtin, 1024, 1792 + nt * 64, lds); return; } r -= 256;
    if (r < 192) { const int kt = r / 24, nt = r % 24; transpose_tile(win, INW, kt * 128, 3632 + nt * 64, 64, wtin, 1024, 3840 + nt * 64, lds); return; } r -= 192;
    if (r < 384) { const int kt = r / 48, nt = r % 48; transpose_tile(win, INW, kt * 128, 5168 + nt * 64, 64, wtin, 1024, 5376 + nt * 64, lds); return; } r -= 384;
    if (r < 192) { const int j = r / 64, q = r % 64, kt = q / 16, nt = q % 16;
        transpose_tile(P.in[I_WBR] + ((size_t)l * 3 + j) * 512 * 1024, 1024, kt * 128, nt * 64, 64, (bf16_t*)(ws_l(P) + WS_WTBR), 512, j * 1024 + nt * 64, lds); return; } r -= 192;
    if (r < 128) { const int kt = r / 16, nt = r % 16; transpose_tile(P.in[I_WO] + (size_t)l * D * D, 1024, kt * 128, nt * 64, 64, (bf16_t*)(ws_l(P) + WS_WTO), 1024, nt * 64, lds); return; } r -= 128;
    if (r < 512) { const int kt = r / 64, nt = r % 64; transpose_tile(P.in[I_WUP] + (size_t)l * D * FF, 4096, kt * 128, nt * 64, 64, (bf16_t*)(ws_l(P) + WS_WTUP), 1024, nt * 64, lds); return; } r -= 512;
    { const int kt = r / 16, nt = r % 16; transpose_tile(P.in[I_WDN] + (size_t)l * FF * D, 1024, kt * 128, nt * 64, 64, (bf16_t*)(ws_l(P) + WS_WTDN), 4096, nt * 64, lds); }
}
__device__ __forceinline__ void convert_all(const Params& P, int l, char* lds) {
    const int VG = vgrid(), slot = bid_l();
    static_assert(CONV_TILES % 2 == 0, "both halves of a workgroup must be active together");
    for (int i0 = 0; i0 < CONV_TILES; i0 += VG) { const int it = i0 + slot; if (it >= CONV_TILES) continue; convert_tile(P, l, it, lds); }
}

__device__ __forceinline__ void norm_phase(const Params& P, XPtr X, const float* g, int l, int sidx, int nrows) {
    const int lane = tid_l() & 63; const int gw = bid_l() * 4 + (tid_l() >> 6), ngw = vgrid() * 4;
    bf16_t* hb = (bf16_t*)(ws_l(P) + WS_HBUF);
    const float* mods = (const float*)(ws_l(P) + WS_MODS) + (size_t)l * 3 * 6144;
    for (int r = gw; r < nrows; r += 2 * ngw) {
        const int r1 = r + ngw; const bool has1 = r1 < nrows; const int rr1 = has1 ? r1 : r;
        const f32x4* xa = (const f32x4*)xrow(X, r); const f32x4* xb = (const f32x4*)xrow(X, rr1);
        f32x4 va[4], vb[4]; float sa_ = 0.f, sb_ = 0.f;
#pragma unroll
        for (int j = 0; j < 4; ++j) { va[j] = xa[lane + 64 * j]; vb[j] = xb[lane + 64 * j]; }
#pragma unroll
        for (int j = 0; j < 4; ++j) { sa_ += va[j].x * va[j].x + va[j].y * va[j].y + va[j].z * va[j].z + va[j].w * va[j].w; sb_ += vb[j].x * vb[j].x + vb[j].y * vb[j].y + vb[j].z * vb[j].z + vb[j].w * vb[j].w; }
        sa_ = wave_sum(sa_); sb_ = wave_sum(sb_);
        const float rsa = rsqrtf(sa_ * (1.f / 1024.f) + 1e-6f), rsb = rsqrtf(sb_ * (1.f / 1024.f) + 1e-6f);
        const float* mda = mods + modidx(r) * 6144; const float* mdb = mods + modidx(rr1) * 6144;
#pragma unroll
        for (int j = 0; j < 4; ++j) {
            const int col = (lane + 64 * j) * 4;
            const f32x4 gg = *(const f32x4*)(g + col);
            { const f32x4 sh = *(const f32x4*)(mda + sidx * 1024 + col), sc = *(const f32x4*)(mda + (sidx + 1) * 1024 + col);
              const f32x4 hh = va[j] * rsa * gg * (sc + 1.f) + sh; u32x2 o; o.x = cvt_pk(hh.x, hh.y); o.y = cvt_pk(hh.z, hh.w); *(u32x2*)(hb + (size_t)r * 1024 + col) = o; }
            if (has1) { const f32x4 sh = *(const f32x4*)(mdb + sidx * 1024 + col), sc = *(const f32x4*)(mdb + (sidx + 1) * 1024 + col);
              const f32x4 hh = vb[j] * rsb * gg * (sc + 1.f) + sh; u32x2 o; o.x = cvt_pk(hh.x, hh.y); o.y = cvt_pk(hh.z, hh.w); *(u32x2*)(hb + (size_t)r1 * 1024 + col) = o; }
        }
    }
}
__device__ __forceinline__ void final_norm_phase(const Params& P) {
    const int lane = tid_l() & 63; const int gw = bid_l() * 4 + (tid_l() >> 6), ngw = vgrid() * 4;
    const float* g = P.in[I_FG];
    for (int r = gw; r < RL; r += 2 * ngw) {
        const int r1 = r + ngw;
        f32x4* xa = (f32x4*)(P.out + (size_t)r * D); f32x4* xb = (f32x4*)(P.out + (size_t)r1 * D);
        f32x4 va[4], vb[4]; float sa_ = 0.f, sb_ = 0.f;
#pragma unroll
        for (int j = 0; j < 4; ++j) { va[j] = xa[lane + 64 * j]; vb[j] = xb[lane + 64 * j]; }
#pragma unroll
        for (int j = 0; j < 4; ++j) { sa_ += va[j].x * va[j].x + va[j].y * va[j].y + va[j].z * va[j].z + va[j].w * va[j].w; sb_ += vb[j].x * vb[j].x + vb[j].y * vb[j].y + vb[j].z * vb[j].z + vb[j].w * vb[j].w; }
        sa_ = wave_sum(sa_); sb_ = wave_sum(sb_);
        const float rsa = rsqrtf(sa_ * (1.f / 1024.f) + 1e-6f), rsb = rsqrtf(sb_ * (1.f / 1024.f) + 1e-6f);
#pragma unroll
        for (int j = 0; j < 4; ++j) { const f32x4 gg = *(const f32x4*)(g + (lane + 64 * j) * 4); xa[lane + 64 * j] = va[j] * rsa * gg; xb[lane + 64 * j] = vb[j] * rsb * gg; }
    }
}

struct EpiP {
    bf16_t* Pb; int pitch; int nmain; float* small;
    __device__ __forceinline__ void operator()(int r, int c, const f32x4& v, int) const {
        if (c < nmain) { u32x2 o; o.x = cvt_pk(v.x, v.y); o.y = cvt_pk(v.z, v.w); *(u32x2*)(Pb + (size_t)r * pitch + c) = o; }
        else { const int cc = c - nmain; if (cc < 48) *(f32x4*)(small + (size_t)r * 48 + cc) = v; }
    }
    __device__ __forceinline__ void w8(int r, int c, const f32x4& v0, const f32x4& v1, int) const {
        if (c < nmain) { u32x4 o; o.x = cvt_pk(v0.x, v0.y); o.y = cvt_pk(v0.z, v0.w); o.z = cvt_pk(v1.x, v1.y); o.w = cvt_pk(v1.z, v1.w); *(u32x4*)(Pb + (size_t)r * pitch + c) = o; }
        else { const int cc = c - nmain; if (cc < 48) { *(f32x4*)(small + (size_t)r * 48 + cc) = v0; *(f32x4*)(small + (size_t)r * 48 + cc + 4) = v1; } }
    }
};
struct EpiSig {
    bf16_t* O;
    __device__ __forceinline__ void operator()(int r, int c, const f32x4& v, int) const {
        u32x2 o; o.x = cvt_pk(sigmf(v.x), sigmf(v.y)); o.y = cvt_pk(sigmf(v.z), sigmf(v.w)); *(u32x2*)(O + (size_t)r * 3072 + c) = o;
    }
    __device__ __forceinline__ void w8(int r, int c, const f32x4& v0, const f32x4& v1, int) const {
        u32x4 o; o.x = cvt_pk(sigmf(v0.x), sigmf(v0.y)); o.y = cvt_pk(sigmf(v0.z), sigmf(v0.w)); o.z = cvt_pk(sigmf(v1.x), sigmf(v1.y)); o.w = cvt_pk(sigmf(v1.z), sigmf(v1.w));
        *(u32x4*)(O + (size_t)r * 3072 + c) = o;
    }
};
struct EpiRelu2 {
    bf16_t* O;
    __device__ __forceinline__ void operator()(int r, int c, const f32x4& v, int) const {
        const float a = fmaxf(v.x, 0.f), b = fmaxf(v.y, 0.f), cc = fmaxf(v.z, 0.f), d = fmaxf(v.w, 0.f);
        u32x2 o; o.x = cvt_pk(a * a, b * b); o.y = cvt_pk(cc * cc, d * d); *(u32x2*)(O + (size_t)r * 4096 + c) = o;
    }
    __device__ __forceinline__ void w8(int r, int c, const f32x4& v0, const f32x4& v1, int) const {
        const float a = fmaxf(v0.x, 0.f), b = fmaxf(v0.y, 0.f), cc = fmaxf(v0.z, 0.f), d = fmaxf(v0.w, 0.f), e = fmaxf(v1.x, 0.f), f = fmaxf(v1.y, 0.f), g = fmaxf(v1.z, 0.f), h = fmaxf(v1.w, 0.f);
        u32x4 o; o.x = cvt_pk(a * a, b * b); o.y = cvt_pk(cc * cc, d * d); o.z = cvt_pk(e * e, f * f); o.w = cvt_pk(g * g, h * h); *(u32x4*)(O + (size_t)r * 4096 + c) = o;
    }
};
struct EpiRes {
    XPtr Xold, Xnew; const float* mods_l; int gidx;
    __device__ __forceinline__ void operator()(int r, int c, const f32x4& v, int) const {
        const f32x4 g = *(const f32x4*)(mods_l + modidx(r) * 6144 + gidx * 1024 + c);
        const f32x4 xo = *(const f32x4*)(xrow(Xold, r) + c);
        *(f32x4*)(xrow(Xnew, r) + c) = xo + g * v;
    }
    __device__ __forceinline__ void w8(int r, int c, const f32x4& v0, const f32x4& v1, int) const {
        const float* gp = mods_l + modidx(r) * 6144 + gidx * 1024 + c; const float* xo = xrow(Xold, r) + c; float* xn = xrow(Xnew, r) + c;
        const f32x4 g0 = *(const f32x4*)gp, g1 = *(const f32x4*)(gp + 4), x0 = *(const f32x4*)xo, x1 = *(const f32x4*)(xo + 4);
        *(f32x4*)xn = x0 + g0 * v0; *(f32x4*)(xn + 4) = x1 + g1 * v1;
    }
};
struct EpiMerge {
    const bf16_t* gs; bf16_t* mb;
    __device__ __forceinline__ void operator()(int r, int c, const f32x4& v, int j) const {
        const u32x2 g = *(const u32x2*)(gs + (size_t)r * 3072 + j * 1024 + c);
        float a0 = v.x * bflo(g.x), a1 = v.y * bfhi(g.x), a2 = v.z * bflo(g.y), a3 = v.w * bfhi(g.y);
        u32x2* mp = (u32x2*)(mb + (size_t)r * 1024 + c);
        if (j > 0) { const u32x2 o = *mp; a0 += bflo(o.x); a1 += bfhi(o.x); a2 += bflo(o.y); a3 += bfhi(o.y); }
        u32x2 w; w.x = cvt_pk(a0, a1); w.y = cvt_pk(a2, a3); *mp = w;
    }
    __device__ __forceinline__ void w8(int r, int c, const f32x4& v0, const f32x4& v1, int j) const {
        const u32x4 g = *(const u32x4*)(gs + (size_t)r * 3072 + j * 1024 + c);
        float a0 = v0.x * bflo(g.x), a1 = v0.y * bfhi(g.x), a2 = v0.z * bflo(g.y), a3 = v0.w * bfhi(g.y), a4 = v1.x * bflo(g.z), a5 = v1.y * bfhi(g.z), a6 = v1.z * bflo(g.w), a7 = v1.w * bfhi(g.w);
        u32x4* mp = (u32x4*)(mb + (size_t)r * 1024 + c);
        if (j > 0) { const u32x4 o = *mp; a0 += bflo(o.x); a1 += bfhi(o.x); a2 += bflo(o.y); a3 += bfhi(o.y); a4 += bflo(o.z); a5 += bfhi(o.z); a6 += bflo(o.w); a7 += bfhi(o.w); }
        u32x4 w; w.x = cvt_pk(a0, a1); w.y = cvt_pk(a2, a3); w.z = cvt_pk(a4, a5); w.w = cvt_pk(a6, a7); *mp = w;
    }
};

namespace pg8 {
constexpr int BM = 256, BK = 64, HALF = 128, HTB = HALF * BK * 2, STAGE_BYTES = 8 * HTB, NXCD = 8, WGM = 2;
__device__ __forceinline__ int lds_byte(int r, int c) { const int st = (r >> 4) * 2 + (c >> 5), rr = r & 15, cc = c & 31, ob = rr * 64 + cc * 2; return st * 1024 + (ob ^ (((ob >> 9) & 1) << 5)); }
__device__ __forceinline__ int perm32(int rho) { const int n = rho >> 4, i = rho & 15; return 8 * (i >> 2) + 4 * n + (i & 3); }
__device__ __forceinline__ void stage_rc(int b, int& R_, int& C_) { const int st = b / 1024, sb = b % 1024, swz = sb ^ (((sb >> 9) & 1) << 5); R_ = (st >> 1) * 16 + swz / 64; C_ = (st & 1) * 32 + (swz % 64) / 2; }
struct Unit { int pm, pn, acol, brow, j; };
struct Gemm { const bf16_t* A; const bf16_t* Bt; int lda, K; };
struct StaticOrder {
    int nM, nN, nwg, G, c;
    __device__ void init(int M, int N, int G_, int c_) { nM = M / BM; nN = N / BM; nwg = nM * nN; G = G_; c = c_; }
    __device__ __forceinline__ bool tile(long L, int& pm, int& pn) const {
        if (L >= nwg) return false;
        int wgid = (int)L; { const int q = nwg / NXCD, r = nwg % NXCD, xcd = wgid % NXCD, off = wgid / NXCD; wgid = (xcd < r ? xcd * (q + 1) : r * (q + 1) + (xcd - r) * q) + off; }
        const int nig = WGM * nN, gid = wgid / nig, fm = gid * WGM, gsz = (nM - fm) < WGM ? (nM - fm) : WGM;
        pm = fm + ((wgid % nig) % gsz); pn = (wgid % nig) / gsz; return true;
    }
    __device__ __forceinline__ bool next(int i, Unit& u) const { if (!tile((long)i * G + c, u.pm, u.pn)) return false; u.acol = 0; u.brow = u.pn; u.j = 0; return true; }
};
struct MergeOrder {
    StaticOrder S;
    __device__ __forceinline__ bool next(int i, Unit& u) const { const int j = i % 3; if (!S.tile((long)(i / 3) * S.G + S.c, u.pm, u.pn)) return false; u.acol = j * 512; u.brow = j * 4 + u.pn; u.j = j; return true; }
};
template <class F> struct Epi {
    F f;
    __device__ __forceinline__ void operator()(const f32x4 (&acc)[2][2][4][2], const Unit& u, int wr, int wc, int fr, int fq) const {
#pragma unroll
        for (int ai = 0; ai < 2; ++ai)
#pragma unroll
            for (int m = 0; m < 4; ++m)
#pragma unroll
                for (int bj = 0; bj < 2; ++bj)
                    f.w8(u.pm * BM + ai * HALF + wr * 64 + m * 16 + fr, u.pn * BM + bj * HALF + wc * 32 + 8 * fq, acc[ai][bj][m][0], acc[ai][bj][m][1], u.j);
    }
};

template <class E_, class Sched>
__device__ __forceinline__ void gemm_phase(LAS unsigned char* lds, const Gemm g, const Sched& S, const E_& E) {
    int tid_ = threadIdx.x; asm volatile("" : "+v"(tid_));
    const int tid = tid_, wid = __builtin_amdgcn_readfirstlane(tid >> 6), lane = tid & 63, wr = wid >> 2, wc = wid & 3, fr = lane & 15, fq = lane >> 4;
    const int K = g.K, nt = K / BK;
    unsigned voffA[2], voffB[2];
#pragma unroll
    for (int i = 0; i < 2; ++i) { int R_, C_; stage_rc(tid * 16 + i * 8192, R_, C_); const int Rb = (R_ & ~31) + perm32(R_ & 31); voffA[i] = (unsigned)(R_ * g.lda + C_) * 2u; voffB[i] = (unsigned)(Rb * K + C_) * 2u; }
    const size_t kstep = (size_t)(BK * 2);
    const size_t hstepA = (size_t)HALF * g.lda * 2, hstepB = (size_t)HALF * K * 2;
    const unsigned ldsw = (unsigned)wid * 1024u;
    const int aoff = lds_byte(wr * 64 + fr, fq * 8), boff = lds_byte(wc * 32 + fr, fq * 8);
#define PG8_SA(b, h) (((b) * 2 + (h)) * HTB)
#define PG8_SB(b, h) ((4 + (b) * 2 + (h)) * HTB)
#define PG8_STAGE(bufoff, gbase, voff) do { _Pragma("unroll") for (int _i = 0; _i < 2; ++_i) \
        __builtin_amdgcn_global_load_lds((const unsigned*)((const char*)(gbase) + (voff)[_i]), (LAS unsigned*)(lds + (bufoff) + ldsw + _i * 8192), 16, 0, 0); } while (0)
#define PG8_LDA(dst, b, h) do { _Pragma("unroll") for (int m = 0; m < 4; ++m) _Pragma("unroll") for (int k = 0; k < 2; ++k) dst[m][k] = *(const LAS bf16x8*)(lds + PG8_SA(b, h) + aoff + m * 2048 + k * 1024); } while (0)
#define PG8_LDB(dst, b, h) do { _Pragma("unroll") for (int n = 0; n < 2; ++n) _Pragma("unroll") for (int k = 0; k < 2; ++k) dst[n][k] = *(const LAS bf16x8*)(lds + PG8_SB(b, h) + boff + n * 2048 + k * 1024); } while (0)
#define PG8_MMA(ai, bj, At, Bt) do { __builtin_amdgcn_s_setprio(1); _Pragma("unroll") for (int m = 0; m < 4; ++m) _Pragma("unroll") for (int n = 0; n < 2; ++n) _Pragma("unroll") for (int k = 0; k < 2; ++k) \
        acc[ai][bj][m][n] = __builtin_amdgcn_mfma_f32_16x16x32_bf16(Bt[n][k], At[m][k], acc[ai][bj][m][n], 0, 0, 0); __builtin_amdgcn_s_setprio(0); } while (0)
#define PG8_WAIT_V(n) asm volatile("s_waitcnt vmcnt(" #n ")" ::: "memory")
#define PG8_WAIT_L(n) asm volatile("s_waitcnt lgkmcnt(" #n ")" ::: "memory")
#define PG8_BAR __builtin_amdgcn_s_barrier()
#define PG8_SCHED __builtin_amdgcn_sched_barrier(0)
#define PG8_UA(u) ((const char*)g.A + ((size_t)(u).pm * BM * g.lda + (u).acol) * 2)
#define PG8_UB(u) ((const char*)g.Bt + (size_t)(u).brow * BM * K * 2)
    Unit cur, nxt; int ui = 0;
    if (!S.next(0, cur)) return;
    f32x4 acc[2][2][4][2];
#pragma unroll
    for (int a = 0; a < 2; ++a)
#pragma unroll
        for (int b = 0; b < 2; ++b)
#pragma unroll
            for (int m = 0; m < 4; ++m)
#pragma unroll
                for (int n = 0; n < 2; ++n) acc[a][b][m][n] = (f32x4){0.f, 0.f, 0.f, 0.f};
    bf16x8 At[4][2], B0[2][2], B1[2][2];
    const char* cA = PG8_UA(cur); const char* cB = PG8_UB(cur);
    PG8_STAGE(PG8_SB(0, 0), cB, voffB); PG8_STAGE(PG8_SB(0, 1), cB + hstepB, voffB); PG8_STAGE(PG8_SA(0, 0), cA, voffA); PG8_STAGE(PG8_SA(0, 1), cA + hstepA, voffA);
    if (wr == 1) PG8_BAR;
    PG8_WAIT_V(2); PG8_BAR;
    PG8_STAGE(PG8_SB(1, 0), cB + kstep, voffB); PG8_STAGE(PG8_SA(1, 0), cA + kstep, voffA); PG8_STAGE(PG8_SB(1, 1), cB + hstepB + kstep, voffB);
    PG8_WAIT_V(6); PG8_BAR;
    for (;;) {
        const bool has_next = S.next(ui + 1, nxt);
        const char* nA = has_next ? PG8_UA(nxt) : cA; const char* nB = has_next ? PG8_UB(nxt) : cB;
        for (int t = 0; t < nt; t += 2) {
            const bool last = (t == nt - 2);
            const char* a1 = cA + (size_t)(t + 1) * kstep;
            const char* a2 = last ? nA : cA + (size_t)(t + 2) * kstep; const char* b2 = last ? nB : cB + (size_t)(t + 2) * kstep;
            const char* a3 = a2 + kstep; const char* b3 = b2 + kstep;
            PG8_LDB(B0, 0, 0); PG8_LDB(B1, 0, 1); PG8_SCHED; PG8_LDA(At, 0, 0); PG8_STAGE(PG8_SA(1, 1), a1 + hstepA, voffA);
            PG8_WAIT_V(8); PG8_WAIT_L(0); PG8_BAR; PG8_MMA(0, 0, At, B0); PG8_MMA(0, 1, At, B1); PG8_BAR; PG8_SCHED;
            PG8_LDA(At, 0, 1); PG8_STAGE(PG8_SB(0, 0), b2, voffB); PG8_STAGE(PG8_SB(0, 1), b2 + hstepB, voffB); PG8_STAGE(PG8_SA(0, 0), a2, voffA);
            PG8_WAIT_V(8); PG8_WAIT_L(0); PG8_BAR; PG8_MMA(1, 0, At, B0); PG8_MMA(1, 1, At, B1); PG8_BAR; PG8_SCHED;
            PG8_LDB(B0, 1, 0); PG8_LDB(B1, 1, 1); PG8_SCHED; PG8_LDA(At, 1, 0); PG8_STAGE(PG8_SA(0, 1), a2 + hstepA, voffA);
            PG8_WAIT_V(8); PG8_WAIT_L(0); PG8_BAR; PG8_MMA(0, 0, At, B0); PG8_MMA(0, 1, At, B1); PG8_BAR; PG8_SCHED;
            PG8_LDA(At, 1, 1); PG8_STAGE(PG8_SB(1, 0), b3, voffB); PG8_STAGE(PG8_SB(1, 1), b3 + hstepB, voffB); PG8_STAGE(PG8_SA(1, 0), a3, voffA);
            PG8_WAIT_V(8); PG8_WAIT_L(0); PG8_BAR; PG8_MMA(1, 0, At, B0); PG8_MMA(1, 1, At, B1); PG8_BAR; PG8_SCHED;
        }
        if (wr == 0) PG8_BAR;
        E(acc, cur, wr, wc, fr, fq);
        if (!has_next) break;
#pragma unroll
        for (int a = 0; a < 2; ++a)
#pragma unroll
            for (int b = 0; b < 2; ++b)
#pragma unroll
                for (int m = 0; m < 4; ++m)
#pragma unroll
                    for (int n = 0; n < 2; ++n) acc[a][b][m][n] = (f32x4){0.f, 0.f, 0.f, 0.f};
        cur = nxt; cA = nA; cB = nB; ++ui;
        if (wr == 1) PG8_BAR;
    }
    PG8_WAIT_V(0);
    PG8_BAR;
#undef PG8_SA
#undef PG8_SB
#undef PG8_STAGE
#undef PG8_LDA
#undef PG8_LDB
#undef PG8_MMA
#undef PG8_WAIT_V
#undef PG8_WAIT_L
#undef PG8_BAR
#undef PG8_SCHED
#undef PG8_UA
#undef PG8_UB
}
}

template <class F>
__device__ __forceinline__ void big_gemm(LAS unsigned char* ldsb, const bf16_t* A, int lda, const bf16_t* Bt, int K, int N, const F& f) {
    pg8::Gemm g{A, Bt, lda, K}; pg8::StaticOrder S; S.init(RL, N, (int)gridDim.x, (int)blockIdx.x);
    pg8::Epi<F> E{f};
    pg8::gemm_phase(ldsb, g, S, E);
    __syncthreads();
}
template <int NI>
__device__ __forceinline__ void gemm_kloop(f32x4 (&acc)[4][NI], const bf16_t* Ag, int lda, const bf16_t* Bg, int ldb, int K, char* lds) {
    const int tid = tid_l(), lane = tid & 63, wid = tid >> 6, wm = wid >> 1, wn = wid & 1, lr = lane & 15, lq = lane >> 4;
    u32x4 ra[4], rb[NI];
    const int prow = tid >> 3, pkc = tid & 7;
    const bf16_t* ap = Ag + (size_t)prow * lda + pkc * 8;
    const bf16_t* bp = Bg + (size_t)prow * ldb + pkc * 8;
    const int soff = prow * 128 + ((pkc ^ (prow & 7)) << 4);
#pragma unroll
    for (int i = 0; i < 4; ++i) { ra[i] = *(const u32x4*)(ap + (size_t)(32 * i) * lda); if (i < NI) rb[i < NI ? i : 0] = *(const u32x4*)(bp + (size_t)(32 * i) * ldb); }
#pragma unroll
    for (int i = 0; i < 4; ++i) { *(u32x4*)(lds + soff + i * 4096) = ra[i]; if (i < NI) *(u32x4*)(lds + 32768 + soff + i * 4096) = rb[i < NI ? i : 0]; }
    __syncthreads();
    const int nk = K >> 6;
    for (int kt = 0; kt < nk; ++kt) {
        const int buf = kt & 1;
        if (kt + 1 < nk) {
#pragma unroll
            for (int i = 0; i < 4; ++i) { ra[i] = *(const u32x4*)(ap + (size_t)(32 * i) * lda + (kt + 1) * 64); if (i < NI) rb[i < NI ? i : 0] = *(const u32x4*)(bp + (size_t)(32 * i) * ldb + (kt + 1) * 64); }
        }
        const char* la = lds + buf * 16384; const char* lb = lds + 32768 + buf * 16384;
#pragma unroll
        for (int kk = 0; kk < 2; ++kk) {
            bf16x8 af[4], bfr[NI];
            const int chunk = kk * 4 + lq;
#pragma unroll
            for (int mi = 0; mi < 4; ++mi) { const int row = wm * 64 + mi * 16 + lr; af[mi] = *(const bf16x8*)(la + row * 128 + ((chunk ^ (row & 7)) << 4)); }
#pragma unroll
            for (int ni = 0; ni < NI; ++ni) { const int row = wn * (16 * NI) + ni * 16 + lr; bfr[ni] = *(const bf16x8*)(lb + row * 128 + ((chunk ^ (row & 7)) << 4)); }
#pragma unroll
            for (int mi = 0; mi < 4; ++mi)
#pragma unroll
                for (int ni = 0; ni < NI; ++ni) acc[mi][ni] = __builtin_amdgcn_mfma_f32_16x16x32_bf16(bfr[ni], af[mi], acc[mi][ni], 0, 0, 0);
        }
        if (kt + 1 < nk) {
            char* sa = lds + (buf ^ 1) * 16384 + soff;
#pragma unroll
            for (int i = 0; i < 4; ++i) { *(u32x4*)(sa + i * 4096) = ra[i]; if (i < NI) *(u32x4*)(sa + 32768 + i * 4096) = rb[i < NI ? i : 0]; }
        }
        __syncthreads();
    }
}

__device__ __forceinline__ void tile_of(int t, int Mt, int Nt, int& tm, int& tn) {
    const int per = 8 * Nt; const int p = t / per; const int r = t - p * per; const int pm = (Mt - 8 * p) < 8 ? (Mt - 8 * p) : 8;
    tm = 8 * p + r % pm; tn = r / pm;
}

template <int TYPE> struct MX {
    static constexpr int DK = TYPE == 1 ? 128 : 64;
    static constexpr int NOC = DK / 8;
    static constexpr int PITCH = TYPE == 1 ? 2048 : 1536;
    static constexpr int QOFF = 0;
    static constexpr int KOFF = TYPE == 1 ? 512 : 256;
    static constexpr int VOFF = TYPE == 1 ? 1024 : 512;
    static constexpr int GOFF = TYPE == 1 ? 1536 : 1024;
    static constexpr int QP = DK + 16;
};
constexpr int L_VT = 0;
constexpr int L_Q = 20480;
constexpr int L_CUM = 40960;
constexpr int L_ATT = 57344;
constexpr int L_SC = 67584;
constexpr int L_SA = 68096;

template <int TYPE>
__device__ __forceinline__ void load_qk8(const Params& P, int l, const bf16_t* pb, int b, int c, int t, int h, int oc, bool isk, float (&f)[8], const float* wpre = nullptr) {
    typedef MX<TYPE> M;
    const int coff = (isk ? M::KOFF : M::QOFF) + h * M::DK;
    const size_t rowi = (size_t)(rowbase(b, c) + t);
    if (TYPE == 0) {
        const u32x4 u = *(const u32x4*)(pb + rowi * M::PITCH + coff + oc * 8); UNPACK8(u, f);
    } else if (TYPE == 1) {
        const bool hp = (t > 0) || (c != 0 && c != 4), hn = (t < 63) || (c != 3 && c != NCH - 1);
        const bf16_t* p0 = pb + rowi * M::PITCH + coff + oc * 8;
        u32x4 u1 = *(const u32x4*)p0, u0 = (u32x4){0u, 0u, 0u, 0u}, u2 = (u32x4){0u, 0u, 0u, 0u};
        if (hp) u0 = *(const u32x4*)(p0 - M::PITCH);
        if (hn) u2 = *(const u32x4*)(p0 + M::PITCH);
        float a[8], m[8], n[8]; UNPACK8(u0, a); UNPACK8(u1, m); UNPACK8(u2, n);
        float w0[8], w1[8], w2[8];
        if (wpre) {
#pragma unroll
            for (int j = 0; j < 8; ++j) { w0[j] = wpre[j]; w1[j] = wpre[8 + j]; w2[j] = wpre[16 + j]; }
        } else {
            const float* cw = P.in[I_CONV] + (size_t)l * 3 * 1024 + (isk ? 512 : 0) + h * 128 + oc * 8;
            const f32x4 w0a = *(const f32x4*)cw, w0b = *(const f32x4*)(cw + 4), w1a = *(const f32x4*)(cw + 1024), w1b = *(const f32x4*)(cw + 1028), w2a = *(const f32x4*)(cw + 2048), w2b = *(const f32x4*)(cw + 2052);
            w0[0] = w0a.x; w0[1] = w0a.y; w0[2] = w0a.z; w0[3] = w0a.w; w0[4] = w0b.x; w0[5] = w0b.y; w0[6] = w0b.z; w0[7] = w0b.w;
            w1[0] = w1a.x; w1[1] = w1a.y; w1[2] = w1a.z; w1[3] = w1a.w; w1[4] = w1b.x; w1[5] = w1b.y; w1[6] = w1b.z; w1[7] = w1b.w;
            w2[0] = w2a.x; w2[1] = w2a.y; w2[2] = w2a.z; w2[3] = w2a.w; w2[4] = w2b.x; w2[5] = w2b.y; w2[6] = w2b.z; w2[7] = w2b.w;
        }
#pragma unroll
        for (int j = 0; j < 8; ++j) f[j] = siluf(w0[j] * a[j] + w1[j] * m[j] + w2[j] * n[j]);
    } else {
        if (c < 4) { const u32x4 u = *(const u32x4*)(pb + rowi * M::PITCH + coff + oc * 8); UNPACK8(u, f); }
        else {
            const int o4 = oc & 3;
            const u32x4 ua = *(const u32x4*)(pb + rowi * M::PITCH + coff + o4 * 8), ub = *(const u32x4*)(pb + rowi * M::PITCH + coff + 32 + o4 * 8);
            float x1[8], x2[8]; UNPACK8(ua, x1); UNPACK8(ub, x2);
            const float* tab = (const float*)(ws_l(P) + WS_ROPE);
            const float* cs = o4 < 2 ? tab + (c - 4) * 16 + o4 * 8 : tab + 4096 + t * 16 + (o4 - 2) * 8;
            const float* sn = o4 < 2 ? tab + 2048 + (c - 4) * 16 + o4 * 8 : tab + 4096 + 1024 + t * 16 + (o4 - 2) * 8;
            const f32x4 ca = *(const f32x4*)cs, cb = *(const f32x4*)(cs + 4), sa = *(const f32x4*)sn, sb = *(const f32x4*)(sn + 4);
            const float cv[8] = {ca.x, ca.y, ca.z, ca.w, cb.x, cb.y, cb.z, cb.w}, sv[8] = {sa.x, sa.y, sa.z, sa.w, sb.x, sb.y, sb.z, sb.w};
#pragma unroll
            for (int j = 0; j < 8; ++j) f[j] = oc < 4 ? x1[j] * cv[j] - x2[j] * sv[j] : x1[j] * sv[j] + x2[j] * cv[j];
        }
    }
}

__device__ __forceinline__ void load_convw(const Params& P, int l, int h, int oc, bool isk, float (&w)[24]) {
    const float* cw = P.in[I_CONV] + (size_t)l * 3 * 1024 + (isk ? 512 : 0) + h * 128 + oc * 8;
#pragma unroll
    for (int tp = 0; tp < 3; ++tp) { const f32x4 a = *(const f32x4*)(cw + tp * 1024), b = *(const f32x4*)(cw + tp * 1024 + 4);
        w[tp * 8 + 0] = a.x; w[tp * 8 + 1] = a.y; w[tp * 8 + 2] = a.z; w[tp * 8 + 3] = a.w; w[tp * 8 + 4] = b.x; w[tp * 8 + 5] = b.y; w[tp * 8 + 6] = b.z; w[tp * 8 + 7] = b.w; }
}
template <int TYPE>
__device__ __forceinline__ void decay_setup(const Params& P, int l, int b, int c, int h, int dir, char* lds, const float* apre = nullptr) {
    const int tid = tid_l(); const int r0 = rowbase(b, c);
    float* sc = (float*)(lds + L_SC);
    const float* small = (const float*)(ws_l(P) + WS_SMALL);
    if (TYPE == 0) {
        float* cum = (float*)(lds + L_CUM); float* sa = (float*)(lds + L_SA);
        if (apre) {
#pragma unroll
            for (int k = 0; k < 4; ++k) sa[tid + k * NTHR] = apre[k];
        } else {
            for (int i = tid; i < 1024; i += NTHR) sa[i] = small[(size_t)(r0 + (i >> 4)) * 48 + dir * 16 + (i & 15)];
        }
        __syncthreads();
        const int d = tid & 63, tq = tid >> 6;
        const float* a2 = P.in[I_A2] + ((size_t)(l * 2 + dir) * 16) * 256 + h * 64 + d;
        float w[16];
#pragma unroll
        for (int rr = 0; rr < 16; ++rr) w[rr] = a2[rr * 256];
        const float bias = P.in[I_ABIAS][(l * 2 + dir) * 256 + h * 64 + d];
        float* blk = sa + 1024;
        float lv[16];
#pragma unroll
        for (int i = 0; i < 16; ++i) {
            const int t = tq * 16 + i;
            const f32x4 a0 = *(const f32x4*)(sa + t * 16), a1 = *(const f32x4*)(sa + t * 16 + 4), a2v = *(const f32x4*)(sa + t * 16 + 8), a3 = *(const f32x4*)(sa + t * 16 + 12);
            float z = bias;
            z += a0.x * w[0] + a0.y * w[1] + a0.z * w[2] + a0.w * w[3];
            z += a1.x * w[4] + a1.y * w[5] + a1.z * w[6] + a1.w * w[7];
            z += a2v.x * w[8] + a2v.y * w[9] + a2v.z * w[10] + a2v.w * w[11];
            z += a3.x * w[12] + a3.y * w[13] + a3.z * w[14] + a3.w * w[15];
            lv[i] = logsig_fast(z) * (1.f / 16.f);
        }
        if (dir == 0) {
#pragma unroll
            for (int i = 1; i < 16; ++i) lv[i] += lv[i - 1];
        } else {
#pragma unroll
            for (int i = 14; i >= 0; --i) lv[i] += lv[i + 1];
        }
        blk[tq * 64 + d] = dir == 0 ? lv[15] : lv[0];
        __syncthreads();
        float off = 0.f;
#pragma unroll
        for (int q = 0; q < 4; ++q) if (dir == 0 ? (q < tq) : (q > tq)) off += blk[q * 64 + d];
#pragma unroll
        for (int i = 0; i < 16; ++i) cum[(tq * 16 + i) * 64 + d] = lv[i] + off;
    } else if (TYPE == 1) {
        if (tid < 64) {
            const float fg = small[(size_t)(r0 + tid) * 48 + 40 + dir * 4 + h] + P.in[I_FB][l * 8 + dir * 4 + h];
            float v = logsig(fg);
            if (dir == 0) {
#pragma unroll
                for (int o = 1; o < 64; o <<= 1) { const float n = __shfl_up(v, o); if (tid >= o) v += n; }
            } else {
#pragma unroll
                for (int o = 1; o < 64; o <<= 1) { const float n = __shfl_down(v, o); if (tid + o < 64) v += n; }
            }
            const float tot = __shfl(v, dir == 0 ? 63 : 0);
            sc[tid] = v;
            sc[64 + tid] = small[(size_t)(r0 + tid) * 48 + 32 + dir * 4 + h] + P.in[I_IB][l * 8 + dir * 4 + h];
            if (tid == 0) sc[128] = tot;
        }
    } else {
        if (tid < 64) {
            const float lg = logsig(P.in[I_RDL][l * 8 + dir * 4 + h]);
            sc[tid] = (dir == 0 ? (float)(tid + 1) : (float)(64 - tid)) * lg;
            if (tid == 0) sc[128] = 64.f * lg;
        }
    }
    __syncthreads();
}

template <int TYPE>
__device__ __forceinline__ void build_vT(const bf16_t* pb, int b, int c, int h, char* lds) {
    typedef MX<TYPE> M;
    bf16_t* vT = (bf16_t*)(lds + L_VT);
#pragma unroll
    for (int i = 0; i < 2; ++i) {
        const int pid = tid_l() + i * NTHR, tp = pid & 31, oc = pid >> 5;
        const bf16_t* p0 = pb + (size_t)(rowbase(b, c) + 2 * tp) * M::PITCH + M::VOFF + h * 128 + oc * 8;
        const u32x4 u0 = *(const u32x4*)p0, u1 = *(const u32x4*)(p0 + M::PITCH);
        unsigned* dst = (unsigned*)(vT + (size_t)(oc * 8) * 80 + 2 * tp);
        dst[0 * 40] = (u0.x & 0xffffu) | (u1.x << 16); dst[1 * 40] = (u0.x >> 16) | (u1.x & 0xffff0000u);
        dst[2 * 40] = (u0.y & 0xffffu) | (u1.y << 16); dst[3 * 40] = (u0.y >> 16) | (u1.y & 0xffff0000u);
        dst[4 * 40] = (u0.z & 0xffffu) | (u1.z << 16); dst[5 * 40] = (u0.z >> 16) | (u1.z & 0xffff0000u);
        dst[6 * 40] = (u0.w & 0xffffu) | (u1.w << 16); dst[7 * 40] = (u0.w >> 16) | (u1.w & 0xffff0000u);
    }
}

__device__ __forceinline__ int scan_index(int dir, int c) { return dir == 0 ? c : (c < 4 ? 3 - c : 135 - c); }

template <int TYPE>
__device__ __forceinline__ void u_phase(const Params& P, int l, char* lds) {
    typedef MX<TYPE> M; constexpr int DK = M::DK;
    const int tid = tid_l(), lane = tid & 63, wid = tid >> 6, lr = lane & 15, lq = lane >> 4;
    const bf16_t* pb = (const bf16_t*)(ws_l(P) + WS_PBUF);
    bf16_t* U = (bf16_t*)(ws_l(P) + WS_SBUF); float* DEC = (float*)(ws_l(P) + WS_DEC); float* UN = (float*)(ws_l(P) + WS_UN);
    bf16_t* vT = (bf16_t*)(lds + L_VT); bf16_t* kT = (bf16_t*)(lds + L_Q);
    const float* cum = (const float*)(lds + L_CUM); const float* sc = (const float*)(lds + L_SC);
    const int NU = NB * 4 * 2 * NCH, VG = vgrid(), slot = bid_l();
    for (int u0 = 0; u0 < NU; u0 += VG) {
        int unit = u0 + slot; if (unit >= NU) unit = NU - 1;
        const int c = unit % NCH; const int rest = unit / NCH; const int dir = rest & 1, h = (rest >> 1) & 3, b = rest >> 3;
        const int chain = (b * 4 + h) * 2 + dir, n = scan_index(dir, c);
        static_assert(TYPE == 0, "the scalar-decay branches use u_phase_s");
        float k0[8], k1[8], apre[4];
        { const int tp = tid & 31, oc = tid >> 5;
          load_qk8<TYPE>(P, l, pb, b, c, 2 * tp, h, oc, true, k0);
          load_qk8<TYPE>(P, l, pb, b, c, 2 * tp + 1, h, oc, true, k1);
          const float* small = (const float*)(ws_l(P) + WS_SMALL); const int r0 = rowbase(b, c);
#pragma unroll
          for (int k = 0; k < 4; ++k) { const int i = tid + k * NTHR; apre[k] = small[(size_t)(r0 + (i >> 4)) * 48 + dir * 16 + (i & 15)]; } }
        build_vT<TYPE>(pb, b, c, h, lds);
        decay_setup<TYPE>(P, l, b, c, h, dir, lds, apre);
        const int tlast = dir == 0 ? 63 : 0;
        {
            const int pid = tid, tp = pid & 31, oc = pid >> 5;
            unsigned* dst = (unsigned*)(kT + (size_t)(oc * 8) * 80 + 2 * tp);
            if (TYPE == 0) {
#pragma unroll
                for (int j = 0; j < 8; ++j) { const int d = oc * 8 + j; const float tot = cum[tlast * 64 + d];
                    dst[j * 40] = cvt_pk(k0[j] * __expf(tot - cum[(2 * tp) * 64 + d]), k1[j] * __expf(tot - cum[(2 * tp + 1) * 64 + d])); }
            } else {
                const float tot = sc[128];
                const float w0 = TYPE == 1 ? __expf(tot - sc[2 * tp] + sc[64 + 2 * tp]) * 0.08838834764831845f : __expf(tot - sc[2 * tp]) * 0.125f;
                const float w1 = TYPE == 1 ? __expf(tot - sc[2 * tp + 1] + sc[64 + 2 * tp + 1]) * 0.08838834764831845f : __expf(tot - sc[2 * tp + 1]) * 0.125f;
#pragma unroll
                for (int j = 0; j < 8; ++j) dst[j * 40] = cvt_pk(k0[j] * w0, k1[j] * w1);
            }
        }
        __syncthreads();
        f32x4 acc[2][DK / 16];
#pragma unroll
        for (int i = 0; i < 2; ++i)
#pragma unroll
            for (int nt = 0; nt < DK / 16; ++nt) acc[i][nt] = (f32x4){0.f, 0.f, 0.f, 0.f};
#pragma unroll
        for (int kk = 0; kk < 2; ++kk) {
            bf16x8 fv[2];
#pragma unroll
            for (int i = 0; i < 2; ++i) fv[i] = *(const bf16x8*)(vT + (size_t)((2 * wid + i) * 16 + lr) * 80 + kk * 32 + lq * 8);
#pragma unroll
            for (int nt = 0; nt < DK / 16; ++nt) {
                const bf16x8 fk = *(const bf16x8*)(kT + (size_t)(nt * 16 + lr) * 80 + kk * 32 + lq * 8);
#pragma unroll
                for (int i = 0; i < 2; ++i) acc[i][nt] = __builtin_amdgcn_mfma_f32_16x16x32_bf16(fk, fv[i], acc[i][nt], 0, 0, 0);
            }
        }
        bf16_t* ub = U + (size_t)(chain * NCH + n) * 128 * DK;
#pragma unroll
        for (int i = 0; i < 2; ++i)
#pragma unroll
            for (int nt = 0; nt < DK / 16; ++nt) {
                const int e = (2 * wid + i) * 16 + lr, d = nt * 16 + lq * 4;
                u32x2 o; o.x = cvt_pk(acc[i][nt].x, acc[i][nt].y); o.y = cvt_pk(acc[i][nt].z, acc[i][nt].w);
                *(u32x2*)(ub + (size_t)e * DK + d) = o;
            }
        if (tid < DK) {
            const float tot = TYPE == 0 ? cum[tlast * 64 + (tid & 63)] : sc[128];
            DEC[(size_t)(chain * NCH + n) * 128 + tid] = __expf(tot);
            if (TYPE == 1) {
                float s = 0.f;
#pragma unroll
                for (int q = 0; q < 8; ++q) { const u32x4 u = *(const u32x4*)(kT + (size_t)tid * 80 + q * 8); float f[8]; UNPACK8(u, f);
#pragma unroll
                    for (int j = 0; j < 8; ++j) s += f[j]; }
                UN[(size_t)(chain * NCH + n) * 128 + tid] = s;
            }
        }
        __syncthreads();
    }
}

template <int TYPE>
__device__ __forceinline__ void u_phase_s(const Params& P, int l, char* lds) {
    typedef MX<TYPE> M; constexpr int DK = M::DK; constexpr int NIT = M::NOC * 32 / NTHR;
    const int tid = tid_l(), lane = tid & 63, wid = tid >> 6, lr = lane & 15, lq = lane >> 4;
    const bf16_t* pb = (const bf16_t*)(ws_l(P) + WS_PBUF);
    const float* small = (const float*)(ws_l(P) + WS_SMALL);
    bf16_t* U = (bf16_t*)(ws_l(P) + WS_SBUF); float* DEC = (float*)(ws_l(P) + WS_DEC); float* UN = (float*)(ws_l(P) + WS_UN);
    bf16_t* vT = (bf16_t*)(lds + L_VT); bf16_t* kT0 = (bf16_t*)(lds + 20480); bf16_t* kT1 = (bf16_t*)(lds + 40960);
    float* sc = (float*)(lds + L_SC);
    const int NU = NB * 4 * NCH, VG = vgrid(), slot = bid_l();
    for (int u0 = 0; u0 < NU; u0 += VG) {
        int unit = u0 + slot; int dmask = 3;
        if (VG == 512 && u0 >= 1024) { if (slot >= 2 * (NU - 1024)) continue; unit = 1024 + (slot >> 1); dmask = 1 << (slot & 1); }
        else if (unit >= NU) unit = NU - 1;
        const int c = unit % NCH; const int rest = unit / NCH; const int h = rest & 3, b = rest >> 2;
        const int r0 = rowbase(b, c);
        float kv[NIT][2][8];
#pragma unroll
        for (int i = 0; i < NIT; ++i) {
            const int pid = tid + i * NTHR, tp = pid & 31, oc = pid >> 5;
            load_qk8<TYPE>(P, l, pb, b, c, 2 * tp, h, oc, true, kv[i][0]);
            load_qk8<TYPE>(P, l, pb, b, c, 2 * tp + 1, h, oc, true, kv[i][1]);
        }
        if (TYPE == 1) {
            if (tid < 128) {
                const int dir = tid >> 6, t = tid & 63;
                const float fg = small[(size_t)(r0 + t) * 48 + 40 + dir * 4 + h] + P.in[I_FB][l * 8 + dir * 4 + h];
                float v = logsig(fg);
                if (dir == 0) {
#pragma unroll
                    for (int o = 1; o < 64; o <<= 1) { const float n = __shfl_up(v, o); if (t >= o) v += n; }
                } else {
#pragma unroll
                    for (int o = 1; o < 64; o <<= 1) { const float n = __shfl_down(v, o); if (t + o < 64) v += n; }
                }
                sc[dir * 64 + t] = v;
                sc[128 + dir * 64 + t] = small[(size_t)(r0 + t) * 48 + 32 + dir * 4 + h] + P.in[I_IB][l * 8 + dir * 4 + h];
            }
        } else {
            if (tid < 64) {
                const float lg0 = logsig(P.in[I_RDL][l * 8 + h]), lg1 = logsig(P.in[I_RDL][l * 8 + 4 + h]);
                sc[tid] = (float)(tid + 1) * lg0; sc[64 + tid] = (float)(64 - tid) * lg1;
            }
        }
        build_vT<TYPE>(pb, b, c, h, lds);
        __syncthreads();
        const float totf = sc[63], totb = sc[64];
        const float ks = TYPE == 1 ? 0.08838834764831845f : 0.125f;
#pragma unroll
        for (int i = 0; i < NIT; ++i) {
            const int pid = tid + i * NTHR, tp = pid & 31, oc = pid >> 5;
            const int t0 = 2 * tp, t1 = 2 * tp + 1;
            const float wf0 = __expf(totf - sc[t0] + (TYPE == 1 ? sc[128 + t0] : 0.f)) * ks, wf1 = __expf(totf - sc[t1] + (TYPE == 1 ? sc[128 + t1] : 0.f)) * ks;
            const float wb0 = __expf(totb - sc[64 + t0] + (TYPE == 1 ? sc[192 + t0] : 0.f)) * ks, wb1 = __expf(totb - sc[64 + t1] + (TYPE == 1 ? sc[192 + t1] : 0.f)) * ks;
            unsigned* d0 = (unsigned*)(kT0 + (size_t)(oc * 8) * 80 + 2 * tp); unsigned* d1 = (unsigned*)(kT1 + (size_t)(oc * 8) * 80 + 2 * tp);
#pragma unroll
            for (int j = 0; j < 8; ++j) { d0[j * 40] = cvt_pk(kv[i][0][j] * wf0, kv[i][1][j] * wf1); d1[j * 40] = cvt_pk(kv[i][0][j] * wb0, kv[i][1][j] * wb1); }
        }
        __syncthreads();
        const int chf = (b * 4 + h) * 2;
#pragma unroll 1
        for (int dir = 0; dir < 2; ++dir) {
            if (!((dmask >> dir) & 1)) continue;
            const bf16_t* kT = dir == 0 ? kT0 : kT1;
            const int n = scan_index(dir, c);
            f32x4 acc[2][DK / 16];
#pragma unroll
            for (int i = 0; i < 2; ++i)
#pragma unroll
                for (int nt = 0; nt < DK / 16; ++nt) acc[i][nt] = (f32x4){0.f, 0.f, 0.f, 0.f};
#pragma unroll
            for (int kk = 0; kk < 2; ++kk) {
                bf16x8 fv[2];
#pragma unroll
                for (int i = 0; i < 2; ++i) fv[i] = *(const bf16x8*)(vT + (size_t)((2 * wid + i) * 16 + lr) * 80 + kk * 32 + lq * 8);
#pragma unroll
                for (int nt = 0; nt < DK / 16; ++nt) {
                    const bf16x8 fk = *(const bf16x8*)(kT + (size_t)(nt * 16 + lr) * 80 + kk * 32 + lq * 8);
#pragma unroll
                    for (int i = 0; i < 2; ++i) acc[i][nt] = __builtin_amdgcn_mfma_f32_16x16x32_bf16(fk, fv[i], acc[i][nt], 0, 0, 0);
                }
            }
            bf16_t* ub = U + (size_t)((chf + dir) * NCH + n) * 128 * DK;
#pragma unroll
            for (int i = 0; i < 2; ++i)
#pragma unroll
                for (int nt = 0; nt < DK / 16; ++nt) {
                    const int e = (2 * wid + i) * 16 + lr, d = nt * 16 + lq * 4;
                    u32x2 o; o.x = cvt_pk(acc[i][nt].x, acc[i][nt].y); o.y = cvt_pk(acc[i][nt].z, acc[i][nt].w);
                    *(u32x2*)(ub + (size_t)e * DK + d) = o;
                }
        }
        if (tid < 2 * DK) {
            const int dir = tid / DK, d = tid % DK; const int n = scan_index(dir, c);
            if ((dmask >> dir) & 1) {
            DEC[(size_t)((chf + dir) * NCH + n) * 128 + d] = __expf(dir == 0 ? totf : totb);
            if (TYPE == 1) {
                const bf16_t* kT = dir == 0 ? kT0 : kT1;
                float sum = 0.f;
#pragma unroll
                for (int q = 0; q < 8; ++q) { const u32x4 u = *(const u32x4*)(kT + (size_t)d * 80 + q * 8); float f[8]; UNPACK8(u, f);
#pragma unroll
                    for (int j = 0; j < 8; ++j) sum += f[j]; }
                UN[(size_t)((chf + dir) * NCH + n) * 128 + d] = sum;
            }
            }
        }
        __syncthreads();
    }
}

template <int DK, bool HASN>
__device__ __forceinline__ void scan_phase(const Params& P) {
    bf16_t* U = (bf16_t*)(ws_l(P) + WS_SBUF); const float* DEC = (const float*)(ws_l(P) + WS_DEC); float* UN = (float*)(ws_l(P) + WS_UN);
    constexpr int VEC = DK / 64;
    constexpr int DQ = DK / VEC; constexpr int TT = 16 * 128 * DQ;
    constexpr size_t US = (size_t)128 * DK;
    for (int g = bid_l() * NTHR + tid_l(); g < TT; g += vgrid() * NTHR) {
        const int dq = g % DQ, e = (g / DQ) % 128, chain = g / (DQ * 128);
        bf16_t* up = U + ((size_t)chain * NCH * 128 + e) * DK + dq * VEC;
        const float* dp = DEC + (size_t)chain * NCH * 128 + dq * VEC;
        float S0 = 0.f, S1 = 0.f;
        constexpr int SB = 12;
        unsigned ua[SB], ubv[SB]; f32x2 da[SB], db[SB];
#define SC_LOAD(uu, dd, n0) do { _Pragma("unroll") for (int j = 0; j < SB; ++j) { \
            if (VEC == 2) { uu[j] = *(const unsigned*)(up + (size_t)((n0) + j) * US); dd[j] = *(const f32x2*)(dp + (size_t)((n0) + j) * 128); } \
            else { uu[j] = (unsigned)up[(size_t)((n0) + j) * US]; dd[j].x = dp[(size_t)((n0) + j) * 128]; dd[j].y = 0.f; } } } while (0)
#define SC_STEP(uu, dd, n0) do { _Pragma("unroll") for (int j = 0; j < SB; ++j) { \
            if (VEC == 2) { *(unsigned*)(up + (size_t)((n0) + j) * US) = cvt_pk(S0, S1); S0 = dd[j].x * S0 + bflo(uu[j]); S1 = dd[j].y * S1 + bfhi(uu[j]); } \
            else { up[(size_t)((n0) + j) * US] = (bf16_t)(cvt_pk(S0, 0.f) & 0xffffu); S0 = dd[j].x * S0 + bflo(uu[j]); } } } while (0)
        SC_LOAD(ua, da, 0);
        for (int n0 = 0; n0 < 120; n0 += 24) {
            SC_LOAD(ubv, db, n0 + 12);
            SC_STEP(ua, da, n0);
            SC_LOAD(ua, da, n0 + 24);
            SC_STEP(ubv, db, n0 + 12);
        }
        SC_STEP(ua, da, 120);
#undef SC_LOAD
#undef SC_STEP
    }
    if (HASN) {
        for (int g = bid_l() * NTHR + tid_l(); g < 16 * 128; g += vgrid() * NTHR) {
            const int d = g & 127, chain = g >> 7;
            float* np = UN + (size_t)chain * NCH * 128 + d; const float* dp = DEC + (size_t)chain * NCH * 128 + d;
            float S = 0.f;
            float ua_[12], da_[12], ub_[12], db_[12];
#define NS_LOAD(uu, dd, n0) do { _Pragma("unroll") for (int j = 0; j < 12; ++j) { uu[j] = np[(size_t)((n0) + j) * 128]; dd[j] = dp[(size_t)((n0) + j) * 128]; } } while (0)
#define NS_STEP(uu, dd, n0) do { _Pragma("unroll") for (int j = 0; j < 12; ++j) { np[(size_t)((n0) + j) * 128] = S; S = dd[j] * S + uu[j]; } } while (0)
            NS_LOAD(ua_, da_, 0);
            for (int n0 = 0; n0 < 120; n0 += 24) {
                NS_LOAD(ub_, db_, n0 + 12);
                NS_STEP(ua_, da_, n0);
                NS_LOAD(ua_, da_, n0 + 24);
                NS_STEP(ub_, db_, n0 + 12);
            }
            NS_STEP(ua_, da_, 120);
#undef NS_LOAD
#undef NS_STEP
        }
    }
}

template <int TYPE>
__device__ __forceinline__ void out_phase(const Params& P, int l, int pass, bool latent_only, char* lds) {
    typedef MX<TYPE> M; constexpr int DK = M::DK; constexpr int QP = M::QP;
    const int tid = tid_l(), lane = tid & 63, wid = tid >> 6, lr = lane & 15, lq = lane >> 4;
    const bf16_t* pb = (const bf16_t*)(ws_l(P) + WS_PBUF);
    const bf16_t* U = (const bf16_t*)(ws_l(P) + WS_SBUF); const float* UN = (const float*)(ws_l(P) + WS_UN);
    bf16_t* brp = (bf16_t*)(ws_l(P) + WS_BR);
    bf16_t* vT = (bf16_t*)(lds + L_VT); bf16_t* qin = (bf16_t*)(lds + L_Q); bf16_t* kin = qin + 64 * QP; bf16_t* att = (bf16_t*)(lds + L_ATT);
    const float* cum = (const float*)(lds + L_CUM); const float* sc = (const float*)(lds + L_SC);
    const float* ng = P.in[TYPE == 0 ? I_GNG : (TYPE == 1 ? I_MNG : I_RNG)] + l * 512;
    const int NC = latent_only ? NCH - 4 : NCH; const int NU = NB * 4 * NC, VG = vgrid(), slot = bid_l();
    for (int u0 = 0; u0 < NU; u0 += VG) {
        int unit = u0 + slot; if (unit >= NU) unit = NU - 1;
        const int c = unit % NC + (latent_only ? 4 : 0); const int rest = unit / NC; const int h = rest & 3, b = rest >> 2;
        const int r0 = rowbase(b, c);
        build_vT<TYPE>(pb, b, c, h, lds);
        f32x4 tot[8];
#pragma unroll
        for (int et = 0; et < 8; ++et) tot[et] = (f32x4){0.f, 0.f, 0.f, 0.f};
        const int trow = wid * 16 + lr;
        for (int dir = 0; dir < 2; ++dir) {
            const int chain = (b * 4 + h) * 2 + dir, n = scan_index(dir, c);
            decay_setup<TYPE>(P, l, b, c, h, dir, lds);
#pragma unroll 2
            for (int i = 0; i < 64 * M::NOC / NTHR; ++i) {
                const int pid = tid + i * NTHR, t = pid / M::NOC, oc = pid % M::NOC;
                float q8[8], k8[8];
                load_qk8<TYPE>(P, l, pb, b, c, t, h, oc, false, q8);
                load_qk8<TYPE>(P, l, pb, b, c, t, h, oc, true, k8);
                if (TYPE == 0) {
#pragma unroll
                    for (int j = 0; j < 8; ++j) { const float cv = cum[t * 64 + oc * 8 + j]; q8[j] *= __expf(cv) * 0.125f; k8[j] *= __expf(-cv); }
                } else {
                    const float cv = sc[t];
                    const float wq = __expf(cv);
                    const float wk = TYPE == 1 ? __expf(sc[64 + t] - cv) * 0.08838834764831845f : __expf(-cv) * 0.125f;
#pragma unroll
                    for (int j = 0; j < 8; ++j) { q8[j] *= wq; k8[j] *= wk; }
                }
                u32x4 oq, ok;
                oq.x = cvt_pk(q8[0], q8[1]); oq.y = cvt_pk(q8[2], q8[3]); oq.z = cvt_pk(q8[4], q8[5]); oq.w = cvt_pk(q8[6], q8[7]);
                ok.x = cvt_pk(k8[0], k8[1]); ok.y = cvt_pk(k8[2], k8[3]); ok.z = cvt_pk(k8[4], k8[5]); ok.w = cvt_pk(k8[6], k8[7]);
                *(u32x4*)(qin + (size_t)t * QP + oc * 8) = oq;
                *(u32x4*)(kin + (size_t)t * QP + oc * 8) = ok;
            }
            __syncthreads();
            f32x4 sacc[4];
#pragma unroll
            for (int nt = 0; nt < 4; ++nt) sacc[nt] = (f32x4){0.f, 0.f, 0.f, 0.f};
#pragma unroll
            for (int kk = 0; kk < DK / 32; ++kk) {
                const bf16x8 fq = *(const bf16x8*)(qin + (size_t)trow * QP + kk * 32 + lq * 8);
#pragma unroll
                for (int nt = 0; nt < 4; ++nt) {
                    const bf16x8 fk = *(const bf16x8*)(kin + (size_t)(nt * 16 + lr) * QP + kk * 32 + lq * 8);
                    sacc[nt] = __builtin_amdgcn_mfma_f32_16x16x32_bf16(fk, fq, sacc[nt], 0, 0, 0);
                }
            }
            float den = 0.f;
#pragma unroll
            for (int nt = 0; nt < 4; ++nt) {
                const int s0 = nt * 16 + lq * 4;
                float a0 = sacc[nt].x, a1 = sacc[nt].y, a2 = sacc[nt].z, a3 = sacc[nt].w;
                if (dir == 0) { if (s0 + 0 > trow) a0 = 0.f; if (s0 + 1 > trow) a1 = 0.f; if (s0 + 2 > trow) a2 = 0.f; if (s0 + 3 > trow) a3 = 0.f; }
                else { if (s0 + 0 < trow) a0 = 0.f; if (s0 + 1 < trow) a1 = 0.f; if (s0 + 2 < trow) a2 = 0.f; if (s0 + 3 < trow) a3 = 0.f; }
                den += (a0 + a1) + (a2 + a3);
                u32x2 o; o.x = cvt_pk(a0, a1); o.y = cvt_pk(a2, a3);
                *(u32x2*)(att + (size_t)trow * 80 + s0) = o;
            }
            __syncthreads();
            f32x4 oacc[8];
#pragma unroll
            for (int et = 0; et < 8; ++et) oacc[et] = (f32x4){0.f, 0.f, 0.f, 0.f};
#pragma unroll
            for (int kk = 0; kk < 2; ++kk) {
                const bf16x8 fa = *(const bf16x8*)(att + (size_t)trow * 80 + kk * 32 + lq * 8);
#pragma unroll
                for (int et = 0; et < 8; ++et) {
                    const bf16x8 fv = *(const bf16x8*)(vT + (size_t)(et * 16 + lr) * 80 + kk * 32 + lq * 8);
                    oacc[et] = __builtin_amdgcn_mfma_f32_16x16x32_bf16(fv, fa, oacc[et], 0, 0, 0);
                }
            }
            const bf16_t* sp = U + (size_t)(chain * NCH + n) * 128 * DK;
#pragma unroll
            for (int kk = 0; kk < DK / 32; ++kk) {
                const bf16x8 fq = *(const bf16x8*)(qin + (size_t)trow * QP + kk * 32 + lq * 8);
#pragma unroll
                for (int et = 0; et < 8; ++et) {
                    const bf16x8 fs = *(const bf16x8*)(sp + (size_t)(et * 16 + lr) * DK + kk * 32 + lq * 8);
                    oacc[et] = __builtin_amdgcn_mfma_f32_16x16x32_bf16(fs, fq, oacc[et], 0, 0, 0);
                }
            }
            if (TYPE == 1) {
                const float* np = UN + (size_t)(chain * NCH + n) * 128 + lq * 32;
#pragma unroll
                for (int q = 0; q < 4; ++q) {
                    const u32x4 u = *(const u32x4*)(qin + (size_t)trow * QP + lq * 32 + q * 8); float f[8]; UNPACK8(u, f);
                    const f32x4 n0 = *(const f32x4*)(np + q * 8), n1 = *(const f32x4*)(np + q * 8 + 4);
                    den += f[0] * n0.x + f[1] * n0.y + f[2] * n0.z + f[3] * n0.w + f[4] * n1.x + f[5] * n1.y + f[6] * n1.z + f[7] * n1.w;
                }
                den += __shfl_xor(den, 16); den += __shfl_xor(den, 32);
                const float sc1 = 1.f / fmaxf(fabsf(den), 1.f);
#pragma unroll
                for (int et = 0; et < 8; ++et) tot[et] += oacc[et] * sc1;
            } else {
#pragma unroll
                for (int et = 0; et < 8; ++et) tot[et] += oacc[et];
            }
            __syncthreads();
        }
        float s1 = 0.f;
#pragma unroll
        for (int et = 0; et < 8; ++et) s1 += (tot[et].x + tot[et].y) + (tot[et].z + tot[et].w);
        s1 += __shfl_xor(s1, 16); s1 += __shfl_xor(s1, 32);
        const float mean = TYPE == 0 ? 0.f : s1 * (1.f / 128.f);
        float s2 = 0.f;
#pragma unroll
        for (int et = 0; et < 8; ++et) { tot[et] = tot[et] - mean; s2 += (tot[et].x * tot[et].x + tot[et].y * tot[et].y) + (tot[et].z * tot[et].z + tot[et].w * tot[et].w); }
        s2 += __shfl_xor(s2, 16); s2 += __shfl_xor(s2, 32);
        const float rstd = rsqrtf(s2 * (1.f / 128.f) + 1e-6f);
        const size_t rowi = (size_t)(r0 + trow);
#pragma unroll
        for (int et = 0; et < 8; ++et) {
            const int e = et * 16 + lq * 4;
            const f32x4 gg = *(const f32x4*)(ng + h * 128 + e);
            const u32x2 gu = *(const u32x2*)(pb + rowi * M::PITCH + M::GOFF + h * 128 + e);
            const float g0 = bflo(gu.x), g1 = bfhi(gu.x), g2 = bflo(gu.y), g3 = bfhi(gu.y);
            u32x2 o;
            float y0 = tot[et].x * rstd * gg.x * siluf(g0), y1 = tot[et].y * rstd * gg.y * siluf(g1), y2 = tot[et].z * rstd * gg.z * siluf(g2), y3 = tot[et].w * rstd * gg.w * siluf(g3);
            o.x = cvt_pk(y0, y1); o.y = cvt_pk(y2, y3);
            *(u32x2*)(brp + rowi * 1536 + pass * 512 + h * 128 + e) = o;
        }
        __syncthreads();
    }
}

template <int TYPE>
__device__ __forceinline__ void out_phase_s(const Params& P, int l, int pass, bool latent_only, char* lds) {
    typedef MX<TYPE> M; constexpr int DK = M::DK; constexpr int QP = M::QP; constexpr int NKK = DK / 32;
    const bf16_t* pb = (const bf16_t*)(ws_l(P) + WS_PBUF);
    const bf16_t* U = (const bf16_t*)(ws_l(P) + WS_SBUF); const float* UN = (const float*)(ws_l(P) + WS_UN);
    const float* small = (const float*)(ws_l(P) + WS_SMALL);
    bf16_t* brp = (bf16_t*)(ws_l(P) + WS_BR);
    bf16_t* vT = (bf16_t*)(lds + L_VT); bf16_t* qr = (bf16_t*)(lds + L_Q); bf16_t* kr = qr + 64 * QP; bf16_t* att = (bf16_t*)(lds + L_ATT);
    float* sc = (float*)(lds + L_SC);
    float* sn = sc + 256;
    float* rsv = sc + 512;
    float* part = sc + 640;
    const float* ng = P.in[TYPE == 1 ? I_MNG : I_RNG] + l * 512;
    const int NC = latent_only ? NCH - 4 : NCH; const int NU = NB * 4 * NC, VG = vgrid(), slot = bid_l();
    for (int u0 = 0; u0 < NU; u0 += VG) {
        int unit = u0 + slot; if (unit >= NU) unit = NU - 1;
        const int tid = tid_l(), lane = tid & 63, wid = tid >> 6, lr = lane & 15, lq = lane >> 4;
        const int c = unit % NC + (latent_only ? 4 : 0); const int rest = unit / NC; const int h = rest & 3, b = rest >> 2;
        const int r0 = rowbase(b, c);
        const int trow = wid * 16 + lr;
        const int chf = (b * 4 + h) * 2, nf = scan_index(0, c), nb = scan_index(1, c);
        if (TYPE == 1) {
            sn[tid] = UN[(size_t)((chf + (tid >> 7)) * NCH + ((tid >> 7) == 0 ? nf : nb)) * 128 + (tid & 127)];
            if (tid < 128) {
                const int dir = tid >> 6, t = tid & 63;
                const float fg = small[(size_t)(r0 + t) * 48 + 40 + dir * 4 + h] + P.in[I_FB][l * 8 + dir * 4 + h];
                float v = logsig(fg);
                if (dir == 0) {
#pragma unroll
                    for (int o = 1; o < 64; o <<= 1) { const float n = __shfl_up(v, o); if (t >= o) v += n; }
                } else {
#pragma unroll
                    for (int o = 1; o < 64; o <<= 1) { const float n = __shfl_down(v, o); if (t + o < 64) v += n; }
                }
                sc[dir * 64 + t] = v;
                sc[128 + dir * 64 + t] = small[(size_t)(r0 + t) * 48 + 32 + dir * 4 + h] + P.in[I_IB][l * 8 + dir * 4 + h];
            }
        } else {
            if (tid < 64) {
                const float lg0 = logsig(P.in[I_RDL][l * 8 + h]), lg1 = logsig(P.in[I_RDL][l * 8 + 4 + h]);
                sc[tid] = (float)(tid + 1) * lg0; sc[64 + tid] = (float)(64 - tid) * lg1;
            }
        }
        float wq[24], wk[24];
        if (TYPE == 1) { load_convw(P, l, h, tid % M::NOC, false, wq); load_convw(P, l, h, tid % M::NOC, true, wk); }
        build_vT<TYPE>(pb, b, c, h, lds);
#pragma unroll
        for (int i = 0; i < 64 * M::NOC / NTHR; ++i) {
            const int pid = tid + i * NTHR, t = pid / M::NOC, oc = pid % M::NOC;
            float q8[8], k8[8];
            load_qk8<TYPE>(P, l, pb, b, c, t, h, oc, false, q8, TYPE == 1 ? wq : nullptr);
            load_qk8<TYPE>(P, l, pb, b, c, t, h, oc, true, k8, TYPE == 1 ? wk : nullptr);
            const float ks = TYPE == 1 ? 0.08838834764831845f : 0.125f;
            u32x4 oq, ok;
            oq.x = cvt_pk(q8[0], q8[1]); oq.y = cvt_pk(q8[2], q8[3]); oq.z = cvt_pk(q8[4], q8[5]); oq.w = cvt_pk(q8[6], q8[7]);
            ok.x = cvt_pk(k8[0] * ks, k8[1] * ks); ok.y = cvt_pk(k8[2] * ks, k8[3] * ks); ok.z = cvt_pk(k8[4] * ks, k8[5] * ks); ok.w = cvt_pk(k8[6] * ks, k8[7] * ks);
            *(u32x4*)(qr + (size_t)t * QP + oc * 8) = oq;
            *(u32x4*)(kr + (size_t)t * QP + oc * 8) = ok;
        }
        const bf16_t* spf = U + (size_t)(chf * NCH + nf) * 128 * DK; const bf16_t* spb = U + (size_t)((chf + 1) * NCH + nb) * 128 * DK;
        bf16x8 fsf[2][NKK], fsb[2][NKK];
#pragma unroll
        for (int i = 0; i < 2; ++i)
#pragma unroll
            for (int kk = 0; kk < NKK; ++kk) {
                fsf[i][kk] = *(const bf16x8*)(spf + (size_t)((2 * wid + i) * 16 + lr) * DK + kk * 32 + lq * 8);
                fsb[i][kk] = *(const bf16x8*)(spb + (size_t)((2 * wid + i) * 16 + lr) * DK + kk * 32 + lq * 8);
            }
        u32x2 gu[4][2];
#pragma unroll
        for (int mt = 0; mt < 4; ++mt)
#pragma unroll
            for (int i = 0; i < 2; ++i) gu[mt][i] = *(const u32x2*)(pb + (size_t)(r0 + mt * 16 + lr) * M::PITCH + M::GOFF + h * 128 + (2 * wid + i) * 16 + lq * 4);
        __syncthreads();
        f32x4 sacc[4];
#pragma unroll
        for (int nt = 0; nt < 4; ++nt) sacc[nt] = (f32x4){0.f, 0.f, 0.f, 0.f};
#pragma unroll
        for (int kk = 0; kk < NKK; ++kk) {
            const bf16x8 fq = *(const bf16x8*)(qr + (size_t)trow * QP + kk * 32 + lq * 8);
#pragma unroll
            for (int nt = 0; nt < 4; ++nt) {
                const bf16x8 fk = *(const bf16x8*)(kr + (size_t)(nt * 16 + lr) * QP + kk * 32 + lq * 8);
                sacc[nt] = __builtin_amdgcn_mfma_f32_16x16x32_bf16(fk, fq, sacc[nt], 0, 0, 0);
            }
        }
        {
            const float cft = sc[trow], cbt = sc[64 + trow];
            const float eft = __expf(cft), ebt = __expf(cbt);
            float af[4][4], ab[4][4]; float denf = 0.f, denb = 0.f;
#pragma unroll
            for (int nt = 0; nt < 4; ++nt) {
                const float av[4] = {sacc[nt].x, sacc[nt].y, sacc[nt].z, sacc[nt].w};
#pragma unroll
                for (int r = 0; r < 4; ++r) {
                    const int s_ = nt * 16 + lq * 4 + r;
                    const float argf = cft - sc[s_] + (TYPE == 1 ? sc[128 + s_] : 0.f), argb = cbt - sc[64 + s_] + (TYPE == 1 ? sc[192 + s_] : 0.f);
                    const float wf = s_ <= trow ? __expf(argf) : 0.f, wb = s_ >= trow ? __expf(argb) : 0.f;
                    af[nt][r] = av[r] * wf; ab[nt][r] = av[r] * wb; denf += af[nt][r]; denb += ab[nt][r];
                }
            }
            float scf = 1.f, scb = 1.f;
            if (TYPE == 1) {
                float qf = 0.f, qb = 0.f;
#pragma unroll
                for (int q = 0; q < 4; ++q) {
                    const u32x4 u = *(const u32x4*)(qr + (size_t)trow * QP + lq * 32 + q * 8); float f[8]; UNPACK8(u, f);
                    const float* a = sn + lq * 32 + q * 8; const float* bq = sn + 128 + lq * 32 + q * 8;
                    const f32x4 a0 = *(const f32x4*)a, a1 = *(const f32x4*)(a + 4), b0 = *(const f32x4*)bq, b1 = *(const f32x4*)(bq + 4);
                    qf += f[0] * a0.x + f[1] * a0.y + f[2] * a0.z + f[3] * a0.w + f[4] * a1.x + f[5] * a1.y + f[6] * a1.z + f[7] * a1.w;
                    qb += f[0] * b0.x + f[1] * b0.y + f[2] * b0.z + f[3] * b0.w + f[4] * b1.x + f[5] * b1.y + f[6] * b1.z + f[7] * b1.w;
                }
                denf += eft * qf; denb += ebt * qb;
                denf += __shfl_xor(denf, 16); denf += __shfl_xor(denf, 32);
                denb += __shfl_xor(denb, 16); denb += __shfl_xor(denb, 32);
                scf = 1.f / fmaxf(fabsf(denf), 1.f); scb = 1.f / fmaxf(fabsf(denb), 1.f);
            }
#pragma unroll
            for (int nt = 0; nt < 4; ++nt) {
                u32x2 o; o.x = cvt_pk(af[nt][0] * scf + ab[nt][0] * scb, af[nt][1] * scf + ab[nt][1] * scb); o.y = cvt_pk(af[nt][2] * scf + ab[nt][2] * scb, af[nt][3] * scf + ab[nt][3] * scb);
                *(u32x2*)(att + (size_t)trow * 80 + nt * 16 + lq * 4) = o;
            }
            if (lq == 0) { rsv[trow] = eft * scf; rsv[64 + trow] = ebt * scb; }
        }
        __syncthreads();
        f32x4 oacc[4][2];
#pragma unroll
        for (int mt = 0; mt < 4; ++mt)
#pragma unroll
            for (int i = 0; i < 2; ++i) oacc[mt][i] = (f32x4){0.f, 0.f, 0.f, 0.f};
#pragma unroll
        for (int kk = 0; kk < 2; ++kk) {
            bf16x8 fv[2];
#pragma unroll
            for (int i = 0; i < 2; ++i) fv[i] = *(const bf16x8*)(vT + (size_t)((2 * wid + i) * 16 + lr) * 80 + kk * 32 + lq * 8);
#pragma unroll
            for (int mt = 0; mt < 4; ++mt) {
                const bf16x8 fa = *(const bf16x8*)(att + (size_t)(mt * 16 + lr) * 80 + kk * 32 + lq * 8);
#pragma unroll
                for (int i = 0; i < 2; ++i) oacc[mt][i] = __builtin_amdgcn_mfma_f32_16x16x32_bf16(fv[i], fa, oacc[mt][i], 0, 0, 0);
            }
        }
#pragma unroll
        for (int dir = 0; dir < 2; ++dir) {
            f32x4 tmp[4][2];
#pragma unroll
            for (int mt = 0; mt < 4; ++mt)
#pragma unroll
                for (int i = 0; i < 2; ++i) tmp[mt][i] = (f32x4){0.f, 0.f, 0.f, 0.f};
#pragma unroll
            for (int kk = 0; kk < NKK; ++kk)
#pragma unroll
                for (int mt = 0; mt < 4; ++mt) {
                    const bf16x8 fq = *(const bf16x8*)(qr + (size_t)(mt * 16 + lr) * QP + kk * 32 + lq * 8);
#pragma unroll
                    for (int i = 0; i < 2; ++i) tmp[mt][i] = __builtin_amdgcn_mfma_f32_16x16x32_bf16(dir == 0 ? fsf[i][kk] : fsb[i][kk], fq, tmp[mt][i], 0, 0, 0);
                }
#pragma unroll
            for (int mt = 0; mt < 4; ++mt) {
                const float rs = rsv[dir * 64 + mt * 16 + lr];
#pragma unroll
                for (int i = 0; i < 2; ++i) oacc[mt][i] += tmp[mt][i] * rs;
            }
        }
#pragma unroll
        for (int mt = 0; mt < 4; ++mt) {
            float s1 = (oacc[mt][0].x + oacc[mt][0].y) + (oacc[mt][0].z + oacc[mt][0].w) + (oacc[mt][1].x + oacc[mt][1].y) + (oacc[mt][1].z + oacc[mt][1].w);
            float s2 = (oacc[mt][0].x * oacc[mt][0].x + oacc[mt][0].y * oacc[mt][0].y) + (oacc[mt][0].z * oacc[mt][0].z + oacc[mt][0].w * oacc[mt][0].w)
                     + (oacc[mt][1].x * oacc[mt][1].x + oacc[mt][1].y * oacc[mt][1].y) + (oacc[mt][1].z * oacc[mt][1].z + oacc[mt][1].w * oacc[mt][1].w);
            s1 += __shfl_xor(s1, 16); s1 += __shfl_xor(s1, 32); s2 += __shfl_xor(s2, 16); s2 += __shfl_xor(s2, 32);
            if (lq == 0) { part[(wid * 64 + mt * 16 + lr) * 2] = s1; part[(wid * 64 + mt * 16 + lr) * 2 + 1] = s2; }
        }
        __syncthreads();
#pragma unroll
        for (int mt = 0; mt < 4; ++mt) {
            const int t = mt * 16 + lr;
            float s1 = 0.f, s2 = 0.f;
#pragma unroll
            for (int w = 0; w < 4; ++w) { s1 += part[(w * 64 + t) * 2]; s2 += part[(w * 64 + t) * 2 + 1]; }
            const float mean = s1 * (1.f / 128.f);
            const float rstd = rsqrtf(fmaxf(s2 * (1.f / 128.f) - mean * mean, 0.f) + 1e-6f);
            const size_t rowi = (size_t)(r0 + t);
#pragma unroll
            for (int i = 0; i < 2; ++i) {
                const int e = (2 * wid + i) * 16 + lq * 4;
                const f32x4 gg = *(const f32x4*)(ng + h * 128 + e);
                const float g0 = bflo(gu[mt][i].x), g1 = bfhi(gu[mt][i].x), g2 = bflo(gu[mt][i].y), g3 = bfhi(gu[mt][i].y);
                u32x2 o;
                o.x = cvt_pk((oacc[mt][i].x - mean) * rstd * gg.x * siluf(g0), (oacc[mt][i].y - mean) * rstd * gg.y * siluf(g1));
                o.y = cvt_pk((oacc[mt][i].z - mean) * rstd * gg.z * siluf(g2), (oacc[mt][i].w - mean) * rstd * gg.w * siluf(g3));
                *(u32x2*)(brp + rowi * 1536 + pass * 512 + h * 128 + e) = o;
            }
        }
        __syncthreads();
    }
}

__device__ __forceinline__ void out_phase_g(const Params& P, int l, bool latent_only, char* lds) {
    typedef MX<0> M; constexpr int DK = 64, QP = 80;
    const bf16_t* pb = (const bf16_t*)(ws_l(P) + WS_PBUF);
    const bf16_t* U = (const bf16_t*)(ws_l(P) + WS_SBUF);
    const float* small = (const float*)(ws_l(P) + WS_SMALL);
    bf16_t* brp = (bf16_t*)(ws_l(P) + WS_BR);
    bf16_t* vT = (bf16_t*)(lds + L_VT); bf16_t* qin = (bf16_t*)(lds + L_Q); bf16_t* kin = qin + 64 * QP; bf16_t* att = (bf16_t*)(lds + L_ATT);
    float* cum = (float*)(lds + L_CUM); float* part = cum;
    const float* ng = P.in[I_GNG] + l * 512;
    const int NC = latent_only ? NCH - 4 : NCH; const int NU = NB * 4 * NC, VG = vgrid(), slot = bid_l();
    for (int u0 = 0; u0 < NU; u0 += VG) {
        int unit = u0 + slot; if (unit >= NU) unit = NU - 1;
        const int tid = tid_l(), lane = tid & 63, wid = tid >> 6, lr = lane & 15, lq = lane >> 4;
        const int c = unit % NC + (latent_only ? 4 : 0); const int rest = unit / NC; const int h = rest & 3, b = rest >> 2;
        const int r0 = rowbase(b, c);
        const int trow = wid * 16 + lr;
        const int chf = (b * 4 + h) * 2, nf = scan_index(0, c), nb = scan_index(1, c);
        float qraw[2][8], kraw[2][8], apre[2][4];
#pragma unroll
        for (int i = 0; i < 2; ++i) {
            const int pid = tid + i * NTHR, t = pid >> 3, oc = pid & 7;
            load_qk8<0>(P, l, pb, b, c, t, h, oc, false, qraw[i]);
            load_qk8<0>(P, l, pb, b, c, t, h, oc, true, kraw[i]);
        }
#pragma unroll
        for (int dir = 0; dir < 2; ++dir)
#pragma unroll
            for (int k = 0; k < 4; ++k) { const int i = tid + k * NTHR; apre[dir][k] = small[(size_t)(r0 + (i >> 4)) * 48 + dir * 16 + (i & 15)]; }
        build_vT<0>(pb, b, c, h, lds);
        const bf16_t* spf = U + (size_t)(chf * NCH + nf) * 128 * DK; const bf16_t* spb = U + (size_t)((chf + 1) * NCH + nb) * 128 * DK;
        bf16x8 fsf[2][2], fsb[2][2];
#pragma unroll
        for (int i = 0; i < 2; ++i)
#pragma unroll
            for (int kk = 0; kk < 2; ++kk) {
                fsf[i][kk] = *(const bf16x8*)(spf + (size_t)((2 * wid + i) * 16 + lr) * DK + kk * 32 + lq * 8);
                fsb[i][kk] = *(const bf16x8*)(spb + (size_t)((2 * wid + i) * 16 + lr) * DK + kk * 32 + lq * 8);
            }
        u32x2 gu[4][2];
#pragma unroll
        for (int mt = 0; mt < 4; ++mt)
#pragma unroll
            for (int i = 0; i < 2; ++i) gu[mt][i] = *(const u32x2*)(pb + (size_t)(r0 + mt * 16 + lr) * M::PITCH + M::GOFF + h * 128 + (2 * wid + i) * 16 + lq * 4);
        f32x4 oacc[4][2];
#pragma unroll
        for (int mt = 0; mt < 4; ++mt)
#pragma unroll
            for (int i = 0; i < 2; ++i) oacc[mt][i] = (f32x4){0.f, 0.f, 0.f, 0.f};
#pragma unroll
        for (int dir = 0; dir < 2; ++dir) {
            decay_setup<0>(P, l, b, c, h, dir, lds, apre[dir]);
#pragma unroll
            for (int i = 0; i < 2; ++i) {
                const int pid = tid + i * NTHR, t = pid >> 3, oc = pid & 7;
                float q8[8], k8[8];
#pragma unroll
                for (int j = 0; j < 8; ++j) { const float cv = cum[t * 64 + oc * 8 + j]; q8[j] = qraw[i][j] * (__expf(cv) * 0.125f); k8[j] = kraw[i][j] * __expf(-cv); }
                u32x4 oq, ok;
                oq.x = cvt_pk(q8[0], q8[1]); oq.y = cvt_pk(q8[2], q8[3]); oq.z = cvt_pk(q8[4], q8[5]); oq.w = cvt_pk(q8[6], q8[7]);
                ok.x = cvt_pk(k8[0], k8[1]); ok.y = cvt_pk(k8[2], k8[3]); ok.z = cvt_pk(k8[4], k8[5]); ok.w = cvt_pk(k8[6], k8[7]);
                *(u32x4*)(qin + (size_t)t * QP + oc * 8) = oq;
                *(u32x4*)(kin + (size_t)t * QP + oc * 8) = ok;
            }
            __syncthreads();
            f32x4 sacc[4];
#pragma unroll
            for (int nt = 0; nt < 4; ++nt) sacc[nt] = (f32x4){0.f, 0.f, 0.f, 0.f};
#pragma unroll
            for (int kk = 0; kk < 2; ++kk) {
                const bf16x8 fq = *(const bf16x8*)(qin + (size_t)trow * QP + kk * 32 + lq * 8);
#pragma unroll
                for (int nt = 0; nt < 4; ++nt) {
                    const bf16x8 fk = *(const bf16x8*)(kin + (size_t)(nt * 16 + lr) * QP + kk * 32 + lq * 8);
                    sacc[nt] = __builtin_amdgcn_mfma_f32_16x16x32_bf16(fk, fq, sacc[nt], 0, 0, 0);
                }
            }
#pragma unroll
            for (int nt = 0; nt < 4; ++nt) {
                const int s0 = nt * 16 + lq * 4;
                float a0 = sacc[nt].x, a1 = sacc[nt].y, a2 = sacc[nt].z, a3 = sacc[nt].w;
                if (dir == 0) { if (s0 + 0 > trow) a0 = 0.f; if (s0 + 1 > trow) a1 = 0.f; if (s0 + 2 > trow) a2 = 0.f; if (s0 + 3 > trow) a3 = 0.f; }
                else { if (s0 + 0 < trow) a0 = 0.f; if (s0 + 1 < trow) a1 = 0.f; if (s0 + 2 < trow) a2 = 0.f; if (s0 + 3 < trow) a3 = 0.f; }
                u32x2 o; o.x = cvt_pk(a0, a1); o.y = cvt_pk(a2, a3);
                *(u32x2*)(att + (size_t)trow * 80 + s0) = o;
            }
            __syncthreads();
#pragma unroll
            for (int kk = 0; kk < 2; ++kk) {
                bf16x8 fv[2];
#pragma unroll
                for (int i = 0; i < 2; ++i) fv[i] = *(const bf16x8*)(vT + (size_t)((2 * wid + i) * 16 + lr) * 80 + kk * 32 + lq * 8);
#pragma unroll
                for (int mt = 0; mt < 4; ++mt) {
                    const bf16x8 fa = *(const bf16x8*)(att + (size_t)(mt * 16 + lr) * 80 + kk * 32 + lq * 8);
                    const bf16x8 fq = *(const bf16x8*)(qin + (size_t)(mt * 16 + lr) * QP + kk * 32 + lq * 8);
#pragma unroll
                    for (int i = 0; i < 2; ++i) {
                        oacc[mt][i] = __builtin_amdgcn_mfma_f32_16x16x32_bf16(fv[i], fa, oacc[mt][i], 0, 0, 0);
                        oacc[mt][i] = __builtin_amdgcn_mfma_f32_16x16x32_bf16(dir == 0 ? fsf[i][kk] : fsb[i][kk], fq, oacc[mt][i], 0, 0, 0);
                    }
                }
            }
            __syncthreads();
        }
#pragma unroll
        for (int mt = 0; mt < 4; ++mt) {
            float s2 = (oacc[mt][0].x * oacc[mt][0].x + oacc[mt][0].y * oacc[mt][0].y) + (oacc[mt][0].z * oacc[mt][0].z + oacc[mt][0].w * oacc[mt][0].w)
                     + (oacc[mt][1].x * oacc[mt][1].x + oacc[mt][1].y * oacc[mt][1].y) + (oacc[mt][1].z * oacc[mt][1].z + oacc[mt][1].w * oacc[mt][1].w);
            s2 += __shfl_xor(s2, 16); s2 += __shfl_xor(s2, 32);
            if (lq == 0) part[wid * 64 + mt * 16 + lr] = s2;
        }
        __syncthreads();
#pragma unroll
        for (int mt = 0; mt < 4; ++mt) {
            const int t = mt * 16 + lr;
            const float s2 = (part[t] + part[64 + t]) + (part[128 + t] + part[192 + t]);
            const float rstd = rsqrtf(s2 * (1.f / 128.f) + 1e-6f);
            const size_t rowi = (size_t)(r0 + t);
#pragma unroll
            for (int i = 0; i < 2; ++i) {
                const int e = (2 * wid + i) * 16 + lq * 4;
                const f32x4 gg = *(const f32x4*)(ng + h * 128 + e);
                const float g0 = bflo(gu[mt][i].x), g1 = bfhi(gu[mt][i].x), g2 = bflo(gu[mt][i].y), g3 = bfhi(gu[mt][i].y);
                u32x2 o;
                o.x = cvt_pk(oacc[mt][i].x * rstd * gg.x * siluf(g0), oacc[mt][i].y * rstd * gg.y * siluf(g1));
                o.y = cvt_pk(oacc[mt][i].z * rstd * gg.z * siluf(g2), oacc[mt][i].w * rstd * gg.w * siluf(g3));
                *(u32x2*)(brp + rowi * 1536 + h * 128 + e) = o;
            }
        }
        __syncthreads();
    }
}

template <int NI, class F>
__device__ __forceinline__ void ctx_gemm(const bf16_t* A, int lda, const bf16_t* Bt, int ldb, int K, int N, const F& f, char* lds) {
    const int tid = tid_l(), lane = tid & 63, wid = tid >> 6, wm = wid >> 1, wn = wid & 1, lr = lane & 15, lq = lane >> 4;
    const int Nt = (N + 32 * NI - 1) / (32 * NI);
    const int total = 4 * Nt, VG = vgrid(), slot = bid_l();
    for (int t0 = 0; t0 < total; t0 += VG) {
        const int t = t0 + (VG - 1 - slot); if (t >= total) continue;
        const int tm = t & 3, tn = t >> 2;
        f32x4 acc[4][NI];
#pragma unroll
        for (int mi = 0; mi < 4; ++mi)
#pragma unroll
            for (int ni = 0; ni < NI; ++ni) acc[mi][ni] = (f32x4){0.f, 0.f, 0.f, 0.f};
        gemm_kloop<NI>(acc, A + (size_t)(RL + tm * 128) * lda, lda, Bt + (size_t)tn * (32 * NI) * ldb, ldb, K, lds);
#pragma unroll
        for (int mi = 0; mi < 4; ++mi)
#pragma unroll
            for (int ni = 0; ni < NI; ++ni) f(RL + tm * 128 + wm * 64 + mi * 16 + lr, tn * (32 * NI) + wn * (16 * NI) + ni * 16 + lq * 4, acc[mi][ni], 0);
    }
}
__device__ __forceinline__ void ctx_merge(const Params& P, char* lds) {
    const int tid = tid_l(), lane = tid & 63, wid = tid >> 6, wm = wid >> 1, wn = wid & 1, lr = lane & 15, lq = lane >> 4;
    const bf16_t* br = (const bf16_t*)(ws_l(P) + WS_BR); const bf16_t* wb = (const bf16_t*)(ws_l(P) + WS_WTBR);
    const bf16_t* gs = (const bf16_t*)(ws_l(P) + WS_GS); bf16_t* mb = (bf16_t*)(ws_l(P) + WS_MB);
    const int total = 64, VG = vgrid(), slot = bid_l();
    for (int t0 = 0; t0 < total; t0 += VG) {
        const int t = t0 + (VG - 1 - slot); if (t >= total) continue;
        const int tm = t & 3, tn = t >> 2;
        f32x4 m[4][2];
#pragma unroll
        for (int mi = 0; mi < 4; ++mi)
#pragma unroll
            for (int ni = 0; ni < 2; ++ni) m[mi][ni] = (f32x4){0.f, 0.f, 0.f, 0.f};
#pragma unroll 1
        for (int j = 0; j < 3; ++j) {
            f32x4 acc[4][2];
#pragma unroll
            for (int mi = 0; mi < 4; ++mi)
#pragma unroll
                for (int ni = 0; ni < 2; ++ni) acc[mi][ni] = (f32x4){0.f, 0.f, 0.f, 0.f};
            gemm_kloop<2>(acc, br + (size_t)(RL + tm * 128) * 1536 + j * 512, 1536, wb + ((size_t)j * 1024 + tn * 64) * 512, 512, 512, lds);
#pragma unroll
            for (int mi = 0; mi < 4; ++mi)
#pragma unroll
                for (int ni = 0; ni < 2; ++ni) {
                    const int r = RL + tm * 128 + wm * 64 + mi * 16 + lr, c = tn * 64 + wn * 32 + ni * 16 + lq * 4;
                    const u32x2 g = *(const u32x2*)(gs + (size_t)r * 3072 + j * 1024 + c);
                    m[mi][ni].x += acc[mi][ni].x * bflo(g.x); m[mi][ni].y += acc[mi][ni].y * bfhi(g.x);
                    m[mi][ni].z += acc[mi][ni].z * bflo(g.y); m[mi][ni].w += acc[mi][ni].w * bfhi(g.y);
                }
        }
#pragma unroll
        for (int mi = 0; mi < 4; ++mi)
#pragma unroll
            for (int ni = 0; ni < 2; ++ni) {
                const int r = RL + tm * 128 + wm * 64 + mi * 16 + lr, c = tn * 64 + wn * 32 + ni * 16 + lq * 4;
                u32x2 o; o.x = cvt_pk(m[mi][ni].x, m[mi][ni].y); o.y = cvt_pk(m[mi][ni].z, m[mi][ni].w);
                *(u32x2*)(mb + (size_t)r * 1024 + c) = o;
            }
    }
}


#define XB_TMO      128
#define XB_XCNT(j)  (256  + 64 * (j))
#define XB_XSUB(j)  (1280 + 64 * (j))
#define XB_XGEN(j)  (2304 + 64 * (j))
#define XB_TOP      3328
#define XB_TOPGEN   3392
#define XCD_BAR_WORDS 3456
#define XB_SPIN_CAP (1u << 18)
__device__ __forceinline__ unsigned xb_ld(unsigned* p)              { return __hip_atomic_load(p, __ATOMIC_RELAXED, __HIP_MEMORY_SCOPE_AGENT); }
__device__ __forceinline__ unsigned xb_add(unsigned* p, unsigned v) { return __hip_atomic_fetch_add(p, v, __ATOMIC_RELAXED, __HIP_MEMORY_SCOPE_AGENT); }
__device__ __forceinline__ unsigned xb_xcc_id() { return (unsigned)__builtin_amdgcn_s_getreg((3 << 11) | 20) & 0xFu; }
#define XB_SPIN(cond, bar) do { unsigned _sp = 0; while (cond) { __builtin_amdgcn_s_sleep(1); \
    if ((++_sp & 255u) == 0u) { if (xb_ld(&(bar)[XB_TMO])) break; if (_sp > XB_SPIN_CAP) { atomicAdd(&(bar)[XB_TMO], 1u); break; } } } } while (0)
struct XcdBarrier { unsigned* bar; unsigned x; volatile LAS unsigned* st; };
__device__ __forceinline__ XcdBarrier xcd_barrier_post(unsigned* bar, volatile LAS unsigned* st) {
    XcdBarrier b; b.bar = bar; b.x = xb_xcc_id(); b.st = st;
    if (threadIdx.x == 0) (void)xb_add(&bar[XB_XCNT(b.x)], 1u);
    return b;
}
__device__ __forceinline__ void xcd_barrier_complete(unsigned* bar, unsigned x, unsigned& nloc, unsigned& nx) {
    const unsigned G = gridDim.x * gridDim.y * gridDim.z;
    unsigned sum, cnt, mine, sp = 0u;
    for (;;) {
        sum = 0u; cnt = 0u; mine = 0u;
#pragma unroll
        for (unsigned j = 0; j < 16; ++j) { const unsigned c = xb_ld(&bar[XB_XCNT(j)]); sum += c; cnt += (c > 0u) ? 1u : 0u; mine = (j == x) ? c : mine; }
        if (sum == G) break;
        __builtin_amdgcn_s_sleep(1);
        if ((++sp & 255u) == 0u) { if (xb_ld(&bar[XB_TMO])) break; if (sp > XB_SPIN_CAP) { atomicAdd(&bar[XB_TMO], 1u); break; } }
    }
    nloc = mine > 0u ? mine : 1u; nx = cnt > 0u ? cnt : 1u;
}
__device__ __forceinline__ void xcd_barrier(const XcdBarrier& b) {
    asm volatile("s_waitcnt vmcnt(0)" ::: "memory");
    __syncthreads();
    if (threadIdx.x == 0) {
        unsigned* bar = b.bar;
        __builtin_amdgcn_s_waitcnt(0);
        unsigned nloc = b.st[0], nx = b.st[1];
        if (nloc == 0u) { xcd_barrier_complete(bar, b.x, nloc, nx); b.st[0] = nloc; b.st[1] = nx; }
        const unsigned old = xb_add(&bar[XB_XSUB(b.x)], 1u);
        const unsigned gen = old / nloc;
        if (old + 1u == (gen + 1u) * nloc) {
            __builtin_amdgcn_fence(__ATOMIC_RELEASE, "agent");
            asm volatile("s_waitcnt vmcnt(0)" ::: "memory");
            const unsigned og = xb_add(&bar[XB_TOP], 1u);
            const unsigned tg = og / nx;
            if (og + 1u == (tg + 1u) * nx) xb_add(&bar[XB_TOPGEN], 1u);
            else XB_SPIN(xb_ld(&bar[XB_TOPGEN]) == tg, bar);
            __builtin_amdgcn_fence(__ATOMIC_ACQUIRE, "agent");
            xb_add(&bar[XB_XGEN(b.x)], 1u);
            asm volatile("s_waitcnt vmcnt(0)" ::: "memory");
        } else {
            XB_SPIN(xb_ld(&bar[XB_XGEN(b.x)]) == gen, bar);
            __builtin_amdgcn_fence(__ATOMIC_ACQUIRE, "agent");
            asm volatile("s_waitcnt vmcnt(0)" ::: "memory");
        }
    }
    __syncthreads();
}

__global__ void __launch_bounds__(512, 2) fwd_kernel(Params P) {
    extern __shared__ __attribute__((aligned(16))) unsigned char lds_raw[];
    cg::grid_group grid = cg::this_grid();
    LAS unsigned char* ldsb = (LAS unsigned char*)lds_raw;
#define LDSH ((char*)lds_raw + __builtin_amdgcn_readfirstlane(threadIdx.x >> 8) * HALF_LDS)
    volatile LAS unsigned* bst = (volatile LAS unsigned*)(ldsb + 2 * HALF_LDS);
    if (threadIdx.x < 2) bst[threadIdx.x] = 0u;
    __syncthreads();
    XcdBarrier xbar = xcd_barrier_post((unsigned*)(P.ws + WS_BAR), bst);
    int ph = 0;
#define PHASE_BEGIN if (ph >= P.lo && ph < P.hi) {
#define PHASE_END } ++ph; if (P.coop && ph > P.lo && ph < P.hi) { if (P.coop == 2) grid.sync(); else xcd_barrier(xbar); }

    PHASE_BEGIN
        {
        { const int VG = vgrid(), slot = bid_l();
          for (int i0 = 0; i0 < 384; i0 += VG) { int it = i0 + slot; if (it >= 384) it = 383; mods_task(P, it, LDSH); } }
        if (bid_l() == vgrid() - 1) rope_task(P);
        convert_all(P, 0, LDSH);
        }
    PHASE_END

    const XPtr Xin{(float*)P.in[I_X], (float*)P.in[I_CTX]};
    const XPtr Xcur{P.out, (float*)(P.ws + WS_CTXX)};

    for (int l = 0; l < 2; ++l) {
        const XPtr Xold = l == 0 ? Xin : Xcur;
        const bool ctx_on = (l == 0);
        PHASE_BEGIN
            {
            if (l == 1) convert_all(P, 1, LDSH);
            norm_phase(P, Xold, P.in[I_N1G] + l * D, l, 0, R);
            }
        PHASE_END
        PHASE_BEGIN
            const bf16_t* hb = (const bf16_t*)(ws_l(P) + WS_HBUF); const bf16_t* wt = (const bf16_t*)(ws_l(P) + WS_WTIN);
            EpiP e{(bf16_t*)(ws_l(P) + WS_PBUF), 1536, 1536, (float*)(ws_l(P) + WS_SMALL)};
            {
            big_gemm(ldsb, hb, 1024, wt, 1024, 1792, e);
            ctx_gemm<4>(hb, 1024, wt, 1024, 1024, 1664, e, LDSH); }
        PHASE_END
        PHASE_BEGIN u_phase<0>(P, l, LDSH); PHASE_END
        PHASE_BEGIN scan_phase<64, false>(P); PHASE_END
        PHASE_BEGIN out_phase_g(P, l, !ctx_on, LDSH); PHASE_END
        PHASE_BEGIN
            const bf16_t* hb = (const bf16_t*)(ws_l(P) + WS_HBUF); const bf16_t* wt = (const bf16_t*)(ws_l(P) + WS_WTIN) + (size_t)1792 * 1024;
            EpiP e{(bf16_t*)(ws_l(P) + WS_PBUF), 2048, 2048, nullptr};
            {
            big_gemm(ldsb, hb, 1024, wt, 1024, 2048, e);
            ctx_gemm<2>(hb, 1024, wt, 1024, 1024, 2048, e, LDSH); }
        PHASE_END
        PHASE_BEGIN u_phase_s<1>(P, l, LDSH); PHASE_END
        PHASE_BEGIN scan_phase<128, true>(P); PHASE_END
        PHASE_BEGIN out_phase_s<1>(P, l, 1, !ctx_on, LDSH); PHASE_END
        PHASE_BEGIN
            const bf16_t* hb = (const bf16_t*)(ws_l(P) + WS_HBUF); const bf16_t* wt = (const bf16_t*)(ws_l(P) + WS_WTIN) + (size_t)3840 * 1024;
            EpiP e{(bf16_t*)(ws_l(P) + WS_PBUF), 1536, 1536, nullptr};
            {
            big_gemm(ldsb, hb, 1024, wt, 1024, 1536, e);
            ctx_gemm<4>(hb, 1024, wt, 1024, 1024, 1536, e, LDSH); }
        PHASE_END
        PHASE_BEGIN u_phase_s<2>(P, l, LDSH); PHASE_END
        PHASE_BEGIN scan_phase<64, false>(P); PHASE_END
        PHASE_BEGIN out_phase_s<2>(P, l, 2, !ctx_on, LDSH); PHASE_END
        PHASE_BEGIN
            const bf16_t* hb = (const bf16_t*)(ws_l(P) + WS_HBUF); const bf16_t* wt = (const bf16_t*)(ws_l(P) + WS_WTIN) + (size_t)5376 * 1024;
            EpiSig e{(bf16_t*)(ws_l(P) + WS_GS)};
            {
            big_gemm(ldsb, hb, 1024, wt, 1024, 3072, e);
            if (ctx_on) ctx_gemm<2>(hb, 1024, wt, 1024, 1024, 3072, e, LDSH); }
        PHASE_END
        PHASE_BEGIN
            {   pg8::Gemm g{(const bf16_t*)(ws_l(P) + WS_BR), (const bf16_t*)(ws_l(P) + WS_WTBR), 1536, 512};
                pg8::MergeOrder S; S.S.init(RL, 1024, (int)gridDim.x, (int)blockIdx.x);
                pg8::Epi<EpiMerge> E{EpiMerge{(const bf16_t*)(ws_l(P) + WS_GS), (bf16_t*)(ws_l(P) + WS_MB)}};
                pg8::gemm_phase(ldsb, g, S, E);
                __syncthreads(); }
            if (ctx_on) ctx_merge(P, LDSH);
        PHASE_END
        PHASE_BEGIN
            const float* mods_l = (const float*)(ws_l(P) + WS_MODS) + (size_t)l * 3 * 6144;
            EpiRes e{Xold, Xcur, mods_l, 2};
            big_gemm(ldsb, (const bf16_t*)(ws_l(P) + WS_MB), 1024, (const bf16_t*)(ws_l(P) + WS_WTO), 1024, 1024, e);
            if (ctx_on) ctx_gemm<1>((const bf16_t*)(ws_l(P) + WS_MB), 1024, (const bf16_t*)(ws_l(P) + WS_WTO), 1024, 1024, 1024, e, LDSH);
        PHASE_END
        PHASE_BEGIN norm_phase(P, Xcur, P.in[I_N2G] + l * D, l, 3, ctx_on ? R : RL); PHASE_END
        PHASE_BEGIN
            const bf16_t* hb = (const bf16_t*)(ws_l(P) + WS_HBUF);
            EpiRelu2 e{(bf16_t*)(ws_l(P) + WS_HID)};
            {
            big_gemm(ldsb, hb, 1024, (const bf16_t*)(ws_l(P) + WS_WTUP), 1024, 4096, e);
            if (ctx_on) ctx_gemm<2>(hb, 1024, (const bf16_t*)(ws_l(P) + WS_WTUP), 1024, 1024, 4096, e, LDSH); }
        PHASE_END
        PHASE_BEGIN
            const float* mods_l = (const float*)(ws_l(P) + WS_MODS) + (size_t)l * 3 * 6144;
            EpiRes e{Xcur, Xcur, mods_l, 5};
            big_gemm(ldsb, (const bf16_t*)(ws_l(P) + WS_HID), 4096, (const bf16_t*)(ws_l(P) + WS_WTDN), 4096, 1024, e);
            if (ctx_on) ctx_gemm<1>((const bf16_t*)(ws_l(P) + WS_HID), 4096, (const bf16_t*)(ws_l(P) + WS_WTDN), 4096, 4096, 1024, e, LDSH);
        PHASE_END
    }
    PHASE_BEGIN final_norm_phase(P); PHASE_END
#undef PHASE_BEGIN
#undef PHASE_END
}
constexpr int NPHASES = 1 + 2 * 19 + 1;

extern "C" void kernel_launch(void* const* d_in, const int* in_sizes, int n_in, void* d_out, int out_size, void* d_ws, size_t ws_size, hipStream_t stream) {
    static int grid = 0;
    if (grid == 0) {
        if (n_in != 23 || ws_size < WS_END || out_size != NB * SEQ * D) { fprintf(stderr, "kernel_launch: unexpected sizes n_in %d ws %zu (need %zu) out %d\n", n_in, ws_size, (size_t)WS_END, out_size); grid = -1; return; }
        int dev = 0, cus = 0, per_cu = 0;
        if (hipGetDevice(&dev) != hipSuccess || hipDeviceGetAttribute(&cus, hipDeviceAttributeMultiprocessorCount, dev) != hipSuccess) { grid = -1; return; }
        if (hipFuncSetAttribute((const void*)fwd_kernel, hipFuncAttributeMaxDynamicSharedMemorySize, LDS_BYTES) != hipSuccess) { fprintf(stderr, "kernel_launch: hipFuncSetAttribute failed\n"); grid = -1; return; }
        if (hipOccupancyMaxActiveBlocksPerMultiprocessor(&per_cu, (const void*)fwd_kernel, 512, LDS_BYTES) != hipSuccess || per_cu < 1) { fprintf(stderr, "kernel_launch: occupancy query failed (%d)\n", per_cu); grid = -1; return; }
        grid = cus;
        grid -= grid % 8;
    }
    if (grid < 0) return;
    if (hipMemsetAsync((char*)d_ws + WS_BAR, 0, (size_t)3456 * 4, stream) != hipSuccess) { fprintf(stderr, "kernel_launch: memset failed\n"); return; }
    Params p{};
    for (int i = 0; i < 23; ++i) p.in[i] = (const float*)d_in[i];
    p.out = (float*)d_out; p.ws = (unsigned char*)d_ws;
    p.lo = 0; p.hi = NPHASES; p.coop = 1;
    void* args[] = {&p};
    hipError_t e = hipLaunchCooperativeKernel((const void*)fwd_kernel, dim3(grid), dim3(512), args, LDS_BYTES, stream);
    if (e != hipSuccess) fprintf(stderr, "kernel_launch: cooperative launch failed: %s (grid %d)\n", hipGetErrorString(e), grid);
}
```

```cpp
#include <hip/hip_runtime.h>
#include <hip/hip_cooperative_groups.h>
#include <stdint.h>
#include <stdio.h>
namespace cg = cooperative_groups;

#define LAS __attribute__((address_space(3)))
typedef unsigned short bf16_t;
typedef short bf16x8 __attribute__((ext_vector_type(8)));
typedef float f32x4 __attribute__((ext_vector_type(4)));
typedef unsigned u32x4 __attribute__((ext_vector_type(4)));
typedef unsigned u32x2 __attribute__((ext_vector_type(2)));

constexpr int D = 1024, NB = 2, SEQ = 8192, CTX = 256, RB = SEQ + CTX, R = NB * RB, RL = NB * SEQ, NCH = RB / 64, FF = 4096;
constexpr int INW = 8240;
constexpr int NTHR = 256;
constexpr int HALF_LDS = 73728;
constexpr int LDS_BYTES = 2 * HALF_LDS + 16;

constexpr size_t WS_WTIN = 0;
constexpr size_t WS_WTBR = WS_WTIN + (size_t)8448 * 1024 * 2;
constexpr size_t WS_WTO = WS_WTBR + (size_t)3 * 1024 * 512 * 2;
constexpr size_t WS_WTUP = WS_WTO + (size_t)1024 * 1024 * 2;
constexpr size_t WS_WTDN = WS_WTUP + (size_t)4096 * 1024 * 2;
constexpr size_t WS_HBUF = WS_WTDN + (size_t)4096 * 1024 * 2;
constexpr size_t WS_PBUF = WS_HBUF + (size_t)R * 1024 * 2;
constexpr size_t WS_SBUF = WS_PBUF + (size_t)R * 2048 * 2;
constexpr size_t WS_BR = WS_SBUF + (size_t)R * 2048 * 2;
constexpr size_t WS_CTXX = WS_BR + (size_t)R * 1536 * 2;
constexpr size_t WS_SMALL = WS_CTXX + (size_t)512 * 1024 * 4;
constexpr size_t WS_DEC = WS_SMALL + (size_t)R * 48 * 4;
constexpr size_t WS_UN = WS_DEC + (size_t)16 * NCH * 128 * 4;
constexpr size_t WS_MODS = WS_UN + (size_t)16 * NCH * 128 * 4;
constexpr size_t WS_ROPE = WS_MODS + (size_t)2 * 3 * 6144 * 4;
constexpr size_t WS_BAR = WS_ROPE + (size_t)(128 + 64) * 16 * 2 * 4;
constexpr size_t WS_END = WS_BAR + (size_t)3456 * 4;
constexpr size_t WS_GS = WS_PBUF;
constexpr size_t WS_MB = WS_PBUF + (size_t)R * 3072 * 2;
constexpr size_t WS_HID = WS_PBUF;

struct Params { const float* in[23]; float* out; unsigned char* ws; int lo, hi, coop, pad; };

__device__ __forceinline__ int tid_l() { int t = threadIdx.x & 255; asm volatile("" : "+v"(t)); return t; }
__device__ __forceinline__ int bid_l() { int t = blockIdx.x * 2 + (__builtin_amdgcn_readfirstlane(threadIdx.x >> 8)); asm volatile("" : "+s"(t)); return t; }
__device__ __forceinline__ int vgrid() { return gridDim.x * 2; }
typedef __attribute__((address_space(1))) unsigned char gas_u8;
__device__ __forceinline__ unsigned char* ws_l(const Params& P) { gas_u8* w = (gas_u8*)P.ws; asm volatile("" : "+s"(w)); return (unsigned char*)w; }
enum { I_X = 0, I_C, I_CTX, I_CCTX, I_N1G, I_N2G, I_WADA, I_BADA, I_WIN, I_A2, I_ABIAS, I_GNG, I_CONV, I_IB, I_FB, I_MNG, I_RDL, I_RNG, I_WBR, I_WO, I_WUP, I_WDN, I_FG };

typedef __bf16 bf16x2_t __attribute__((ext_vector_type(2)));
typedef float f32x2 __attribute__((ext_vector_type(2)));
__device__ __forceinline__ unsigned cvt_pk(float lo, float hi) { f32x2 v = {lo, hi}; bf16x2_t b = __builtin_convertvector(v, bf16x2_t); return __builtin_bit_cast(unsigned, b); }
__device__ __forceinline__ float bflo(unsigned u) { return __uint_as_float(u << 16); }
__device__ __forceinline__ float bfhi(unsigned u) { return __uint_as_float(u & 0xffff0000u); }
__device__ __forceinline__ float wave_sum(float v) {
#pragma unroll
    for (int o = 32; o > 0; o >>= 1) v += __shfl_xor(v, o);
    return v;
}
__device__ __forceinline__ float logsig(float x) { return fminf(x, 0.f) - log1pf(__expf(-fabsf(x))); }
__device__ __forceinline__ float logsig_fast(float x) { return fminf(x, 0.f) - __logf(1.f + __expf(-fabsf(x))); }
__device__ __forceinline__ float siluf(float x) { return x * __builtin_amdgcn_rcpf(1.f + __expf(-x)); }
__device__ __forceinline__ float sigmf(float x) { return __builtin_amdgcn_rcpf(1.f + __expf(-x)); }

struct XPtr { float* lat; float* ctx; };
__device__ __forceinline__ float* xrow(const XPtr& X, int r) { return r < RL ? X.lat + (size_t)r * D : X.ctx + (size_t)(r - RL) * D; }
__device__ __forceinline__ int modidx(int r) { return r < SEQ ? 0 : (r < RL ? 1 : 2); }
__device__ __forceinline__ int rowbase(int b, int c) { return c < 4 ? RL + b * CTX + c * 64 : b * SEQ + (c - 4) * 64; }

#define UNPACK8(u, f) do { f[0] = bflo(u.x); f[1] = bfhi(u.x); f[2] = bflo(u.y); f[3] = bfhi(u.y); f[4] = bflo(u.z); f[5] = bfhi(u.z); f[6] = bflo(u.w); f[7] = bfhi(u.w); } while (0)

__device__ __forceinline__ void mods_task(const Params& P, int task, char* lds) {
    float* s = (float*)lds;
    float* red = (float*)(lds + 12288);
    const int tid = tid_l();
    const int l = task / 192, col0 = (task % 192) * 32;
    const float* c = P.in[I_C]; const float* cc = P.in[I_CCTX];
    for (int i = tid; i < 3072; i += NTHR) { const int v = i >> 10, k = i & 1023; const float cv = v < 2 ? c[v * 1024 + k] : cc[k]; s[i] = siluf(cv); }
    __syncthreads();
    const int col = tid & 31, kg = tid >> 5;
    const float* w = P.in[I_WADA] + (size_t)l * D * 6144 + col0 + col;
    float a0 = 0.f, a1 = 0.f, a2 = 0.f;
#pragma unroll 32
    for (int k = kg * 128; k < kg * 128 + 128; ++k) { const float wv = w[(size_t)k * 6144]; a0 += s[k] * wv; a1 += s[1024 + k] * wv; a2 += s[2048 + k] * wv; }
    red[(kg * 32 + col) * 3 + 0] = a0; red[(kg * 32 + col) * 3 + 1] = a1; red[(kg * 32 + col) * 3 + 2] = a2;
    __syncthreads();
    if (tid < 96) {
        const int v = tid >> 5, c2 = tid & 31; float sum = 0.f;
#pragma unroll
        for (int g = 0; g < 8; ++g) sum += red[(g * 32 + c2) * 3 + v];
        sum += P.in[I_BADA][l * 6144 + col0 + c2];
        ((float*)(ws_l(P) + WS_MODS))[(l * 3 + v) * 6144 + col0 + c2] = sum;
    }
    __syncthreads();
}

__device__ __forceinline__ void rope_task(const Params& P) {
    float* tab = (float*)(ws_l(P) + WS_ROPE);
    for (int i = tid_l(); i < 192 * 16; i += NTHR) {
        const int pos = i >> 4, f = i & 15;
        const float inv = exp2f(-(float)f * (13.287712379549449f / 16.f));
        const float p = pos < 128 ? (float)pos : (float)(pos - 128);
        const float ang = p * inv;
        const float cs = cosf(ang), sn = sinf(ang);
        if (pos < 128) { tab[pos * 16 + f] = cs; tab[2048 + pos * 16 + f] = sn; }
        else { tab[4096 + (pos - 128) * 16 + f] = cs; tab[4096 + 1024 + (pos - 128) * 16 + f] = sn; }
    }
}

__device__ __forceinline__ void transpose_tile(const float* src, int ldsrc, int k0, int n0src, int nvalid, bf16_t* dst, int ldd, int drow0, char* lds) {
    float* tile = (float*)lds;
    const int tid = tid_l(), nl = tid & 63, kq = tid >> 6;
    float v[32];
#pragma unroll
    for (int i = 0; i < 32; ++i) v[i] = nl < nvalid ? src[(size_t)(k0 + kq + 4 * i) * ldsrc + n0src + nl] : 0.f;
#pragma unroll
    for (int i = 0; i < 32; ++i) tile[(kq + 4 * i) * 65 + nl] = v[i];
    __syncthreads();
    const int n = tid >> 2, ks = (tid & 3) * 32;
    if (n < nvalid) {
        u32x4* dp = (u32x4*)(dst + (size_t)(drow0 + n) * ldd + k0 + ks);
#pragma unroll
        for (int q = 0; q < 4; ++q) {
            u32x4 o;
            o.x = cvt_pk(tile[(ks + 8 * q + 0) * 65 + n], tile[(ks + 8 * q + 1) * 65 + n]); o.y = cvt_pk(tile[(ks + 8 * q + 2) * 65 + n], tile[(ks + 8 * q + 3) * 65 + n]);
            o.z = cvt_pk(tile[(ks + 8 * q + 4) * 65 + n], tile[(ks + 8 * q + 5) * 65 + n]); o.w = cvt_pk(tile[(ks + 8 * q + 6) * 65 + n], tile[(ks + 8 * q + 7) * 65 + n]);
            dp[q] = o;
        }
    }
    __syncthreads();
}

constexpr int CONV_TILES = 192 + 8 + 8 + 256 + 192 + 384 + 192 + 128 + 512 + 512;
__device__ __forceinline__ void convert_tile(const Params& P, int l, int it, char* lds) {
    const float* win = P.in[I_WIN] + (size_t)l * D * INW;
    bf16_t* wtin = (bf16_t*)(ws_l(P) + WS_WTIN);
    int r = it;
    if (r < 192) { const int kt = r / 24, nt = r % 24; transpose_tile(win, INW, kt * 128, nt * 64, 64, wtin, 1024, nt * 64, lds); return; } r -= 192;
    if (r < 8) { transpose_tile(win, INW, r * 128, 1536, 32, wtin, 1024, 1536, lds); return; } r -= 8;
    if (r < 8) { transpose_tile(win, INW, r * 128, 3616, 16, wtin, 1024, 1568, lds); return; } r -= 8;
    if (r < 256) { const int kt = r / 32, nt = r % 32; transpose_tile(win, INW, kt * 128, 1568 + nt * 64, 64, wtin, 1024, 1792 + nt * 64, lds); return; } r -= 256;
    if (r < 192) { const int kt = r / 24, nt = r % 24; transpose_tile(win, INW, kt * 128, 3632 + nt * 64, 64, wtin, 1024, 3840 + nt * 64, lds); return; } r -= 192;
    if (r < 384) { const int kt = r / 48, nt = r % 48; transpose_tile(win, INW, kt * 128, 5168 + nt * 64, 64, wtin, 1024, 5376 + nt * 64, lds); return; } r -= 384;
    if (r < 192) { const int j = r / 64, q = r % 64, kt = q / 16, nt = q % 16;
        transpose_tile(P.in[I_WBR] + ((size_t)l * 3 + j) * 512 * 1024, 1024, kt * 128, nt * 64, 64, (bf16_t*)(ws_l(P) + WS_WTBR), 512, j * 1024 + nt * 64, lds); return; } r -= 192;
    if (r < 128) { const int kt = r / 16, nt = r % 16; transpose_tile(P.in[I_WO] + (size_t)l * D * D, 1024, kt * 128, nt * 64, 64, (bf16_t*)(ws_l(P) + WS_WTO), 1024, nt * 64, lds); return; } r -= 128;
    if (r < 512) { const int kt = r / 64, nt = r % 64; transpose_tile(P.in[I_WUP] + (size_t)l * D * FF, 4096, kt * 128, nt * 64, 64, (bf16_t*)(ws_l(P) + WS_WTUP), 1024, nt * 64, lds); return; } r -= 512;
    { const int kt = r / 16, nt = r % 16; transpose_tile(P.in[I_WDN] + (size_t)l * FF * D, 1024, kt * 128, nt * 64, 64, (bf16_t*)(ws_l(P) + WS_WTDN), 4096, nt * 64, lds); }
}
__device__ __forceinline__ void convert_all(const Params& P, int l, char* lds) {
    const int VG = vgrid(), slot = bid_l();
    static_assert(CONV_TILES % 2 == 0, "both halves of a workgroup must be active together");
    for (int i0 = 0; i0 < CONV_TILES; i0 += VG) { const int it = i0 + slot; if (it >= CONV_TILES) continue; convert_tile(P, l, it, lds); }
}

__device__ __forceinline__ void norm_phase(const Params& P, XPtr X, const float* g, int l, int sidx, int nrows) {
    const int lane = tid_l() & 63; const int gw = bid_l() * 4 + (tid_l() >> 6), ngw = vgrid() * 4;
    bf16_t* hb = (bf16_t*)(ws_l(P) + WS_HBUF);
    const float* mods = (const float*)(ws_l(P) + WS_MODS) + (size_t)l * 3 * 6144;
    for (int r = gw; r < nrows; r += 2 * ngw) {
        const int r1 = r + ngw; const bool has1 = r1 < nrows; const int rr1 = has1 ? r1 : r;
        const f32x4* xa = (const f32x4*)xrow(X, r); const f32x4* xb = (const f32x4*)xrow(X, rr1);
        f32x4 va[4], vb[4]; float sa_ = 0.f, sb_ = 0.f;
#pragma unroll
        for (int j = 0; j < 4; ++j) { va[j] = xa[lane + 64 * j]; vb[j] = xb[lane + 64 * j]; }
#pragma unroll
        for (int j = 0; j < 4; ++j) { sa_ += va[j].x * va[j].x + va[j].y * va[j].y + va[j].z * va[j].z + va[j].w * va[j].w; sb_ += vb[j].x * vb[j].x + vb[j].y * vb[j].y + vb[j].z * vb[j].z + vb[j].w * vb[j].w; }
        sa_ = wave_sum(sa_); sb_ = wave_sum(sb_);
        const float rsa = rsqrtf(sa_ * (1.f / 1024.f) + 1e-6f), rsb = rsqrtf(sb_ * (1.f / 1024.f) + 1e-6f);
        const float* mda = mods + modidx(r) * 6144; const float* mdb = mods + modidx(rr1) * 6144;
#pragma unroll
        for (int j = 0; j < 4; ++j) {
            const int col = (lane + 64 * j) * 4;
            const f32x4 gg = *(const f32x4*)(g + col);
            { const f32x4 sh = *(const f32x4*)(mda + sidx * 1024 + col), sc = *(const f32x4*)(mda + (sidx + 1) * 1024 + col);
              const f32x4 hh = va[j] * rsa * gg * (sc + 1.f) + sh; u32x2 o; o.x = cvt_pk(hh.x, hh.y); o.y = cvt_pk(hh.z, hh.w); *(u32x2*)(hb + (size_t)r * 1024 + col) = o; }
            if (has1) { const f32x4 sh = *(const f32x4*)(mdb + sidx * 1024 + col), sc = *(const f32x4*)(mdb + (sidx + 1) * 1024 + col);
              const f32x4 hh = vb[j] * rsb * gg * (sc + 1.f) + sh; u32x2 o; o.x = cvt_pk(hh.x, hh.y); o.y = cvt_pk(hh.z, hh.w); *(u32x2*)(hb + (size_t)r1 * 1024 + col) = o; }
        }
    }
}
__device__ __forceinline__ void final_norm_phase(const Params& P) {
    const int lane = tid_l() & 63; const int gw = bid_l() * 4 + (tid_l() >> 6), ngw = vgrid() * 4;
    const float* g = P.in[I_FG];
    for (int r = gw; r < RL; r += 2 * ngw) {
        const int r1 = r + ngw;
        f32x4* xa = (f32x4*)(P.out + (size_t)r * D); f32x4* xb = (f32x4*)(P.out + (size_t)r1 * D);
        f32x4 va[4], vb[4]; float sa_ = 0.f, sb_ = 0.f;
#pragma unroll
        for (int j = 0; j < 4; ++j) { va[j] = xa[lane + 64 * j]; vb[j] = xb[lane + 64 * j]; }
#pragma unroll
        for (int j = 0; j < 4; ++j) { sa_ += va[j].x * va[j].x + va[j].y * va[j].y + va[j].z * va[j].z + va[j].w * va[j].w; sb_ += vb[j].x * vb[j].x + vb[j].y * vb[j].y + vb[j].z * vb[j].z + vb[j].w * vb[j].w; }
        sa_ = wave_sum(sa_); sb_ = wave_sum(sb_);
        const float rsa = rsqrtf(sa_ * (1.f / 1024.f) + 1e-6f), rsb = rsqrtf(sb_ * (1.f / 1024.f) + 1e-6f);
#pragma unroll
        for (int j = 0; j < 4; ++j) { const f32x4 gg = *(const f32x4*)(g + (lane + 64 * j) * 4); xa[lane + 64 * j] = va[j] * rsa * gg; xb[lane + 64 * j] = vb[j] * rsb * gg; }
    }
}

struct EpiP {
    bf16_t* Pb; int pitch; int nmain; float* small;
    __device__ __forceinline__ void operator()(int r, int c, const f32x4& v, int) const {
        if (c < nmain) { u32x2 o; o.x = cvt_pk(v.x, v.y); o.y = cvt_pk(v.z, v.w); *(u32x2*)(Pb + (size_t)r * pitch + c) = o; }
        else { const int cc = c - nmain; if (cc < 48) *(f32x4*)(small + (size_t)r * 48 + cc) = v; }
    }
    __device__ __forceinline__ void w8(int r, int c, const f32x4& v0, const f32x4& v1, int) const {
        if (c < nmain) { u32x4 o; o.x = cvt_pk(v0.x, v0.y); o.y = cvt_pk(v0.z, v0.w); o.z = cvt_pk(v1.x, v1.y); o.w = cvt_pk(v1.z, v1.w); *(u32x4*)(Pb + (size_t)r * pitch + c) = o; }
        else { const int cc = c - nmain; if (cc < 48) { *(f32x4*)(small + (size_t)r * 48 + cc) = v0; *(f32x4*)(small + (size_t)r * 48 + cc + 4) = v1; } }
    }
};
struct EpiSig {
    bf16_t* O;
    __device__ __forceinline__ void operator()(int r, int c, const f32x4& v, int) const {
        u32x2 o; o.x = cvt_pk(sigmf(v.x), sigmf(v.y)); o.y = cvt_pk(sigmf(v.z), sigmf(v.w)); *(u32x2*)(O + (size_t)r * 3072 + c) = o;
    }
    __device__ __forceinline__ void w8(int r, int c, const f32x4& v0, const f32x4& v1, int) const {
        u32x4 o; o.x = cvt_pk(sigmf(v0.x), sigmf(v0.y)); o.y = cvt_pk(sigmf(v0.z), sigmf(v0.w)); o.z = cvt_pk(sigmf(v1.x), sigmf(v1.y)); o.w = cvt_pk(sigmf(v1.z), sigmf(v1.w));
        *(u32x4*)(O + (size_t)r * 3072 + c) = o;
    }
};
struct EpiRelu2 {
    bf16_t* O;
    __device__ __forceinline__ void operator()(int r, int c, const f32x4& v, int) const {
        const float a = fmaxf(v.x, 0.f), b = fmaxf(v.y, 0.f), cc = fmaxf(v.z, 0.f), d = fmaxf(v.w, 0.f);
        u32x2 o; o.x = cvt_pk(a * a, b * b); o.y = cvt_pk(cc * cc, d * d); *(u32x2*)(O + (size_t)r * 4096 + c) = o;
    }
    __device__ __forceinline__ void w8(int r, int c, const f32x4& v0, const f32x4& v1, int) const {
        const float a = fmaxf(v0.x, 0.f), b = fmaxf(v0.y, 0.f), cc = fmaxf(v0.z, 0.f), d = fmaxf(v0.w, 0.f), e = fmaxf(v1.x, 0.f), f = fmaxf(v1.y, 0.f), g = fmaxf(v1.z, 0.f), h = fmaxf(v1.w, 0.f);
        u32x4 o; o.x = cvt_pk(a * a, b * b); o.y = cvt_pk(cc * cc, d * d); o.z = cvt_pk(e * e, f * f); o.w = cvt_pk(g * g, h * h); *(u32x4*)(O + (size_t)r * 4096 + c) = o;
    }
};
struct EpiRes {
    XPtr Xold, Xnew; const float* mods_l; int gidx;
    __device__ __forceinline__ void operator()(int r, int c, const f32x4& v, int) const {
        const f32x4 g = *(const f32x4*)(mods_l + modidx(r) * 6144 + gidx * 1024 + c);
        const f32x4 xo = *(const f32x4*)(xrow(Xold, r) + c);
        *(f32x4*)(xrow(Xnew, r) + c) = xo + g * v;
    }
    __device__ __forceinline__ void w8(int r, int c, const f32x4& v0, const f32x4& v1, int) const {
        const float* gp = mods_l + modidx(r) * 6144 + gidx * 1024 + c; const float* xo = xrow(Xold, r) + c; float* xn = xrow(Xnew, r) + c;
        const f32x4 g0 = *(const f32x4*)gp, g1 = *(const f32x4*)(gp + 4), x0 = *(const f32x4*)xo, x1 = *(const f32x4*)(xo + 4);
        *(f32x4*)xn = x0 + g0 * v0; *(f32x4*)(xn + 4) = x1 + g1 * v1;
    }
};
struct EpiMerge {
    const bf16_t* gs; bf16_t* mb;
    __device__ __forceinline__ void operator()(int r, int c, const f32x4& v, int j) const {
        const u32x2 g = *(const u32x2*)(gs + (size_t)r * 3072 + j * 1024 + c);
        float a0 = v.x * bflo(g.x), a1 = v.y * bfhi(g.x), a2 = v.z * bflo(g.y), a3 = v.w * bfhi(g.y);
        u32x2* mp = (u32x2*)(mb + (size_t)r * 1024 + c);
        if (j > 0) { const u32x2 o = *mp; a0 += bflo(o.x); a1 += bfhi(o.x); a2 += bflo(o.y); a3 += bfhi(o.y); }
        u32x2 w; w.x = cvt_pk(a0, a1); w.y = cvt_pk(a2, a3); *mp = w;
    }
    __device__ __forceinline__ void w8(int r, int c, const f32x4& v0, const f32x4& v1, int j) const {
        const u32x4 g = *(const u32x4*)(gs + (size_t)r * 3072 + j * 1024 + c);
        float a0 = v0.x * bflo(g.x), a1 = v0.y * bfhi(g.x), a2 = v0.z * bflo(g.y), a3 = v0.w * bfhi(g.y), a4 = v1.x * bflo(g.z), a5 = v1.y * bfhi(g.z), a6 = v1.z * bflo(g.w), a7 = v1.w * bfhi(g.w);
        u32x4* mp = (u32x4*)(mb + (size_t)r * 1024 + c);
        if (j > 0) { const u32x4 o = *mp; a0 += bflo(o.x); a1 += bfhi(o.x); a2 += bflo(o.y); a3 += bfhi(o.y); a4 += bflo(o.z); a5 += bfhi(o.z); a6 += bflo(o.w); a7 += bfhi(o.w); }
        u32x4 w; w.x = cvt_pk(a0, a1); w.y = cvt_pk(a2, a3); w.z = cvt_pk(a4, a5); w.w = cvt_pk(a6, a7); *mp = w;
    }
};

namespace pg8 {
constexpr int BM = 256, BK = 64, HALF = 128, HTB = HALF * BK * 2, STAGE_BYTES = 8 * HTB, NXCD = 8, WGM = 2;
__device__ __forceinline__ int lds_byte(int r, int c) { const int st = (r >> 4) * 2 + (c >> 5), rr = r & 15, cc = c & 31, ob = rr * 64 + cc * 2; return st * 1024 + (ob ^ (((ob >> 9) & 1) << 5)); }
__device__ __forceinline__ int perm32(int rho) { const int n = rho >> 4, i = rho & 15; return 8 * (i >> 2) + 4 * n + (i & 3); }
__device__ __forceinline__ void stage_rc(int b, int& R_, int& C_) { const int st = b / 1024, sb = b % 1024, swz = sb ^ (((sb >> 9) & 1) << 5); R_ = (st >> 1) * 16 + swz / 64; C_ = (st & 1) * 32 + (swz % 64) / 2; }
struct Unit { int pm, pn, acol, brow, j; };
struct Gemm { const bf16_t* A; const bf16_t* Bt; int lda, K; };
struct StaticOrder {
    int nM, nN, nwg, G, c;
    __device__ void init(int M, int N, int G_, int c_) { nM = M / BM; nN = N / BM; nwg = nM * nN; G = G_; c = c_; }
    __device__ __forceinline__ bool tile(long L, int& pm, int& pn) const {
        if (L >= nwg) return false;
        int wgid = (int)L; { const int q = nwg / NXCD, r = nwg % NXCD, xcd = wgid % NXCD, off = wgid / NXCD; wgid = (xcd < r ? xcd * (q + 1) : r * (q + 1) + (xcd - r) * q) + off; }
        const int nig = WGM * nN, gid = wgid / nig, fm = gid * WGM, gsz = (nM - fm) < WGM ? (nM - fm) : WGM;
        pm = fm + ((wgid % nig) % gsz); pn = (wgid % nig) / gsz; return true;
    }
    __device__ __forceinline__ bool next(int i, Unit& u) const { if (!tile((long)i * G + c, u.pm, u.pn)) return false; u.acol = 0; u.brow = u.pn; u.j = 0; return true; }
};
struct MergeOrder {
    StaticOrder S;
    __device__ __forceinline__ bool next(int i, Unit& u) const { const int j = i % 3; if (!S.tile((long)(i / 3) * S.G + S.c, u.pm, u.pn)) return false; u.acol = j * 512; u.brow = j * 4 + u.pn; u.j = j; return true; }
};
template <class F> struct Epi {
    F f;
    __device__ __forceinline__ void operator()(const f32x4 (&acc)[2][2][4][2], const Unit& u, int wr, int wc, int fr, int fq) const {
#pragma unroll
        for (int ai = 0; ai < 2; ++ai)
#pragma unroll
            for (int m = 0; m < 4; ++m)
#pragma unroll
                for (int bj = 0; bj < 2; ++bj)
                    f.w8(u.pm * BM + ai * HALF + wr * 64 + m * 16 + fr, u.pn * BM + bj * HALF + wc * 32 + 8 * fq, acc[ai][bj][m][0], acc[ai][bj][m][1], u.j);
    }
};

template <class E_, class Sched>
__device__ __forceinline__ void gemm_phase(LAS unsigned char* lds, const Gemm g, const Sched& S, const E_& E) {
    int tid_ = threadIdx.x; asm volatile("" : "+v"(tid_));
    const int tid = tid_, wid = __builtin_amdgcn_readfirstlane(tid >> 6), lane = tid & 63, wr = wid >> 2, wc = wid & 3, fr = lane & 15, fq = lane >> 4;
    const int K = g.K, nt = K / BK;
    unsigned voffA[2], voffB[2];
#pragma unroll
    for (int i = 0; i < 2; ++i) { int R_, C_; stage_rc(tid * 16 + i * 8192, R_, C_); const int Rb = (R_ & ~31) + perm32(R_ & 31); voffA[i] = (unsigned)(R_ * g.lda + C_) * 2u; voffB[i] = (unsigned)(Rb * K + C_) * 2u; }
    const size_t kstep = (size_t)(BK * 2);
    const size_t hstepA = (size_t)HALF * g.lda * 2, hstepB = (size_t)HALF * K * 2;
    const unsigned ldsw = (unsigned)wid * 1024u;
    const int aoff = lds_byte(wr * 64 + fr, fq * 8), boff = lds_byte(wc * 32 + fr, fq * 8);
#define PG8_SA(b, h) (((b) * 2 + (h)) * HTB)
#define PG8_SB(b, h) ((4 + (b) * 2 + (h)) * HTB)
#define PG8_STAGE(bufoff, gbase, voff) do { _Pragma("unroll") for (int _i = 0; _i < 2; ++_i) \
        __builtin_amdgcn_global_load_lds((const unsigned*)((const char*)(gbase) + (voff)[_i]), (LAS unsigned*)(lds + (bufoff) + ldsw + _i * 8192), 16, 0, 0); } while (0)
#define PG8_LDA(dst, b, h) do { _Pragma("unroll") for (int m = 0; m < 4; ++m) _Pragma("unroll") for (int k = 0; k < 2; ++k) dst[m][k] = *(const LAS bf16x8*)(lds + PG8_SA(b, h) + aoff + m * 2048 + k * 1024); } while (0)
#define PG8_LDB(dst, b, h) do { _Pragma("unroll") for (int n = 0; n < 2; ++n) _Pragma("unroll") for (int k = 0; k < 2; ++k) dst[n][k] = *(const LAS bf16x8*)(lds + PG8_SB(b, h) + boff + n * 2048 + k * 1024); } while (0)
#define PG8_MMA(ai, bj, At, Bt) do { __builtin_amdgcn_s_setprio(1); _Pragma("unroll") for (int m = 0; m < 4; ++m) _Pragma("unroll") for (int n = 0; n < 2; ++n) _Pragma("unroll") for (int k = 0; k < 2; ++k) \
        acc[ai][bj][m][n] = __builtin_amdgcn_mfma_f32_16x16x32_bf16(Bt[n][k], At[m][k], acc[ai][bj][m][n], 0, 0, 0); __builtin_amdgcn_s_setprio(0); } while (0)
#define PG8_WAIT_V(n) asm volatile("s_waitcnt vmcnt(" #n ")" ::: "memory")
#define PG8_WAIT_L(n) asm volatile("s_waitcnt lgkmcnt(" #n ")" ::: "memory")
#define PG8_BAR __builtin_amdgcn_s_barrier()
#define PG8_SCHED __builtin_amdgcn_sched_barrier(0)
#define PG8_UA(u) ((const char*)g.A + ((size_t)(u).pm * BM * g.lda + (u).acol) * 2)
#define PG8_UB(u) ((const char*)g.Bt + (size_t)(u).brow * BM * K * 2)
    Unit cur, nxt; int ui = 0;
    if (!S.next(0, cur)) return;
    f32x4 acc[2][2][4][2];
#pragma unroll
    for (int a = 0; a < 2; ++a)
#pragma unroll
        for (int b = 0; b < 2; ++b)
#pragma unroll
            for (int m = 0; m < 4; ++m)
#pragma unroll
                for (int n = 0; n < 2; ++n) acc[a][b][m][n] = (f32x4){0.f, 0.f, 0.f, 0.f};
    bf16x8 At[4][2], B0[2][2], B1[2][2];
    const char* cA = PG8_UA(cur); const char* cB = PG8_UB(cur);
    PG8_STAGE(PG8_SB(0, 0), cB, voffB); PG8_STAGE(PG8_SB(0, 1), cB + hstepB, voffB); PG8_STAGE(PG8_SA(0, 0), cA, voffA); PG8_STAGE(PG8_SA(0, 1), cA + hstepA, voffA);
    if (wr == 1) PG8_BAR;
    PG8_WAIT_V(2); PG8_BAR;
    PG8_STAGE(PG8_SB(1, 0), cB + kstep, voffB); PG8_STAGE(PG8_SA(1, 0), cA + kstep, voffA); PG8_STAGE(PG8_SB(1, 1), cB + hstepB + kstep, voffB);
    PG8_WAIT_V(6); PG8_BAR;
    for (;;) {
        const bool has_next = S.next(ui + 1, nxt);
        const char* nA = has_next ? PG8_UA(nxt) : cA; const char* nB = has_next ? PG8_UB(nxt) : cB;
        for (int t = 0; t < nt; t += 2) {
            const bool last = (t == nt - 2);
            const char* a1 = cA + (size_t)(t + 1) * kstep;
            const char* a2 = last ? nA : cA + (size_t)(t + 2) * kstep; const char* b2 = last ? nB : cB + (size_t)(t + 2) * kstep;
            const char* a3 = a2 + kstep; const char* b3 = b2 + kstep;
            PG8_LDB(B0, 0, 0); PG8_LDB(B1, 0, 1); PG8_SCHED; PG8_LDA(At, 0, 0); PG8_STAGE(PG8_SA(1, 1), a1 + hstepA, voffA);
            PG8_WAIT_V(8); PG8_WAIT_L(0); PG8_BAR; PG8_MMA(0, 0, At, B0); PG8_MMA(0, 1, At, B1); PG8_BAR; PG8_SCHED;
            PG8_LDA(At, 0, 1); PG8_STAGE(PG8_SB(0, 0), b2, voffB); PG8_STAGE(PG8_SB(0, 1), b2 + hstepB, voffB); PG8_STAGE(PG8_SA(0, 0), a2, voffA);
            PG8_WAIT_V(8); PG8_WAIT_L(0); PG8_BAR; PG8_MMA(1, 0, At, B0); PG8_MMA(1, 1, At, B1); PG8_BAR; PG8_SCHED;
            PG8_LDB(B0, 1, 0); PG8_LDB(B1, 1, 1); PG8_SCHED; PG8_LDA(At, 1, 0); PG8_STAGE(PG8_SA(0, 1), a2 + hstepA, voffA);
            PG8_WAIT_V(8); PG8_WAIT_L(0); PG8_BAR; PG8_MMA(0, 0, At, B0); PG8_MMA(0, 1, At, B1); PG8_BAR; PG8_SCHED;
            PG8_LDA(At, 1, 1); PG8_STAGE(PG8_SB(1, 0), b3, voffB); PG8_STAGE(PG8_SB(1, 1), b3 + hstepB, voffB); PG8_STAGE(PG8_SA(1, 0), a3, voffA);
            PG8_WAIT_V(8); PG8_WAIT_L(0); PG8_BAR; PG8_MMA(1, 0, At, B0); PG8_MMA(1, 1, At, B1); PG8_BAR; PG8_SCHED;
        }
        if (wr == 0) PG8_BAR;
        E(acc, cur, wr, wc, fr, fq);
        if (!has_next) break;
#pragma unroll
        for (int a = 0; a < 2; ++a)
#pragma unroll
            for (int b = 0; b < 2; ++b)
#pragma unroll
                for (int m = 0; m < 4; ++m)
#pragma unroll
                    for (int n = 0; n < 2; ++n) acc[a][b][m][n] = (f32x4){0.f, 0.f, 0.f, 0.f};
        cur = nxt; cA = nA; cB = nB; ++ui;
        if (wr == 1) PG8_BAR;
    }
    PG8_WAIT_V(0);
    PG8_BAR;
#undef PG8_SA
#undef PG8_SB
#undef PG8_STAGE
#undef PG8_LDA
#undef PG8_LDB
#undef PG8_MMA
#undef PG8_WAIT_V
#undef PG8_WAIT_L
#undef PG8_BAR
#undef PG8_SCHED
#undef PG8_UA
#undef PG8_UB
}
}

template <class F>
__device__ __forceinline__ void big_gemm(LAS unsigned char* ldsb, const bf16_t* A, int lda, const bf16_t* Bt, int K, int N, const F& f) {
    pg8::Gemm g{A, Bt, lda, K}; pg8::StaticOrder S; S.init(RL, N, (int)gridDim.x, (int)blockIdx.x);
    pg8::Epi<F> E{f};
    pg8::gemm_phase(ldsb, g, S, E);
    __syncthreads();
}
template <int NI>
__device__ __forceinline__ void gemm_kloop(f32x4 (&acc)[4][NI], const bf16_t* Ag, int lda, const bf16_t* Bg, int ldb, int K, char* lds) {
    const int tid = tid_l(), lane = tid & 63, wid = tid >> 6, wm = wid >> 1, wn = wid & 1, lr = lane & 15, lq = lane >> 4;
    u32x4 ra[4], rb[NI];
    const int prow = tid >> 3, pkc = tid & 7;
    const bf16_t* ap = Ag + (size_t)prow * lda + pkc * 8;
    const bf16_t* bp = Bg + (size_t)prow * ldb + pkc * 8;
    const int soff = prow * 128 + ((pkc ^ (prow & 7)) << 4);
#pragma unroll
    for (int i = 0; i < 4; ++i) { ra[i] = *(const u32x4*)(ap + (size_t)(32 * i) * lda); if (i < NI) rb[i < NI ? i : 0] = *(const u32x4*)(bp + (size_t)(32 * i) * ldb); }
#pragma unroll
    for (int i = 0; i < 4; ++i) { *(u32x4*)(lds + soff + i * 4096) = ra[i]; if (i < NI) *(u32x4*)(lds + 32768 + soff + i * 4096) = rb[i < NI ? i : 0]; }
    __syncthreads();
    const int nk = K >> 6;
    for (int kt = 0; kt < nk; ++kt) {
        const int buf = kt & 1;
        if (kt + 1 < nk) {
#pragma unroll
            for (int i = 0; i < 4; ++i) { ra[i] = *(const u32x4*)(ap + (size_t)(32 * i) * lda + (kt + 1) * 64); if (i < NI) rb[i < NI ? i : 0] = *(const u32x4*)(bp + (size_t)(32 * i) * ldb + (kt + 1) * 64); }
        }
        const char* la = lds + buf * 16384; const char* lb = lds + 32768 + buf * 16384;
#pragma unroll
        for (int kk = 0; kk < 2; ++kk) {
            bf16x8 af[4], bfr[NI];
            const int chunk = kk * 4 + lq;
#pragma unroll
            for (int mi = 0; mi < 4; ++mi) { const int row = wm * 64 + mi * 16 + lr; af[mi] = *(const bf16x8*)(la + row * 128 + ((chunk ^ (row & 7)) << 4)); }
#pragma unroll
            for (int ni = 0; ni < NI; ++ni) { const int row = wn * (16 * NI) + ni * 16 + lr; bfr[ni] = *(const bf16x8*)(lb + row * 128 + ((chunk ^ (row & 7)) << 4)); }
#pragma unroll
            for (int mi = 0; mi < 4; ++mi)
#pragma unroll
                for (int ni = 0; ni < NI; ++ni) acc[mi][ni] = __builtin_amdgcn_mfma_f32_16x16x32_bf16(bfr[ni], af[mi], acc[mi][ni], 0, 0, 0);
        }
        if (kt + 1 < nk) {
            char* sa = lds + (buf ^ 1) * 16384 + soff;
#pragma unroll
            for (int i = 0; i < 4; ++i) { *(u32x4*)(sa + i * 4096) = ra[i]; if (i < NI) *(u32x4*)(sa + 32768 + i * 4096) = rb[i < NI ? i : 0]; }
        }
        __syncthreads();
    }
}

__device__ __forceinline__ void tile_of(int t, int Mt, int Nt, int& tm, int& tn) {
    const int per = 8 * Nt; const int p = t / per; const int r = t - p * per; const int pm = (Mt - 8 * p) < 8 ? (Mt - 8 * p) : 8;
    tm = 8 * p + r % pm; tn = r / pm;
}

template <int TYPE> struct MX {
    static constexpr int DK = TYPE == 1 ? 128 : 64;
    static constexpr int NOC = DK / 8;
    static constexpr int PITCH = TYPE == 1 ? 2048 : 1536;
    static constexpr int QOFF = 0;
    static constexpr int KOFF = TYPE == 1 ? 512 : 256;
    static constexpr int VOFF = TYPE == 1 ? 1024 : 512;
    static constexpr int GOFF = TYPE == 1 ? 1536 : 1024;
    static constexpr int QP = DK + 16;
};
constexpr int L_VT = 0;
constexpr int L_Q = 20480;
constexpr int L_CUM = 40960;
constexpr int L_ATT = 57344;
constexpr int L_SC = 67584;
constexpr int L_SA = 68096;

template <int TYPE>
__device__ __forceinline__ void load_qk8(const Params& P, int l, const bf16_t* pb, int b, int c, int t, int h, int oc, bool isk, float (&f)[8], const float* wpre = nullptr) {
    typedef MX<TYPE> M;
    const int coff = (isk ? M::KOFF : M::QOFF) + h * M::DK;
    const size_t rowi = (size_t)(rowbase(b, c) + t);
    if (TYPE == 0) {
        const u32x4 u = *(const u32x4*)(pb + rowi * M::PITCH + coff + oc * 8); UNPACK8(u, f);
    } else if (TYPE == 1) {
        const bool hp = (t > 0) || (c != 0 && c != 4), hn = (t < 63) || (c != 3 && c != NCH - 1);
        const bf16_t* p0 = pb + rowi * M::PITCH + coff + oc * 8;
        u32x4 u1 = *(const u32x4*)p0, u0 = (u32x4){0u, 0u, 0u, 0u}, u2 = (u32x4){0u, 0u, 0u, 0u};
        if (hp) u0 = *(const u32x4*)(p0 - M::PITCH);
        if (hn) u2 = *(const u32x4*)(p0 + M::PITCH);
        float a[8], m[8], n[8]; UNPACK8(u0, a); UNPACK8(u1, m); UNPACK8(u2, n);
        float w0[8], w1[8], w2[8];
        if (wpre) {
#pragma unroll
            for (int j = 0; j < 8; ++j) { w0[j] = wpre[j]; w1[j] = wpre[8 + j]; w2[j] = wpre[16 + j]; }
        } else {
            const float* cw = P.in[I_CONV] + (size_t)l * 3 * 1024 + (isk ? 512 : 0) + h * 128 + oc * 8;
            const f32x4 w0a = *(const f32x4*)cw, w0b = *(const f32x4*)(cw + 4), w1a = *(const f32x4*)(cw + 1024), w1b = *(const f32x4*)(cw + 1028), w2a = *(const f32x4*)(cw + 2048), w2b = *(const f32x4*)(cw + 2052);
            w0[0] = w0a.x; w0[1] = w0a.y; w0[2] = w0a.z; w0[3] = w0a.w; w0[4] = w0b.x; w0[5] = w0b.y; w0[6] = w0b.z; w0[7] = w0b.w;
            w1[0] = w1a.x; w1[1] = w1a.y; w1[2] = w1a.z; w1[3] = w1a.w; w1[4] = w1b.x; w1[5] = w1b.y; w1[6] = w1b.z; w1[7] = w1b.w;
            w2[0] = w2a.x; w2[1] = w2a.y; w2[2] = w2a.z; w2[3] = w2a.w; w2[4] = w2b.x; w2[5] = w2b.y; w2[6] = w2b.z; w2[7] = w2b.w;
        }
#pragma unroll
        for (int j = 0; j < 8; ++j) f[j] = siluf(w0[j] * a[j] + w1[j] * m[j] + w2[j] * n[j]);
    } else {
        if (c < 4) { const u32x4 u = *(const u32x4*)(pb + rowi * M::PITCH + coff + oc * 8); UNPACK8(u, f); }
        else {
            const int o4 = oc & 3;
            const u32x4 ua = *(const u32x4*)(pb + rowi * M::PITCH + coff + o4 * 8), ub = *(const u32x4*)(pb + rowi * M::PITCH + coff + 32 + o4 * 8);
            float x1[8], x2[8]; UNPACK8(ua, x1); UNPACK8(ub, x2);
            const float* tab = (const float*)(ws_l(P) + WS_ROPE);
            const float* cs = o4 < 2 ? tab + (c - 4) * 16 + o4 * 8 : tab + 4096 + t * 16 + (o4 - 2) * 8;
            const float* sn = o4 < 2 ? tab + 2048 + (c - 4) * 16 + o4 * 8 : tab + 4096 + 1024 + t * 16 + (o4 - 2) * 8;
            const f32x4 ca = *(const f32x4*)cs, cb = *(const f32x4*)(cs + 4), sa = *(const f32x4*)sn, sb = *(const f32x4*)(sn + 4);
            const float cv[8] = {ca.x, ca.y, ca.z, ca.w, cb.x, cb.y, cb.z, cb.w}, sv[8] = {sa.x, sa.y, sa.z, sa.w, sb.x, sb.y, sb.z, sb.w};
#pragma unroll
            for (int j = 0; j < 8; ++j) f[j] = oc < 4 ? x1[j] * cv[j] - x2[j] * sv[j] : x1[j] * sv[j] + x2[j] * cv[j];
        }
    }
}

__device__ __forceinline__ void load_convw(const Params& P, int l, int h, int oc, bool isk, float (&w)[24]) {
    const float* cw = P.in[I_CONV] + (size_t)l * 3 * 1024 + (isk ? 512 : 0) + h * 128 + oc * 8;
#pragma unroll
    for (int tp = 0; tp < 3; ++tp) { const f32x4 a = *(const f32x4*)(cw + tp * 1024), b = *(const f32x4*)(cw + tp * 1024 + 4);
        w[tp * 8 + 0] = a.x; w[tp * 8 + 1] = a.y; w[tp * 8 + 2] = a.z; w[tp * 8 + 3] = a.w; w[tp * 8 + 4] = b.x; w[tp * 8 + 5] = b.y; w[tp * 8 + 6] = b.z; w[tp * 8 + 7] = b.w; }
}
template <int TYPE>
__device__ __forceinline__ void decay_setup(const Params& P, int l, int b, int c, int h, int dir, char* lds, const float* apre = nullptr) {
    const int tid = tid_l(); const int r0 = rowbase(b, c);
    float* sc = (float*)(lds + L_SC);
    const float* small = (const float*)(ws_l(P) + WS_SMALL);
    if (TYPE == 0) {
        float* cum = (float*)(lds + L_CUM); float* sa = (float*)(lds + L_SA);
        if (apre) {
#pragma unroll
            for (int k = 0; k < 4; ++k) sa[tid + k * NTHR] = apre[k];
        } else {
            for (int i = tid; i < 1024; i += NTHR) sa[i] = small[(size_t)(r0 + (i >> 4)) * 48 + dir * 16 + (i & 15)];
        }
        __syncthreads();
        const int d = tid & 63, tq = tid >> 6;
        const float* a2 = P.in[I_A2] + ((size_t)(l * 2 + dir) * 16) * 256 + h * 64 + d;
        float w[16];
#pragma unroll
        for (int rr = 0; rr < 16; ++rr) w[rr] = a2[rr * 256];
        const float bias = P.in[I_ABIAS][(l * 2 + dir) * 256 + h * 64 + d];
        float* blk = sa + 1024;
        float lv[16];
#pragma unroll
        for (int i = 0; i < 16; ++i) {
            const int t = tq * 16 + i;
            const f32x4 a0 = *(const f32x4*)(sa + t * 16), a1 = *(const f32x4*)(sa + t * 16 + 4), a2v = *(const f32x4*)(sa + t * 16 + 8), a3 = *(const f32x4*)(sa + t * 16 + 12);
            float z = bias;
            z += a0.x * w[0] + a0.y * w[1] + a0.z * w[2] + a0.w * w[3];
            z += a1.x * w[4] + a1.y * w[5] + a1.z * w[6] + a1.w * w[7];
            z += a2v.x * w[8] + a2v.y * w[9] + a2v.z * w[10] + a2v.w * w[11];
            z += a3.x * w[12] + a3.y * w[13] + a3.z * w[14] + a3.w * w[15];
            lv[i] = logsig_fast(z) * (1.f / 16.f);
        }
        if (dir == 0) {
#pragma unroll
            for (int i = 1; i < 16; ++i) lv[i] += lv[i - 1];
        } else {
#pragma unroll
            for (int i = 14; i >= 0; --i) lv[i] += lv[i + 1];
        }
        blk[tq * 64 + d] = dir == 0 ? lv[15] : lv[0];
        __syncthreads();
        float off = 0.f;
#pragma unroll
        for (int q = 0; q < 4; ++q) if (dir == 0 ? (q < tq) : (q > tq)) off += blk[q * 64 + d];
#pragma unroll
        for (int i = 0; i < 16; ++i) cum[(tq * 16 + i) * 64 + d] = lv[i] + off;
    } else if (TYPE == 1) {
        if (tid < 64) {
            const float fg = small[(size_t)(r0 + tid) * 48 + 40 + dir * 4 + h] + P.in[I_FB][l * 8 + dir * 4 + h];
            float v = logsig(fg);
            if (dir == 0) {
#pragma unroll
                for (int o = 1; o < 64; o <<= 1) { const float n = __shfl_up(v, o); if (tid >= o) v += n; }
            } else {
#pragma unroll
                for (int o = 1; o < 64; o <<= 1) { const float n = __shfl_down(v, o); if (tid + o < 64) v += n; }
            }
            const float tot = __shfl(v, dir == 0 ? 63 : 0);
            sc[tid] = v;
            sc[64 + tid] = small[(size_t)(r0 + tid) * 48 + 32 + dir * 4 + h] + P.in[I_IB][l * 8 + dir * 4 + h];
            if (tid == 0) sc[128] = tot;
        }
    } else {
        if (tid < 64) {
            const float lg = logsig(P.in[I_RDL][l * 8 + dir * 4 + h]);
            sc[tid] = (dir == 0 ? (float)(tid + 1) : (float)(64 - tid)) * lg;
            if (tid == 0) sc[128] = 64.f * lg;
        }
    }
    __syncthreads();
}

template <int TYPE>
__device__ __forceinline__ void build_vT(const bf16_t* pb, int b, int c, int h, char* lds) {
    typedef MX<TYPE> M;
    bf16_t* vT = (bf16_t*)(lds + L_VT);
#pragma unroll
    for (int i = 0; i < 2; ++i) {
        const int pid = tid_l() + i * NTHR, tp = pid & 31, oc = pid >> 5;
        const bf16_t* p0 = pb + (size_t)(rowbase(b, c) + 2 * tp) * M::PITCH + M::VOFF + h * 128 + oc * 8;
        const u32x4 u0 = *(const u32x4*)p0, u1 = *(const u32x4*)(p0 + M::PITCH);
        unsigned* dst = (unsigned*)(vT + (size_t)(oc * 8) * 80 + 2 * tp);
        dst[0 * 40] = (u0.x & 0xffffu) | (u1.x << 16); dst[1 * 40] = (u0.x >> 16) | (u1.x & 0xffff0000u);
        dst[2 * 40] = (u0.y & 0xffffu) | (u1.y << 16); dst[3 * 40] = (u0.y >> 16) | (u1.y & 0xffff0000u);
        dst[4 * 40] = (u0.z & 0xffffu) | (u1.z << 16); dst[5 * 40] = (u0.z >> 16) | (u1.z & 0xffff0000u);
        dst[6 * 40] = (u0.w & 0xffffu) | (u1.w << 16); dst[7 * 40] = (u0.w >> 16) | (u1.w & 0xffff0000u);
    }
}

__device__ __forceinline__ int scan_index(int dir, int c) { return dir == 0 ? c : (c < 4 ? 3 - c : 135 - c); }

template <int TYPE>
__device__ __forceinline__ void u_phase(const Params& P, int l, char* lds) {
    typedef MX<TYPE> M; constexpr int DK = M::DK;
    const int tid = tid_l(), lane = tid & 63, wid = tid >> 6, lr = lane & 15, lq = lane >> 4;
    const bf16_t* pb = (const bf16_t*)(ws_l(P) + WS_PBUF);
    bf16_t* U = (bf16_t*)(ws_l(P) + WS_SBUF); float* DEC = (float*)(ws_l(P) + WS_DEC); float* UN = (float*)(ws_l(P) + WS_UN);
    bf16_t* vT = (bf16_t*)(lds + L_VT); bf16_t* kT = (bf16_t*)(lds + L_Q);
    const float* cum = (const float*)(lds + L_CUM); const float* sc = (const float*)(lds + L_SC);
    const int NU = NB * 4 * 2 * NCH, VG = vgrid(), slot = bid_l();
    for (int u0 = 0; u0 < NU; u0 += VG) {
        int unit = u0 + slot; if (unit >= NU) unit = NU - 1;
        const int c = unit % NCH; const int rest = unit / NCH; const int dir = rest & 1, h = (rest >> 1) & 3, b = rest >> 3;
        const int chain = (b * 4 + h) * 2 + dir, n = scan_index(dir, c);
        static_assert(TYPE == 0, "the scalar-decay branches use u_phase_s");
        float k0[8], k1[8], apre[4];
        { const int tp = tid & 31, oc = tid >> 5;
          load_qk8<TYPE>(P, l, pb, b, c, 2 * tp, h, oc, true, k0);
          load_qk8<TYPE>(P, l, pb, b, c, 2 * tp + 1, h, oc, true, k1);
          const float* small = (const float*)(ws_l(P) + WS_SMALL); const int r0 = rowbase(b, c);
#pragma unroll
          for (int k = 0; k < 4; ++k) { const int i = tid + k * NTHR; apre[k] = small[(size_t)(r0 + (i >> 4)) * 48 + dir * 16 + (i & 15)]; } }
        build_vT<TYPE>(pb, b, c, h, lds);
        decay_setup<TYPE>(P, l, b, c, h, dir, lds, apre);
        const int tlast = dir == 0 ? 63 : 0;
        {
            const int pid = tid, tp = pid & 31, oc = pid >> 5;
            unsigned* dst = (unsigned*)(kT + (size_t)(oc * 8) * 80 + 2 * tp);
            if (TYPE == 0) {
#pragma unroll
                for (int j = 0; j < 8; ++j) { const int d = oc * 8 + j; const float tot = cum[tlast * 64 + d];
                    dst[j * 40] = cvt_pk(k0[j] * __expf(tot - cum[(2 * tp) * 64 + d]), k1[j] * __expf(tot - cum[(2 * tp + 1) * 64 + d])); }
            } else {
                const float tot = sc[128];
                const float w0 = TYPE == 1 ? __expf(tot - sc[2 * tp] + sc[64 + 2 * tp]) * 0.08838834764831845f : __expf(tot - sc[2 * tp]) * 0.125f;
                const float w1 = TYPE == 1 ? __expf(tot - sc[2 * tp + 1] + sc[64 + 2 * tp + 1]) * 0.08838834764831845f : __expf(tot - sc[2 * tp + 1]) * 0.125f;
#pragma unroll
                for (int j = 0; j < 8; ++j) dst[j * 40] = cvt_pk(k0[j] * w0, k1[j] * w1);
            }
        }
        __syncthreads();
        f32x4 acc[2][DK / 16];
#pragma unroll
        for (int i = 0; i < 2; ++i)
#pragma unroll
            for (int nt = 0; nt < DK / 16; ++nt) acc[i][nt] = (f32x4){0.f, 0.f, 0.f, 0.f};
#pragma unroll
        for (int kk = 0; kk < 2; ++kk) {
            bf16x8 fv[2];
#pragma unroll
            for (int i = 0; i < 2; ++i) fv[i] = *(const bf16x8*)(vT + (size_t)((2 * wid + i) * 16 + lr) * 80 + kk * 32 + lq * 8);
#pragma unroll
            for (int nt = 0; nt < DK / 16; ++nt) {
                const bf16x8 fk = *(const bf16x8*)(kT + (size_t)(nt * 16 + lr) * 80 + kk * 32 + lq * 8);
#pragma unroll
                for (int i = 0; i < 2; ++i) acc[i][nt] = __builtin_amdgcn_mfma_f32_16x16x32_bf16(fk, fv[i], acc[i][nt], 0, 0, 0);
            }
        }
        bf16_t* ub = U + (size_t)(chain * NCH + n) * 128 * DK;
#pragma unroll
        for (int i = 0; i < 2; ++i)
#pragma unroll
            for (int nt = 0; nt < DK / 16; ++nt) {
                const int e = (2 * wid + i) * 16 + lr, d = nt * 16 + lq * 4;
                u32x2 o; o.x = cvt_pk(acc[i][nt].x, acc[i][nt].y); o.y = cvt_pk(acc[i][nt].z, acc[i][nt].w);
                *(u32x2*)(ub + (size_t)e * DK + d) = o;
            }
        if (tid < DK) {
            const float tot = TYPE == 0 ? cum[tlast * 64 + (tid & 63)] : sc[128];
            DEC[(size_t)(chain * NCH + n) * 128 + tid] = __expf(tot);
            if (TYPE == 1) {
                float s = 0.f;
#pragma unroll
                for (int q = 0; q < 8; ++q) { const u32x4 u = *(const u32x4*)(kT + (size_t)tid * 80 + q * 8); float f[8]; UNPACK8(u, f);
#pragma unroll
                    for (int j = 0; j < 8; ++j) s += f[j]; }
                UN[(size_t)(chain * NCH + n) * 128 + tid] = s;
            }
        }
        __syncthreads();
    }
}

template <int TYPE>
__device__ __forceinline__ void u_phase_s(const Params& P, int l, char* lds) {
    typedef MX<TYPE> M; constexpr int DK = M::DK; constexpr int NIT = M::NOC * 32 / NTHR;
    const int tid = tid_l(), lane = tid & 63, wid = tid >> 6, lr = lane & 15, lq = lane >> 4;
    const bf16_t* pb = (const bf16_t*)(ws_l(P) + WS_PBUF);
    const float* small = (const float*)(ws_l(P) + WS_SMALL);
    bf16_t* U = (bf16_t*)(ws_l(P) + WS_SBUF); float* DEC = (float*)(ws_l(P) + WS_DEC); float* UN = (float*)(ws_l(P) + WS_UN);
    bf16_t* vT = (bf16_t*)(lds + L_VT); bf16_t* kT0 = (bf16_t*)(lds + 20480); bf16_t* kT1 = (bf16_t*)(lds + 40960);
    float* sc = (float*)(lds + L_SC);
    const int NU = NB * 4 * NCH, VG = vgrid(), slot = bid_l();
    for (int u0 = 0; u0 < NU; u0 += VG) {
        int unit = u0 + slot; int dmask = 3;
        if (VG == 512 && u0 >= 1024) { if (slot >= 2 * (NU - 1024)) continue; unit = 1024 + (slot >> 1); dmask = 1 << (slot & 1); }
        else if (unit >= NU) unit = NU - 1;
        const int c = unit % NCH; const int rest = unit / NCH; const int h = rest & 3, b = rest >> 2;
        const int r0 = rowbase(b, c);
        float kv[NIT][2][8];
#pragma unroll
        for (int i = 0; i < NIT; ++i) {
            const int pid = tid + i * NTHR, tp = pid & 31, oc = pid >> 5;
            load_qk8<TYPE>(P, l, pb, b, c, 2 * tp, h, oc, true, kv[i][0]);
            load_qk8<TYPE>(P, l, pb, b, c, 2 * tp + 1, h, oc, true, kv[i][1]);
        }
        if (TYPE == 1) {
            if (tid < 128) {
                const int dir = tid >> 6, t = tid & 63;
                const float fg = small[(size_t)(r0 + t) * 48 + 40 + dir * 4 + h] + P.in[I_FB][l * 8 + dir * 4 + h];
                float v = logsig(fg);
                if (dir == 0) {
#pragma unroll
                    for (int o = 1; o < 64; o <<= 1) { const float n = __shfl_up(v, o); if (t >= o) v += n; }
                } else {
#pragma unroll
                    for (int o = 1; o < 64; o <<= 1) { const float n = __shfl_down(v, o); if (t + o < 64) v += n; }
                }
                sc[dir * 64 + t] = v;
                sc[128 + dir * 64 + t] = small[(size_t)(r0 + t) * 48 + 32 + dir * 4 + h] + P.in[I_IB][l * 8 + dir * 4 + h];
            }
        } else {
            if (tid < 64) {
                const float lg0 = logsig(P.in[I_RDL][l * 8 + h]), lg1 = logsig(P.in[I_RDL][l * 8 + 4 + h]);
                sc[tid] = (float)(tid + 1) * lg0; sc[64 + tid] = (float)(64 - tid) * lg1;
            }
        }
        build_vT<TYPE>(pb, b, c, h, lds);
        __syncthreads();
        const float totf = sc[63], totb = sc[64];
        const float ks = TYPE == 1 ? 0.08838834764831845f : 0.125f;
#pragma unroll
        for (int i = 0; i < NIT; ++i) {
            const int pid = tid + i * NTHR, tp = pid & 31, oc = pid >> 5;
            const int t0 = 2 * tp, t1 = 2 * tp + 1;
            const float wf0 = __expf(totf - sc[t0] + (TYPE == 1 ? sc[128 + t0] : 0.f)) * ks, wf1 = __expf(totf - sc[t1] + (TYPE == 1 ? sc[128 + t1] : 0.f)) * ks;
            const float wb0 = __expf(totb - sc[64 + t0] + (TYPE == 1 ? sc[192 + t0] : 0.f)) * ks, wb1 = __expf(totb - sc[64 + t1] + (TYPE == 1 ? sc[192 + t1] : 0.f)) * ks;
            unsigned* d0 = (unsigned*)(kT0 + (size_t)(oc * 8) * 80 + 2 * tp); unsigned* d1 = (unsigned*)(kT1 + (size_t)(oc * 8) * 80 + 2 * tp);
#pragma unroll
            for (int j = 0; j < 8; ++j) { d0[j * 40] = cvt_pk(kv[i][0][j] * wf0, kv[i][1][j] * wf1); d1[j * 40] = cvt_pk(kv[i][0][j] * wb0, kv[i][1][j] * wb1); }
        }
        __syncthreads();
        const int chf = (b * 4 + h) * 2;
#pragma unroll 1
        for (int dir = 0; dir < 2; ++dir) {
            if (!((dmask >> dir) & 1)) continue;
            const bf16_t* kT = dir == 0 ? kT0 : kT1;
            const int n = scan_index(dir, c);
            f32x4 acc[2][DK / 16];
#pragma unroll
            for (int i = 0; i < 2; ++i)
#pragma unroll
                for (int nt = 0; nt < DK / 16; ++nt) acc[i][nt] = (f32x4){0.f, 0.f, 0.f, 0.f};
#pragma unroll
            for (int kk = 0; kk < 2; ++kk) {
                bf16x8 fv[2];
#pragma unroll
                for (int i = 0; i < 2; ++i) fv[i] = *(const bf16x8*)(vT + (size_t)((2 * wid + i) * 16 + lr) * 80 + kk * 32 + lq * 8);
#pragma unroll
                for (int nt = 0; nt < DK / 16; ++nt) {
                    const bf16x8 fk = *(const bf16x8*)(kT + (size_t)(nt * 16 + lr) * 80 + kk * 32 + lq * 8);
#pragma unroll
                    for (int i = 0; i < 2; ++i) acc[i][nt] = __builtin_amdgcn_mfma_f32_16x16x32_bf16(fk, fv[i], acc[i][nt], 0, 0, 0);
                }
            }
            bf16_t* ub = U + (size_t)((chf + dir) * NCH + n) * 128 * DK;
#pragma unroll
            for (int i = 0; i < 2; ++i)
#pragma unroll
                for (int nt = 0; nt < DK / 16; ++nt) {
                    const int e = (2 * wid + i) * 16 + lr, d = nt * 16 + lq * 4;
                    u32x2 o; o.x = cvt_pk(acc[i][nt].x, acc[i][nt].y); o.y = cvt_pk(acc[i][nt].z, acc[i][nt].w);
                    *(u32x2*)(ub + (size_t)e * DK + d) = o;
                }
        }
        if (tid < 2 * DK) {
            const int dir = tid / DK, d = tid % DK; const int n = scan_index(dir, c);
            if ((dmask >> dir) & 1) {
            DEC[(size_t)((chf + dir) * NCH + n) * 128 + d] = __expf(dir == 0 ? totf : totb);
            if (TYPE == 1) {
                const bf16_t* kT = dir == 0 ? kT0 : kT1;
                float sum = 0.f;
#pragma unroll
                for (int q = 0; q < 8; ++q) { const u32x4 u = *(const u32x4*)(kT + (size_t)d * 80 + q * 8); float f[8]; UNPACK8(u, f);
#pragma unroll
                    for (int j = 0; j < 8; ++j) sum += f[j]; }
                UN[(size_t)((chf + dir) * NCH + n) * 128 + d] = sum;
            }
            }
        }
        __syncthreads();
    }
}

template <int DK, bool HASN>
__device__ __forceinline__ void scan_phase(const Params& P) {
    bf16_t* U = (bf16_t*)(ws_l(P) + WS_SBUF); const float* DEC = (const float*)(ws_l(P) + WS_DEC); float* UN = (float*)(ws_l(P) + WS_UN);
    constexpr int VEC = DK / 64;
    constexpr int DQ = DK / VEC; constexpr int TT = 16 * 128 * DQ;
    constexpr size_t US = (size_t)128 * DK;
    for (int g = bid_l() * NTHR + tid_l(); g < TT; g += vgrid() * NTHR) {
        const int dq = g % DQ, e = (g / DQ) % 128, chain = g / (DQ * 128);
        bf16_t* up = U + ((size_t)chain * NCH * 128 + e) * DK + dq * VEC;
        const float* dp = DEC + (size_t)chain * NCH * 128 + dq * VEC;
        float S0 = 0.f, S1 = 0.f;
        constexpr int SB = 12;
        unsigned ua[SB], ubv[SB]; f32x2 da[SB], db[SB];
#define SC_LOAD(uu, dd, n0) do { _Pragma("unroll") for (int j = 0; j < SB; ++j) { \
            if (VEC == 2) { uu[j] = *(const unsigned*)(up + (size_t)((n0) + j) * US); dd[j] = *(const f32x2*)(dp + (size_t)((n0) + j) * 128); } \
            else { uu[j] = (unsigned)up[(size_t)((n0) + j) * US]; dd[j].x = dp[(size_t)((n0) + j) * 128]; dd[j].y = 0.f; } } } while (0)
#define SC_STEP(uu, dd, n0) do { _Pragma("unroll") for (int j = 0; j < SB; ++j) { \
            if (VEC == 2) { *(unsigned*)(up + (size_t)((n0) + j) * US) = cvt_pk(S0, S1); S0 = dd[j].x * S0 + bflo(uu[j]); S1 = dd[j].y * S1 + bfhi(uu[j]); } \
            else { up[(size_t)((n0) + j) * US] = (bf16_t)(cvt_pk(S0, 0.f) & 0xffffu); S0 = dd[j].x * S0 + bflo(uu[j]); } } } while (0)
        SC_LOAD(ua, da, 0);
        for (int n0 = 0; n0 < 120; n0 += 24) {
            SC_LOAD(ubv, db, n0 + 12);
            SC_STEP(ua, da, n0);
            SC_LOAD(ua, da, n0 + 24);
            SC_STEP(ubv, db, n0 + 12);
        }
        SC_STEP(ua, da, 120);
#undef SC_LOAD
#undef SC_STEP
    }
    if (HASN) {
        for (int g = bid_l() * NTHR + tid_l(); g < 16 * 128; g += vgrid() * NTHR) {
            const int d = g & 127, chain = g >> 7;
            float* np = UN + (size_t)chain * NCH * 128 + d; const float* dp = DEC + (size_t)chain * NCH * 128 + d;
            float S = 0.f;
            float ua_[12], da_[12], ub_[12], db_[12];
#define NS_LOAD(uu, dd, n0) do { _Pragma("unroll") for (int j = 0; j < 12; ++j) { uu[j] = np[(size_t)((n0) + j) * 128]; dd[j] = dp[(size_t)((n0) + j) * 128]; } } while (0)
#define NS_STEP(uu, dd, n0) do { _Pragma("unroll") for (int j = 0; j < 12; ++j) { np[(size_t)((n0) + j) * 128] = S; S = dd[j] * S + uu[j]; } } while (0)
            NS_LOAD(ua_, da_, 0);
            for (int n0 = 0; n0 < 120; n0 += 24) {
                NS_LOAD(ub_, db_, n0 + 12);
                NS_STEP(ua_, da_, n0);
                NS_LOAD(ua_, da_, n0 + 24);
                NS_STEP(ub_, db_, n0 + 12);
            }
            NS_STEP(ua_, da_, 120);
#undef NS_LOAD
#undef NS_STEP
        }
    }
}

template <int TYPE>
__device__ __forceinline__ void out_phase(const Params& P, int l, int pass, bool latent_only, char* lds) {
    typedef MX<TYPE> M; constexpr int DK = M::DK; constexpr int QP = M::QP;
    const int tid = tid_l(), lane = tid & 63, wid = tid >> 6, lr = lane & 15, lq = lane >> 4;
    const bf16_t* pb = (const bf16_t*)(ws_l(P) + WS_PBUF);
    const bf16_t* U = (const bf16_t*)(ws_l(P) + WS_SBUF); const float* UN = (const float*)(ws_l(P) + WS_UN);
    bf16_t* brp = (bf16_t*)(ws_l(P) + WS_BR);
    bf16_t* vT = (bf16_t*)(lds + L_VT); bf16_t* qin = (bf16_t*)(lds + L_Q); bf16_t* kin = qin + 64 * QP; bf16_t* att = (bf16_t*)(lds + L_ATT);
    const float* cum = (const float*)(lds + L_CUM); const float* sc = (const float*)(lds + L_SC);
    const float* ng = P.in[TYPE == 0 ? I_GNG : (TYPE == 1 ? I_MNG : I_RNG)] + l * 512;
    const int NC = latent_only ? NCH - 4 : NCH; const int NU = NB * 4 * NC, VG = vgrid(), slot = bid_l();
    for (int u0 = 0; u0 < NU; u0 += VG) {
        int unit = u0 + slot; if (unit >= NU) unit = NU - 1;
        const int c = unit % NC + (latent_only ? 4 : 0); const int rest = unit / NC; const int h = rest & 3, b = rest >> 2;
        const int r0 = rowbase(b, c);
        build_vT<TYPE>(pb, b, c, h, lds);
        f32x4 tot[8];
#pragma unroll
        for (int et = 0; et < 8; ++et) tot[et] = (f32x4){0.f, 0.f, 0.f, 0.f};
        const int trow = wid * 16 + lr;
        for (int dir = 0; dir < 2; ++dir) {
            const int chain = (b * 4 + h) * 2 + dir, n = scan_index(dir, c);
            decay_setup<TYPE>(P, l, b, c, h, dir, lds);
#pragma unroll 2
            for (int i = 0; i < 64 * M::NOC / NTHR; ++i) {
                const int pid = tid + i * NTHR, t = pid / M::NOC, oc = pid % M::NOC;
                float q8[8], k8[8];
                load_qk8<TYPE>(P, l, pb, b, c, t, h, oc, false, q8);
                load_qk8<TYPE>(P, l, pb, b, c, t, h, oc, true, k8);
                if (TYPE == 0) {
#pragma unroll
                    for (int j = 0; j < 8; ++j) { const float cv = cum[t * 64 + oc * 8 + j]; q8[j] *= __expf(cv) * 0.125f; k8[j] *= __expf(-cv); }
                } else {
                    const float cv = sc[t];
                    const float wq = __expf(cv);
                    const float wk = TYPE == 1 ? __expf(sc[64 + t] - cv) * 0.08838834764831845f : __expf(-cv) * 0.125f;
#pragma unroll
                    for (int j = 0; j < 8; ++j) { q8[j] *= wq; k8[j] *= wk; }
                }
                u32x4 oq, ok;
                oq.x = cvt_pk(q8[0], q8[1]); oq.y = cvt_pk(q8[2], q8[3]); oq.z = cvt_pk(q8[4], q8[5]); oq.w = cvt_pk(q8[6], q8[7]);
                ok.x = cvt_pk(k8[0], k8[1]); ok.y = cvt_pk(k8[2], k8[3]); ok.z = cvt_pk(k8[4], k8[5]); ok.w = cvt_pk(k8[6], k8[7]);
                *(u32x4*)(qin + (size_t)t * QP + oc * 8) = oq;
                *(u32x4*)(kin + (size_t)t * QP + oc * 8) = ok;
            }
            __syncthreads();
            f32x4 sacc[4];
#pragma unroll
            for (int nt = 0; nt < 4; ++nt) sacc[nt] = (f32x4){0.f, 0.f, 0.f, 0.f};
#pragma unroll
            for (int kk = 0; kk < DK / 32; ++kk) {
                const bf16x8 fq = *(const bf16x8*)(qin + (size_t)trow * QP + kk * 32 + lq * 8);
#pragma unroll
                for (int nt = 0; nt < 4; ++nt) {
                    const bf16x8 fk = *(const bf16x8*)(kin + (size_t)(nt * 16 + lr) * QP + kk * 32 + lq * 8);
                    sacc[nt] = __builtin_amdgcn_mfma_f32_16x16x32_bf16(fk, fq, sacc[nt], 0, 0, 0);
                }
            }
            float den = 0.f;
#pragma unroll
            for (int nt = 0; nt < 4; ++nt) {
                const int s0 = nt * 16 + lq * 4;
                float a0 = sacc[nt].x, a1 = sacc[nt].y, a2 = sacc[nt].z, a3 = sacc[nt].w;
                if (dir == 0) { if (s0 + 0 > trow) a0 = 0.f; if (s0 + 1 > trow) a1 = 0.f; if (s0 + 2 > trow) a2 = 0.f; if (s0 + 3 > trow) a3 = 0.f; }
                else { if (s0 + 0 < trow) a0 = 0.f; if (s0 + 1 < trow) a1 = 0.f; if (s0 + 2 < trow) a2 = 0.f; if (s0 + 3 < trow) a3 = 0.f; }
                den += (a0 + a1) + (a2 + a3);
                u32x2 o; o.x = cvt_pk(a0, a1); o.y = cvt_pk(a2, a3);
                *(u32x2*)(att + (size_t)trow * 80 + s0) = o;
            }
            __syncthreads();
            f32x4 oacc[8];
#pragma unroll
            for (int et = 0; et < 8; ++et) oacc[et] = (f32x4){0.f, 0.f, 0.f, 0.f};
#pragma unroll
            for (int kk = 0; kk < 2; ++kk) {
                const bf16x8 fa = *(const bf16x8*)(att + (size_t)trow * 80 + kk * 32 + lq * 8);
#pragma unroll
                for (int et = 0; et < 8; ++et) {
                    const bf16x8 fv = *(const bf16x8*)(vT + (size_t)(et * 16 + lr) * 80 + kk * 32 + lq * 8);
                    oacc[et] = __builtin_amdgcn_mfma_f32_16x16x32_bf16(fv, fa, oacc[et], 0, 0, 0);
                }
            }
            const bf16_t* sp = U + (size_t)(chain * NCH + n) * 128 * DK;
#pragma unroll
            for (int kk = 0; kk < DK / 32; ++kk) {
                const bf16x8 fq = *(const bf16x8*)(qin + (size_t)trow * QP + kk * 32 + lq * 8);
#pragma unroll
                for (int et = 0; et < 8; ++et) {
                    const bf16x8 fs = *(const bf16x8*)(sp + (size_t)(et * 16 + lr) * DK + kk * 32 + lq * 8);
                    oacc[et] = __builtin_amdgcn_mfma_f32_16x16x32_bf16(fs, fq, oacc[et], 0, 0, 0);
                }
            }
            if (TYPE == 1) {
                const float* np = UN + (size_t)(chain * NCH + n) * 128 + lq * 32;
#pragma unroll
                for (int q = 0; q < 4; ++q) {
                    const u32x4 u = *(const u32x4*)(qin + (size_t)trow * QP + lq * 32 + q * 8); float f[8]; UNPACK8(u, f);
                    const f32x4 n0 = *(const f32x4*)(np + q * 8), n1 = *(const f32x4*)(np + q * 8 + 4);
                    den += f[0] * n0.x + f[1] * n0.y + f[2] * n0.z + f[3] * n0.w + f[4] * n1.x + f[5] * n1.y + f[6] * n1.z + f[7] * n1.w;
                }
                den += __shfl_xor(den, 16); den += __shfl_xor(den, 32);
                const float sc1 = 1.f / fmaxf(fabsf(den), 1.f);
#pragma unroll
                for (int et = 0; et < 8; ++et) tot[et] += oacc[et] * sc1;
            } else {
#pragma unroll
                for (int et = 0; et < 8; ++et) tot[et] += oacc[et];
            }
            __syncthreads();
        }
        float s1 = 0.f;
#pragma unroll
        for (int et = 0; et < 8; ++et) s1 += (tot[et].x + tot[et].y) + (tot[et].z + tot[et].w);
        s1 += __shfl_xor(s1, 16); s1 += __shfl_xor(s1, 32);
        const float mean = TYPE == 0 ? 0.f : s1 * (1.f / 128.f);
        float s2 = 0.f;
#pragma unroll
        for (int et = 0; et < 8; ++et) { tot[et] = tot[et] - mean; s2 += (tot[et].x * tot[et].x + tot[et].y * tot[et].y) + (tot[et].z * tot[et].z + tot[et].w * tot[et].w); }
        s2 += __shfl_xor(s2, 16); s2 += __shfl_xor(s2, 32);
        const float rstd = rsqrtf(s2 * (1.f / 128.f) + 1e-6f);
        const size_t rowi = (size_t)(r0 + trow);
#pragma unroll
        for (int et = 0; et < 8; ++et) {
            const int e = et * 16 + lq * 4;
            const f32x4 gg = *(const f32x4*)(ng + h * 128 + e);
            const u32x2 gu = *(const u32x2*)(pb + rowi * M::PITCH + M::GOFF + h * 128 + e);
            const float g0 = bflo(gu.x), g1 = bfhi(gu.x), g2 = bflo(gu.y), g3 = bfhi(gu.y);
            u32x2 o;
            float y0 = tot[et].x * rstd * gg.x * siluf(g0), y1 = tot[et].y * rstd * gg.y * siluf(g1), y2 = tot[et].z * rstd * gg.z * siluf(g2), y3 = tot[et].w * rstd * gg.w * siluf(g3);
            o.x = cvt_pk(y0, y1); o.y = cvt_pk(y2, y3);
            *(u32x2*)(brp + rowi * 1536 + pass * 512 + h * 128 + e) = o;
        }
        __syncthreads();
    }
}

template <int TYPE>
__device__ __forceinline__ void out_phase_s(const Params& P, int l, int pass, bool latent_only, char* lds) {
    typedef MX<TYPE> M; constexpr int DK = M::DK; constexpr int QP = M::QP; constexpr int NKK = DK / 32;
    const bf16_t* pb = (const bf16_t*)(ws_l(P) + WS_PBUF);
    const bf16_t* U = (const bf16_t*)(ws_l(P) + WS_SBUF); const float* UN = (const float*)(ws_l(P) + WS_UN);
    const float* small = (const float*)(ws_l(P) + WS_SMALL);
    bf16_t* brp = (bf16_t*)(ws_l(P) + WS_BR);
    bf16_t* vT = (bf16_t*)(lds + L_VT); bf16_t* qr = (bf16_t*)(lds + L_Q); bf16_t* kr = qr + 64 * QP; bf16_t* att = (bf16_t*)(lds + L_ATT);
    float* sc = (float*)(lds + L_SC);
    float* sn = sc + 256;
    float* rsv = sc + 512;
    float* part = sc + 640;
    float* ec = sc + 1152;
    const float* ng = P.in[TYPE == 1 ? I_MNG : I_RNG] + l * 512;
    const int NC = latent_only ? NCH - 4 : NCH; const int NU = NB * 4 * NC, VG = vgrid(), slot = bid_l();
    for (int u0 = 0; u0 < NU; u0 += VG) {
        int unit = u0 + slot; if (unit >= NU) unit = NU - 1;
        const int tid = tid_l(), lane = tid & 63, wid = tid >> 6, lr = lane & 15, lq = lane >> 4;
        const int c = unit % NC + (latent_only ? 4 : 0); const int rest = unit / NC; const int h = rest & 3, b = rest >> 2;
        const int r0 = rowbase(b, c);
        const int trow = wid * 16 + lr;
        const int chf = (b * 4 + h) * 2, nf = scan_index(0, c), nb = scan_index(1, c);
        if (TYPE == 1) {
            sn[tid] = UN[(size_t)((chf + (tid >> 7)) * NCH + ((tid >> 7) == 0 ? nf : nb)) * 128 + (tid & 127)];
            if (tid < 128) {
                const int dir = tid >> 6, t = tid & 63;
                const float fg = small[(size_t)(r0 + t) * 48 + 40 + dir * 4 + h] + P.in[I_FB][l * 8 + dir * 4 + h];
                float v = logsig(fg);
                if (dir == 0) {
#pragma unroll
                    for (int o = 1; o < 64; o <<= 1) { const float n = __shfl_up(v, o); if (t >= o) v += n; }
                } else {
#pragma unroll
                    for (int o = 1; o < 64; o <<= 1) { const float n = __shfl_down(v, o); if (t + o < 64) v += n; }
                }
                sc[dir * 64 + t] = v;
                const float liv = small[(size_t)(r0 + t) * 48 + 32 + dir * 4 + h] + P.in[I_IB][l * 8 + dir * 4 + h];
                sc[128 + dir * 64 + t] = liv;
                ec[dir * 64 + t] = __expf(liv - v);
            }
        } else {
            if (tid < 64) {
                const float lg0 = logsig(P.in[I_RDL][l * 8 + h]), lg1 = logsig(P.in[I_RDL][l * 8 + 4 + h]);
                sc[tid] = (float)(tid + 1) * lg0; sc[64 + tid] = (float)(64 - tid) * lg1;
                ec[tid] = __expf(-(float)(tid + 1) * lg0); ec[64 + tid] = __expf(-(float)(64 - tid) * lg1);
            }
        }
        float wq[24], wk[24];
        if (TYPE == 1) { load_convw(P, l, h, tid % M::NOC, false, wq); load_convw(P, l, h, tid % M::NOC, true, wk); }
        build_vT<TYPE>(pb, b, c, h, lds);
#pragma unroll
        for (int i = 0; i < 64 * M::NOC / NTHR; ++i) {
            const int pid = tid + i * NTHR, t = pid / M::NOC, oc = pid % M::NOC;
            float q8[8], k8[8];
            load_qk8<TYPE>(P, l, pb, b, c, t, h, oc, false, q8, TYPE == 1 ? wq : nullptr);
            load_qk8<TYPE>(P, l, pb, b, c, t, h, oc, true, k8, TYPE == 1 ? wk : nullptr);
            const float ks = TYPE == 1 ? 0.08838834764831845f : 0.125f;
            u32x4 oq, ok;
            oq.x = cvt_pk(q8[0], q8[1]); oq.y = cvt_pk(q8[2], q8[3]); oq.z = cvt_pk(q8[4], q8[5]); oq.w = cvt_pk(q8[6], q8[7]);
            ok.x = cvt_pk(k8[0] * ks, k8[1] * ks); ok.y = cvt_pk(k8[2] * ks, k8[3] * ks); ok.z = cvt_pk(k8[4] * ks, k8[5] * ks); ok.w = cvt_pk(k8[6] * ks, k8[7] * ks);
            *(u32x4*)(qr + (size_t)t * QP + oc * 8) = oq;
            *(u32x4*)(kr + (size_t)t * QP + oc * 8) = ok;
        }
        const bf16_t* spf = U + (size_t)(chf * NCH + nf) * 128 * DK; const bf16_t* spb = U + (size_t)((chf + 1) * NCH + nb) * 128 * DK;
        bf16x8 fsf[2][NKK], fsb[2][NKK];
#pragma unroll
        for (int i = 0; i < 2; ++i)
#pragma unroll
            for (int kk = 0; kk < NKK; ++kk) {
                fsf[i][kk] = *(const bf16x8*)(spf + (size_t)((2 * wid + i) * 16 + lr) * DK + kk * 32 + lq * 8);
                fsb[i][kk] = *(const bf16x8*)(spb + (size_t)((2 * wid + i) * 16 + lr) * DK + kk * 32 + lq * 8);
            }
        u32x2 gu[4][2];
#pragma unroll
        for (int mt = 0; mt < 4; ++mt)
#pragma unroll
            for (int i = 0; i < 2; ++i) gu[mt][i] = *(const u32x2*)(pb + (size_t)(r0 + mt * 16 + lr) * M::PITCH + M::GOFF + h * 128 + (2 * wid + i) * 16 + lq * 4);
        __syncthreads();
        f32x4 sacc[4];
#pragma unroll
        for (int nt = 0; nt < 4; ++nt) sacc[nt] = (f32x4){0.f, 0.f, 0.f, 0.f};
#pragma unroll
        for (int kk = 0; kk < NKK; ++kk) {
            const bf16x8 fq = *(const bf16x8*)(qr + (size_t)trow * QP + kk * 32 + lq * 8);
#pragma unroll
            for (int nt = 0; nt < 4; ++nt) {
                const bf16x8 fk = *(const bf16x8*)(kr + (size_t)(nt * 16 + lr) * QP + kk * 32 + lq * 8);
                sacc[nt] = __builtin_amdgcn_mfma_f32_16x16x32_bf16(fk, fq, sacc[nt], 0, 0, 0);
            }
        }
        {
            const float cft = sc[trow], cbt = sc[64 + trow];
            const float eft = __expf(cft), ebt = __expf(cbt);
            float af[4][4], ab[4][4]; float denf = 0.f, denb = 0.f;
#pragma unroll
            for (int nt = 0; nt < 4; ++nt) {
                const float av[4] = {sacc[nt].x, sacc[nt].y, sacc[nt].z, sacc[nt].w};
                const int sb_ = nt * 16 + lq * 4;
                const f32x4 e4f = *(const f32x4*)(ec + sb_), e4b = *(const f32x4*)(ec + 64 + sb_);
                const float efs[4] = {e4f.x, e4f.y, e4f.z, e4f.w}, ebs[4] = {e4b.x, e4b.y, e4b.z, e4b.w};
#pragma unroll
                for (int r = 0; r < 4; ++r) {
                    const int s_ = sb_ + r;
                    const float wf = s_ <= trow ? eft * efs[r] : 0.f, wb = s_ >= trow ? ebt * ebs[r] : 0.f;
                    af[nt][r] = av[r] * wf; ab[nt][r] = av[r] * wb; denf += af[nt][r]; denb += ab[nt][r];
                }
            }
            float scf = 1.f, scb = 1.f;
            if (TYPE == 1) {
                float qf = 0.f, qb = 0.f;
#pragma unroll
                for (int q = 0; q < 4; ++q) {
                    const u32x4 u = *(const u32x4*)(qr + (size_t)trow * QP + lq * 32 + q * 8); float f[8]; UNPACK8(u, f);
                    const float* a = sn + lq * 32 + q * 8; const float* bq = sn + 128 + lq * 32 + q * 8;
                    const f32x4 a0 = *(const f32x4*)a, a1 = *(const f32x4*)(a + 4), b0 = *(const f32x4*)bq, b1 = *(const f32x4*)(bq + 4);
                    qf += f[0] * a0.x + f[1] * a0.y + f[2] * a0.z + f[3] * a0.w + f[4] * a1.x + f[5] * a1.y + f[6] * a1.z + f[7] * a1.w;
                    qb += f[0] * b0.x + f[1] * b0.y + f[2] * b0.z + f[3] * b0.w + f[4] * b1.x + f[5] * b1.y + f[6] * b1.z + f[7] * b1.w;
                }
                denf += eft * qf; denb += ebt * qb;
                denf += __shfl_xor(denf, 16); denf += __shfl_xor(denf, 32);
                denb += __shfl_xor(denb, 16); denb += __shfl_xor(denb, 32);
                scf = 1.f / fmaxf(fabsf(denf), 1.f); scb = 1.f / fmaxf(fabsf(denb), 1.f);
            }
#pragma unroll
            for (int nt = 0; nt < 4; ++nt) {
                u32x2 o; o.x = cvt_pk(af[nt][0] * scf + ab[nt][0] * scb, af[nt][1] * scf + ab[nt][1] * scb); o.y = cvt_pk(af[nt][2] * scf + ab[nt][2] * scb, af[nt][3] * scf + ab[nt][3] * scb);
                *(u32x2*)(att + (size_t)trow * 80 + nt * 16 + lq * 4) = o;
            }
            if (lq == 0) { rsv[trow] = eft * scf; rsv[64 + trow] = ebt * scb; }
        }
        __syncthreads();
        f32x4 oacc[4][2];
#pragma unroll
        for (int mt = 0; mt < 4; ++mt)
#pragma unroll
            for (int i = 0; i < 2; ++i) oacc[mt][i] = (f32x4){0.f, 0.f, 0.f, 0.f};
#pragma unroll
        for (int kk = 0; kk < 2; ++kk) {
            bf16x8 fv[2];
#pragma unroll
            for (int i = 0; i < 2; ++i) fv[i] = *(const bf16x8*)(vT + (size_t)((2 * wid + i) * 16 + lr) * 80 + kk * 32 + lq * 8);
#pragma unroll
            for (int mt = 0; mt < 4; ++mt) {
                const bf16x8 fa = *(const bf16x8*)(att + (size_t)(mt * 16 + lr) * 80 + kk * 32 + lq * 8);
#pragma unroll
                for (int i = 0; i < 2; ++i) oacc[mt][i] = __builtin_amdgcn_mfma_f32_16x16x32_bf16(fv[i], fa, oacc[mt][i], 0, 0, 0);
            }
        }
#pragma unroll
        for (int dir = 0; dir < 2; ++dir) {
            f32x4 tmp[4][2];
#pragma unroll
            for (int mt = 0; mt < 4; ++mt)
#pragma unroll
                for (int i = 0; i < 2; ++i) tmp[mt][i] = (f32x4){0.f, 0.f, 0.f, 0.f};
#pragma unroll
            for (int kk = 0; kk < NKK; ++kk)
#pragma unroll
                for (int mt = 0; mt < 4; ++mt) {
                    const bf16x8 fq = *(const bf16x8*)(qr + (size_t)(mt * 16 + lr) * QP + kk * 32 + lq * 8);
#pragma unroll
                    for (int i = 0; i < 2; ++i) tmp[mt][i] = __builtin_amdgcn_mfma_f32_16x16x32_bf16(dir == 0 ? fsf[i][kk] : fsb[i][kk], fq, tmp[mt][i], 0, 0, 0);
                }
#pragma unroll
            for (int mt = 0; mt < 4; ++mt) {
                const float rs = rsv[dir * 64 + mt * 16 + lr];
#pragma unroll
                for (int i = 0; i < 2; ++i) oacc[mt][i] += tmp[mt][i] * rs;
            }
        }
#pragma unroll
        for (int mt = 0; mt < 4; ++mt) {
            float s1 = (oacc[mt][0].x + oacc[mt][0].y) + (oacc[mt][0].z + oacc[mt][0].w) + (oacc[mt][1].x + oacc[mt][1].y) + (oacc[mt][1].z + oacc[mt][1].w);
            float s2 = (oacc[mt][0].x * oacc[mt][0].x + oacc[mt][0].y * oacc[mt][0].y) + (oacc[mt][0].z * oacc[mt][0].z + oacc[mt][0].w * oacc[mt][0].w)
                     + (oacc[mt][1].x * oacc[mt][1].x + oacc[mt][1].y * oacc[mt][1].y) + (oacc[mt][1].z * oacc[mt][1].z + oacc[mt][1].w * oacc[mt][1].w);
            s1 += __shfl_xor(s1, 16); s1 += __shfl_xor(s1, 32); s2 += __shfl_xor(s2, 16); s2 += __shfl_xor(s2, 32);
            if (lq == 0) { part[(wid * 64 + mt * 16 + lr) * 2] = s1; part[(wid * 64 + mt * 16 + lr) * 2 + 1] = s2; }
        }
        __syncthreads();
#pragma unroll
        for (int mt = 0; mt < 4; ++mt) {
            const int t = mt * 16 + lr;
            float s1 = 0.f, s2 = 0.f;
#pragma unroll
            for (int w = 0; w < 4; ++w) { s1 += part[(w * 64 + t) * 2]; s2 += part[(w * 64 + t) * 2 + 1]; }
            const float mean = s1 * (1.f / 128.f);
            const float rstd = rsqrtf(fmaxf(s2 * (1.f / 128.f) - mean * mean, 0.f) + 1e-6f);
            const size_t rowi = (size_t)(r0 + t);
#pragma unroll
            for (int i = 0; i < 2; ++i) {
                const int e = (2 * wid + i) * 16 + lq * 4;
                const f32x4 gg = *(const f32x4*)(ng + h * 128 + e);
                const float g0 = bflo(gu[mt][i].x), g1 = bfhi(gu[mt][i].x), g2 = bflo(gu[mt][i].y), g3 = bfhi(gu[mt][i].y);
                u32x2 o;
                o.x = cvt_pk((oacc[mt][i].x - mean) * rstd * gg.x * siluf(g0), (oacc[mt][i].y - mean) * rstd * gg.y * siluf(g1));
                o.y = cvt_pk((oacc[mt][i].z - mean) * rstd * gg.z * siluf(g2), (oacc[mt][i].w - mean) * rstd * gg.w * siluf(g3));
                *(u32x2*)(brp + rowi * 1536 + pass * 512 + h * 128 + e) = o;
            }
        }
        __syncthreads();
    }
}

__device__ __forceinline__ void out_phase_g(const Params& P, int l, bool latent_only, char* lds) {
    typedef MX<0> M; constexpr int DK = 64, QP = 80;
    const bf16_t* pb = (const bf16_t*)(ws_l(P) + WS_PBUF);
    const bf16_t* U = (const bf16_t*)(ws_l(P) + WS_SBUF);
    const float* small = (const float*)(ws_l(P) + WS_SMALL);
    bf16_t* brp = (bf16_t*)(ws_l(P) + WS_BR);
    bf16_t* vT = (bf16_t*)(lds + L_VT); bf16_t* qin = (bf16_t*)(lds + L_Q); bf16_t* kin = qin + 64 * QP; bf16_t* att = (bf16_t*)(lds + L_ATT);
    float* cum = (float*)(lds + L_CUM); float* part = cum;
    const float* ng = P.in[I_GNG] + l * 512;
    const int NC = latent_only ? NCH - 4 : NCH; const int NU = NB * 4 * NC, VG = vgrid(), slot = bid_l();
    for (int u0 = 0; u0 < NU; u0 += VG) {
        int unit = u0 + slot; if (unit >= NU) unit = NU - 1;
        const int tid = tid_l(), lane = tid & 63, wid = tid >> 6, lr = lane & 15, lq = lane >> 4;
        const int c = unit % NC + (latent_only ? 4 : 0); const int rest = unit / NC; const int h = rest & 3, b = rest >> 2;
        const int r0 = rowbase(b, c);
        const int trow = wid * 16 + lr;
        const int chf = (b * 4 + h) * 2, nf = scan_index(0, c), nb = scan_index(1, c);
        float qraw[2][8], kraw[2][8], apre[2][4];
#pragma unroll
        for (int i = 0; i < 2; ++i) {
            const int pid = tid + i * NTHR, t = pid >> 3, oc = pid & 7;
            load_qk8<0>(P, l, pb, b, c, t, h, oc, false, qraw[i]);
            load_qk8<0>(P, l, pb, b, c, t, h, oc, true, kraw[i]);
        }
#pragma unroll
        for (int dir = 0; dir < 2; ++dir)
#pragma unroll
            for (int k = 0; k < 4; ++k) { const int i = tid + k * NTHR; apre[dir][k] = small[(size_t)(r0 + (i >> 4)) * 48 + dir * 16 + (i & 15)]; }
        build_vT<0>(pb, b, c, h, lds);
        const bf16_t* spf = U + (size_t)(chf * NCH + nf) * 128 * DK; const bf16_t* spb = U + (size_t)((chf + 1) * NCH + nb) * 128 * DK;
        bf16x8 fsf[2][2], fsb[2][2];
#pragma unroll
        for (int i = 0; i < 2; ++i)
#pragma unroll
            for (int kk = 0; kk < 2; ++kk) {
                fsf[i][kk] = *(const bf16x8*)(spf + (size_t)((2 * wid + i) * 16 + lr) * DK + kk * 32 + lq * 8);
                fsb[i][kk] = *(const bf16x8*)(spb + (size_t)((2 * wid + i) * 16 + lr) * DK + kk * 32 + lq * 8);
            }
        u32x2 gu[4][2];
#pragma unroll
        for (int mt = 0; mt < 4; ++mt)
#pragma unroll
            for (int i = 0; i < 2; ++i) gu[mt][i] = *(const u32x2*)(pb + (size_t)(r0 + mt * 16 + lr) * M::PITCH + M::GOFF + h * 128 + (2 * wid + i) * 16 + lq * 4);
        f32x4 oacc[4][2];
#pragma unroll
        for (int mt = 0; mt < 4; ++mt)
#pragma unroll
            for (int i = 0; i < 2; ++i) oacc[mt][i] = (f32x4){0.f, 0.f, 0.f, 0.f};
#pragma unroll
        for (int dir = 0; dir < 2; ++dir) {
            decay_setup<0>(P, l, b, c, h, dir, lds, apre[dir]);
#pragma unroll
            for (int i = 0; i < 2; ++i) {
                const int pid = tid + i * NTHR, t = pid >> 3, oc = pid & 7;
                float q8[8], k8[8];
#pragma unroll
                for (int j = 0; j < 8; ++j) { const float cv = cum[t * 64 + oc * 8 + j]; q8[j] = qraw[i][j] * (__expf(cv) * 0.125f); k8[j] = kraw[i][j] * __expf(-cv); }
                u32x4 oq, ok;
                oq.x = cvt_pk(q8[0], q8[1]); oq.y = cvt_pk(q8[2], q8[3]); oq.z = cvt_pk(q8[4], q8[5]); oq.w = cvt_pk(q8[6], q8[7]);
                ok.x = cvt_pk(k8[0], k8[1]); ok.y = cvt_pk(k8[2], k8[3]); ok.z = cvt_pk(k8[4], k8[5]); ok.w = cvt_pk(k8[6], k8[7]);
                *(u32x4*)(qin + (size_t)t * QP + oc * 8) = oq;
                *(u32x4*)(kin + (size_t)t * QP + oc * 8) = ok;
            }
            __syncthreads();
            f32x4 sacc[4];
#pragma unroll
            for (int nt = 0; nt < 4; ++nt) sacc[nt] = (f32x4){0.f, 0.f, 0.f, 0.f};
#pragma unroll
            for (int kk = 0; kk < 2; ++kk) {
                const bf16x8 fq = *(const bf16x8*)(qin + (size_t)trow * QP + kk * 32 + lq * 8);
#pragma unroll
                for (int nt = 0; nt < 4; ++nt) {
                    const bf16x8 fk = *(const bf16x8*)(kin + (size_t)(nt * 16 + lr) * QP + kk * 32 + lq * 8);
                    sacc[nt] = __builtin_amdgcn_mfma_f32_16x16x32_bf16(fk, fq, sacc[nt], 0, 0, 0);
                }
            }
#pragma unroll
            for (int nt = 0; nt < 4; ++nt) {
                const int s0 = nt * 16 + lq * 4;
                float a0 = sacc[nt].x, a1 = sacc[nt].y, a2 = sacc[nt].z, a3 = sacc[nt].w;
                if (dir == 0) { if (s0 + 0 > trow) a0 = 0.f; if (s0 + 1 > trow) a1 = 0.f; if (s0 + 2 > trow) a2 = 0.f; if (s0 + 3 > trow) a3 = 0.f; }
                else { if (s0 + 0 < trow) a0 = 0.f; if (s0 + 1 < trow) a1 = 0.f; if (s0 + 2 < trow) a2 = 0.f; if (s0 + 3 < trow) a3 = 0.f; }
                u32x2 o; o.x = cvt_pk(a0, a1); o.y = cvt_pk(a2, a3);
                *(u32x2*)(att + (size_t)trow * 80 + s0) = o;
            }
            __syncthreads();
#pragma unroll
            for (int kk = 0; kk < 2; ++kk) {
                bf16x8 fv[2];
#pragma unroll
                for (int i = 0; i < 2; ++i) fv[i] = *(const bf16x8*)(vT + (size_t)((2 * wid + i) * 16 + lr) * 80 + kk * 32 + lq * 8);
#pragma unroll
                for (int mt = 0; mt < 4; ++mt) {
                    const bf16x8 fa = *(const bf16x8*)(att + (size_t)(mt * 16 + lr) * 80 + kk * 32 + lq * 8);
                    const bf16x8 fq = *(const bf16x8*)(qin + (size_t)(mt * 16 + lr) * QP + kk * 32 + lq * 8);
#pragma unroll
                    for (int i = 0; i < 2; ++i) {
                        oacc[mt][i] = __builtin_amdgcn_mfma_f32_16x16x32_bf16(fv[i], fa, oacc[mt][i], 0, 0, 0);
                        oacc[mt][i] = __builtin_amdgcn_mfma_f32_16x16x32_bf16(dir == 0 ? fsf[i][kk] : fsb[i][kk], fq, oacc[mt][i], 0, 0, 0);
                    }
                }
            }
            __syncthreads();
        }
#pragma unroll
        for (int mt = 0; mt < 4; ++mt) {
            float s2 = (oacc[mt][0].x * oacc[mt][0].x + oacc[mt][0].y * oacc[mt][0].y) + (oacc[mt][0].z * oacc[mt][0].z + oacc[mt][0].w * oacc[mt][0].w)
                     + (oacc[mt][1].x * oacc[mt][1].x + oacc[mt][1].y * oacc[mt][1].y) + (oacc[mt][1].z * oacc[mt][1].z + oacc[mt][1].w * oacc[mt][1].w);
            s2 += __shfl_xor(s2, 16); s2 += __shfl_xor(s2, 32);
            if (lq == 0) part[wid * 64 + mt * 16 + lr] = s2;
        }
        __syncthreads();
#pragma unroll
        for (int mt = 0; mt < 4; ++mt) {
            const int t = mt * 16 + lr;
            const float s2 = (part[t] + part[64 + t]) + (part[128 + t] + part[192 + t]);
            const float rstd = rsqrtf(s2 * (1.f / 128.f) + 1e-6f);
            const size_t rowi = (size_t)(r0 + t);
#pragma unroll
            for (int i = 0; i < 2; ++i) {
                const int e = (2 * wid + i) * 16 + lq * 4;
                const f32x4 gg = *(const f32x4*)(ng + h * 128 + e);
                const float g0 = bflo(gu[mt][i].x), g1 = bfhi(gu[mt][i].x), g2 = bflo(gu[mt][i].y), g3 = bfhi(gu[mt][i].y);
                u32x2 o;
                o.x = cvt_pk(oacc[mt][i].x * rstd * gg.x * siluf(g0), oacc[mt][i].y * rstd * gg.y * siluf(g1));
                o.y = cvt_pk(oacc[mt][i].z * rstd * gg.z * siluf(g2), oacc[mt][i].w * rstd * gg.w * siluf(g3));
                *(u32x2*)(brp + rowi * 1536 + h * 128 + e) = o;
            }
        }
        __syncthreads();
    }
}

template <int NI, class F>
__device__ __forceinline__ void ctx_gemm(const bf16_t* A, int lda, const bf16_t* Bt, int ldb, int K, int N, const F& f, char* lds) {
    const int tid = tid_l(), lane = tid & 63, wid = tid >> 6, wm = wid >> 1, wn = wid & 1, lr = lane & 15, lq = lane >> 4;
    const int Nt = (N + 32 * NI - 1) / (32 * NI);
    const int total = 4 * Nt, VG = vgrid(), slot = bid_l();
    for (int t0 = 0; t0 < total; t0 += VG) {
        const int t = t0 + (VG - 1 - slot); if (t >= total) continue;
        const int tm = t & 3, tn = t >> 2;
        f32x4 acc[4][NI];
#pragma unroll
        for (int mi = 0; mi < 4; ++mi)
#pragma unroll
            for (int ni = 0; ni < NI; ++ni) acc[mi][ni] = (f32x4){0.f, 0.f, 0.f, 0.f};
        gemm_kloop<NI>(acc, A + (size_t)(RL + tm * 128) * lda, lda, Bt + (size_t)tn * (32 * NI) * ldb, ldb, K, lds);
#pragma unroll
        for (int mi = 0; mi < 4; ++mi)
#pragma unroll
            for (int ni = 0; ni < NI; ++ni) f(RL + tm * 128 + wm * 64 + mi * 16 + lr, tn * (32 * NI) + wn * (16 * NI) + ni * 16 + lq * 4, acc[mi][ni], 0);
    }
}
__device__ __forceinline__ void ctx_merge(const Params& P, char* lds) {
    const int tid = tid_l(), lane = tid & 63, wid = tid >> 6, wm = wid >> 1, wn = wid & 1, lr = lane & 15, lq = lane >> 4;
    const bf16_t* br = (const bf16_t*)(ws_l(P) + WS_BR); const bf16_t* wb = (const bf16_t*)(ws_l(P) + WS_WTBR);
    const bf16_t* gs = (const bf16_t*)(ws_l(P) + WS_GS); bf16_t* mb = (bf16_t*)(ws_l(P) + WS_MB);
    const int total = 64, VG = vgrid(), slot = bid_l();
    for (int t0 = 0; t0 < total; t0 += VG) {
        const int t = t0 + (VG - 1 - slot); if (t >= total) continue;
        const int tm = t & 3, tn = t >> 2;
        f32x4 m[4][2];
#pragma unroll
        for (int mi = 0; mi < 4; ++mi)
#pragma unroll
            for (int ni = 0; ni < 2; ++ni) m[mi][ni] = (f32x4){0.f, 0.f, 0.f, 0.f};
#pragma unroll 1
        for (int j = 0; j < 3; ++j) {
            f32x4 acc[4][2];
#pragma unroll
            for (int mi = 0; mi < 4; ++mi)
#pragma unroll
                for (int ni = 0; ni < 2; ++ni) acc[mi][ni] = (f32x4){0.f, 0.f, 0.f, 0.f};
            gemm_kloop<2>(acc, br + (size_t)(RL + tm * 128) * 1536 + j * 512, 1536, wb + ((size_t)j * 1024 + tn * 64) * 512, 512, 512, lds);
#pragma unroll
            for (int mi = 0; mi < 4; ++mi)
#pragma unroll
                for (int ni = 0; ni < 2; ++ni) {
                    const int r = RL + tm * 128 + wm * 64 + mi * 16 + lr, c = tn * 64 + wn * 32 + ni * 16 + lq * 4;
                    const u32x2 g = *(const u32x2*)(gs + (size_t)r * 3072 + j * 1024 + c);
                    m[mi][ni].x += acc[mi][ni].x * bflo(g.x); m[mi][ni].y += acc[mi][ni].y * bfhi(g.x);
                    m[mi][ni].z += acc[mi][ni].z * bflo(g.y); m[mi][ni].w += acc[mi][ni].w * bfhi(g.y);
                }
        }
#pragma unroll
        for (int mi = 0; mi < 4; ++mi)
#pragma unroll
            for (int ni = 0; ni < 2; ++ni) {
                const int r = RL + tm * 128 + wm * 64 + mi * 16 + lr, c = tn * 64 + wn * 32 + ni * 16 + lq * 4;
                u32x2 o; o.x = cvt_pk(m[mi][ni].x, m[mi][ni].y); o.y = cvt_pk(m[mi][ni].z, m[mi][ni].w);
                *(u32x2*)(mb + (size_t)r * 1024 + c) = o;
            }
    }
}


#define XB_TMO      128
#define XB_XCNT(j)  (256  + 64 * (j))
#define XB_XSUB(j)  (1280 + 64 * (j))
#define XB_XGEN(j)  (2304 + 64 * (j))
#define XB_TOP      3328
#define XB_TOPGEN   3392
#define XCD_BAR_WORDS 3456
#define XB_SPIN_CAP (1u << 18)
__device__ __forceinline__ unsigned xb_ld(unsigned* p)              { return __hip_atomic_load(p, __ATOMIC_RELAXED, __HIP_MEMORY_SCOPE_AGENT); }
__device__ __forceinline__ unsigned xb_add(unsigned* p, unsigned v) { return __hip_atomic_fetch_add(p, v, __ATOMIC_RELAXED, __HIP_MEMORY_SCOPE_AGENT); }
__device__ __forceinline__ unsigned xb_xcc_id() { return (unsigned)__builtin_amdgcn_s_getreg((3 << 11) | 20) & 0xFu; }
#define XB_SPIN(cond, bar) do { unsigned _sp = 0; while (cond) { __builtin_amdgcn_s_sleep(1); \
    if ((++_sp & 255u) == 0u) { if (xb_ld(&(bar)[XB_TMO])) break; if (_sp > XB_SPIN_CAP) { atomicAdd(&(bar)[XB_TMO], 1u); break; } } } } while (0)
struct XcdBarrier { unsigned* bar; unsigned x; volatile LAS unsigned* st; };
__device__ __forceinline__ XcdBarrier xcd_barrier_post(unsigned* bar, volatile LAS unsigned* st) {
    XcdBarrier b; b.bar = bar; b.x = xb_xcc_id(); b.st = st;
    if (threadIdx.x == 0) (void)xb_add(&bar[XB_XCNT(b.x)], 1u);
    return b;
}
__device__ __forceinline__ void xcd_barrier_complete(unsigned* bar, unsigned x, unsigned& nloc, unsigned& nx) {
    const unsigned G = gridDim.x * gridDim.y * gridDim.z;
    unsigned sum, cnt, mine, sp = 0u;
    for (;;) {
        sum = 0u; cnt = 0u; mine = 0u;
#pragma unroll
        for (unsigned j = 0; j < 16; ++j) { const unsigned c = xb_ld(&bar[XB_XCNT(j)]); sum += c; cnt += (c > 0u) ? 1u : 0u; mine = (j == x) ? c : mine; }
        if (sum == G) break;
        __builtin_amdgcn_s_sleep(1);
        if ((++sp & 255u) == 0u) { if (xb_ld(&bar[XB_TMO])) break; if (sp > XB_SPIN_CAP) { atomicAdd(&bar[XB_TMO], 1u); break; } }
    }
    nloc = mine > 0u ? mine : 1u; nx = cnt > 0u ? cnt : 1u;
}
__device__ __forceinline__ void xcd_barrier(const XcdBarrier& b) {
    asm volatile("s_waitcnt vmcnt(0)" ::: "memory");
    __syncthreads();
    if (threadIdx.x == 0) {
        unsigned* bar = b.bar;
        __builtin_amdgcn_s_waitcnt(0);
        unsigned nloc = b.st[0], nx = b.st[1];
        if (nloc == 0u) { xcd_barrier_complete(bar, b.x, nloc, nx); b.st[0] = nloc; b.st[1] = nx; }
        const unsigned old = xb_add(&bar[XB_XSUB(b.x)], 1u);
        const unsigned gen = old / nloc;
        if (old + 1u == (gen + 1u) * nloc) {
            __builtin_amdgcn_fence(__ATOMIC_RELEASE, "agent");
            asm volatile("s_waitcnt vmcnt(0)" ::: "memory");
            const unsigned og = xb_add(&bar[XB_TOP], 1u);
            const unsigned tg = og / nx;
            if (og + 1u == (tg + 1u) * nx) xb_add(&bar[XB_TOPGEN], 1u);
            else XB_SPIN(xb_ld(&bar[XB_TOPGEN]) == tg, bar);
            __builtin_amdgcn_fence(__ATOMIC_ACQUIRE, "agent");
            xb_add(&bar[XB_XGEN(b.x)], 1u);
            asm volatile("s_waitcnt vmcnt(0)" ::: "memory");
        } else {
            XB_SPIN(xb_ld(&bar[XB_XGEN(b.x)]) == gen, bar);
            __builtin_amdgcn_fence(__ATOMIC_ACQUIRE, "agent");
            asm volatile("s_waitcnt vmcnt(0)" ::: "memory");
        }
    }
    __syncthreads();
}

__global__ void __launch_bounds__(512, 2) fwd_kernel(Params P) {
    extern __shared__ __attribute__((aligned(16))) unsigned char lds_raw[];
    cg::grid_group grid = cg::this_grid();
    LAS unsigned char* ldsb = (LAS unsigned char*)lds_raw;
#define LDSH ((char*)lds_raw + __builtin_amdgcn_readfirstlane(threadIdx.x >> 8) * HALF_LDS)
    volatile LAS unsigned* bst = (volatile LAS unsigned*)(ldsb + 2 * HALF_LDS);
    if (threadIdx.x < 2) bst[threadIdx.x] = 0u;
    __syncthreads();
    XcdBarrier xbar = xcd_barrier_post((unsigned*)(P.ws + WS_BAR), bst);
    int ph = 0;
#define PHASE_BEGIN if (ph >= P.lo && ph < P.hi) {
#define PHASE_END } ++ph; if (P.coop && ph > P.lo && ph < P.hi) { if (P.coop == 2) grid.sync(); else xcd_barrier(xbar); }

    PHASE_BEGIN
        {
        { const int VG = vgrid(), slot = bid_l();
          for (int i0 = 0; i0 < 384; i0 += VG) { int it = i0 + slot; if (it >= 384) it = 383; mods_task(P, it, LDSH); } }
        if (bid_l() == vgrid() - 1) rope_task(P);
        convert_all(P, 0, LDSH);
        }
    PHASE_END

    const XPtr Xin{(float*)P.in[I_X], (float*)P.in[I_CTX]};
    const XPtr Xcur{P.out, (float*)(P.ws + WS_CTXX)};

    for (int l = 0; l < 2; ++l) {
        const XPtr Xold = l == 0 ? Xin : Xcur;
        const bool ctx_on = (l == 0);
        PHASE_BEGIN
            {
            if (l == 1) convert_all(P, 1, LDSH);
            norm_phase(P, Xold, P.in[I_N1G] + l * D, l, 0, R);
            }
        PHASE_END
        PHASE_BEGIN
            const bf16_t* hb = (const bf16_t*)(ws_l(P) + WS_HBUF); const bf16_t* wt = (const bf16_t*)(ws_l(P) + WS_WTIN);
            EpiP e{(bf16_t*)(ws_l(P) + WS_PBUF), 1536, 1536, (float*)(ws_l(P) + WS_SMALL)};
            {
            big_gemm(ldsb, hb, 1024, wt, 1024, 1792, e);
            ctx_gemm<4>(hb, 1024, wt, 1024, 1024, 1664, e, LDSH); }
        PHASE_END
        PHASE_BEGIN u_phase<0>(P, l, LDSH); PHASE_END
        PHASE_BEGIN scan_phase<64, false>(P); PHASE_END
        PHASE_BEGIN out_phase_g(P, l, !ctx_on, LDSH); PHASE_END
        PHASE_BEGIN
            const bf16_t* hb = (const bf16_t*)(ws_l(P) + WS_HBUF); const bf16_t* wt = (const bf16_t*)(ws_l(P) + WS_WTIN) + (size_t)1792 * 1024;
            EpiP e{(bf16_t*)(ws_l(P) + WS_PBUF), 2048, 2048, nullptr};
            {
            big_gemm(ldsb, hb, 1024, wt, 1024, 2048, e);
            ctx_gemm<2>(hb, 1024, wt, 1024, 1024, 2048, e, LDSH); }
        PHASE_END
        PHASE_BEGIN u_phase_s<1>(P, l, LDSH); PHASE_END
        PHASE_BEGIN scan_phase<128, true>(P); PHASE_END
        PHASE_BEGIN out_phase_s<1>(P, l, 1, !ctx_on, LDSH); PHASE_END
        PHASE_BEGIN
            const bf16_t* hb = (const bf16_t*)(ws_l(P) + WS_HBUF); const bf16_t* wt = (const bf16_t*)(ws_l(P) + WS_WTIN) + (size_t)3840 * 1024;
            EpiP e{(bf16_t*)(ws_l(P) + WS_PBUF), 1536, 1536, nullptr};
            {
            big_gemm(ldsb, hb, 1024, wt, 1024, 1536, e);
            ctx_gemm<4>(hb, 1024, wt, 1024, 1024, 1536, e, LDSH); }
        PHASE_END
        PHASE_BEGIN u_phase_s<2>(P, l, LDSH); PHASE_END
        PHASE_BEGIN scan_phase<64, false>(P); PHASE_END
        PHASE_BEGIN out_phase_s<2>(P, l, 2, !ctx_on, LDSH); PHASE_END
        PHASE_BEGIN
            const bf16_t* hb = (const bf16_t*)(ws_l(P) + WS_HBUF); const bf16_t* wt = (const bf16_t*)(ws_l(P) + WS_WTIN) + (size_t)5376 * 1024;
            EpiSig e{(bf16_t*)(ws_l(P) + WS_GS)};
            {
            big_gemm(ldsb, hb, 1024, wt, 1024, 3072, e);
            if (ctx_on) ctx_gemm<2>(hb, 1024, wt, 1024, 1024, 3072, e, LDSH); }
        PHASE_END
        PHASE_BEGIN
            {   pg8::Gemm g{(const bf16_t*)(ws_l(P) + WS_BR), (const bf16_t*)(ws_l(P) + WS_WTBR), 1536, 512};
                pg8::MergeOrder S; S.S.init(RL, 1024, (int)gridDim.x, (int)blockIdx.x);
                pg8::Epi<EpiMerge> E{EpiMerge{(const bf16_t*)(ws_l(P) + WS_GS), (bf16_t*)(ws_l(P) + WS_MB)}};
                pg8::gemm_phase(ldsb, g, S, E);
                __syncthreads(); }
            if (ctx_on) ctx_merge(P, LDSH);
        PHASE_END
        PHASE_BEGIN
            const float* mods_l = (const float*)(ws_l(P) + WS_MODS) + (size_t)l * 3 * 6144;
            EpiRes e{Xold, Xcur, mods_l, 2};
            big_gemm(ldsb, (const bf16_t*)(ws_l(P) + WS_MB), 1024, (const bf16_t*)(ws_l(P) + WS_WTO), 1024, 1024, e);
            if (ctx_on) ctx_gemm<1>((const bf16_t*)(ws_l(P) + WS_MB), 1024, (const bf16_t*)(ws_l(P) + WS_WTO), 1024, 1024, 1024, e, LDSH);
        PHASE_END
        PHASE_BEGIN norm_phase(P, Xcur, P.in[I_N2G] + l * D, l, 3, ctx_on ? R : RL); PHASE_END
        PHASE_BEGIN
            const bf16_t* hb = (const bf16_t*)(ws_l(P) + WS_HBUF);
            EpiRelu2 e{(bf16_t*)(ws_l(P) + WS_HID)};
            {
            big_gemm(ldsb, hb, 1024, (const bf16_t*)(ws_l(P) + WS_WTUP), 1024, 4096, e);
            if (ctx_on) ctx_gemm<2>(hb, 1024, (const bf16_t*)(ws_l(P) + WS_WTUP), 1024, 1024, 4096, e, LDSH); }
        PHASE_END
        PHASE_BEGIN
            const float* mods_l = (const float*)(ws_l(P) + WS_MODS) + (size_t)l * 3 * 6144;
            EpiRes e{Xcur, Xcur, mods_l, 5};
            big_gemm(ldsb, (const bf16_t*)(ws_l(P) + WS_HID), 4096, (const bf16_t*)(ws_l(P) + WS_WTDN), 4096, 1024, e);
            if (ctx_on) ctx_gemm<1>((const bf16_t*)(ws_l(P) + WS_HID), 4096, (const bf16_t*)(ws_l(P) + WS_WTDN), 4096, 4096, 1024, e, LDSH);
        PHASE_END
    }
    PHASE_BEGIN final_norm_phase(P); PHASE_END
#undef PHASE_BEGIN
#undef PHASE_END
}
constexpr int NPHASES = 1 + 2 * 19 + 1;

extern "C" void kernel_launch(void* const* d_in, const int* in_sizes, int n_in, void* d_out, int out_size, void* d_ws, size_t ws_size, hipStream_t stream) {
    static int grid = 0;
    if (grid == 0) {
        if (n_in != 23 || ws_size < WS_END || out_size != NB * SEQ * D) { fprintf(stderr, "kernel_launch: unexpected sizes n_in %d ws %zu (need %zu) out %d\n", n_in, ws_size, (size_t)WS_END, out_size); grid = -1; return; }
        int dev = 0, cus = 0, per_cu = 0;
        if (hipGetDevice(&dev) != hipSuccess || hipDeviceGetAttribute(&cus, hipDeviceAttributeMultiprocessorCount, dev) != hipSuccess) { grid = -1; return; }
        if (hipFuncSetAttribute((const void*)fwd_kernel, hipFuncAttributeMaxDynamicSharedMemorySize, LDS_BYTES) != hipSuccess) { fprintf(stderr, "kernel_launch: hipFuncSetAttribute failed\n"); grid = -1; return; }
        if (hipOccupancyMaxActiveBlocksPerMultiprocessor(&per_cu, (const void*)fwd_kernel, 512, LDS_BYTES) != hipSuccess || per_cu < 1) { fprintf(stderr, "kernel_launch: occupancy query failed (%d)\n", per_cu); grid = -1; return; }
        grid = cus;
        grid -= grid % 8;
    }
    if (grid < 0) return;
    if (hipMemsetAsync((char*)d_ws + WS_BAR, 0, (size_t)3456 * 4, stream) != hipSuccess) { fprintf(stderr, "kernel_launch: memset failed\n"); return; }
    Params p{};
    for (int i = 0; i < 23; ++i) p.in[i] = (const float*)d_in[i];
    p.out = (float*)d_out; p.ws = (unsigned char*)d_ws;
    p.lo = 0; p.hi = NPHASES; p.coop = 1;
    void* args[] = {&p};
    hipError_t e = hipLaunchCooperativeKernel((const void*)fwd_kernel, dim3(grid), dim3(512), args, LDS_BYTES, stream);
    if (e != hipSuccess) fprintf(stderr, "kernel_launch: cooperative launch failed: %s (grid %d)\n", hipGetErrorString(e), grid);
}
```
